# Optimizing an MI355X kernel written in HIP

```python
import jax
import jax.numpy as jnp
from jax import lax
import numpy as np

D_MODEL = 1024
BATCH = 4
SEQ = 4096
DEPTH = 2

GRID_W = 64
CTX_LEN = 256
Q_BLOCK = 128
ROPE_THETA = 10000.0
NORM_EPS = 1e-6

GQA_HEADS = 8
GQA_KV_HEADS = 2
GQA_GROUP = GQA_HEADS // GQA_KV_HEADS
GQA_HEAD_DIM = 64
GQA_SCALE = GQA_HEAD_DIM ** -0.5

RWKV_HEADS = 8
RWKV_HEAD = 64
RWKV_DIM = RWKV_HEADS * RWKV_HEAD
DECAY_LORA = 64
AAA_LORA = 64
GATE_LORA = 128
LNX_EPS = 64e-5

MLA_HEADS = 8
Q_LORA = 384
KV_LORA = 256
QK_NOPE = 64
QK_ROPE = 32
V_HEAD = 64
MLA_SCALE = (QK_NOPE + QK_ROPE) ** -0.5

N_BRANCH = 3
BRANCH_W = 512
D_FF = 4 * D_MODEL

RWKV_SPLITS = (RWKV_DIM, RWKV_DIM, RWKV_DIM, 2 * DECAY_LORA, 2 * AAA_LORA, GATE_LORA)
RWKV_IN = 3 * RWKV_DIM + 2 * DECAY_LORA + 2 * AAA_LORA + GATE_LORA
SPLIT_SIZES = (GQA_HEADS * GQA_HEAD_DIM, GQA_KV_HEADS * GQA_HEAD_DIM, GQA_KV_HEADS * GQA_HEAD_DIM,
               RWKV_IN, Q_LORA, KV_LORA, QK_ROPE, N_BRANCH * D_MODEL)
N_IN = sum(SPLIT_SIZES)

kernel_name = 'hybrid_gqa_rwkv7_mla_dit_trunk'


def split_last(t, sizes):
    out, start = [], 0
    for s in sizes:
        out.append(t[..., start:start + s])
        start += s
    return out


def rms_norm(x, gain, eps=NORM_EPS):
    xf = x.astype(jnp.float32)
    y = xf * lax.rsqrt(jnp.mean(xf * xf, axis=-1, keepdims=True) + eps)
    return (y * gain.astype(jnp.float32)).astype(x.dtype)


def modulate(h, shift, scale):
    return h * (1.0 + scale) + shift


def rope_1d(x, pos):
    n = x.shape[-1] // 2
    inv_freq = ROPE_THETA ** (-jnp.arange(n, dtype=jnp.float32) / n)
    ang = pos.astype(jnp.float32)[:, None] * inv_freq[None, :]
    cos = jnp.cos(ang)[None, :, None, :]
    sin = jnp.sin(ang)[None, :, None, :]
    xf = x.astype(jnp.float32)
    x1, x2 = xf[..., :n], xf[..., n:]
    return jnp.concatenate([x1 * cos - x2 * sin, x1 * sin + x2 * cos], axis=-1).astype(x.dtype)


def axial_rope(x, rows, cols):
    half = x.shape[-1] // 2
    return jnp.concatenate([rope_1d(x[..., :half], rows), rope_1d(x[..., half:], cols)], axis=-1)


def block_attention(q, k, v, scale):
    b, t, hk, g, dq = q.shape
    nb = t // Q_BLOCK
    qb = jnp.moveaxis(q.reshape(b, nb, Q_BLOCK, hk, g, dq), 1, 0)

    def one_block(qi):
        s = jnp.einsum('bqhgd,bkhd->bhgqk', qi, k, preferred_element_type=jnp.float32) * scale
        p = jax.nn.softmax(s, axis=-1).astype(v.dtype)
        return jnp.einsum('bhgqk,bkhe->bqhge', p, v)

    o = lax.map(one_block, qb)
    return jnp.moveaxis(o, 0, 1).reshape(b, t, hk, g, v.shape[-1])


def gqa_branch(p_ctx, p_lat, q_gain, k_gain, pos, ctx_out):
    def heads(t, n):
        return t.reshape(t.shape[0], t.shape[1], n, GQA_HEAD_DIM)

    def keys_values(p, pos_):
        k = rms_norm(heads(p[1], GQA_KV_HEADS), k_gain)
        if pos_ is not None:
            k = axial_rope(k, *pos_)
        return k, heads(p[2], GQA_KV_HEADS)

    def queries(p, pos_):
        q = rms_norm(heads(p[0], GQA_HEADS), q_gain)
        if pos_ is not None:
            q = axial_rope(q, *pos_)
        return q.reshape(q.shape[0], q.shape[1], GQA_KV_HEADS, GQA_GROUP, GQA_HEAD_DIM)

    k_c, v_c = keys_values(p_ctx, None)
    k_l, v_l = keys_values(p_lat, pos)
    b, t = p_lat[0].shape[:2]
    y_lat = block_attention(queries(p_lat, pos), jnp.concatenate([k_c, k_l], axis=1),
                            jnp.concatenate([v_c, v_l], axis=1), GQA_SCALE).reshape(b, t, GQA_HEADS * GQA_HEAD_DIM)
    y_ctx = None
    if ctx_out:
        bc, tc = p_ctx[0].shape[:2]
        y_ctx = block_attention(queries(p_ctx, None), k_c, v_c, GQA_SCALE).reshape(bc, tc, GQA_HEADS * GQA_HEAD_DIM)
    return y_ctx, y_lat


def centred_shift(u, mu):
    zero = jnp.zeros_like(u[:, :1])
    prev = jnp.concatenate([zero, u[:, :-1]], axis=1)
    nxt = jnp.concatenate([u[:, 1:], zero], axis=1)
    return u + mu[0] * (prev - u) + mu[1] * (nxt - u)


def wkv7_scan(state0, r, decay, k, v, a_vec, b_vec, reverse, emit):
    def step(S, inp):
        r_t, w_t, k_t, v_t, a_t, b_t = inp
        sa = jnp.einsum('bhvk,bhk->bhv', S, a_t)
        S = S * w_t[:, :, None, :] + sa[..., None] * b_t[:, :, None, :] + v_t[..., None] * k_t[:, :, None, :]
        y = jnp.einsum('bhvk,bhk->bhv', S, r_t) if emit else None
        return S, y

    xs = tuple(jnp.moveaxis(t, 1, 0) for t in (r, decay, k, v, a_vec, b_vec))
    S, ys = lax.scan(step, state0, xs, reverse=reverse)
    return S, (jnp.moveaxis(ys, 0, 1) if emit else None)


def rwkv7_branch(u_ctx, u_lat, w0, w2, a0, a2, g2, k_k, k_a, r_k, ln_w, ln_b, ctx_out):
    out_dtype = u_lat.dtype
    k_a_h = k_a.reshape(RWKV_HEADS, RWKV_HEAD).astype(jnp.float32)

    def heads(t):
        return t.reshape(t.shape[0], t.shape[1], RWKV_HEADS, RWKV_HEAD)

    def prep(u):
        r, k, v, wd, ad, gd = split_last(u.astype(jnp.float32), RWKV_SPLITS)
        kk = heads(k * k_k)
        kk = kk / jnp.maximum(jnp.sqrt(jnp.sum(kk * kk, axis=-1, keepdims=True)), 1e-12)
        return heads(r), heads(k), heads(v), kk, wd, ad, gd

    def direction_inputs(k, kk, wd, ad, d):
        wd_d = wd[..., d * DECAY_LORA:(d + 1) * DECAY_LORA]
        ad_d = ad[..., d * AAA_LORA:(d + 1) * AAA_LORA]
        w_log = -jax.nn.softplus(-(w0[d] + jnp.tanh(wd_d) @ w2[d])) - 0.5
        decay = heads(jnp.exp(-jnp.exp(w_log)))
        a = heads(jax.nn.sigmoid(a0[d] + ad_d @ a2[d]))
        k_d = k * (1.0 + (a - 1.0) * k_a_h)
        return decay, k_d, -kk, kk * a

    def bonus(r, k_d, v):
        return jnp.sum(r * k_d * r_k, axis=-1, keepdims=True) * v

    def finish(y, bon, gd):
        b, t = y.shape[:2]
        mu = jnp.mean(y, axis=-1, keepdims=True)
        var = jnp.mean(jnp.square(y - mu), axis=-1, keepdims=True)
        yn = ((y - mu) * lax.rsqrt(var + LNX_EPS)).reshape(b, t, RWKV_DIM) * ln_w + ln_b
        out = (yn + bon.reshape(b, t, RWKV_DIM)) * (jax.nn.sigmoid(gd) @ g2)
        return out.astype(out_dtype)

    r_c, k_c, v_c, kk_c, wd_c, ad_c, gd_c = prep(u_ctx)
    r_l, k_l, v_l, kk_l, wd_l, ad_l, gd_l = prep(u_lat)
    state0 = jnp.zeros((u_ctx.shape[0], RWKV_HEADS, RWKV_HEAD, RWKV_HEAD), jnp.float32)
    ys_c, bs_c, ys_l, bs_l = [], [], [], []
    for d in range(2):
        rev = d == 1
        dec_c, kd_c, av_c, bv_c = direction_inputs(k_c, kk_c, wd_c, ad_c, d)
        s_ctx, y_c = wkv7_scan(state0, r_c, dec_c, kd_c, v_c, av_c, bv_c, rev, ctx_out)
        dec_l, kd_l, av_l, bv_l = direction_inputs(k_l, kk_l, wd_l, ad_l, d)
        _, y_l = wkv7_scan(s_ctx, r_l, dec_l, kd_l, v_l, av_l, bv_l, rev, True)
        ys_l.append(y_l)
        bs_l.append(bonus(r_l, kd_l, v_l))
        if ctx_out:
            ys_c.append(y_c)
            bs_c.append(bonus(r_c, kd_c, v_c))
    y_lat = finish(ys_l[0] + ys_l[1], bs_l[0] + bs_l[1], gd_l)
    y_ctx = finish(ys_c[0] + ys_c[1], bs_c[0] + bs_c[1], gd_c) if ctx_out else None
    return y_ctx, y_lat


def mla_branch(p_ctx, p_lat, q_norm, q_up, kv_norm, kv_up, pos, ctx_out):
    def keys_values(p, pos_):
        kv_down, k_rope = p[1], p[2]
        b, t = kv_down.shape[:2]
        kv = (rms_norm(kv_down, kv_norm) @ kv_up).reshape(b, t, MLA_HEADS, QK_NOPE + V_HEAD)
        k_rope = k_rope[:, :, None, :]
        if pos_ is not None:
            k_rope = axial_rope(k_rope, *pos_)
        k = jnp.concatenate([kv[..., :QK_NOPE], jnp.broadcast_to(k_rope, (b, t, MLA_HEADS, QK_ROPE))], axis=-1)
        return k, kv[..., QK_NOPE:]

    def queries(p, pos_):
        q_down = p[0]
        b, t = q_down.shape[:2]
        q = (rms_norm(q_down, q_norm) @ q_up).reshape(b, t, MLA_HEADS, QK_NOPE + QK_ROPE)
        if pos_ is not None:
            q = jnp.concatenate([q[..., :QK_NOPE], axial_rope(q[..., QK_NOPE:], *pos_)], axis=-1)
        return q[:, :, :, None, :]

    k_c, v_c = keys_values(p_ctx, None)
    k_l, v_l = keys_values(p_lat, pos)
    b, t = p_lat[0].shape[:2]
    y_lat = block_attention(queries(p_lat, pos), jnp.concatenate([k_c, k_l], axis=1),
                            jnp.concatenate([v_c, v_l], axis=1), MLA_SCALE).reshape(b, t, MLA_HEADS * V_HEAD)
    y_ctx = None
    if ctx_out:
        bc, tc = p_ctx[0].shape[:2]
        y_ctx = block_attention(queries(p_ctx, None), k_c, v_c, MLA_SCALE).reshape(bc, tc, MLA_HEADS * V_HEAD)
    return y_ctx, y_lat


def merge_branches(ys, gate_logits, w_branch, w_out):
    d = w_out.shape[0]
    gates = jax.nn.sigmoid(gate_logits)
    mixed = gates[..., :d] * (ys[0] @ w_branch[0])
    for i in range(1, N_BRANCH):
        mixed = mixed + gates[..., i * d:(i + 1) * d] * (ys[i] @ w_branch[i])
    return mixed @ w_out


def sqrelu_mlp(h, w1, w2):
    return jnp.square(jax.nn.relu(h @ w1)) @ w2


def setup_inputs(seed: int = 0) -> dict:
    key = jax.random.key(seed)
    keys = iter(jax.random.split(key, 48))
    f32 = jnp.float32
    L, D = DEPTH, D_MODEL

    def normal(shape, scale):
        return jax.random.normal(next(keys), shape, f32) * scale

    def uniform(shape, lo, hi):
        return jax.random.uniform(next(keys), shape, f32, lo, hi)

    return {
        'x': normal((BATCH, SEQ, D), 1.0),
        'c': normal((BATCH, D), 1.0),
        'ctx': normal((BATCH, CTX_LEN, D), 1.0),
        'c_ctx': normal((D,), 1.0),
        'w_mod': normal((L, D, 6 * D), 0.5 * D ** -0.5),
        'b_mod': normal((L, 6 * D), 0.02),
        'g_norm1': 1.0 + normal((L, D), 0.02),
        'g_norm2': 1.0 + normal((L, D), 0.02),
        'w_in': normal((L, D, N_IN), D ** -0.5),
        'gqa_q_gain': 1.0 + normal((L, GQA_HEAD_DIM), 0.02),
        'gqa_k_gain': 1.0 + normal((L, GQA_HEAD_DIM), 0.02),
        'rwkv_shift_mu': uniform((L, 2, RWKV_IN), 0.0, 0.5),
        'rwkv_w0': uniform((L, 2, RWKV_DIM), -6.0, -1.0),
        'rwkv_w2': normal((L, 2, DECAY_LORA, RWKV_DIM), 0.1 * DECAY_LORA ** -0.5),
        'rwkv_a0': normal((L, 2, RWKV_DIM), 0.1),
        'rwkv_a2': normal((L, 2, AAA_LORA, RWKV_DIM), 0.5 * AAA_LORA ** -0.5),
        'rwkv_g2': normal((L, GATE_LORA, RWKV_DIM), GATE_LORA ** -0.5),
        'rwkv_k_k': 0.85 + normal((L, RWKV_DIM), 0.02),
        'rwkv_k_a': 1.0 + normal((L, RWKV_DIM), 0.02),
        'rwkv_r_k': normal((L, RWKV_HEADS, RWKV_HEAD), 0.1),
        'rwkv_ln_w': 1.0 + normal((L, RWKV_DIM), 0.02),
        'rwkv_ln_b': normal((L, RWKV_DIM), 0.02),
        'mla_q_norm': 1.0 + normal((L, Q_LORA), 0.02),
        'mla_q_up': normal((L, Q_LORA, MLA_HEADS * (QK_NOPE + QK_ROPE)), Q_LORA ** -0.5),
        'mla_kv_norm': 1.0 + normal((L, KV_LORA), 0.02),
        'mla_kv_up': normal((L, KV_LORA, MLA_HEADS * (QK_NOPE + V_HEAD)), KV_LORA ** -0.5),
        'w_branch': normal((L, N_BRANCH, BRANCH_W, D), BRANCH_W ** -0.5),
        'w_out': normal((L, D, D), D ** -0.5),
        'w_ff1': normal((L, D, D_FF), D ** -0.5),
        'w_ff2': normal((L, D_FF, D), D_FF ** -0.5),
        'g_final': 1.0 + normal((D,), 0.02),
    }


def reference(x, c, ctx, c_ctx, w_mod, b_mod, g_norm1, g_norm2, w_in, gqa_q_gain, gqa_k_gain,
              rwkv_shift_mu, rwkv_w0, rwkv_w2, rwkv_a0, rwkv_a2, rwkv_g2, rwkv_k_k, rwkv_k_a, rwkv_r_k,
              rwkv_ln_w, rwkv_ln_b, mla_q_norm, mla_q_up, mla_kv_norm, mla_kv_up,
              w_branch, w_out, w_ff1, w_ff2, g_final):
    b, t, d = x.shape
    rows_n = t // GRID_W
    rows = jnp.repeat(jnp.arange(rows_n, dtype=jnp.int32), GRID_W)
    cols = jnp.tile(jnp.arange(GRID_W, dtype=jnp.int32), rows_n)
    pos = (rows, cols)

    for l in range(DEPTH):
        ctx_out = l < DEPTH - 1
        mod_lat = (jax.nn.silu(c) @ w_mod[l] + b_mod[l])[:, None, :]
        mod_ctx = (jax.nn.silu(c_ctx) @ w_mod[l] + b_mod[l])[None, None, :]
        sh_a, sc_a, gt_a, sh_f, sc_f, gt_f = split_last(mod_lat, (d,) * 6)
        csh_a, csc_a, cgt_a, csh_f, csc_f, cgt_f = split_last(mod_ctx, (d,) * 6)

        h_lat = modulate(rms_norm(x, g_norm1[l]), sh_a, sc_a)
        h_ctx = modulate(rms_norm(ctx, g_norm1[l]), csh_a, csc_a)
        p_lat = split_last(h_lat @ w_in[l], SPLIT_SIZES)
        p_ctx = split_last(h_ctx @ w_in[l], SPLIT_SIZES)

        a_ctx, a_lat = gqa_branch(p_ctx[0:3], p_lat[0:3], gqa_q_gain[l], gqa_k_gain[l], pos, ctx_out)
        r_ctx, r_lat = rwkv7_branch(centred_shift(p_ctx[3], rwkv_shift_mu[l]),
                                    centred_shift(p_lat[3], rwkv_shift_mu[l]),
                                    rwkv_w0[l], rwkv_w2[l], rwkv_a0[l], rwkv_a2[l], rwkv_g2[l],
                                    rwkv_k_k[l], rwkv_k_a[l], rwkv_r_k[l], rwkv_ln_w[l], rwkv_ln_b[l], ctx_out)
        m_ctx, m_lat = mla_branch(p_ctx[4:7], p_lat[4:7], mla_q_norm[l], mla_q_up[l],
                                  mla_kv_norm[l], mla_kv_up[l], pos, ctx_out)

        x = x + gt_a * merge_branches((a_lat, r_lat, m_lat), p_lat[7], w_branch[l], w_out[l])
        x = x + gt_f * sqrelu_mlp(modulate(rms_norm(x, g_norm2[l]), sh_f, sc_f), w_ff1[l], w_ff2[l])
        if ctx_out:
            ctx = ctx + cgt_a * merge_branches((a_ctx, r_ctx, m_ctx), p_ctx[7], w_branch[l], w_out[l])
            ctx = ctx + cgt_f * sqrelu_mlp(modulate(rms_norm(ctx, g_norm2[l]), csh_f, csc_f), w_ff1[l], w_ff2[l])

    return rms_norm(x, g_final)
```

```cpp
#include <hip/hip_runtime.h>
#include <hip/hip_bf16.h>
#include <cstdio>
#include <cstdint>

#ifndef ONE_LAUNCH
#define ONE_LAUNCH 1
#define P2_WGS 8
#endif

constexpr int DM = 1024, NB = 4, SEQ = 4096, CTX = 256, RPB = SEQ + CTX  , MROWS = NB * RPB  , HM = 2 * RPB  ;
constexpr int NIN = 6432, PPW = 3584  , NGATE = 3072;
constexpr int C_GQ = 0, C_GK = 512, C_GV = 640, C_RW = 768, C_QD = 2688, C_KVD = 3072, C_KR = 3328, C_GATE = 3360;
constexpr int RW_R = 0, RW_K = 512, RW_V = 1024, RW_WD = 1536, RW_AD = 1664, RW_GD = 1792, RWIN = 1920;
constexpr int DFF = 4096;
constexpr float NORM_EPS = 1e-6f, LNX_EPS = 64e-5f;

__device__ __forceinline__ int otid() { int t = threadIdx.x; asm volatile("" : "+v"(t)); return t; }
namespace pg8 {
#define PG8_LAS __attribute__((address_space(3)))
typedef unsigned short bf16_t;
typedef short bf16x8 __attribute__((ext_vector_type(8)));
typedef float f32x4 __attribute__((ext_vector_type(4)));
typedef unsigned u32x4 __attribute__((ext_vector_type(4)));
constexpr int BM = 256, BK = 64, HALF = 128, HTB = HALF * BK * 2, STAGE_BYTES = 8 * HTB, NXCD = 8, WGM = 8;

__host__ __device__ __forceinline__ int lds_byte(int r, int c) { const int st = (r >> 4) * 2 + (c >> 5), rr = r & 15, cc = c & 31, ob = rr * 64 + cc * 2; return st * 1024 + (ob ^ (((ob >> 9) & 1) << 5)); }
__host__ __device__ __forceinline__ void stage_rc(int b, int& R, int& C) { const int st = b / 1024, sb = b % 1024, swz = sb ^ (((sb >> 9) & 1) << 5); R = (st >> 1) * 16 + swz / 64; C = (st & 1) * 32 + (swz % 64) / 2; }
__host__ __device__ __forceinline__ int perm32(int rho) { const int n = rho >> 4, i = rho & 15; return 8 * (i >> 2) + 4 * n + (i & 3); }

struct Unit { int pm, pn, ka; };
struct Gemm { const bf16_t* A; const bf16_t* Bt; int lda, ldb, K; };

struct TileOrder {
    int nM, nN, nwg, G, c, skipctx;
    __device__ void init(int nM_, int nN_, int G_, int c_, int skip_) { nM = nM_; nN = nN_; nwg = nM * nN; G = G_; c = c_; skipctx = skip_; }
    __device__ bool next(int i, Unit& u) const {
        const long L = (long)i * G + c; if (L >= nwg) return false;
        int wgid = (int)L; { const int q = nwg / NXCD, r = nwg % NXCD, xcd = wgid % NXCD, off = wgid / NXCD; wgid = (xcd < r ? xcd * (q + 1) : r * (q + 1) + (xcd - r) * q) + off; }
        const int nig = WGM * nN, gid = wgid / nig, fm = gid * WGM, gsz = (nM - fm) < WGM ? (nM - fm) : WGM;
        u.pm = fm + ((wgid % nig) % gsz); u.pn = (wgid % nig) / gsz; u.ka = 0;
        if (skipctx) u.pm = u.pm + u.pm / 16 + 1;
        return true;
    }
    __device__ __forceinline__ void a_ready(const Unit&) const {}
    __device__ __forceinline__ void done(const Unit&) const {}
};

struct CtxSplitOrder {
    int G, c, kslice;
    __device__ void init(int G_, int c_, int kslice_) { G = G_; c = c_; kslice = kslice_; }
    __device__ bool next(int i, Unit& u) const { const int L = i * G + c; if (L >= 64) return false; const int t = L >> 2; u.pm = (t >> 2) * 17; u.pn = t & 3; u.ka = (L & 3) * kslice; return true; }
    __device__ __forceinline__ void a_ready(const Unit&) const {}
    __device__ __forceinline__ void done(const Unit&) const {}
};
__device__ __forceinline__ unsigned cvt_pk_bf16(float lo, float hi) { unsigned r; asm volatile("v_cvt_pk_bf16_f32 %0, %1, %2" : "=v"(r) : "v"(lo), "v"(hi)); return r; }
__device__ __forceinline__ float bf_lo(unsigned w) { return __uint_as_float(w << 16); }
__device__ __forceinline__ float bf_hi(unsigned w) { return __uint_as_float(w & 0xffff0000u); }

enum { EPI_BF16 = 0, EPI_RELU2 = 1, EPI_SIGMOID = 2, EPI_ROWSCALE = 3, EPI_MLAQ = 4, EPI_GATEMUL0 = 5, EPI_GATEMUL = 6, EPI_RESID = 7 };
template <int MODE> struct Epi {
    static constexpr bool PERM = true, AFTER_DRAIN = false;
    bf16_t* O; int ldc;
    const float* rs;
    const bf16_t* G; int ldg;
    const float* tc; const float* ts;
    int first;
    int pm_off, kslice;
    float* part;
    const float* xsl; const float* xsc; float* xdl; float* xdc; const float* gate;
    __device__ __forceinline__ void operator()(const f32x4 (&acc)[2][2][4][2], const Unit& u, int wr, int wc, int fr, int fq) const {
        const int col0 = u.pn * BM + wc * 32 + 8 * fq;
        if constexpr (MODE == EPI_RESID) {
            const int gpm = u.pm + pm_off, b = gpm / 17, t = gpm % 17;
            const float* xs = (t == 0) ? xsc + (size_t)(b * CTX) * DM : xsl + (size_t)(b * SEQ + (t - 1) * 256) * DM;
            float* xd = (t == 0) ? xdc + (size_t)(b * CTX) * DM : xdl + (size_t)(b * SEQ + (t - 1) * 256) * DM;
            const float* gv = gate + (size_t)((t == 0) ? 4 : b) * 6144;
            f32x4 g[2][2];
#pragma unroll
            for (int bj = 0; bj < 2; ++bj)
#pragma unroll
                for (int n = 0; n < 2; ++n) g[bj][n] = *(const f32x4*)(gv + col0 + bj * HALF + 4 * n);
#pragma unroll
            for (int ai = 0; ai < 2; ++ai)
#pragma unroll
                for (int m = 0; m < 4; ++m) { const size_t ro = (size_t)(ai * HALF + wr * 64 + m * 16 + fr) * DM + col0;
#pragma unroll
                    for (int bj = 0; bj < 2; ++bj)
#pragma unroll
                        for (int n = 0; n < 2; ++n) {
                            if (u.ka != 0) *(f32x4*)(part + (size_t)(u.ka / kslice - 1) * 1048576 + (size_t)(b * CTX) * DM + ro + bj * HALF + 4 * n) = g[bj][n] * acc[ai][bj][m][n];
                            else { const f32x4 xv = *(const f32x4*)(xs + ro + bj * HALF + 4 * n);
                                *(f32x4*)(xd + ro + bj * HALF + 4 * n) = xv + g[bj][n] * acc[ai][bj][m][n]; } } }
        } else {
            const int row0 = u.pm * BM + wr * 64 + fr;
#pragma unroll
            for (int ai = 0; ai < 2; ++ai)
#pragma unroll
                for (int m = 0; m < 4; ++m) { const int row = row0 + ai * HALF + m * 16; bf16_t* rowp = O + (size_t)row * ldc + col0;
                    float rsc = 1.f; int pr = 0, pc = 0; bool lat = false;
                    if constexpr (MODE == EPI_ROWSCALE || MODE == EPI_MLAQ) rsc = rs[row];
                    if constexpr (MODE == EPI_MLAQ) { const int s = row % RPB; lat = s >= CTX; const int tt = s - CTX; pr = (tt >> 6) & 63; pc = tt & 63; }
#pragma unroll
                    for (int bj = 0; bj < 2; ++bj) { f32x4 v0 = acc[ai][bj][m][0], v1 = acc[ai][bj][m][1];
                        if constexpr (MODE == EPI_RELU2) {
#pragma unroll
                            for (int e = 0; e < 4; ++e) { float a = fmaxf(v0[e], 0.f), b = fmaxf(v1[e], 0.f); v0[e] = a * a; v1[e] = b * b; } }
                        if constexpr (MODE == EPI_SIGMOID) {
#pragma unroll
                            for (int e = 0; e < 4; ++e) { v0[e] = 1.f / (1.f + __expf(-v0[e])); v1[e] = 1.f / (1.f + __expf(-v1[e])); } }
                        if constexpr (MODE == EPI_ROWSCALE || MODE == EPI_MLAQ) { v0 = v0 * rsc; v1 = v1 * rsc; }
                        if constexpr (MODE == EPI_MLAQ) {
                            const int g32 = u.pn * 8 + bj * 4 + wc;
                            if (g32 % 3 == 2) {
                                f32x4 p0, p1;
#pragma unroll
                                for (int e = 0; e < 4; ++e) { p0[e] = __shfl_xor(v0[e], 16); p1[e] = __shfl_xor(v1[e], 16); }
                                if (lat) { const int pos = (fq < 2) ? pr : pc; const f32x4 c0 = *(const f32x4*)(tc + pos * 8), c1 = *(const f32x4*)(tc + pos * 8 + 4), s0 = *(const f32x4*)(ts + pos * 8), s1 = *(const f32x4*)(ts + pos * 8 + 4);
                                    if ((fq & 1) == 0) { v0 = v0 * c0 - p0 * s0; v1 = v1 * c1 - p1 * s1; } else { v0 = p0 * s0 + v0 * c0; v1 = p1 * s1 + v1 * c1; } }
                            } }
                        if constexpr (MODE == EPI_GATEMUL0 || MODE == EPI_GATEMUL) {
                            const u32x4 gw = *(const u32x4*)(G + (size_t)row * ldg + col0 + bj * HALF);
                            v0[0] *= bf_lo(gw.x); v0[1] *= bf_hi(gw.x); v0[2] *= bf_lo(gw.y); v0[3] *= bf_hi(gw.y); v1[0] *= bf_lo(gw.z); v1[1] *= bf_hi(gw.z); v1[2] *= bf_lo(gw.w); v1[3] *= bf_hi(gw.w);
                            if (MODE == EPI_GATEMUL && !first) { const u32x4 ow = *(const u32x4*)(rowp + bj * HALF);
                                v0[0] += bf_lo(ow.x); v0[1] += bf_hi(ow.x); v0[2] += bf_lo(ow.y); v0[3] += bf_hi(ow.y); v1[0] += bf_lo(ow.z); v1[1] += bf_hi(ow.z); v1[2] += bf_lo(ow.w); v1[3] += bf_hi(ow.w); } }
                        u32x4 w; w.x = cvt_pk_bf16(v0[0], v0[1]); w.y = cvt_pk_bf16(v0[2], v0[3]); w.z = cvt_pk_bf16(v1[0], v1[1]); w.w = cvt_pk_bf16(v1[2], v1[3]);
                        *(u32x4*)(rowp + bj * HALF) = w; } }
        }
    }
};

template <class EpiT, class Sched, bool ALIGN_EPI>
__device__ __forceinline__ void gemm_phase(PG8_LAS unsigned char* lds, const Gemm g, const Sched& S, const EpiT& E) {
    const int tid = otid(), wid = __builtin_amdgcn_readfirstlane(tid >> 6), lane = tid & 63, wr = wid >> 2, wc = wid & 3, fr = lane & 15, fq = lane >> 4;
    const int nt = g.K / BK;
    unsigned voffA[2], voffB[2];
#pragma unroll
    for (int i = 0; i < 2; ++i) { int R, C; stage_rc(tid * 16 + i * 8192, R, C); const int Rb = EpiT::PERM ? ((R & ~31) + perm32(R & 31)) : R;
        voffA[i] = (unsigned)(R * g.lda + C) * 2u; voffB[i] = (unsigned)(Rb * g.ldb + C) * 2u; }
    const size_t kstep = (size_t)(BK * 2);
    const size_t hsA = (size_t)HALF * g.lda * 2, hsB = (size_t)HALF * g.ldb * 2, tsA = 2 * hsA, tsB = 2 * hsB;
    const unsigned ldsw = (unsigned)wid * 1024u;
    const int aoff = lds_byte(wr * 64 + fr, fq * 8), boff = lds_byte(wc * 32 + fr, fq * 8);
#define PG8_SA(b, h) (((b) * 2 + (h)) * HTB)
#define PG8_SB(b, h) ((4 + (b) * 2 + (h)) * HTB)
#define PG8_STAGE(bufoff, gbase, voff) do { _Pragma("unroll") for (int _i = 0; _i < 2; ++_i) \
        __builtin_amdgcn_global_load_lds((const unsigned*)((const char*)(gbase) + (voff)[_i]), (PG8_LAS unsigned*)(lds + (bufoff) + ldsw + _i * 8192), 16, 0, 0); } while (0)
#define PG8_LDA(dst, b, h) do { _Pragma("unroll") for (int m = 0; m < 4; ++m) _Pragma("unroll") for (int k = 0; k < 2; ++k) dst[m][k] = *(const PG8_LAS bf16x8*)(lds + PG8_SA(b, h) + aoff + m * 2048 + k * 1024); } while (0)
#define PG8_LDB(dst, b, h) do { _Pragma("unroll") for (int n = 0; n < 2; ++n) _Pragma("unroll") for (int k = 0; k < 2; ++k) dst[n][k] = *(const PG8_LAS bf16x8*)(lds + PG8_SB(b, h) + boff + n * 2048 + k * 1024); } while (0)
#define PG8_MMA(ai, bj, At, Bt) do { __builtin_amdgcn_s_setprio(1); _Pragma("unroll") for (int m = 0; m < 4; ++m) _Pragma("unroll") for (int n = 0; n < 2; ++n) _Pragma("unroll") for (int k = 0; k < 2; ++k) \
        acc[ai][bj][m][n] = __builtin_amdgcn_mfma_f32_16x16x32_bf16(Bt[n][k], At[m][k], acc[ai][bj][m][n], 0, 0, 0); __builtin_amdgcn_s_setprio(0); } while (0)
#define PG8_WAIT_V(n) asm volatile("s_waitcnt vmcnt(" #n ")" ::: "memory")
#define PG8_WAIT_L(n) asm volatile("s_waitcnt lgkmcnt(" #n ")" ::: "memory")
#define PG8_BAR __builtin_amdgcn_s_barrier()
#define PG8_SCHED __builtin_amdgcn_sched_barrier(0)
    Unit cur, nxt; int ui = 0;
    if (!S.next(0, cur)) return;
    f32x4 acc[2][2][4][2];
    float zf; asm volatile("v_mov_b32 %0, 0" : "=v"(zf));
#pragma unroll
    for (int a = 0; a < 2; ++a)
#pragma unroll
        for (int b = 0; b < 2; ++b)
#pragma unroll
            for (int m = 0; m < 4; ++m)
#pragma unroll
                for (int n = 0; n < 2; ++n) acc[a][b][m][n] = (f32x4){zf, zf, zf, zf};
    bf16x8 At[4][2], B0[2][2], B1[2][2];
    const char* cA = (const char*)g.A + (size_t)cur.pm * tsA + (size_t)cur.ka * 2; const char* cB = (const char*)g.Bt + (size_t)cur.pn * tsB + (size_t)cur.ka * 2;
    S.a_ready(cur);
    PG8_STAGE(PG8_SB(0, 0), cB, voffB); PG8_STAGE(PG8_SB(0, 1), cB + hsB, voffB); PG8_STAGE(PG8_SA(0, 0), cA, voffA); PG8_STAGE(PG8_SA(0, 1), cA + hsA, voffA);
    if (wr == 1) PG8_BAR;
    PG8_WAIT_V(2); PG8_BAR;
    PG8_STAGE(PG8_SB(1, 0), cB + kstep, voffB); PG8_STAGE(PG8_SA(1, 0), cA + kstep, voffA); PG8_STAGE(PG8_SB(1, 1), cB + hsB + kstep, voffB);
    PG8_WAIT_V(6); PG8_BAR;
    for (;;) {
        const bool has_next = S.next(ui + 1, nxt);
        const char* nA = has_next ? (const char*)g.A + (size_t)nxt.pm * tsA + (size_t)nxt.ka * 2 : cA; const char* nB = has_next ? (const char*)g.Bt + (size_t)nxt.pn * tsB + (size_t)nxt.ka * 2 : cB;
        for (int t = 0; t < nt; t += 2) {
            const bool last = (t == nt - 2);
            const char* a1 = cA + (size_t)(t + 1) * kstep;
            const char* a2 = last ? nA : cA + (size_t)(t + 2) * kstep; const char* b2 = last ? nB : cB + (size_t)(t + 2) * kstep;
            const char* a3 = a2 + kstep; const char* b3 = b2 + kstep;
            if (last && has_next) S.a_ready(nxt);
            PG8_LDB(B0, 0, 0); PG8_LDB(B1, 0, 1); PG8_SCHED; PG8_LDA(At, 0, 0); PG8_STAGE(PG8_SA(1, 1), a1 + hsA, voffA);
            PG8_WAIT_V(8); PG8_WAIT_L(0); PG8_BAR; PG8_MMA(0, 0, At, B0); PG8_MMA(0, 1, At, B1); PG8_BAR; PG8_SCHED;
            PG8_LDA(At, 0, 1); PG8_STAGE(PG8_SB(0, 0), b2, voffB); PG8_STAGE(PG8_SB(0, 1), b2 + hsB, voffB); PG8_STAGE(PG8_SA(0, 0), a2, voffA);
            PG8_WAIT_V(8); PG8_WAIT_L(0); PG8_BAR; PG8_MMA(1, 0, At, B0); PG8_MMA(1, 1, At, B1); PG8_BAR; PG8_SCHED;
            PG8_LDB(B0, 1, 0); PG8_LDB(B1, 1, 1); PG8_SCHED; PG8_LDA(At, 1, 0); PG8_STAGE(PG8_SA(0, 1), a2 + hsA, voffA);
            PG8_WAIT_V(8); PG8_WAIT_L(0); PG8_BAR; PG8_MMA(0, 0, At, B0); PG8_MMA(0, 1, At, B1); PG8_BAR; PG8_SCHED;
            PG8_LDA(At, 1, 1); PG8_STAGE(PG8_SB(1, 0), b3, voffB); PG8_STAGE(PG8_SB(1, 1), b3 + hsB, voffB); PG8_STAGE(PG8_SA(1, 0), a3, voffA);
            PG8_WAIT_V(8); PG8_WAIT_L(0); PG8_BAR; PG8_MMA(1, 0, At, B0); PG8_MMA(1, 1, At, B1); PG8_BAR; PG8_SCHED;
        }
        if constexpr (ALIGN_EPI) { if (wr == 0) PG8_BAR; }
        E(acc, cur, wr, wc, fr, fq); S.done(cur);
        if (!has_next) break;
        asm volatile("v_mov_b32 %0, 0" : "=v"(zf));
#pragma unroll
        for (int a = 0; a < 2; ++a)
#pragma unroll
            for (int b = 0; b < 2; ++b)
#pragma unroll
                for (int m = 0; m < 4; ++m)
#pragma unroll
                    for (int n = 0; n < 2; ++n) acc[a][b][m][n] = (f32x4){zf, zf, zf, zf};
        cur = nxt; cA = nA; cB = nB; ++ui;
        if constexpr (ALIGN_EPI) { if (wr == 1) PG8_BAR; }
    }
    PG8_WAIT_V(0);
    if constexpr (!ALIGN_EPI) { if (wr == 0) PG8_BAR; }
    PG8_BAR;
#undef PG8_SA
#undef PG8_SB
#undef PG8_STAGE
#undef PG8_LDA
#undef PG8_LDB
#undef PG8_MMA
#undef PG8_WAIT_V
#undef PG8_WAIT_L
#undef PG8_BAR
#undef PG8_SCHED
}
}

namespace att {
using bf16 = unsigned short;
using bf16x8 = __attribute__((ext_vector_type(8))) short;
using s16x4 = __attribute__((ext_vector_type(4))) short;
using f32x16 = __attribute__((ext_vector_type(16))) float;
using u32x4 = __attribute__((ext_vector_type(4))) unsigned;
constexpr int NW = 8, QBLK = 32, KVBLK = 64;
constexpr float THR = 8.f;
#define SBAR() __builtin_amdgcn_sched_barrier(0)
__device__ __forceinline__ int crow(int r, int hi) { return (r & 3) + 8 * (r >> 2) + 4 * hi; }
__device__ __forceinline__ unsigned cvtpk(float lo, float hi) { unsigned r; asm volatile("v_cvt_pk_bf16_f32 %0, %1, %2" : "=v"(r) : "v"(lo), "v"(hi)); return r; }
template <int DQ> __device__ __forceinline__ int kaddr(int row, int c) {
    if constexpr (DQ == 64) return row * 128 + ((c ^ ((row >> 1) & 7)) << 4); else return row * 208 + c * 16; }
template <int DQ> constexpr int ktile_bytes() { return DQ == 64 ? 64 * 128 : 64 * 208; }
constexpr int VTILE = 64 * 64 * 2;
template <int DQ> constexpr int lds_bytes() { return 2 * ktile_bytes<DQ>() + 2 * VTILE + NW * 64 * 4; }

template <bool FIRST> __device__ __forceinline__ void partialSM(f32x16& p0, f32x16& p1, f32x16& nm16, float& alpha) {
    float pmax = p0[0];
#pragma unroll
    for (int r = 1; r < 16; ++r) pmax = fmaxf(pmax, p0[r]);
#pragma unroll
    for (int r = 0; r < 16; ++r) pmax = fmaxf(pmax, p1[r]);
    { auto rr = __builtin_amdgcn_permlane32_swap(__float_as_uint(pmax), __float_as_uint(pmax), false, false);
      pmax = fmaxf(__uint_as_float(rr[0]), __uint_as_float(rr[1])); }
    alpha = 1.f;
    if (FIRST || !__builtin_expect(__all(pmax <= THR), 1)) {
        const float dl = FIRST ? pmax : fmaxf(pmax, 0.f); if (!FIRST) alpha = __builtin_amdgcn_exp2f(-dl);
#pragma unroll
        for (int r = 0; r < 16; ++r) { nm16[r] -= dl; p0[r] -= dl; p1[r] -= dl; } }
#pragma unroll
    for (int r = 0; r < 16; ++r) p0[r] = __builtin_amdgcn_exp2f(p0[r]);
}
__device__ __forceinline__ void finishSM(f32x16& p0, f32x16& p1, float alpha, float& l_reg, bf16x8& pa0, bf16x8& pa1, bf16x8& pa2, bf16x8& pa3) {
#pragma unroll
    for (int r = 0; r < 16; ++r) p1[r] = __builtin_amdgcn_exp2f(p1[r]);
    float ps = 0;
#pragma unroll
    for (int r = 0; r < 16; ++r) ps += p0[r];
#pragma unroll
    for (int r = 0; r < 16; ++r) ps += p1[r];
    { auto rr = __builtin_amdgcn_permlane32_swap(__float_as_uint(ps), __float_as_uint(ps), false, false);
      ps = __uint_as_float(rr[0]) + __uint_as_float(rr[1]); }
    l_reg = l_reg * alpha + ps;
#define PK4(P, BASE, OUT) do { unsigned a0 = cvtpk(P[BASE + 0], P[BASE + 1]), a1 = cvtpk(P[BASE + 2], P[BASE + 3]);   \
    unsigned b0 = cvtpk(P[BASE + 4], P[BASE + 5]), b1 = cvtpk(P[BASE + 6], P[BASE + 7]);                              \
    auto r0 = __builtin_amdgcn_permlane32_swap(a0, b0, false, false); auto r1 = __builtin_amdgcn_permlane32_swap(a1, b1, false, false); \
    u32x4 w = {r0[0], r1[0], r0[1], r1[1]}; OUT = *reinterpret_cast<bf16x8*>(&w); } while (0)
    PK4(p0, 0, pa0); PK4(p0, 8, pa1); PK4(p1, 0, pa2); PK4(p1, 8, pa3);
#undef PK4
}
template <int DQ> __device__ __forceinline__ void qkt(f32x16& p0, f32x16& p1, const char* Ks, const bf16x8* qr, int r32, int hi, const f32x16& nm16) {
    p0 = nm16; p1 = nm16;
#pragma unroll
    for (int d0 = 0; d0 < DQ / 16; ++d0) { const int c = d0 * 2 + hi;
        const bf16x8 b0 = *reinterpret_cast<const bf16x8*>(Ks + kaddr<DQ>(r32, c));
        const bf16x8 b1 = *reinterpret_cast<const bf16x8*>(Ks + kaddr<DQ>(32 + r32, c));
        p0 = __builtin_amdgcn_mfma_f32_32x32x16_bf16(b0, qr[d0], p0, 0, 0, 0);
        p1 = __builtin_amdgcn_mfma_f32_32x32x16_bf16(b1, qr[d0], p1, 0, 0, 0); }
}
__device__ __forceinline__ int v_st(int k, int c) { const int kk = (k & ~0xC) | ((k & 4) << 1) | ((k & 8) >> 1); return ((kk >> 3) * 2 + (c >> 5)) * 512 + ((kk & 7) * 32 + (c & 31)) * 2; }
__device__ __forceinline__ int v_rd_base(int lane) { return ((lane & 3) << 3) | (((lane >> 2) & 3) << 6) | (((lane >> 4) & 1) << 5) | (((lane >> 5) & 1) << 8); }
constexpr int v_rd_off(int d0, int ks, int half) { return d0 * 512 + ks * 2048 + half * 1024; }
template <int OFF> __device__ __forceinline__ s16x4 tr_read(int vb) { s16x4 r; asm volatile("ds_read_b64_tr_b16 %0, %1 offset:%2" : "=&v"(r) : "v"(vb), "i"(OFF) : "memory"); return r; }
template <int D0> __device__ __forceinline__ void pv_one(f32x16& od, int vb, bf16x8 pa0, bf16x8 pa1, bf16x8 pa2, bf16x8 pa3) {
    const s16x4 l0 = tr_read<v_rd_off(D0, 0, 0)>(vb), h0 = tr_read<v_rd_off(D0, 0, 1)>(vb), l1 = tr_read<v_rd_off(D0, 1, 0)>(vb), h1 = tr_read<v_rd_off(D0, 1, 1)>(vb);
    const s16x4 l2 = tr_read<v_rd_off(D0, 2, 0)>(vb), h2 = tr_read<v_rd_off(D0, 2, 1)>(vb), l3 = tr_read<v_rd_off(D0, 3, 0)>(vb), h3 = tr_read<v_rd_off(D0, 3, 1)>(vb);
    asm volatile("s_waitcnt lgkmcnt(0)" ::: "memory"); SBAR();
#define PK(L, H) (bf16x8){L[0], L[1], L[2], L[3], H[0], H[1], H[2], H[3]}
    od = __builtin_amdgcn_mfma_f32_32x32x16_bf16(pa0, PK(l0, h0), od, 0, 0, 0);
    od = __builtin_amdgcn_mfma_f32_32x32x16_bf16(pa1, PK(l1, h1), od, 0, 0, 0);
    od = __builtin_amdgcn_mfma_f32_32x32x16_bf16(pa2, PK(l2, h2), od, 0, 0, 0);
    od = __builtin_amdgcn_mfma_f32_32x32x16_bf16(pa3, PK(l3, h3), od, 0, 0, 0);
#undef PK
}
struct Args { const bf16* Q; int ldq; const bf16* K0; int ldk0; const bf16* K1; int ldk1; const bf16* V; int ldv; bf16* O; int ldo; int nkeys; int rope_t0; const float* tc; const float* ts; };
template <int DQ>
__device__ __forceinline__ void attn_unit(const Args a, char* lds) {
    constexpr int KT = ktile_bytes<DQ>(), NLD = (DQ == 64) ? 2 : 3;
    const int tid = otid(), wid = tid >> 6, lane = tid & 63, r32 = lane & 31, hi = lane >> 5;
    char* V_lds = lds; char* K_lds = lds + 2 * VTILE;
    float* ws = (float*)(lds + 2 * VTILE + 2 * KT) + wid * 64; float* li_l = ws; float* al_l = ws + 32;
    float l_reg = 0; f32x16 o[2] = {}; f32x16 nm16 = {}; bf16x8 qr[DQ / 16];
    const bf16* Qw = a.Q + (long)(wid * QBLK + r32) * a.ldq + hi * 8;
#pragma unroll
    for (int d0 = 0; d0 < DQ / 16; ++d0) qr[d0] = *reinterpret_cast<const bf16x8*>(Qw + d0 * 16);
    if constexpr (DQ == 96) { if (a.rope_t0 >= 0) {
        const int tq = a.rope_t0 + wid * QBLK + r32, pr = (tq >> 6) & 63, pc = tq & 63;
#pragma unroll
        for (int f = 4; f < 6; ++f) { const int pos = (f == 4) ? pr : pc; u32x4 w = *reinterpret_cast<u32x4*>(&qr[f]); u32x4 o;
#pragma unroll
            for (int e = 0; e < 4; ++e) { const unsigned mine = w[e], oth = (unsigned)__shfl_xor((int)mine, 32);
                const float m0 = __uint_as_float(mine << 16), m1 = __uint_as_float(mine & 0xffff0000u), o0 = __uint_as_float(oth << 16), o1 = __uint_as_float(oth & 0xffff0000u);
                const float c0 = a.tc[pos * 8 + 2 * e], c1 = a.tc[pos * 8 + 2 * e + 1], s0 = a.ts[pos * 8 + 2 * e], s1 = a.ts[pos * 8 + 2 * e + 1];
                const float r0 = (hi == 0) ? m0 * c0 - o0 * s0 : o0 * s0 + m0 * c0, r1 = (hi == 0) ? m1 * c1 - o1 * s1 : o1 * s1 + m1 * c1;
                o[e] = cvtpk(r0, r1); }
            qr[f] = *reinterpret_cast<bf16x8*>(&o); } } }
    const int vrow = tid >> 3, vcol = (tid & 7) * 8, vst = v_st(vrow, vcol);
    const bf16* vsrc = a.V + (long)vrow * a.ldv + vcol; const long vstep = (long)KVBLK * a.ldv;
    int kr0, kc0, kr1 = 0, kc1 = 0;
    if constexpr (DQ == 64) { kr0 = tid >> 3; kc0 = tid & 7; } else { kr0 = tid / 12; kc0 = tid % 12; const int id1 = 512 + (tid & 255); kr1 = id1 / 12; kc1 = id1 % 12; }
    const bf16* ksrc0 = (kc0 < 8) ? a.K0 + (long)kr0 * a.ldk0 + kc0 * 8 : a.K1 + (long)kr0 * a.ldk1 + (kc0 - 8) * 8; const long kstep0 = (long)KVBLK * ((kc0 < 8) ? a.ldk0 : a.ldk1);
    const bf16* ksrc1 = ksrc0; long kstep1 = kstep0;
    if constexpr (DQ == 96) { ksrc1 = (kc1 < 8) ? a.K0 + (long)kr1 * a.ldk0 + kc1 * 8 : a.K1 + (long)kr1 * a.ldk1 + (kc1 - 8) * 8; kstep1 = (long)KVBLK * ((kc1 < 8) ? a.ldk0 : a.ldk1); }
    const int kst0 = kaddr<DQ>(kr0, kc0), kst1 = kaddr<DQ>(kr1, kc1);
    const int vb0 = (int)(uintptr_t)V_lds + v_rd_base(lane);
    struct { bf16x8 vs, ks0, ks1; } sr_[2];
#define SLOAD(i, t) do { sr_[i].vs = *reinterpret_cast<const bf16x8*>(vsrc + (long)(t) * vstep); sr_[i].ks0 = *reinterpret_cast<const bf16x8*>(ksrc0 + (long)(t) * kstep0); \
    if constexpr (DQ == 96) sr_[i].ks1 = *reinterpret_cast<const bf16x8*>(ksrc1 + (long)(t) * kstep1); } while (0)
#define SWRITE(b, i) do { *(bf16x8*)(V_lds + (b) * VTILE + vst) = sr_[i].vs; *(bf16x8*)(K_lds + (b) * KT + kst0) = sr_[i].ks0; \
    if constexpr (DQ == 96) *(bf16x8*)(K_lds + (b) * KT + kst1) = sr_[i].ks1; } while (0)
#define SWAIT() do { if constexpr (NLD == 2) asm volatile("s_waitcnt vmcnt(2)" ::: "memory"); else asm volatile("s_waitcnt vmcnt(3)" ::: "memory"); } while (0)
#define RESC(al) do { if (__any((al) < 1.f)) { if (hi == 0) al_l[r32] = (al); asm volatile("s_waitcnt lgkmcnt(0)" ::: "memory"); \
    _Pragma("unroll") for (int d = 0; d < 2; ++d) _Pragma("unroll") for (int r = 0; r < 16; ++r) o[d][r] *= al_l[crow(r, hi)]; } } while (0)
    f32x16 pA0, pA1, pB0, pB1; float alA, alB; bf16x8 pa0, pa1, pa2, pa3; const int NT = a.nkeys / KVBLK;
    constexpr int SE = 0, SO = 1;
    SLOAD(SE, 0); asm volatile("s_waitcnt vmcnt(0)" ::: "memory"); SWRITE(0, SE); __syncthreads();
    qkt<DQ>(pA0, pA1, K_lds, qr, r32, hi, nm16); partialSM<true>(pA0, pA1, nm16, alA);
    SLOAD(SO, 1); if (2 < NT) SLOAD(SE, 2);
    SWAIT(); SWRITE(1, SO); __syncthreads();
    for (int j = 1; j + 1 < NT; j += 2) {
        SBAR(); qkt<DQ>(pB0, pB1, K_lds + KT, qr, r32, hi, nm16);
        finishSM(pA0, pA1, alA, l_reg, pa0, pa1, pa2, pa3); SBAR();
        SLOAD(SO, j + 2); SBAR();
        pv_one<0>(o[0], vb0, pa0, pa1, pa2, pa3); pv_one<1>(o[1], vb0, pa0, pa1, pa2, pa3); partialSM<false>(pB0, pB1, nm16, alB);
        __syncthreads(); SWAIT(); SWRITE(0, SE);
        RESC(alB); __syncthreads();
        SBAR(); qkt<DQ>(pA0, pA1, K_lds, qr, r32, hi, nm16);
        finishSM(pB0, pB1, alB, l_reg, pa0, pa1, pa2, pa3); SBAR();
        if (j + 3 < NT) SLOAD(SE, j + 3); SBAR();
        pv_one<0>(o[0], vb0 + VTILE, pa0, pa1, pa2, pa3); pv_one<1>(o[1], vb0 + VTILE, pa0, pa1, pa2, pa3); partialSM<false>(pA0, pA1, nm16, alA);
        __syncthreads(); SWAIT(); SWRITE(1, SO);
        RESC(alA); __syncthreads();
    }
    SBAR(); qkt<DQ>(pB0, pB1, K_lds + KT, qr, r32, hi, nm16);
    finishSM(pA0, pA1, alA, l_reg, pa0, pa1, pa2, pa3); SBAR();
    pv_one<0>(o[0], vb0, pa0, pa1, pa2, pa3); pv_one<1>(o[1], vb0, pa0, pa1, pa2, pa3); partialSM<false>(pB0, pB1, nm16, alB);
    __syncthreads(); RESC(alB);
    finishSM(pB0, pB1, alB, l_reg, pa0, pa1, pa2, pa3); SBAR();
    pv_one<0>(o[0], vb0 + VTILE, pa0, pa1, pa2, pa3); pv_one<1>(o[1], vb0 + VTILE, pa0, pa1, pa2, pa3);
    if (hi == 0) li_l[r32] = l_reg; asm volatile("s_waitcnt lgkmcnt(0)" ::: "memory");
    float rli[16];
#pragma unroll
    for (int r = 0; r < 16; ++r) rli[r] = __builtin_amdgcn_rcpf(li_l[crow(r, hi)]);
    __syncthreads();
    { unsigned short* stg = (unsigned short*)(lds) + wid * 2048;
#pragma unroll
      for (int r = 0; r < 16; ++r) { const int orow = crow(r, hi);
#pragma unroll
        for (int d0 = 0; d0 < 2; ++d0) { const float v = o[d0][r] * rli[r]; const unsigned u = __float_as_uint(v); stg[orow * 64 + d0 * 32 + r32] = (unsigned short)((u + 0x7fffu + ((u >> 16) & 1u)) >> 16); } }
      asm volatile("s_waitcnt lgkmcnt(0)" ::: "memory");
      bf16* Ow = a.O + (long)(wid * QBLK) * a.ldo;
#pragma unroll
      for (int i = 0; i < 4; ++i) { const int row = i * 8 + (lane >> 3), ch = lane & 7; const u32x4 v = *(const u32x4*)(stg + row * 64 + ch * 8); *(u32x4*)(Ow + (long)row * a.ldo + ch * 8) = v; } }
    __syncthreads();
#undef SLOAD
#undef SWRITE
#undef SWAIT
#undef RESC
}
#undef SBAR
}

namespace at64 {
using att::bf16; using att::bf16x8; using att::s16x4; using att::f32x16; using att::u32x4;
constexpr int NW = 8, QBLK = 32, KVBLK = 64;
constexpr float C2 = 0.125f * 1.4426950408889634f;
constexpr float THR = 8.f;
constexpr int SLOTB = 8192, LDS_K = 0, LDS_V = 3 * SLOTB, LDS_WS = 6 * SLOTB, LDS_OST = LDS_WS + NW * 256, LDS_TOT = LDS_OST + NW * 4096;
#define A6_SBAR() __builtin_amdgcn_sched_barrier(0)
#define A6_PIN(x) asm volatile("" : "+v"(x))
#define A6_MFMA(a, b, c) __builtin_amdgcn_mfma_f32_32x32x16_bf16(a, b, c, 0, 0, 0)
#define A6_WAIT_BAR(N) asm volatile("s_waitcnt vmcnt(" #N ") lgkmcnt(0)\n\ts_barrier" ::: "memory")
__device__ __forceinline__ int crow(int r, int hi) { return (r & 3) + 8 * (r >> 2) + 4 * hi; }
__device__ __forceinline__ unsigned cvtpk(float lo, float hi) { unsigned r; asm("v_cvt_pk_bf16_f32 %0, %1, %2" : "=v"(r) : "v"(lo), "v"(hi)); return r; }
__device__ __forceinline__ void glds16(const void* g, unsigned lds_base) {
    unsigned sv; asm volatile("s_mov_b32 %0, m0\n\ts_mov_b32 m0, %2\n\ts_nop 0\n\tglobal_load_lds_dwordx4 %1, off\n\ts_mov_b32 m0, %0" : "=&s"(sv) : "v"(g), "s"(lds_base) : "memory"); }
typedef __attribute__((address_space(3))) const char* lds_cptr;
typedef short v4i16_t __attribute__((ext_vector_type(4)));
__device__ __forceinline__ void kload2(bf16x8* kf, lds_cptr kp, int d0) { kf[2 * d0] = *(const __attribute__((address_space(3))) bf16x8*)(kp + d0 * 2048); kf[2 * d0 + 1] = *(const __attribute__((address_space(3))) bf16x8*)(kp + d0 * 2048 + 512); }
__device__ __forceinline__ s16x4 vtr(lds_cptr p) { return __builtin_bit_cast(s16x4, __builtin_amdgcn_ds_read_tr16_b64_v4i16((__attribute__((address_space(3))) v4i16_t*)p)); }
#define A6_MX3(a, b, c) __builtin_fmaxf(__builtin_fmaxf((a), (b)), (c))
__device__ __forceinline__ float rowmax(const f32x16& p0, const f32x16& p1) {
    float a = A6_MX3(p0[0], p0[1], p1[0]), b = A6_MX3(p0[2], p0[3], p1[1]); a = A6_MX3(a, p1[2], p1[3]);
#pragma unroll
    for (int r = 4; r < 16; r += 4) { a = A6_MX3(a, p0[r], p0[r + 1]); b = A6_MX3(b, p0[r + 2], p0[r + 3]); a = A6_MX3(a, p1[r], p1[r + 1]); b = A6_MX3(b, p1[r + 2], p1[r + 3]); }
    float m = __builtin_fmaxf(a, b); auto rr = __builtin_amdgcn_permlane32_swap(__float_as_uint(m), __float_as_uint(m), false, false);
    return __builtin_fmaxf(__uint_as_float(rr[0]), __uint_as_float(rr[1])); }
struct Args { const bf16* Q; int ldq; const bf16* K; int ldk; const bf16* V; int ldv; bf16* O; int ldo; int nkeys; };
__device__ __forceinline__ void unit(const Args a, char* lds) {
    const int tid = otid(), lane = tid & 63, r32 = lane & 31, hi = lane >> 5; const int wid = __builtin_amdgcn_readfirstlane(tid >> 6);
    const int NT = a.nkeys / KVBLK;
    const bf16* Qw = a.Q + (long)(wid * QBLK) * a.ldq;
    const unsigned lds0 = (unsigned)(uintptr_t)lds; float* wsf = (float*)(lds + LDS_WS) + wid * 64;
    const bf16* ksrc = a.K + (long)lane * a.ldk + wid * 8; const long kstep = (long)KVBLK * a.ldk;
    const bf16* vsrc = a.V + (long)(16 * (wid & 3) + (lane >> 2)) * a.ldv + (wid >> 2) * 32 + (lane & 3) * 8; const long vstep = (long)KVBLK * a.ldv;
    const unsigned kdst = lds0 + LDS_K + wid * 1024, vdst = lds0 + LDS_V + wid * 1024;
#define DMA_K(t, slot) glds16(ksrc + (long)(t) * kstep, (unsigned)__builtin_amdgcn_readfirstlane(kdst + (slot)))
#define DMA_V(t, slot) glds16(vsrc + (long)(t) * vstep, (unsigned)__builtin_amdgcn_readfirstlane(vdst + (slot)))
    const lds_cptr vp0 = (lds_cptr)lds + LDS_V + ((lane >> 4) & 1) * 32 + (lane & 3) * 8 + (4 * hi + ((lane & 15) >> 2)) * 64;
    const lds_cptr kp0 = (lds_cptr)lds + LDS_K + hi * 1024 + r32 * 16;
    DMA_K(0, 0); DMA_V(0, 0); DMA_K(1, SLOTB);
    bf16x8 qr[4];
#pragma unroll
    for (int d0 = 0; d0 < 4; ++d0) qr[d0] = *reinterpret_cast<const bf16x8*>(&Qw[(long)r32 * a.ldq + d0 * 16 + hi * 8]);
    float l_reg = 0.f; f32x16 o[2]; o[0] = f32x16{}; o[1] = f32x16{};
    f32x16 nmh16 = f32x16{}; A6_PIN(nmh16);
    bool resc = false;
    f32x16 pA0, pA1, pB0, pB1; bf16x8 kf[8]; s16x4 vlo[8], vhi[8]; u32x4 pw0, pw1, pw2, pw3;
    int sl_prev = 0, sl_cur = 0, sl_next = SLOTB;
#define ROT() do { sl_prev = sl_cur; sl_cur = sl_next; sl_next = (sl_next == 2 * SLOTB) ? 0 : sl_next + SLOTB; } while (0)
#define EX(v) __builtin_amdgcn_exp2f(v)
#define RESC() do { if (resc) { _Pragma("unroll") for (int d_ = 0; d_ < 2; ++d_) _Pragma("unroll") for (int r = 0; r < 16; ++r) o[d_][r] *= wsf[crow(r, hi)]; } } while (0)
    DMA_K(2, 2 * SLOTB);
    A6_WAIT_BAR(3);
    _Pragma("unroll") for (int d0 = 0; d0 < 4; ++d0) kload2(kf, kp0, d0);
    pA0 = A6_MFMA(kf[0], qr[0], nmh16); pA1 = A6_MFMA(kf[1], qr[0], nmh16); pA0 = A6_MFMA(kf[2], qr[1], pA0); pA1 = A6_MFMA(kf[3], qr[1], pA1);
    pA0 = A6_MFMA(kf[4], qr[2], pA0); pA1 = A6_MFMA(kf[5], qr[2], pA1); pA0 = A6_MFMA(kf[6], qr[3], pA0); pA1 = A6_MFMA(kf[7], qr[3], pA1);
    { const float rm = rowmax(pA0, pA1);
#pragma unroll
      for (int r = 0; r < 16; ++r) { nmh16[r] = -rm; pA0[r] = EX(pA0[r] - rm); pA1[r] = EX(pA1[r] - rm); } }
    A6_WAIT_BAR(0);
    DMA_K(3, 0); DMA_V(1, SLOTB); ROT();
    _Pragma("unroll") for (int d0 = 0; d0 < 4; ++d0) kload2(kf, kp0 + sl_cur, d0);
    A6_WAIT_BAR(2);
#define PKW(P, i) cvtpk(P[i], P[i + 1])
#define PAF(k) __builtin_bit_cast(bf16x8, pw##k)
#define VFR(i) (bf16x8){vlo[i][0], vlo[i][1], vlo[i][2], vlo[i][3], vhi[i][0], vhi[i][1], vhi[i][2], vhi[i][3]}
#define VRD(i) do { vlo[i] = vtr(vp_ + (((i) >> 2) * 4096 + ((i) & 3) * 1024)); vhi[i] = vtr(vp_ + (((i) >> 2) * 4096 + ((i) & 3) * 1024 + 512)); } while (0)
#define KRD(G, d0) do { if (G) { kload2(kf, kp0 + sl_next, d0); A6_SBAR(); } } while (0)
#define GAPA(MF, a0, a1, a2, a3, W0, W1, PW) do { MF; sacc += a0; sacc += a1; sacc += a2; sacc += a3; W0; W1; A6_PIN(PW); A6_PIN(sacc); A6_SBAR(); } while (0)
#define GAPB(MF, X, i) do { MF; X[i] = EX(X[i]); X[i + 1] = EX(X[i + 1]); X[i + 2] = EX(X[i + 2]); X[i + 3] = EX(X[i + 3]); A6_PIN(X); A6_SBAR(); } while (0)
#define STEP(C0, C1, P0, P1, t, GK, GV, GL) do { A6_SBAR(); \
    const lds_cptr vp_ = vp0 + sl_prev; \
    VRD(0); A6_SBAR(); float sacc = P0[0] + P0[1]; \
                       GAPA(C0 = A6_MFMA(kf[0], qr[0], nmh16), P0[2], P0[3], P0[4], P0[5],     pw0[0] = PKW(P0, 0),  pw0[1] = PKW(P0, 2),  pw0); \
    VRD(4); A6_SBAR(); GAPA(C1 = A6_MFMA(kf[1], qr[0], nmh16), P0[6], P0[7], P0[8], P0[9],     pw0[2] = PKW(P0, 4),  pw0[3] = PKW(P0, 6),  pw0); \
    VRD(1); A6_SBAR(); GAPA(C0 = A6_MFMA(kf[2], qr[1], C0),    P0[10], P0[11], P0[12], P0[13], pw1[0] = PKW(P0, 8),  pw1[1] = PKW(P0, 10), pw1); \
    VRD(5); A6_SBAR(); GAPA(C1 = A6_MFMA(kf[3], qr[1], C1),    P0[14], P0[15], P1[0], P1[1],   pw1[2] = PKW(P0, 12), pw1[3] = PKW(P0, 14), pw1); \
    VRD(2); A6_SBAR(); GAPA(C0 = A6_MFMA(kf[4], qr[2], C0),    P1[2], P1[3], P1[4], P1[5],     pw2[0] = PKW(P1, 0),  pw2[1] = PKW(P1, 2),  pw2); \
    VRD(6); A6_SBAR(); GAPA(C1 = A6_MFMA(kf[5], qr[2], C1),    P1[6], P1[7], P1[8], P1[9],     pw2[2] = PKW(P1, 4),  pw2[3] = PKW(P1, 6),  pw2); \
    VRD(3); A6_SBAR(); GAPA(C0 = A6_MFMA(kf[6], qr[3], C0),    P1[10], P1[11], P1[12], P1[13], pw3[0] = PKW(P1, 8),  pw3[1] = PKW(P1, 10), pw3); \
    VRD(7); A6_SBAR(); GAPA(C1 = A6_MFMA(kf[7], qr[3], C1),    P1[14], P1[15], 0.f, 0.f,       pw3[2] = PKW(P1, 12), pw3[3] = PKW(P1, 14), pw3); \
    l_reg += sacc; \
    if (GK) DMA_K((t) + 3, sl_cur); if (GV) DMA_V((t) + 1, sl_next); \
    { const float rm = rowmax(C0, C1); resc = false; \
      if (__builtin_expect(__any(rm > THR), 0)) { const float dl = __builtin_fmaxf(rm, 0.f); \
          _Pragma("unroll") for (int r_ = 0; r_ < 16; ++r_) { nmh16[r_] -= dl; C0[r_] -= dl; C1[r_] -= dl; } \
          const float f = __builtin_amdgcn_exp2f(-dl); l_reg *= f; if (hi == 0) wsf[r32] = f; resc = true; } } \
    A6_SBAR(); \
    GAPB(o[0] = A6_MFMA(PAF(0), VFR(0), o[0]), C0, 0);              GAPB(o[1] = A6_MFMA(PAF(0), VFR(4), o[1]), C0, 4); \
    KRD(GL, 0); GAPB(o[0] = A6_MFMA(PAF(1), VFR(1), o[0]), C0, 8);  KRD(GL, 1); GAPB(o[1] = A6_MFMA(PAF(1), VFR(5), o[1]), C0, 12); \
    KRD(GL, 2); GAPB(o[0] = A6_MFMA(PAF(2), VFR(2), o[0]), C1, 0);  KRD(GL, 3); GAPB(o[1] = A6_MFMA(PAF(2), VFR(6), o[1]), C1, 4); \
    GAPB(o[0] = A6_MFMA(PAF(3), VFR(3), o[0]), C1, 8);              GAPB(o[1] = A6_MFMA(PAF(3), VFR(7), o[1]), C1, 12); \
    } while (0)
    int t = 1;
    for (; t + 5 < NT; t += 2) {
        STEP(pB0, pB1, pA0, pA1, t, true, true, true);     A6_WAIT_BAR(2); RESC(); ROT();
        STEP(pA0, pA1, pB0, pB1, t + 1, true, true, true); A6_WAIT_BAR(2); RESC(); ROT();
    }
#define ENDW(tt) do { if ((tt) + 3 < NT) { A6_WAIT_BAR(2); } else if ((tt) + 2 < NT) { A6_WAIT_BAR(1); } else { A6_WAIT_BAR(0); } } while (0)
    for (; t + 1 < NT; t += 2) {
        STEP(pB0, pB1, pA0, pA1, t, (t + 3 < NT), (t + 1 < NT), (t + 1 < NT));         ENDW(t);     RESC(); ROT();
        STEP(pA0, pA1, pB0, pB1, t + 1, (t + 4 < NT), (t + 2 < NT), (t + 2 < NT));     ENDW(t + 1); RESC(); ROT();
    }
    STEP(pB0, pB1, pA0, pA1, NT - 1, false, false, false); RESC();
    { float sacc = pB0[0] + pB0[1];
#pragma unroll
      for (int r = 2; r < 16; ++r) sacc += pB0[r];
#pragma unroll
      for (int r = 0; r < 16; ++r) sacc += pB1[r];
      l_reg += sacc;
      pw0 = (u32x4){PKW(pB0, 0), PKW(pB0, 2), PKW(pB0, 4), PKW(pB0, 6)}; pw1 = (u32x4){PKW(pB0, 8), PKW(pB0, 10), PKW(pB0, 12), PKW(pB0, 14)};
      pw2 = (u32x4){PKW(pB1, 0), PKW(pB1, 2), PKW(pB1, 4), PKW(pB1, 6)}; pw3 = (u32x4){PKW(pB1, 8), PKW(pB1, 10), PKW(pB1, 12), PKW(pB1, 14)};
      const lds_cptr vp_ = vp0 + sl_cur; _Pragma("unroll") for (int i = 0; i < 8; ++i) VRD(i);
      o[0] = A6_MFMA(PAF(0), VFR(0), o[0]); o[1] = A6_MFMA(PAF(0), VFR(4), o[1]); o[0] = A6_MFMA(PAF(1), VFR(1), o[0]); o[1] = A6_MFMA(PAF(1), VFR(5), o[1]);
      o[0] = A6_MFMA(PAF(2), VFR(2), o[0]); o[1] = A6_MFMA(PAF(2), VFR(6), o[1]); o[0] = A6_MFMA(PAF(3), VFR(3), o[0]); o[1] = A6_MFMA(PAF(3), VFR(7), o[1]); }
    { auto rr = __builtin_amdgcn_permlane32_swap(__float_as_uint(l_reg), __float_as_uint(l_reg), false, false); l_reg = __uint_as_float(rr[0]) + __uint_as_float(rr[1]); }
    if (hi == 0) wsf[32 + r32] = l_reg; asm volatile("s_waitcnt lgkmcnt(0)" ::: "memory");
    float rli[16];
#pragma unroll
    for (int r = 0; r < 16; ++r) rli[r] = __builtin_amdgcn_rcpf(wsf[32 + crow(r, hi)]);
    bf16* Ow = a.O + (long)(wid * QBLK) * a.ldo; unsigned short* stg = (unsigned short*)(lds + LDS_OST) + wid * 2048;
#pragma unroll
    for (int r = 0; r < 16; ++r) { const int orow = crow(r, hi);
#pragma unroll
        for (int d0 = 0; d0 < 2; ++d0) { const float v = o[d0][r] * rli[r]; const unsigned u = __float_as_uint(v); stg[orow * 64 + d0 * 32 + r32] = (unsigned short)((u + 0x7fffu + ((u >> 16) & 1u)) >> 16); } }
    asm volatile("s_waitcnt lgkmcnt(0)" ::: "memory");
#pragma unroll
    for (int i = 0; i < 4; ++i) { const int row = i * 8 + (lane >> 3), ch = lane & 7; *(u32x4*)(Ow + (long)row * a.ldo + ch * 8) = *(const u32x4*)(stg + row * 64 + ch * 8); }
    asm volatile("s_waitcnt lgkmcnt(0)\n\ts_barrier" ::: "memory");
#undef DMA_K
#undef DMA_V
#undef ROT
#undef EX
#undef RESC
#undef PKW
#undef PAF
#undef VFR
#undef VRD
#undef KRD
#undef ENDW
#undef GAPA
#undef GAPB
#undef STEP
}
#undef A6_SBAR
#undef A6_PIN
#undef A6_MFMA
#undef A6_WAIT_BAR
#undef A6_MX3
}

namespace at96 {
using att::bf16; using att::bf16x8; using att::s16x4; using att::f32x16; using att::u32x4;
using at64::crow; using at64::cvtpk; using at64::glds16; using at64::lds_cptr; using at64::kload2; using at64::vtr; using at64::rowmax;
constexpr int NW = 8, QBLK = 32, KVBLK = 64;
constexpr float THR = 8.f;
constexpr int SLOTB = 8192, SLOTR = 4096, LDS_K = 0, LDS_V = 3 * SLOTB, LDS_R = 6 * SLOTB, LDS_WS = LDS_R + 4 * SLOTR, LDS_OST = LDS_WS + NW * 256, LDS_TOT = LDS_OST + NW * 4096;
#define A9_SBAR() __builtin_amdgcn_sched_barrier(0)
#define A9_PIN(x) asm volatile("" : "+v"(x))
#define A9_MFMA(a, b, c) __builtin_amdgcn_mfma_f32_32x32x16_bf16(a, b, c, 0, 0, 0)
#define A9_WAIT_BAR(N) asm volatile("s_waitcnt vmcnt(" #N ") lgkmcnt(0)\n\ts_barrier" ::: "memory")
struct Args { const bf16* Q; int ldq; const bf16* K0; int ldk0; const bf16* K1; int ldk1; const bf16* V; int ldv; bf16* O; int ldo; int nkeys; int rope_t0; const float* tc; const float* ts; };
__device__ __forceinline__ void unit(const Args a, char* lds) {
    const int tid = otid(), lane = tid & 63, r32 = lane & 31, hi = lane >> 5; const int wid = __builtin_amdgcn_readfirstlane(tid >> 6);
    const int NT = a.nkeys / KVBLK;
    const bf16* Qw = a.Q + (long)(wid * QBLK) * a.ldq;
    const unsigned lds0 = (unsigned)(uintptr_t)lds; float* wsf = (float*)(lds + LDS_WS) + wid * 64;
    const bf16* ksrc = a.K0 + (long)lane * a.ldk0 + wid * 8; const long kstep = (long)KVBLK * a.ldk0;
    const bf16* rsrc = a.K1 + (long)(32 * (wid & 1) + r32) * a.ldk1 + (wid >> 1) * 8; const long rstep = (long)KVBLK * a.ldk1;
    const bf16* vsrc = a.V + (long)(16 * (wid & 3) + (lane >> 2)) * a.ldv + (wid >> 2) * 32 + (lane & 3) * 8; const long vstep = (long)KVBLK * a.ldv;
    const unsigned kdst = lds0 + LDS_K + wid * 1024, vdst = lds0 + LDS_V + wid * 1024, rdst = lds0 + LDS_R + (wid >> 1) * 1024 + (wid & 1) * 512;
#define DMA_K(t, slot, rslot) do { glds16(ksrc + (long)(t) * kstep, (unsigned)__builtin_amdgcn_readfirstlane(kdst + (slot))); \
        if (lane < 32) glds16(rsrc + (long)(t) * rstep, (unsigned)__builtin_amdgcn_readfirstlane(rdst + (rslot))); } while (0)
#define DMA_V(t, slot) glds16(vsrc + (long)(t) * vstep, (unsigned)__builtin_amdgcn_readfirstlane(vdst + (slot)))
    const lds_cptr vp0 = (lds_cptr)lds + LDS_V + ((lane >> 4) & 1) * 32 + (lane & 3) * 8 + (4 * hi + ((lane & 15) >> 2)) * 64;
    const lds_cptr kp0 = (lds_cptr)lds + LDS_K + hi * 1024 + r32 * 16;
    const lds_cptr rp0 = (lds_cptr)lds + LDS_R + hi * 1024 + r32 * 16;
    DMA_K(0, 0, 0); DMA_V(0, 0); DMA_K(1, SLOTB, SLOTR);
    bf16x8 qr[6];
#pragma unroll
    for (int d0 = 0; d0 < 6; ++d0) qr[d0] = *reinterpret_cast<const bf16x8*>(&Qw[(long)r32 * a.ldq + d0 * 16 + hi * 8]);
    if (a.rope_t0 >= 0) {
        const int tq = a.rope_t0 + wid * QBLK + r32, pr = (tq >> 6) & 63, pc = tq & 63;
#pragma unroll
        for (int f = 4; f < 6; ++f) { const int pos = (f == 4) ? pr : pc; u32x4 w = *reinterpret_cast<u32x4*>(&qr[f]); u32x4 o_;
#pragma unroll
            for (int e = 0; e < 4; ++e) { const unsigned mine = w[e], oth = (unsigned)__shfl_xor((int)mine, 32);
                const float m0 = __uint_as_float(mine << 16), m1 = __uint_as_float(mine & 0xffff0000u), o0 = __uint_as_float(oth << 16), o1 = __uint_as_float(oth & 0xffff0000u);
                const float c0 = a.tc[pos * 8 + 2 * e], c1 = a.tc[pos * 8 + 2 * e + 1], s0 = a.ts[pos * 8 + 2 * e], s1 = a.ts[pos * 8 + 2 * e + 1];
                const float r0 = (hi == 0) ? m0 * c0 - o0 * s0 : o0 * s0 + m0 * c0, r1 = (hi == 0) ? m1 * c1 - o1 * s1 : o1 * s1 + m1 * c1;
                o_[e] = cvtpk(r0, r1); }
            qr[f] = *reinterpret_cast<bf16x8*>(&o_); } }
    float l_reg = 0.f; f32x16 o[2]; o[0] = f32x16{}; o[1] = f32x16{};
    f32x16 nmh16 = f32x16{}; A9_PIN(nmh16);
    bool resc = false;
    f32x16 pA0, pA1, pB0, pB1; bf16x8 kf[8], kr[4]; s16x4 vlo[8], vhi[8]; u32x4 pw0, pw1, pw2, pw3;
    int sl_prev = 0, sl_cur = 0, sl_next = SLOTB, rs_cur = 0;
#define ROT() do { sl_prev = sl_cur; sl_cur = sl_next; sl_next = (sl_next == 2 * SLOTB) ? 0 : sl_next + SLOTB; rs_cur = (rs_cur + SLOTR) & (4 * SLOTR - 1); } while (0)
#define RS3() ((rs_cur + 3 * SLOTR) & (4 * SLOTR - 1))
#define EX(v) __builtin_amdgcn_exp2f(v)
#define RESC() do { if (resc) { _Pragma("unroll") for (int d_ = 0; d_ < 2; ++d_) _Pragma("unroll") for (int r = 0; r < 16; ++r) o[d_][r] *= wsf[crow(r, hi)]; } } while (0)
    DMA_K(2, 2 * SLOTB, 2 * SLOTR);
    A9_WAIT_BAR(5);
    _Pragma("unroll") for (int d0 = 0; d0 < 4; ++d0) kload2(kf, kp0, d0);
    kload2(kr, rp0, 0); kload2(kr, rp0, 1);
    pA0 = A9_MFMA(kf[0], qr[0], nmh16); pA1 = A9_MFMA(kf[1], qr[0], nmh16); pA0 = A9_MFMA(kf[2], qr[1], pA0); pA1 = A9_MFMA(kf[3], qr[1], pA1);
    pA0 = A9_MFMA(kf[4], qr[2], pA0); pA1 = A9_MFMA(kf[5], qr[2], pA1); pA0 = A9_MFMA(kf[6], qr[3], pA0); pA1 = A9_MFMA(kf[7], qr[3], pA1);
    pA0 = A9_MFMA(kr[0], qr[4], pA0); pA1 = A9_MFMA(kr[1], qr[4], pA1); pA0 = A9_MFMA(kr[2], qr[5], pA0); pA1 = A9_MFMA(kr[3], qr[5], pA1);
    { const float rm = rowmax(pA0, pA1);
#pragma unroll
      for (int r = 0; r < 16; ++r) { nmh16[r] = -rm; pA0[r] = EX(pA0[r] - rm); pA1[r] = EX(pA1[r] - rm); } }
    A9_WAIT_BAR(0);
    DMA_K(3, 0, 3 * SLOTR); DMA_V(1, SLOTB); ROT();
    _Pragma("unroll") for (int d0 = 0; d0 < 4; ++d0) kload2(kf, kp0 + sl_cur, d0);
    A9_WAIT_BAR(3);
#define PKW(P, i) cvtpk(P[i], P[i + 1])
#define PAF(k) __builtin_bit_cast(bf16x8, pw##k)
#define VFR(i) (bf16x8){vlo[i][0], vlo[i][1], vlo[i][2], vlo[i][3], vhi[i][0], vhi[i][1], vhi[i][2], vhi[i][3]}
#define VRD(i) do { vlo[i] = vtr(vp_ + (((i) >> 2) * 4096 + ((i) & 3) * 1024)); vhi[i] = vtr(vp_ + (((i) >> 2) * 4096 + ((i) & 3) * 1024 + 512)); } while (0)
#define KRD(G, d0) do { if (G) { kload2(kf, kp0 + sl_next, d0); A9_SBAR(); } } while (0)
#define GAP3(MF, a0, a1, a2, W0, PW) do { MF; sacc += a0; sacc += a1; sacc += a2; W0; A9_PIN(PW); A9_PIN(sacc); A9_SBAR(); } while (0)
#define GAP2(MF, a0, a1, W0, W1, PW) do { MF; sacc += a0; sacc += a1; W0; W1; A9_PIN(PW); A9_PIN(sacc); A9_SBAR(); } while (0)
#define GAPB(MF, X, i) do { MF; X[i] = EX(X[i]); X[i + 1] = EX(X[i + 1]); X[i + 2] = EX(X[i + 2]); X[i + 3] = EX(X[i + 3]); A9_PIN(X); A9_SBAR(); } while (0)
#define STEP(C0, C1, P0, P1, t, GK, GV, GL) do { A9_SBAR(); \
    const lds_cptr vp_ = vp0 + sl_prev; const lds_cptr rp_ = rp0 + rs_cur; \
    VRD(0); kload2(kr, rp_, 0); A9_SBAR(); float sacc = P0[0] + P0[1]; \
                       GAP3(C0 = A9_MFMA(kf[0], qr[0], nmh16), P0[2], P0[3], P0[4],    pw0[0] = PKW(P0, 0), pw0); \
    VRD(4); kload2(kr, rp_, 1); A9_SBAR(); \
                       GAP3(C1 = A9_MFMA(kf[1], qr[0], nmh16), P0[5], P0[6], P0[7],    pw0[1] = PKW(P0, 2), pw0); \
    VRD(1); A9_SBAR(); GAP2(C0 = A9_MFMA(kf[2], qr[1], C0),    P0[8], P0[9],           pw0[2] = PKW(P0, 4), pw0[3] = PKW(P0, 6), pw0); \
    VRD(5); A9_SBAR(); GAP3(C1 = A9_MFMA(kf[3], qr[1], C1),    P0[10], P0[11], P0[12], pw1[0] = PKW(P0, 8), pw1); \
    VRD(2); A9_SBAR(); GAP3(C0 = A9_MFMA(kf[4], qr[2], C0),    P0[13], P0[14], P0[15], pw1[1] = PKW(P0, 10), pw1); \
    VRD(6); A9_SBAR(); GAP2(C1 = A9_MFMA(kf[5], qr[2], C1),    P1[0], P1[1],           pw1[2] = PKW(P0, 12), pw1[3] = PKW(P0, 14), pw1); \
    VRD(3); A9_SBAR(); GAP3(C0 = A9_MFMA(kf[6], qr[3], C0),    P1[2], P1[3], P1[4],    pw2[0] = PKW(P1, 0), pw2); \
    VRD(7); A9_SBAR(); GAP3(C1 = A9_MFMA(kf[7], qr[3], C1),    P1[5], P1[6], P1[7],    pw2[1] = PKW(P1, 2), pw2); \
                       GAP2(C0 = A9_MFMA(kr[0], qr[4], C0),    P1[8], P1[9],           pw2[2] = PKW(P1, 4), pw2[3] = PKW(P1, 6), pw2); \
                       GAP3(C1 = A9_MFMA(kr[1], qr[4], C1),    P1[10], P1[11], P1[12], pw3[0] = PKW(P1, 8), pw3); \
                       GAP3(C0 = A9_MFMA(kr[2], qr[5], C0),    P1[13], P1[14], P1[15], pw3[1] = PKW(P1, 10), pw3); \
                       GAP2(C1 = A9_MFMA(kr[3], qr[5], C1),    0.f, 0.f,               pw3[2] = PKW(P1, 12), pw3[3] = PKW(P1, 14), pw3); \
    l_reg += sacc; \
    if (GK) DMA_K((t) + 3, sl_cur, RS3()); if (GV) DMA_V((t) + 1, sl_next); \
    { const float rm = rowmax(C0, C1); resc = false; \
      if (__builtin_expect(__any(rm > THR), 0)) { const float dl = __builtin_fmaxf(rm, 0.f); \
          _Pragma("unroll") for (int r_ = 0; r_ < 16; ++r_) { nmh16[r_] -= dl; C0[r_] -= dl; C1[r_] -= dl; } \
          const float f = __builtin_amdgcn_exp2f(-dl); l_reg *= f; if (hi == 0) wsf[r32] = f; resc = true; } } \
    A9_SBAR(); \
    GAPB(o[0] = A9_MFMA(PAF(0), VFR(0), o[0]), C0, 0);              GAPB(o[1] = A9_MFMA(PAF(0), VFR(4), o[1]), C0, 4); \
    KRD(GL, 0); GAPB(o[0] = A9_MFMA(PAF(1), VFR(1), o[0]), C0, 8);  KRD(GL, 1); GAPB(o[1] = A9_MFMA(PAF(1), VFR(5), o[1]), C0, 12); \
    KRD(GL, 2); GAPB(o[0] = A9_MFMA(PAF(2), VFR(2), o[0]), C1, 0);  KRD(GL, 3); GAPB(o[1] = A9_MFMA(PAF(2), VFR(6), o[1]), C1, 4); \
    GAPB(o[0] = A9_MFMA(PAF(3), VFR(3), o[0]), C1, 8);              GAPB(o[1] = A9_MFMA(PAF(3), VFR(7), o[1]), C1, 12); \
    } while (0)
    int t = 1;
    for (; t + 5 < NT; t += 2) {
        STEP(pB0, pB1, pA0, pA1, t, true, true, true);     A9_WAIT_BAR(3); RESC(); ROT();
        STEP(pA0, pA1, pB0, pB1, t + 1, true, true, true); A9_WAIT_BAR(3); RESC(); ROT();
    }
#define ENDW(tt) do { if ((tt) + 3 < NT) { A9_WAIT_BAR(3); } else if ((tt) + 2 < NT) { A9_WAIT_BAR(1); } else { A9_WAIT_BAR(0); } } while (0)
    for (; t + 1 < NT; t += 2) {
        STEP(pB0, pB1, pA0, pA1, t, (t + 3 < NT), (t + 1 < NT), (t + 1 < NT));         ENDW(t);     RESC(); ROT();
        STEP(pA0, pA1, pB0, pB1, t + 1, (t + 4 < NT), (t + 2 < NT), (t + 2 < NT));     ENDW(t + 1); RESC(); ROT();
    }
    STEP(pB0, pB1, pA0, pA1, NT - 1, false, false, false); RESC();
    { float sacc = pB0[0] + pB0[1];
#pragma unroll
      for (int r = 2; r < 16; ++r) sacc += pB0[r];
#pragma unroll
      for (int r = 0; r < 16; ++r) sacc += pB1[r];
      l_reg += sacc;
      pw0 = (u32x4){PKW(pB0, 0), PKW(pB0, 2), PKW(pB0, 4), PKW(pB0, 6)}; pw1 = (u32x4){PKW(pB0, 8), PKW(pB0, 10), PKW(pB0, 12), PKW(pB0, 14)};
      pw2 = (u32x4){PKW(pB1, 0), PKW(pB1, 2), PKW(pB1, 4), PKW(pB1, 6)}; pw3 = (u32x4){PKW(pB1, 8), PKW(pB1, 10), PKW(pB1, 12), PKW(pB1, 14)};
      const lds_cptr vp_ = vp0 + sl_cur; _Pragma("unroll") for (int i = 0; i < 8; ++i) VRD(i);
      o[0] = A9_MFMA(PAF(0), VFR(0), o[0]); o[1] = A9_MFMA(PAF(0), VFR(4), o[1]); o[0] = A9_MFMA(PAF(1), VFR(1), o[0]); o[1] = A9_MFMA(PAF(1), VFR(5), o[1]);
      o[0] = A9_MFMA(PAF(2), VFR(2), o[0]); o[1] = A9_MFMA(PAF(2), VFR(6), o[1]); o[0] = A9_MFMA(PAF(3), VFR(3), o[0]); o[1] = A9_MFMA(PAF(3), VFR(7), o[1]); }
    { auto rr = __builtin_amdgcn_permlane32_swap(__float_as_uint(l_reg), __float_as_uint(l_reg), false, false); l_reg = __uint_as_float(rr[0]) + __uint_as_float(rr[1]); }
    if (hi == 0) wsf[32 + r32] = l_reg; asm volatile("s_waitcnt lgkmcnt(0)" ::: "memory");
    float rli[16];
#pragma unroll
    for (int r = 0; r < 16; ++r) rli[r] = __builtin_amdgcn_rcpf(wsf[32 + crow(r, hi)]);
    bf16* Ow = a.O + (long)(wid * QBLK) * a.ldo; unsigned short* stg = (unsigned short*)(lds + LDS_OST) + wid * 2048;
#pragma unroll
    for (int r = 0; r < 16; ++r) { const int orow = crow(r, hi);
#pragma unroll
        for (int d0 = 0; d0 < 2; ++d0) { const float v = o[d0][r] * rli[r]; const unsigned u = __float_as_uint(v); stg[orow * 64 + d0 * 32 + r32] = (unsigned short)((u + 0x7fffu + ((u >> 16) & 1u)) >> 16); } }
    asm volatile("s_waitcnt lgkmcnt(0)" ::: "memory");
#pragma unroll
    for (int i = 0; i < 4; ++i) { const int row = i * 8 + (lane >> 3), ch = lane & 7; *(u32x4*)(Ow + (long)row * a.ldo + ch * 8) = *(const u32x4*)(stg + row * 64 + ch * 8); }
    asm volatile("s_waitcnt lgkmcnt(0)\n\ts_barrier" ::: "memory");
#undef DMA_K
#undef DMA_V
#undef ROT
#undef RS3
#undef EX
#undef RESC
#undef PKW
#undef PAF
#undef VFR
#undef VRD
#undef KRD
#undef ENDW
#undef GAP3
#undef GAP2
#undef GAPB
#undef STEP
}
#undef A9_SBAR
#undef A9_PIN
#undef A9_MFMA
#undef A9_WAIT_BAR
}

constexpr size_t MiB = 1u << 20;
constexpr size_t WS_CTL = 0, CTL_BYTES = 1 * MiB;
constexpr size_t WS_MOD = 1 * MiB;
constexpr size_t WS_T16C = WS_MOD + 256 * 1024, WS_T16S = WS_T16C + 4096, WS_T8C = WS_T16S + 4096, WS_T8S = WS_T8C + 2048;
constexpr size_t WS_RSQ = WS_MOD + 320 * 1024, WS_RSKV = WS_RSQ + 64 * 1024;
constexpr size_t WS_TAB = WS_MOD + 512 * 1024;
constexpr size_t WS_WT = 3 * MiB;
constexpr size_t WT_IN = 0, WT_G = WT_IN + (size_t)PPW * DM * 2, WT_QU = WT_G + (size_t)NGATE * DM * 2, WT_KVU = WT_QU + (size_t)768 * 384 * 2, WT_BR = WT_KVU + (size_t)1024 * 256 * 2,
                 WT_OUT = WT_BR + (size_t)3 * DM * 512 * 2, WT_F1 = WT_OUT + (size_t)DM * DM * 2, WT_F2 = WT_F1 + (size_t)DFF * DM * 2, WT_END = WT_F2 + (size_t)DM * DFF * 2;
static_assert(WT_END <= 36 * MiB, "weights");
constexpr size_t WS_CTXX = WS_WT + 36 * MiB;
constexpr size_t WS_XN = WS_CTXX + 4 * MiB;
constexpr size_t WS_HALF = WS_XN + 34 * MiB;
constexpr int NUNIT = 32 * (RPB / 32);
constexpr size_t H_PP = 0, H_QM = H_PP + (size_t)HM * PPW * 2, H_KVM = H_QM + (size_t)HM * 768 * 2, H_MO = H_KVM + (size_t)HM * 1024 * 2, H_PHI = H_MO + (size_t)HM * 512 * 2,
                 H_PSI = H_PHI + (size_t)NUNIT * 8192, H_GC = H_PSI + (size_t)NUNIT * 8192, H_END = H_GC + (size_t)NUNIT * 256;
constexpr size_t WS_END = WS_HALF + H_END;
static_assert(WS_END + 12 * MiB <= 256 * MiB, "workspace (the 12 MiB after WS_END hold transient scratch: pass-3 parking / split-K slabs)");
constexpr size_t WS_GB = WS_HALF + H_PHI, WS_MIX = WS_GB + (size_t)HM * 3 * DM * 2;
constexpr size_t WS_HID = WS_HALF;
static_assert(WS_MIX + (size_t)HM * DM * 2 <= WS_HALF + H_GC && WS_HID + (size_t)MROWS * DFF * 2 <= WS_END, "overlays");
constexpr int CW_BAR = 4096, CW_ATT = 16384;

#define GAS __attribute__((address_space(1)))
#define LAS __attribute__((address_space(3)))
typedef unsigned short bf16;
typedef unsigned v4u __attribute__((ext_vector_type(4)));
typedef float f32x4 __attribute__((ext_vector_type(4)));
typedef float f32x8 __attribute__((ext_vector_type(8)));
#define LDS_WAIT() asm volatile("s_waitcnt lgkmcnt(0)" ::: "memory")
__device__ __forceinline__ unsigned f2bf(float f) { unsigned u = __builtin_bit_cast(unsigned, f); return (u + 0x7fffu + ((u >> 16) & 1u)) >> 16; }
__device__ __forceinline__ unsigned pk2(float lo, float hi) { return f2bf(lo) | (f2bf(hi) << 16); }
__device__ __forceinline__ float bf2f(unsigned short h) { return __uint_as_float((unsigned)h << 16); }

#define XB_TMO      128
#define XB_XCNT(j)  (256  + 64 * (j))
#define XB_XSUB(j)  (1280 + 64 * (j))
#define XB_XGEN(j)  (2304 + 64 * (j))
#define XB_TOP      3328
#define XB_TOPGEN   3392
#define XCD_BAR_WORDS 3456
#define XB_SPIN_CAP (1u << 22)
__device__ __forceinline__ unsigned xb_ld(unsigned* p)              { return __hip_atomic_load(p, __ATOMIC_RELAXED, __HIP_MEMORY_SCOPE_AGENT); }
__device__ __forceinline__ unsigned xb_add(unsigned* p, unsigned v) { return __hip_atomic_fetch_add(p, v, __ATOMIC_RELAXED, __HIP_MEMORY_SCOPE_AGENT); }
__device__ __forceinline__ unsigned xb_xcc_id() { return (unsigned)__builtin_amdgcn_s_getreg((3 << 11) | 20) & 0xFu; }
#define XB_SPIN(cond, bar) do { unsigned _sp = 0; while (cond) { __builtin_amdgcn_s_sleep(1); \
    if ((++_sp & 255u) == 0u) { if (xb_ld(&(bar)[XB_TMO])) break; if (_sp > XB_SPIN_CAP) { atomicAdd(&(bar)[XB_TMO], 1u); break; } } } } while (0)
struct XcdBarrier { unsigned* bar; unsigned x; volatile LAS unsigned* st; };
__device__ __forceinline__ XcdBarrier xcd_barrier_post(unsigned* bar, volatile LAS unsigned* st) {
    XcdBarrier b; b.bar = bar; b.x = xb_xcc_id(); b.st = st;
    if (threadIdx.x == 0) (void)xb_add(&bar[XB_XCNT(b.x)], 1u);
    return b;
}
__device__ __forceinline__ void xcd_barrier_complete(unsigned* bar, unsigned x, unsigned& nloc, unsigned& nx) {
    const unsigned G = gridDim.x * gridDim.y * gridDim.z;
    unsigned sum, cnt, mine, sp = 0u;
    for (;;) {
        sum = 0u; cnt = 0u; mine = 0u;
#pragma unroll
        for (unsigned j = 0; j < 16; ++j) { const unsigned c = xb_ld(&bar[XB_XCNT(j)]); sum += c; cnt += (c > 0u) ? 1u : 0u; mine = (j == x) ? c : mine; }
        if (sum == G) break;
        __builtin_amdgcn_s_sleep(1);
        if ((++sp & 255u) == 0u) { if (xb_ld(&bar[XB_TMO])) break; if (sp > XB_SPIN_CAP) { atomicAdd(&bar[XB_TMO], 1u); break; } }
    }
    nloc = mine > 0u ? mine : 1u; nx = cnt > 0u ? cnt : 1u;
}
__device__ __forceinline__ void xcd_barrier(const XcdBarrier& b) {
    asm volatile("s_waitcnt vmcnt(0)" ::: "memory");
    __syncthreads();
    if (threadIdx.x == 0) {
        unsigned* bar = b.bar; asm volatile("" : "+s"(bar));
        __builtin_amdgcn_s_waitcnt(0);
        unsigned nloc = b.st[0], nx = b.st[1];
        if (nloc == 0u) { xcd_barrier_complete(bar, b.x, nloc, nx); b.st[0] = nloc; b.st[1] = nx; }
        const unsigned old = xb_add(&bar[XB_XSUB(b.x)], 1u);
        const unsigned gen = old / nloc;
        if (old + 1u == (gen + 1u) * nloc) {
            __builtin_amdgcn_fence(__ATOMIC_RELEASE, "agent");
            asm volatile("s_waitcnt vmcnt(0)" ::: "memory");
            const unsigned og = xb_add(&bar[XB_TOP], 1u);
            const unsigned tg = og / nx;
            if (og + 1u == (tg + 1u) * nx) xb_add(&bar[XB_TOPGEN], 1u);
            else XB_SPIN(xb_ld(&bar[XB_TOPGEN]) == tg, bar);
            __builtin_amdgcn_fence(__ATOMIC_ACQUIRE, "agent");
            xb_add(&bar[XB_XGEN(b.x)], 1u);
            asm volatile("s_waitcnt vmcnt(0)" ::: "memory");
        } else {
            XB_SPIN(xb_ld(&bar[XB_XGEN(b.x)]) == gen, bar);
            __builtin_amdgcn_fence(__ATOMIC_ACQUIRE, "agent");
            asm volatile("s_waitcnt vmcnt(0)" ::: "memory");
        }
    }
    __syncthreads();
}

constexpr int NWAVES = 8, RING_BYTES = 131072, LDS_BYTES = 163840, MISC_OFF = LDS_BYTES - 512;
struct Args { const float* in[31]; float* out; unsigned char* ws; int ph_lo, ph_hi; };
enum { I_X = 0, I_C, I_CTX, I_CCTX, I_WMOD, I_BMOD, I_G1, I_G2, I_WIN, I_QGAIN, I_KGAIN, I_MU, I_W0, I_W2, I_A0, I_A2, I_G2R, I_KK, I_KA, I_RK, I_LNW, I_LNB, I_QNORM, I_QUP, I_KVNORM, I_KVUP, I_WBR, I_WOUT, I_FF1, I_FF2, I_GFIN };
#define CAS __attribute__((address_space(4)))
__device__ __forceinline__ const float* inp(int i) { const CAS Args* ap = (const CAS Args*)__builtin_amdgcn_kernarg_segment_ptr(); asm volatile("" : "+s"(ap)); return ap->in[i]; }
struct Frame {
    LAS unsigned char* lds; unsigned char* ldsg;
    unsigned* ctl; unsigned char* ws; float* out;
    int G, bid;
};
#define FTID() otid()
#define FLANE() (otid() & 63)
#define FWAVE() __builtin_amdgcn_readfirstlane(otid() >> 6)
__device__ __forceinline__ float wave_sum(float v) {
#pragma unroll
    for (int o = 1; o < 64; o <<= 1) v += __shfl_xor(v, o);
    return v;
}
__device__ __forceinline__ const float* xrow_ptr(const float* xl, const float* xc, int m) { const int b = m / RPB, s = m % RPB; return (s < CTX) ? xc + (size_t)(b * CTX + s) * DM : xl + (size_t)(b * SEQ + s - CTX) * DM; }

__device__ __forceinline__ void p0_transpose_item(const float* W, int ldw, int col0, int Kd, int N, bf16* WT, const float* kscale, LAS unsigned* scr, int item, int lane, int ldwt) {
    const int nblk = (N + 63) / 64, kb = item / nblk, nb = item % nblk, k0 = 64 * kb, n0 = 64 * nb, c = lane & 15, r4 = lane >> 4;
    const bool valid = n0 + 4 * c < N;
#pragma unroll
    for (int i = 0; i < 8; ++i) { const int k = 8 * i + 2 * r4; f32x4 a = (f32x4){0.f, 0.f, 0.f, 0.f}, bq = a;
        if (valid) { a = *(const f32x4*)(W + (size_t)(k0 + k) * ldw + col0 + n0 + 4 * c); bq = *(const f32x4*)(W + (size_t)(k0 + k + 1) * ldw + col0 + n0 + 4 * c); }
        if (kscale) { a = a * kscale[k0 + k]; bq = bq * kscale[k0 + k + 1]; }
#pragma unroll
        for (int e = 0; e < 4; ++e) scr[(4 * c + e) * 33 + (k >> 1)] = pk2(a[e], bq[e]); }
    LDS_WAIT(); asm volatile("" ::: "memory");
#pragma unroll
    for (int t = 0; t < 8; ++t) { const int n = (lane >> 3) + 8 * t, j = lane & 7; const LAS unsigned* p = scr + n * 33 + 4 * j;
        v4u o; o.x = p[0]; o.y = p[1]; o.z = p[2]; o.w = p[3];
        if (n0 + n < N) *(v4u*)(WT + (size_t)(n0 + n) * ldwt + k0 + 8 * j) = o; }
    LDS_WAIT(); asm volatile("" ::: "memory");
}

constexpr int WI_A = 16 * 53, WI_B = 16 * 48, WI_C2 = 6 * 12, WI_D = 4 * 16, WI_E = 8 * 16, WI_F = 16 * 16, WI_G = 16 * 64, WI_H = 64 * 16;
constexpr int WI_MIX = WI_A + WI_B + WI_C2 + WI_D + 3 * WI_E + WI_F, WI_ALL = WI_MIX + WI_G + WI_H;
__device__ __forceinline__ void weight_items(Frame& F, int l, int it0, int it1, int w, int nw);
__device__ __forceinline__ void ph_weights(Frame& F, int l) {
    unsigned char* wt = F.ws + WS_WT;
    if (l == 0) {
        LAS float* sl = (LAS float*)F.lds;
        LAS float* red = (LAS float*)(F.lds + 32768);
        for (int i = FTID(); i < 5 * 1024; i += 512) { const int j = i >> 10, k = i & 1023; const float c = (j < 4) ? inp(I_C)[j * 1024 + k] : inp(I_CCTX)[k]; sl[i] = c / (1.f + __expf(-c)); }
        __syncthreads();
        for (int it = F.bid; it < 2 * 96; it += F.G) {
            const int ll = it / 96, n0 = (it % 96) * 64;
            const float* wm = inp(I_WMOD) + (size_t)ll * 1024 * 6144 + n0 + FLANE();
            float a0 = 0, a1 = 0, a2 = 0, a3 = 0, a4 = 0;
            for (int k = FWAVE() * 128; k < FWAVE() * 128 + 128; ++k) { const float w = wm[(size_t)k * 6144]; a0 += sl[k] * w; a1 += sl[1024 + k] * w; a2 += sl[2048 + k] * w; a3 += sl[3072 + k] * w; a4 += sl[4096 + k] * w; }
            LAS float* r = red + FWAVE() * 320 + FLANE(); r[0] = a0; r[64] = a1; r[128] = a2; r[192] = a3; r[256] = a4;
            __syncthreads();
            if (FTID() < 320) { float s = 0; for (int w = 0; w < 8; ++w) s += red[w * 320 + FTID()]; const int j = FTID() >> 6, n = n0 + (FTID() & 63);
                ((float*)(F.ws + WS_MOD))[(size_t)(ll * 5 + j) * 6144 + n] = s + inp(I_BMOD)[ll * 6144 + n]; }
            __syncthreads();
        }
        if (F.bid == F.G - 1) {
            for (int i = FTID(); i < 64 * 16; i += 512) { const int pos = i >> 4, f = i & 15; const float ang = (float)pos * powf(10000.f, -(float)f / 16.f); ((float*)(F.ws + WS_T16C))[i] = cosf(ang); ((float*)(F.ws + WS_T16S))[i] = sinf(ang); }
            for (int i = FTID(); i < 64 * 8; i += 512) { const int pos = i >> 3, f = i & 7; const float ang = (float)pos * powf(10000.f, -(float)f / 8.f); ((float*)(F.ws + WS_T8C))[i] = cosf(ang); ((float*)(F.ws + WS_T8S))[i] = sinf(ang); }
        }
        __syncthreads();
    }
    {
        bf16* w2P = (bf16*)(F.ws + WS_TAB); bf16* a2B = (bf16*)(F.ws + WS_TAB + 131072); bf16* g2P = (bf16*)(F.ws + WS_TAB + 524288);
        const float* w2 = inp(I_W2) + (size_t)l * 2 * 64 * 512; const float* a2 = inp(I_A2) + (size_t)l * 2 * 64 * 512; const float* g2 = inp(I_G2R) + (size_t)l * 128 * 512;
        const float* mu = inp(I_MU) + (size_t)l * 2 * RWIN;
        for (int idx = F.bid * 512 + FTID(); idx < 65536; idx += F.G * 512) {
            { const int dh = idx >> 12, d = dh >> 3, hd = dh & 7, rem = idx & 4095, Ii = rem >> 11, J = (rem >> 10) & 1, S = (rem >> 9) & 1, ln = (rem >> 3) & 63, e = rem & 7;
              const int i = 32 * Ii + 16 * S + 8 * (e >> 2) + 4 * (ln >> 5) + (e & 3), k = 32 * J + (ln & 31);
              w2P[idx] = (bf16)f2bf(w2[(size_t)(d * 64 + i) * 512 + hd * 64 + k]); }
            { const int hd = idx >> 13, rem = idx & 8191, Ii = rem >> 11, Iv = (rem >> 10) & 1, S = (rem >> 9) & 1, ln = (rem >> 3) & 63, e = rem & 7;
              const int i = 32 * Ii + 16 * S + 8 * (e >> 2) + 4 * (ln >> 5) + (e & 3), v = 32 * Iv + (ln & 31);
              g2P[idx] = (bf16)f2bf(g2[(size_t)i * 512 + hd * 64 + v]); } }
        {   bf16* DF = (bf16*)(F.ws + WS_TAB + 655360);
            for (int idx = F.bid * 512 + FTID(); idx < 60 * 3 * 2 * 64 * 8; idx += F.G * 512) {
                const int e = idx & 7, ln = (idx >> 3) & 63, q = (idx >> 9) & 1, w = (idx >> 10) % 3, blk = idx / 3072, r = ln & 31, h = ln >> 5, cc = 32 * blk + r;
                const float m0 = mu[cc], m1 = mu[RWIN + cc]; const float cf = (w == 0) ? 1.f - m0 - m1 : (w == 1 ? m0 : m1);
                DF[idx] = (r == 16 * q + 8 * h + e) ? (bf16)f2bf(cf) : (bf16)0; } }
        for (int idx = F.bid * 512 + FTID(); idx < 196608; idx += F.G * 512) {
            const int dh = idx / 12288, rem = idx % 12288, w = rem >> 12, k = (rem >> 6) & 63, i = rem & 63, d = dh >> 3, hd = dh & 7;
            const float m0 = mu[RW_AD + d * 64 + i], m1 = mu[RWIN + RW_AD + d * 64 + i]; const float cf = (w == 0) ? 1.f - m0 - m1 : (w == 1 ? m0 : m1);
            a2B[idx] = (bf16)f2bf(a2[(size_t)(d * 64 + i) * 512 + hd * 64 + k] * cf); } }
    weight_items(F, l, 0, WI_MIX, F.bid * NWAVES + FWAVE(), F.G * NWAVES);
    { v4u* z = (v4u*)((bf16*)(wt + WT_IN) + (size_t)3360 * DM); const int nz = 224 * DM * 2 / 16; unsigned z0; asm volatile("v_mov_b32 %0, 0" : "=v"(z0));
      for (int i = F.bid * 512 + FTID(); i < nz; i += F.G * 512) z[i] = (v4u){z0, z0, z0, z0}; }
}
__device__ __forceinline__ void weight_items(Frame& F, int l, int it0, int it1, int w, int nw) {
    unsigned char* wt = F.ws + WS_WT;
    LAS unsigned* scr = (LAS unsigned*)(F.lds + FWAVE() * 16384);
    const float* win = inp(I_WIN) + (size_t)l * DM * NIN;
    constexpr int I_A = WI_A, I_B = WI_B, I_C2 = WI_C2, I_D = WI_D, I_E = WI_E, I_F = WI_F, I_G = WI_G;
    for (int it = it0 + w; it < it1; it += nw) {
        int r = it; const int lane = FLANE();
        if (r < I_A) { p0_transpose_item(win, NIN, 0, DM, 3360, (bf16*)(wt + WT_IN), nullptr, scr, r, lane, DM); continue; } r -= I_A;
        if (r < I_B) { p0_transpose_item(win, NIN, C_GATE, DM, NGATE, (bf16*)(wt + WT_G), nullptr, scr, r, lane, DM); continue; } r -= I_B;
        if (r < I_C2) { p0_transpose_item(inp(I_QUP) + (size_t)l * 384 * 768, 768, 0, 384, 768, (bf16*)(wt + WT_QU), inp(I_QNORM) + l * 384, scr, r, lane, 384); continue; } r -= I_C2;
        if (r < I_D) { p0_transpose_item(inp(I_KVUP) + (size_t)l * 256 * 1024, 1024, 0, 256, 1024, (bf16*)(wt + WT_KVU), inp(I_KVNORM) + l * 256, scr, r, lane, 256); continue; } r -= I_D;
        if (r < 3 * I_E) { const int i = r / I_E; p0_transpose_item(inp(I_WBR) + (size_t)(l * 3 + i) * 512 * DM, DM, 0, 512, DM, (bf16*)(wt + WT_BR) + (size_t)i * DM * 512, nullptr, scr, r % I_E, lane, 512); continue; } r -= 3 * I_E;
        if (r < I_F) { p0_transpose_item(inp(I_WOUT) + (size_t)l * DM * DM, DM, 0, DM, DM, (bf16*)(wt + WT_OUT), nullptr, scr, r, lane, DM); continue; } r -= I_F;
        if (r < I_G) { p0_transpose_item(inp(I_FF1) + (size_t)l * DM * DFF, DFF, 0, DM, DFF, (bf16*)(wt + WT_F1), nullptr, scr, r, lane, DM); continue; } r -= I_G;
        p0_transpose_item(inp(I_FF2) + (size_t)l * DFF * DM, DM, 0, DFF, DM, (bf16*)(wt + WT_F2), nullptr, scr, r, lane, DFF);
    }
}

__device__ __forceinline__ void ph_norm(Frame& F, int l, const float* xl, const float* xc, const float* g, int which, bool skipctx, const float* part = nullptr) {
    const int gw = F.bid * NWAVES + FWAVE(), NGW = F.G * NWAVES;
    const float* mod = (const float*)(F.ws + WS_MOD) + (size_t)l * 5 * 6144;
    bf16* XN = (bf16*)(F.ws + WS_XN);
    for (int m = gw; m < MROWS; m += NGW) {
        const int b = m / RPB, s = m % RPB; if (skipctx && s < CTX) continue;
        const f32x4* xr = (const f32x4*)xrow_ptr(xl, xc, m) + FLANE();
        const float* mv = mod + (size_t)((s < CTX) ? 4 : b) * 6144 + which * 3072;
        f32x4 v[4]; float ss = 0.f;
#pragma unroll
        for (int j = 0; j < 4; ++j) { v[j] = xr[64 * j];
            if (part && s < CTX) { const f32x4* pr = (const f32x4*)(part + (size_t)(b * CTX + s) * DM) + FLANE() + 64 * j; v[j] = v[j] + pr[0] + pr[262144] + pr[524288]; }
            ss += (v[j].x * v[j].x + v[j].y * v[j].y) + (v[j].z * v[j].z + v[j].w * v[j].w); }
        const float rstd = 1.f / sqrtf(wave_sum(ss) * (1.f / DM) + NORM_EPS);
        unsigned long long* o8 = (unsigned long long*)(XN + (size_t)m * DM) + FLANE();
#pragma unroll
        for (int j = 0; j < 4; ++j) { const int c = 4 * FLANE() + 256 * j; const f32x4 gg = *(const f32x4*)(g + c), sh = *(const f32x4*)(mv + c), sc = *(const f32x4*)(mv + 1024 + c);
            const f32x4 y = v[j] * rstd * gg * (sc + 1.0f) + sh;
            o8[64 * j] = (unsigned long long)pk2(y.x, y.y) | ((unsigned long long)pk2(y.z, y.w) << 32); }
    }
}
__device__ __forceinline__ void ph_final(Frame& F) {
    const int gw = F.bid * NWAVES + FWAVE(), NGW = F.G * NWAVES; const float* g = inp(I_GFIN);
    for (int m = gw; m < NB * SEQ; m += NGW) {
        f32x4* xr = (f32x4*)(F.out + (size_t)m * DM) + FLANE(); f32x4 v[4]; float ss = 0.f;
#pragma unroll
        for (int j = 0; j < 4; ++j) { v[j] = xr[64 * j]; ss += (v[j].x * v[j].x + v[j].y * v[j].y) + (v[j].z * v[j].z + v[j].w * v[j].w); }
        const float rstd = 1.f / sqrtf(wave_sum(ss) * (1.f / DM) + NORM_EPS);
#pragma unroll
        for (int j = 0; j < 4; ++j) { const f32x4 gg = *(const f32x4*)(g + 4 * FLANE() + 256 * j); xr[64 * j] = v[j] * rstd * gg; }
    }
}

__device__ __forceinline__ void ph_prep(Frame& F, int l, int half) {
    const int gw = F.bid * NWAVES + FWAVE(), NGW = F.G * NWAVES, lane = FLANE();
    bf16* PP = (bf16*)(F.ws + WS_HALF + H_PP);
    const float* t16c = (const float*)(F.ws + WS_T16C); const float* t16s = (const float*)(F.ws + WS_T16S); const float* t8c = (const float*)(F.ws + WS_T8C); const float* t8s = (const float*)(F.ws + WS_T8S);
    float* rsq = (float*)(F.ws + WS_RSQ); float* rskv = (float*)(F.ws + WS_RSKV);
    const float* qg = inp(I_QGAIN) + l * 64; const float* kg = inp(I_KGAIN) + l * 64;
    for (int m = gw; m < HM; m += NGW) {
        const int s = m % RPB; const bool lat = s >= CTX; const int tt = s - CTX, pr = (tt >> 6) & 63, pc = tt & 63;
        bf16* row = PP + (size_t)m * PPW;
        for (int part = 0; part < 2; ++part) {
            if (part == 1 && lane >= 16) break;
            bf16* p = row + (part == 0 ? C_GQ : C_GK) + lane * 8; const float* gain = part == 0 ? qg : kg;
            const v4u w = *(const v4u*)p; float v[8] = {pg8::bf_lo(w.x), pg8::bf_hi(w.x), pg8::bf_lo(w.y), pg8::bf_hi(w.y), pg8::bf_lo(w.z), pg8::bf_hi(w.z), pg8::bf_lo(w.w), pg8::bf_hi(w.w)};
            float ss = 0; for (int e = 0; e < 8; ++e) ss += v[e] * v[e];
            ss += __shfl_xor(ss, 1); ss += __shfl_xor(ss, 2); ss += __shfl_xor(ss, 4);
            const float rstd = 1.f / sqrtf(ss * (1.f / 64.f) + NORM_EPS); const int j = lane & 7;
            const float qs = (part == 0) ? 0.125f * 1.4426950408889634f : 1.f;
            for (int e = 0; e < 8; ++e) v[e] = v[e] * (rstd * qs) * gain[j * 8 + e];
            float pv[8]; for (int e = 0; e < 8; ++e) pv[e] = __shfl_xor(v[e], 2);
            if (lat) { const int pos = (j < 4) ? pr : pc; const int f0 = 8 * (j & 1);
                for (int e = 0; e < 8; ++e) { const float c = t16c[pos * 16 + f0 + e], sn = t16s[pos * 16 + f0 + e]; v[e] = ((j & 2) == 0) ? v[e] * c - pv[e] * sn : pv[e] * sn + v[e] * c; } }
            v4u o; o.x = pk2(v[0], v[1]); o.y = pk2(v[2], v[3]); o.z = pk2(v[4], v[5]); o.w = pk2(v[6], v[7]); *(v4u*)p = o;
        }
        if (lane < 4) {
            bf16* p = row + C_KR + lane * 8; const v4u w = *(const v4u*)p; float v[8] = {pg8::bf_lo(w.x), pg8::bf_hi(w.x), pg8::bf_lo(w.y), pg8::bf_hi(w.y), pg8::bf_lo(w.z), pg8::bf_hi(w.z), pg8::bf_lo(w.w), pg8::bf_hi(w.w)};
            float pv[8]; for (int e = 0; e < 8; ++e) pv[e] = __shfl_xor(v[e], 1);
            if (lat) { const int pos = (lane < 2) ? pr : pc;
                for (int e = 0; e < 8; ++e) { const float c = t8c[pos * 8 + e], sn = t8s[pos * 8 + e]; v[e] = ((lane & 1) == 0) ? v[e] * c - pv[e] * sn : pv[e] * sn + v[e] * c; } }
            v4u o; o.x = pk2(v[0], v[1]); o.y = pk2(v[2], v[3]); o.z = pk2(v[4], v[5]); o.w = pk2(v[6], v[7]); *(v4u*)p = o;
        }
        { float sq = 0, skv = 0;
          if (lane < 48) { const v4u w = *(const v4u*)(row + C_QD + lane * 8); const float v[8] = {pg8::bf_lo(w.x), pg8::bf_hi(w.x), pg8::bf_lo(w.y), pg8::bf_hi(w.y), pg8::bf_lo(w.z), pg8::bf_hi(w.z), pg8::bf_lo(w.w), pg8::bf_hi(w.w)}; for (int e = 0; e < 8; ++e) sq += v[e] * v[e]; }
          if (lane < 32) { const v4u w = *(const v4u*)(row + C_KVD + lane * 8); const float v[8] = {pg8::bf_lo(w.x), pg8::bf_hi(w.x), pg8::bf_lo(w.y), pg8::bf_hi(w.y), pg8::bf_lo(w.z), pg8::bf_hi(w.z), pg8::bf_lo(w.w), pg8::bf_hi(w.w)}; for (int e = 0; e < 8; ++e) skv += v[e] * v[e]; }
          sq = wave_sum(sq); skv = wave_sum(skv);
          if (lane == 0) { rsq[m] = (0.10206207261596575f * 1.4426950408889634f) / sqrtf(sq * (1.f / 384.f) + NORM_EPS);     rskv[m] = 1.f / sqrtf(skv * (1.f / 256.f) + NORM_EPS); } }
    }
}
__device__ __forceinline__ void shifted8(const bf16* PP, int m, int cc0, const float* mu, float (&u)[8]) {
    const int s = m % RPB; const float fp = (s != 0 && s != CTX) ? 1.f : 0.f, fn = (s != CTX - 1 && s != RPB - 1) ? 1.f : 0.f;
    const int mp = m > 0 ? m - 1 : 0, mn = m < HM - 1 ? m + 1 : HM - 1;
    const v4u w = *(const v4u*)(PP + (size_t)m * PPW + C_RW + cc0), wp = *(const v4u*)(PP + (size_t)mp * PPW + C_RW + cc0), wn = *(const v4u*)(PP + (size_t)mn * PPW + C_RW + cc0);
    const f32x4 m0a = *(const f32x4*)(mu + cc0), m0b = *(const f32x4*)(mu + cc0 + 4), m1a = *(const f32x4*)(mu + RWIN + cc0), m1b = *(const f32x4*)(mu + RWIN + cc0 + 4);
    const float c[8] = {pg8::bf_lo(w.x), pg8::bf_hi(w.x), pg8::bf_lo(w.y), pg8::bf_hi(w.y), pg8::bf_lo(w.z), pg8::bf_hi(w.z), pg8::bf_lo(w.w), pg8::bf_hi(w.w)};
    const float a[8] = {pg8::bf_lo(wp.x), pg8::bf_hi(wp.x), pg8::bf_lo(wp.y), pg8::bf_hi(wp.y), pg8::bf_lo(wp.z), pg8::bf_hi(wp.z), pg8::bf_lo(wp.w), pg8::bf_hi(wp.w)};
    const float n[8] = {pg8::bf_lo(wn.x), pg8::bf_hi(wn.x), pg8::bf_lo(wn.y), pg8::bf_hi(wn.y), pg8::bf_lo(wn.z), pg8::bf_hi(wn.z), pg8::bf_lo(wn.w), pg8::bf_hi(wn.w)};
#pragma unroll
    for (int e = 0; e < 8; ++e) { const float m0 = (e < 4 ? m0a[e & 3] : m0b[e & 3]), m1 = (e < 4 ? m1a[e & 3] : m1b[e & 3]); u[e] = c[e] + m0 * (fp * a[e] - c[e]) + m1 * (fn * n[e] - c[e]); }
}
namespace rk {
using bf16x8 = __attribute__((ext_vector_type(8))) short;
using f32x16 = __attribute__((ext_vector_type(16))) float;
using u32x4 = __attribute__((ext_vector_type(4))) unsigned;
typedef float f32x2_t __attribute__((ext_vector_type(2))); typedef __bf16 bf16x2_t __attribute__((ext_vector_type(2)));
#define RK_DI __device__ __forceinline__
RK_DI f32x16 RK_MF(bf16x8 a, bf16x8 b, f32x16 c) { return __builtin_amdgcn_mfma_f32_32x32x16_bf16(a, b, c, 0, 0, 0); }
constexpr int NH = 8;
RK_DI unsigned cvt2(float lo, float hi) { f32x2_t v = {lo, hi}; bf16x2_t b = __builtin_convertvector(v, bf16x2_t); return __builtin_bit_cast(unsigned, b); }
RK_DI float lo16(unsigned w) { return __uint_as_float(w << 16); }
RK_DI float hi16(unsigned w) { return __uint_as_float(w & 0xffff0000u); }
RK_DI int crow(int reg, int h) { return (reg & 3) + 8 * (reg >> 2) + 4 * h; }
RK_DI int krow(int s, int h, int e) { return 16 * s + 8 * (e >> 2) + 4 * h + (e & 3); }
template <int S> RK_DI bf16x8 pack(const f32x16& x) { u32x4 p = {cvt2(x[8 * S], x[8 * S + 1]), cvt2(x[8 * S + 2], x[8 * S + 3]), cvt2(x[8 * S + 4], x[8 * S + 5]), cvt2(x[8 * S + 6], x[8 * S + 7])}; return __builtin_bit_cast(bf16x8, p); }
RK_DI bf16x8 pack8(const float (&u)[8]) { u32x4 p = {cvt2(u[0], u[1]), cvt2(u[2], u[3]), cvt2(u[4], u[5]), cvt2(u[6], u[7])}; return __builtin_bit_cast(bf16x8, p); }
RK_DI void unpack8(bf16x8 v, float (&u)[8]) { const u32x4 p = __builtin_bit_cast(u32x4, v); u[0] = lo16(p.x); u[1] = hi16(p.x); u[2] = lo16(p.y); u[3] = hi16(p.y); u[4] = lo16(p.z); u[5] = hi16(p.z); u[6] = lo16(p.w); u[7] = hi16(p.w); }
constexpr short ONE = (short)0x3F80;
template <int K> RK_DI bf16x8 idn(int r, int h) { bf16x8 v;
#pragma unroll
    for (int e = 0; e < 8; ++e) v[e] = (r == 16 * K + 8 * h + e) ? ONE : (short)0; return v; }
template <int S> RK_DI bf16x8 idp(int r, int h) { bf16x8 v;
#pragma unroll
    for (int e = 0; e < 8; ++e) v[e] = (r == krow(S, h, e)) ? ONE : (short)0; return v; }
RK_DI bf16x8 idn_q(int q, int r, int h) { return q ? idn<1>(r, h) : idn<0>(r, h); }
template <int S, bool STRICT> RK_DI bf16x8 incp(int r, int h, int flip) { bf16x8 v;
#pragma unroll
    for (int e = 0; e < 8; ++e) { const int s = krow(S, h, e); const bool on = flip ? (STRICT ? s > r : s >= r) : (STRICT ? s < r : s <= r); v[e] = on ? ONE : (short)0; } return v; }
template <bool STRICT> RK_DI void tmask(f32x16& g, int r, int h, int flip) {
#pragma unroll
    for (int reg = 0; reg < 16; ++reg) { const int s = crow(reg, h); const bool on = flip ? (STRICT ? s > r : s >= r) : (STRICT ? s < r : s <= r); g[reg] = on ? g[reg] : 0.f; } }
template <int FLIP> RK_DI void solve32(f32x16& x, const bf16x8 (&Mp)[2]) {
    constexpr int F1 = FLIP ? 1 : 0, F2 = 1 - F1;
    f32x16 base = x;
#pragma unroll 1
    for (int it = 0; it < NH; ++it) { const f32x16 t = RK_MF(Mp[F1], pack<F1>(x), base);
#pragma unroll
        for (int e = 0; e < 8; ++e) x[8 * F1 + e] = t[8 * F1 + e]; }
    { const f32x16 t = RK_MF(Mp[F1], pack<F1>(x), base); x = t; base = t; }
#pragma unroll 1
    for (int it = 0; it < NH; ++it) { const f32x16 t = RK_MF(Mp[F2], pack<F2>(x), base);
#pragma unroll
        for (int e = 0; e < 8; ++e) x[8 * F2 + e] = t[8 * F2 + e]; }
}
template <int FLIP> RK_DI void solve32p(f32x16& x, f32x16& y, const bf16x8 (&Mp)[2]) {
    constexpr int F1 = FLIP ? 1 : 0, F2 = 1 - F1;
    f32x16 bx = x, by = y;
#pragma unroll 1
    for (int it = 0; it < NH; ++it) { const f32x16 t = RK_MF(Mp[F1], pack<F1>(x), bx); const f32x16 u = RK_MF(Mp[F1], pack<F1>(y), by);
#pragma unroll
        for (int e = 0; e < 8; ++e) { x[8 * F1 + e] = t[8 * F1 + e]; y[8 * F1 + e] = u[8 * F1 + e]; } }
    { const f32x16 t = RK_MF(Mp[F1], pack<F1>(x), bx); const f32x16 u = RK_MF(Mp[F1], pack<F1>(y), by); x = t; bx = t; y = u; by = u; }
#pragma unroll 1
    for (int it = 0; it < NH; ++it) { const f32x16 t = RK_MF(Mp[F2], pack<F2>(x), bx); const f32x16 u = RK_MF(Mp[F2], pack<F2>(y), by);
#pragma unroll
        for (int e = 0; e < 8; ++e) { x[8 * F2 + e] = t[8 * F2 + e]; y[8 * F2 + e] = u[8 * F2 + e]; } }
}
RK_DI float sigm(float x) { return __builtin_amdgcn_rcpf(1.f + __expf(-x)); }
RK_DI float tanh_f(float x) { return 2.f * __builtin_amdgcn_rcpf(1.f + __expf(-2.f * x)) - 1.f; }

struct Ctx {
    unsigned char* ws; LAS unsigned char* sb; int m0, r, h, hd, dir, l, flip;
    int cofs, dofs;
    int zt;
    int lofs;
    unsigned mp, mn; int rowc, rowp, rown;
};
#define C_PP(c) ((const bf16*)((c).ws + WS_HALF + H_PP))
#define C_MU(c) (inp(I_MU) + (size_t)(c).l * 2 * RWIN)
#define C_W2P(c) ((const bf16*)((c).ws + WS_TAB) + (size_t)((c).dir * 8 + (c).hd) * 4096)
#define C_A2B(c) ((const bf16*)((c).ws + WS_TAB + 131072) + (size_t)((c).dir * 8 + (c).hd) * 3 * 4096)
constexpr int SBUF = 34 * 128;
RK_DI void stage_slice(const Ctx& c, int buf, int cc0) {
    const int lane = c.r + 32 * c.h, p = lane & 7, q4 = lane >> 4;
    const bf16* base = C_PP(c) + (ptrdiff_t)(c.m0 - 1 + (lane >> 3)) * PPW + C_RW + cc0;
    const int oe = (p ^ q4) << 3, oo = (p ^ (4 + q4)) << 3;
#pragma unroll
    for (int j = 0; j < 5; ++j) { const bf16* src = base + (ptrdiff_t)j * 8 * PPW + ((j & 1) ? oo : oe);
        if (j < 4 || lane < 16) __builtin_amdgcn_global_load_lds((const unsigned*)src, (LAS unsigned*)(c.sb + buf * SBUF + j * 1024), 16, 0, 0); }
}
#define RK_WAIT_DMA() asm volatile("s_waitcnt vmcnt(0)" ::: "memory")
#define RK_WAIT_LDS() asm volatile("s_waitcnt lgkmcnt(0)" ::: "memory")
RK_DI bf16x8 rawfrag(const Ctx& c, int buf, int ch, int w) {
    const int rho = c.r + (w == 0 ? 1 : (w == 1 ? 0 : 2)); const unsigned m = (w == 0) ? 0xffffffffu : (w == 1 ? c.mp : c.mn);
    u32x4 v = *(const LAS u32x4*)(c.sb + buf * SBUF + rho * 128 + ((ch ^ ((rho >> 1) & 7)) << 4) + c.zt); v.x &= m; v.y &= m; v.z &= m; v.w &= m; return __builtin_bit_cast(bf16x8, v); }
RK_DI bf16x8 dfrag(const Ctx& c, int cc32, int w, int q) { return *(const bf16x8*)((const bf16*)(c.ws + WS_TAB + 655360) + (((cc32 >> 5) * 3 + w) * 2 + q) * 512 + c.lofs); }
RK_DI f32x16 load_o2(Ctx& c, int buf, int lblk, int cc32) { f32x16 z = f32x16{};
#pragma unroll
    for (int q = 0; q < 2; ++q) {
#pragma unroll
        for (int w = 0; w < 3; ++w) z = RK_MF(dfrag(c, cc32, w, q), rawfrag(c, buf, 4 * lblk + 2 * q + c.h, w), z); }
    asm volatile("" : "+v"(c.lofs), "+v"(c.zt), "+v"(z));
    return z; }
RK_DI f32x16 load_o1(Ctx& c, int buf, int lblk, int cc32) { f32x16 z = f32x16{};
#pragma unroll
    for (int q = 0; q < 2; ++q) {
#pragma unroll
        for (int w = 0; w < 3; ++w) z = RK_MF(rawfrag(c, buf, 4 * lblk + 2 * q + c.h, w), dfrag(c, cc32, w, q), z); }
    asm volatile("" : "+v"(c.lofs), "+v"(c.zt), "+v"(z));
    return z; }

struct Tilde { bf16x8 At[2][2], Bt[2][2], Kt[2][2], Rt[2][2], Vp[2][2]; float gtot[2]; float bon; };
#define RK_STAGE(x) asm volatile("" : "+v"(c.lofs), "+v"(c.zt), "+v"(x))
template <bool NEED_R> RK_DI void build_tilde(Ctx& c, Tilde& T) {
    const int r = c.r, h = c.h;
    stage_slice(c, 0, RW_WD + c.dir * 64); stage_slice(c, 1, RW_K + c.hd * 64); stage_slice(c, 2, RW_AD + c.dir * 64); if constexpr (NEED_R) stage_slice(c, 3, RW_R + c.hd * 64);
    RK_WAIT_DMA();
    bf16x8 lwp[2][2];
    {   bf16x8 twp[2][2];
#pragma unroll
        for (int Ii = 0; Ii < 2; ++Ii) { f32x16 t = load_o2(c, 0, Ii, RW_WD + c.dir * 64 + 32 * Ii);
#pragma unroll
            for (int reg = 0; reg < 16; ++reg) t[reg] = tanh_f(t[reg]);
            twp[Ii][0] = pack<0>(t); twp[Ii][1] = pack<1>(t); RK_STAGE(twp[Ii][1]); }
#pragma unroll
        for (int J = 0; J < 2; ++J) { f32x16 wl = f32x16{};
#pragma unroll
            for (int Ii = 0; Ii < 2; ++Ii)
#pragma unroll
                for (int S = 0; S < 2; ++S) wl = RK_MF(twp[Ii][S], *(const bf16x8*)(C_W2P(c) + ((Ii * 2 + J) * 2 + S) * 512 + c.lofs), wl);
            const float w0 = inp(I_W0)[c.dofs + 32 * J + r]; float gs = 0.f;
#pragma unroll
            for (int reg = 0; reg < 16; ++reg) wl[reg] = -0.6065306597126334f * sigm(wl[reg] + w0);
            lwp[J][0] = pack<0>(wl); lwp[J][1] = pack<1>(wl);
            { float q[8]; unpack8(lwp[J][0], q);
#pragma unroll
              for (int e = 0; e < 8; ++e) gs += q[e]; unpack8(lwp[J][1], q);
#pragma unroll
              for (int e = 0; e < 8; ++e) gs += q[e]; }
            gs += __shfl_xor(gs, 32); T.gtot[J] = gs; RK_STAGE(lwp[J][1]); } }
    RK_WAIT_LDS(); stage_slice(c, 0, RW_V + c.hd * 64);
    float rinv;
    {   float ss = 0.f;
#pragma unroll
        for (int Ik = 0; Ik < 2; ++Ik) { const f32x16 kt = load_o2(c, 1, Ik, RW_K + c.hd * 64 + 32 * Ik);
#pragma unroll
            for (int g = 0; g < 4; ++g) { const f32x4 kk = *(const f32x4*)(inp(I_KK) + c.cofs + 32 * Ik + 8 * g + 4 * h);
#pragma unroll
                for (int j = 0; j < 4; ++j) { const float q = kt[4 * g + j] * kk[j]; ss += q * q; } }
            RK_STAGE(ss); }
        ss += __shfl_xor(ss, 32); rinv = 1.f / fmaxf(sqrtf(ss), 1e-12f); RK_STAGE(rinv); }
    float bon = 0.f;
#pragma unroll
    for (int Ik = 0; Ik < 2; ++Ik) {
        f32x16 em, ep;
        { em = RK_MF(lwp[Ik][0], incp<0, false>(r, h, c.flip), f32x16{}); em = RK_MF(lwp[Ik][1], incp<1, false>(r, h, c.flip), em);
          ep = RK_MF(lwp[Ik][0], incp<0, true>(r, h, c.flip), f32x16{}); ep = RK_MF(lwp[Ik][1], incp<1, true>(r, h, c.flip), ep);
#pragma unroll
          for (int reg = 0; reg < 16; ++reg) { em[reg] = __expf(-em[reg]); ep[reg] = __expf(ep[reg]); } }
        RK_STAGE(ep);
        f32x16 kt = load_o2(c, 1, Ik, RW_K + c.hd * 64 + 32 * Ik); f32x16 kn;
#pragma unroll
        for (int g = 0; g < 4; ++g) { const f32x4 kk = *(const f32x4*)(inp(I_KK) + c.cofs + 32 * Ik + 8 * g + 4 * h);
#pragma unroll
            for (int j = 0; j < 4; ++j) { const int reg = 4 * g + j; kn[reg] = kt[reg] * kk[j] * rinv; ep[reg] = -kn[reg] * ep[reg]; } }
        T.At[Ik][0] = pack<0>(ep); T.At[Ik][1] = pack<1>(ep);
        RK_STAGE(T.At[Ik][1]);
        f32x16 as = f32x16{};
#pragma unroll
        for (int w = 0; w < 3; ++w) {
#pragma unroll
            for (int sp = 0; sp < 4; ++sp) as = RK_MF(*(const bf16x8*)(C_A2B(c) + w * 4096 + (32 * Ik + r) * 64 + 16 * sp + 8 * h), rawfrag(c, 2, 2 * sp + h, w), as);
            RK_STAGE(as); }
#pragma unroll
        for (int g = 0; g < 4; ++g) { const f32x4 a0 = *(const f32x4*)(inp(I_A0) + c.dofs + 32 * Ik + 8 * g + 4 * h);
#pragma unroll
            for (int j = 0; j < 4; ++j) { const int reg = 4 * g + j; as[reg] = sigm(as[reg] + a0[j]); kn[reg] = kn[reg] * as[reg] * em[reg]; } }
        T.Bt[Ik][0] = pack<0>(kn); T.Bt[Ik][1] = pack<1>(kn);
        RK_STAGE(T.Bt[Ik][1]);
#pragma unroll
        for (int g = 0; g < 4; ++g) { const f32x4 ka = *(const f32x4*)(inp(I_KA) + c.cofs + 32 * Ik + 8 * g + 4 * h);
#pragma unroll
            for (int j = 0; j < 4; ++j) { const int reg = 4 * g + j; kt[reg] = kt[reg] * (1.f + (as[reg] - 1.f) * ka[j]); as[reg] = kt[reg] * em[reg]; } }
        T.Kt[Ik][0] = pack<0>(as); T.Kt[Ik][1] = pack<1>(as);
        RK_STAGE(T.Kt[Ik][1]);
        if constexpr (NEED_R) {
            f32x16 rt = load_o2(c, 3, Ik, RW_R + c.hd * 64 + 32 * Ik);
#pragma unroll
            for (int g = 0; g < 4; ++g) { const f32x4 rk = *(const f32x4*)(inp(I_RK) + c.cofs + 32 * Ik + 8 * g + 4 * h);
#pragma unroll
                for (int j = 0; j < 4; ++j) { const int reg = 4 * g + j; bon += rt[reg] * kt[reg] * rk[j]; rt[reg] = rt[reg] * __builtin_amdgcn_rcpf(em[reg]); } }
            T.Rt[Ik][0] = pack<0>(rt); T.Rt[Ik][1] = pack<1>(rt); RK_STAGE(T.Rt[Ik][1]); }
    }
    T.bon = bon;
    RK_WAIT_DMA();
#pragma unroll
    for (int J = 0; J < 2; ++J) { const f32x16 va = load_o1(c, 0, J, RW_V + c.hd * 64 + 32 * J); T.Vp[J][0] = pack<0>(va); T.Vp[J][1] = pack<1>(va); RK_STAGE(T.Vp[J][1]); }
}
RK_DI void grams_la(const Ctx& c, const Tilde& T, bf16x8 (&Lk)[2], bf16x8 (&Mp)[2]) {
    f32x16 g = f32x16{}, m = f32x16{};
#pragma unroll
    for (int Ik = 0; Ik < 2; ++Ik)
#pragma unroll
        for (int S = 0; S < 2; ++S) { g = RK_MF(T.Kt[Ik][S], T.At[Ik][S], g); m = RK_MF(T.Bt[Ik][S], T.At[Ik][S], m); }
    tmask<true>(g, c.r, c.h, c.flip); tmask<true>(m, c.r, c.h, c.flip);
    Lk[0] = pack<0>(g); Lk[1] = pack<1>(g); Mp[0] = pack<0>(m); Mp[1] = pack<1>(m);
}
}

namespace rk {
constexpr int NSUB = RPB / 32;
RK_DI int chain_unit(int dir, int j) { return dir == 0 ? j : (j < 8 ? 7 - j : 143 - j); }
RK_DI int chain_pos(int dir, int c) { return dir == 0 ? c : (c < 8 ? 7 - c : 143 - c); }
RK_DI void setup_ctx(Ctx& c, unsigned char* ws, LAS unsigned char* sb, int l, int bl, int hd, int dir, int c32, int lane) {
    c.ws = ws; c.sb = sb; c.m0 = bl * RPB + 32 * c32; c.r = lane & 31; c.h = lane >> 5; c.hd = hd; c.dir = dir; c.l = l; c.flip = dir;
    c.cofs = l * 512 + hd * 64; c.dofs = (l * 2 + dir) * 512 + hd * 64;
    const int m = c.m0 + c.r, sg = m % RPB;
    c.mp = (sg != 0 && sg != CTX) ? 0xffffffffu : 0u; c.mn = (sg != CTX - 1 && sg != RPB - 1) ? 0xffffffffu : 0u;
    c.rowc = m; c.rowp = m > 0 ? m - 1 : 0; c.rown = m < HM - 1 ? m + 1 : HM - 1; c.lofs = (c.r + 32 * c.h) * 8; asm volatile("v_mov_b32 %0, 0" : "=v"(c.zt));
}
RK_DI void pass1_unit(unsigned char* ws, LAS unsigned char* sb, int l, int u, int lane) {
    const int q = u / NSUB, c32 = u % NSUB, bl = q >> 4, hd = (q >> 1) & 7, dir = q & 1;
    Ctx c; setup_ctx(c, ws, sb, l, bl, hd, dir, c32, lane);
    Tilde T; build_tilde<false>(c, T); __builtin_amdgcn_sched_barrier(0);
    const int r = c.r, h = c.h;
    bf16x8 Lk[2], Mp[2]; grams_la(c, T, Lk, Mp); __builtin_amdgcn_sched_barrier(0);
    const bf16x8 P0 = idp<0>(r, h), P1 = idp<1>(r, h);
    bf16x8 W1p[2][2], W2p[2][2], Bop[2][2], Kop[2][2];
#pragma unroll
    for (int J = 0; J < 2; ++J) {
        f32x16 x = RK_MF(T.At[J][0], P0, f32x16{}); x = RK_MF(T.At[J][1], P1, x);
        f32x16 y = RK_MF(Lk[0], T.Vp[J][0], f32x16{}); y = RK_MF(Lk[1], T.Vp[J][1], y);
        if (c.flip) solve32p<1>(x, y, Mp); else solve32p<0>(x, y, Mp);
        W1p[J][0] = pack<0>(x); W1p[J][1] = pack<1>(x);
        W2p[J][0] = pack<0>(y); W2p[J][1] = pack<1>(y);
        const float gcj = __expf(T.gtot[J]);
        f32x16 b = RK_MF(T.Bt[J][0], P0, f32x16{}); b = RK_MF(T.Bt[J][1], P1, b);
        f32x16 k = RK_MF(T.Kt[J][0], P0, f32x16{}); k = RK_MF(T.Kt[J][1], P1, k);
#pragma unroll
        for (int reg = 0; reg < 16; ++reg) { b[reg] *= gcj; k[reg] *= gcj; }
        Bop[J][0] = pack<0>(b); Bop[J][1] = pack<1>(b); Kop[J][0] = pack<0>(k); Kop[J][1] = pack<1>(k);
    }
    u32x4* phi = (u32x4*)(ws + WS_HALF + H_PHI) + (size_t)u * 512 + lane;
    u32x4* psi = (u32x4*)(ws + WS_HALF + H_PSI) + (size_t)u * 512 + lane;
#pragma unroll
    for (int I = 0; I < 2; ++I)
#pragma unroll
        for (int J = 0; J < 2; ++J) {
            f32x16 a = RK_MF(W1p[I][0], Bop[J][0], f32x16{}); a = RK_MF(W1p[I][1], Bop[J][1], a);
            if (I == J) {
#pragma unroll
                for (int reg = 0; reg < 16; ++reg) a[reg] += (crow(reg, h) == r) ? __expf(T.gtot[J]) : 0.f; }
            phi[((I * 2 + J) * 2 + 0) * 64] = __builtin_bit_cast(u32x4, pack<0>(a)); phi[((I * 2 + J) * 2 + 1) * 64] = __builtin_bit_cast(u32x4, pack<1>(a));
            f32x16 p = RK_MF(Bop[I][0], W2p[J][0], f32x16{}); p = RK_MF(Bop[I][1], W2p[J][1], p); p = RK_MF(Kop[I][0], T.Vp[J][0], p); p = RK_MF(Kop[I][1], T.Vp[J][1], p);
            psi[((I * 2 + J) * 2 + 0) * 64] = (u32x4){cvt2(p[0], p[1]), cvt2(p[2], p[3]), cvt2(p[4], p[5]), cvt2(p[6], p[7])};
            psi[((I * 2 + J) * 2 + 1) * 64] = (u32x4){cvt2(p[8], p[9]), cvt2(p[10], p[11]), cvt2(p[12], p[13]), cvt2(p[14], p[15])};
        }
}
RK_DI void pass2_chain(unsigned char* ws, int q, int lane, bool do_store) {
    const int dir = q & 1;
    f32x16 H[2][2] = {{f32x16{}, f32x16{}}, {f32x16{}, f32x16{}}};
    u32x4 phi[8], psi[8];
    { const int u0 = q * NSUB + chain_unit(dir, 0);
      const u32x4* ph = (const u32x4*)(ws + WS_HALF + H_PHI) + (size_t)u0 * 512 + lane; const u32x4* ps = (const u32x4*)(ws + WS_HALF + H_PSI) + (size_t)u0 * 512 + lane;
#pragma unroll
      for (int f = 0; f < 8; ++f) { phi[f] = ph[f * 64]; psi[f] = ps[f * 64]; } }
    int uprev = q * NSUB + chain_unit(dir, 0);
#pragma unroll 1
    for (int j = 0; j < NSUB - 1; ++j) {
        const int un = q * NSUB + chain_unit(dir, j + 1 < NSUB - 1 ? j + 1 : j);
        u32x4 nphi[8], npsi[8];
        { const u32x4* ph = (const u32x4*)(ws + WS_HALF + H_PHI) + (size_t)un * 512 + lane; const u32x4* ps = (const u32x4*)(ws + WS_HALF + H_PSI) + (size_t)un * 512 + lane;
#pragma unroll
          for (int f = 0; f < 8; ++f) { nphi[f] = ph[f * 64]; npsi[f] = ps[f * 64]; } }
        bf16x8 Hp[2][2][2];
#pragma unroll
        for (int I = 0; I < 2; ++I)
#pragma unroll
            for (int J = 0; J < 2; ++J) { Hp[I][J][0] = pack<0>(H[I][J]); Hp[I][J][1] = pack<1>(H[I][J]); }
#pragma unroll
        for (int Ik = 0; Ik < 2; ++Ik)
#pragma unroll
            for (int Jv = 0; Jv < 2; ++Jv) {
                f32x16 a; const u32x4 p0 = psi[(Ik * 2 + Jv) * 2], p1 = psi[(Ik * 2 + Jv) * 2 + 1];
                a[0] = lo16(p0.x); a[1] = hi16(p0.x); a[2] = lo16(p0.y); a[3] = hi16(p0.y); a[4] = lo16(p0.z); a[5] = hi16(p0.z); a[6] = lo16(p0.w); a[7] = hi16(p0.w);
                a[8] = lo16(p1.x); a[9] = hi16(p1.x); a[10] = lo16(p1.y); a[11] = hi16(p1.y); a[12] = lo16(p1.z); a[13] = hi16(p1.z); a[14] = lo16(p1.w); a[15] = hi16(p1.w);
#pragma unroll
                for (int Ip = 0; Ip < 2; ++Ip) { a = RK_MF(__builtin_bit_cast(bf16x8, phi[(Ip * 2 + Ik) * 2 + 0]), Hp[Ip][Jv][0], a); a = RK_MF(__builtin_bit_cast(bf16x8, phi[(Ip * 2 + Ik) * 2 + 1]), Hp[Ip][Jv][1], a); }
                H[Ik][Jv] = a; }
        if (do_store) { u32x4* st = (u32x4*)(ws + WS_HALF + H_PSI) + (size_t)uprev * 512 + lane;
#pragma unroll
            for (int I = 0; I < 2; ++I)
#pragma unroll
                for (int J = 0; J < 2; ++J) { st[((I * 2 + J) * 2 + 0) * 64] = __builtin_bit_cast(u32x4, pack<0>(H[I][J])); st[((I * 2 + J) * 2 + 1) * 64] = __builtin_bit_cast(u32x4, pack<1>(H[I][J])); } }
        uprev = un;
#pragma unroll
        for (int f = 0; f < 8; ++f) { phi[f] = nphi[f]; psi[f] = npsi[f]; }
    }
    if (!do_store) { float chk = 0.f;
#pragma unroll
        for (int I = 0; I < 2; ++I)
#pragma unroll
            for (int J = 0; J < 2; ++J)
#pragma unroll
                for (int reg = 0; reg < 16; ++reg) chk += H[I][J][reg];
        if (chk == 123456.789f) ((float*)(ws + WS_END))[lane] = chk; }
}
RK_DI void pass2_half(unsigned char* ws, int q, int jv, int lane) {
    static_assert((NSUB - 1) % 3 == 0, "three-step rotation");
    const int dir = q & 1;
    bf16x8 Hp[2][2] = {{bf16x8{}, bf16x8{}}, {bf16x8{}, bf16x8{}}};
#define P2_LD(jj, PH, PS) do { const int jc_ = (jj) < NSUB - 1 ? (jj) : NSUB - 2; const int un_ = q * NSUB + chain_unit(dir, jc_); \
        const u32x4* ph_ = (const u32x4*)(ws + WS_HALF + H_PHI) + (size_t)un_ * 512 + lane; const u32x4* ps_ = (const u32x4*)(ws + WS_HALF + H_PSI) + (size_t)un_ * 512 + jv * 128 + lane; \
        _Pragma("unroll") for (int f = 0; f < 8; ++f) PH[f] = ph_[f * 64]; \
        PS[0] = ps_[0]; PS[1] = ps_[64]; PS[2] = ps_[256]; PS[3] = ps_[320]; } while (0)
#define P2_UNPK(A, p0, p1) do { A[0] = lo16(p0.x); A[1] = hi16(p0.x); A[2] = lo16(p0.y); A[3] = hi16(p0.y); A[4] = lo16(p0.z); A[5] = hi16(p0.z); A[6] = lo16(p0.w); A[7] = hi16(p0.w); \
        A[8] = lo16(p1.x); A[9] = hi16(p1.x); A[10] = lo16(p1.y); A[11] = hi16(p1.y); A[12] = lo16(p1.z); A[13] = hi16(p1.z); A[14] = lo16(p1.w); A[15] = hi16(p1.w); } while (0)
#define P2_STEP(jj, PH, PS) do { f32x16 a0, a1; P2_UNPK(a0, PS[0], PS[1]); P2_UNPK(a1, PS[2], PS[3]); \
        _Pragma("unroll") for (int Ip = 0; Ip < 2; ++Ip) { \
            a0 = RK_MF(__builtin_bit_cast(bf16x8, PH[(Ip * 2 + 0) * 2 + 0]), Hp[Ip][0], a0); a1 = RK_MF(__builtin_bit_cast(bf16x8, PH[(Ip * 2 + 1) * 2 + 0]), Hp[Ip][0], a1); \
            a0 = RK_MF(__builtin_bit_cast(bf16x8, PH[(Ip * 2 + 0) * 2 + 1]), Hp[Ip][1], a0); a1 = RK_MF(__builtin_bit_cast(bf16x8, PH[(Ip * 2 + 1) * 2 + 1]), Hp[Ip][1], a1); } \
        Hp[0][0] = pack<0>(a0); Hp[0][1] = pack<1>(a0); Hp[1][0] = pack<0>(a1); Hp[1][1] = pack<1>(a1); \
        u32x4* st_ = (u32x4*)(ws + WS_HALF + H_PSI) + (size_t)(q * NSUB + chain_unit(dir, (jj))) * 512 + jv * 128 + lane;        \
        st_[0] = __builtin_bit_cast(u32x4, Hp[0][0]); st_[64] = __builtin_bit_cast(u32x4, Hp[0][1]); st_[256] = __builtin_bit_cast(u32x4, Hp[1][0]); st_[320] = __builtin_bit_cast(u32x4, Hp[1][1]); } while (0)
    u32x4 phA[8], psA[4], phB[8], psB[4], phC[8], psC[4];
    P2_LD(0, phA, psA); P2_LD(1, phB, psB);
#pragma unroll 1
    for (int j = 0; j < NSUB - 1; j += 3) {
        P2_LD(j + 2, phC, psC); P2_STEP(j, phA, psA);
        P2_LD(j + 3, phA, psA); P2_STEP(j + 1, phB, psB);
        P2_LD(j + 4, phB, psB); P2_STEP(j + 2, phC, psC);
    }
#undef P2_LD
#undef P2_UNPK
#undef P2_STEP
}
RK_DI void pass3_dir(const int DIR, unsigned char* ws, LAS unsigned char* sb, int l, int bl, int hd, int c32, int lane, f32x16 (&Y)[2], float& bons) {
    Ctx c; setup_ctx(c, ws, sb, l, bl, hd, DIR, c32, lane);
    const int r = c.r, h = c.h;
    Tilde T; build_tilde<true>(c, T); __builtin_amdgcn_sched_barrier(0);
    bons += T.bon + __shfl_xor(T.bon, 32);
    bf16x8 Lk[2], Mp[2]; grams_la(c, T, Lk, Mp); __builtin_amdgcn_sched_barrier(0);
    bf16x8 Ab[2], Ak[2];
    {   f32x16 gb = f32x16{}, gk = f32x16{};
#pragma unroll
        for (int Ik = 0; Ik < 2; ++Ik)
#pragma unroll
            for (int S = 0; S < 2; ++S) { gb = RK_MF(T.Bt[Ik][S], T.Rt[Ik][S], gb); gk = RK_MF(T.Kt[Ik][S], T.Rt[Ik][S], gk); }
        tmask<false>(gb, r, h, DIR); tmask<false>(gk, r, h, DIR);
        Ab[0] = pack<0>(gb); Ab[1] = pack<1>(gb); Ak[0] = pack<0>(gk); Ak[1] = pack<1>(gk); }
    RK_STAGE(Ak[1]);
    bf16x8 H0p[2][2][2];
    { const int q = (bl * 8 + hd) * 2 + DIR, j = chain_pos(DIR, c32);
      if (j > 0) { const u32x4* st = (const u32x4*)(ws + WS_HALF + H_PSI) + (size_t)(q * NSUB + chain_unit(DIR, j - 1)) * 512 + lane;
#pragma unroll
          for (int I = 0; I < 2; ++I)
#pragma unroll
              for (int J = 0; J < 2; ++J) { H0p[I][J][0] = __builtin_bit_cast(bf16x8, st[((I * 2 + J) * 2 + 0) * 64]); H0p[I][J][1] = __builtin_bit_cast(bf16x8, st[((I * 2 + J) * 2 + 1) * 64]); } }
      else {
#pragma unroll
          for (int I = 0; I < 2; ++I)
#pragma unroll
              for (int J = 0; J < 2; ++J) { H0p[I][J][0] = bf16x8{}; H0p[I][J][1] = bf16x8{}; } } }
    bf16x8 Up[2][2];
    {   f32x16 xs[2];
#pragma unroll
        for (int Jv = 0; Jv < 2; ++Jv) {
            f32x16 x = RK_MF(Lk[0], T.Vp[Jv][0], f32x16{}); x = RK_MF(Lk[1], T.Vp[Jv][1], x);
#pragma unroll
            for (int Ik = 0; Ik < 2; ++Ik) { x = RK_MF(T.At[Ik][0], H0p[Ik][Jv][0], x); x = RK_MF(T.At[Ik][1], H0p[Ik][Jv][1], x); }
            xs[Jv] = x; }
        if (DIR) solve32p<1>(xs[0], xs[1], Mp); else solve32p<0>(xs[0], xs[1], Mp);
#pragma unroll
        for (int Jv = 0; Jv < 2; ++Jv) { Up[Jv][0] = pack<0>(xs[Jv]); Up[Jv][1] = pack<1>(xs[Jv]); }
        __builtin_amdgcn_sched_barrier(0); }
    __builtin_amdgcn_sched_barrier(0);
#pragma unroll
    for (int Iv = 0; Iv < 2; ++Iv) {
        f32x16 y = f32x16{};
#pragma unroll
        for (int Ik = 0; Ik < 2; ++Ik) { y = RK_MF(H0p[Ik][Iv][0], T.Rt[Ik][0], y); y = RK_MF(H0p[Ik][Iv][1], T.Rt[Ik][1], y); }
        y = RK_MF(Up[Iv][0], Ab[0], y); y = RK_MF(Up[Iv][1], Ab[1], y); y = RK_MF(T.Vp[Iv][0], Ak[0], y); y = RK_MF(T.Vp[Iv][1], Ak[1], y);
        Y[Iv] = y; }
}
RK_DI void pass3_unit(unsigned char* ws, LAS unsigned char* sb, int l, int v3, int lane, unsigned* ypark) {
    const int c32 = v3 % NSUB, bh = v3 / NSUB, bl = bh >> 3, hd = bh & 7, r = lane & 31, h = lane >> 5;
    float bons = 0.f;
    LAS float* ylds = (LAS float*)(sb + SBUF);
#pragma unroll 1
    for (int dir = 0; dir < 2; ++dir) {
        int lane_ = lane; asm volatile("" : "+v"(lane_));
        f32x16 Y[2]; pass3_dir(dir, ws, sb, l, bl, hd, c32, lane_, Y, bons);
        if (dir == 0) {
#pragma unroll
            for (int Iv = 0; Iv < 2; ++Iv)
#pragma unroll
                for (int d = 0; d < 8; ++d) ypark[(Iv * 8 + d) * 64 + lane] = cvt2(Y[Iv][2 * d], Y[Iv][2 * d + 1]); }
        else {
#pragma unroll
            for (int Iv = 0; Iv < 2; ++Iv)
#pragma unroll
                for (int reg = 0; reg < 16; ++reg) ylds[(Iv * 16 + reg) * 64 + lane] = Y[Iv][reg]; }
        __builtin_amdgcn_sched_barrier(0); }
    f32x16 YT[2];
#pragma unroll
    for (int Iv = 0; Iv < 2; ++Iv)
#pragma unroll
        for (int d = 0; d < 8; ++d) { const unsigned w = ypark[(Iv * 8 + d) * 64 + lane]; YT[Iv][2 * d] = ylds[(Iv * 16 + 2 * d) * 64 + lane] + lo16(w); YT[Iv][2 * d + 1] = ylds[(Iv * 16 + 2 * d + 1) * 64 + lane] + hi16(w); }
    Ctx c; setup_ctx(c, ws, sb, l, bl, hd, 0, c32, lane);
    RK_WAIT_LDS(); stage_slice(c, 1, RW_GD); stage_slice(c, 2, RW_GD + 64); RK_WAIT_DMA();
    float sm = 0.f;
#pragma unroll
    for (int Iv = 0; Iv < 2; ++Iv)
#pragma unroll
        for (int reg = 0; reg < 16; ++reg) sm += YT[Iv][reg];
    sm += __shfl_xor(sm, 32); const float mean = sm * (1.f / 64.f); float vq = 0.f;
#pragma unroll
    for (int Iv = 0; Iv < 2; ++Iv)
#pragma unroll
        for (int reg = 0; reg < 16; ++reg) { YT[Iv][reg] -= mean; vq += YT[Iv][reg] * YT[Iv][reg]; }
    vq += __shfl_xor(vq, 32); const float rstd = 1.f / sqrtf(vq * (1.f / 64.f) + LNX_EPS);
    const bf16* g2P = (const bf16*)(ws + WS_TAB + 524288) + (size_t)hd * 8192;
    const float* lnw = inp(I_LNW) + l * 512 + hd * 64; const float* lnb = inp(I_LNB) + l * 512 + hd * 64;
    bf16x8 sgp[4][2];
#pragma unroll
    for (int Ii = 0; Ii < 4; ++Ii) { f32x16 t = load_o2(c, 1 + (Ii >> 1), Ii & 1, RW_GD + 32 * Ii);
#pragma unroll
        for (int reg = 0; reg < 16; ++reg) t[reg] = sigm(t[reg]);
        sgp[Ii][0] = pack<0>(t); sgp[Ii][1] = pack<1>(t); __builtin_amdgcn_sched_barrier(0); }
    RK_WAIT_LDS(); LAS unsigned char* st = c.sb + SBUF;
#pragma unroll
    for (int Iv = 0; Iv < 2; ++Iv) {
        f32x16 gt = f32x16{};
#pragma unroll
        for (int Ii = 0; Ii < 4; ++Ii)
#pragma unroll
            for (int S = 0; S < 2; ++S) { gt = RK_MF(*(const bf16x8*)(g2P + ((Ii * 2 + Iv) * 2 + S) * 512 + c.lofs), sgp[Ii][S], gt); if (S) RK_STAGE(gt); }
        const f32x16 vt = load_o2(c, 0, Iv, RW_V + hd * 64 + 32 * Iv);
#pragma unroll
        for (int g = 0; g < 4; ++g) { const int v0 = 32 * Iv + 8 * g + 4 * h; const f32x4 lw = *(const f32x4*)(lnw + v0), lb = *(const f32x4*)(lnb + v0); float o[4];
#pragma unroll
            for (int j = 0; j < 4; ++j) { const int reg = 4 * g + j; o[j] = (YT[Iv][reg] * rstd * lw[j] + lb[j] + bons * vt[reg]) * gt[reg]; }
            *(LAS unsigned long long*)(st + r * 144 + 2 * v0) = (unsigned long long)cvt2(o[0], o[1]) | ((unsigned long long)cvt2(o[2], o[3]) << 32); }
    }
    asm volatile("s_waitcnt lgkmcnt(0)" ::: "memory");
    bf16* RO = (bf16*)(ws + WS_HALF + H_PP) + (size_t)c.m0 * PPW + C_QD + hd * 64;
#pragma unroll
    for (int i = 0; i < 4; ++i) { const int id = i * 64 + lane, row = id >> 3, ch = id & 7; const u32x4 v = *(const LAS u32x4*)(st + row * 144 + ch * 16); *(u32x4*)(RO + (size_t)row * PPW + ch * 8) = v; }
    asm volatile("s_waitcnt lgkmcnt(0)" ::: "memory");
}
}

__device__ __forceinline__ void ph_rwkv1(Frame& F, int l) {
    const int gw = F.bid * NWAVES + FWAVE(), NGW = F.G * NWAVES; LAS unsigned char* sb = F.lds + FWAVE() * (4 * rk::SBUF);
#pragma unroll 1
    for (int u = gw; u < NUNIT; u += NGW) rk::pass1_unit(F.ws, sb, l, u, otid() & 63);
    asm volatile("s_waitcnt vmcnt(0) lgkmcnt(0)" ::: "memory");
}
__device__ __forceinline__ void ph_rwkv3(Frame& F, int l, bool ctx_emit) {
    const int gw = F.bid * NWAVES + FWAVE(), NGW = F.G * NWAVES; LAS unsigned char* sb = F.lds + FWAVE() * (4 * rk::SBUF);
    unsigned* ypark = (unsigned*)(F.ws + WS_END) + (size_t)gw * 1024;
    const int per = ctx_emit ? rk::NSUB : rk::NSUB - 8, nun = 16 * per;
#pragma unroll 1
    for (int j = gw; j < nun; j += NGW) { const int v3 = (j / per) * rk::NSUB + (rk::NSUB - per) + j % per; rk::pass3_unit(F.ws, sb, l, v3, otid() & 63, ypark); }
    asm volatile("s_waitcnt vmcnt(0) lgkmcnt(0)" ::: "memory");
}
__device__ __forceinline__ void ph_mixer(Frame& F, int l, int half, int rep) {
    const bool ctx_out = (l == 0);
#ifdef EXTRA_P2
    if (F.bid < 4 && rep == 0) rk::pass2_chain(F.ws, F.bid * 8 + FWAVE(), otid() & 63, false);
#endif
    if (F.bid < 16 && rep == 0 && FWAVE() < 4) { const int ch = F.bid * 4 + FWAVE(); rk::pass2_half(F.ws, ch >> 1, ch & 1, otid() & 63); }
    __syncthreads();
    unsigned* ctr = F.ctl + CW_ATT + ((l * 2 + half) * 2 + rep) * 64;
    LAS unsigned* slot = (LAS unsigned*)(F.lds + MISC_OFF);
    const bf16* PP = (const bf16*)(F.ws + WS_HALF + H_PP); const bf16* QM = (const bf16*)(F.ws + WS_HALF + H_QM); const bf16* KVM = (const bf16*)(F.ws + WS_HALF + H_KVM);
    bf16* MO = (bf16*)(F.ws + WS_HALF + H_MO); bf16* DUM = (bf16*)(F.ws + WS_END);
    const int nunits = ctx_out ? 544 : 512;
    for (;;) {
        if (FTID() == 0) slot[0] = atomicAdd(ctr, 1u);
        __syncthreads();
        const int u = (int)slot[0];
        __syncthreads();
        if (u >= nunits) break;
        int type, bl, h, qb, nkeys, qrow0;
        if (u < 512) { type = u >> 8; const int v = u & 255; bl = v >> 7; h = (v >> 4) & 7; qb = v & 15; nkeys = RPB; qrow0 = bl * RPB + CTX + qb * 256; }
        else { const int v = u - 512; type = v >> 4; bl = (v >> 3) & 1; h = v & 7; qb = 0; nkeys = CTX; qrow0 = bl * RPB; }
        const int krow0 = bl * RPB;
        att::Args a;
        if (type == 0) {
            a.Q = QM + (size_t)qrow0 * 768 + h * 96; a.ldq = 768; a.K0 = KVM + (size_t)krow0 * 1024 + h * 128; a.ldk0 = 1024; a.K1 = PP + (size_t)krow0 * PPW + C_KR; a.ldk1 = PPW;
            a.V = KVM + (size_t)krow0 * 1024 + h * 128 + 64; a.ldv = 1024; a.O = (rep ? DUM : MO) + (size_t)qrow0 * 512 + h * 64; a.ldo = 512; a.nkeys = nkeys;
            a.rope_t0 = (u < 512) ? qb * 256 : -1; a.tc = (const float*)(F.ws + WS_T8C); a.ts = (const float*)(F.ws + WS_T8S);
            at96::Args b; b.Q = a.Q; b.ldq = a.ldq; b.K0 = a.K0; b.ldk0 = a.ldk0; b.K1 = a.K1; b.ldk1 = a.ldk1; b.V = a.V; b.ldv = a.ldv; b.O = a.O; b.ldo = a.ldo; b.nkeys = a.nkeys;
            b.rope_t0 = a.rope_t0; b.tc = a.tc; b.ts = a.ts;
            at96::unit(b, (char*)F.ldsg);
        } else {
            const int kvh = h >> 2;
            a.Q = PP + (size_t)qrow0 * PPW + C_GQ + h * 64; a.ldq = PPW; a.K0 = PP + (size_t)krow0 * PPW + C_GK + kvh * 64; a.ldk0 = PPW; a.K1 = a.K0; a.ldk1 = PPW;
            a.V = PP + (size_t)krow0 * PPW + C_GV + kvh * 64; a.ldv = PPW; a.O = rep ? DUM + (size_t)qrow0 * 512 + h * 64 : (bf16*)PP + (size_t)qrow0 * PPW + C_GQ + h * 64; a.ldo = rep ? 512 : PPW; a.nkeys = nkeys; a.rope_t0 = -1; a.tc = nullptr; a.ts = nullptr;
            at64::Args b; b.Q = a.Q; b.ldq = a.ldq; b.K = a.K0; b.ldk = a.ldk0; b.V = a.V; b.ldv = a.ldv; b.O = a.O; b.ldo = a.ldo; b.nkeys = a.nkeys;
            at64::unit(b, (char*)F.ldsg);
        }
    }
}

enum { OP_W0 = 0, OP_NORM1, OP_INPROJ, OP_PREP, OP_UP, OP_MIXER, OP_FINISH, OP_MERGE, OP_WOUT, OP_NORM2, OP_FFUP, OP_FFDOWN, OP_FINAL };
constexpr int N_PHASES = 36;
__global__ void __launch_bounds__(NWAVES * 64, 2) trunk_fwd(Args args) {
    extern __shared__ __attribute__((aligned(16))) unsigned char lds[];
    Frame F;
    F.lds = (LAS unsigned char*)lds; F.ldsg = lds;
    F.G = gridDim.x; F.bid = blockIdx.x; F.ws = args.ws; F.ctl = (unsigned*)(args.ws + WS_CTL); F.out = args.out;
    volatile LAS unsigned* MISC = (volatile LAS unsigned*)(F.lds + MISC_OFF);
    for (int u = threadIdx.x; u < 32; u += NWAVES * 64) MISC[u] = 0u;
    __syncthreads();
    const int lo = args.ph_lo, hi = args.ph_hi;
    XcdBarrier bar = xcd_barrier_post(F.ctl + CW_BAR, MISC + 8);
#ifdef EXTRA_OP
    for (int pp = 2 * lo; pp < 2 * hi; ++pp) { const int p = pp >> 1, rep = pp & 1;
#else
    for (int p = lo; p < hi; ++p) { const int rep = 0;
#endif
        GAS unsigned char* wsg_ = (GAS unsigned char*)args.ws; GAS float* outg_ = (GAS float*)args.out; int bid_ = blockIdx.x, G_ = gridDim.x;
        asm volatile("" : "+s"(wsg_), "+s"(outg_), "+s"(bid_), "+s"(G_));
        unsigned char* ws = (unsigned char*)wsg_; float* outp = (float*)outg_;
        F.ws = ws; F.out = outp; F.bid = bid_; F.G = G_; F.ctl = (unsigned*)(ws + WS_CTL);
        unsigned char* wt = ws + WS_WT; const bf16* XN = (const bf16*)(ws + WS_XN); float* ctxx = (float*)(ws + WS_CTXX);
        int op, l = 0, half = 0;
        if (p == 0) op = OP_W0; else if (p == N_PHASES - 1) op = OP_FINAL;
        else { const int q = p - 1, r = q % 17; l = q / 17; if (r == 0) op = OP_NORM1; else if (r <= 7) { half = 0; op = OP_INPROJ + (r - 1); } else if (r <= 13) { half = 1; op = OP_PREP + (r - 8); } else op = OP_NORM2 + (r - 14); }
#ifdef ONLY_OP
        op = ONLY_OP;
#endif
#ifdef EXTRA_OP
        if (rep && op != EXTRA_OP) continue;
#endif
        const float* xl = (l == 0) ? inp(I_X) : F.out; const float* xc = (l == 0) ? inp(I_CTX) : ctxx;
        const bool ctx_out = (l == 0);
        const int nMf = ctx_out ? 68 : 64, nMh = ctx_out ? 34 : 32, skipf = ctx_out ? 0 : 1;
        switch (op) {
        case OP_W0: ph_weights(F, 0); break;
        case OP_NORM1: if (l == 1) ph_weights(F, 1); ph_norm(F, l, xl, xc, inp(I_G1) + l * DM, 0, false, (l == 1) ? (const float*)(ws + WS_END) : nullptr); break;
#define RUN_INPROJ(hh) do { pg8::Gemm g_{XN + (size_t)(hh) * HM * DM, (const bf16*)(wt + WT_IN), DM, DM, DM}; pg8::TileOrder S_; S_.init(HM / 256, PPW / 256, F.G, F.bid, 0); \
            pg8::Epi<pg8::EPI_BF16> E_{}; E_.O = (bf16*)(ws + WS_HALF + H_PP); E_.ldc = PPW; pg8::gemm_phase<pg8::Epi<pg8::EPI_BF16>, pg8::TileOrder, true>(F.lds, g_, S_, E_); } while (0)
        case OP_INPROJ: RUN_INPROJ(half); break;
        case OP_PREP: if (rep == 0) ph_prep(F, l, half); ph_rwkv1(F, l); break;
        case OP_UP: {
            { pg8::Gemm g{(const bf16*)(ws + WS_HALF + H_PP) + C_QD, (const bf16*)(wt + WT_QU), PPW, 384, 384}; pg8::TileOrder S; S.init(HM / 256, 3, F.G, F.bid, 0);
              pg8::Epi<pg8::EPI_ROWSCALE> E{}; E.O = (bf16*)(ws + WS_HALF + H_QM); E.ldc = 768; E.rs = (const float*)(ws + WS_RSQ);
              pg8::gemm_phase<pg8::Epi<pg8::EPI_ROWSCALE>, pg8::TileOrder, true>(F.lds, g, S, E); }
            { pg8::Gemm g{(const bf16*)(ws + WS_HALF + H_PP) + C_KVD, (const bf16*)(wt + WT_KVU), PPW, 256, 256}; pg8::TileOrder S; S.init(HM / 256, 4, F.G, (F.bid + 102) % F.G, 0);
              pg8::Epi<pg8::EPI_ROWSCALE> E{}; E.O = (bf16*)(ws + WS_HALF + H_KVM); E.ldc = 1024; E.rs = (const float*)(ws + WS_RSKV);
              pg8::gemm_phase<pg8::Epi<pg8::EPI_ROWSCALE>, pg8::TileOrder, true>(F.lds, g, S, E); } } break;
        case OP_MIXER: ph_mixer(F, l, half, rep); break;
        case OP_FINISH: ph_rwkv3(F, l, ctx_out); break;
        case OP_MERGE: {
            { pg8::Gemm g{XN + (size_t)half * HM * DM, (const bf16*)(wt + WT_G), DM, DM, DM}; pg8::TileOrder S; S.init(nMh, 12, F.G, F.bid, skipf);
              pg8::Epi<pg8::EPI_SIGMOID> E{}; E.O = (bf16*)(ws + WS_GB); E.ldc = 3 * DM;
              pg8::gemm_phase<pg8::Epi<pg8::EPI_SIGMOID>, pg8::TileOrder, true>(F.lds, g, S, E); }
            xcd_barrier(bar);
            if (half == 0 && rep == 0 && F.bid >= nMh * 4) weight_items(F, l, WI_MIX, WI_ALL, (F.bid - nMh * 4) * NWAVES + FWAVE(), (F.G - nMh * 4) * NWAVES);
            for (int i = 0; i < 3; ++i) {
                const bf16* A = (i == 0) ? (const bf16*)(ws + WS_HALF + H_PP) + C_GQ : (i == 1) ? (const bf16*)(ws + WS_HALF + H_PP) + C_QD : (const bf16*)(ws + WS_HALF + H_MO);
                pg8::Gemm g{A, (const bf16*)(wt + WT_BR) + (size_t)i * DM * 512, (i == 2) ? 512 : PPW, 512, 512}; pg8::TileOrder S; S.init(nMh, 4, F.G, F.bid, skipf);
                pg8::Epi<pg8::EPI_GATEMUL> E{}; E.O = (bf16*)(ws + WS_MIX); E.ldc = DM; E.G = (const bf16*)(ws + WS_GB) + i * DM; E.ldg = 3 * DM; E.first = (i == 0);
                pg8::gemm_phase<pg8::Epi<pg8::EPI_GATEMUL>, pg8::TileOrder, true>(F.lds, g, S, E); }
            } break;
        case OP_WOUT: {
            pg8::Gemm g{(const bf16*)(ws + WS_MIX), (const bf16*)(wt + WT_OUT), DM, DM, DM}; pg8::TileOrder S; S.init(nMh, 4, F.G, F.bid, skipf);
            pg8::Epi<pg8::EPI_RESID> E{}; E.xsl = xl; E.xsc = xc; E.xdl = F.out; E.xdc = ctxx; E.gate = (const float*)(ws + WS_MOD) + (size_t)l * 5 * 6144 + 2048; E.pm_off = half * 34; E.part = nullptr; E.kslice = 1;
            pg8::gemm_phase<pg8::Epi<pg8::EPI_RESID>, pg8::TileOrder, true>(F.lds, g, S, E);
            if (half == 0) RUN_INPROJ(1);
            } break;
        case OP_NORM2: ph_norm(F, l, F.out, ctxx, inp(I_G2) + l * DM, 1, !ctx_out); break;
        case OP_FFUP: {
            pg8::Gemm g{XN, (const bf16*)(wt + WT_F1), DM, DM, DM}; pg8::TileOrder S; S.init(nMf, 16, F.G, F.bid, skipf);
            pg8::Epi<pg8::EPI_RELU2> E{}; E.O = (bf16*)(ws + WS_HID); E.ldc = DFF;
            pg8::gemm_phase<pg8::Epi<pg8::EPI_RELU2>, pg8::TileOrder, true>(F.lds, g, S, E); } break;
        case OP_FFDOWN: {
            pg8::Gemm g{(const bf16*)(ws + WS_HID), (const bf16*)(wt + WT_F2), DFF, DFF, DFF}; pg8::TileOrder S; S.init(64, 4, F.G, F.bid, 1);
            pg8::Epi<pg8::EPI_RESID> E{}; E.xsl = F.out; E.xsc = ctxx; E.xdl = F.out; E.xdc = ctxx; E.gate = (const float*)(ws + WS_MOD) + (size_t)l * 5 * 6144 + 5120; E.pm_off = 0; E.part = nullptr; E.kslice = 1;
            pg8::gemm_phase<pg8::Epi<pg8::EPI_RESID>, pg8::TileOrder, true>(F.lds, g, S, E);
            if (ctx_out) { pg8::Gemm g2{(const bf16*)(ws + WS_HID), (const bf16*)(wt + WT_F2), DFF, DFF, DFF / 4}; pg8::CtxSplitOrder S2; S2.init(F.G, F.bid, DFF / 4);
                E.part = (float*)(ws + WS_END); E.kslice = DFF / 4; pg8::gemm_phase<pg8::Epi<pg8::EPI_RESID>, pg8::CtxSplitOrder, true>(F.lds, g2, S2, E); } } break;
        default: ph_final(F); break;
        }
#ifdef EXTRA_OP
        if (pp + 1 < 2 * hi) xcd_barrier(bar);
#else
        if (p + 1 < hi) xcd_barrier(bar);
#endif
    }
}

extern "C" void kernel_launch(void* const* d_in, const int* in_sizes, int n_in, void* d_out, int out_size, void* d_ws, size_t ws_size, hipStream_t stream) {
    static int grid = 0;
    if (grid == 0) {
        if (n_in != 31 || out_size != NB * SEQ * DM || ws_size < WS_END + 12 * MiB) { fprintf(stderr, "kernel_launch: unexpected shapes (n_in %d out %d ws %zu, need ws >= %zu)\n", n_in, out_size, ws_size, (size_t)WS_END); grid = -1; return; }
        int dev = 0, cus = 0;
        if (hipGetDevice(&dev) != hipSuccess || hipDeviceGetAttribute(&cus, hipDeviceAttributeMultiprocessorCount, dev) != hipSuccess) { grid = -1; return; }
        if (hipFuncSetAttribute((const void*)trunk_fwd, hipFuncAttributeMaxDynamicSharedMemorySize, LDS_BYTES) != hipSuccess) { fprintf(stderr, "kernel_launch: hipFuncSetAttribute failed\n"); grid = -1; return; }
        grid = cus;
    }
    if (grid < 0) return;
    (void)hipMemsetAsync((char*)d_ws + WS_CTL, 0, CTL_BYTES, stream);
    Args a{};
    for (int i = 0; i < 31; ++i) a.in[i] = (const float*)d_in[i];
    a.out = (float*)d_out; a.ws = (unsigned char*)d_ws;
#if ONE_LAUNCH
    a.ph_lo = 0; a.ph_hi = N_PHASES;
    hipLaunchKernelGGL(trunk_fwd, dim3(grid), dim3(NWAVES * 64), LDS_BYTES, stream, a);
#else
    for (int p = 0; p < N_PHASES; ++p) { a.ph_lo = p; a.ph_hi = p + 1; hipLaunchKernelGGL(trunk_fwd, dim3(grid), dim3(NWAVES * 64), LDS_BYTES, stream, a); }
#endif
}
```

```cpp
#include <hip/hip_runtime.h>
#include <hip/hip_bf16.h>
#include <cstdio>
#include <cstdint>

#ifndef ONE_LAUNCH
#define ONE_LAUNCH 1
#define P2_WGS 8
#endif

constexpr int DM = 1024, NB = 4, SEQ = 4096, CTX = 256, RPB = SEQ + CTX  , MROWS = NB * RPB  , HM = 2 * RPB  ;
constexpr int NIN = 6432, PPW = 3584  , NGATE = 3072;
constexpr int C_GQ = 0, C_GK = 512, C_GV = 640, C_RW = 768, C_QD = 2688, C_KVD = 3072, C_KR = 3328, C_GATE = 3360;
constexpr int RW_R = 0, RW_K = 512, RW_V = 1024, RW_WD = 1536, RW_AD = 1664, RW_GD = 1792, RWIN = 1920;
constexpr int DFF = 4096;
constexpr float NORM_EPS = 1e-6f, LNX_EPS = 64e-5f;

__device__ __forceinline__ int otid() { int t = threadIdx.x; asm volatile("" : "+v"(t)); return t; }
namespace pg8 {
#define PG8_LAS __attribute__((address_space(3)))
typedef unsigned short bf16_t;
typedef short bf16x8 __attribute__((ext_vector_type(8)));
typedef float f32x4 __attribute__((ext_vector_type(4)));
typedef unsigned u32x4 __attribute__((ext_vector_type(4)));
constexpr int BM = 256, BK = 64, HALF = 128, HTB = HALF * BK * 2, STAGE_BYTES = 8 * HTB, NXCD = 8, WGM = 8;

__host__ __device__ __forceinline__ int lds_byte(int r, int c) { const int st = (r >> 4) * 2 + (c >> 5), rr = r & 15, cc = c & 31, ob = rr * 64 + cc * 2; return st * 1024 + (ob ^ (((ob >> 9) & 1) << 5)); }
__host__ __device__ __forceinline__ void stage_rc(int b, int& R, int& C) { const int st = b / 1024, sb = b % 1024, swz = sb ^ (((sb >> 9) & 1) << 5); R = (st >> 1) * 16 + swz / 64; C = (st & 1) * 32 + (swz % 64) / 2; }
__host__ __device__ __forceinline__ int perm32(int rho) { const int n = rho >> 4, i = rho & 15; return 8 * (i >> 2) + 4 * n + (i & 3); }

struct Unit { int pm, pn, ka; };
struct Gemm { const bf16_t* A; const bf16_t* Bt; int lda, ldb, K; };

struct TileOrder {
    int nM, nN, nwg, G, c, skipctx;
    __device__ void init(int nM_, int nN_, int G_, int c_, int skip_) { nM = nM_; nN = nN_; nwg = nM * nN; G = G_; c = c_; skipctx = skip_; }
    __device__ bool next(int i, Unit& u) const {
        const long L = (long)i * G + c; if (L >= nwg) return false;
        int wgid = (int)L; { const int q = nwg / NXCD, r = nwg % NXCD, xcd = wgid % NXCD, off = wgid / NXCD; wgid = (xcd < r ? xcd * (q + 1) : r * (q + 1) + (xcd - r) * q) + off; }
        const int nig = WGM * nN, gid = wgid / nig, fm = gid * WGM, gsz = (nM - fm) < WGM ? (nM - fm) : WGM;
        u.pm = fm + ((wgid % nig) % gsz); u.pn = (wgid % nig) / gsz; u.ka = 0;
        if (skipctx) u.pm = u.pm + u.pm / 16 + 1;
        return true;
    }
    __device__ __forceinline__ void a_ready(const Unit&) const {}
    __device__ __forceinline__ void done(const Unit&) const {}
};

struct CtxSplitOrder {
    int G, c, kslice;
    __device__ void init(int G_, int c_, int kslice_) { G = G_; c = c_; kslice = kslice_; }
    __device__ bool next(int i, Unit& u) const { const int L = i * G + c; if (L >= 64) return false; const int t = L >> 2; u.pm = (t >> 2) * 17; u.pn = t & 3; u.ka = (L & 3) * kslice; return true; }
    __device__ __forceinline__ void a_ready(const Unit&) const {}
    __device__ __forceinline__ void done(const Unit&) const {}
};
__device__ __forceinline__ unsigned cvt_pk_bf16(float lo, float hi) { unsigned r; asm volatile("v_cvt_pk_bf16_f32 %0, %1, %2" : "=v"(r) : "v"(lo), "v"(hi)); return r; }
__device__ __forceinline__ float bf_lo(unsigned w) { return __uint_as_float(w << 16); }
__device__ __forceinline__ float bf_hi(unsigned w) { return __uint_as_float(w & 0xffff0000u); }

enum { EPI_BF16 = 0, EPI_RELU2 = 1, EPI_SIGMOID = 2, EPI_ROWSCALE = 3, EPI_MLAQ = 4, EPI_GATEMUL0 = 5, EPI_GATEMUL = 6, EPI_RESID = 7 };
template <int MODE> struct Epi {
    static constexpr bool PERM = true, AFTER_DRAIN = false;
    bf16_t* O; int ldc;
    bf16_t* O1; bf16_t* O2;
    const float* rs;
    const bf16_t* G; int ldg;
    const float* tc; const float* ts;
    int first;
    int pm_off, kslice;
    float* part;
    const float* xsl; const float* xsc; float* xdl; float* xdc; const float* gate;
    __device__ __forceinline__ void operator()(const f32x4 (&acc)[2][2][4][2], const Unit& u, int wr, int wc, int fr, int fq) const {
        const int col0 = u.pn * BM + wc * 32 + 8 * fq;
        if constexpr (MODE == EPI_RESID) {
            const int gpm = u.pm + pm_off, b = gpm / 17, t = gpm % 17;
            const float* xs = (t == 0) ? xsc + (size_t)(b * CTX) * DM : xsl + (size_t)(b * SEQ + (t - 1) * 256) * DM;
            float* xd = (t == 0) ? xdc + (size_t)(b * CTX) * DM : xdl + (size_t)(b * SEQ + (t - 1) * 256) * DM;
            const float* gv = gate + (size_t)((t == 0) ? 4 : b) * 6144;
            f32x4 g[2][2];
#pragma unroll
            for (int bj = 0; bj < 2; ++bj)
#pragma unroll
                for (int n = 0; n < 2; ++n) g[bj][n] = *(const f32x4*)(gv + col0 + bj * HALF + 4 * n);
#pragma unroll
            for (int ai = 0; ai < 2; ++ai)
#pragma unroll
                for (int m = 0; m < 4; ++m) { const size_t ro = (size_t)(ai * HALF + wr * 64 + m * 16 + fr) * DM + col0;
#pragma unroll
                    for (int bj = 0; bj < 2; ++bj)
#pragma unroll
                        for (int n = 0; n < 2; ++n) {
                            if (u.ka != 0) *(f32x4*)(part + (size_t)(u.ka / kslice - 1) * 1048576 + (size_t)(b * CTX) * DM + ro + bj * HALF + 4 * n) = g[bj][n] * acc[ai][bj][m][n];
                            else { const f32x4 xv = *(const f32x4*)(xs + ro + bj * HALF + 4 * n);
                                *(f32x4*)(xd + ro + bj * HALF + 4 * n) = xv + g[bj][n] * acc[ai][bj][m][n]; } } }
        } else {
            const int row0 = u.pm * BM + wr * 64 + fr;
#pragma unroll
            for (int ai = 0; ai < 2; ++ai)
#pragma unroll
                for (int m = 0; m < 4; ++m) { const int row = row0 + ai * HALF + m * 16; bf16_t* rowp = O + (size_t)row * ldc + col0;
                    if constexpr (MODE == EPI_SIGMOID) { const int bi = u.pn >> 2; rowp += (long)(bi & 1) * (O1 - O) + (long)(bi >> 1) * (O2 - O) - bi * 4 * BM; }
                    float rsc = 1.f; int pr = 0, pc = 0; bool lat = false;
                    if constexpr (MODE == EPI_ROWSCALE || MODE == EPI_MLAQ) rsc = rs[row];
                    if constexpr (MODE == EPI_MLAQ) { const int s = row % RPB; lat = s >= CTX; const int tt = s - CTX; pr = (tt >> 6) & 63; pc = tt & 63; }
#pragma unroll
                    for (int bj = 0; bj < 2; ++bj) { f32x4 v0 = acc[ai][bj][m][0], v1 = acc[ai][bj][m][1];
                        if constexpr (MODE == EPI_RELU2) {
#pragma unroll
                            for (int e = 0; e < 4; ++e) { float a = fmaxf(v0[e], 0.f), b = fmaxf(v1[e], 0.f); v0[e] = a * a; v1[e] = b * b; } }
                        if constexpr (MODE == EPI_SIGMOID) {
#pragma unroll
                            for (int e = 0; e < 4; ++e) { v0[e] = 1.f / (1.f + __expf(-v0[e])); v1[e] = 1.f / (1.f + __expf(-v1[e])); } }
                        if constexpr (MODE == EPI_ROWSCALE || MODE == EPI_MLAQ) { v0 = v0 * rsc; v1 = v1 * rsc; }
                        if constexpr (MODE == EPI_MLAQ) {
                            const int g32 = u.pn * 8 + bj * 4 + wc;
                            if (g32 % 3 == 2) {
                                f32x4 p0, p1;
#pragma unroll
                                for (int e = 0; e < 4; ++e) { p0[e] = __shfl_xor(v0[e], 16); p1[e] = __shfl_xor(v1[e], 16); }
                                if (lat) { const int pos = (fq < 2) ? pr : pc; const f32x4 c0 = *(const f32x4*)(tc + pos * 8), c1 = *(const f32x4*)(tc + pos * 8 + 4), s0 = *(const f32x4*)(ts + pos * 8), s1 = *(const f32x4*)(ts + pos * 8 + 4);
                                    if ((fq & 1) == 0) { v0 = v0 * c0 - p0 * s0; v1 = v1 * c1 - p1 * s1; } else { v0 = p0 * s0 + v0 * c0; v1 = p1 * s1 + v1 * c1; } }
                            } }
                        if constexpr (MODE == EPI_GATEMUL0 || MODE == EPI_GATEMUL) {
                            const u32x4 gw = *(const u32x4*)(G + (size_t)row * ldg + col0 + bj * HALF);
                            v0[0] *= bf_lo(gw.x); v0[1] *= bf_hi(gw.x); v0[2] *= bf_lo(gw.y); v0[3] *= bf_hi(gw.y); v1[0] *= bf_lo(gw.z); v1[1] *= bf_hi(gw.z); v1[2] *= bf_lo(gw.w); v1[3] *= bf_hi(gw.w);
                            if (MODE == EPI_GATEMUL && !first) { const u32x4 ow = *(const u32x4*)(rowp + bj * HALF);
                                v0[0] += bf_lo(ow.x); v0[1] += bf_hi(ow.x); v0[2] += bf_lo(ow.y); v0[3] += bf_hi(ow.y); v1[0] += bf_lo(ow.z); v1[1] += bf_hi(ow.z); v1[2] += bf_lo(ow.w); v1[3] += bf_hi(ow.w); } }
                        u32x4 w; w.x = cvt_pk_bf16(v0[0], v0[1]); w.y = cvt_pk_bf16(v0[2], v0[3]); w.z = cvt_pk_bf16(v1[0], v1[1]); w.w = cvt_pk_bf16(v1[2], v1[3]);
                        *(u32x4*)(rowp + bj * HALF) = w; } }
        }
    }
};

template <class EpiT, class Sched, bool ALIGN_EPI>
__device__ __forceinline__ void gemm_phase(PG8_LAS unsigned char* lds, const Gemm g, const Sched& S, const EpiT& E) {
    const int tid = otid(), wid = __builtin_amdgcn_readfirstlane(tid >> 6), lane = tid & 63, wr = wid >> 2, wc = wid & 3, fr = lane & 15, fq = lane >> 4;
    const int nt = g.K / BK;
    unsigned voffA[2], voffB[2];
#pragma unroll
    for (int i = 0; i < 2; ++i) { int R, C; stage_rc(tid * 16 + i * 8192, R, C); const int Rb = EpiT::PERM ? ((R & ~31) + perm32(R & 31)) : R;
        voffA[i] = (unsigned)(R * g.lda + C) * 2u; voffB[i] = (unsigned)(Rb * g.ldb + C) * 2u; }
    const size_t kstep = (size_t)(BK * 2);
    const size_t hsA = (size_t)HALF * g.lda * 2, hsB = (size_t)HALF * g.ldb * 2, tsA = 2 * hsA, tsB = 2 * hsB;
    const unsigned ldsw = (unsigned)wid * 1024u;
    const int aoff = lds_byte(wr * 64 + fr, fq * 8), boff = lds_byte(wc * 32 + fr, fq * 8);
#define PG8_SA(b, h) (((b) * 2 + (h)) * HTB)
#define PG8_SB(b, h) ((4 + (b) * 2 + (h)) * HTB)
#define PG8_STAGE(bufoff, gbase, voff) do { _Pragma("unroll") for (int _i = 0; _i < 2; ++_i) \
        __builtin_amdgcn_global_load_lds((const unsigned*)((const char*)(gbase) + (voff)[_i]), (PG8_LAS unsigned*)(lds + (bufoff) + ldsw + _i * 8192), 16, 0, 0); } while (0)
#define PG8_LDA(dst, b, h) do { _Pragma("unroll") for (int m = 0; m < 4; ++m) _Pragma("unroll") for (int k = 0; k < 2; ++k) dst[m][k] = *(const PG8_LAS bf16x8*)(lds + PG8_SA(b, h) + aoff + m * 2048 + k * 1024); } while (0)
#define PG8_LDB(dst, b, h) do { _Pragma("unroll") for (int n = 0; n < 2; ++n) _Pragma("unroll") for (int k = 0; k < 2; ++k) dst[n][k] = *(const PG8_LAS bf16x8*)(lds + PG8_SB(b, h) + boff + n * 2048 + k * 1024); } while (0)
#define PG8_MMA(ai, bj, At, Bt) do { __builtin_amdgcn_s_setprio(1); _Pragma("unroll") for (int m = 0; m < 4; ++m) _Pragma("unroll") for (int n = 0; n < 2; ++n) _Pragma("unroll") for (int k = 0; k < 2; ++k) \
        acc[ai][bj][m][n] = __builtin_amdgcn_mfma_f32_16x16x32_bf16(Bt[n][k], At[m][k], acc[ai][bj][m][n], 0, 0, 0); __builtin_amdgcn_s_setprio(0); } while (0)
#define PG8_WAIT_V(n) asm volatile("s_waitcnt vmcnt(" #n ")" ::: "memory")
#define PG8_WAIT_L(n) asm volatile("s_waitcnt lgkmcnt(" #n ")" ::: "memory")
#define PG8_BAR __builtin_amdgcn_s_barrier()
#define PG8_SCHED __builtin_amdgcn_sched_barrier(0)
    Unit cur, nxt; int ui = 0;
    if (!S.next(0, cur)) return;
    f32x4 acc[2][2][4][2];
    float zf; asm volatile("v_mov_b32 %0, 0" : "=v"(zf));
#pragma unroll
    for (int a = 0; a < 2; ++a)
#pragma unroll
        for (int b = 0; b < 2; ++b)
#pragma unroll
            for (int m = 0; m < 4; ++m)
#pragma unroll
                for (int n = 0; n < 2; ++n) acc[a][b][m][n] = (f32x4){zf, zf, zf, zf};
    bf16x8 At[4][2], B0[2][2], B1[2][2];
    const char* cA = (const char*)g.A + (size_t)cur.pm * tsA + (size_t)cur.ka * 2; const char* cB = (const char*)g.Bt + (size_t)cur.pn * tsB + (size_t)cur.ka * 2;
    S.a_ready(cur);
    PG8_STAGE(PG8_SB(0, 0), cB, voffB); PG8_STAGE(PG8_SB(0, 1), cB + hsB, voffB); PG8_STAGE(PG8_SA(0, 0), cA, voffA); PG8_STAGE(PG8_SA(0, 1), cA + hsA, voffA);
    if (wr == 1) PG8_BAR;
    PG8_WAIT_V(2); PG8_BAR;
    PG8_STAGE(PG8_SB(1, 0), cB + kstep, voffB); PG8_STAGE(PG8_SA(1, 0), cA + kstep, voffA); PG8_STAGE(PG8_SB(1, 1), cB + hsB + kstep, voffB);
    PG8_WAIT_V(6); PG8_BAR;
    for (;;) {
        const bool has_next = S.next(ui + 1, nxt);
        const char* nA = has_next ? (const char*)g.A + (size_t)nxt.pm * tsA + (size_t)nxt.ka * 2 : cA; const char* nB = has_next ? (const char*)g.Bt + (size_t)nxt.pn * tsB + (size_t)nxt.ka * 2 : cB;
        for (int t = 0; t < nt; t += 2) {
            const bool last = (t == nt - 2);
            const char* a1 = cA + (size_t)(t + 1) * kstep;
            const char* a2 = last ? nA : cA + (size_t)(t + 2) * kstep; const char* b2 = last ? nB : cB + (size_t)(t + 2) * kstep;
            const char* a3 = a2 + kstep; const char* b3 = b2 + kstep;
            if (last && has_next) S.a_ready(nxt);
            PG8_LDB(B0, 0, 0); PG8_LDB(B1, 0, 1); PG8_SCHED; PG8_LDA(At, 0, 0); PG8_STAGE(PG8_SA(1, 1), a1 + hsA, voffA);
            PG8_WAIT_V(8); PG8_WAIT_L(0); PG8_BAR; PG8_MMA(0, 0, At, B0); PG8_MMA(0, 1, At, B1); PG8_BAR; PG8_SCHED;
            PG8_LDA(At, 0, 1); PG8_STAGE(PG8_SB(0, 0), b2, voffB); PG8_STAGE(PG8_SB(0, 1), b2 + hsB, voffB); PG8_STAGE(PG8_SA(0, 0), a2, voffA);
            PG8_WAIT_V(8); PG8_WAIT_L(0); PG8_BAR; PG8_MMA(1, 0, At, B0); PG8_MMA(1, 1, At, B1); PG8_BAR; PG8_SCHED;
            PG8_LDB(B0, 1, 0); PG8_LDB(B1, 1, 1); PG8_SCHED; PG8_LDA(At, 1, 0); PG8_STAGE(PG8_SA(0, 1), a2 + hsA, voffA);
            PG8_WAIT_V(8); PG8_WAIT_L(0); PG8_BAR; PG8_MMA(0, 0, At, B0); PG8_MMA(0, 1, At, B1); PG8_BAR; PG8_SCHED;
            PG8_LDA(At, 1, 1); PG8_STAGE(PG8_SB(1, 0), b3, voffB); PG8_STAGE(PG8_SB(1, 1), b3 + hsB, voffB); PG8_STAGE(PG8_SA(1, 0), a3, voffA);
            PG8_WAIT_V(8); PG8_WAIT_L(0); PG8_BAR; PG8_MMA(1, 0, At, B0); PG8_MMA(1, 1, At, B1); PG8_BAR; PG8_SCHED;
        }
        if constexpr (ALIGN_EPI) { if (wr == 0) PG8_BAR; }
        E(acc, cur, wr, wc, fr, fq); S.done(cur);
        if (!has_next) break;
        asm volatile("v_mov_b32 %0, 0" : "=v"(zf));
#pragma unroll
        for (int a = 0; a < 2; ++a)
#pragma unroll
            for (int b = 0; b < 2; ++b)
#pragma unroll
                for (int m = 0; m < 4; ++m)
#pragma unroll
                    for (int n = 0; n < 2; ++n) acc[a][b][m][n] = (f32x4){zf, zf, zf, zf};
        cur = nxt; cA = nA; cB = nB; ++ui;
        if constexpr (ALIGN_EPI) { if (wr == 1) PG8_BAR; }
    }
    PG8_WAIT_V(0);
    if constexpr (!ALIGN_EPI) { if (wr == 0) PG8_BAR; }
    PG8_BAR;
#undef PG8_SA
#undef PG8_SB
#undef PG8_STAGE
#undef PG8_LDA
#undef PG8_LDB
#undef PG8_MMA
#undef PG8_WAIT_V
#undef PG8_WAIT_L
#undef PG8_BAR
#undef PG8_SCHED
}
}

namespace att {
using bf16 = unsigned short;
using bf16x8 = __attribute__((ext_vector_type(8))) short;
using s16x4 = __attribute__((ext_vector_type(4))) short;
using f32x16 = __attribute__((ext_vector_type(16))) float;
using u32x4 = __attribute__((ext_vector_type(4))) unsigned;
constexpr int NW = 8, QBLK = 32, KVBLK = 64;
constexpr float THR = 8.f;
#define SBAR() __builtin_amdgcn_sched_barrier(0)
__device__ __forceinline__ int crow(int r, int hi) { return (r & 3) + 8 * (r >> 2) + 4 * hi; }
__device__ __forceinline__ unsigned cvtpk(float lo, float hi) { unsigned r; asm volatile("v_cvt_pk_bf16_f32 %0, %1, %2" : "=v"(r) : "v"(lo), "v"(hi)); return r; }
template <int DQ> __device__ __forceinline__ int kaddr(int row, int c) {
    if constexpr (DQ == 64) return row * 128 + ((c ^ ((row >> 1) & 7)) << 4); else return row * 208 + c * 16; }
template <int DQ> constexpr int ktile_bytes() { return DQ == 64 ? 64 * 128 : 64 * 208; }
constexpr int VTILE = 64 * 64 * 2;
template <int DQ> constexpr int lds_bytes() { return 2 * ktile_bytes<DQ>() + 2 * VTILE + NW * 64 * 4; }

template <bool FIRST> __device__ __forceinline__ void partialSM(f32x16& p0, f32x16& p1, f32x16& nm16, float& alpha) {
    float pmax = p0[0];
#pragma unroll
    for (int r = 1; r < 16; ++r) pmax = fmaxf(pmax, p0[r]);
#pragma unroll
    for (int r = 0; r < 16; ++r) pmax = fmaxf(pmax, p1[r]);
    { auto rr = __builtin_amdgcn_permlane32_swap(__float_as_uint(pmax), __float_as_uint(pmax), false, false);
      pmax = fmaxf(__uint_as_float(rr[0]), __uint_as_float(rr[1])); }
    alpha = 1.f;
    if (FIRST || !__builtin_expect(__all(pmax <= THR), 1)) {
        const float dl = FIRST ? pmax : fmaxf(pmax, 0.f); if (!FIRST) alpha = __builtin_amdgcn_exp2f(-dl);
#pragma unroll
        for (int r = 0; r < 16; ++r) { nm16[r] -= dl; p0[r] -= dl; p1[r] -= dl; } }
#pragma unroll
    for (int r = 0; r < 16; ++r) p0[r] = __builtin_amdgcn_exp2f(p0[r]);
}
__device__ __forceinline__ void finishSM(f32x16& p0, f32x16& p1, float alpha, float& l_reg, bf16x8& pa0, bf16x8& pa1, bf16x8& pa2, bf16x8& pa3) {
#pragma unroll
    for (int r = 0; r < 16; ++r) p1[r] = __builtin_amdgcn_exp2f(p1[r]);
    float ps = 0;
#pragma unroll
    for (int r = 0; r < 16; ++r) ps += p0[r];
#pragma unroll
    for (int r = 0; r < 16; ++r) ps += p1[r];
    { auto rr = __builtin_amdgcn_permlane32_swap(__float_as_uint(ps), __float_as_uint(ps), false, false);
      ps = __uint_as_float(rr[0]) + __uint_as_float(rr[1]); }
    l_reg = l_reg * alpha + ps;
#define PK4(P, BASE, OUT) do { unsigned a0 = cvtpk(P[BASE + 0], P[BASE + 1]), a1 = cvtpk(P[BASE + 2], P[BASE + 3]);   \
    unsigned b0 = cvtpk(P[BASE + 4], P[BASE + 5]), b1 = cvtpk(P[BASE + 6], P[BASE + 7]);                              \
    auto r0 = __builtin_amdgcn_permlane32_swap(a0, b0, false, false); auto r1 = __builtin_amdgcn_permlane32_swap(a1, b1, false, false); \
    u32x4 w = {r0[0], r1[0], r0[1], r1[1]}; OUT = *reinterpret_cast<bf16x8*>(&w); } while (0)
    PK4(p0, 0, pa0); PK4(p0, 8, pa1); PK4(p1, 0, pa2); PK4(p1, 8, pa3);
#undef PK4
}
template <int DQ> __device__ __forceinline__ void qkt(f32x16& p0, f32x16& p1, const char* Ks, const bf16x8* qr, int r32, int hi, const f32x16& nm16) {
    p0 = nm16; p1 = nm16;
#pragma unroll
    for (int d0 = 0; d0 < DQ / 16; ++d0) { const int c = d0 * 2 + hi;
        const bf16x8 b0 = *reinterpret_cast<const bf16x8*>(Ks + kaddr<DQ>(r32, c));
        const bf16x8 b1 = *reinterpret_cast<const bf16x8*>(Ks + kaddr<DQ>(32 + r32, c));
        p0 = __builtin_amdgcn_mfma_f32_32x32x16_bf16(b0, qr[d0], p0, 0, 0, 0);
        p1 = __builtin_amdgcn_mfma_f32_32x32x16_bf16(b1, qr[d0], p1, 0, 0, 0); }
}
__device__ __forceinline__ int v_st(int k, int c) { const int kk = (k & ~0xC) | ((k & 4) << 1) | ((k & 8) >> 1); return ((kk >> 3) * 2 + (c >> 5)) * 512 + ((kk & 7) * 32 + (c & 31)) * 2; }
__device__ __forceinline__ int v_rd_base(int lane) { return ((lane & 3) << 3) | (((lane >> 2) & 3) << 6) | (((lane >> 4) & 1) << 5) | (((lane >> 5) & 1) << 8); }
constexpr int v_rd_off(int d0, int ks, int half) { return d0 * 512 + ks * 2048 + half * 1024; }
template <int OFF> __device__ __forceinline__ s16x4 tr_read(int vb) { s16x4 r; asm volatile("ds_read_b64_tr_b16 %0, %1 offset:%2" : "=&v"(r) : "v"(vb), "i"(OFF) : "memory"); return r; }
template <int D0> __device__ __forceinline__ void pv_one(f32x16& od, int vb, bf16x8 pa0, bf16x8 pa1, bf16x8 pa2, bf16x8 pa3) {
    const s16x4 l0 = tr_read<v_rd_off(D0, 0, 0)>(vb), h0 = tr_read<v_rd_off(D0, 0, 1)>(vb), l1 = tr_read<v_rd_off(D0, 1, 0)>(vb), h1 = tr_read<v_rd_off(D0, 1, 1)>(vb);
    const s16x4 l2 = tr_read<v_rd_off(D0, 2, 0)>(vb), h2 = tr_read<v_rd_off(D0, 2, 1)>(vb), l3 = tr_read<v_rd_off(D0, 3, 0)>(vb), h3 = tr_read<v_rd_off(D0, 3, 1)>(vb);
    asm volatile("s_waitcnt lgkmcnt(0)" ::: "memory"); SBAR();
#define PK(L, H) (bf16x8){L[0], L[1], L[2], L[3], H[0], H[1], H[2], H[3]}
    od = __builtin_amdgcn_mfma_f32_32x32x16_bf16(pa0, PK(l0, h0), od, 0, 0, 0);
    od = __builtin_amdgcn_mfma_f32_32x32x16_bf16(pa1, PK(l1, h1), od, 0, 0, 0);
    od = __builtin_amdgcn_mfma_f32_32x32x16_bf16(pa2, PK(l2, h2), od, 0, 0, 0);
    od = __builtin_amdgcn_mfma_f32_32x32x16_bf16(pa3, PK(l3, h3), od, 0, 0, 0);
#undef PK
}
struct Args { const bf16* Q; int ldq; const bf16* K0; int ldk0; const bf16* K1; int ldk1; const bf16* V; int ldv; bf16* O; int ldo; int nkeys; int rope_t0; const float* tc; const float* ts; };
template <int DQ>
__device__ __forceinline__ void attn_unit(const Args a, char* lds) {
    constexpr int KT = ktile_bytes<DQ>(), NLD = (DQ == 64) ? 2 : 3;
    const int tid = otid(), wid = tid >> 6, lane = tid & 63, r32 = lane & 31, hi = lane >> 5;
    char* V_lds = lds; char* K_lds = lds + 2 * VTILE;
    float* ws = (float*)(lds + 2 * VTILE + 2 * KT) + wid * 64; float* li_l = ws; float* al_l = ws + 32;
    float l_reg = 0; f32x16 o[2] = {}; f32x16 nm16 = {}; bf16x8 qr[DQ / 16];
    const bf16* Qw = a.Q + (long)(wid * QBLK + r32) * a.ldq + hi * 8;
#pragma unroll
    for (int d0 = 0; d0 < DQ / 16; ++d0) qr[d0] = *reinterpret_cast<const bf16x8*>(Qw + d0 * 16);
    if constexpr (DQ == 96) { if (a.rope_t0 >= 0) {
        const int tq = a.rope_t0 + wid * QBLK + r32, pr = (tq >> 6) & 63, pc = tq & 63;
#pragma unroll
        for (int f = 4; f < 6; ++f) { const int pos = (f == 4) ? pr : pc; u32x4 w = *reinterpret_cast<u32x4*>(&qr[f]); u32x4 o;
#pragma unroll
            for (int e = 0; e < 4; ++e) { const unsigned mine = w[e], oth = (unsigned)__shfl_xor((int)mine, 32);
                const float m0 = __uint_as_float(mine << 16), m1 = __uint_as_float(mine & 0xffff0000u), o0 = __uint_as_float(oth << 16), o1 = __uint_as_float(oth & 0xffff0000u);
                const float c0 = a.tc[pos * 8 + 2 * e], c1 = a.tc[pos * 8 + 2 * e + 1], s0 = a.ts[pos * 8 + 2 * e], s1 = a.ts[pos * 8 + 2 * e + 1];
                const float r0 = (hi == 0) ? m0 * c0 - o0 * s0 : o0 * s0 + m0 * c0, r1 = (hi == 0) ? m1 * c1 - o1 * s1 : o1 * s1 + m1 * c1;
                o[e] = cvtpk(r0, r1); }
            qr[f] = *reinterpret_cast<bf16x8*>(&o); } } }
    const int vrow = tid >> 3, vcol = (tid & 7) * 8, vst = v_st(vrow, vcol);
    const bf16* vsrc = a.V + (long)vrow * a.ldv + vcol; const long vstep = (long)KVBLK * a.ldv;
    int kr0, kc0, kr1 = 0, kc1 = 0;
    if constexpr (DQ == 64) { kr0 = tid >> 3; kc0 = tid & 7; } else { kr0 = tid / 12; kc0 = tid % 12; const int id1 = 512 + (tid & 255); kr1 = id1 / 12; kc1 = id1 % 12; }
    const bf16* ksrc0 = (kc0 < 8) ? a.K0 + (long)kr0 * a.ldk0 + kc0 * 8 : a.K1 + (long)kr0 * a.ldk1 + (kc0 - 8) * 8; const long kstep0 = (long)KVBLK * ((kc0 < 8) ? a.ldk0 : a.ldk1);
    const bf16* ksrc1 = ksrc0; long kstep1 = kstep0;
    if constexpr (DQ == 96) { ksrc1 = (kc1 < 8) ? a.K0 + (long)kr1 * a.ldk0 + kc1 * 8 : a.K1 + (long)kr1 * a.ldk1 + (kc1 - 8) * 8; kstep1 = (long)KVBLK * ((kc1 < 8) ? a.ldk0 : a.ldk1); }
    const int kst0 = kaddr<DQ>(kr0, kc0), kst1 = kaddr<DQ>(kr1, kc1);
    const int vb0 = (int)(uintptr_t)V_lds + v_rd_base(lane);
    struct { bf16x8 vs, ks0, ks1; } sr_[2];
#define SLOAD(i, t) do { sr_[i].vs = *reinterpret_cast<const bf16x8*>(vsrc + (long)(t) * vstep); sr_[i].ks0 = *reinterpret_cast<const bf16x8*>(ksrc0 + (long)(t) * kstep0); \
    if constexpr (DQ == 96) sr_[i].ks1 = *reinterpret_cast<const bf16x8*>(ksrc1 + (long)(t) * kstep1); } while (0)
#define SWRITE(b, i) do { *(bf16x8*)(V_lds + (b) * VTILE + vst) = sr_[i].vs; *(bf16x8*)(K_lds + (b) * KT + kst0) = sr_[i].ks0; \
    if constexpr (DQ == 96) *(bf16x8*)(K_lds + (b) * KT + kst1) = sr_[i].ks1; } while (0)
#define SWAIT() do { if constexpr (NLD == 2) asm volatile("s_waitcnt vmcnt(2)" ::: "memory"); else asm volatile("s_waitcnt vmcnt(3)" ::: "memory"); } while (0)
#define RESC(al) do { if (__any((al) < 1.f)) { if (hi == 0) al_l[r32] = (al); asm volatile("s_waitcnt lgkmcnt(0)" ::: "memory"); \
    _Pragma("unroll") for (int d = 0; d < 2; ++d) _Pragma("unroll") for (int r = 0; r < 16; ++r) o[d][r] *= al_l[crow(r, hi)]; } } while (0)
    f32x16 pA0, pA1, pB0, pB1; float alA, alB; bf16x8 pa0, pa1, pa2, pa3; const int NT = a.nkeys / KVBLK;
    constexpr int SE = 0, SO = 1;
    SLOAD(SE, 0); asm volatile("s_waitcnt vmcnt(0)" ::: "memory"); SWRITE(0, SE); __syncthreads();
    qkt<DQ>(pA0, pA1, K_lds, qr, r32, hi, nm16); partialSM<true>(pA0, pA1, nm16, alA);
    SLOAD(SO, 1); if (2 < NT) SLOAD(SE, 2);
    SWAIT(); SWRITE(1, SO); __syncthreads();
    for (int j = 1; j + 1 < NT; j += 2) {
        SBAR(); qkt<DQ>(pB0, pB1, K_lds + KT, qr, r32, hi, nm16);
        finishSM(pA0, pA1, alA, l_reg, pa0, pa1, pa2, pa3); SBAR();
        SLOAD(SO, j + 2); SBAR();
        pv_one<0>(o[0], vb0, pa0, pa1, pa2, pa3); pv_one<1>(o[1], vb0, pa0, pa1, pa2, pa3); partialSM<false>(pB0, pB1, nm16, alB);
        __syncthreads(); SWAIT(); SWRITE(0, SE);
        RESC(alB); __syncthreads();
        SBAR(); qkt<DQ>(pA0, pA1, K_lds, qr, r32, hi, nm16);
        finishSM(pB0, pB1, alB, l_reg, pa0, pa1, pa2, pa3); SBAR();
        if (j + 3 < NT) SLOAD(SE, j + 3); SBAR();
        pv_one<0>(o[0], vb0 + VTILE, pa0, pa1, pa2, pa3); pv_one<1>(o[1], vb0 + VTILE, pa0, pa1, pa2, pa3); partialSM<false>(pA0, pA1, nm16, alA);
        __syncthreads(); SWAIT(); SWRITE(1, SO);
        RESC(alA); __syncthreads();
    }
    SBAR(); qkt<DQ>(pB0, pB1, K_lds + KT, qr, r32, hi, nm16);
    finishSM(pA0, pA1, alA, l_reg, pa0, pa1, pa2, pa3); SBAR();
    pv_one<0>(o[0], vb0, pa0, pa1, pa2, pa3); pv_one<1>(o[1], vb0, pa0, pa1, pa2, pa3); partialSM<false>(pB0, pB1, nm16, alB);
    __syncthreads(); RESC(alB);
    finishSM(pB0, pB1, alB, l_reg, pa0, pa1, pa2, pa3); SBAR();
    pv_one<0>(o[0], vb0 + VTILE, pa0, pa1, pa2, pa3); pv_one<1>(o[1], vb0 + VTILE, pa0, pa1, pa2, pa3);
    if (hi == 0) li_l[r32] = l_reg; asm volatile("s_waitcnt lgkmcnt(0)" ::: "memory");
    float rli[16];
#pragma unroll
    for (int r = 0; r < 16; ++r) rli[r] = __builtin_amdgcn_rcpf(li_l[crow(r, hi)]);
    __syncthreads();
    { unsigned short* stg = (unsigned short*)(lds) + wid * 2048;
#pragma unroll
      for (int r = 0; r < 16; ++r) { const int orow = crow(r, hi);
#pragma unroll
        for (int d0 = 0; d0 < 2; ++d0) { const float v = o[d0][r] * rli[r]; const unsigned u = __float_as_uint(v); stg[orow * 64 + d0 * 32 + r32] = (unsigned short)((u + 0x7fffu + ((u >> 16) & 1u)) >> 16); } }
      asm volatile("s_waitcnt lgkmcnt(0)" ::: "memory");
      bf16* Ow = a.O + (long)(wid * QBLK) * a.ldo;
#pragma unroll
      for (int i = 0; i < 4; ++i) { const int row = i * 8 + (lane >> 3), ch = lane & 7; const u32x4 v = *(const u32x4*)(stg + row * 64 + ch * 8); *(u32x4*)(Ow + (long)row * a.ldo + ch * 8) = v; } }
    __syncthreads();
#undef SLOAD
#undef SWRITE
#undef SWAIT
#undef RESC
}
#undef SBAR
}

namespace at64 {
using att::bf16; using att::bf16x8; using att::s16x4; using att::f32x16; using att::u32x4;
constexpr int NW = 8, QBLK = 32, KVBLK = 64;
constexpr float C2 = 0.125f * 1.4426950408889634f;
constexpr float THR = 8.f;
constexpr int SLOTB = 8192, LDS_K = 0, LDS_V = 3 * SLOTB, LDS_WS = 6 * SLOTB, LDS_OST = LDS_WS + NW * 256, LDS_TOT = LDS_OST + NW * 4096;
#define A6_SBAR() __builtin_amdgcn_sched_barrier(0)
#define A6_PIN(x) asm volatile("" : "+v"(x))
#define A6_MFMA(a, b, c) __builtin_amdgcn_mfma_f32_32x32x16_bf16(a, b, c, 0, 0, 0)
#define A6_WAIT_BAR(N) asm volatile("s_waitcnt vmcnt(" #N ") lgkmcnt(0)\n\ts_barrier" ::: "memory")
__device__ __forceinline__ int crow(int r, int hi) { return (r & 3) + 8 * (r >> 2) + 4 * hi; }
__device__ __forceinline__ unsigned cvtpk(float lo, float hi) { unsigned r; asm("v_cvt_pk_bf16_f32 %0, %1, %2" : "=v"(r) : "v"(lo), "v"(hi)); return r; }
__device__ __forceinline__ void glds16(const void* g, unsigned lds_base) {
    unsigned sv; asm volatile("s_mov_b32 %0, m0\n\ts_mov_b32 m0, %2\n\ts_nop 0\n\tglobal_load_lds_dwordx4 %1, off\n\ts_mov_b32 m0, %0" : "=&s"(sv) : "v"(g), "s"(lds_base) : "memory"); }
typedef __attribute__((address_space(3))) const char* lds_cptr;
typedef short v4i16_t __attribute__((ext_vector_type(4)));
__device__ __forceinline__ void kload2(bf16x8* kf, lds_cptr kp, int d0) { kf[2 * d0] = *(const __attribute__((address_space(3))) bf16x8*)(kp + d0 * 2048); kf[2 * d0 + 1] = *(const __attribute__((address_space(3))) bf16x8*)(kp + d0 * 2048 + 512); }
__device__ __forceinline__ s16x4 vtr(lds_cptr p) { return __builtin_bit_cast(s16x4, __builtin_amdgcn_ds_read_tr16_b64_v4i16((__attribute__((address_space(3))) v4i16_t*)p)); }
#define A6_MX3(a, b, c) __builtin_fmaxf(__builtin_fmaxf((a), (b)), (c))
__device__ __forceinline__ float rowmax(const f32x16& p0, const f32x16& p1) {
    float a = A6_MX3(p0[0], p0[1], p1[0]), b = A6_MX3(p0[2], p0[3], p1[1]); a = A6_MX3(a, p1[2], p1[3]);
#pragma unroll
    for (int r = 4; r < 16; r += 4) { a = A6_MX3(a, p0[r], p0[r + 1]); b = A6_MX3(b, p0[r + 2], p0[r + 3]); a = A6_MX3(a, p1[r], p1[r + 1]); b = A6_MX3(b, p1[r + 2], p1[r + 3]); }
    float m = __builtin_fmaxf(a, b); auto rr = __builtin_amdgcn_permlane32_swap(__float_as_uint(m), __float_as_uint(m), false, false);
    return __builtin_fmaxf(__uint_as_float(rr[0]), __uint_as_float(rr[1])); }
struct Args { const bf16* Q; int ldq; const bf16* K; int ldk; const bf16* V; int ldv; bf16* O; int ldo; int nkeys; };
__device__ __forceinline__ void unit(const Args a, char* lds) {
    const int tid = otid(), lane = tid & 63, r32 = lane & 31, hi = lane >> 5; const int wid = __builtin_amdgcn_readfirstlane(tid >> 6);
    const int NT = a.nkeys / KVBLK;
    const bf16* Qw = a.Q + (long)(wid * QBLK) * a.ldq;
    const unsigned lds0 = (unsigned)(uintptr_t)lds; float* wsf = (float*)(lds + LDS_WS) + wid * 64;
    const bf16* ksrc = a.K + (long)lane * a.ldk + wid * 8; const long kstep = (long)KVBLK * a.ldk;
    const bf16* vsrc = a.V + (long)(16 * (wid & 3) + (lane >> 2)) * a.ldv + (wid >> 2) * 32 + (lane & 3) * 8; const long vstep = (long)KVBLK * a.ldv;
    const unsigned kdst = lds0 + LDS_K + wid * 1024, vdst = lds0 + LDS_V + wid * 1024;
#define DMA_K(t, slot) glds16(ksrc + (long)(t) * kstep, (unsigned)__builtin_amdgcn_readfirstlane(kdst + (slot)))
#define DMA_V(t, slot) glds16(vsrc + (long)(t) * vstep, (unsigned)__builtin_amdgcn_readfirstlane(vdst + (slot)))
    const lds_cptr vp0 = (lds_cptr)lds + LDS_V + ((lane >> 4) & 1) * 32 + (lane & 3) * 8 + (4 * hi + ((lane & 15) >> 2)) * 64;
    const lds_cptr kp0 = (lds_cptr)lds + LDS_K + hi * 1024 + r32 * 16;
    DMA_K(0, 0); DMA_V(0, 0); DMA_K(1, SLOTB);
    bf16x8 qr[4];
#pragma unroll
    for (int d0 = 0; d0 < 4; ++d0) qr[d0] = *reinterpret_cast<const bf16x8*>(&Qw[(long)r32 * a.ldq + d0 * 16 + hi * 8]);
    float l_reg = 0.f; f32x16 o[2]; o[0] = f32x16{}; o[1] = f32x16{};
    f32x16 nmh16 = f32x16{}; A6_PIN(nmh16);
    bool resc = false;
    f32x16 pA0, pA1, pB0, pB1; bf16x8 kf[8]; s16x4 vlo[8], vhi[8]; u32x4 pw0, pw1, pw2, pw3;
    int sl_prev = 0, sl_cur = 0, sl_next = SLOTB;
#define ROT() do { sl_prev = sl_cur; sl_cur = sl_next; sl_next = (sl_next == 2 * SLOTB) ? 0 : sl_next + SLOTB; } while (0)
#define EX(v) __builtin_amdgcn_exp2f(v)
#define RESC() do { if (resc) { _Pragma("unroll") for (int d_ = 0; d_ < 2; ++d_) _Pragma("unroll") for (int r = 0; r < 16; ++r) o[d_][r] *= wsf[crow(r, hi)]; } } while (0)
    DMA_K(2, 2 * SLOTB);
    A6_WAIT_BAR(3);
    _Pragma("unroll") for (int d0 = 0; d0 < 4; ++d0) kload2(kf, kp0, d0);
    pA0 = A6_MFMA(kf[0], qr[0], nmh16); pA1 = A6_MFMA(kf[1], qr[0], nmh16); pA0 = A6_MFMA(kf[2], qr[1], pA0); pA1 = A6_MFMA(kf[3], qr[1], pA1);
    pA0 = A6_MFMA(kf[4], qr[2], pA0); pA1 = A6_MFMA(kf[5], qr[2], pA1); pA0 = A6_MFMA(kf[6], qr[3], pA0); pA1 = A6_MFMA(kf[7], qr[3], pA1);
    { const float rm = rowmax(pA0, pA1);
#pragma unroll
      for (int r = 0; r < 16; ++r) { nmh16[r] = -rm; pA0[r] = EX(pA0[r] - rm); pA1[r] = EX(pA1[r] - rm); } }
    A6_WAIT_BAR(0);
    DMA_K(3, 0); DMA_V(1, SLOTB); ROT();
    _Pragma("unroll") for (int d0 = 0; d0 < 4; ++d0) kload2(kf, kp0 + sl_cur, d0);
    A6_WAIT_BAR(2);
#define PKW(P, i) cvtpk(P[i], P[i + 1])
#define PAF(k) __builtin_bit_cast(bf16x8, pw##k)
#define VFR(i) (bf16x8){vlo[i][0], vlo[i][1], vlo[i][2], vlo[i][3], vhi[i][0], vhi[i][1], vhi[i][2], vhi[i][3]}
#define VRD(i) do { vlo[i] = vtr(vp_ + (((i) >> 2) * 4096 + ((i) & 3) * 1024)); vhi[i] = vtr(vp_ + (((i) >> 2) * 4096 + ((i) & 3) * 1024 + 512)); } while (0)
#define KRD(G, d0) do { if (G) { kload2(kf, kp0 + sl_next, d0); A6_SBAR(); } } while (0)
#define GAPA(MF, a0, a1, a2, a3, W0, W1, PW) do { MF; sacc += a0; sacc += a1; sacc += a2; sacc += a3; W0; W1; A6_PIN(PW); A6_PIN(sacc); A6_SBAR(); } while (0)
#define GAPB(MF, X, i) do { MF; X[i] = EX(X[i]); X[i + 1] = EX(X[i + 1]); X[i + 2] = EX(X[i + 2]); X[i + 3] = EX(X[i + 3]); A6_PIN(X); A6_SBAR(); } while (0)
#define STEP(C0, C1, P0, P1, t, GK, GV, GL) do { A6_SBAR(); \
    const lds_cptr vp_ = vp0 + sl_prev; \
    VRD(0); A6_SBAR(); float sacc = P0[0] + P0[1]; \
                       GAPA(C0 = A6_MFMA(kf[0], qr[0], nmh16), P0[2], P0[3], P0[4], P0[5],     pw0[0] = PKW(P0, 0),  pw0[1] = PKW(P0, 2),  pw0); \
    VRD(4); A6_SBAR(); GAPA(C1 = A6_MFMA(kf[1], qr[0], nmh16), P0[6], P0[7], P0[8], P0[9],     pw0[2] = PKW(P0, 4),  pw0[3] = PKW(P0, 6),  pw0); \
    VRD(1); A6_SBAR(); GAPA(C0 = A6_MFMA(kf[2], qr[1], C0),    P0[10], P0[11], P0[12], P0[13], pw1[0] = PKW(P0, 8),  pw1[1] = PKW(P0, 10), pw1); \
    VRD(5); A6_SBAR(); GAPA(C1 = A6_MFMA(kf[3], qr[1], C1),    P0[14], P0[15], P1[0], P1[1],   pw1[2] = PKW(P0, 12), pw1[3] = PKW(P0, 14), pw1); \
    VRD(2); A6_SBAR(); GAPA(C0 = A6_MFMA(kf[4], qr[2], C0),    P1[2], P1[3], P1[4], P1[5],     pw2[0] = PKW(P1, 0),  pw2[1] = PKW(P1, 2),  pw2); \
    VRD(6); A6_SBAR(); GAPA(C1 = A6_MFMA(kf[5], qr[2], C1),    P1[6], P1[7], P1[8], P1[9],     pw2[2] = PKW(P1, 4),  pw2[3] = PKW(P1, 6),  pw2); \
    VRD(3); A6_SBAR(); GAPA(C0 = A6_MFMA(kf[6], qr[3], C0),    P1[10], P1[11], P1[12], P1[13], pw3[0] = PKW(P1, 8),  pw3[1] = PKW(P1, 10), pw3); \
    VRD(7); A6_SBAR(); GAPA(C1 = A6_MFMA(kf[7], qr[3], C1),    P1[14], P1[15], 0.f, 0.f,       pw3[2] = PKW(P1, 12), pw3[3] = PKW(P1, 14), pw3); \
    l_reg += sacc; \
    if (GK) DMA_K((t) + 3, sl_cur); if (GV) DMA_V((t) + 1, sl_next); \
    { const float rm = rowmax(C0, C1); resc = false; \
      if (__builtin_expect(__any(rm > THR), 0)) { const float dl = __builtin_fmaxf(rm, 0.f); \
          _Pragma("unroll") for (int r_ = 0; r_ < 16; ++r_) { nmh16[r_] -= dl; C0[r_] -= dl; C1[r_] -= dl; } \
          const float f = __builtin_amdgcn_exp2f(-dl); l_reg *= f; if (hi == 0) wsf[r32] = f; resc = true; } } \
    A6_SBAR(); \
    GAPB(o[0] = A6_MFMA(PAF(0), VFR(0), o[0]), C0, 0);              GAPB(o[1] = A6_MFMA(PAF(0), VFR(4), o[1]), C0, 4); \
    KRD(GL, 0); GAPB(o[0] = A6_MFMA(PAF(1), VFR(1), o[0]), C0, 8);  KRD(GL, 1); GAPB(o[1] = A6_MFMA(PAF(1), VFR(5), o[1]), C0, 12); \
    KRD(GL, 2); GAPB(o[0] = A6_MFMA(PAF(2), VFR(2), o[0]), C1, 0);  KRD(GL, 3); GAPB(o[1] = A6_MFMA(PAF(2), VFR(6), o[1]), C1, 4); \
    GAPB(o[0] = A6_MFMA(PAF(3), VFR(3), o[0]), C1, 8);              GAPB(o[1] = A6_MFMA(PAF(3), VFR(7), o[1]), C1, 12); \
    } while (0)
    int t = 1;
    for (; t + 5 < NT; t += 2) {
        STEP(pB0, pB1, pA0, pA1, t, true, true, true);     A6_WAIT_BAR(2); RESC(); ROT();
        STEP(pA0, pA1, pB0, pB1, t + 1, true, true, true); A6_WAIT_BAR(2); RESC(); ROT();
    }
#define ENDW(tt) do { if ((tt) + 3 < NT) { A6_WAIT_BAR(2); } else if ((tt) + 2 < NT) { A6_WAIT_BAR(1); } else { A6_WAIT_BAR(0); } } while (0)
    for (; t + 1 < NT; t += 2) {
        STEP(pB0, pB1, pA0, pA1, t, (t + 3 < NT), (t + 1 < NT), (t + 1 < NT));         ENDW(t);     RESC(); ROT();
        STEP(pA0, pA1, pB0, pB1, t + 1, (t + 4 < NT), (t + 2 < NT), (t + 2 < NT));     ENDW(t + 1); RESC(); ROT();
    }
    STEP(pB0, pB1, pA0, pA1, NT - 1, false, false, false); RESC();
    { float sacc = pB0[0] + pB0[1];
#pragma unroll
      for (int r = 2; r < 16; ++r) sacc += pB0[r];
#pragma unroll
      for (int r = 0; r < 16; ++r) sacc += pB1[r];
      l_reg += sacc;
      pw0 = (u32x4){PKW(pB0, 0), PKW(pB0, 2), PKW(pB0, 4), PKW(pB0, 6)}; pw1 = (u32x4){PKW(pB0, 8), PKW(pB0, 10), PKW(pB0, 12), PKW(pB0, 14)};
      pw2 = (u32x4){PKW(pB1, 0), PKW(pB1, 2), PKW(pB1, 4), PKW(pB1, 6)}; pw3 = (u32x4){PKW(pB1, 8), PKW(pB1, 10), PKW(pB1, 12), PKW(pB1, 14)};
      const lds_cptr vp_ = vp0 + sl_cur; _Pragma("unroll") for (int i = 0; i < 8; ++i) VRD(i);
      o[0] = A6_MFMA(PAF(0), VFR(0), o[0]); o[1] = A6_MFMA(PAF(0), VFR(4), o[1]); o[0] = A6_MFMA(PAF(1), VFR(1), o[0]); o[1] = A6_MFMA(PAF(1), VFR(5), o[1]);
      o[0] = A6_MFMA(PAF(2), VFR(2), o[0]); o[1] = A6_MFMA(PAF(2), VFR(6), o[1]); o[0] = A6_MFMA(PAF(3), VFR(3), o[0]); o[1] = A6_MFMA(PAF(3), VFR(7), o[1]); }
    { auto rr = __builtin_amdgcn_permlane32_swap(__float_as_uint(l_reg), __float_as_uint(l_reg), false, false); l_reg = __uint_as_float(rr[0]) + __uint_as_float(rr[1]); }
    if (hi == 0) wsf[32 + r32] = l_reg; asm volatile("s_waitcnt lgkmcnt(0)" ::: "memory");
    float rli[16];
#pragma unroll
    for (int r = 0; r < 16; ++r) rli[r] = __builtin_amdgcn_rcpf(wsf[32 + crow(r, hi)]);
    bf16* Ow = a.O + (long)(wid * QBLK) * a.ldo; unsigned short* stg = (unsigned short*)(lds + LDS_OST) + wid * 2048;
#pragma unroll
    for (int r = 0; r < 16; ++r) { const int orow = crow(r, hi);
#pragma unroll
        for (int d0 = 0; d0 < 2; ++d0) { const float v = o[d0][r] * rli[r]; const unsigned u = __float_as_uint(v); stg[orow * 64 + d0 * 32 + r32] = (unsigned short)((u + 0x7fffu + ((u >> 16) & 1u)) >> 16); } }
    asm volatile("s_waitcnt lgkmcnt(0)" ::: "memory");
#pragma unroll
    for (int i = 0; i < 4; ++i) { const int row = i * 8 + (lane >> 3), ch = lane & 7; *(u32x4*)(Ow + (long)row * a.ldo + ch * 8) = *(const u32x4*)(stg + row * 64 + ch * 8); }
    asm volatile("s_waitcnt lgkmcnt(0)\n\ts_barrier" ::: "memory");
#undef DMA_K
#undef DMA_V
#undef ROT
#undef EX
#undef RESC
#undef PKW
#undef PAF
#undef VFR
#undef VRD
#undef KRD
#undef ENDW
#undef GAPA
#undef GAPB
#undef STEP
}
#undef A6_SBAR
#undef A6_PIN
#undef A6_MFMA
#undef A6_WAIT_BAR
#undef A6_MX3
}

namespace at96 {
using att::bf16; using att::bf16x8; using att::s16x4; using att::f32x16; using att::u32x4;
using at64::crow; using at64::cvtpk; using at64::glds16; using at64::lds_cptr; using at64::kload2; using at64::vtr; using at64::rowmax;
constexpr int NW = 8, QBLK = 32, KVBLK = 64;
constexpr float THR = 8.f;
constexpr int SLOTB = 8192, SLOTR = 4096, LDS_K = 0, LDS_V = 3 * SLOTB, LDS_R = 6 * SLOTB, LDS_WS = LDS_R + 4 * SLOTR, LDS_OST = LDS_WS + NW * 256, LDS_TOT = LDS_OST + NW * 4096;
#define A9_SBAR() __builtin_amdgcn_sched_barrier(0)
#define A9_PIN(x) asm volatile("" : "+v"(x))
#define A9_MFMA(a, b, c) __builtin_amdgcn_mfma_f32_32x32x16_bf16(a, b, c, 0, 0, 0)
#define A9_WAIT_BAR(N) asm volatile("s_waitcnt vmcnt(" #N ") lgkmcnt(0)\n\ts_barrier" ::: "memory")
struct Args { const bf16* Q; int ldq; const bf16* K0; int ldk0; const bf16* K1; int ldk1; const bf16* V; int ldv; bf16* O; int ldo; int nkeys; int rope_t0; const float* tc; const float* ts; };
__device__ __forceinline__ void unit(const Args a, char* lds) {
    const int tid = otid(), lane = tid & 63, r32 = lane & 31, hi = lane >> 5; const int wid = __builtin_amdgcn_readfirstlane(tid >> 6);
    const int NT = a.nkeys / KVBLK;
    const bf16* Qw = a.Q + (long)(wid * QBLK) * a.ldq;
    const unsigned lds0 = (unsigned)(uintptr_t)lds; float* wsf = (float*)(lds + LDS_WS) + wid * 64;
    const bf16* ksrc = a.K0 + (long)lane * a.ldk0 + wid * 8; const long kstep = (long)KVBLK * a.ldk0;
    const bf16* rsrc = a.K1 + (long)(32 * (wid & 1) + r32) * a.ldk1 + (wid >> 1) * 8; const long rstep = (long)KVBLK * a.ldk1;
    const bf16* vsrc = a.V + (long)(16 * (wid & 3) + (lane >> 2)) * a.ldv + (wid >> 2) * 32 + (lane & 3) * 8; const long vstep = (long)KVBLK * a.ldv;
    const unsigned kdst = lds0 + LDS_K + wid * 1024, vdst = lds0 + LDS_V + wid * 1024, rdst = lds0 + LDS_R + (wid >> 1) * 1024 + (wid & 1) * 512;
#define DMA_K(t, slot, rslot) do { glds16(ksrc + (long)(t) * kstep, (unsigned)__builtin_amdgcn_readfirstlane(kdst + (slot))); \
        if (lane < 32) glds16(rsrc + (long)(t) * rstep, (unsigned)__builtin_amdgcn_readfirstlane(rdst + (rslot))); } while (0)
#define DMA_V(t, slot) glds16(vsrc + (long)(t) * vstep, (unsigned)__builtin_amdgcn_readfirstlane(vdst + (slot)))
    const lds_cptr vp0 = (lds_cptr)lds + LDS_V + ((lane >> 4) & 1) * 32 + (lane & 3) * 8 + (4 * hi + ((lane & 15) >> 2)) * 64;
    const lds_cptr kp0 = (lds_cptr)lds + LDS_K + hi * 1024 + r32 * 16;
    const lds_cptr rp0 = (lds_cptr)lds + LDS_R + hi * 1024 + r32 * 16;
    DMA_K(0, 0, 0); DMA_V(0, 0); DMA_K(1, SLOTB, SLOTR);
    bf16x8 qr[6];
#pragma unroll
    for (int d0 = 0; d0 < 6; ++d0) qr[d0] = *reinterpret_cast<const bf16x8*>(&Qw[(long)r32 * a.ldq + d0 * 16 + hi * 8]);
    if (a.rope_t0 >= 0) {
        const int tq = a.rope_t0 + wid * QBLK + r32, pr = (tq >> 6) & 63, pc = tq & 63;
#pragma unroll
        for (int f = 4; f < 6; ++f) { const int pos = (f == 4) ? pr : pc; u32x4 w = *reinterpret_cast<u32x4*>(&qr[f]); u32x4 o_;
#pragma unroll
            for (int e = 0; e < 4; ++e) { const unsigned mine = w[e], oth = (unsigned)__shfl_xor((int)mine, 32);
                const float m0 = __uint_as_float(mine << 16), m1 = __uint_as_float(mine & 0xffff0000u), o0 = __uint_as_float(oth << 16), o1 = __uint_as_float(oth & 0xffff0000u);
                const float c0 = a.tc[pos * 8 + 2 * e], c1 = a.tc[pos * 8 + 2 * e + 1], s0 = a.ts[pos * 8 + 2 * e], s1 = a.ts[pos * 8 + 2 * e + 1];
                const float r0 = (hi == 0) ? m0 * c0 - o0 * s0 : o0 * s0 + m0 * c0, r1 = (hi == 0) ? m1 * c1 - o1 * s1 : o1 * s1 + m1 * c1;
                o_[e] = cvtpk(r0, r1); }
            qr[f] = *reinterpret_cast<bf16x8*>(&o_); } }
    float l_reg = 0.f; f32x16 o[2]; o[0] = f32x16{}; o[1] = f32x16{};
    f32x16 nmh16 = f32x16{}; A9_PIN(nmh16);
    bool resc = false;
    f32x16 pA0, pA1, pB0, pB1; bf16x8 kf[8], kr[4]; s16x4 vlo[8], vhi[8]; u32x4 pw0, pw1, pw2, pw3;
    int sl_prev = 0, sl_cur = 0, sl_next = SLOTB, rs_cur = 0;
#define ROT() do { sl_prev = sl_cur; sl_cur = sl_next; sl_next = (sl_next == 2 * SLOTB) ? 0 : sl_next + SLOTB; rs_cur = (rs_cur + SLOTR) & (4 * SLOTR - 1); } while (0)
#define RS3() ((rs_cur + 3 * SLOTR) & (4 * SLOTR - 1))
#define EX(v) __builtin_amdgcn_exp2f(v)
#define RESC() do { if (resc) { _Pragma("unroll") for (int d_ = 0; d_ < 2; ++d_) _Pragma("unroll") for (int r = 0; r < 16; ++r) o[d_][r] *= wsf[crow(r, hi)]; } } while (0)
    DMA_K(2, 2 * SLOTB, 2 * SLOTR);
    A9_WAIT_BAR(5);
    _Pragma("unroll") for (int d0 = 0; d0 < 4; ++d0) kload2(kf, kp0, d0);
    kload2(kr, rp0, 0); kload2(kr, rp0, 1);
    pA0 = A9_MFMA(kf[0], qr[0], nmh16); pA1 = A9_MFMA(kf[1], qr[0], nmh16); pA0 = A9_MFMA(kf[2], qr[1], pA0); pA1 = A9_MFMA(kf[3], qr[1], pA1);
    pA0 = A9_MFMA(kf[4], qr[2], pA0); pA1 = A9_MFMA(kf[5], qr[2], pA1); pA0 = A9_MFMA(kf[6], qr[3], pA0); pA1 = A9_MFMA(kf[7], qr[3], pA1);
    pA0 = A9_MFMA(kr[0], qr[4], pA0); pA1 = A9_MFMA(kr[1], qr[4], pA1); pA0 = A9_MFMA(kr[2], qr[5], pA0); pA1 = A9_MFMA(kr[3], qr[5], pA1);
    { const float rm = rowmax(pA0, pA1);
#pragma unroll
      for (int r = 0; r < 16; ++r) { nmh16[r] = -rm; pA0[r] = EX(pA0[r] - rm); pA1[r] = EX(pA1[r] - rm); } }
    A9_WAIT_BAR(0);
    DMA_K(3, 0, 3 * SLOTR); DMA_V(1, SLOTB); ROT();
    _Pragma("unroll") for (int d0 = 0; d0 < 4; ++d0) kload2(kf, kp0 + sl_cur, d0);
    A9_WAIT_BAR(3);
#define PKW(P, i) cvtpk(P[i], P[i + 1])
#define PAF(k) __builtin_bit_cast(bf16x8, pw##k)
#define VFR(i) (bf16x8){vlo[i][0], vlo[i][1], vlo[i][2], vlo[i][3], vhi[i][0], vhi[i][1], vhi[i][2], vhi[i][3]}
#define VRD(i) do { vlo[i] = vtr(vp_ + (((i) >> 2) * 4096 + ((i) & 3) * 1024)); vhi[i] = vtr(vp_ + (((i) >> 2) * 4096 + ((i) & 3) * 1024 + 512)); } while (0)
#define KRD(G, d0) do { if (G) { kload2(kf, kp0 + sl_next, d0); A9_SBAR(); } } while (0)
#define GAP3(MF, a0, a1, a2, W0, PW) do { MF; sacc += a0; sacc += a1; sacc += a2; W0; A9_PIN(PW); A9_PIN(sacc); A9_SBAR(); } while (0)
#define GAP2(MF, a0, a1, W0, W1, PW) do { MF; sacc += a0; sacc += a1; W0; W1; A9_PIN(PW); A9_PIN(sacc); A9_SBAR(); } while (0)
#define GAPB(MF, X, i) do { MF; X[i] = EX(X[i]); X[i + 1] = EX(X[i + 1]); X[i + 2] = EX(X[i + 2]); X[i + 3] = EX(X[i + 3]); A9_PIN(X); A9_SBAR(); } while (0)
#define STEP(C0, C1, P0, P1, t, GK, GV, GL) do { A9_SBAR(); \
    const lds_cptr vp_ = vp0 + sl_prev; const lds_cptr rp_ = rp0 + rs_cur; \
    VRD(0); kload2(kr, rp_, 0); A9_SBAR(); float sacc = P0[0] + P0[1]; \
                       GAP3(C0 = A9_MFMA(kf[0], qr[0], nmh16), P0[2], P0[3], P0[4],    pw0[0] = PKW(P0, 0), pw0); \
    VRD(4); kload2(kr, rp_, 1); A9_SBAR(); \
                       GAP3(C1 = A9_MFMA(kf[1], qr[0], nmh16), P0[5], P0[6], P0[7],    pw0[1] = PKW(P0, 2), pw0); \
    VRD(1); A9_SBAR(); GAP2(C0 = A9_MFMA(kf[2], qr[1], C0),    P0[8], P0[9],           pw0[2] = PKW(P0, 4), pw0[3] = PKW(P0, 6), pw0); \
    VRD(5); A9_SBAR(); GAP3(C1 = A9_MFMA(kf[3], qr[1], C1),    P0[10], P0[11], P0[12], pw1[0] = PKW(P0, 8), pw1); \
    VRD(2); A9_SBAR(); GAP3(C0 = A9_MFMA(kf[4], qr[2], C0),    P0[13], P0[14], P0[15], pw1[1] = PKW(P0, 10), pw1); \
    VRD(6); A9_SBAR(); GAP2(C1 = A9_MFMA(kf[5], qr[2], C1),    P1[0], P1[1],           pw1[2] = PKW(P0, 12), pw1[3] = PKW(P0, 14), pw1); \
    VRD(3); A9_SBAR(); GAP3(C0 = A9_MFMA(kf[6], qr[3], C0),    P1[2], P1[3], P1[4],    pw2[0] = PKW(P1, 0), pw2); \
    VRD(7); A9_SBAR(); GAP3(C1 = A9_MFMA(kf[7], qr[3], C1),    P1[5], P1[6], P1[7],    pw2[1] = PKW(P1, 2), pw2); \
                       GAP2(C0 = A9_MFMA(kr[0], qr[4], C0),    P1[8], P1[9],           pw2[2] = PKW(P1, 4), pw2[3] = PKW(P1, 6), pw2); \
                       GAP3(C1 = A9_MFMA(kr[1], qr[4], C1),    P1[10], P1[11], P1[12], pw3[0] = PKW(P1, 8), pw3); \
                       GAP3(C0 = A9_MFMA(kr[2], qr[5], C0),    P1[13], P1[14], P1[15], pw3[1] = PKW(P1, 10), pw3); \
                       GAP2(C1 = A9_MFMA(kr[3], qr[5], C1),    0.f, 0.f,               pw3[2] = PKW(P1, 12), pw3[3] = PKW(P1, 14), pw3); \
    l_reg += sacc; \
    if (GK) DMA_K((t) + 3, sl_cur, RS3()); if (GV) DMA_V((t) + 1, sl_next); \
    { const float rm = rowmax(C0, C1); resc = false; \
      if (__builtin_expect(__any(rm > THR), 0)) { const float dl = __builtin_fmaxf(rm, 0.f); \
          _Pragma("unroll") for (int r_ = 0; r_ < 16; ++r_) { nmh16[r_] -= dl; C0[r_] -= dl; C1[r_] -= dl; } \
          const float f = __builtin_amdgcn_exp2f(-dl); l_reg *= f; if (hi == 0) wsf[r32] = f; resc = true; } } \
    A9_SBAR(); \
    GAPB(o[0] = A9_MFMA(PAF(0), VFR(0), o[0]), C0, 0);              GAPB(o[1] = A9_MFMA(PAF(0), VFR(4), o[1]), C0, 4); \
    KRD(GL, 0); GAPB(o[0] = A9_MFMA(PAF(1), VFR(1), o[0]), C0, 8);  KRD(GL, 1); GAPB(o[1] = A9_MFMA(PAF(1), VFR(5), o[1]), C0, 12); \
    KRD(GL, 2); GAPB(o[0] = A9_MFMA(PAF(2), VFR(2), o[0]), C1, 0);  KRD(GL, 3); GAPB(o[1] = A9_MFMA(PAF(2), VFR(6), o[1]), C1, 4); \
    GAPB(o[0] = A9_MFMA(PAF(3), VFR(3), o[0]), C1, 8);              GAPB(o[1] = A9_MFMA(PAF(3), VFR(7), o[1]), C1, 12); \
    } while (0)
    int t = 1;
    for (; t + 5 < NT; t += 2) {
        STEP(pB0, pB1, pA0, pA1, t, true, true, true);     A9_WAIT_BAR(3); RESC(); ROT();
        STEP(pA0, pA1, pB0, pB1, t + 1, true, true, true); A9_WAIT_BAR(3); RESC(); ROT();
    }
#define ENDW(tt) do { if ((tt) + 3 < NT) { A9_WAIT_BAR(3); } else if ((tt) + 2 < NT) { A9_WAIT_BAR(1); } else { A9_WAIT_BAR(0); } } while (0)
    for (; t + 1 < NT; t += 2) {
        STEP(pB0, pB1, pA0, pA1, t, (t + 3 < NT), (t + 1 < NT), (t + 1 < NT));         ENDW(t);     RESC(); ROT();
        STEP(pA0, pA1, pB0, pB1, t + 1, (t + 4 < NT), (t + 2 < NT), (t + 2 < NT));     ENDW(t + 1); RESC(); ROT();
    }
    STEP(pB0, pB1, pA0, pA1, NT - 1, false, false, false); RESC();
    { float sacc = pB0[0] + pB0[1];
#pragma unroll
      for (int r = 2; r < 16; ++r) sacc += pB0[r];
#pragma unroll
      for (int r = 0; r < 16; ++r) sacc += pB1[r];
      l_reg += sacc;
      pw0 = (u32x4){PKW(pB0, 0), PKW(pB0, 2), PKW(pB0, 4), PKW(pB0, 6)}; pw1 = (u32x4){PKW(pB0, 8), PKW(pB0, 10), PKW(pB0, 12), PKW(pB0, 14)};
      pw2 = (u32x4){PKW(pB1, 0), PKW(pB1, 2), PKW(pB1, 4), PKW(pB1, 6)}; pw3 = (u32x4){PKW(pB1, 8), PKW(pB1, 10), PKW(pB1, 12), PKW(pB1, 14)};
      const lds_cptr vp_ = vp0 + sl_cur; _Pragma("unroll") for (int i = 0; i < 8; ++i) VRD(i);
      o[0] = A9_MFMA(PAF(0), VFR(0), o[0]); o[1] = A9_MFMA(PAF(0), VFR(4), o[1]); o[0] = A9_MFMA(PAF(1), VFR(1), o[0]); o[1] = A9_MFMA(PAF(1), VFR(5), o[1]);
      o[0] = A9_MFMA(PAF(2), VFR(2), o[0]); o[1] = A9_MFMA(PAF(2), VFR(6), o[1]); o[0] = A9_MFMA(PAF(3), VFR(3), o[0]); o[1] = A9_MFMA(PAF(3), VFR(7), o[1]); }
    { auto rr = __builtin_amdgcn_permlane32_swap(__float_as_uint(l_reg), __float_as_uint(l_reg), false, false); l_reg = __uint_as_float(rr[0]) + __uint_as_float(rr[1]); }
    if (hi == 0) wsf[32 + r32] = l_reg; asm volatile("s_waitcnt lgkmcnt(0)" ::: "memory");
    float rli[16];
#pragma unroll
    for (int r = 0; r < 16; ++r) rli[r] = __builtin_amdgcn_rcpf(wsf[32 + crow(r, hi)]);
    bf16* Ow = a.O + (long)(wid * QBLK) * a.ldo; unsigned short* stg = (unsigned short*)(lds + LDS_OST) + wid * 2048;
#pragma unroll
    for (int r = 0; r < 16; ++r) { const int orow = crow(r, hi);
#pragma unroll
        for (int d0 = 0; d0 < 2; ++d0) { const float v = o[d0][r] * rli[r]; const unsigned u = __float_as_uint(v); stg[orow * 64 + d0 * 32 + r32] = (unsigned short)((u + 0x7fffu + ((u >> 16) & 1u)) >> 16); } }
    asm volatile("s_waitcnt lgkmcnt(0)" ::: "memory");
#pragma unroll
    for (int i = 0; i < 4; ++i) { const int row = i * 8 + (lane >> 3), ch = lane & 7; *(u32x4*)(Ow + (long)row * a.ldo + ch * 8) = *(const u32x4*)(stg + row * 64 + ch * 8); }
    asm volatile("s_waitcnt lgkmcnt(0)\n\ts_barrier" ::: "memory");
#undef DMA_K
#undef DMA_V
#undef ROT
#undef RS3
#undef EX
#undef RESC
#undef PKW
#undef PAF
#undef VFR
#undef VRD
#undef KRD
#undef ENDW
#undef GAP3
#undef GAP2
#undef GAPB
#undef STEP
}
#undef A9_SBAR
#undef A9_PIN
#undef A9_MFMA
#undef A9_WAIT_BAR
}

constexpr size_t MiB = 1u << 20;
constexpr size_t WS_CTL = 0, CTL_BYTES = 1 * MiB;
constexpr size_t WS_MOD = 1 * MiB;
constexpr size_t WS_T16C = WS_MOD + 256 * 1024, WS_T16S = WS_T16C + 4096, WS_T8C = WS_T16S + 4096, WS_T8S = WS_T8C + 2048;
constexpr size_t WS_RSQ = WS_MOD + 320 * 1024, WS_RSKV = WS_RSQ + 64 * 1024;
constexpr size_t WS_TAB = WS_MOD + 512 * 1024;
constexpr size_t WS_WT = 3 * MiB;
constexpr size_t WT_IN = 0, WT_G = WT_IN + (size_t)PPW * DM * 2, WT_QU = WT_G + (size_t)NGATE * DM * 2, WT_KVU = WT_QU + (size_t)768 * 384 * 2, WT_BR = WT_KVU + (size_t)1024 * 256 * 2,
                 WT_OUT = WT_BR + (size_t)3 * DM * 512 * 2, WT_F1 = WT_OUT + (size_t)DM * DM * 2, WT_F2 = WT_F1 + (size_t)DFF * DM * 2, WT_END = WT_F2 + (size_t)DM * DFF * 2;
static_assert(WT_END <= 36 * MiB, "weights");
constexpr size_t WS_CTXX = WS_WT + 36 * MiB;
constexpr size_t WS_XN = WS_CTXX + 4 * MiB;
constexpr size_t WS_HALF = WS_XN + 34 * MiB;
constexpr int NUNIT = 32 * (RPB / 32);
constexpr size_t H_PP = 0, H_QM = H_PP + (size_t)HM * PPW * 2, H_KVM = H_QM + (size_t)HM * 768 * 2, H_MO = H_KVM + (size_t)HM * 1024 * 2, H_PHI = H_MO + (size_t)HM * 512 * 2,
                 H_PSI = H_PHI + (size_t)NUNIT * 8192, H_GC = H_PSI + (size_t)NUNIT * 8192, H_END = H_GC + (size_t)NUNIT * 256;
constexpr size_t WS_END = WS_HALF + H_END;
static_assert(WS_END + 12 * MiB <= 256 * MiB, "workspace (the 12 MiB after WS_END hold transient scratch: pass-3 parking / split-K slabs)");
constexpr size_t WS_GB = WS_HALF + H_PHI, WS_MIX = WS_GB + (size_t)HM * 3 * DM * 2;
constexpr size_t WS_G0 = WS_HALF + H_KVM, WS_G1 = WS_HALF + H_PHI, WS_G2 = WS_G1 + (size_t)HM * DM * 2;
static_assert(WS_G2 + (size_t)HM * DM * 2 <= WS_HALF + H_PSI, "gate buffers");
constexpr size_t WS_HID = WS_HALF;
static_assert(WS_MIX + (size_t)HM * DM * 2 <= WS_HALF + H_GC && WS_HID + (size_t)MROWS * DFF * 2 <= WS_END, "overlays");
constexpr int CW_BAR = 4096, CW_ATT = 16384;

#define GAS __attribute__((address_space(1)))
#define LAS __attribute__((address_space(3)))
typedef unsigned short bf16;
typedef unsigned v4u __attribute__((ext_vector_type(4)));
typedef float f32x4 __attribute__((ext_vector_type(4)));
typedef float f32x8 __attribute__((ext_vector_type(8)));
#define LDS_WAIT() asm volatile("s_waitcnt lgkmcnt(0)" ::: "memory")
__device__ __forceinline__ unsigned f2bf(float f) { unsigned u = __builtin_bit_cast(unsigned, f); return (u + 0x7fffu + ((u >> 16) & 1u)) >> 16; }
__device__ __forceinline__ unsigned pk2(float lo, float hi) { return f2bf(lo) | (f2bf(hi) << 16); }
__device__ __forceinline__ float bf2f(unsigned short h) { return __uint_as_float((unsigned)h << 16); }

#define XB_TMO      128
#define XB_XCNT(j)  (256  + 64 * (j))
#define XB_XSUB(j)  (1280 + 64 * (j))
#define XB_XGEN(j)  (2304 + 64 * (j))
#define XB_TOP      3328
#define XB_TOPGEN   3392
#define XCD_BAR_WORDS 3456
#define XB_SPIN_CAP (1u << 22)
__device__ __forceinline__ unsigned xb_ld(unsigned* p)              { return __hip_atomic_load(p, __ATOMIC_RELAXED, __HIP_MEMORY_SCOPE_AGENT); }
__device__ __forceinline__ unsigned xb_add(unsigned* p, unsigned v) { return __hip_atomic_fetch_add(p, v, __ATOMIC_RELAXED, __HIP_MEMORY_SCOPE_AGENT); }
__device__ __forceinline__ unsigned xb_xcc_id() { return (unsigned)__builtin_amdgcn_s_getreg((3 << 11) | 20) & 0xFu; }
#define XB_SPIN(cond, bar) do { unsigned _sp = 0; while (cond) { __builtin_amdgcn_s_sleep(1); \
    if ((++_sp & 255u) == 0u) { if (xb_ld(&(bar)[XB_TMO])) break; if (_sp > XB_SPIN_CAP) { atomicAdd(&(bar)[XB_TMO], 1u); break; } } } } while (0)
struct XcdBarrier { unsigned* bar; unsigned x; volatile LAS unsigned* st; };
__device__ __forceinline__ XcdBarrier xcd_barrier_post(unsigned* bar, volatile LAS unsigned* st) {
    XcdBarrier b; b.bar = bar; b.x = xb_xcc_id(); b.st = st;
    if (threadIdx.x == 0) (void)xb_add(&bar[XB_XCNT(b.x)], 1u);
    return b;
}
__device__ __forceinline__ void xcd_barrier_complete(unsigned* bar, unsigned x, unsigned& nloc, unsigned& nx) {
    const unsigned G = gridDim.x * gridDim.y * gridDim.z;
    unsigned sum, cnt, mine, sp = 0u;
    for (;;) {
        sum = 0u; cnt = 0u; mine = 0u;
#pragma unroll
        for (unsigned j = 0; j < 16; ++j) { const unsigned c = xb_ld(&bar[XB_XCNT(j)]); sum += c; cnt += (c > 0u) ? 1u : 0u; mine = (j == x) ? c : mine; }
        if (sum == G) break;
        __builtin_amdgcn_s_sleep(1);
        if ((++sp & 255u) == 0u) { if (xb_ld(&bar[XB_TMO])) break; if (sp > XB_SPIN_CAP) { atomicAdd(&bar[XB_TMO], 1u); break; } }
    }
    nloc = mine > 0u ? mine : 1u; nx = cnt > 0u ? cnt : 1u;
}
__device__ __forceinline__ void xcd_barrier(const XcdBarrier& b) {
    asm volatile("s_waitcnt vmcnt(0)" ::: "memory");
    __syncthreads();
    if (threadIdx.x == 0) {
        unsigned* bar = b.bar; asm volatile("" : "+s"(bar));
        __builtin_amdgcn_s_waitcnt(0);
        unsigned nloc = b.st[0], nx = b.st[1];
        if (nloc == 0u) { xcd_barrier_complete(bar, b.x, nloc, nx); b.st[0] = nloc; b.st[1] = nx; }
        const unsigned old = xb_add(&bar[XB_XSUB(b.x)], 1u);
        const unsigned gen = old / nloc;
        if (old + 1u == (gen + 1u) * nloc) {
            __builtin_amdgcn_fence(__ATOMIC_RELEASE, "agent");
            asm volatile("s_waitcnt vmcnt(0)" ::: "memory");
            const unsigned og = xb_add(&bar[XB_TOP], 1u);
            const unsigned tg = og / nx;
            if (og + 1u == (tg + 1u) * nx) xb_add(&bar[XB_TOPGEN], 1u);
            else XB_SPIN(xb_ld(&bar[XB_TOPGEN]) == tg, bar);
            __builtin_amdgcn_fence(__ATOMIC_ACQUIRE, "agent");
            xb_add(&bar[XB_XGEN(b.x)], 1u);
            asm volatile("s_waitcnt vmcnt(0)" ::: "memory");
        } else {
            XB_SPIN(xb_ld(&bar[XB_XGEN(b.x)]) == gen, bar);
            __builtin_amdgcn_fence(__ATOMIC_ACQUIRE, "agent");
            asm volatile("s_waitcnt vmcnt(0)" ::: "memory");
        }
    }
    __syncthreads();
}

constexpr int NWAVES = 8, RING_BYTES = 131072, LDS_BYTES = 163840, MISC_OFF = LDS_BYTES - 512;
struct Args { const float* in[31]; float* out; unsigned char* ws; int ph_lo, ph_hi; };
enum { I_X = 0, I_C, I_CTX, I_CCTX, I_WMOD, I_BMOD, I_G1, I_G2, I_WIN, I_QGAIN, I_KGAIN, I_MU, I_W0, I_W2, I_A0, I_A2, I_G2R, I_KK, I_KA, I_RK, I_LNW, I_LNB, I_QNORM, I_QUP, I_KVNORM, I_KVUP, I_WBR, I_WOUT, I_FF1, I_FF2, I_GFIN };
#define CAS __attribute__((address_space(4)))
__device__ __forceinline__ const float* inp(int i) { const CAS Args* ap = (const CAS Args*)__builtin_amdgcn_kernarg_segment_ptr(); asm volatile("" : "+s"(ap)); return ap->in[i]; }
struct Frame {
    LAS unsigned char* lds; unsigned char* ldsg;
    unsigned* ctl; unsigned char* ws; float* out;
    int G, bid;
};
#define FTID() otid()
#define FLANE() (otid() & 63)
#define FWAVE() __builtin_amdgcn_readfirstlane(otid() >> 6)
__device__ __forceinline__ float wave_sum(float v) {
#pragma unroll
    for (int o = 1; o < 64; o <<= 1) v += __shfl_xor(v, o);
    return v;
}
__device__ __forceinline__ const float* xrow_ptr(const float* xl, const float* xc, int m) { const int b = m / RPB, s = m % RPB; return (s < CTX) ? xc + (size_t)(b * CTX + s) * DM : xl + (size_t)(b * SEQ + s - CTX) * DM; }

__device__ __forceinline__ void p0_transpose_item(const float* W, int ldw, int col0, int Kd, int N, bf16* WT, const float* kscale, LAS unsigned* scr, int item, int lane, int ldwt) {
    const int nblk = (N + 63) / 64, kb = item / nblk, nb = item % nblk, k0 = 64 * kb, n0 = 64 * nb, c = lane & 15, r4 = lane >> 4;
    const bool valid = n0 + 4 * c < N;
#pragma unroll
    for (int i = 0; i < 8; ++i) { const int k = 8 * i + 2 * r4; f32x4 a = (f32x4){0.f, 0.f, 0.f, 0.f}, bq = a;
        if (valid) { a = *(const f32x4*)(W + (size_t)(k0 + k) * ldw + col0 + n0 + 4 * c); bq = *(const f32x4*)(W + (size_t)(k0 + k + 1) * ldw + col0 + n0 + 4 * c); }
        if (kscale) { a = a * kscale[k0 + k]; bq = bq * kscale[k0 + k + 1]; }
#pragma unroll
        for (int e = 0; e < 4; ++e) scr[(4 * c + e) * 33 + (k >> 1)] = pk2(a[e], bq[e]); }
    LDS_WAIT(); asm volatile("" ::: "memory");
#pragma unroll
    for (int t = 0; t < 8; ++t) { const int n = (lane >> 3) + 8 * t, j = lane & 7; const LAS unsigned* p = scr + n * 33 + 4 * j;
        v4u o; o.x = p[0]; o.y = p[1]; o.z = p[2]; o.w = p[3];
        if (n0 + n < N) *(v4u*)(WT + (size_t)(n0 + n) * ldwt + k0 + 8 * j) = o; }
    LDS_WAIT(); asm volatile("" ::: "memory");
}

__device__ __forceinline__ void ph_weights(Frame& F, int l) {
    unsigned char* wt = F.ws + WS_WT;
    if (l == 0) {
        LAS float* sl = (LAS float*)F.lds;
        LAS float* red = (LAS float*)(F.lds + 32768);
        for (int i = FTID(); i < 5 * 1024; i += 512) { const int j = i >> 10, k = i & 1023; const float c = (j < 4) ? inp(I_C)[j * 1024 + k] : inp(I_CCTX)[k]; sl[i] = c / (1.f + __expf(-c)); }
        __syncthreads();
        for (int it = F.bid; it < 2 * 96; it += F.G) {
            const int ll = it / 96, n0 = (it % 96) * 64;
            const float* wm = inp(I_WMOD) + (size_t)ll * 1024 * 6144 + n0 + FLANE();
            float a0 = 0, a1 = 0, a2 = 0, a3 = 0, a4 = 0;
            for (int k = FWAVE() * 128; k < FWAVE() * 128 + 128; ++k) { const float w = wm[(size_t)k * 6144]; a0 += sl[k] * w; a1 += sl[1024 + k] * w; a2 += sl[2048 + k] * w; a3 += sl[3072 + k] * w; a4 += sl[4096 + k] * w; }
            LAS float* r = red + FWAVE() * 320 + FLANE(); r[0] = a0; r[64] = a1; r[128] = a2; r[192] = a3; r[256] = a4;
            __syncthreads();
            if (FTID() < 320) { float s = 0; for (int w = 0; w < 8; ++w) s += red[w * 320 + FTID()]; const int j = FTID() >> 6, n = n0 + (FTID() & 63);
                ((float*)(F.ws + WS_MOD))[(size_t)(ll * 5 + j) * 6144 + n] = s + inp(I_BMOD)[ll * 6144 + n]; }
            __syncthreads();
        }
        if (F.bid == F.G - 1) {
            for (int i = FTID(); i < 64 * 16; i += 512) { const int pos = i >> 4, f = i & 15; const float ang = (float)pos * powf(10000.f, -(float)f / 16.f); ((float*)(F.ws + WS_T16C))[i] = cosf(ang); ((float*)(F.ws + WS_T16S))[i] = sinf(ang); }
            for (int i = FTID(); i < 64 * 8; i += 512) { const int pos = i >> 3, f = i & 7; const float ang = (float)pos * powf(10000.f, -(float)f / 8.f); ((float*)(F.ws + WS_T8C))[i] = cosf(ang); ((float*)(F.ws + WS_T8S))[i] = sinf(ang); }
        }
        __syncthreads();
    }
    {
        bf16* w2P = (bf16*)(F.ws + WS_TAB); bf16* a2B = (bf16*)(F.ws + WS_TAB + 131072); bf16* g2P = (bf16*)(F.ws + WS_TAB + 524288);
        const float* w2 = inp(I_W2) + (size_t)l * 2 * 64 * 512; const float* a2 = inp(I_A2) + (size_t)l * 2 * 64 * 512; const float* g2 = inp(I_G2R) + (size_t)l * 128 * 512;
        const float* mu = inp(I_MU) + (size_t)l * 2 * RWIN;
        for (int idx = F.bid * 512 + FTID(); idx < 65536; idx += F.G * 512) {
            { const int dh = idx >> 12, d = dh >> 3, hd = dh & 7, rem = idx & 4095, Ii = rem >> 11, J = (rem >> 10) & 1, S = (rem >> 9) & 1, ln = (rem >> 3) & 63, e = rem & 7;
              const int i = 32 * Ii + 16 * S + 8 * (e >> 2) + 4 * (ln >> 5) + (e & 3), k = 32 * J + (ln & 31);
              w2P[idx] = (bf16)f2bf(w2[(size_t)(d * 64 + i) * 512 + hd * 64 + k]); }
            { const int hd = idx >> 13, rem = idx & 8191, Ii = rem >> 11, Iv = (rem >> 10) & 1, S = (rem >> 9) & 1, ln = (rem >> 3) & 63, e = rem & 7;
              const int i = 32 * Ii + 16 * S + 8 * (e >> 2) + 4 * (ln >> 5) + (e & 3), v = 32 * Iv + (ln & 31);
              g2P[idx] = (bf16)f2bf(g2[(size_t)i * 512 + hd * 64 + v]); } }
        {   bf16* DF = (bf16*)(F.ws + WS_TAB + 655360);
            for (int idx = F.bid * 512 + FTID(); idx < 60 * 3 * 2 * 64 * 8; idx += F.G * 512) {
                const int e = idx & 7, ln = (idx >> 3) & 63, q = (idx >> 9) & 1, w = (idx >> 10) % 3, blk = idx / 3072, r = ln & 31, h = ln >> 5, cc = 32 * blk + r;
                const float m0 = mu[cc], m1 = mu[RWIN + cc]; const float cf = (w == 0) ? 1.f - m0 - m1 : (w == 1 ? m0 : m1);
                DF[idx] = (r == 16 * q + 8 * h + e) ? (bf16)f2bf(cf) : (bf16)0; } }
        for (int idx = F.bid * 512 + FTID(); idx < 196608; idx += F.G * 512) {
            const int dh = idx / 12288, rem = idx % 12288, w = rem >> 12, k = (rem >> 6) & 63, i = rem & 63, d = dh >> 3, hd = dh & 7;
            const float m0 = mu[RW_AD + d * 64 + i], m1 = mu[RWIN + RW_AD + d * 64 + i]; const float cf = (w == 0) ? 1.f - m0 - m1 : (w == 1 ? m0 : m1);
            a2B[idx] = (bf16)f2bf(a2[(size_t)(d * 64 + i) * 512 + hd * 64 + k] * cf); } }
    LAS unsigned* scr = (LAS unsigned*)(F.lds + FWAVE() * 16384);
    const int gw = F.bid * NWAVES + FWAVE(), NGW = F.G * NWAVES;
    const float* win = inp(I_WIN) + (size_t)l * DM * NIN;
    constexpr int I_A = 16 * 53, I_B = 16 * 48, I_C2 = 6 * 12, I_D = 4 * 16, I_E = 8 * 16, I_F = 16 * 16, I_G = 16 * 64, I_H = 64 * 16;
    constexpr int NITEMS = I_A + I_B + I_C2 + I_D + 3 * I_E + I_F + I_G + I_H;
    for (int it = gw; it < NITEMS; it += NGW) {
        int r = it; const int lane = FLANE();
        if (r < I_A) { p0_transpose_item(win, NIN, 0, DM, 3360, (bf16*)(wt + WT_IN), nullptr, scr, r, lane, DM); continue; } r -= I_A;
        if (r < I_B) { p0_transpose_item(win, NIN, C_GATE, DM, NGATE, (bf16*)(wt + WT_G), nullptr, scr, r, lane, DM); continue; } r -= I_B;
        if (r < I_C2) { p0_transpose_item(inp(I_QUP) + (size_t)l * 384 * 768, 768, 0, 384, 768, (bf16*)(wt + WT_QU), inp(I_QNORM) + l * 384, scr, r, lane, 384); continue; } r -= I_C2;
        if (r < I_D) { p0_transpose_item(inp(I_KVUP) + (size_t)l * 256 * 1024, 1024, 0, 256, 1024, (bf16*)(wt + WT_KVU), inp(I_KVNORM) + l * 256, scr, r, lane, 256); continue; } r -= I_D;
        if (r < 3 * I_E) { const int i = r / I_E; p0_transpose_item(inp(I_WBR) + (size_t)(l * 3 + i) * 512 * DM, DM, 0, 512, DM, (bf16*)(wt + WT_BR) + (size_t)i * DM * 512, nullptr, scr, r % I_E, lane, 512); continue; } r -= 3 * I_E;
        if (r < I_F) { p0_transpose_item(inp(I_WOUT) + (size_t)l * DM * DM, DM, 0, DM, DM, (bf16*)(wt + WT_OUT), nullptr, scr, r, lane, DM); continue; } r -= I_F;
        if (r < I_G) { p0_transpose_item(inp(I_FF1) + (size_t)l * DM * DFF, DFF, 0, DM, DFF, (bf16*)(wt + WT_F1), nullptr, scr, r, lane, DM); continue; } r -= I_G;
        p0_transpose_item(inp(I_FF2) + (size_t)l * DFF * DM, DM, 0, DFF, DM, (bf16*)(wt + WT_F2), nullptr, scr, r, lane, DFF);
    }
    { v4u* z = (v4u*)((bf16*)(wt + WT_IN) + (size_t)3360 * DM); const int nz = 224 * DM * 2 / 16; unsigned z0; asm volatile("v_mov_b32 %0, 0" : "=v"(z0));
      for (int i = F.bid * 512 + FTID(); i < nz; i += F.G * 512) z[i] = (v4u){z0, z0, z0, z0}; }
}

__device__ __forceinline__ void ph_norm(Frame& F, int l, const float* xl, const float* xc, const float* g, int which, bool skipctx, const float* part = nullptr) {
    const int gw = F.bid * NWAVES + FWAVE(), NGW = F.G * NWAVES;
    const float* mod = (const float*)(F.ws + WS_MOD) + (size_t)l * 5 * 6144;
    bf16* XN = (bf16*)(F.ws + WS_XN);
    for (int m = gw; m < MROWS; m += NGW) {
        const int b = m / RPB, s = m % RPB; if (skipctx && s < CTX) continue;
        const f32x4* xr = (const f32x4*)xrow_ptr(xl, xc, m) + FLANE();
        const float* mv = mod + (size_t)((s < CTX) ? 4 : b) * 6144 + which * 3072;
        f32x4 v[4]; float ss = 0.f;
#pragma unroll
        for (int j = 0; j < 4; ++j) { v[j] = xr[64 * j];
            if (part && s < CTX) { const f32x4* pr = (const f32x4*)(part + (size_t)(b * CTX + s) * DM) + FLANE() + 64 * j; v[j] = v[j] + pr[0] + pr[262144] + pr[524288]; }
            ss += (v[j].x * v[j].x + v[j].y * v[j].y) + (v[j].z * v[j].z + v[j].w * v[j].w); }
        const float rstd = 1.f / sqrtf(wave_sum(ss) * (1.f / DM) + NORM_EPS);
        unsigned long long* o8 = (unsigned long long*)(XN + (size_t)m * DM) + FLANE();
#pragma unroll
        for (int j = 0; j < 4; ++j) { const int c = 4 * FLANE() + 256 * j; const f32x4 gg = *(const f32x4*)(g + c), sh = *(const f32x4*)(mv + c), sc = *(const f32x4*)(mv + 1024 + c);
            const f32x4 y = v[j] * rstd * gg * (sc + 1.0f) + sh;
            o8[64 * j] = (unsigned long long)pk2(y.x, y.y) | ((unsigned long long)pk2(y.z, y.w) << 32); }
    }
}
__device__ __forceinline__ void ph_final(Frame& F) {
    const int gw = F.bid * NWAVES + FWAVE(), NGW = F.G * NWAVES; const float* g = inp(I_GFIN);
    for (int m = gw; m < NB * SEQ; m += NGW) {
        f32x4* xr = (f32x4*)(F.out + (size_t)m * DM) + FLANE(); f32x4 v[4]; float ss = 0.f;
#pragma unroll
        for (int j = 0; j < 4; ++j) { v[j] = xr[64 * j]; ss += (v[j].x * v[j].x + v[j].y * v[j].y) + (v[j].z * v[j].z + v[j].w * v[j].w); }
        const float rstd = 1.f / sqrtf(wave_sum(ss) * (1.f / DM) + NORM_EPS);
#pragma unroll
        for (int j = 0; j < 4; ++j) { const f32x4 gg = *(const f32x4*)(g + 4 * FLANE() + 256 * j); xr[64 * j] = v[j] * rstd * gg; }
    }
}

__device__ __forceinline__ void ph_prep(Frame& F, int l, int half) {
    const int gw = F.bid * NWAVES + FWAVE(), NGW = F.G * NWAVES, lane = FLANE();
    bf16* PP = (bf16*)(F.ws + WS_HALF + H_PP);
    const float* t16c = (const float*)(F.ws + WS_T16C); const float* t16s = (const float*)(F.ws + WS_T16S); const float* t8c = (const float*)(F.ws + WS_T8C); const float* t8s = (const float*)(F.ws + WS_T8S);
    float* rsq = (float*)(F.ws + WS_RSQ); float* rskv = (float*)(F.ws + WS_RSKV);
    const float* qg = inp(I_QGAIN) + l * 64; const float* kg = inp(I_KGAIN) + l * 64;
    for (int m = gw; m < HM; m += NGW) {
        const int s = m % RPB; const bool lat = s >= CTX; const int tt = s - CTX, pr = (tt >> 6) & 63, pc = tt & 63;
        bf16* row = PP + (size_t)m * PPW;
        for (int part = 0; part < 2; ++part) {
            if (part == 1 && lane >= 16) break;
            bf16* p = row + (part == 0 ? C_GQ : C_GK) + lane * 8; const float* gain = part == 0 ? qg : kg;
            const v4u w = *(const v4u*)p; float v[8] = {pg8::bf_lo(w.x), pg8::bf_hi(w.x), pg8::bf_lo(w.y), pg8::bf_hi(w.y), pg8::bf_lo(w.z), pg8::bf_hi(w.z), pg8::bf_lo(w.w), pg8::bf_hi(w.w)};
            float ss = 0; for (int e = 0; e < 8; ++e) ss += v[e] * v[e];
            ss += __shfl_xor(ss, 1); ss += __shfl_xor(ss, 2); ss += __shfl_xor(ss, 4);
            const float rstd = 1.f / sqrtf(ss * (1.f / 64.f) + NORM_EPS); const int j = lane & 7;
            const float qs = (part == 0) ? 0.125f * 1.4426950408889634f : 1.f;
            for (int e = 0; e < 8; ++e) v[e] = v[e] * (rstd * qs) * gain[j * 8 + e];
            float pv[8]; for (int e = 0; e < 8; ++e) pv[e] = __shfl_xor(v[e], 2);
            if (lat) { const int pos = (j < 4) ? pr : pc; const int f0 = 8 * (j & 1);
                for (int e = 0; e < 8; ++e) { const float c = t16c[pos * 16 + f0 + e], sn = t16s[pos * 16 + f0 + e]; v[e] = ((j & 2) == 0) ? v[e] * c - pv[e] * sn : pv[e] * sn + v[e] * c; } }
            v4u o; o.x = pk2(v[0], v[1]); o.y = pk2(v[2], v[3]); o.z = pk2(v[4], v[5]); o.w = pk2(v[6], v[7]); *(v4u*)p = o;
        }
        if (lane < 4) {
            bf16* p = row + C_KR + lane * 8; const v4u w = *(const v4u*)p; float v[8] = {pg8::bf_lo(w.x), pg8::bf_hi(w.x), pg8::bf_lo(w.y), pg8::bf_hi(w.y), pg8::bf_lo(w.z), pg8::bf_hi(w.z), pg8::bf_lo(w.w), pg8::bf_hi(w.w)};
            float pv[8]; for (int e = 0; e < 8; ++e) pv[e] = __shfl_xor(v[e], 1);
            if (lat) { const int pos = (lane < 2) ? pr : pc;
                for (int e = 0; e < 8; ++e) { const float c = t8c[pos * 8 + e], sn = t8s[pos * 8 + e]; v[e] = ((lane & 1) == 0) ? v[e] * c - pv[e] * sn : pv[e] * sn + v[e] * c; } }
            v4u o; o.x = pk2(v[0], v[1]); o.y = pk2(v[2], v[3]); o.z = pk2(v[4], v[5]); o.w = pk2(v[6], v[7]); *(v4u*)p = o;
        }
        { float sq = 0, skv = 0;
          if (lane < 48) { const v4u w = *(const v4u*)(row + C_QD + lane * 8); const float v[8] = {pg8::bf_lo(w.x), pg8::bf_hi(w.x), pg8::bf_lo(w.y), pg8::bf_hi(w.y), pg8::bf_lo(w.z), pg8::bf_hi(w.z), pg8::bf_lo(w.w), pg8::bf_hi(w.w)}; for (int e = 0; e < 8; ++e) sq += v[e] * v[e]; }
          if (lane < 32) { const v4u w = *(const v4u*)(row + C_KVD + lane * 8); const float v[8] = {pg8::bf_lo(w.x), pg8::bf_hi(w.x), pg8::bf_lo(w.y), pg8::bf_hi(w.y), pg8::bf_lo(w.z), pg8::bf_hi(w.z), pg8::bf_lo(w.w), pg8::bf_hi(w.w)}; for (int e = 0; e < 8; ++e) skv += v[e] * v[e]; }
          sq = wave_sum(sq); skv = wave_sum(skv);
          if (lane == 0) { rsq[m] = (0.10206207261596575f * 1.4426950408889634f) / sqrtf(sq * (1.f / 384.f) + NORM_EPS);     rskv[m] = 1.f / sqrtf(skv * (1.f / 256.f) + NORM_EPS); } }
    }
}
__device__ __forceinline__ void shifted8(const bf16* PP, int m, int cc0, const float* mu, float (&u)[8]) {
    const int s = m % RPB; const float fp = (s != 0 && s != CTX) ? 1.f : 0.f, fn = (s != CTX - 1 && s != RPB - 1) ? 1.f : 0.f;
    const int mp = m > 0 ? m - 1 : 0, mn = m < HM - 1 ? m + 1 : HM - 1;
    const v4u w = *(const v4u*)(PP + (size_t)m * PPW + C_RW + cc0), wp = *(const v4u*)(PP + (size_t)mp * PPW + C_RW + cc0), wn = *(const v4u*)(PP + (size_t)mn * PPW + C_RW + cc0);
    const f32x4 m0a = *(const f32x4*)(mu + cc0), m0b = *(const f32x4*)(mu + cc0 + 4), m1a = *(const f32x4*)(mu + RWIN + cc0), m1b = *(const f32x4*)(mu + RWIN + cc0 + 4);
    const float c[8] = {pg8::bf_lo(w.x), pg8::bf_hi(w.x), pg8::bf_lo(w.y), pg8::bf_hi(w.y), pg8::bf_lo(w.z), pg8::bf_hi(w.z), pg8::bf_lo(w.w), pg8::bf_hi(w.w)};
    const float a[8] = {pg8::bf_lo(wp.x), pg8::bf_hi(wp.x), pg8::bf_lo(wp.y), pg8::bf_hi(wp.y), pg8::bf_lo(wp.z), pg8::bf_hi(wp.z), pg8::bf_lo(wp.w), pg8::bf_hi(wp.w)};
    const float n[8] = {pg8::bf_lo(wn.x), pg8::bf_hi(wn.x), pg8::bf_lo(wn.y), pg8::bf_hi(wn.y), pg8::bf_lo(wn.z), pg8::bf_hi(wn.z), pg8::bf_lo(wn.w), pg8::bf_hi(wn.w)};
#pragma unroll
    for (int e = 0; e < 8; ++e) { const float m0 = (e < 4 ? m0a[e & 3] : m0b[e & 3]), m1 = (e < 4 ? m1a[e & 3] : m1b[e & 3]); u[e] = c[e] + m0 * (fp * a[e] - c[e]) + m1 * (fn * n[e] - c[e]); }
}
namespace rk {
using bf16x8 = __attribute__((ext_vector_type(8))) short;
using f32x16 = __attribute__((ext_vector_type(16))) float;
using u32x4 = __attribute__((ext_vector_type(4))) unsigned;
typedef float f32x2_t __attribute__((ext_vector_type(2))); typedef __bf16 bf16x2_t __attribute__((ext_vector_type(2)));
#define RK_DI __device__ __forceinline__
RK_DI f32x16 RK_MF(bf16x8 a, bf16x8 b, f32x16 c) { return __builtin_amdgcn_mfma_f32_32x32x16_bf16(a, b, c, 0, 0, 0); }
constexpr int NH = 8;
RK_DI unsigned cvt2(float lo, float hi) { f32x2_t v = {lo, hi}; bf16x2_t b = __builtin_convertvector(v, bf16x2_t); return __builtin_bit_cast(unsigned, b); }
RK_DI float lo16(unsigned w) { return __uint_as_float(w << 16); }
RK_DI float hi16(unsigned w) { return __uint_as_float(w & 0xffff0000u); }
RK_DI int crow(int reg, int h) { return (reg & 3) + 8 * (reg >> 2) + 4 * h; }
RK_DI int krow(int s, int h, int e) { return 16 * s + 8 * (e >> 2) + 4 * h + (e & 3); }
template <int S> RK_DI bf16x8 pack(const f32x16& x) { u32x4 p = {cvt2(x[8 * S], x[8 * S + 1]), cvt2(x[8 * S + 2], x[8 * S + 3]), cvt2(x[8 * S + 4], x[8 * S + 5]), cvt2(x[8 * S + 6], x[8 * S + 7])}; return __builtin_bit_cast(bf16x8, p); }
RK_DI bf16x8 pack8(const float (&u)[8]) { u32x4 p = {cvt2(u[0], u[1]), cvt2(u[2], u[3]), cvt2(u[4], u[5]), cvt2(u[6], u[7])}; return __builtin_bit_cast(bf16x8, p); }
RK_DI void unpack8(bf16x8 v, float (&u)[8]) { const u32x4 p = __builtin_bit_cast(u32x4, v); u[0] = lo16(p.x); u[1] = hi16(p.x); u[2] = lo16(p.y); u[3] = hi16(p.y); u[4] = lo16(p.z); u[5] = hi16(p.z); u[6] = lo16(p.w); u[7] = hi16(p.w); }
constexpr short ONE = (short)0x3F80;
template <int K> RK_DI bf16x8 idn(int r, int h) { bf16x8 v;
#pragma unroll
    for (int e = 0; e < 8; ++e) v[e] = (r == 16 * K + 8 * h + e) ? ONE : (short)0; return v; }
template <int S> RK_DI bf16x8 idp(int r, int h) { bf16x8 v;
#pragma unroll
    for (int e = 0; e < 8; ++e) v[e] = (r == krow(S, h, e)) ? ONE : (short)0; return v; }
RK_DI bf16x8 idn_q(int q, int r, int h) { return q ? idn<1>(r, h) : idn<0>(r, h); }
template <int S, bool STRICT> RK_DI bf16x8 incp(int r, int h, int flip) { bf16x8 v;
#pragma unroll
    for (int e = 0; e < 8; ++e) { const int s = krow(S, h, e); const bool on = flip ? (STRICT ? s > r : s >= r) : (STRICT ? s < r : s <= r); v[e] = on ? ONE : (short)0; } return v; }
template <bool STRICT> RK_DI void tmask(f32x16& g, int r, int h, int flip) {
#pragma unroll
    for (int reg = 0; reg < 16; ++reg) { const int s = crow(reg, h); const bool on = flip ? (STRICT ? s > r : s >= r) : (STRICT ? s < r : s <= r); g[reg] = on ? g[reg] : 0.f; } }
template <int FLIP> RK_DI void solve32(f32x16& x, const bf16x8 (&Mp)[2]) {
    constexpr int F1 = FLIP ? 1 : 0, F2 = 1 - F1;
    f32x16 base = x;
#pragma unroll 1
    for (int it = 0; it < NH; ++it) { const f32x16 t = RK_MF(Mp[F1], pack<F1>(x), base);
#pragma unroll
        for (int e = 0; e < 8; ++e) x[8 * F1 + e] = t[8 * F1 + e]; }
    { const f32x16 t = RK_MF(Mp[F1], pack<F1>(x), base); x = t; base = t; }
#pragma unroll 1
    for (int it = 0; it < NH; ++it) { const f32x16 t = RK_MF(Mp[F2], pack<F2>(x), base);
#pragma unroll
        for (int e = 0; e < 8; ++e) x[8 * F2 + e] = t[8 * F2 + e]; }
}
template <int FLIP> RK_DI void solve32p(f32x16& x, f32x16& y, const bf16x8 (&Mp)[2]) {
    constexpr int F1 = FLIP ? 1 : 0, F2 = 1 - F1;
    f32x16 bx = x, by = y;
#pragma unroll 1
    for (int it = 0; it < NH; ++it) { const f32x16 t = RK_MF(Mp[F1], pack<F1>(x), bx); const f32x16 u = RK_MF(Mp[F1], pack<F1>(y), by);
#pragma unroll
        for (int e = 0; e < 8; ++e) { x[8 * F1 + e] = t[8 * F1 + e]; y[8 * F1 + e] = u[8 * F1 + e]; } }
    { const f32x16 t = RK_MF(Mp[F1], pack<F1>(x), bx); const f32x16 u = RK_MF(Mp[F1], pack<F1>(y), by); x = t; bx = t; y = u; by = u; }
#pragma unroll 1
    for (int it = 0; it < NH; ++it) { const f32x16 t = RK_MF(Mp[F2], pack<F2>(x), bx); const f32x16 u = RK_MF(Mp[F2], pack<F2>(y), by);
#pragma unroll
        for (int e = 0; e < 8; ++e) { x[8 * F2 + e] = t[8 * F2 + e]; y[8 * F2 + e] = u[8 * F2 + e]; } }
}
RK_DI float sigm(float x) { return __builtin_amdgcn_rcpf(1.f + __expf(-x)); }
RK_DI float tanh_f(float x) { return 2.f * __builtin_amdgcn_rcpf(1.f + __expf(-2.f * x)) - 1.f; }

struct Ctx {
    unsigned char* ws; LAS unsigned char* sb; int m0, r, h, hd, dir, l, flip;
    int cofs, dofs;
    int zt;
    int lofs;
    unsigned mp, mn; int rowc, rowp, rown;
};
#define C_PP(c) ((const bf16*)((c).ws + WS_HALF + H_PP))
#define C_MU(c) (inp(I_MU) + (size_t)(c).l * 2 * RWIN)
#define C_W2P(c) ((const bf16*)((c).ws + WS_TAB) + (size_t)((c).dir * 8 + (c).hd) * 4096)
#define C_A2B(c) ((const bf16*)((c).ws + WS_TAB + 131072) + (size_t)((c).dir * 8 + (c).hd) * 3 * 4096)
constexpr int SBUF = 34 * 128;
RK_DI void stage_slice(const Ctx& c, int buf, int cc0) {
    const int lane = c.r + 32 * c.h, p = lane & 7, q4 = lane >> 4;
    const bf16* base = C_PP(c) + (ptrdiff_t)(c.m0 - 1 + (lane >> 3)) * PPW + C_RW + cc0;
    const int oe = (p ^ q4) << 3, oo = (p ^ (4 + q4)) << 3;
#pragma unroll
    for (int j = 0; j < 5; ++j) { const bf16* src = base + (ptrdiff_t)j * 8 * PPW + ((j & 1) ? oo : oe);
        if (j < 4 || lane < 16) __builtin_amdgcn_global_load_lds((const unsigned*)src, (LAS unsigned*)(c.sb + buf * SBUF + j * 1024), 16, 0, 0); }
}
#define RK_WAIT_DMA() asm volatile("s_waitcnt vmcnt(0)" ::: "memory")
#define RK_WAIT_LDS() asm volatile("s_waitcnt lgkmcnt(0)" ::: "memory")
RK_DI bf16x8 rawfrag(const Ctx& c, int buf, int ch, int w) {
    const int rho = c.r + (w == 0 ? 1 : (w == 1 ? 0 : 2)); const unsigned m = (w == 0) ? 0xffffffffu : (w == 1 ? c.mp : c.mn);
    u32x4 v = *(const LAS u32x4*)(c.sb + buf * SBUF + rho * 128 + ((ch ^ ((rho >> 1) & 7)) << 4) + c.zt); v.x &= m; v.y &= m; v.z &= m; v.w &= m; return __builtin_bit_cast(bf16x8, v); }
RK_DI bf16x8 dfrag(const Ctx& c, int cc32, int w, int q) { return *(const bf16x8*)((const bf16*)(c.ws + WS_TAB + 655360) + (((cc32 >> 5) * 3 + w) * 2 + q) * 512 + c.lofs); }
RK_DI f32x16 load_o2(Ctx& c, int buf, int lblk, int cc32) { f32x16 z = f32x16{};
#pragma unroll
    for (int q = 0; q < 2; ++q) {
#pragma unroll
        for (int w = 0; w < 3; ++w) z = RK_MF(dfrag(c, cc32, w, q), rawfrag(c, buf, 4 * lblk + 2 * q + c.h, w), z); }
    asm volatile("" : "+v"(c.lofs), "+v"(c.zt), "+v"(z));
    return z; }
RK_DI f32x16 load_o1(Ctx& c, int buf, int lblk, int cc32) { f32x16 z = f32x16{};
#pragma unroll
    for (int q = 0; q < 2; ++q) {
#pragma unroll
        for (int w = 0; w < 3; ++w) z = RK_MF(rawfrag(c, buf, 4 * lblk + 2 * q + c.h, w), dfrag(c, cc32, w, q), z); }
    asm volatile("" : "+v"(c.lofs), "+v"(c.zt), "+v"(z));
    return z; }

struct Tilde { bf16x8 At[2][2], Bt[2][2], Kt[2][2], Rt[2][2], Vp[2][2]; float gtot[2]; float bon; };
#define RK_STAGE(x) asm volatile("" : "+v"(c.lofs), "+v"(c.zt), "+v"(x))
template <bool NEED_R> RK_DI void build_tilde(Ctx& c, Tilde& T) {
    const int r = c.r, h = c.h;
    stage_slice(c, 0, RW_WD + c.dir * 64); stage_slice(c, 1, RW_K + c.hd * 64); stage_slice(c, 2, RW_AD + c.dir * 64); if constexpr (NEED_R) stage_slice(c, 3, RW_R + c.hd * 64);
    RK_WAIT_DMA();
    bf16x8 lwp[2][2];
    {   bf16x8 twp[2][2];
#pragma unroll
        for (int Ii = 0; Ii < 2; ++Ii) { f32x16 t = load_o2(c, 0, Ii, RW_WD + c.dir * 64 + 32 * Ii);
#pragma unroll
            for (int reg = 0; reg < 16; ++reg) t[reg] = tanh_f(t[reg]);
            twp[Ii][0] = pack<0>(t); twp[Ii][1] = pack<1>(t); RK_STAGE(twp[Ii][1]); }
#pragma unroll
        for (int J = 0; J < 2; ++J) { f32x16 wl = f32x16{};
#pragma unroll
            for (int Ii = 0; Ii < 2; ++Ii)
#pragma unroll
                for (int S = 0; S < 2; ++S) wl = RK_MF(twp[Ii][S], *(const bf16x8*)(C_W2P(c) + ((Ii * 2 + J) * 2 + S) * 512 + c.lofs), wl);
            const float w0 = inp(I_W0)[c.dofs + 32 * J + r]; float gs = 0.f;
#pragma unroll
            for (int reg = 0; reg < 16; ++reg) wl[reg] = -0.6065306597126334f * sigm(wl[reg] + w0);
            lwp[J][0] = pack<0>(wl); lwp[J][1] = pack<1>(wl);
            { float q[8]; unpack8(lwp[J][0], q);
#pragma unroll
              for (int e = 0; e < 8; ++e) gs += q[e]; unpack8(lwp[J][1], q);
#pragma unroll
              for (int e = 0; e < 8; ++e) gs += q[e]; }
            gs += __shfl_xor(gs, 32); T.gtot[J] = gs; RK_STAGE(lwp[J][1]); } }
    RK_WAIT_LDS(); stage_slice(c, 0, RW_V + c.hd * 64);
    float rinv;
    {   float ss = 0.f;
#pragma unroll
        for (int Ik = 0; Ik < 2; ++Ik) { const f32x16 kt = load_o2(c, 1, Ik, RW_K + c.hd * 64 + 32 * Ik);
#pragma unroll
            for (int g = 0; g < 4; ++g) { const f32x4 kk = *(const f32x4*)(inp(I_KK) + c.cofs + 32 * Ik + 8 * g + 4 * h);
#pragma unroll
                for (int j = 0; j < 4; ++j) { const float q = kt[4 * g + j] * kk[j]; ss += q * q; } }
            RK_STAGE(ss); }
        ss += __shfl_xor(ss, 32); rinv = 1.f / fmaxf(sqrtf(ss), 1e-12f); RK_STAGE(rinv); }
    float bon = 0.f;
#pragma unroll
    for (int Ik = 0; Ik < 2; ++Ik) {
        f32x16 em, ep;
        { em = RK_MF(lwp[Ik][0], incp<0, false>(r, h, c.flip), f32x16{}); em = RK_MF(lwp[Ik][1], incp<1, false>(r, h, c.flip), em);
          ep = RK_MF(lwp[Ik][0], incp<0, true>(r, h, c.flip), f32x16{}); ep = RK_MF(lwp[Ik][1], incp<1, true>(r, h, c.flip), ep);
#pragma unroll
          for (int reg = 0; reg < 16; ++reg) { em[reg] = __expf(-em[reg]); ep[reg] = __expf(ep[reg]); } }
        RK_STAGE(ep);
        f32x16 kt = load_o2(c, 1, Ik, RW_K + c.hd * 64 + 32 * Ik); f32x16 kn;
#pragma unroll
        for (int g = 0; g < 4; ++g) { const f32x4 kk = *(const f32x4*)(inp(I_KK) + c.cofs + 32 * Ik + 8 * g + 4 * h);
#pragma unroll
            for (int j = 0; j < 4; ++j) { const int reg = 4 * g + j; kn[reg] = kt[reg] * kk[j] * rinv; ep[reg] = -kn[reg] * ep[reg]; } }
        T.At[Ik][0] = pack<0>(ep); T.At[Ik][1] = pack<1>(ep);
        RK_STAGE(T.At[Ik][1]);
        f32x16 as = f32x16{};
#pragma unroll
        for (int w = 0; w < 3; ++w) {
#pragma unroll
            for (int sp = 0; sp < 4; ++sp) as = RK_MF(*(const bf16x8*)(C_A2B(c) + w * 4096 + (32 * Ik + r) * 64 + 16 * sp + 8 * h), rawfrag(c, 2, 2 * sp + h, w), as);
            RK_STAGE(as); }
#pragma unroll
        for (int g = 0; g < 4; ++g) { const f32x4 a0 = *(const f32x4*)(inp(I_A0) + c.dofs + 32 * Ik + 8 * g + 4 * h);
#pragma unroll
            for (int j = 0; j < 4; ++j) { const int reg = 4 * g + j; as[reg] = sigm(as[reg] + a0[j]); kn[reg] = kn[reg] * as[reg] * em[reg]; } }
        T.Bt[Ik][0] = pack<0>(kn); T.Bt[Ik][1] = pack<1>(kn);
        RK_STAGE(T.Bt[Ik][1]);
#pragma unroll
        for (int g = 0; g < 4; ++g) { const f32x4 ka = *(const f32x4*)(inp(I_KA) + c.cofs + 32 * Ik + 8 * g + 4 * h);
#pragma unroll
            for (int j = 0; j < 4; ++j) { const int reg = 4 * g + j; kt[reg] = kt[reg] * (1.f + (as[reg] - 1.f) * ka[j]); as[reg] = kt[reg] * em[reg]; } }
        T.Kt[Ik][0] = pack<0>(as); T.Kt[Ik][1] = pack<1>(as);
        RK_STAGE(T.Kt[Ik][1]);
        if constexpr (NEED_R) {
            f32x16 rt = load_o2(c, 3, Ik, RW_R + c.hd * 64 + 32 * Ik);
#pragma unroll
            for (int g = 0; g < 4; ++g) { const f32x4 rk = *(const f32x4*)(inp(I_RK) + c.cofs + 32 * Ik + 8 * g + 4 * h);
#pragma unroll
                for (int j = 0; j < 4; ++j) { const int reg = 4 * g + j; bon += rt[reg] * kt[reg] * rk[j]; rt[reg] = rt[reg] * __builtin_amdgcn_rcpf(em[reg]); } }
            T.Rt[Ik][0] = pack<0>(rt); T.Rt[Ik][1] = pack<1>(rt); RK_STAGE(T.Rt[Ik][1]); }
    }
    T.bon = bon;
    RK_WAIT_DMA();
#pragma unroll
    for (int J = 0; J < 2; ++J) { const f32x16 va = load_o1(c, 0, J, RW_V + c.hd * 64 + 32 * J); T.Vp[J][0] = pack<0>(va); T.Vp[J][1] = pack<1>(va); RK_STAGE(T.Vp[J][1]); }
}
RK_DI void grams_la(const Ctx& c, const Tilde& T, bf16x8 (&Lk)[2], bf16x8 (&Mp)[2]) {
    f32x16 g = f32x16{}, m = f32x16{};
#pragma unroll
    for (int Ik = 0; Ik < 2; ++Ik)
#pragma unroll
        for (int S = 0; S < 2; ++S) { g = RK_MF(T.Kt[Ik][S], T.At[Ik][S], g); m = RK_MF(T.Bt[Ik][S], T.At[Ik][S], m); }
    tmask<true>(g, c.r, c.h, c.flip); tmask<true>(m, c.r, c.h, c.flip);
    Lk[0] = pack<0>(g); Lk[1] = pack<1>(g); Mp[0] = pack<0>(m); Mp[1] = pack<1>(m);
}
}

namespace rk {
constexpr int NSUB = RPB / 32;
RK_DI int chain_unit(int dir, int j) { return dir == 0 ? j : (j < 8 ? 7 - j : 143 - j); }
RK_DI int chain_pos(int dir, int c) { return dir == 0 ? c : (c < 8 ? 7 - c : 143 - c); }
RK_DI void setup_ctx(Ctx& c, unsigned char* ws, LAS unsigned char* sb, int l, int bl, int hd, int dir, int c32, int lane) {
    c.ws = ws; c.sb = sb; c.m0 = bl * RPB + 32 * c32; c.r = lane & 31; c.h = lane >> 5; c.hd = hd; c.dir = dir; c.l = l; c.flip = dir;
    c.cofs = l * 512 + hd * 64; c.dofs = (l * 2 + dir) * 512 + hd * 64;
    const int m = c.m0 + c.r, sg = m % RPB;
    c.mp = (sg != 0 && sg != CTX) ? 0xffffffffu : 0u; c.mn = (sg != CTX - 1 && sg != RPB - 1) ? 0xffffffffu : 0u;
    c.rowc = m; c.rowp = m > 0 ? m - 1 : 0; c.rown = m < HM - 1 ? m + 1 : HM - 1; c.lofs = (c.r + 32 * c.h) * 8; asm volatile("v_mov_b32 %0, 0" : "=v"(c.zt));
}
RK_DI void pass1_unit(unsigned char* ws, LAS unsigned char* sb, int l, int u, int lane) {
    const int q = u / NSUB, c32 = u % NSUB, bl = q >> 4, hd = (q >> 1) & 7, dir = q & 1;
    Ctx c; setup_ctx(c, ws, sb, l, bl, hd, dir, c32, lane);
    Tilde T; build_tilde<false>(c, T); __builtin_amdgcn_sched_barrier(0);
    const int r = c.r, h = c.h;
    bf16x8 Lk[2], Mp[2]; grams_la(c, T, Lk, Mp); __builtin_amdgcn_sched_barrier(0);
    const bf16x8 P0 = idp<0>(r, h), P1 = idp<1>(r, h);
    bf16x8 W1p[2][2], W2p[2][2], Bop[2][2], Kop[2][2];
#pragma unroll
    for (int J = 0; J < 2; ++J) {
        f32x16 x = RK_MF(T.At[J][0], P0, f32x16{}); x = RK_MF(T.At[J][1], P1, x);
        f32x16 y = RK_MF(Lk[0], T.Vp[J][0], f32x16{}); y = RK_MF(Lk[1], T.Vp[J][1], y);
        if (c.flip) solve32p<1>(x, y, Mp); else solve32p<0>(x, y, Mp);
        W1p[J][0] = pack<0>(x); W1p[J][1] = pack<1>(x);
        W2p[J][0] = pack<0>(y); W2p[J][1] = pack<1>(y);
        const float gcj = __expf(T.gtot[J]);
        f32x16 b = RK_MF(T.Bt[J][0], P0, f32x16{}); b = RK_MF(T.Bt[J][1], P1, b);
        f32x16 k = RK_MF(T.Kt[J][0], P0, f32x16{}); k = RK_MF(T.Kt[J][1], P1, k);
#pragma unroll
        for (int reg = 0; reg < 16; ++reg) { b[reg] *= gcj; k[reg] *= gcj; }
        Bop[J][0] = pack<0>(b); Bop[J][1] = pack<1>(b); Kop[J][0] = pack<0>(k); Kop[J][1] = pack<1>(k);
    }
    u32x4* phi = (u32x4*)(ws + WS_HALF + H_PHI) + (size_t)u * 512 + lane;
    u32x4* psi = (u32x4*)(ws + WS_HALF + H_PSI) + (size_t)u * 512 + lane;
#pragma unroll
    for (int I = 0; I < 2; ++I)
#pragma unroll
        for (int J = 0; J < 2; ++J) {
            f32x16 a = RK_MF(W1p[I][0], Bop[J][0], f32x16{}); a = RK_MF(W1p[I][1], Bop[J][1], a);
            if (I == J) {
#pragma unroll
                for (int reg = 0; reg < 16; ++reg) a[reg] += (crow(reg, h) == r) ? __expf(T.gtot[J]) : 0.f; }
            phi[((I * 2 + J) * 2 + 0) * 64] = __builtin_bit_cast(u32x4, pack<0>(a)); phi[((I * 2 + J) * 2 + 1) * 64] = __builtin_bit_cast(u32x4, pack<1>(a));
            f32x16 p = RK_MF(Bop[I][0], W2p[J][0], f32x16{}); p = RK_MF(Bop[I][1], W2p[J][1], p); p = RK_MF(Kop[I][0], T.Vp[J][0], p); p = RK_MF(Kop[I][1], T.Vp[J][1], p);
            psi[((I * 2 + J) * 2 + 0) * 64] = (u32x4){cvt2(p[0], p[1]), cvt2(p[2], p[3]), cvt2(p[4], p[5]), cvt2(p[6], p[7])};
            psi[((I * 2 + J) * 2 + 1) * 64] = (u32x4){cvt2(p[8], p[9]), cvt2(p[10], p[11]), cvt2(p[12], p[13]), cvt2(p[14], p[15])};
        }
}
RK_DI void pass2_chain(unsigned char* ws, int q, int lane, bool do_store) {
    const int dir = q & 1;
    f32x16 H[2][2] = {{f32x16{}, f32x16{}}, {f32x16{}, f32x16{}}};
    u32x4 phi[8], psi[8];
    { const int u0 = q * NSUB + chain_unit(dir, 0);
      const u32x4* ph = (const u32x4*)(ws + WS_HALF + H_PHI) + (size_t)u0 * 512 + lane; const u32x4* ps = (const u32x4*)(ws + WS_HALF + H_PSI) + (size_t)u0 * 512 + lane;
#pragma unroll
      for (int f = 0; f < 8; ++f) { phi[f] = ph[f * 64]; psi[f] = ps[f * 64]; } }
    int uprev = q * NSUB + chain_unit(dir, 0);
#pragma unroll 1
    for (int j = 0; j < NSUB - 1; ++j) {
        const int un = q * NSUB + chain_unit(dir, j + 1 < NSUB - 1 ? j + 1 : j);
        u32x4 nphi[8], npsi[8];
        { const u32x4* ph = (const u32x4*)(ws + WS_HALF + H_PHI) + (size_t)un * 512 + lane; const u32x4* ps = (const u32x4*)(ws + WS_HALF + H_PSI) + (size_t)un * 512 + lane;
#pragma unroll
          for (int f = 0; f < 8; ++f) { nphi[f] = ph[f * 64]; npsi[f] = ps[f * 64]; } }
        bf16x8 Hp[2][2][2];
#pragma unroll
        for (int I = 0; I < 2; ++I)
#pragma unroll
            for (int J = 0; J < 2; ++J) { Hp[I][J][0] = pack<0>(H[I][J]); Hp[I][J][1] = pack<1>(H[I][J]); }
#pragma unroll
        for (int Ik = 0; Ik < 2; ++Ik)
#pragma unroll
            for (int Jv = 0; Jv < 2; ++Jv) {
                f32x16 a; const u32x4 p0 = psi[(Ik * 2 + Jv) * 2], p1 = psi[(Ik * 2 + Jv) * 2 + 1];
                a[0] = lo16(p0.x); a[1] = hi16(p0.x); a[2] = lo16(p0.y); a[3] = hi16(p0.y); a[4] = lo16(p0.z); a[5] = hi16(p0.z); a[6] = lo16(p0.w); a[7] = hi16(p0.w);
                a[8] = lo16(p1.x); a[9] = hi16(p1.x); a[10] = lo16(p1.y); a[11] = hi16(p1.y); a[12] = lo16(p1.z); a[13] = hi16(p1.z); a[14] = lo16(p1.w); a[15] = hi16(p1.w);
#pragma unroll
                for (int Ip = 0; Ip < 2; ++Ip) { a = RK_MF(__builtin_bit_cast(bf16x8, phi[(Ip * 2 + Ik) * 2 + 0]), Hp[Ip][Jv][0], a); a = RK_MF(__builtin_bit_cast(bf16x8, phi[(Ip * 2 + Ik) * 2 + 1]), Hp[Ip][Jv][1], a); }
                H[Ik][Jv] = a; }
        if (do_store) { u32x4* st = (u32x4*)(ws + WS_HALF + H_PSI) + (size_t)uprev * 512 + lane;
#pragma unroll
            for (int I = 0; I < 2; ++I)
#pragma unroll
                for (int J = 0; J < 2; ++J) { st[((I * 2 + J) * 2 + 0) * 64] = __builtin_bit_cast(u32x4, pack<0>(H[I][J])); st[((I * 2 + J) * 2 + 1) * 64] = __builtin_bit_cast(u32x4, pack<1>(H[I][J])); } }
        uprev = un;
#pragma unroll
        for (int f = 0; f < 8; ++f) { phi[f] = nphi[f]; psi[f] = npsi[f]; }
    }
    if (!do_store) { float chk = 0.f;
#pragma unroll
        for (int I = 0; I < 2; ++I)
#pragma unroll
            for (int J = 0; J < 2; ++J)
#pragma unroll
                for (int reg = 0; reg < 16; ++reg) chk += H[I][J][reg];
        if (chk == 123456.789f) ((float*)(ws + WS_END))[lane] = chk; }
}
RK_DI void pass2_half(unsigned char* ws, int q, int jv, int lane) {
    static_assert((NSUB - 1) % 3 == 0, "three-step rotation");
    const int dir = q & 1;
    bf16x8 Hp[2][2] = {{bf16x8{}, bf16x8{}}, {bf16x8{}, bf16x8{}}};
#define P2_LD(jj, PH, PS) do { const int jc_ = (jj) < NSUB - 1 ? (jj) : NSUB - 2; const int un_ = q * NSUB + chain_unit(dir, jc_); \
        const u32x4* ph_ = (const u32x4*)(ws + WS_HALF + H_PHI) + (size_t)un_ * 512 + lane; const u32x4* ps_ = (const u32x4*)(ws + WS_HALF + H_PSI) + (size_t)un_ * 512 + jv * 128 + lane; \
        _Pragma("unroll") for (int f = 0; f < 8; ++f) PH[f] = ph_[f * 64]; \
        PS[0] = ps_[0]; PS[1] = ps_[64]; PS[2] = ps_[256]; PS[3] = ps_[320]; } while (0)
#define P2_UNPK(A, p0, p1) do { A[0] = lo16(p0.x); A[1] = hi16(p0.x); A[2] = lo16(p0.y); A[3] = hi16(p0.y); A[4] = lo16(p0.z); A[5] = hi16(p0.z); A[6] = lo16(p0.w); A[7] = hi16(p0.w); \
        A[8] = lo16(p1.x); A[9] = hi16(p1.x); A[10] = lo16(p1.y); A[11] = hi16(p1.y); A[12] = lo16(p1.z); A[13] = hi16(p1.z); A[14] = lo16(p1.w); A[15] = hi16(p1.w); } while (0)
#define P2_STEP(jj, PH, PS) do { f32x16 a0, a1; P2_UNPK(a0, PS[0], PS[1]); P2_UNPK(a1, PS[2], PS[3]); \
        _Pragma("unroll") for (int Ip = 0; Ip < 2; ++Ip) { \
            a0 = RK_MF(__builtin_bit_cast(bf16x8, PH[(Ip * 2 + 0) * 2 + 0]), Hp[Ip][0], a0); a1 = RK_MF(__builtin_bit_cast(bf16x8, PH[(Ip * 2 + 1) * 2 + 0]), Hp[Ip][0], a1); \
            a0 = RK_MF(__builtin_bit_cast(bf16x8, PH[(Ip * 2 + 0) * 2 + 1]), Hp[Ip][1], a0); a1 = RK_MF(__builtin_bit_cast(bf16x8, PH[(Ip * 2 + 1) * 2 + 1]), Hp[Ip][1], a1); } \
        Hp[0][0] = pack<0>(a0); Hp[0][1] = pack<1>(a0); Hp[1][0] = pack<0>(a1); Hp[1][1] = pack<1>(a1); \
        u32x4* st_ = (u32x4*)(ws + WS_HALF + H_PSI) + (size_t)(q * NSUB + chain_unit(dir, (jj))) * 512 + jv * 128 + lane;        \
        st_[0] = __builtin_bit_cast(u32x4, Hp[0][0]); st_[64] = __builtin_bit_cast(u32x4, Hp[0][1]); st_[256] = __builtin_bit_cast(u32x4, Hp[1][0]); st_[320] = __builtin_bit_cast(u32x4, Hp[1][1]); } while (0)
    u32x4 phA[8], psA[4], phB[8], psB[4], phC[8], psC[4];
    P2_LD(0, phA, psA); P2_LD(1, phB, psB);
#pragma unroll 1
    for (int j = 0; j < NSUB - 1; j += 3) {
        P2_LD(j + 2, phC, psC); P2_STEP(j, phA, psA);
        P2_LD(j + 3, phA, psA); P2_STEP(j + 1, phB, psB);
        P2_LD(j + 4, phB, psB); P2_STEP(j + 2, phC, psC);
    }
#undef P2_LD
#undef P2_UNPK
#undef P2_STEP
}
RK_DI void pass3_dir(const int DIR, unsigned char* ws, LAS unsigned char* sb, int l, int bl, int hd, int c32, int lane, f32x16 (&Y)[2], float& bons) {
    Ctx c; setup_ctx(c, ws, sb, l, bl, hd, DIR, c32, lane);
    const int r = c.r, h = c.h;
    Tilde T; build_tilde<true>(c, T); __builtin_amdgcn_sched_barrier(0);
    bons += T.bon + __shfl_xor(T.bon, 32);
    bf16x8 Lk[2], Mp[2]; grams_la(c, T, Lk, Mp); __builtin_amdgcn_sched_barrier(0);
    bf16x8 Ab[2], Ak[2];
    {   f32x16 gb = f32x16{}, gk = f32x16{};
#pragma unroll
        for (int Ik = 0; Ik < 2; ++Ik)
#pragma unroll
            for (int S = 0; S < 2; ++S) { gb = RK_MF(T.Bt[Ik][S], T.Rt[Ik][S], gb); gk = RK_MF(T.Kt[Ik][S], T.Rt[Ik][S], gk); }
        tmask<false>(gb, r, h, DIR); tmask<false>(gk, r, h, DIR);
        Ab[0] = pack<0>(gb); Ab[1] = pack<1>(gb); Ak[0] = pack<0>(gk); Ak[1] = pack<1>(gk); }
    RK_STAGE(Ak[1]);
    bf16x8 H0p[2][2][2];
    { const int q = (bl * 8 + hd) * 2 + DIR, j = chain_pos(DIR, c32);
      if (j > 0) { const u32x4* st = (const u32x4*)(ws + WS_HALF + H_PSI) + (size_t)(q * NSUB + chain_unit(DIR, j - 1)) * 512 + lane;
#pragma unroll
          for (int I = 0; I < 2; ++I)
#pragma unroll
              for (int J = 0; J < 2; ++J) { H0p[I][J][0] = __builtin_bit_cast(bf16x8, st[((I * 2 + J) * 2 + 0) * 64]); H0p[I][J][1] = __builtin_bit_cast(bf16x8, st[((I * 2 + J) * 2 + 1) * 64]); } }
      else {
#pragma unroll
          for (int I = 0; I < 2; ++I)
#pragma unroll
              for (int J = 0; J < 2; ++J) { H0p[I][J][0] = bf16x8{}; H0p[I][J][1] = bf16x8{}; } } }
    bf16x8 Up[2][2];
    {   f32x16 xs[2];
#pragma unroll
        for (int Jv = 0; Jv < 2; ++Jv) {
            f32x16 x = RK_MF(Lk[0], T.Vp[Jv][0], f32x16{}); x = RK_MF(Lk[1], T.Vp[Jv][1], x);
#pragma unroll
            for (int Ik = 0; Ik < 2; ++Ik) { x = RK_MF(T.At[Ik][0], H0p[Ik][Jv][0], x); x = RK_MF(T.At[Ik][1], H0p[Ik][Jv][1], x); }
            xs[Jv] = x; }
        if (DIR) solve32p<1>(xs[0], xs[1], Mp); else solve32p<0>(xs[0], xs[1], Mp);
#pragma unroll
        for (int Jv = 0; Jv < 2; ++Jv) { Up[Jv][0] = pack<0>(xs[Jv]); Up[Jv][1] = pack<1>(xs[Jv]); }
        __builtin_amdgcn_sched_barrier(0); }
    __builtin_amdgcn_sched_barrier(0);
#pragma unroll
    for (int Iv = 0; Iv < 2; ++Iv) {
        f32x16 y = f32x16{};
#pragma unroll
        for (int Ik = 0; Ik < 2; ++Ik) { y = RK_MF(H0p[Ik][Iv][0], T.Rt[Ik][0], y); y = RK_MF(H0p[Ik][Iv][1], T.Rt[Ik][1], y); }
        y = RK_MF(Up[Iv][0], Ab[0], y); y = RK_MF(Up[Iv][1], Ab[1], y); y = RK_MF(T.Vp[Iv][0], Ak[0], y); y = RK_MF(T.Vp[Iv][1], Ak[1], y);
        Y[Iv] = y; }
}
RK_DI void pass3_unit(unsigned char* ws, LAS unsigned char* sb, int l, int v3, int lane, unsigned* ypark) {
    const int c32 = v3 % NSUB, bh = v3 / NSUB, bl = bh >> 3, hd = bh & 7, r = lane & 31, h = lane >> 5;
    float bons = 0.f;
    LAS float* ylds = (LAS float*)(sb + SBUF);
#pragma unroll 1
    for (int dir = 0; dir < 2; ++dir) {
        int lane_ = lane; asm volatile("" : "+v"(lane_));
        f32x16 Y[2]; pass3_dir(dir, ws, sb, l, bl, hd, c32, lane_, Y, bons);
        if (dir == 0) {
#pragma unroll
            for (int Iv = 0; Iv < 2; ++Iv)
#pragma unroll
                for (int d = 0; d < 8; ++d) ypark[(Iv * 8 + d) * 64 + lane] = cvt2(Y[Iv][2 * d], Y[Iv][2 * d + 1]); }
        else {
#pragma unroll
            for (int Iv = 0; Iv < 2; ++Iv)
#pragma unroll
                for (int reg = 0; reg < 16; ++reg) ylds[(Iv * 16 + reg) * 64 + lane] = Y[Iv][reg]; }
        __builtin_amdgcn_sched_barrier(0); }
    f32x16 YT[2];
#pragma unroll
    for (int Iv = 0; Iv < 2; ++Iv)
#pragma unroll
        for (int d = 0; d < 8; ++d) { const unsigned w = ypark[(Iv * 8 + d) * 64 + lane]; YT[Iv][2 * d] = ylds[(Iv * 16 + 2 * d) * 64 + lane] + lo16(w); YT[Iv][2 * d + 1] = ylds[(Iv * 16 + 2 * d + 1) * 64 + lane] + hi16(w); }
    Ctx c; setup_ctx(c, ws, sb, l, bl, hd, 0, c32, lane);
    RK_WAIT_LDS(); stage_slice(c, 1, RW_GD); stage_slice(c, 2, RW_GD + 64); RK_WAIT_DMA();
    float sm = 0.f;
#pragma unroll
    for (int Iv = 0; Iv < 2; ++Iv)
#pragma unroll
        for (int reg = 0; reg < 16; ++reg) sm += YT[Iv][reg];
    sm += __shfl_xor(sm, 32); const float mean = sm * (1.f / 64.f); float vq = 0.f;
#pragma unroll
    for (int Iv = 0; Iv < 2; ++Iv)
#pragma unroll
        for (int reg = 0; reg < 16; ++reg) { YT[Iv][reg] -= mean; vq += YT[Iv][reg] * YT[Iv][reg]; }
    vq += __shfl_xor(vq, 32); const float rstd = 1.f / sqrtf(vq * (1.f / 64.f) + LNX_EPS);
    const bf16* g2P = (const bf16*)(ws + WS_TAB + 524288) + (size_t)hd * 8192;
    const float* lnw = inp(I_LNW) + l * 512 + hd * 64; const float* lnb = inp(I_LNB) + l * 512 + hd * 64;
    bf16x8 sgp[4][2];
#pragma unroll
    for (int Ii = 0; Ii < 4; ++Ii) { f32x16 t = load_o2(c, 1 + (Ii >> 1), Ii & 1, RW_GD + 32 * Ii);
#pragma unroll
        for (int reg = 0; reg < 16; ++reg) t[reg] = sigm(t[reg]);
        sgp[Ii][0] = pack<0>(t); sgp[Ii][1] = pack<1>(t); __builtin_amdgcn_sched_barrier(0); }
    RK_WAIT_LDS(); LAS unsigned char* st = c.sb + SBUF;
#pragma unroll
    for (int Iv = 0; Iv < 2; ++Iv) {
        f32x16 gt = f32x16{};
#pragma unroll
        for (int Ii = 0; Ii < 4; ++Ii)
#pragma unroll
            for (int S = 0; S < 2; ++S) { gt = RK_MF(*(const bf16x8*)(g2P + ((Ii * 2 + Iv) * 2 + S) * 512 + c.lofs), sgp[Ii][S], gt); if (S) RK_STAGE(gt); }
        const f32x16 vt = load_o2(c, 0, Iv, RW_V + hd * 64 + 32 * Iv);
#pragma unroll
        for (int g = 0; g < 4; ++g) { const int v0 = 32 * Iv + 8 * g + 4 * h; const f32x4 lw = *(const f32x4*)(lnw + v0), lb = *(const f32x4*)(lnb + v0); float o[4];
#pragma unroll
            for (int j = 0; j < 4; ++j) { const int reg = 4 * g + j; o[j] = (YT[Iv][reg] * rstd * lw[j] + lb[j] + bons * vt[reg]) * gt[reg]; }
            *(LAS unsigned long long*)(st + r * 144 + 2 * v0) = (unsigned long long)cvt2(o[0], o[1]) | ((unsigned long long)cvt2(o[2], o[3]) << 32); }
    }
    asm volatile("s_waitcnt lgkmcnt(0)" ::: "memory");
    bf16* RO = (bf16*)(ws + WS_HALF + H_PP) + (size_t)c.m0 * PPW + C_QD + hd * 64;
#pragma unroll
    for (int i = 0; i < 4; ++i) { const int id = i * 64 + lane, row = id >> 3, ch = id & 7; const u32x4 v = *(const LAS u32x4*)(st + row * 144 + ch * 16); *(u32x4*)(RO + (size_t)row * PPW + ch * 8) = v; }
    asm volatile("s_waitcnt lgkmcnt(0)" ::: "memory");
}
}

__device__ __forceinline__ void ph_rwkv1(Frame& F, int l) {
    const int gw = F.bid * NWAVES + FWAVE(), NGW = F.G * NWAVES; LAS unsigned char* sb = F.lds + FWAVE() * (4 * rk::SBUF);
#pragma unroll 1
    for (int u = gw; u < NUNIT; u += NGW) rk::pass1_unit(F.ws, sb, l, u, otid() & 63);
    asm volatile("s_waitcnt vmcnt(0) lgkmcnt(0)" ::: "memory");
}
__device__ __forceinline__ void ph_rwkv3(Frame& F, int l, bool ctx_emit) {
    const int gw = F.bid * NWAVES + FWAVE(), NGW = F.G * NWAVES; LAS unsigned char* sb = F.lds + FWAVE() * (4 * rk::SBUF);
    unsigned* ypark = (unsigned*)(F.ws + WS_END) + (size_t)gw * 1024;
    const int per = ctx_emit ? rk::NSUB : rk::NSUB - 8, nun = 16 * per;
#pragma unroll 1
    for (int j = gw; j < nun; j += NGW) { const int v3 = (j / per) * rk::NSUB + (rk::NSUB - per) + j % per; rk::pass3_unit(F.ws, sb, l, v3, otid() & 63, ypark); }
    asm volatile("s_waitcnt vmcnt(0) lgkmcnt(0)" ::: "memory");
}
__device__ __forceinline__ void ph_mixer(Frame& F, int l, int half, int rep) {
    const bool ctx_out = (l == 0);
#ifdef EXTRA_P2
    if (F.bid < 4 && rep == 0) rk::pass2_chain(F.ws, F.bid * 8 + FWAVE(), otid() & 63, false);
#endif
    if (F.bid < 16 && rep == 0 && FWAVE() < 4) { const int ch = F.bid * 4 + FWAVE(); rk::pass2_half(F.ws, ch >> 1, ch & 1, otid() & 63); }
    __syncthreads();
    unsigned* ctr = F.ctl + CW_ATT + ((l * 2 + half) * 2 + rep) * 64;
    LAS unsigned* slot = (LAS unsigned*)(F.lds + MISC_OFF);
    const bf16* PP = (const bf16*)(F.ws + WS_HALF + H_PP); const bf16* QM = (const bf16*)(F.ws + WS_HALF + H_QM); const bf16* KVM = (const bf16*)(F.ws + WS_HALF + H_KVM);
    bf16* MO = (bf16*)(F.ws + WS_HALF + H_MO); bf16* DUM = (bf16*)(F.ws + WS_END);
    const int nunits = ctx_out ? 544 : 512;
    for (;;) {
        if (FTID() == 0) slot[0] = atomicAdd(ctr, 1u);
        __syncthreads();
        const int u = (int)slot[0];
        __syncthreads();
        if (u >= nunits) break;
        int type, bl, h, qb, nkeys, qrow0;
        if (u < 512) { type = u >> 8; const int v = u & 255; bl = v >> 7; h = (v >> 4) & 7; qb = v & 15; nkeys = RPB; qrow0 = bl * RPB + CTX + qb * 256; }
        else { const int v = u - 512; type = v >> 4; bl = (v >> 3) & 1; h = v & 7; qb = 0; nkeys = CTX; qrow0 = bl * RPB; }
        const int krow0 = bl * RPB;
        att::Args a;
        if (type == 0) {
            a.Q = QM + (size_t)qrow0 * 768 + h * 96; a.ldq = 768; a.K0 = KVM + (size_t)krow0 * 1024 + h * 128; a.ldk0 = 1024; a.K1 = PP + (size_t)krow0 * PPW + C_KR; a.ldk1 = PPW;
            a.V = KVM + (size_t)krow0 * 1024 + h * 128 + 64; a.ldv = 1024; a.O = (rep ? DUM : MO) + (size_t)qrow0 * 512 + h * 64; a.ldo = 512; a.nkeys = nkeys;
            a.rope_t0 = (u < 512) ? qb * 256 : -1; a.tc = (const float*)(F.ws + WS_T8C); a.ts = (const float*)(F.ws + WS_T8S);
            at96::Args b; b.Q = a.Q; b.ldq = a.ldq; b.K0 = a.K0; b.ldk0 = a.ldk0; b.K1 = a.K1; b.ldk1 = a.ldk1; b.V = a.V; b.ldv = a.ldv; b.O = a.O; b.ldo = a.ldo; b.nkeys = a.nkeys;
            b.rope_t0 = a.rope_t0; b.tc = a.tc; b.ts = a.ts;
            at96::unit(b, (char*)F.ldsg);
        } else {
            const int kvh = h >> 2;
            a.Q = PP + (size_t)qrow0 * PPW + C_GQ + h * 64; a.ldq = PPW; a.K0 = PP + (size_t)krow0 * PPW + C_GK + kvh * 64; a.ldk0 = PPW; a.K1 = a.K0; a.ldk1 = PPW;
            a.V = PP + (size_t)krow0 * PPW + C_GV + kvh * 64; a.ldv = PPW; a.O = rep ? DUM + (size_t)qrow0 * 512 + h * 64 : (bf16*)PP + (size_t)qrow0 * PPW + C_GQ + h * 64; a.ldo = rep ? 512 : PPW; a.nkeys = nkeys; a.rope_t0 = -1; a.tc = nullptr; a.ts = nullptr;
            at64::Args b; b.Q = a.Q; b.ldq = a.ldq; b.K = a.K0; b.ldk = a.ldk0; b.V = a.V; b.ldv = a.ldv; b.O = a.O; b.ldo = a.ldo; b.nkeys = a.nkeys;
            at64::unit(b, (char*)F.ldsg);
        }
    }
}

enum { OP_W0 = 0, OP_NORM1, OP_INPROJ, OP_PREP, OP_UP, OP_MIXER, OP_FINISH, OP_GATE, OP_MERGE, OP_WOUT, OP_NORM2, OP_FFUP, OP_FFDOWN, OP_FINAL };
constexpr int N_PHASES = 40;
__global__ void __launch_bounds__(NWAVES * 64, 2) trunk_fwd(Args args) {
    extern __shared__ __attribute__((aligned(16))) unsigned char lds[];
    Frame F;
    F.lds = (LAS unsigned char*)lds; F.ldsg = lds;
    F.G = gridDim.x; F.bid = blockIdx.x; F.ws = args.ws; F.ctl = (unsigned*)(args.ws + WS_CTL); F.out = args.out;
    volatile LAS unsigned* MISC = (volatile LAS unsigned*)(F.lds + MISC_OFF);
    for (int u = threadIdx.x; u < 32; u += NWAVES * 64) MISC[u] = 0u;
    __syncthreads();
    const int lo = args.ph_lo, hi = args.ph_hi;
    XcdBarrier bar = xcd_barrier_post(F.ctl + CW_BAR, MISC + 8);
#ifdef EXTRA_OP
    for (int pp = 2 * lo; pp < 2 * hi; ++pp) { const int p = pp >> 1, rep = pp & 1;
#else
    for (int p = lo; p < hi; ++p) { const int rep = 0;
#endif
        GAS unsigned char* wsg_ = (GAS unsigned char*)args.ws; GAS float* outg_ = (GAS float*)args.out; int bid_ = blockIdx.x, G_ = gridDim.x;
        asm volatile("" : "+s"(wsg_), "+s"(outg_), "+s"(bid_), "+s"(G_));
        unsigned char* ws = (unsigned char*)wsg_; float* outp = (float*)outg_;
        F.ws = ws; F.out = outp; F.bid = bid_; F.G = G_; F.ctl = (unsigned*)(ws + WS_CTL);
        unsigned char* wt = ws + WS_WT; const bf16* XN = (const bf16*)(ws + WS_XN); float* ctxx = (float*)(ws + WS_CTXX);
        int op, l = 0, half = 0;
        if (p == 0) op = OP_W0; else if (p == N_PHASES - 1) op = OP_FINAL;
        else { const int q = p - 1, r = q % 19; l = q / 19; if (r == 0) op = OP_NORM1; else if (r <= 8) { half = 0; op = OP_INPROJ + (r - 1); } else if (r <= 15) { half = 1; op = OP_PREP + (r - 9); } else op = OP_NORM2 + (r - 16); }
#ifdef ONLY_OP
        op = ONLY_OP;
#endif
#ifdef EXTRA_OP
        if (rep && op != EXTRA_OP) continue;
#endif
        const float* xl = (l == 0) ? inp(I_X) : F.out; const float* xc = (l == 0) ? inp(I_CTX) : ctxx;
        const bool ctx_out = (l == 0);
        const int nMf = ctx_out ? 68 : 64, nMh = ctx_out ? 34 : 32, skipf = ctx_out ? 0 : 1;
        switch (op) {
        case OP_W0: ph_weights(F, 0); break;
        case OP_NORM1: if (l == 1) ph_weights(F, 1); ph_norm(F, l, xl, xc, inp(I_G1) + l * DM, 0, false, (l == 1) ? (const float*)(ws + WS_END) : nullptr); break;
#define RUN_INPROJ(hh) do { pg8::Gemm g_{XN + (size_t)(hh) * HM * DM, (const bf16*)(wt + WT_IN), DM, DM, DM}; pg8::TileOrder S_; S_.init(HM / 256, PPW / 256, F.G, F.bid, 0); \
            pg8::Epi<pg8::EPI_BF16> E_{}; E_.O = (bf16*)(ws + WS_HALF + H_PP); E_.ldc = PPW; pg8::gemm_phase<pg8::Epi<pg8::EPI_BF16>, pg8::TileOrder, true>(F.lds, g_, S_, E_); } while (0)
        case OP_INPROJ: RUN_INPROJ(half); break;
        case OP_PREP: if (rep == 0) ph_prep(F, l, half); ph_rwkv1(F, l); break;
        case OP_UP: {
            { pg8::Gemm g{(const bf16*)(ws + WS_HALF + H_PP) + C_QD, (const bf16*)(wt + WT_QU), PPW, 384, 384}; pg8::TileOrder S; S.init(HM / 256, 3, F.G, F.bid, 0);
              pg8::Epi<pg8::EPI_ROWSCALE> E{}; E.O = (bf16*)(ws + WS_HALF + H_QM); E.ldc = 768; E.rs = (const float*)(ws + WS_RSQ);
              pg8::gemm_phase<pg8::Epi<pg8::EPI_ROWSCALE>, pg8::TileOrder, true>(F.lds, g, S, E); }
            { pg8::Gemm g{(const bf16*)(ws + WS_HALF + H_PP) + C_KVD, (const bf16*)(wt + WT_KVU), PPW, 256, 256}; pg8::TileOrder S; S.init(HM / 256, 4, F.G, (F.bid + 102) % F.G, 0);
              pg8::Epi<pg8::EPI_ROWSCALE> E{}; E.O = (bf16*)(ws + WS_HALF + H_KVM); E.ldc = 1024; E.rs = (const float*)(ws + WS_RSKV);
              pg8::gemm_phase<pg8::Epi<pg8::EPI_ROWSCALE>, pg8::TileOrder, true>(F.lds, g, S, E); } } break;
        case OP_MIXER: ph_mixer(F, l, half, rep); break;
        case OP_FINISH: ph_rwkv3(F, l, ctx_out); if (ctx_out) __syncthreads(); break;
        case OP_GATE: {
            const int gs = ctx_out ? 16 : 0;
            if (F.bid >= gs) { pg8::Gemm g{XN + (size_t)half * HM * DM, (const bf16*)(wt + WT_G), DM, DM, DM}; pg8::TileOrder S; S.init(nMh, 12, F.G - gs, F.bid - gs, skipf);
                pg8::Epi<pg8::EPI_SIGMOID> E{}; E.O = (bf16*)(ws + WS_G0); E.O1 = (bf16*)(ws + WS_G1); E.O2 = (bf16*)(ws + WS_G2); E.ldc = DM;
                pg8::gemm_phase<pg8::Epi<pg8::EPI_SIGMOID>, pg8::TileOrder, true>(F.lds, g, S, E); } } break;
        case OP_MERGE: {
            for (int i = 0; i < 3; ++i) {
                const bf16* A = (i == 0) ? (const bf16*)(ws + WS_HALF + H_PP) + C_GQ : (i == 1) ? (const bf16*)(ws + WS_HALF + H_PP) + C_QD : (const bf16*)(ws + WS_HALF + H_MO);
                pg8::Gemm g{A, (const bf16*)(wt + WT_BR) + (size_t)i * DM * 512, (i == 2) ? 512 : PPW, 512, 512}; pg8::TileOrder S; S.init(nMh, 4, F.G, F.bid, skipf);
                pg8::Epi<pg8::EPI_GATEMUL> E{}; E.O = (bf16*)(ws + WS_MIX); E.ldc = DM; E.G = (const bf16*)(ws + ((i == 0) ? WS_G0 : (i == 1) ? WS_G1 : WS_G2)); E.ldg = DM; E.first = (i == 0);
                pg8::gemm_phase<pg8::Epi<pg8::EPI_GATEMUL>, pg8::TileOrder, true>(F.lds, g, S, E); }
            } break;
        case OP_WOUT: {
            pg8::Gemm g{(const bf16*)(ws + WS_MIX), (const bf16*)(wt + WT_OUT), DM, DM, DM}; pg8::TileOrder S; S.init(nMh, 4, F.G, F.bid, skipf);
            pg8::Epi<pg8::EPI_RESID> E{}; E.xsl = xl; E.xsc = xc; E.xdl = F.out; E.xdc = ctxx; E.gate = (const float*)(ws + WS_MOD) + (size_t)l * 5 * 6144 + 2048; E.pm_off = half * 34; E.part = nullptr; E.kslice = 1;
            pg8::gemm_phase<pg8::Epi<pg8::EPI_RESID>, pg8::TileOrder, true>(F.lds, g, S, E);
            if (half == 0) RUN_INPROJ(1);
            } break;
        case OP_NORM2: ph_norm(F, l, F.out, ctxx, inp(I_G2) + l * DM, 1, !ctx_out); break;
        case OP_FFUP: {
            pg8::Gemm g{XN, (const bf16*)(wt + WT_F1), DM, DM, DM}; pg8::TileOrder S; S.init(nMf, 16, F.G, F.bid, skipf);
            pg8::Epi<pg8::EPI_RELU2> E{}; E.O = (bf16*)(ws + WS_HID); E.ldc = DFF;
            pg8::gemm_phase<pg8::Epi<pg8::EPI_RELU2>, pg8::TileOrder, true>(F.lds, g, S, E); } break;
        case OP_FFDOWN: {
            pg8::Gemm g{(const bf16*)(ws + WS_HID), (const bf16*)(wt + WT_F2), DFF, DFF, DFF}; pg8::TileOrder S; S.init(64, 4, F.G, F.bid, 1);
            pg8::Epi<pg8::EPI_RESID> E{}; E.xsl = F.out; E.xsc = ctxx; E.xdl = F.out; E.xdc = ctxx; E.gate = (const float*)(ws + WS_MOD) + (size_t)l * 5 * 6144 + 5120; E.pm_off = 0; E.part = nullptr; E.kslice = 1;
            pg8::gemm_phase<pg8::Epi<pg8::EPI_RESID>, pg8::TileOrder, true>(F.lds, g, S, E);
            if (ctx_out) { pg8::Gemm g2{(const bf16*)(ws + WS_HID), (const bf16*)(wt + WT_F2), DFF, DFF, DFF / 4}; pg8::CtxSplitOrder S2; S2.init(F.G, F.bid, DFF / 4);
                E.part = (float*)(ws + WS_END); E.kslice = DFF / 4; pg8::gemm_phase<pg8::Epi<pg8::EPI_RESID>, pg8::CtxSplitOrder, true>(F.lds, g2, S2, E); } } break;
        default: ph_final(F); break;
        }
        if (op == OP_FINISH && ctx_out) continue;
#ifdef EXTRA_OP
        if (pp + 1 < 2 * hi) xcd_barrier(bar);
#else
        if (p + 1 < hi) xcd_barrier(bar);
#endif
    }
}

extern "C" void kernel_launch(void* const* d_in, const int* in_sizes, int n_in, void* d_out, int out_size, void* d_ws, size_t ws_size, hipStream_t stream) {
    static int grid = 0;
    if (grid == 0) {
        if (n_in != 31 || out_size != NB * SEQ * DM || ws_size < WS_END + 12 * MiB) { fprintf(stderr, "kernel_launch: unexpected shapes (n_in %d out %d ws %zu, need ws >= %zu)\n", n_in, out_size, ws_size, (size_t)WS_END); grid = -1; return; }
        int dev = 0, cus = 0;
        if (hipGetDevice(&dev) != hipSuccess || hipDeviceGetAttribute(&cus, hipDeviceAttributeMultiprocessorCount, dev) != hipSuccess) { grid = -1; return; }
        if (hipFuncSetAttribute((const void*)trunk_fwd, hipFuncAttributeMaxDynamicSharedMemorySize, LDS_BYTES) != hipSuccess) { fprintf(stderr, "kernel_launch: hipFuncSetAttribute failed\n"); grid = -1; return; }
        grid = cus;
    }
    if (grid < 0) return;
    (void)hipMemsetAsync((char*)d_ws + WS_CTL, 0, CTL_BYTES, stream);
    Args a{};
    for (int i = 0; i < 31; ++i) a.in[i] = (const float*)d_in[i];
    a.out = (float*)d_out; a.ws = (unsigned char*)d_ws;
#if ONE_LAUNCH
    a.ph_lo = 0; a.ph_hi = N_PHASES;
    hipLaunchKernelGGL(trunk_fwd, dim3(grid), dim3(NWAVES * 64), LDS_BYTES, stream, a);
#else
    for (int p = 0; p < N_PHASES; ++p) { a.ph_lo = p; a.ph_hi = p + 1; hipLaunchKernelGGL(trunk_fwd, dim3(grid), dim3(NWAVES * 64), LDS_BYTES, stream, a); }
#endif
}
```

```cpp
#include <hip/hip_runtime.h>
#include <hip/hip_bf16.h>
#include <cstdio>
#include <cstdint>

#ifndef ONE_LAUNCH
#define ONE_LAUNCH 1
#define P2_WGS 8
#endif

constexpr int DM = 1024, NB = 4, SEQ = 4096, CTX = 256, RPB = SEQ + CTX  , MROWS = NB * RPB  , HM = 2 * RPB  ;
constexpr int NIN = 6432, PPW = 3584  , NGATE = 3072;
constexpr int C_GQ = 0, C_GK = 512, C_GV = 640, C_RW = 768, C_QD = 2688, C_KVD = 3072, C_KR = 3328, C_GATE = 3360;
constexpr int RW_R = 0, RW_K = 512, RW_V = 1024, RW_WD = 1536, RW_AD = 1664, RW_GD = 1792, RWIN = 1920;
constexpr int DFF = 4096;
constexpr float NORM_EPS = 1e-6f, LNX_EPS = 64e-5f;

__device__ __forceinline__ int otid() { int t = threadIdx.x; asm volatile("" : "+v"(t)); return t; }
namespace pg8 {
#define PG8_LAS __attribute__((address_space(3)))
typedef unsigned short bf16_t;
typedef short bf16x8 __attribute__((ext_vector_type(8)));
typedef float f32x4 __attribute__((ext_vector_type(4)));
typedef unsigned u32x4 __attribute__((ext_vector_type(4)));
constexpr int BM = 256, BK = 64, HALF = 128, HTB = HALF * BK * 2, STAGE_BYTES = 8 * HTB, NXCD = 8, WGM = 8;

__host__ __device__ __forceinline__ int lds_byte(int r, int c) { const int st = (r >> 4) * 2 + (c >> 5), rr = r & 15, cc = c & 31, ob = rr * 64 + cc * 2; return st * 1024 + (ob ^ (((ob >> 9) & 1) << 5)); }
__host__ __device__ __forceinline__ void stage_rc(int b, int& R, int& C) { const int st = b / 1024, sb = b % 1024, swz = sb ^ (((sb >> 9) & 1) << 5); R = (st >> 1) * 16 + swz / 64; C = (st & 1) * 32 + (swz % 64) / 2; }
__host__ __device__ __forceinline__ int perm32(int rho) { const int n = rho >> 4, i = rho & 15; return 8 * (i >> 2) + 4 * n + (i & 3); }

struct Unit { int pm, pn, ka; };
struct Gemm { const bf16_t* A; const bf16_t* Bt; int lda, ldb, K; };

struct TileOrder {
    int nM, nN, nwg, G, c, skipctx;
    __device__ void init(int nM_, int nN_, int G_, int c_, int skip_) { nM = nM_; nN = nN_; nwg = nM * nN; G = G_; c = c_; skipctx = skip_; }
    __device__ bool next(int i, Unit& u) const {
        const long L = (long)i * G + c; if (L >= nwg) return false;
        int wgid = (int)L; { const int q = nwg / NXCD, r = nwg % NXCD, xcd = wgid % NXCD, off = wgid / NXCD; wgid = (xcd < r ? xcd * (q + 1) : r * (q + 1) + (xcd - r) * q) + off; }
        const int nig = WGM * nN, gid = wgid / nig, fm = gid * WGM, gsz = (nM - fm) < WGM ? (nM - fm) : WGM;
        u.pm = fm + ((wgid % nig) % gsz); u.pn = (wgid % nig) / gsz; u.ka = 0;
        if (skipctx) u.pm = u.pm + u.pm / 16 + 1;
        return true;
    }
    __device__ __forceinline__ void a_ready(const Unit&) const {}
    __device__ __forceinline__ void done(const Unit&) const {}
};

struct CtxSplitOrder {
    int G, c, kslice;
    __device__ void init(int G_, int c_, int kslice_) { G = G_; c = c_; kslice = kslice_; }
    __device__ bool next(int i, Unit& u) const { const int L = i * G + c; if (L >= 64) return false; const int t = L >> 2; u.pm = (t >> 2) * 17; u.pn = t & 3; u.ka = (L & 3) * kslice; return true; }
    __device__ __forceinline__ void a_ready(const Unit&) const {}
    __device__ __forceinline__ void done(const Unit&) const {}
};
__device__ __forceinline__ unsigned cvt_pk_bf16(float lo, float hi) { unsigned r; asm volatile("v_cvt_pk_bf16_f32 %0, %1, %2" : "=v"(r) : "v"(lo), "v"(hi)); return r; }
__device__ __forceinline__ float bf_lo(unsigned w) { return __uint_as_float(w << 16); }
__device__ __forceinline__ float bf_hi(unsigned w) { return __uint_as_float(w & 0xffff0000u); }

enum { EPI_BF16 = 0, EPI_RELU2 = 1, EPI_SIGMOID = 2, EPI_ROWSCALE = 3, EPI_MLAQ = 4, EPI_GATEMUL0 = 5, EPI_GATEMUL = 6, EPI_RESID = 7 };
template <int MODE> struct Epi {
    static constexpr bool PERM = true, AFTER_DRAIN = false;
    bf16_t* O; int ldc;
    bf16_t* O1; bf16_t* O2;
    const float* rs;
    const bf16_t* G; int ldg;
    const float* tc; const float* ts;
    int first;
    int pm_off, kslice;
    float* part;
    const float* xsl; const float* xsc; float* xdl; float* xdc; const float* gate;
    __device__ __forceinline__ void operator()(const f32x4 (&acc)[2][2][4][2], const Unit& u, int wr, int wc, int fr, int fq) const {
        const int col0 = u.pn * BM + wc * 32 + 8 * fq;
        if constexpr (MODE == EPI_RESID) {
            const int gpm = u.pm + pm_off, b = gpm / 17, t = gpm % 17;
            const float* xs = (t == 0) ? xsc + (size_t)(b * CTX) * DM : xsl + (size_t)(b * SEQ + (t - 1) * 256) * DM;
            float* xd = (t == 0) ? xdc + (size_t)(b * CTX) * DM : xdl + (size_t)(b * SEQ + (t - 1) * 256) * DM;
            const float* gv = gate + (size_t)((t == 0) ? 4 : b) * 6144;
            f32x4 g[2][2];
#pragma unroll
            for (int bj = 0; bj < 2; ++bj)
#pragma unroll
                for (int n = 0; n < 2; ++n) g[bj][n] = *(const f32x4*)(gv + col0 + bj * HALF + 4 * n);
#pragma unroll
            for (int ai = 0; ai < 2; ++ai)
#pragma unroll
                for (int m = 0; m < 4; ++m) { const size_t ro = (size_t)(ai * HALF + wr * 64 + m * 16 + fr) * DM + col0;
#pragma unroll
                    for (int bj = 0; bj < 2; ++bj)
#pragma unroll
                        for (int n = 0; n < 2; ++n) {
                            if (u.ka != 0) *(f32x4*)(part + (size_t)(u.ka / kslice - 1) * 1048576 + (size_t)(b * CTX) * DM + ro + bj * HALF + 4 * n) = g[bj][n] * acc[ai][bj][m][n];
                            else { const f32x4 xv = *(const f32x4*)(xs + ro + bj * HALF + 4 * n);
                                *(f32x4*)(xd + ro + bj * HALF + 4 * n) = xv + g[bj][n] * acc[ai][bj][m][n]; } } }
        } else {
            const int row0 = u.pm * BM + wr * 64 + fr;
#pragma unroll
            for (int ai = 0; ai < 2; ++ai)
#pragma unroll
                for (int m = 0; m < 4; ++m) { const int row = row0 + ai * HALF + m * 16; bf16_t* rowp = O + (size_t)row * ldc + col0;
                    if constexpr (MODE == EPI_SIGMOID) { const int bi = u.pn >> 2; rowp += (long)(bi & 1) * (O1 - O) + (long)(bi >> 1) * (O2 - O) - bi * 4 * BM; }
                    float rsc = 1.f; int pr = 0, pc = 0; bool lat = false;
                    if constexpr (MODE == EPI_ROWSCALE || MODE == EPI_MLAQ) rsc = rs[row];
                    if constexpr (MODE == EPI_MLAQ) { const int s = row % RPB; lat = s >= CTX; const int tt = s - CTX; pr = (tt >> 6) & 63; pc = tt & 63; }
#pragma unroll
                    for (int bj = 0; bj < 2; ++bj) { f32x4 v0 = acc[ai][bj][m][0], v1 = acc[ai][bj][m][1];
                        if constexpr (MODE == EPI_RELU2) {
#pragma unroll
                            for (int e = 0; e < 4; ++e) { float a = fmaxf(v0[e], 0.f), b = fmaxf(v1[e], 0.f); v0[e] = a * a; v1[e] = b * b; } }
                        if constexpr (MODE == EPI_SIGMOID) {
#pragma unroll
                            for (int e = 0; e < 4; ++e) { v0[e] = 1.f / (1.f + __expf(-v0[e])); v1[e] = 1.f / (1.f + __expf(-v1[e])); } }
                        if constexpr (MODE == EPI_ROWSCALE || MODE == EPI_MLAQ) { v0 = v0 * rsc; v1 = v1 * rsc; }
                        if constexpr (MODE == EPI_MLAQ) {
                            const int g32 = u.pn * 8 + bj * 4 + wc;
                            if (g32 % 3 == 2) {
                                f32x4 p0, p1;
#pragma unroll
                                for (int e = 0; e < 4; ++e) { p0[e] = __shfl_xor(v0[e], 16); p1[e] = __shfl_xor(v1[e], 16); }
                                if (lat) { const int pos = (fq < 2) ? pr : pc; const f32x4 c0 = *(const f32x4*)(tc + pos * 8), c1 = *(const f32x4*)(tc + pos * 8 + 4), s0 = *(const f32x4*)(ts + pos * 8), s1 = *(const f32x4*)(ts + pos * 8 + 4);
                                    if ((fq & 1) == 0) { v0 = v0 * c0 - p0 * s0; v1 = v1 * c1 - p1 * s1; } else { v0 = p0 * s0 + v0 * c0; v1 = p1 * s1 + v1 * c1; } }
                            } }
                        if constexpr (MODE == EPI_GATEMUL0 || MODE == EPI_GATEMUL) {
                            const u32x4 gw = *(const u32x4*)(G + (size_t)row * ldg + col0 + bj * HALF);
                            v0[0] *= bf_lo(gw.x); v0[1] *= bf_hi(gw.x); v0[2] *= bf_lo(gw.y); v0[3] *= bf_hi(gw.y); v1[0] *= bf_lo(gw.z); v1[1] *= bf_hi(gw.z); v1[2] *= bf_lo(gw.w); v1[3] *= bf_hi(gw.w);
                            if (MODE == EPI_GATEMUL && !first) { const u32x4 ow = *(const u32x4*)(rowp + bj * HALF);
                                v0[0] += bf_lo(ow.x); v0[1] += bf_hi(ow.x); v0[2] += bf_lo(ow.y); v0[3] += bf_hi(ow.y); v1[0] += bf_lo(ow.z); v1[1] += bf_hi(ow.z); v1[2] += bf_lo(ow.w); v1[3] += bf_hi(ow.w); } }
                        u32x4 w; w.x = cvt_pk_bf16(v0[0], v0[1]); w.y = cvt_pk_bf16(v0[2], v0[3]); w.z = cvt_pk_bf16(v1[0], v1[1]); w.w = cvt_pk_bf16(v1[2], v1[3]);
                        *(u32x4*)(rowp + bj * HALF) = w; } }
        }
    }
};

template <class EpiT, class Sched, bool ALIGN_EPI>
__device__ __forceinline__ void gemm_phase(PG8_LAS unsigned char* lds, const Gemm g, const Sched& S, const EpiT& E) {
    const int tid = otid(), wid = __builtin_amdgcn_readfirstlane(tid >> 6), lane = tid & 63, wr = wid >> 2, wc = wid & 3, fr = lane & 15, fq = lane >> 4;
    const int nt = g.K / BK;
    unsigned voffA[2], voffB[2];
#pragma unroll
    for (int i = 0; i < 2; ++i) { int R, C; stage_rc(tid * 16 + i * 8192, R, C); const int Rb = EpiT::PERM ? ((R & ~31) + perm32(R & 31)) : R;
        voffA[i] = (unsigned)(R * g.lda + C) * 2u; voffB[i] = (unsigned)(Rb * g.ldb + C) * 2u; }
    const size_t kstep = (size_t)(BK * 2);
    const size_t hsA = (size_t)HALF * g.lda * 2, hsB = (size_t)HALF * g.ldb * 2, tsA = 2 * hsA, tsB = 2 * hsB;
    const unsigned ldsw = (unsigned)wid * 1024u;
    const int aoff = lds_byte(wr * 64 + fr, fq * 8), boff = lds_byte(wc * 32 + fr, fq * 8);
#define PG8_SA(b, h) (((b) * 2 + (h)) * HTB)
#define PG8_SB(b, h) ((4 + (b) * 2 + (h)) * HTB)
#define PG8_STAGE(bufoff, gbase, voff) do { _Pragma("unroll") for (int _i = 0; _i < 2; ++_i) \
        __builtin_amdgcn_global_load_lds((const unsigned*)((const char*)(gbase) + (voff)[_i]), (PG8_LAS unsigned*)(lds + (bufoff) + ldsw + _i * 8192), 16, 0, 0); } while (0)
#define PG8_LDA(dst, b, h) do { _Pragma("unroll") for (int m = 0; m < 4; ++m) _Pragma("unroll") for (int k = 0; k < 2; ++k) dst[m][k] = *(const PG8_LAS bf16x8*)(lds + PG8_SA(b, h) + aoff + m * 2048 + k * 1024); } while (0)
#define PG8_LDB(dst, b, h) do { _Pragma("unroll") for (int n = 0; n < 2; ++n) _Pragma("unroll") for (int k = 0; k < 2; ++k) dst[n][k] = *(const PG8_LAS bf16x8*)(lds + PG8_SB(b, h) + boff + n * 2048 + k * 1024); } while (0)
#define PG8_MMA(ai, bj, At, Bt) do { __builtin_amdgcn_s_setprio(1); _Pragma("unroll") for (int m = 0; m < 4; ++m) _Pragma("unroll") for (int n = 0; n < 2; ++n) _Pragma("unroll") for (int k = 0; k < 2; ++k) \
        acc[ai][bj][m][n] = __builtin_amdgcn_mfma_f32_16x16x32_bf16(Bt[n][k], At[m][k], acc[ai][bj][m][n], 0, 0, 0); __builtin_amdgcn_s_setprio(0); } while (0)
#define PG8_WAIT_V(n) asm volatile("s_waitcnt vmcnt(" #n ")" ::: "memory")
#define PG8_WAIT_L(n) asm volatile("s_waitcnt lgkmcnt(" #n ")" ::: "memory")
#define PG8_BAR __builtin_amdgcn_s_barrier()
#define PG8_SCHED __builtin_amdgcn_sched_barrier(0)
    Unit cur, nxt; int ui = 0;
    if (!S.next(0, cur)) return;
    f32x4 acc[2][2][4][2];
    float zf; asm volatile("v_mov_b32 %0, 0" : "=v"(zf));
#pragma unroll
    for (int a = 0; a < 2; ++a)
#pragma unroll
        for (int b = 0; b < 2; ++b)
#pragma unroll
            for (int m = 0; m < 4; ++m)
#pragma unroll
                for (int n = 0; n < 2; ++n) acc[a][b][m][n] = (f32x4){zf, zf, zf, zf};
    bf16x8 At[4][2], B0[2][2], B1[2][2];
    const char* cA = (const char*)g.A + (size_t)cur.pm * tsA + (size_t)cur.ka * 2; const char* cB = (const char*)g.Bt + (size_t)cur.pn * tsB + (size_t)cur.ka * 2;
    S.a_ready(cur);
    PG8_STAGE(PG8_SB(0, 0), cB, voffB); PG8_STAGE(PG8_SB(0, 1), cB + hsB, voffB); PG8_STAGE(PG8_SA(0, 0), cA, voffA); PG8_STAGE(PG8_SA(0, 1), cA + hsA, voffA);
    if (wr == 1) PG8_BAR;
    PG8_WAIT_V(2); PG8_BAR;
    PG8_STAGE(PG8_SB(1, 0), cB + kstep, voffB); PG8_STAGE(PG8_SA(1, 0), cA + kstep, voffA); PG8_STAGE(PG8_SB(1, 1), cB + hsB + kstep, voffB);
    PG8_WAIT_V(6); PG8_BAR;
    for (;;) {
        const bool has_next = S.next(ui + 1, nxt);
        const char* nA = has_next ? (const char*)g.A + (size_t)nxt.pm * tsA + (size_t)nxt.ka * 2 : cA; const char* nB = has_next ? (const char*)g.Bt + (size_t)nxt.pn * tsB + (size_t)nxt.ka * 2 : cB;
        for (int t = 0; t < nt; t += 2) {
            const bool last = (t == nt - 2);
            const char* a1 = cA + (size_t)(t + 1) * kstep;
            const char* a2 = last ? nA : cA + (size_t)(t + 2) * kstep; const char* b2 = last ? nB : cB + (size_t)(t + 2) * kstep;
            const char* a3 = a2 + kstep; const char* b3 = b2 + kstep;
            if (last && has_next) S.a_ready(nxt);
            PG8_LDB(B0, 0, 0); PG8_LDB(B1, 0, 1); PG8_SCHED; PG8_LDA(At, 0, 0); PG8_STAGE(PG8_SA(1, 1), a1 + hsA, voffA);
            PG8_WAIT_V(8); PG8_WAIT_L(0); PG8_BAR; PG8_MMA(0, 0, At, B0); PG8_MMA(0, 1, At, B1); PG8_BAR; PG8_SCHED;
            PG8_LDA(At, 0, 1); PG8_STAGE(PG8_SB(0, 0), b2, voffB); PG8_STAGE(PG8_SB(0, 1), b2 + hsB, voffB); PG8_STAGE(PG8_SA(0, 0), a2, voffA);
            PG8_WAIT_V(8); PG8_WAIT_L(0); PG8_BAR; PG8_MMA(1, 0, At, B0); PG8_MMA(1, 1, At, B1); PG8_BAR; PG8_SCHED;
            PG8_LDB(B0, 1, 0); PG8_LDB(B1, 1, 1); PG8_SCHED; PG8_LDA(At, 1, 0); PG8_STAGE(PG8_SA(0, 1), a2 + hsA, voffA);
            PG8_WAIT_V(8); PG8_WAIT_L(0); PG8_BAR; PG8_MMA(0, 0, At, B0); PG8_MMA(0, 1, At, B1); PG8_BAR; PG8_SCHED;
            PG8_LDA(At, 1, 1); PG8_STAGE(PG8_SB(1, 0), b3, voffB); PG8_STAGE(PG8_SB(1, 1), b3 + hsB, voffB); PG8_STAGE(PG8_SA(1, 0), a3, voffA);
            PG8_WAIT_V(8); PG8_WAIT_L(0); PG8_BAR; PG8_MMA(1, 0, At, B0); PG8_MMA(1, 1, At, B1); PG8_BAR; PG8_SCHED;
        }
        if constexpr (ALIGN_EPI) { if (wr == 0) PG8_BAR; }
        E(acc, cur, wr, wc, fr, fq); S.done(cur);
        if (!has_next) break;
        asm volatile("v_mov_b32 %0, 0" : "=v"(zf));
#pragma unroll
        for (int a = 0; a < 2; ++a)
#pragma unroll
            for (int b = 0; b < 2; ++b)
#pragma unroll
                for (int m = 0; m < 4; ++m)
#pragma unroll
                    for (int n = 0; n < 2; ++n) acc[a][b][m][n] = (f32x4){zf, zf, zf, zf};
        cur = nxt; cA = nA; cB = nB; ++ui;
        if constexpr (ALIGN_EPI) { if (wr == 1) PG8_BAR; }
    }
    PG8_WAIT_V(0);
    if constexpr (!ALIGN_EPI) { if (wr == 0) PG8_BAR; }
    PG8_BAR;
#undef PG8_SA
#undef PG8_SB
#undef PG8_STAGE
#undef PG8_LDA
#undef PG8_LDB
#undef PG8_MMA
#undef PG8_WAIT_V
#undef PG8_WAIT_L
#undef PG8_BAR
#undef PG8_SCHED
}
}

namespace att {
using bf16 = unsigned short;
using bf16x8 = __attribute__((ext_vector_type(8))) short;
using s16x4 = __attribute__((ext_vector_type(4))) short;
using f32x16 = __attribute__((ext_vector_type(16))) float;
using u32x4 = __attribute__((ext_vector_type(4))) unsigned;
constexpr int NW = 8, QBLK = 32, KVBLK = 64;
constexpr float THR = 8.f;
#define SBAR() __builtin_amdgcn_sched_barrier(0)
__device__ __forceinline__ int crow(int r, int hi) { return (r & 3) + 8 * (r >> 2) + 4 * hi; }
__device__ __forceinline__ unsigned cvtpk(float lo, float hi) { unsigned r; asm volatile("v_cvt_pk_bf16_f32 %0, %1, %2" : "=v"(r) : "v"(lo), "v"(hi)); return r; }
template <int DQ> __device__ __forceinline__ int kaddr(int row, int c) {
    if constexpr (DQ == 64) return row * 128 + ((c ^ ((row >> 1) & 7)) << 4); else return row * 208 + c * 16; }
template <int DQ> constexpr int ktile_bytes() { return DQ == 64 ? 64 * 128 : 64 * 208; }
constexpr int VTILE = 64 * 64 * 2;
template <int DQ> constexpr int lds_bytes() { return 2 * ktile_bytes<DQ>() + 2 * VTILE + NW * 64 * 4; }

template <bool FIRST> __device__ __forceinline__ void partialSM(f32x16& p0, f32x16& p1, f32x16& nm16, float& alpha) {
    float pmax = p0[0];
#pragma unroll
    for (int r = 1; r < 16; ++r) pmax = fmaxf(pmax, p0[r]);
#pragma unroll
    for (int r = 0; r < 16; ++r) pmax = fmaxf(pmax, p1[r]);
    { auto rr = __builtin_amdgcn_permlane32_swap(__float_as_uint(pmax), __float_as_uint(pmax), false, false);
      pmax = fmaxf(__uint_as_float(rr[0]), __uint_as_float(rr[1])); }
    alpha = 1.f;
    if (FIRST || !__builtin_expect(__all(pmax <= THR), 1)) {
        const float dl = FIRST ? pmax : fmaxf(pmax, 0.f); if (!FIRST) alpha = __builtin_amdgcn_exp2f(-dl);
#pragma unroll
        for (int r = 0; r < 16; ++r) { nm16[r] -= dl; p0[r] -= dl; p1[r] -= dl; } }
#pragma unroll
    for (int r = 0; r < 16; ++r) p0[r] = __builtin_amdgcn_exp2f(p0[r]);
}
__device__ __forceinline__ void finishSM(f32x16& p0, f32x16& p1, float alpha, float& l_reg, bf16x8& pa0, bf16x8& pa1, bf16x8& pa2, bf16x8& pa3) {
#pragma unroll
    for (int r = 0; r < 16; ++r) p1[r] = __builtin_amdgcn_exp2f(p1[r]);
    float ps = 0;
#pragma unroll
    for (int r = 0; r < 16; ++r) ps += p0[r];
#pragma unroll
    for (int r = 0; r < 16; ++r) ps += p1[r];
    { auto rr = __builtin_amdgcn_permlane32_swap(__float_as_uint(ps), __float_as_uint(ps), false, false);
      ps = __uint_as_float(rr[0]) + __uint_as_float(rr[1]); }
    l_reg = l_reg * alpha + ps;
#define PK4(P, BASE, OUT) do { unsigned a0 = cvtpk(P[BASE + 0], P[BASE + 1]), a1 = cvtpk(P[BASE + 2], P[BASE + 3]);   \
    unsigned b0 = cvtpk(P[BASE + 4], P[BASE + 5]), b1 = cvtpk(P[BASE + 6], P[BASE + 7]);                              \
    auto r0 = __builtin_amdgcn_permlane32_swap(a0, b0, false, false); auto r1 = __builtin_amdgcn_permlane32_swap(a1, b1, false, false); \
    u32x4 w = {r0[0], r1[0], r0[1], r1[1]}; OUT = *reinterpret_cast<bf16x8*>(&w); } while (0)
    PK4(p0, 0, pa0); PK4(p0, 8, pa1); PK4(p1, 0, pa2); PK4(p1, 8, pa3);
#undef PK4
}
template <int DQ> __device__ __forceinline__ void qkt(f32x16& p0, f32x16& p1, const char* Ks, const bf16x8* qr, int r32, int hi, const f32x16& nm16) {
    p0 = nm16; p1 = nm16;
#pragma unroll
    for (int d0 = 0; d0 < DQ / 16; ++d0) { const int c = d0 * 2 + hi;
        const bf16x8 b0 = *reinterpret_cast<const bf16x8*>(Ks + kaddr<DQ>(r32, c));
        const bf16x8 b1 = *reinterpret_cast<const bf16x8*>(Ks + kaddr<DQ>(32 + r32, c));
        p0 = __builtin_amdgcn_mfma_f32_32x32x16_bf16(b0, qr[d0], p0, 0, 0, 0);
        p1 = __builtin_amdgcn_mfma_f32_32x32x16_bf16(b1, qr[d0], p1, 0, 0, 0); }
}
__device__ __forceinline__ int v_st(int k, int c) { const int kk = (k & ~0xC) | ((k & 4) << 1) | ((k & 8) >> 1); return ((kk >> 3) * 2 + (c >> 5)) * 512 + ((kk & 7) * 32 + (c & 31)) * 2; }
__device__ __forceinline__ int v_rd_base(int lane) { return ((lane & 3) << 3) | (((lane >> 2) & 3) << 6) | (((lane >> 4) & 1) << 5) | (((lane >> 5) & 1) << 8); }
constexpr int v_rd_off(int d0, int ks, int half) { return d0 * 512 + ks * 2048 + half * 1024; }
template <int OFF> __device__ __forceinline__ s16x4 tr_read(int vb) { s16x4 r; asm volatile("ds_read_b64_tr_b16 %0, %1 offset:%2" : "=&v"(r) : "v"(vb), "i"(OFF) : "memory"); return r; }
template <int D0> __device__ __forceinline__ void pv_one(f32x16& od, int vb, bf16x8 pa0, bf16x8 pa1, bf16x8 pa2, bf16x8 pa3) {
    const s16x4 l0 = tr_read<v_rd_off(D0, 0, 0)>(vb), h0 = tr_read<v_rd_off(D0, 0, 1)>(vb), l1 = tr_read<v_rd_off(D0, 1, 0)>(vb), h1 = tr_read<v_rd_off(D0, 1, 1)>(vb);
    const s16x4 l2 = tr_read<v_rd_off(D0, 2, 0)>(vb), h2 = tr_read<v_rd_off(D0, 2, 1)>(vb), l3 = tr_read<v_rd_off(D0, 3, 0)>(vb), h3 = tr_read<v_rd_off(D0, 3, 1)>(vb);
    asm volatile("s_waitcnt lgkmcnt(0)" ::: "memory"); SBAR();
#define PK(L, H) (bf16x8){L[0], L[1], L[2], L[3], H[0], H[1], H[2], H[3]}
    od = __builtin_amdgcn_mfma_f32_32x32x16_bf16(pa0, PK(l0, h0), od, 0, 0, 0);
    od = __builtin_amdgcn_mfma_f32_32x32x16_bf16(pa1, PK(l1, h1), od, 0, 0, 0);
    od = __builtin_amdgcn_mfma_f32_32x32x16_bf16(pa2, PK(l2, h2), od, 0, 0, 0);
    od = __builtin_amdgcn_mfma_f32_32x32x16_bf16(pa3, PK(l3, h3), od, 0, 0, 0);
#undef PK
}
struct Args { const bf16* Q; int ldq; const bf16* K0; int ldk0; const bf16* K1; int ldk1; const bf16* V; int ldv; bf16* O; int ldo; int nkeys; int rope_t0; const float* tc; const float* ts; };
template <int DQ>
__device__ __forceinline__ void attn_unit(const Args a, char* lds) {
    constexpr int KT = ktile_bytes<DQ>(), NLD = (DQ == 64) ? 2 : 3;
    const int tid = otid(), wid = tid >> 6, lane = tid & 63, r32 = lane & 31, hi = lane >> 5;
    char* V_lds = lds; char* K_lds = lds + 2 * VTILE;
    float* ws = (float*)(lds + 2 * VTILE + 2 * KT) + wid * 64; float* li_l = ws; float* al_l = ws + 32;
    float l_reg = 0; f32x16 o[2] = {}; f32x16 nm16 = {}; bf16x8 qr[DQ / 16];
    const bf16* Qw = a.Q + (long)(wid * QBLK + r32) * a.ldq + hi * 8;
#pragma unroll
    for (int d0 = 0; d0 < DQ / 16; ++d0) qr[d0] = *reinterpret_cast<const bf16x8*>(Qw + d0 * 16);
    if constexpr (DQ == 96) { if (a.rope_t0 >= 0) {
        const int tq = a.rope_t0 + wid * QBLK + r32, pr = (tq >> 6) & 63, pc = tq & 63;
#pragma unroll
        for (int f = 4; f < 6; ++f) { const int pos = (f == 4) ? pr : pc; u32x4 w = *reinterpret_cast<u32x4*>(&qr[f]); u32x4 o;
#pragma unroll
            for (int e = 0; e < 4; ++e) { const unsigned mine = w[e], oth = (unsigned)__shfl_xor((int)mine, 32);
                const float m0 = __uint_as_float(mine << 16), m1 = __uint_as_float(mine & 0xffff0000u), o0 = __uint_as_float(oth << 16), o1 = __uint_as_float(oth & 0xffff0000u);
                const float c0 = a.tc[pos * 8 + 2 * e], c1 = a.tc[pos * 8 + 2 * e + 1], s0 = a.ts[pos * 8 + 2 * e], s1 = a.ts[pos * 8 + 2 * e + 1];
                const float r0 = (hi == 0) ? m0 * c0 - o0 * s0 : o0 * s0 + m0 * c0, r1 = (hi == 0) ? m1 * c1 - o1 * s1 : o1 * s1 + m1 * c1;
                o[e] = cvtpk(r0, r1); }
            qr[f] = *reinterpret_cast<bf16x8*>(&o); } } }
    const int vrow = tid >> 3, vcol = (tid & 7) * 8, vst = v_st(vrow, vcol);
    const bf16* vsrc = a.V + (long)vrow * a.ldv + vcol; const long vstep = (long)KVBLK * a.ldv;
    int kr0, kc0, kr1 = 0, kc1 = 0;
    if constexpr (DQ == 64) { kr0 = tid >> 3; kc0 = tid & 7; } else { kr0 = tid / 12; kc0 = tid % 12; const int id1 = 512 + (tid & 255); kr1 = id1 / 12; kc1 = id1 % 12; }
    const bf16* ksrc0 = (kc0 < 8) ? a.K0 + (long)kr0 * a.ldk0 + kc0 * 8 : a.K1 + (long)kr0 * a.ldk1 + (kc0 - 8) * 8; const long kstep0 = (long)KVBLK * ((kc0 < 8) ? a.ldk0 : a.ldk1);
    const bf16* ksrc1 = ksrc0; long kstep1 = kstep0;
    if constexpr (DQ == 96) { ksrc1 = (kc1 < 8) ? a.K0 + (long)kr1 * a.ldk0 + kc1 * 8 : a.K1 + (long)kr1 * a.ldk1 + (kc1 - 8) * 8; kstep1 = (long)KVBLK * ((kc1 < 8) ? a.ldk0 : a.ldk1); }
    const int kst0 = kaddr<DQ>(kr0, kc0), kst1 = kaddr<DQ>(kr1, kc1);
    const int vb0 = (int)(uintptr_t)V_lds + v_rd_base(lane);
    struct { bf16x8 vs, ks0, ks1; } sr_[2];
#define SLOAD(i, t) do { sr_[i].vs = *reinterpret_cast<const bf16x8*>(vsrc + (long)(t) * vstep); sr_[i].ks0 = *reinterpret_cast<const bf16x8*>(ksrc0 + (long)(t) * kstep0); \
    if constexpr (DQ == 96) sr_[i].ks1 = *reinterpret_cast<const bf16x8*>(ksrc1 + (long)(t) * kstep1); } while (0)
#define SWRITE(b, i) do { *(bf16x8*)(V_lds + (b) * VTILE + vst) = sr_[i].vs; *(bf16x8*)(K_lds + (b) * KT + kst0) = sr_[i].ks0; \
    if constexpr (DQ == 96) *(bf16x8*)(K_lds + (b) * KT + kst1) = sr_[i].ks1; } while (0)
#define SWAIT() do { if constexpr (NLD == 2) asm volatile("s_waitcnt vmcnt(2)" ::: "memory"); else asm volatile("s_waitcnt vmcnt(3)" ::: "memory"); } while (0)
#define RESC(al) do { if (__any((al) < 1.f)) { if (hi == 0) al_l[r32] = (al); asm volatile("s_waitcnt lgkmcnt(0)" ::: "memory"); \
    _Pragma("unroll") for (int d = 0; d < 2; ++d) _Pragma("unroll") for (int r = 0; r < 16; ++r) o[d][r] *= al_l[crow(r, hi)]; } } while (0)
    f32x16 pA0, pA1, pB0, pB1; float alA, alB; bf16x8 pa0, pa1, pa2, pa3; const int NT = a.nkeys / KVBLK;
    constexpr int SE = 0, SO = 1;
    SLOAD(SE, 0); asm volatile("s_waitcnt vmcnt(0)" ::: "memory"); SWRITE(0, SE); __syncthreads();
    qkt<DQ>(pA0, pA1, K_lds, qr, r32, hi, nm16); partialSM<true>(pA0, pA1, nm16, alA);
    SLOAD(SO, 1); if (2 < NT) SLOAD(SE, 2);
    SWAIT(); SWRITE(1, SO); __syncthreads();
    for (int j = 1; j + 1 < NT; j += 2) {
        SBAR(); qkt<DQ>(pB0, pB1, K_lds + KT, qr, r32, hi, nm16);
        finishSM(pA0, pA1, alA, l_reg, pa0, pa1, pa2, pa3); SBAR();
        SLOAD(SO, j + 2); SBAR();
        pv_one<0>(o[0], vb0, pa0, pa1, pa2, pa3); pv_one<1>(o[1], vb0, pa0, pa1, pa2, pa3); partialSM<false>(pB0, pB1, nm16, alB);
        __syncthreads(); SWAIT(); SWRITE(0, SE);
        RESC(alB); __syncthreads();
        SBAR(); qkt<DQ>(pA0, pA1, K_lds, qr, r32, hi, nm16);
        finishSM(pB0, pB1, alB, l_reg, pa0, pa1, pa2, pa3); SBAR();
        if (j + 3 < NT) SLOAD(SE, j + 3); SBAR();
        pv_one<0>(o[0], vb0 + VTILE, pa0, pa1, pa2, pa3); pv_one<1>(o[1], vb0 + VTILE, pa0, pa1, pa2, pa3); partialSM<false>(pA0, pA1, nm16, alA);
        __syncthreads(); SWAIT(); SWRITE(1, SO);
        RESC(alA); __syncthreads();
    }
    SBAR(); qkt<DQ>(pB0, pB1, K_lds + KT, qr, r32, hi, nm16);
    finishSM(pA0, pA1, alA, l_reg, pa0, pa1, pa2, pa3); SBAR();
    pv_one<0>(o[0], vb0, pa0, pa1, pa2, pa3); pv_one<1>(o[1], vb0, pa0, pa1, pa2, pa3); partialSM<false>(pB0, pB1, nm16, alB);
    __syncthreads(); RESC(alB);
    finishSM(pB0, pB1, alB, l_reg, pa0, pa1, pa2, pa3); SBAR();
    pv_one<0>(o[0], vb0 + VTILE, pa0, pa1, pa2, pa3); pv_one<1>(o[1], vb0 + VTILE, pa0, pa1, pa2, pa3);
    if (hi == 0) li_l[r32] = l_reg; asm volatile("s_waitcnt lgkmcnt(0)" ::: "memory");
    float rli[16];
#pragma unroll
    for (int r = 0; r < 16; ++r) rli[r] = __builtin_amdgcn_rcpf(li_l[crow(r, hi)]);
    __syncthreads();
    { unsigned short* stg = (unsigned short*)(lds) + wid * 2048;
#pragma unroll
      for (int r = 0; r < 16; ++r) { const int orow = crow(r, hi);
#pragma unroll
        for (int d0 = 0; d0 < 2; ++d0) { const float v = o[d0][r] * rli[r]; const unsigned u = __float_as_uint(v); stg[orow * 64 + d0 * 32 + r32] = (unsigned short)((u + 0x7fffu + ((u >> 16) & 1u)) >> 16); } }
      asm volatile("s_waitcnt lgkmcnt(0)" ::: "memory");
      bf16* Ow = a.O + (long)(wid * QBLK) * a.ldo;
#pragma unroll
      for (int i = 0; i < 4; ++i) { const int row = i * 8 + (lane >> 3), ch = lane & 7; const u32x4 v = *(const u32x4*)(stg + row * 64 + ch * 8); *(u32x4*)(Ow + (long)row * a.ldo + ch * 8) = v; } }
    __syncthreads();
#undef SLOAD
#undef SWRITE
#undef SWAIT
#undef RESC
}
#undef SBAR
}

namespace at64 {
using att::bf16; using att::bf16x8; using att::s16x4; using att::f32x16; using att::u32x4;
constexpr int NW = 8, QBLK = 32, KVBLK = 64;
constexpr float C2 = 0.125f * 1.4426950408889634f;
constexpr float THR = 8.f;
constexpr int SLOTB = 8192, LDS_K = 0, LDS_V = 3 * SLOTB, LDS_WS = 6 * SLOTB, LDS_OST = LDS_WS + NW * 256, LDS_TOT = LDS_OST + NW * 4096;
#define A6_SBAR() __builtin_amdgcn_sched_barrier(0)
#define A6_PIN(x) asm volatile("" : "+v"(x))
#define A6_MFMA(a, b, c) __builtin_amdgcn_mfma_f32_32x32x16_bf16(a, b, c, 0, 0, 0)
#define A6_WAIT_BAR(N) asm volatile("s_waitcnt vmcnt(" #N ") lgkmcnt(0)\n\ts_barrier" ::: "memory")
__device__ __forceinline__ int crow(int r, int hi) { return (r & 3) + 8 * (r >> 2) + 4 * hi; }
__device__ __forceinline__ unsigned cvtpk(float lo, float hi) { unsigned r; asm("v_cvt_pk_bf16_f32 %0, %1, %2" : "=v"(r) : "v"(lo), "v"(hi)); return r; }
__device__ __forceinline__ void glds16(const void* g, unsigned lds_base) {
    unsigned sv; asm volatile("s_mov_b32 %0, m0\n\ts_mov_b32 m0, %2\n\ts_nop 0\n\tglobal_load_lds_dwordx4 %1, off\n\ts_mov_b32 m0, %0" : "=&s"(sv) : "v"(g), "s"(lds_base) : "memory"); }
typedef __attribute__((address_space(3))) const char* lds_cptr;
typedef short v4i16_t __attribute__((ext_vector_type(4)));
__device__ __forceinline__ void kload2(bf16x8* kf, lds_cptr kp, int d0) { kf[2 * d0] = *(const __attribute__((address_space(3))) bf16x8*)(kp + d0 * 2048); kf[2 * d0 + 1] = *(const __attribute__((address_space(3))) bf16x8*)(kp + d0 * 2048 + 512); }
__device__ __forceinline__ s16x4 vtr(lds_cptr p) { return __builtin_bit_cast(s16x4, __builtin_amdgcn_ds_read_tr16_b64_v4i16((__attribute__((address_space(3))) v4i16_t*)p)); }
#define A6_MX3(a, b, c) __builtin_fmaxf(__builtin_fmaxf((a), (b)), (c))
__device__ __forceinline__ float rowmax(const f32x16& p0, const f32x16& p1) {
    float a = A6_MX3(p0[0], p0[1], p1[0]), b = A6_MX3(p0[2], p0[3], p1[1]); a = A6_MX3(a, p1[2], p1[3]);
#pragma unroll
    for (int r = 4; r < 16; r += 4) { a = A6_MX3(a, p0[r], p0[r + 1]); b = A6_MX3(b, p0[r + 2], p0[r + 3]); a = A6_MX3(a, p1[r], p1[r + 1]); b = A6_MX3(b, p1[r + 2], p1[r + 3]); }
    float m = __builtin_fmaxf(a, b); auto rr = __builtin_amdgcn_permlane32_swap(__float_as_uint(m), __float_as_uint(m), false, false);
    return __builtin_fmaxf(__uint_as_float(rr[0]), __uint_as_float(rr[1])); }
struct Args { const bf16* Q; int ldq; const bf16* K; int ldk; const bf16* V; int ldv; bf16* O; int ldo; int nkeys; };
__device__ __forceinline__ void unit(const Args a, char* lds) {
    const int tid = otid(), lane = tid & 63, r32 = lane & 31, hi = lane >> 5; const int wid = __builtin_amdgcn_readfirstlane(tid >> 6);
    const int NT = a.nkeys / KVBLK;
    const bf16* Qw = a.Q + (long)(wid * QBLK) * a.ldq;
    const unsigned lds0 = (unsigned)(uintptr_t)lds; float* wsf = (float*)(lds + LDS_WS) + wid * 64;
    const bf16* ksrc = a.K + (long)lane * a.ldk + wid * 8; const long kstep = (long)KVBLK * a.ldk;
    const bf16* vsrc = a.V + (long)(16 * (wid & 3) + (lane >> 2)) * a.ldv + (wid >> 2) * 32 + (lane & 3) * 8; const long vstep = (long)KVBLK * a.ldv;
    const unsigned kdst = lds0 + LDS_K + wid * 1024, vdst = lds0 + LDS_V + wid * 1024;
#define DMA_K(t, slot) glds16(ksrc + (long)(t) * kstep, (unsigned)__builtin_amdgcn_readfirstlane(kdst + (slot)))
#define DMA_V(t, slot) glds16(vsrc + (long)(t) * vstep, (unsigned)__builtin_amdgcn_readfirstlane(vdst + (slot)))
    const lds_cptr vp0 = (lds_cptr)lds + LDS_V + ((lane >> 4) & 1) * 32 + (lane & 3) * 8 + (4 * hi + ((lane & 15) >> 2)) * 64;
    const lds_cptr kp0 = (lds_cptr)lds + LDS_K + hi * 1024 + r32 * 16;
    DMA_K(0, 0); DMA_V(0, 0); DMA_K(1, SLOTB);
    bf16x8 qr[4];
#pragma unroll
    for (int d0 = 0; d0 < 4; ++d0) qr[d0] = *reinterpret_cast<const bf16x8*>(&Qw[(long)r32 * a.ldq + d0 * 16 + hi * 8]);
    float l_reg = 0.f; f32x16 o[2]; o[0] = f32x16{}; o[1] = f32x16{};
    f32x16 nmh16 = f32x16{}; A6_PIN(nmh16);
    bool resc = false;
    f32x16 pA0, pA1, pB0, pB1; bf16x8 kf[8]; s16x4 vlo[8], vhi[8]; u32x4 pw0, pw1, pw2, pw3;
    int sl_prev = 0, sl_cur = 0, sl_next = SLOTB;
#define ROT() do { sl_prev = sl_cur; sl_cur = sl_next; sl_next = (sl_next == 2 * SLOTB) ? 0 : sl_next + SLOTB; } while (0)
#define EX(v) __builtin_amdgcn_exp2f(v)
#define RESC() do { if (resc) { _Pragma("unroll") for (int d_ = 0; d_ < 2; ++d_) _Pragma("unroll") for (int r = 0; r < 16; ++r) o[d_][r] *= wsf[crow(r, hi)]; } } while (0)
    DMA_K(2, 2 * SLOTB);
    A6_WAIT_BAR(3);
    _Pragma("unroll") for (int d0 = 0; d0 < 4; ++d0) kload2(kf, kp0, d0);
    pA0 = A6_MFMA(kf[0], qr[0], nmh16); pA1 = A6_MFMA(kf[1], qr[0], nmh16); pA0 = A6_MFMA(kf[2], qr[1], pA0); pA1 = A6_MFMA(kf[3], qr[1], pA1);
    pA0 = A6_MFMA(kf[4], qr[2], pA0); pA1 = A6_MFMA(kf[5], qr[2], pA1); pA0 = A6_MFMA(kf[6], qr[3], pA0); pA1 = A6_MFMA(kf[7], qr[3], pA1);
    { const float rm = rowmax(pA0, pA1);
#pragma unroll
      for (int r = 0; r < 16; ++r) { nmh16[r] = -rm; pA0[r] = EX(pA0[r] - rm); pA1[r] = EX(pA1[r] - rm); } }
    A6_WAIT_BAR(0);
    DMA_K(3, 0); DMA_V(1, SLOTB); ROT();
    _Pragma("unroll") for (int d0 = 0; d0 < 4; ++d0) kload2(kf, kp0 + sl_cur, d0);
    A6_WAIT_BAR(2);
#define PKW(P, i) cvtpk(P[i], P[i + 1])
#define PAF(k) __builtin_bit_cast(bf16x8, pw##k)
#define VFR(i) (bf16x8){vlo[i][0], vlo[i][1], vlo[i][2], vlo[i][3], vhi[i][0], vhi[i][1], vhi[i][2], vhi[i][3]}
#define VRD(i) do { vlo[i] = vtr(vp_ + (((i) >> 2) * 4096 + ((i) & 3) * 1024)); vhi[i] = vtr(vp_ + (((i) >> 2) * 4096 + ((i) & 3) * 1024 + 512)); } while (0)
#define KRD(G, d0) do { if (G) { kload2(kf, kp0 + sl_next, d0); A6_SBAR(); } } while (0)
#define GAPA(MF, a0, a1, a2, a3, W0, W1, PW) do { MF; sacc += a0; sacc += a1; sacc += a2; sacc += a3; W0; W1; A6_PIN(PW); A6_PIN(sacc); A6_SBAR(); } while (0)
#define GAPB(MF, X, i) do { MF; X[i] = EX(X[i]); X[i + 1] = EX(X[i + 1]); X[i + 2] = EX(X[i + 2]); X[i + 3] = EX(X[i + 3]); A6_PIN(X); A6_SBAR(); } while (0)
#define STEP(C0, C1, P0, P1, t, GK, GV, GL) do { A6_SBAR(); \
    const lds_cptr vp_ = vp0 + sl_prev; \
    VRD(0); A6_SBAR(); float sacc = P0[0] + P0[1]; \
                       GAPA(C0 = A6_MFMA(kf[0], qr[0], nmh16), P0[2], P0[3], P0[4], P0[5],     pw0[0] = PKW(P0, 0),  pw0[1] = PKW(P0, 2),  pw0); \
    VRD(4); A6_SBAR(); GAPA(C1 = A6_MFMA(kf[1], qr[0], nmh16), P0[6], P0[7], P0[8], P0[9],     pw0[2] = PKW(P0, 4),  pw0[3] = PKW(P0, 6),  pw0); \
    VRD(1); A6_SBAR(); GAPA(C0 = A6_MFMA(kf[2], qr[1], C0),    P0[10], P0[11], P0[12], P0[13], pw1[0] = PKW(P0, 8),  pw1[1] = PKW(P0, 10), pw1); \
    VRD(5); A6_SBAR(); GAPA(C1 = A6_MFMA(kf[3], qr[1], C1),    P0[14], P0[15], P1[0], P1[1],   pw1[2] = PKW(P0, 12), pw1[3] = PKW(P0, 14), pw1); \
    VRD(2); A6_SBAR(); GAPA(C0 = A6_MFMA(kf[4], qr[2], C0),    P1[2], P1[3], P1[4], P1[5],     pw2[0] = PKW(P1, 0),  pw2[1] = PKW(P1, 2),  pw2); \
    VRD(6); A6_SBAR(); GAPA(C1 = A6_MFMA(kf[5], qr[2], C1),    P1[6], P1[7], P1[8], P1[9],     pw2[2] = PKW(P1, 4),  pw2[3] = PKW(P1, 6),  pw2); \
    VRD(3); A6_SBAR(); GAPA(C0 = A6_MFMA(kf[6], qr[3], C0),    P1[10], P1[11], P1[12], P1[13], pw3[0] = PKW(P1, 8),  pw3[1] = PKW(P1, 10), pw3); \
    VRD(7); A6_SBAR(); GAPA(C1 = A6_MFMA(kf[7], qr[3], C1),    P1[14], P1[15], 0.f, 0.f,       pw3[2] = PKW(P1, 12), pw3[3] = PKW(P1, 14), pw3); \
    l_reg += sacc; \
    if (GK) DMA_K((t) + 3, sl_cur); if (GV) DMA_V((t) + 1, sl_next); \
    { const float rm = rowmax(C0, C1); resc = false; \
      if (__builtin_expect(__any(rm > THR), 0)) { const float dl = __builtin_fmaxf(rm, 0.f); \
          _Pragma("unroll") for (int r_ = 0; r_ < 16; ++r_) { nmh16[r_] -= dl; C0[r_] -= dl; C1[r_] -= dl; } \
          const float f = __builtin_amdgcn_exp2f(-dl); l_reg *= f; if (hi == 0) wsf[r32] = f; resc = true; } } \
    A6_SBAR(); \
    GAPB(o[0] = A6_MFMA(PAF(0), VFR(0), o[0]), C0, 0);              GAPB(o[1] = A6_MFMA(PAF(0), VFR(4), o[1]), C0, 4); \
    KRD(GL, 0); GAPB(o[0] = A6_MFMA(PAF(1), VFR(1), o[0]), C0, 8);  KRD(GL, 1); GAPB(o[1] = A6_MFMA(PAF(1), VFR(5), o[1]), C0, 12); \
    KRD(GL, 2); GAPB(o[0] = A6_MFMA(PAF(2), VFR(2), o[0]), C1, 0);  KRD(GL, 3); GAPB(o[1] = A6_MFMA(PAF(2), VFR(6), o[1]), C1, 4); \
    GAPB(o[0] = A6_MFMA(PAF(3), VFR(3), o[0]), C1, 8);              GAPB(o[1] = A6_MFMA(PAF(3), VFR(7), o[1]), C1, 12); \
    } while (0)
    int t = 1;
    for (; t + 5 < NT; t += 2) {
        STEP(pB0, pB1, pA0, pA1, t, true, true, true);     A6_WAIT_BAR(2); RESC(); ROT();
        STEP(pA0, pA1, pB0, pB1, t + 1, true, true, true); A6_WAIT_BAR(2); RESC(); ROT();
    }
#define ENDW(tt) do { if ((tt) + 3 < NT) { A6_WAIT_BAR(2); } else if ((tt) + 2 < NT) { A6_WAIT_BAR(1); } else { A6_WAIT_BAR(0); } } while (0)
    for (; t + 1 < NT; t += 2) {
        STEP(pB0, pB1, pA0, pA1, t, (t + 3 < NT), (t + 1 < NT), (t + 1 < NT));         ENDW(t);     RESC(); ROT();
        STEP(pA0, pA1, pB0, pB1, t + 1, (t + 4 < NT), (t + 2 < NT), (t + 2 < NT));     ENDW(t + 1); RESC(); ROT();
    }
    STEP(pB0, pB1, pA0, pA1, NT - 1, false, false, false); RESC();
    { float sacc = pB0[0] + pB0[1];
#pragma unroll
      for (int r = 2; r < 16; ++r) sacc += pB0[r];
#pragma unroll
      for (int r = 0; r < 16; ++r) sacc += pB1[r];
      l_reg += sacc;
      pw0 = (u32x4){PKW(pB0, 0), PKW(pB0, 2), PKW(pB0, 4), PKW(pB0, 6)}; pw1 = (u32x4){PKW(pB0, 8), PKW(pB0, 10), PKW(pB0, 12), PKW(pB0, 14)};
      pw2 = (u32x4){PKW(pB1, 0), PKW(pB1, 2), PKW(pB1, 4), PKW(pB1, 6)}; pw3 = (u32x4){PKW(pB1, 8), PKW(pB1, 10), PKW(pB1, 12), PKW(pB1, 14)};
      const lds_cptr vp_ = vp0 + sl_cur; _Pragma("unroll") for (int i = 0; i < 8; ++i) VRD(i);
      o[0] = A6_MFMA(PAF(0), VFR(0), o[0]); o[1] = A6_MFMA(PAF(0), VFR(4), o[1]); o[0] = A6_MFMA(PAF(1), VFR(1), o[0]); o[1] = A6_MFMA(PAF(1), VFR(5), o[1]);
      o[0] = A6_MFMA(PAF(2), VFR(2), o[0]); o[1] = A6_MFMA(PAF(2), VFR(6), o[1]); o[0] = A6_MFMA(PAF(3), VFR(3), o[0]); o[1] = A6_MFMA(PAF(3), VFR(7), o[1]); }
    { auto rr = __builtin_amdgcn_permlane32_swap(__float_as_uint(l_reg), __float_as_uint(l_reg), false, false); l_reg = __uint_as_float(rr[0]) + __uint_as_float(rr[1]); }
    if (hi == 0) wsf[32 + r32] = l_reg; asm volatile("s_waitcnt lgkmcnt(0)" ::: "memory");
    float rli[16];
#pragma unroll
    for (int r = 0; r < 16; ++r) rli[r] = __builtin_amdgcn_rcpf(wsf[32 + crow(r, hi)]);
    bf16* Ow = a.O + (long)(wid * QBLK) * a.ldo; unsigned short* stg = (unsigned short*)(lds + LDS_OST) + wid * 2048;
#pragma unroll
    for (int r = 0; r < 16; ++r) { const int orow = crow(r, hi);
#pragma unroll
        for (int d0 = 0; d0 < 2; ++d0) { const float v = o[d0][r] * rli[r]; const unsigned u = __float_as_uint(v); stg[orow * 64 + d0 * 32 + r32] = (unsigned short)((u + 0x7fffu + ((u >> 16) & 1u)) >> 16); } }
    asm volatile("s_waitcnt lgkmcnt(0)" ::: "memory");
#pragma unroll
    for (int i = 0; i < 4; ++i) { const int row = i * 8 + (lane >> 3), ch = lane & 7; *(u32x4*)(Ow + (long)row * a.ldo + ch * 8) = *(const u32x4*)(stg + row * 64 + ch * 8); }
    asm volatile("s_waitcnt lgkmcnt(0)\n\ts_barrier" ::: "memory");
#undef DMA_K
#undef DMA_V
#undef ROT
#undef EX
#undef RESC
#undef PKW
#undef PAF
#undef VFR
#undef VRD
#undef KRD
#undef ENDW
#undef GAPA
#undef GAPB
#undef STEP
}
#undef A6_SBAR
#undef A6_PIN
#undef A6_MFMA
#undef A6_WAIT_BAR
#undef A6_MX3
}

namespace at96 {
using att::bf16; using att::bf16x8; using att::s16x4; using att::f32x16; using att::u32x4;
using at64::crow; using at64::cvtpk; using at64::glds16; using at64::lds_cptr; using at64::kload2; using at64::vtr; using at64::rowmax;
constexpr int NW = 8, QBLK = 32, KVBLK = 64;
constexpr float THR = 8.f;
constexpr int SLOTB = 8192, SLOTR = 4096, LDS_K = 0, LDS_V = 3 * SLOTB, LDS_R = 6 * SLOTB, LDS_WS = LDS_R + 4 * SLOTR, LDS_OST = LDS_WS + NW * 256, LDS_TOT = LDS_OST + NW * 4096;
#define A9_SBAR() __builtin_amdgcn_sched_barrier(0)
#define A9_PIN(x) asm volatile("" : "+v"(x))
#define A9_MFMA(a, b, c) __builtin_amdgcn_mfma_f32_32x32x16_bf16(a, b, c, 0, 0, 0)
#define A9_WAIT_BAR(N) asm volatile("s_waitcnt vmcnt(" #N ") lgkmcnt(0)\n\ts_barrier" ::: "memory")
struct Args { const bf16* Q; int ldq; const bf16* K0; int ldk0; const bf16* K1; int ldk1; const bf16* V; int ldv; bf16* O; int ldo; int nkeys; int rope_t0; const float* tc; const float* ts; };
__device__ __forceinline__ void unit(const Args a, char* lds) {
    const int tid = otid(), lane = tid & 63, r32 = lane & 31, hi = lane >> 5; const int wid = __builtin_amdgcn_readfirstlane(tid >> 6);
    const int NT = a.nkeys / KVBLK;
    const bf16* Qw = a.Q + (long)(wid * QBLK) * a.ldq;
    const unsigned lds0 = (unsigned)(uintptr_t)lds; float* wsf = (float*)(lds + LDS_WS) + wid * 64;
    const bf16* ksrc = a.K0 + (long)lane * a.ldk0 + wid * 8; const long kstep = (long)KVBLK * a.ldk0;
    const bf16* rsrc = a.K1 + (long)(32 * (wid & 1) + r32) * a.ldk1 + (wid >> 1) * 8; const long rstep = (long)KVBLK * a.ldk1;
    const bf16* vsrc = a.V + (long)(16 * (wid & 3) + (lane >> 2)) * a.ldv + (wid >> 2) * 32 + (lane & 3) * 8; const long vstep = (long)KVBLK * a.ldv;
    const unsigned kdst = lds0 + LDS_K + wid * 1024, vdst = lds0 + LDS_V + wid * 1024, rdst = lds0 + LDS_R + (wid >> 1) * 1024 + (wid & 1) * 512;
#define DMA_K(t, slot, rslot) do { glds16(ksrc + (long)(t) * kstep, (unsigned)__builtin_amdgcn_readfirstlane(kdst + (slot))); \
        if (lane < 32) glds16(rsrc + (long)(t) * rstep, (unsigned)__builtin_amdgcn_readfirstlane(rdst + (rslot))); } while (0)
#define DMA_V(t, slot) glds16(vsrc + (long)(t) * vstep, (unsigned)__builtin_amdgcn_readfirstlane(vdst + (slot)))
    const lds_cptr vp0 = (lds_cptr)lds + LDS_V + ((lane >> 4) & 1) * 32 + (lane & 3) * 8 + (4 * hi + ((lane & 15) >> 2)) * 64;
    const lds_cptr kp0 = (lds_cptr)lds + LDS_K + hi * 1024 + r32 * 16;
    const lds_cptr rp0 = (lds_cptr)lds + LDS_R + hi * 1024 + r32 * 16;
    DMA_K(0, 0, 0); DMA_V(0, 0); DMA_K(1, SLOTB, SLOTR);
    bf16x8 qr[6];
#pragma unroll
    for (int d0 = 0; d0 < 6; ++d0) qr[d0] = *reinterpret_cast<const bf16x8*>(&Qw[(long)r32 * a.ldq + d0 * 16 + hi * 8]);
    if (a.rope_t0 >= 0) {
        const int tq = a.rope_t0 + wid * QBLK + r32, pr = (tq >> 6) & 63, pc = tq & 63;
#pragma unroll
        for (int f = 4; f < 6; ++f) { const int pos = (f == 4) ? pr : pc; u32x4 w = *reinterpret_cast<u32x4*>(&qr[f]); u32x4 o_;
#pragma unroll
            for (int e = 0; e < 4; ++e) { const unsigned mine = w[e], oth = (unsigned)__shfl_xor((int)mine, 32);
                const float m0 = __uint_as_float(mine << 16), m1 = __uint_as_float(mine & 0xffff0000u), o0 = __uint_as_float(oth << 16), o1 = __uint_as_float(oth & 0xffff0000u);
                const float c0 = a.tc[pos * 8 + 2 * e], c1 = a.tc[pos * 8 + 2 * e + 1], s0 = a.ts[pos * 8 + 2 * e], s1 = a.ts[pos * 8 + 2 * e + 1];
                const float r0 = (hi == 0) ? m0 * c0 - o0 * s0 : o0 * s0 + m0 * c0, r1 = (hi == 0) ? m1 * c1 - o1 * s1 : o1 * s1 + m1 * c1;
                o_[e] = cvtpk(r0, r1); }
            qr[f] = *reinterpret_cast<bf16x8*>(&o_); } }
    float l_reg = 0.f; f32x16 o[2]; o[0] = f32x16{}; o[1] = f32x16{};
    f32x16 nmh16 = f32x16{}; A9_PIN(nmh16);
    bool resc = false;
    f32x16 pA0, pA1, pB0, pB1; bf16x8 kf[8], kr[4]; s16x4 vlo[8], vhi[8]; u32x4 pw0, pw1, pw2, pw3;
    int sl_prev = 0, sl_cur = 0, sl_next = SLOTB, rs_cur = 0;
#define ROT() do { sl_prev = sl_cur; sl_cur = sl_next; sl_next = (sl_next == 2 * SLOTB) ? 0 : sl_next + SLOTB; rs_cur = (rs_cur + SLOTR) & (4 * SLOTR - 1); } while (0)
#define RS3() ((rs_cur + 3 * SLOTR) & (4 * SLOTR - 1))
#define EX(v) __builtin_amdgcn_exp2f(v)
#define RESC() do { if (resc) { _Pragma("unroll") for (int d_ = 0; d_ < 2; ++d_) _Pragma("unroll") for (int r = 0; r < 16; ++r) o[d_][r] *= wsf[crow(r, hi)]; } } while (0)
    DMA_K(2, 2 * SLOTB, 2 * SLOTR);
    A9_WAIT_BAR(5);
    _Pragma("unroll") for (int d0 = 0; d0 < 4; ++d0) kload2(kf, kp0, d0);
    kload2(kr, rp0, 0); kload2(kr, rp0, 1);
    pA0 = A9_MFMA(kf[0], qr[0], nmh16); pA1 = A9_MFMA(kf[1], qr[0], nmh16); pA0 = A9_MFMA(kf[2], qr[1], pA0); pA1 = A9_MFMA(kf[3], qr[1], pA1);
    pA0 = A9_MFMA(kf[4], qr[2], pA0); pA1 = A9_MFMA(kf[5], qr[2], pA1); pA0 = A9_MFMA(kf[6], qr[3], pA0); pA1 = A9_MFMA(kf[7], qr[3], pA1);
    pA0 = A9_MFMA(kr[0], qr[4], pA0); pA1 = A9_MFMA(kr[1], qr[4], pA1); pA0 = A9_MFMA(kr[2], qr[5], pA0); pA1 = A9_MFMA(kr[3], qr[5], pA1);
    { const float rm = rowmax(pA0, pA1);
#pragma unroll
      for (int r = 0; r < 16; ++r) { nmh16[r] = -rm; pA0[r] = EX(pA0[r] - rm); pA1[r] = EX(pA1[r] - rm); } }
    A9_WAIT_BAR(0);
    DMA_K(3, 0, 3 * SLOTR); DMA_V(1, SLOTB); ROT();
    _Pragma("unroll") for (int d0 = 0; d0 < 4; ++d0) kload2(kf, kp0 + sl_cur, d0);
    A9_WAIT_BAR(3);
#define PKW(P, i) cvtpk(P[i], P[i + 1])
#define PAF(k) __builtin_bit_cast(bf16x8, pw##k)
#define VFR(i) (bf16x8){vlo[i][0], vlo[i][1], vlo[i][2], vlo[i][3], vhi[i][0], vhi[i][1], vhi[i][2], vhi[i][3]}
#define VRD(i) do { vlo[i] = vtr(vp_ + (((i) >> 2) * 4096 + ((i) & 3) * 1024)); vhi[i] = vtr(vp_ + (((i) >> 2) * 4096 + ((i) & 3) * 1024 + 512)); } while (0)
#define KRD(G, d0) do { if (G) { kload2(kf, kp0 + sl_next, d0); A9_SBAR(); } } while (0)
#define GAP3(MF, a0, a1, a2, W0, PW) do { MF; sacc += a0; sacc += a1; sacc += a2; W0; A9_PIN(PW); A9_PIN(sacc); A9_SBAR(); } while (0)
#define GAP2(MF, a0, a1, W0, W1, PW) do { MF; sacc += a0; sacc += a1; W0; W1; A9_PIN(PW); A9_PIN(sacc); A9_SBAR(); } while (0)
#define GAPB(MF, X, i) do { MF; X[i] = EX(X[i]); X[i + 1] = EX(X[i + 1]); X[i + 2] = EX(X[i + 2]); X[i + 3] = EX(X[i + 3]); A9_PIN(X); A9_SBAR(); } while (0)
#define STEP(C0, C1, P0, P1, t, GK, GV, GL) do { A9_SBAR(); \
    const lds_cptr vp_ = vp0 + sl_prev; const lds_cptr rp_ = rp0 + rs_cur; \
    VRD(0); kload2(kr, rp_, 0); A9_SBAR(); float sacc = P0[0] + P0[1]; \
                       GAP3(C0 = A9_MFMA(kf[0], qr[0], nmh16), P0[2], P0[3], P0[4],    pw0[0] = PKW(P0, 0), pw0); \
    VRD(4); kload2(kr, rp_, 1); A9_SBAR(); \
                       GAP3(C1 = A9_MFMA(kf[1], qr[0], nmh16), P0[5], P0[6], P0[7],    pw0[1] = PKW(P0, 2), pw0); \
    VRD(1); A9_SBAR(); GAP2(C0 = A9_MFMA(kf[2], qr[1], C0),    P0[8], P0[9],           pw0[2] = PKW(P0, 4), pw0[3] = PKW(P0, 6), pw0); \
    VRD(5); A9_SBAR(); GAP3(C1 = A9_MFMA(kf[3], qr[1], C1),    P0[10], P0[11], P0[12], pw1[0] = PKW(P0, 8), pw1); \
    VRD(2); A9_SBAR(); GAP3(C0 = A9_MFMA(kf[4], qr[2], C0),    P0[13], P0[14], P0[15], pw1[1] = PKW(P0, 10), pw1); \
    VRD(6); A9_SBAR(); GAP2(C1 = A9_MFMA(kf[5], qr[2], C1),    P1[0], P1[1],           pw1[2] = PKW(P0, 12), pw1[3] = PKW(P0, 14), pw1); \
    VRD(3); A9_SBAR(); GAP3(C0 = A9_MFMA(kf[6], qr[3], C0),    P1[2], P1[3], P1[4],    pw2[0] = PKW(P1, 0), pw2); \
    VRD(7); A9_SBAR(); GAP3(C1 = A9_MFMA(kf[7], qr[3], C1),    P1[5], P1[6], P1[7],    pw2[1] = PKW(P1, 2), pw2); \
                       GAP2(C0 = A9_MFMA(kr[0], qr[4], C0),    P1[8], P1[9],           pw2[2] = PKW(P1, 4), pw2[3] = PKW(P1, 6), pw2); \
                       GAP3(C1 = A9_MFMA(kr[1], qr[4], C1),    P1[10], P1[11], P1[12], pw3[0] = PKW(P1, 8), pw3); \
                       GAP3(C0 = A9_MFMA(kr[2], qr[5], C0),    P1[13], P1[14], P1[15], pw3[1] = PKW(P1, 10), pw3); \
                       GAP2(C1 = A9_MFMA(kr[3], qr[5], C1),    0.f, 0.f,               pw3[2] = PKW(P1, 12), pw3[3] = PKW(P1, 14), pw3); \
    l_reg += sacc; \
    if (GK) DMA_K((t) + 3, sl_cur, RS3()); if (GV) DMA_V((t) + 1, sl_next); \
    { const float rm = rowmax(C0, C1); resc = false; \
      if (__builtin_expect(__any(rm > THR), 0)) { const float dl = __builtin_fmaxf(rm, 0.f); \
          _Pragma("unroll") for (int r_ = 0; r_ < 16; ++r_) { nmh16[r_] -= dl; C0[r_] -= dl; C1[r_] -= dl; } \
          const float f = __builtin_amdgcn_exp2f(-dl); l_reg *= f; if (hi == 0) wsf[r32] = f; resc = true; } } \
    A9_SBAR(); \
    GAPB(o[0] = A9_MFMA(PAF(0), VFR(0), o[0]), C0, 0);              GAPB(o[1] = A9_MFMA(PAF(0), VFR(4), o[1]), C0, 4); \
    KRD(GL, 0); GAPB(o[0] = A9_MFMA(PAF(1), VFR(1), o[0]), C0, 8);  KRD(GL, 1); GAPB(o[1] = A9_MFMA(PAF(1), VFR(5), o[1]), C0, 12); \
    KRD(GL, 2); GAPB(o[0] = A9_MFMA(PAF(2), VFR(2), o[0]), C1, 0);  KRD(GL, 3); GAPB(o[1] = A9_MFMA(PAF(2), VFR(6), o[1]), C1, 4); \
    GAPB(o[0] = A9_MFMA(PAF(3), VFR(3), o[0]), C1, 8);              GAPB(o[1] = A9_MFMA(PAF(3), VFR(7), o[1]), C1, 12); \
    } while (0)
    int t = 1;
    for (; t + 5 < NT; t += 2) {
        STEP(pB0, pB1, pA0, pA1, t, true, true, true);     A9_WAIT_BAR(3); RESC(); ROT();
        STEP(pA0, pA1, pB0, pB1, t + 1, true, true, true); A9_WAIT_BAR(3); RESC(); ROT();
    }
#define ENDW(tt) do { if ((tt) + 3 < NT) { A9_WAIT_BAR(3); } else if ((tt) + 2 < NT) { A9_WAIT_BAR(1); } else { A9_WAIT_BAR(0); } } while (0)
    for (; t + 1 < NT; t += 2) {
        STEP(pB0, pB1, pA0, pA1, t, (t + 3 < NT), (t + 1 < NT), (t + 1 < NT));         ENDW(t);     RESC(); ROT();
        STEP(pA0, pA1, pB0, pB1, t + 1, (t + 4 < NT), (t + 2 < NT), (t + 2 < NT));     ENDW(t + 1); RESC(); ROT();
    }
    STEP(pB0, pB1, pA0, pA1, NT - 1, false, false, false); RESC();
    { float sacc = pB0[0] + pB0[1];
#pragma unroll
      for (int r = 2; r < 16; ++r) sacc += pB0[r];
#pragma unroll
      for (int r = 0; r < 16; ++r) sacc += pB1[r];
      l_reg += sacc;
      pw0 = (u32x4){PKW(pB0, 0), PKW(pB0, 2), PKW(pB0, 4), PKW(pB0, 6)}; pw1 = (u32x4){PKW(pB0, 8), PKW(pB0, 10), PKW(pB0, 12), PKW(pB0, 14)};
      pw2 = (u32x4){PKW(pB1, 0), PKW(pB1, 2), PKW(pB1, 4), PKW(pB1, 6)}; pw3 = (u32x4){PKW(pB1, 8), PKW(pB1, 10), PKW(pB1, 12), PKW(pB1, 14)};
      const lds_cptr vp_ = vp0 + sl_cur; _Pragma("unroll") for (int i = 0; i < 8; ++i) VRD(i);
      o[0] = A9_MFMA(PAF(0), VFR(0), o[0]); o[1] = A9_MFMA(PAF(0), VFR(4), o[1]); o[0] = A9_MFMA(PAF(1), VFR(1), o[0]); o[1] = A9_MFMA(PAF(1), VFR(5), o[1]);
      o[0] = A9_MFMA(PAF(2), VFR(2), o[0]); o[1] = A9_MFMA(PAF(2), VFR(6), o[1]); o[0] = A9_MFMA(PAF(3), VFR(3), o[0]); o[1] = A9_MFMA(PAF(3), VFR(7), o[1]); }
    { auto rr = __builtin_amdgcn_permlane32_swap(__float_as_uint(l_reg), __float_as_uint(l_reg), false, false); l_reg = __uint_as_float(rr[0]) + __uint_as_float(rr[1]); }
    if (hi == 0) wsf[32 + r32] = l_reg; asm volatile("s_waitcnt lgkmcnt(0)" ::: "memory");
    float rli[16];
#pragma unroll
    for (int r = 0; r < 16; ++r) rli[r] = __builtin_amdgcn_rcpf(wsf[32 + crow(r, hi)]);
    bf16* Ow = a.O + (long)(wid * QBLK) * a.ldo; unsigned short* stg = (unsigned short*)(lds + LDS_OST) + wid * 2048;
#pragma unroll
    for (int r = 0; r < 16; ++r) { const int orow = crow(r, hi);
#pragma unroll
        for (int d0 = 0; d0 < 2; ++d0) { const float v = o[d0][r] * rli[r]; const unsigned u = __float_as_uint(v); stg[orow * 64 + d0 * 32 + r32] = (unsigned short)((u + 0x7fffu + ((u >> 16) & 1u)) >> 16); } }
    asm volatile("s_waitcnt lgkmcnt(0)" ::: "memory");
#pragma unroll
    for (int i = 0; i < 4; ++i) { const int row = i * 8 + (lane >> 3), ch = lane & 7; *(u32x4*)(Ow + (long)row * a.ldo + ch * 8) = *(const u32x4*)(stg + row * 64 + ch * 8); }
    asm volatile("s_waitcnt lgkmcnt(0)\n\ts_barrier" ::: "memory");
#undef DMA_K
#undef DMA_V
#undef ROT
#undef RS3
#undef EX
#undef RESC
#undef PKW
#undef PAF
#undef VFR
#undef VRD
#undef KRD
#undef ENDW
#undef GAP3
#undef GAP2
#undef GAPB
#undef STEP
}
#undef A9_SBAR
#undef A9_PIN
#undef A9_MFMA
#undef A9_WAIT_BAR
}

constexpr size_t MiB = 1u << 20;
constexpr size_t WS_CTL = 0, CTL_BYTES = 1 * MiB;
constexpr size_t WS_MOD = 1 * MiB;
constexpr size_t WS_T16C = WS_MOD + 256 * 1024, WS_T16S = WS_T16C + 4096, WS_T8C = WS_T16S + 4096, WS_T8S = WS_T8C + 2048;
constexpr size_t WS_RSQ = WS_MOD + 320 * 1024, WS_RSKV = WS_RSQ + 64 * 1024;
constexpr size_t WS_TAB = WS_MOD + 512 * 1024;
constexpr size_t WS_WT = 3 * MiB;
constexpr size_t WT_IN = 0, WT_G = WT_IN + (size_t)PPW * DM * 2, WT_QU = WT_G + (size_t)NGATE * DM * 2, WT_KVU = WT_QU + (size_t)768 * 384 * 2, WT_BR = WT_KVU + (size_t)1024 * 256 * 2,
                 WT_OUT = WT_BR + (size_t)3 * DM * 512 * 2, WT_F1 = WT_OUT + (size_t)DM * DM * 2, WT_F2 = WT_F1 + (size_t)DFF * DM * 2, WT_END = WT_F2 + (size_t)DM * DFF * 2;
static_assert(WT_END <= 36 * MiB, "weights");
constexpr size_t WS_CTXX = WS_WT + 36 * MiB;
constexpr size_t WS_XN = WS_CTXX + 4 * MiB;
constexpr size_t WS_HALF = WS_XN + 34 * MiB;
constexpr int NUNIT = 32 * (RPB / 32);
constexpr size_t H_PP = 0, H_QM = H_PP + (size_t)HM * PPW * 2, H_KVM = H_QM + (size_t)HM * 768 * 2, H_MO = H_KVM + (size_t)HM * 1024 * 2, H_PHI = H_MO + (size_t)HM * 512 * 2,
                 H_PSI = H_PHI + (size_t)NUNIT * 8192, H_GC = H_PSI + (size_t)NUNIT * 8192, H_END = H_GC + (size_t)NUNIT * 256;
constexpr size_t WS_END = WS_HALF + H_END;
static_assert(WS_END + 12 * MiB <= 256 * MiB, "workspace (the 12 MiB after WS_END hold transient scratch: pass-3 parking / split-K slabs)");
constexpr size_t WS_GB = WS_HALF + H_PHI, WS_MIX = WS_GB + (size_t)HM * 3 * DM * 2;
constexpr size_t WS_G0 = WS_HALF + H_KVM, WS_G1 = WS_HALF + H_PHI, WS_G2 = WS_G1 + (size_t)HM * DM * 2;
static_assert(WS_G2 + (size_t)HM * DM * 2 <= WS_HALF + H_PSI, "gate buffers");
constexpr size_t WS_HID = WS_HALF;
static_assert(WS_MIX + (size_t)HM * DM * 2 <= WS_HALF + H_GC && WS_HID + (size_t)MROWS * DFF * 2 <= WS_END, "overlays");
constexpr int CW_BAR = 4096, CW_ATT = 16384;

#define GAS __attribute__((address_space(1)))
#define LAS __attribute__((address_space(3)))
typedef unsigned short bf16;
typedef unsigned v4u __attribute__((ext_vector_type(4)));
typedef float f32x4 __attribute__((ext_vector_type(4)));
typedef float f32x8 __attribute__((ext_vector_type(8)));
#define LDS_WAIT() asm volatile("s_waitcnt lgkmcnt(0)" ::: "memory")
__device__ __forceinline__ unsigned f2bf(float f) { unsigned u = __builtin_bit_cast(unsigned, f); return (u + 0x7fffu + ((u >> 16) & 1u)) >> 16; }
__device__ __forceinline__ unsigned pk2(float lo, float hi) { return f2bf(lo) | (f2bf(hi) << 16); }
__device__ __forceinline__ float bf2f(unsigned short h) { return __uint_as_float((unsigned)h << 16); }

#define XB_TMO      128
#define XB_XCNT(j)  (256  + 64 * (j))
#define XB_XSUB(j)  (1280 + 64 * (j))
#define XB_XGEN(j)  (2304 + 64 * (j))
#define XB_TOP      3328
#define XB_TOPGEN   3392
#define XCD_BAR_WORDS 3456
#define XB_SPIN_CAP (1u << 22)
__device__ __forceinline__ unsigned xb_ld(unsigned* p)              { return __hip_atomic_load(p, __ATOMIC_RELAXED, __HIP_MEMORY_SCOPE_AGENT); }
__device__ __forceinline__ unsigned xb_add(unsigned* p, unsigned v) { return __hip_atomic_fetch_add(p, v, __ATOMIC_RELAXED, __HIP_MEMORY_SCOPE_AGENT); }
__device__ __forceinline__ unsigned xb_xcc_id() { return (unsigned)__builtin_amdgcn_s_getreg((3 << 11) | 20) & 0xFu; }
#define XB_SPIN(cond, bar) do { unsigned _sp = 0; while (cond) { __builtin_amdgcn_s_sleep(1); \
    if ((++_sp & 255u) == 0u) { if (xb_ld(&(bar)[XB_TMO])) break; if (_sp > XB_SPIN_CAP) { atomicAdd(&(bar)[XB_TMO], 1u); break; } } } } while (0)
struct XcdBarrier { unsigned* bar; unsigned x; volatile LAS unsigned* st; };
__device__ __forceinline__ XcdBarrier xcd_barrier_post(unsigned* bar, volatile LAS unsigned* st) {
    XcdBarrier b; b.bar = bar; b.x = xb_xcc_id(); b.st = st;
    if (threadIdx.x == 0) (void)xb_add(&bar[XB_XCNT(b.x)], 1u);
    return b;
}
__device__ __forceinline__ void xcd_barrier_complete(unsigned* bar, unsigned x, unsigned& nloc, unsigned& nx) {
    const unsigned G = gridDim.x * gridDim.y * gridDim.z;
    unsigned sum, cnt, mine, sp = 0u;
    for (;;) {
        sum = 0u; cnt = 0u; mine = 0u;
#pragma unroll
        for (unsigned j = 0; j < 16; ++j) { const unsigned c = xb_ld(&bar[XB_XCNT(j)]); sum += c; cnt += (c > 0u) ? 1u : 0u; mine = (j == x) ? c : mine; }
        if (sum == G) break;
        __builtin_amdgcn_s_sleep(1);
        if ((++sp & 255u) == 0u) { if (xb_ld(&bar[XB_TMO])) break; if (sp > XB_SPIN_CAP) { atomicAdd(&bar[XB_TMO], 1u); break; } }
    }
    nloc = mine > 0u ? mine : 1u; nx = cnt > 0u ? cnt : 1u;
}
__device__ __forceinline__ void xcd_barrier(const XcdBarrier& b) {
    asm volatile("s_waitcnt vmcnt(0)" ::: "memory");
    __syncthreads();
    if (threadIdx.x == 0) {
        unsigned* bar = b.bar; asm volatile("" : "+s"(bar));
        __builtin_amdgcn_s_waitcnt(0);
        unsigned nloc = b.st[0], nx = b.st[1];
        if (nloc == 0u) { xcd_barrier_complete(bar, b.x, nloc, nx); b.st[0] = nloc; b.st[1] = nx; }
        const unsigned old = xb_add(&bar[XB_XSUB(b.x)], 1u);
        const unsigned gen = old / nloc;
        if (old + 1u == (gen + 1u) * nloc) {
            __builtin_amdgcn_fence(__ATOMIC_RELEASE, "agent");
            asm volatile("s_waitcnt vmcnt(0)" ::: "memory");
            const unsigned og = xb_add(&bar[XB_TOP], 1u);
            const unsigned tg = og / nx;
            if (og + 1u == (tg + 1u) * nx) xb_add(&bar[XB_TOPGEN], 1u);
            else XB_SPIN(xb_ld(&bar[XB_TOPGEN]) == tg, bar);
            __builtin_amdgcn_fence(__ATOMIC_ACQUIRE, "agent");
            xb_add(&bar[XB_XGEN(b.x)], 1u);
            asm volatile("s_waitcnt vmcnt(0)" ::: "memory");
        } else {
            XB_SPIN(xb_ld(&bar[XB_XGEN(b.x)]) == gen, bar);
            __builtin_amdgcn_fence(__ATOMIC_ACQUIRE, "agent");
            asm volatile("s_waitcnt vmcnt(0)" ::: "memory");
        }
    }
    __syncthreads();
}

constexpr int NWAVES = 8, RING_BYTES = 131072, LDS_BYTES = 163840, MISC_OFF = LDS_BYTES - 512;
struct Args { const float* in[31]; float* out; unsigned char* ws; int ph_lo, ph_hi; };
enum { I_X = 0, I_C, I_CTX, I_CCTX, I_WMOD, I_BMOD, I_G1, I_G2, I_WIN, I_QGAIN, I_KGAIN, I_MU, I_W0, I_W2, I_A0, I_A2, I_G2R, I_KK, I_KA, I_RK, I_LNW, I_LNB, I_QNORM, I_QUP, I_KVNORM, I_KVUP, I_WBR, I_WOUT, I_FF1, I_FF2, I_GFIN };
#define CAS __attribute__((address_space(4)))
__device__ __forceinline__ const float* inp(int i) { const CAS Args* ap = (const CAS Args*)__builtin_amdgcn_kernarg_segment_ptr(); asm volatile("" : "+s"(ap)); return ap->in[i]; }
struct Frame {
    LAS unsigned char* lds; unsigned char* ldsg;
    unsigned* ctl; unsigned char* ws; float* out;
    int G, bid;
};
#define FTID() otid()
#define FLANE() (otid() & 63)
#define FWAVE() __builtin_amdgcn_readfirstlane(otid() >> 6)
__device__ __forceinline__ float wave_sum(float v) {
#pragma unroll
    for (int o = 1; o < 64; o <<= 1) v += __shfl_xor(v, o);
    return v;
}
__device__ __forceinline__ const float* xrow_ptr(const float* xl, const float* xc, int m) { const int b = m / RPB, s = m % RPB; return (s < CTX) ? xc + (size_t)(b * CTX + s) * DM : xl + (size_t)(b * SEQ + s - CTX) * DM; }

__device__ __forceinline__ void p0_transpose_item(const float* W, int ldw, int col0, int Kd, int N, bf16* WT, const float* kscale, LAS unsigned* scr, int item, int lane, int ldwt) {
    const int nblk = (N + 63) / 64, kb = item / nblk, nb = item % nblk, k0 = 64 * kb, n0 = 64 * nb, c = lane & 15, r4 = lane >> 4;
    const bool valid = n0 + 4 * c < N;
#pragma unroll
    for (int i = 0; i < 8; ++i) { const int k = 8 * i + 2 * r4; f32x4 a = (f32x4){0.f, 0.f, 0.f, 0.f}, bq = a;
        if (valid) { a = *(const f32x4*)(W + (size_t)(k0 + k) * ldw + col0 + n0 + 4 * c); bq = *(const f32x4*)(W + (size_t)(k0 + k + 1) * ldw + col0 + n0 + 4 * c); }
        if (kscale) { a = a * kscale[k0 + k]; bq = bq * kscale[k0 + k + 1]; }
#pragma unroll
        for (int e = 0; e < 4; ++e) scr[(4 * c + e) * 33 + (k >> 1)] = pk2(a[e], bq[e]); }
    LDS_WAIT(); asm volatile("" ::: "memory");
#pragma unroll
    for (int t = 0; t < 8; ++t) { const int n = (lane >> 3) + 8 * t, j = lane & 7; const LAS unsigned* p = scr + n * 33 + 4 * j;
        v4u o; o.x = p[0]; o.y = p[1]; o.z = p[2]; o.w = p[3];
        if (n0 + n < N) *(v4u*)(WT + (size_t)(n0 + n) * ldwt + k0 + 8 * j) = o; }
    LDS_WAIT(); asm volatile("" ::: "memory");
}

__device__ __forceinline__ void ph_weights(Frame& F, int l) {
    unsigned char* wt = F.ws + WS_WT;
    if (l == 0) {
        LAS float* sl = (LAS float*)F.lds;
        LAS float* red = (LAS float*)(F.lds + 32768);
        for (int i = FTID(); i < 5 * 1024; i += 512) { const int j = i >> 10, k = i & 1023; const float c = (j < 4) ? inp(I_C)[j * 1024 + k] : inp(I_CCTX)[k]; sl[i] = c / (1.f + __expf(-c)); }
        __syncthreads();
        for (int it = F.bid; it < 2 * 96; it += F.G) {
            const int ll = it / 96, n0 = (it % 96) * 64;
            const float* wm = inp(I_WMOD) + (size_t)ll * 1024 * 6144 + n0 + FLANE();
            float a0 = 0, a1 = 0, a2 = 0, a3 = 0, a4 = 0;
            for (int k0 = FWAVE() * 128; k0 < FWAVE() * 128 + 128; k0 += 16) { float w[16];
#pragma unroll
                for (int u = 0; u < 16; ++u) w[u] = wm[(size_t)(k0 + u) * 6144];
#pragma unroll
                for (int u = 0; u < 16; ++u) { const int k = k0 + u; a0 += sl[k] * w[u]; a1 += sl[1024 + k] * w[u]; a2 += sl[2048 + k] * w[u]; a3 += sl[3072 + k] * w[u]; a4 += sl[4096 + k] * w[u]; } }
            LAS float* r = red + FWAVE() * 320 + FLANE(); r[0] = a0; r[64] = a1; r[128] = a2; r[192] = a3; r[256] = a4;
            __syncthreads();
            if (FTID() < 320) { float s = 0; for (int w = 0; w < 8; ++w) s += red[w * 320 + FTID()]; const int j = FTID() >> 6, n = n0 + (FTID() & 63);
                ((float*)(F.ws + WS_MOD))[(size_t)(ll * 5 + j) * 6144 + n] = s + inp(I_BMOD)[ll * 6144 + n]; }
            __syncthreads();
        }
        if (F.bid == F.G - 1) {
            for (int i = FTID(); i < 64 * 16; i += 512) { const int pos = i >> 4, f = i & 15; const float ang = (float)pos * powf(10000.f, -(float)f / 16.f); ((float*)(F.ws + WS_T16C))[i] = cosf(ang); ((float*)(F.ws + WS_T16S))[i] = sinf(ang); }
            for (int i = FTID(); i < 64 * 8; i += 512) { const int pos = i >> 3, f = i & 7; const float ang = (float)pos * powf(10000.f, -(float)f / 8.f); ((float*)(F.ws + WS_T8C))[i] = cosf(ang); ((float*)(F.ws + WS_T8S))[i] = sinf(ang); }
        }
        __syncthreads();
    }
    {
        bf16* w2P = (bf16*)(F.ws + WS_TAB); bf16* a2B = (bf16*)(F.ws + WS_TAB + 131072); bf16* g2P = (bf16*)(F.ws + WS_TAB + 524288);
        const float* w2 = inp(I_W2) + (size_t)l * 2 * 64 * 512; const float* a2 = inp(I_A2) + (size_t)l * 2 * 64 * 512; const float* g2 = inp(I_G2R) + (size_t)l * 128 * 512;
        const float* mu = inp(I_MU) + (size_t)l * 2 * RWIN;
        for (int idx = F.bid * 512 + FTID(); idx < 65536; idx += F.G * 512) {
            { const int dh = idx >> 12, d = dh >> 3, hd = dh & 7, rem = idx & 4095, Ii = rem >> 11, J = (rem >> 10) & 1, S = (rem >> 9) & 1, ln = (rem >> 3) & 63, e = rem & 7;
              const int i = 32 * Ii + 16 * S + 8 * (e >> 2) + 4 * (ln >> 5) + (e & 3), k = 32 * J + (ln & 31);
              w2P[idx] = (bf16)f2bf(w2[(size_t)(d * 64 + i) * 512 + hd * 64 + k]); }
            { const int hd = idx >> 13, rem = idx & 8191, Ii = rem >> 11, Iv = (rem >> 10) & 1, S = (rem >> 9) & 1, ln = (rem >> 3) & 63, e = rem & 7;
              const int i = 32 * Ii + 16 * S + 8 * (e >> 2) + 4 * (ln >> 5) + (e & 3), v = 32 * Iv + (ln & 31);
              g2P[idx] = (bf16)f2bf(g2[(size_t)i * 512 + hd * 64 + v]); } }
        {   bf16* DF = (bf16*)(F.ws + WS_TAB + 655360);
            for (int idx = F.bid * 512 + FTID(); idx < 60 * 3 * 2 * 64 * 8; idx += F.G * 512) {
                const int e = idx & 7, ln = (idx >> 3) & 63, q = (idx >> 9) & 1, w = (idx >> 10) % 3, blk = idx / 3072, r = ln & 31, h = ln >> 5, cc = 32 * blk + r;
                const float m0 = mu[cc], m1 = mu[RWIN + cc]; const float cf = (w == 0) ? 1.f - m0 - m1 : (w == 1 ? m0 : m1);
                DF[idx] = (r == 16 * q + 8 * h + e) ? (bf16)f2bf(cf) : (bf16)0; } }
        for (int idx = F.bid * 512 + FTID(); idx < 196608; idx += F.G * 512) {
            const int dh = idx / 12288, rem = idx % 12288, w = rem >> 12, k = (rem >> 6) & 63, i = rem & 63, d = dh >> 3, hd = dh & 7;
            const float m0 = mu[RW_AD + d * 64 + i], m1 = mu[RWIN + RW_AD + d * 64 + i]; const float cf = (w == 0) ? 1.f - m0 - m1 : (w == 1 ? m0 : m1);
            a2B[idx] = (bf16)f2bf(a2[(size_t)(d * 64 + i) * 512 + hd * 64 + k] * cf); } }
    LAS unsigned* scr = (LAS unsigned*)(F.lds + FWAVE() * 16384);
    const int gw = F.bid * NWAVES + FWAVE(), NGW = F.G * NWAVES;
    const float* win = inp(I_WIN) + (size_t)l * DM * NIN;
    constexpr int I_A = 16 * 53, I_B = 16 * 48, I_C2 = 6 * 12, I_D = 4 * 16, I_E = 8 * 16, I_F = 16 * 16, I_G = 16 * 64, I_H = 64 * 16;
    constexpr int NITEMS = I_A + I_B + I_C2 + I_D + 3 * I_E + I_F + I_G + I_H;
    for (int it = gw; it < NITEMS; it += NGW) {
        int r = it; const int lane = FLANE();
        if (r < I_A) { p0_transpose_item(win, NIN, 0, DM, 3360, (bf16*)(wt + WT_IN), nullptr, scr, r, lane, DM); continue; } r -= I_A;
        if (r < I_B) { p0_transpose_item(win, NIN, C_GATE, DM, NGATE, (bf16*)(wt + WT_G), nullptr, scr, r, lane, DM); continue; } r -= I_B;
        if (r < I_C2) { p0_transpose_item(inp(I_QUP) + (size_t)l * 384 * 768, 768, 0, 384, 768, (bf16*)(wt + WT_QU), inp(I_QNORM) + l * 384, scr, r, lane, 384); continue; } r -= I_C2;
        if (r < I_D) { p0_transpose_item(inp(I_KVUP) + (size_t)l * 256 * 1024, 1024, 0, 256, 1024, (bf16*)(wt + WT_KVU), inp(I_KVNORM) + l * 256, scr, r, lane, 256); continue; } r -= I_D;
        if (r < 3 * I_E) { const int i = r / I_E; p0_transpose_item(inp(I_WBR) + (size_t)(l * 3 + i) * 512 * DM, DM, 0, 512, DM, (bf16*)(wt + WT_BR) + (size_t)i * DM * 512, nullptr, scr, r % I_E, lane, 512); continue; } r -= 3 * I_E;
        if (r < I_F) { p0_transpose_item(inp(I_WOUT) + (size_t)l * DM * DM, DM, 0, DM, DM, (bf16*)(wt + WT_OUT), nullptr, scr, r, lane, DM); continue; } r -= I_F;
        if (r < I_G) { p0_transpose_item(inp(I_FF1) + (size_t)l * DM * DFF, DFF, 0, DM, DFF, (bf16*)(wt + WT_F1), nullptr, scr, r, lane, DM); continue; } r -= I_G;
        p0_transpose_item(inp(I_FF2) + (size_t)l * DFF * DM, DM, 0, DFF, DM, (bf16*)(wt + WT_F2), nullptr, scr, r, lane, DFF);
    }
    { v4u* z = (v4u*)((bf16*)(wt + WT_IN) + (size_t)3360 * DM); const int nz = 224 * DM * 2 / 16; unsigned z0; asm volatile("v_mov_b32 %0, 0" : "=v"(z0));
      for (int i = F.bid * 512 + FTID(); i < nz; i += F.G * 512) z[i] = (v4u){z0, z0, z0, z0}; }
}

__device__ __forceinline__ void ph_norm(Frame& F, int l, const float* xl, const float* xc, const float* g, int which, bool skipctx, const float* part = nullptr) {
    const int gw = F.bid * NWAVES + FWAVE(), NGW = F.G * NWAVES;
    const float* mod = (const float*)(F.ws + WS_MOD) + (size_t)l * 5 * 6144;
    bf16* XN = (bf16*)(F.ws + WS_XN);
    for (int m = gw; m < MROWS; m += NGW) {
        const int b = m / RPB, s = m % RPB; if (skipctx && s < CTX) continue;
        const f32x4* xr = (const f32x4*)xrow_ptr(xl, xc, m) + FLANE();
        const float* mv = mod + (size_t)((s < CTX) ? 4 : b) * 6144 + which * 3072;
        f32x4 v[4]; float ss = 0.f;
#pragma unroll
        for (int j = 0; j < 4; ++j) { v[j] = xr[64 * j];
            if (part && s < CTX) { const f32x4* pr = (const f32x4*)(part + (size_t)(b * CTX + s) * DM) + FLANE() + 64 * j; v[j] = v[j] + pr[0] + pr[262144] + pr[524288]; }
            ss += (v[j].x * v[j].x + v[j].y * v[j].y) + (v[j].z * v[j].z + v[j].w * v[j].w); }
        const float rstd = 1.f / sqrtf(wave_sum(ss) * (1.f / DM) + NORM_EPS);
        unsigned long long* o8 = (unsigned long long*)(XN + (size_t)m * DM) + FLANE();
#pragma unroll
        for (int j = 0; j < 4; ++j) { const int c = 4 * FLANE() + 256 * j; const f32x4 gg = *(const f32x4*)(g + c), sh = *(const f32x4*)(mv + c), sc = *(const f32x4*)(mv + 1024 + c);
            const f32x4 y = v[j] * rstd * gg * (sc + 1.0f) + sh;
            o8[64 * j] = (unsigned long long)pk2(y.x, y.y) | ((unsigned long long)pk2(y.z, y.w) << 32); }
    }
}
__device__ __forceinline__ void ph_final(Frame& F) {
    const int gw = F.bid * NWAVES + FWAVE(), NGW = F.G * NWAVES; const float* g = inp(I_GFIN);
    for (int m = gw; m < NB * SEQ; m += NGW) {
        f32x4* xr = (f32x4*)(F.out + (size_t)m * DM) + FLANE(); f32x4 v[4]; float ss = 0.f;
#pragma unroll
        for (int j = 0; j < 4; ++j) { v[j] = xr[64 * j]; ss += (v[j].x * v[j].x + v[j].y * v[j].y) + (v[j].z * v[j].z + v[j].w * v[j].w); }
        const float rstd = 1.f / sqrtf(wave_sum(ss) * (1.f / DM) + NORM_EPS);
#pragma unroll
        for (int j = 0; j < 4; ++j) { const f32x4 gg = *(const f32x4*)(g + 4 * FLANE() + 256 * j); xr[64 * j] = v[j] * rstd * gg; }
    }
}

__device__ __forceinline__ void ph_prep(Frame& F, int l, int half) {
    const int gw = F.bid * NWAVES + FWAVE(), NGW = F.G * NWAVES, lane = FLANE();
    bf16* PP = (bf16*)(F.ws + WS_HALF + H_PP);
    const float* t16c = (const float*)(F.ws + WS_T16C); const float* t16s = (const float*)(F.ws + WS_T16S); const float* t8c = (const float*)(F.ws + WS_T8C); const float* t8s = (const float*)(F.ws + WS_T8S);
    float* rsq = (float*)(F.ws + WS_RSQ); float* rskv = (float*)(F.ws + WS_RSKV);
    const float* qg = inp(I_QGAIN) + l * 64; const float* kg = inp(I_KGAIN) + l * 64;
    for (int m = gw; m < HM; m += NGW) {
        const int s = m % RPB; const bool lat = s >= CTX; const int tt = s - CTX, pr = (tt >> 6) & 63, pc = tt & 63;
        bf16* row = PP + (size_t)m * PPW;
        for (int part = 0; part < 2; ++part) {
            if (part == 1 && lane >= 16) break;
            bf16* p = row + (part == 0 ? C_GQ : C_GK) + lane * 8; const float* gain = part == 0 ? qg : kg;
            const v4u w = *(const v4u*)p; float v[8] = {pg8::bf_lo(w.x), pg8::bf_hi(w.x), pg8::bf_lo(w.y), pg8::bf_hi(w.y), pg8::bf_lo(w.z), pg8::bf_hi(w.z), pg8::bf_lo(w.w), pg8::bf_hi(w.w)};
            float ss = 0; for (int e = 0; e < 8; ++e) ss += v[e] * v[e];
            ss += __shfl_xor(ss, 1); ss += __shfl_xor(ss, 2); ss += __shfl_xor(ss, 4);
            const float rstd = 1.f / sqrtf(ss * (1.f / 64.f) + NORM_EPS); const int j = lane & 7;
            const float qs = (part == 0) ? 0.125f * 1.4426950408889634f : 1.f;
            for (int e = 0; e < 8; ++e) v[e] = v[e] * (rstd * qs) * gain[j * 8 + e];
            float pv[8]; for (int e = 0; e < 8; ++e) pv[e] = __shfl_xor(v[e], 2);
            if (lat) { const int pos = (j < 4) ? pr : pc; const int f0 = 8 * (j & 1);
                for (int e = 0; e < 8; ++e) { const float c = t16c[pos * 16 + f0 + e], sn = t16s[pos * 16 + f0 + e]; v[e] = ((j & 2) == 0) ? v[e] * c - pv[e] * sn : pv[e] * sn + v[e] * c; } }
            v4u o; o.x = pk2(v[0], v[1]); o.y = pk2(v[2], v[3]); o.z = pk2(v[4], v[5]); o.w = pk2(v[6], v[7]); *(v4u*)p = o;
        }
        if (lane < 4) {
            bf16* p = row + C_KR + lane * 8; const v4u w = *(const v4u*)p; float v[8] = {pg8::bf_lo(w.x), pg8::bf_hi(w.x), pg8::bf_lo(w.y), pg8::bf_hi(w.y), pg8::bf_lo(w.z), pg8::bf_hi(w.z), pg8::bf_lo(w.w), pg8::bf_hi(w.w)};
            float pv[8]; for (int e = 0; e < 8; ++e) pv[e] = __shfl_xor(v[e], 1);
            if (lat) { const int pos = (lane < 2) ? pr : pc;
                for (int e = 0; e < 8; ++e) { const float c = t8c[pos * 8 + e], sn = t8s[pos * 8 + e]; v[e] = ((lane & 1) == 0) ? v[e] * c - pv[e] * sn : pv[e] * sn + v[e] * c; } }
            v4u o; o.x = pk2(v[0], v[1]); o.y = pk2(v[2], v[3]); o.z = pk2(v[4], v[5]); o.w = pk2(v[6], v[7]); *(v4u*)p = o;
        }
        { float sq = 0, skv = 0;
          if (lane < 48) { const v4u w = *(const v4u*)(row + C_QD + lane * 8); const float v[8] = {pg8::bf_lo(w.x), pg8::bf_hi(w.x), pg8::bf_lo(w.y), pg8::bf_hi(w.y), pg8::bf_lo(w.z), pg8::bf_hi(w.z), pg8::bf_lo(w.w), pg8::bf_hi(w.w)}; for (int e = 0; e < 8; ++e) sq += v[e] * v[e]; }
          if (lane < 32) { const v4u w = *(const v4u*)(row + C_KVD + lane * 8); const float v[8] = {pg8::bf_lo(w.x), pg8::bf_hi(w.x), pg8::bf_lo(w.y), pg8::bf_hi(w.y), pg8::bf_lo(w.z), pg8::bf_hi(w.z), pg8::bf_lo(w.w), pg8::bf_hi(w.w)}; for (int e = 0; e < 8; ++e) skv += v[e] * v[e]; }
          sq = wave_sum(sq); skv = wave_sum(skv);
          if (lane == 0) { rsq[m] = (0.10206207261596575f * 1.4426950408889634f) / sqrtf(sq * (1.f / 384.f) + NORM_EPS);     rskv[m] = 1.f / sqrtf(skv * (1.f / 256.f) + NORM_EPS); } }
    }
}
__device__ __forceinline__ void shifted8(const bf16* PP, int m, int cc0, const float* mu, float (&u)[8]) {
    const int s = m % RPB; const float fp = (s != 0 && s != CTX) ? 1.f : 0.f, fn = (s != CTX - 1 && s != RPB - 1) ? 1.f : 0.f;
    const int mp = m > 0 ? m - 1 : 0, mn = m < HM - 1 ? m + 1 : HM - 1;
    const v4u w = *(const v4u*)(PP + (size_t)m * PPW + C_RW + cc0), wp = *(const v4u*)(PP + (size_t)mp * PPW + C_RW + cc0), wn = *(const v4u*)(PP + (size_t)mn * PPW + C_RW + cc0);
    const f32x4 m0a = *(const f32x4*)(mu + cc0), m0b = *(const f32x4*)(mu + cc0 + 4), m1a = *(const f32x4*)(mu + RWIN + cc0), m1b = *(const f32x4*)(mu + RWIN + cc0 + 4);
    const float c[8] = {pg8::bf_lo(w.x), pg8::bf_hi(w.x), pg8::bf_lo(w.y), pg8::bf_hi(w.y), pg8::bf_lo(w.z), pg8::bf_hi(w.z), pg8::bf_lo(w.w), pg8::bf_hi(w.w)};
    const float a[8] = {pg8::bf_lo(wp.x), pg8::bf_hi(wp.x), pg8::bf_lo(wp.y), pg8::bf_hi(wp.y), pg8::bf_lo(wp.z), pg8::bf_hi(wp.z), pg8::bf_lo(wp.w), pg8::bf_hi(wp.w)};
    const float n[8] = {pg8::bf_lo(wn.x), pg8::bf_hi(wn.x), pg8::bf_lo(wn.y), pg8::bf_hi(wn.y), pg8::bf_lo(wn.z), pg8::bf_hi(wn.z), pg8::bf_lo(wn.w), pg8::bf_hi(wn.w)};
#pragma unroll
    for (int e = 0; e < 8; ++e) { const float m0 = (e < 4 ? m0a[e & 3] : m0b[e & 3]), m1 = (e < 4 ? m1a[e & 3] : m1b[e & 3]); u[e] = c[e] + m0 * (fp * a[e] - c[e]) + m1 * (fn * n[e] - c[e]); }
}
namespace rk {
using bf16x8 = __attribute__((ext_vector_type(8))) short;
using f32x16 = __attribute__((ext_vector_type(16))) float;
using u32x4 = __attribute__((ext_vector_type(4))) unsigned;
typedef float f32x2_t __attribute__((ext_vector_type(2))); typedef __bf16 bf16x2_t __attribute__((ext_vector_type(2)));
#define RK_DI __device__ __forceinline__
RK_DI f32x16 RK_MF(bf16x8 a, bf16x8 b, f32x16 c) { return __builtin_amdgcn_mfma_f32_32x32x16_bf16(a, b, c, 0, 0, 0); }
constexpr int NH = 8;
RK_DI unsigned cvt2(float lo, float hi) { f32x2_t v = {lo, hi}; bf16x2_t b = __builtin_convertvector(v, bf16x2_t); return __builtin_bit_cast(unsigned, b); }
RK_DI float lo16(unsigned w) { return __uint_as_float(w << 16); }
RK_DI float hi16(unsigned w) { return __uint_as_float(w & 0xffff0000u); }
RK_DI int crow(int reg, int h) { return (reg & 3) + 8 * (reg >> 2) + 4 * h; }
RK_DI int krow(int s, int h, int e) { return 16 * s + 8 * (e >> 2) + 4 * h + (e & 3); }
template <int S> RK_DI bf16x8 pack(const f32x16& x) { u32x4 p = {cvt2(x[8 * S], x[8 * S + 1]), cvt2(x[8 * S + 2], x[8 * S + 3]), cvt2(x[8 * S + 4], x[8 * S + 5]), cvt2(x[8 * S + 6], x[8 * S + 7])}; return __builtin_bit_cast(bf16x8, p); }
RK_DI bf16x8 pack8(const float (&u)[8]) { u32x4 p = {cvt2(u[0], u[1]), cvt2(u[2], u[3]), cvt2(u[4], u[5]), cvt2(u[6], u[7])}; return __builtin_bit_cast(bf16x8, p); }
RK_DI void unpack8(bf16x8 v, float (&u)[8]) { const u32x4 p = __builtin_bit_cast(u32x4, v); u[0] = lo16(p.x); u[1] = hi16(p.x); u[2] = lo16(p.y); u[3] = hi16(p.y); u[4] = lo16(p.z); u[5] = hi16(p.z); u[6] = lo16(p.w); u[7] = hi16(p.w); }
constexpr short ONE = (short)0x3F80;
template <int K> RK_DI bf16x8 idn(int r, int h) { bf16x8 v;
#pragma unroll
    for (int e = 0; e < 8; ++e) v[e] = (r == 16 * K + 8 * h + e) ? ONE : (short)0; return v; }
template <int S> RK_DI bf16x8 idp(int r, int h) { bf16x8 v;
#pragma unroll
    for (int e = 0; e < 8; ++e) v[e] = (r == krow(S, h, e)) ? ONE : (short)0; return v; }
RK_DI bf16x8 idn_q(int q, int r, int h) { return q ? idn<1>(r, h) : idn<0>(r, h); }
template <int S, bool STRICT> RK_DI bf16x8 incp(int r, int h, int flip) { bf16x8 v;
#pragma unroll
    for (int e = 0; e < 8; ++e) { const int s = krow(S, h, e); const bool on = flip ? (STRICT ? s > r : s >= r) : (STRICT ? s < r : s <= r); v[e] = on ? ONE : (short)0; } return v; }
template <bool STRICT> RK_DI void tmask(f32x16& g, int r, int h, int flip) {
#pragma unroll
    for (int reg = 0; reg < 16; ++reg) { const int s = crow(reg, h); const bool on = flip ? (STRICT ? s > r : s >= r) : (STRICT ? s < r : s <= r); g[reg] = on ? g[reg] : 0.f; } }
template <int FLIP> RK_DI void solve32(f32x16& x, const bf16x8 (&Mp)[2]) {
    constexpr int F1 = FLIP ? 1 : 0, F2 = 1 - F1;
    f32x16 base = x;
#pragma unroll 1
    for (int it = 0; it < NH; ++it) { const f32x16 t = RK_MF(Mp[F1], pack<F1>(x), base);
#pragma unroll
        for (int e = 0; e < 8; ++e) x[8 * F1 + e] = t[8 * F1 + e]; }
    { const f32x16 t = RK_MF(Mp[F1], pack<F1>(x), base); x = t; base = t; }
#pragma unroll 1
    for (int it = 0; it < NH; ++it) { const f32x16 t = RK_MF(Mp[F2], pack<F2>(x), base);
#pragma unroll
        for (int e = 0; e < 8; ++e) x[8 * F2 + e] = t[8 * F2 + e]; }
}
template <int FLIP> RK_DI void solve32p(f32x16& x, f32x16& y, const bf16x8 (&Mp)[2]) {
    constexpr int F1 = FLIP ? 1 : 0, F2 = 1 - F1;
    f32x16 bx = x, by = y;
#pragma unroll 1
    for (int it = 0; it < NH; ++it) { const f32x16 t = RK_MF(Mp[F1], pack<F1>(x), bx); const f32x16 u = RK_MF(Mp[F1], pack<F1>(y), by);
#pragma unroll
        for (int e = 0; e < 8; ++e) { x[8 * F1 + e] = t[8 * F1 + e]; y[8 * F1 + e] = u[8 * F1 + e]; } }
    { const f32x16 t = RK_MF(Mp[F1], pack<F1>(x), bx); const f32x16 u = RK_MF(Mp[F1], pack<F1>(y), by); x = t; bx = t; y = u; by = u; }
#pragma unroll 1
    for (int it = 0; it < NH; ++it) { const f32x16 t = RK_MF(Mp[F2], pack<F2>(x), bx); const f32x16 u = RK_MF(Mp[F2], pack<F2>(y), by);
#pragma unroll
        for (int e = 0; e < 8; ++e) { x[8 * F2 + e] = t[8 * F2 + e]; y[8 * F2 + e] = u[8 * F2 + e]; } }
}
RK_DI float sigm(float x) { return __builtin_amdgcn_rcpf(1.f + __expf(-x)); }
RK_DI float tanh_f(float x) { return 2.f * __builtin_amdgcn_rcpf(1.f + __expf(-2.f * x)) - 1.f; }

struct Ctx {
    unsigned char* ws; LAS unsigned char* sb; int m0, r, h, hd, dir, l, flip;
    int cofs, dofs;
    int zt;
    int lofs;
    unsigned mp, mn; int rowc, rowp, rown;
};
#define C_PP(c) ((const bf16*)((c).ws + WS_HALF + H_PP))
#define C_MU(c) (inp(I_MU) + (size_t)(c).l * 2 * RWIN)
#define C_W2P(c) ((const bf16*)((c).ws + WS_TAB) + (size_t)((c).dir * 8 + (c).hd) * 4096)
#define C_A2B(c) ((const bf16*)((c).ws + WS_TAB + 131072) + (size_t)((c).dir * 8 + (c).hd) * 3 * 4096)
constexpr int SBUF = 34 * 128;
RK_DI void stage_slice(const Ctx& c, int buf, int cc0) {
    const int lane = c.r + 32 * c.h, p = lane & 7, q4 = lane >> 4;
    const bf16* base = C_PP(c) + (ptrdiff_t)(c.m0 - 1 + (lane >> 3)) * PPW + C_RW + cc0;
    const int oe = (p ^ q4) << 3, oo = (p ^ (4 + q4)) << 3;
#pragma unroll
    for (int j = 0; j < 5; ++j) { const bf16* src = base + (ptrdiff_t)j * 8 * PPW + ((j & 1) ? oo : oe);
        if (j < 4 || lane < 16) __builtin_amdgcn_global_load_lds((const unsigned*)src, (LAS unsigned*)(c.sb + buf * SBUF + j * 1024), 16, 0, 0); }
}
#define RK_WAIT_DMA() asm volatile("s_waitcnt vmcnt(0)" ::: "memory")
#define RK_WAIT_LDS() asm volatile("s_waitcnt lgkmcnt(0)" ::: "memory")
RK_DI bf16x8 rawfrag(const Ctx& c, int buf, int ch, int w) {
    const int rho = c.r + (w == 0 ? 1 : (w == 1 ? 0 : 2)); const unsigned m = (w == 0) ? 0xffffffffu : (w == 1 ? c.mp : c.mn);
    u32x4 v = *(const LAS u32x4*)(c.sb + buf * SBUF + rho * 128 + ((ch ^ ((rho >> 1) & 7)) << 4) + c.zt); v.x &= m; v.y &= m; v.z &= m; v.w &= m; return __builtin_bit_cast(bf16x8, v); }
RK_DI bf16x8 dfrag(const Ctx& c, int cc32, int w, int q) { return *(const bf16x8*)((const bf16*)(c.ws + WS_TAB + 655360) + (((cc32 >> 5) * 3 + w) * 2 + q) * 512 + c.lofs); }
RK_DI f32x16 load_o2(Ctx& c, int buf, int lblk, int cc32) { f32x16 z = f32x16{};
#pragma unroll
    for (int q = 0; q < 2; ++q) {
#pragma unroll
        for (int w = 0; w < 3; ++w) z = RK_MF(dfrag(c, cc32, w, q), rawfrag(c, buf, 4 * lblk + 2 * q + c.h, w), z); }
    asm volatile("" : "+v"(c.lofs), "+v"(c.zt), "+v"(z));
    return z; }
RK_DI f32x16 load_o1(Ctx& c, int buf, int lblk, int cc32) { f32x16 z = f32x16{};
#pragma unroll
    for (int q = 0; q < 2; ++q) {
#pragma unroll
        for (int w = 0; w < 3; ++w) z = RK_MF(rawfrag(c, buf, 4 * lblk + 2 * q + c.h, w), dfrag(c, cc32, w, q), z); }
    asm volatile("" : "+v"(c.lofs), "+v"(c.zt), "+v"(z));
    return z; }

struct Tilde { bf16x8 At[2][2], Bt[2][2], Kt[2][2], Rt[2][2], Vp[2][2]; float gtot[2]; float bon; };
#define RK_STAGE(x) asm volatile("" : "+v"(c.lofs), "+v"(c.zt), "+v"(x))
template <bool NEED_R> RK_DI void build_tilde(Ctx& c, Tilde& T) {
    const int r = c.r, h = c.h;
    stage_slice(c, 0, RW_WD + c.dir * 64); stage_slice(c, 1, RW_K + c.hd * 64); stage_slice(c, 2, RW_AD + c.dir * 64); if constexpr (NEED_R) stage_slice(c, 3, RW_R + c.hd * 64);
    RK_WAIT_DMA();
    bf16x8 lwp[2][2];
    {   bf16x8 twp[2][2];
#pragma unroll
        for (int Ii = 0; Ii < 2; ++Ii) { f32x16 t = load_o2(c, 0, Ii, RW_WD + c.dir * 64 + 32 * Ii);
#pragma unroll
            for (int reg = 0; reg < 16; ++reg) t[reg] = tanh_f(t[reg]);
            twp[Ii][0] = pack<0>(t); twp[Ii][1] = pack<1>(t); RK_STAGE(twp[Ii][1]); }
#pragma unroll
        for (int J = 0; J < 2; ++J) { f32x16 wl = f32x16{};
#pragma unroll
            for (int Ii = 0; Ii < 2; ++Ii)
#pragma unroll
                for (int S = 0; S < 2; ++S) wl = RK_MF(twp[Ii][S], *(const bf16x8*)(C_W2P(c) + ((Ii * 2 + J) * 2 + S) * 512 + c.lofs), wl);
            const float w0 = inp(I_W0)[c.dofs + 32 * J + r]; float gs = 0.f;
#pragma unroll
            for (int reg = 0; reg < 16; ++reg) wl[reg] = -0.6065306597126334f * sigm(wl[reg] + w0);
            lwp[J][0] = pack<0>(wl); lwp[J][1] = pack<1>(wl);
            { float q[8]; unpack8(lwp[J][0], q);
#pragma unroll
              for (int e = 0; e < 8; ++e) gs += q[e]; unpack8(lwp[J][1], q);
#pragma unroll
              for (int e = 0; e < 8; ++e) gs += q[e]; }
            gs += __shfl_xor(gs, 32); T.gtot[J] = gs; RK_STAGE(lwp[J][1]); } }
    RK_WAIT_LDS(); stage_slice(c, 0, RW_V + c.hd * 64);
    float rinv;
    {   float ss = 0.f;
#pragma unroll
        for (int Ik = 0; Ik < 2; ++Ik) { const f32x16 kt = load_o2(c, 1, Ik, RW_K + c.hd * 64 + 32 * Ik);
#pragma unroll
            for (int g = 0; g < 4; ++g) { const f32x4 kk = *(const f32x4*)(inp(I_KK) + c.cofs + 32 * Ik + 8 * g + 4 * h);
#pragma unroll
                for (int j = 0; j < 4; ++j) { const float q = kt[4 * g + j] * kk[j]; ss += q * q; } }
            RK_STAGE(ss); }
        ss += __shfl_xor(ss, 32); rinv = 1.f / fmaxf(sqrtf(ss), 1e-12f); RK_STAGE(rinv); }
    float bon = 0.f;
#pragma unroll
    for (int Ik = 0; Ik < 2; ++Ik) {
        f32x16 em, ep;
        { em = RK_MF(lwp[Ik][0], incp<0, false>(r, h, c.flip), f32x16{}); em = RK_MF(lwp[Ik][1], incp<1, false>(r, h, c.flip), em);
          ep = RK_MF(lwp[Ik][0], incp<0, true>(r, h, c.flip), f32x16{}); ep = RK_MF(lwp[Ik][1], incp<1, true>(r, h, c.flip), ep);
#pragma unroll
          for (int reg = 0; reg < 16; ++reg) { em[reg] = __expf(-em[reg]); ep[reg] = __expf(ep[reg]); } }
        RK_STAGE(ep);
        f32x16 kt = load_o2(c, 1, Ik, RW_K + c.hd * 64 + 32 * Ik); f32x16 kn;
#pragma unroll
        for (int g = 0; g < 4; ++g) { const f32x4 kk = *(const f32x4*)(inp(I_KK) + c.cofs + 32 * Ik + 8 * g + 4 * h);
#pragma unroll
            for (int j = 0; j < 4; ++j) { const int reg = 4 * g + j; kn[reg] = kt[reg] * kk[j] * rinv; ep[reg] = -kn[reg] * ep[reg]; } }
        T.At[Ik][0] = pack<0>(ep); T.At[Ik][1] = pack<1>(ep);
        RK_STAGE(T.At[Ik][1]);
        f32x16 as = f32x16{};
#pragma unroll
        for (int w = 0; w < 3; ++w) {
#pragma unroll
            for (int sp = 0; sp < 4; ++sp) as = RK_MF(*(const bf16x8*)(C_A2B(c) + w * 4096 + (32 * Ik + r) * 64 + 16 * sp + 8 * h), rawfrag(c, 2, 2 * sp + h, w), as);
            RK_STAGE(as); }
#pragma unroll
        for (int g = 0; g < 4; ++g) { const f32x4 a0 = *(const f32x4*)(inp(I_A0) + c.dofs + 32 * Ik + 8 * g + 4 * h);
#pragma unroll
            for (int j = 0; j < 4; ++j) { const int reg = 4 * g + j; as[reg] = sigm(as[reg] + a0[j]); kn[reg] = kn[reg] * as[reg] * em[reg]; } }
        T.Bt[Ik][0] = pack<0>(kn); T.Bt[Ik][1] = pack<1>(kn);
        RK_STAGE(T.Bt[Ik][1]);
#pragma unroll
        for (int g = 0; g < 4; ++g) { const f32x4 ka = *(const f32x4*)(inp(I_KA) + c.cofs + 32 * Ik + 8 * g + 4 * h);
#pragma unroll
            for (int j = 0; j < 4; ++j) { const int reg = 4 * g + j; kt[reg] = kt[reg] * (1.f + (as[reg] - 1.f) * ka[j]); as[reg] = kt[reg] * em[reg]; } }
        T.Kt[Ik][0] = pack<0>(as); T.Kt[Ik][1] = pack<1>(as);
        RK_STAGE(T.Kt[Ik][1]);
        if constexpr (NEED_R) {
            f32x16 rt = load_o2(c, 3, Ik, RW_R + c.hd * 64 + 32 * Ik);
#pragma unroll
            for (int g = 0; g < 4; ++g) { const f32x4 rk = *(const f32x4*)(inp(I_RK) + c.cofs + 32 * Ik + 8 * g + 4 * h);
#pragma unroll
                for (int j = 0; j < 4; ++j) { const int reg = 4 * g + j; bon += rt[reg] * kt[reg] * rk[j]; rt[reg] = rt[reg] * __builtin_amdgcn_rcpf(em[reg]); } }
            T.Rt[Ik][0] = pack<0>(rt); T.Rt[Ik][1] = pack<1>(rt); RK_STAGE(T.Rt[Ik][1]); }
    }
    T.bon = bon;
    RK_WAIT_DMA();
#pragma unroll
    for (int J = 0; J < 2; ++J) { const f32x16 va = load_o1(c, 0, J, RW_V + c.hd * 64 + 32 * J); T.Vp[J][0] = pack<0>(va); T.Vp[J][1] = pack<1>(va); RK_STAGE(T.Vp[J][1]); }
}
RK_DI void grams_la(const Ctx& c, const Tilde& T, bf16x8 (&Lk)[2], bf16x8 (&Mp)[2]) {
    f32x16 g = f32x16{}, m = f32x16{};
#pragma unroll
    for (int Ik = 0; Ik < 2; ++Ik)
#pragma unroll
        for (int S = 0; S < 2; ++S) { g = RK_MF(T.Kt[Ik][S], T.At[Ik][S], g); m = RK_MF(T.Bt[Ik][S], T.At[Ik][S], m); }
    tmask<true>(g, c.r, c.h, c.flip); tmask<true>(m, c.r, c.h, c.flip);
    Lk[0] = pack<0>(g); Lk[1] = pack<1>(g); Mp[0] = pack<0>(m); Mp[1] = pack<1>(m);
}
}

namespace rk {
constexpr int NSUB = RPB / 32;
RK_DI int chain_unit(int dir, int j) { return dir == 0 ? j : (j < 8 ? 7 - j : 143 - j); }
RK_DI int chain_pos(int dir, int c) { return dir == 0 ? c : (c < 8 ? 7 - c : 143 - c); }
RK_DI void setup_ctx(Ctx& c, unsigned char* ws, LAS unsigned char* sb, int l, int bl, int hd, int dir, int c32, int lane) {
    c.ws = ws; c.sb = sb; c.m0 = bl * RPB + 32 * c32; c.r = lane & 31; c.h = lane >> 5; c.hd = hd; c.dir = dir; c.l = l; c.flip = dir;
    c.cofs = l * 512 + hd * 64; c.dofs = (l * 2 + dir) * 512 + hd * 64;
    const int m = c.m0 + c.r, sg = m % RPB;
    c.mp = (sg != 0 && sg != CTX) ? 0xffffffffu : 0u; c.mn = (sg != CTX - 1 && sg != RPB - 1) ? 0xffffffffu : 0u;
    c.rowc = m; c.rowp = m > 0 ? m - 1 : 0; c.rown = m < HM - 1 ? m + 1 : HM - 1; c.lofs = (c.r + 32 * c.h) * 8; asm volatile("v_mov_b32 %0, 0" : "=v"(c.zt));
}
RK_DI void pass1_unit(unsigned char* ws, LAS unsigned char* sb, int l, int u, int lane) {
    const int q = u / NSUB, c32 = u % NSUB, bl = q >> 4, hd = (q >> 1) & 7, dir = q & 1;
    Ctx c; setup_ctx(c, ws, sb, l, bl, hd, dir, c32, lane);
    Tilde T; build_tilde<false>(c, T); __builtin_amdgcn_sched_barrier(0);
    const int r = c.r, h = c.h;
    bf16x8 Lk[2], Mp[2]; grams_la(c, T, Lk, Mp); __builtin_amdgcn_sched_barrier(0);
    const bf16x8 P0 = idp<0>(r, h), P1 = idp<1>(r, h);
    bf16x8 W1p[2][2], W2p[2][2], Bop[2][2], Kop[2][2];
#pragma unroll
    for (int J = 0; J < 2; ++J) {
        f32x16 x = RK_MF(T.At[J][0], P0, f32x16{}); x = RK_MF(T.At[J][1], P1, x);
        f32x16 y = RK_MF(Lk[0], T.Vp[J][0], f32x16{}); y = RK_MF(Lk[1], T.Vp[J][1], y);
        if (c.flip) solve32p<1>(x, y, Mp); else solve32p<0>(x, y, Mp);
        W1p[J][0] = pack<0>(x); W1p[J][1] = pack<1>(x);
        W2p[J][0] = pack<0>(y); W2p[J][1] = pack<1>(y);
        const float gcj = __expf(T.gtot[J]);
        f32x16 b = RK_MF(T.Bt[J][0], P0, f32x16{}); b = RK_MF(T.Bt[J][1], P1, b);
        f32x16 k = RK_MF(T.Kt[J][0], P0, f32x16{}); k = RK_MF(T.Kt[J][1], P1, k);
#pragma unroll
        for (int reg = 0; reg < 16; ++reg) { b[reg] *= gcj; k[reg] *= gcj; }
        Bop[J][0] = pack<0>(b); Bop[J][1] = pack<1>(b); Kop[J][0] = pack<0>(k); Kop[J][1] = pack<1>(k);
    }
    u32x4* phi = (u32x4*)(ws + WS_HALF + H_PHI) + (size_t)u * 512 + lane;
    u32x4* psi = (u32x4*)(ws + WS_HALF + H_PSI) + (size_t)u * 512 + lane;
#pragma unroll
    for (int I = 0; I < 2; ++I)
#pragma unroll
        for (int J = 0; J < 2; ++J) {
            f32x16 a = RK_MF(W1p[I][0], Bop[J][0], f32x16{}); a = RK_MF(W1p[I][1], Bop[J][1], a);
            if (I == J) {
#pragma unroll
                for (int reg = 0; reg < 16; ++reg) a[reg] += (crow(reg, h) == r) ? __expf(T.gtot[J]) : 0.f; }
            phi[((I * 2 + J) * 2 + 0) * 64] = __builtin_bit_cast(u32x4, pack<0>(a)); phi[((I * 2 + J) * 2 + 1) * 64] = __builtin_bit_cast(u32x4, pack<1>(a));
            f32x16 p = RK_MF(Bop[I][0], W2p[J][0], f32x16{}); p = RK_MF(Bop[I][1], W2p[J][1], p); p = RK_MF(Kop[I][0], T.Vp[J][0], p); p = RK_MF(Kop[I][1], T.Vp[J][1], p);
            psi[((I * 2 + J) * 2 + 0) * 64] = (u32x4){cvt2(p[0], p[1]), cvt2(p[2], p[3]), cvt2(p[4], p[5]), cvt2(p[6], p[7])};
            psi[((I * 2 + J) * 2 + 1) * 64] = (u32x4){cvt2(p[8], p[9]), cvt2(p[10], p[11]), cvt2(p[12], p[13]), cvt2(p[14], p[15])};
        }
}
RK_DI void pass2_chain(unsigned char* ws, int q, int lane, bool do_store) {
    const int dir = q & 1;
    f32x16 H[2][2] = {{f32x16{}, f32x16{}}, {f32x16{}, f32x16{}}};
    u32x4 phi[8], psi[8];
    { const int u0 = q * NSUB + chain_unit(dir, 0);
      const u32x4* ph = (const u32x4*)(ws + WS_HALF + H_PHI) + (size_t)u0 * 512 + lane; const u32x4* ps = (const u32x4*)(ws + WS_HALF + H_PSI) + (size_t)u0 * 512 + lane;
#pragma unroll
      for (int f = 0; f < 8; ++f) { phi[f] = ph[f * 64]; psi[f] = ps[f * 64]; } }
    int uprev = q * NSUB + chain_unit(dir, 0);
#pragma unroll 1
    for (int j = 0; j < NSUB - 1; ++j) {
        const int un = q * NSUB + chain_unit(dir, j + 1 < NSUB - 1 ? j + 1 : j);
        u32x4 nphi[8], npsi[8];
        { const u32x4* ph = (const u32x4*)(ws + WS_HALF + H_PHI) + (size_t)un * 512 + lane; const u32x4* ps = (const u32x4*)(ws + WS_HALF + H_PSI) + (size_t)un * 512 + lane;
#pragma unroll
          for (int f = 0; f < 8; ++f) { nphi[f] = ph[f * 64]; npsi[f] = ps[f * 64]; } }
        bf16x8 Hp[2][2][2];
#pragma unroll
        for (int I = 0; I < 2; ++I)
#pragma unroll
            for (int J = 0; J < 2; ++J) { Hp[I][J][0] = pack<0>(H[I][J]); Hp[I][J][1] = pack<1>(H[I][J]); }
#pragma unroll
        for (int Ik = 0; Ik < 2; ++Ik)
#pragma unroll
            for (int Jv = 0; Jv < 2; ++Jv) {
                f32x16 a; const u32x4 p0 = psi[(Ik * 2 + Jv) * 2], p1 = psi[(Ik * 2 + Jv) * 2 + 1];
                a[0] = lo16(p0.x); a[1] = hi16(p0.x); a[2] = lo16(p0.y); a[3] = hi16(p0.y); a[4] = lo16(p0.z); a[5] = hi16(p0.z); a[6] = lo16(p0.w); a[7] = hi16(p0.w);
                a[8] = lo16(p1.x); a[9] = hi16(p1.x); a[10] = lo16(p1.y); a[11] = hi16(p1.y); a[12] = lo16(p1.z); a[13] = hi16(p1.z); a[14] = lo16(p1.w); a[15] = hi16(p1.w);
#pragma unroll
                for (int Ip = 0; Ip < 2; ++Ip) { a = RK_MF(__builtin_bit_cast(bf16x8, phi[(Ip * 2 + Ik) * 2 + 0]), Hp[Ip][Jv][0], a); a = RK_MF(__builtin_bit_cast(bf16x8, phi[(Ip * 2 + Ik) * 2 + 1]), Hp[Ip][Jv][1], a); }
                H[Ik][Jv] = a; }
        if (do_store) { u32x4* st = (u32x4*)(ws + WS_HALF + H_PSI) + (size_t)uprev * 512 + lane;
#pragma unroll
            for (int I = 0; I < 2; ++I)
#pragma unroll
                for (int J = 0; J < 2; ++J) { st[((I * 2 + J) * 2 + 0) * 64] = __builtin_bit_cast(u32x4, pack<0>(H[I][J])); st[((I * 2 + J) * 2 + 1) * 64] = __builtin_bit_cast(u32x4, pack<1>(H[I][J])); } }
        uprev = un;
#pragma unroll
        for (int f = 0; f < 8; ++f) { phi[f] = nphi[f]; psi[f] = npsi[f]; }
    }
    if (!do_store) { float chk = 0.f;
#pragma unroll
        for (int I = 0; I < 2; ++I)
#pragma unroll
            for (int J = 0; J < 2; ++J)
#pragma unroll
                for (int reg = 0; reg < 16; ++reg) chk += H[I][J][reg];
        if (chk == 123456.789f) ((float*)(ws + WS_END))[lane] = chk; }
}
RK_DI void pass2_half(unsigned char* ws, int q, int jv, int lane) {
    static_assert((NSUB - 1) % 3 == 0, "three-step rotation");
    const int dir = q & 1;
    bf16x8 Hp[2][2] = {{bf16x8{}, bf16x8{}}, {bf16x8{}, bf16x8{}}};
#define P2_LD(jj, PH, PS) do { const int jc_ = (jj) < NSUB - 1 ? (jj) : NSUB - 2; const int un_ = q * NSUB + chain_unit(dir, jc_); \
        const u32x4* ph_ = (const u32x4*)(ws + WS_HALF + H_PHI) + (size_t)un_ * 512 + lane; const u32x4* ps_ = (const u32x4*)(ws + WS_HALF + H_PSI) + (size_t)un_ * 512 + jv * 128 + lane; \
        _Pragma("unroll") for (int f = 0; f < 8; ++f) PH[f] = ph_[f * 64]; \
        PS[0] = ps_[0]; PS[1] = ps_[64]; PS[2] = ps_[256]; PS[3] = ps_[320]; } while (0)
#define P2_UNPK(A, p0, p1) do { A[0] = lo16(p0.x); A[1] = hi16(p0.x); A[2] = lo16(p0.y); A[3] = hi16(p0.y); A[4] = lo16(p0.z); A[5] = hi16(p0.z); A[6] = lo16(p0.w); A[7] = hi16(p0.w); \
        A[8] = lo16(p1.x); A[9] = hi16(p1.x); A[10] = lo16(p1.y); A[11] = hi16(p1.y); A[12] = lo16(p1.z); A[13] = hi16(p1.z); A[14] = lo16(p1.w); A[15] = hi16(p1.w); } while (0)
#define P2_STEP(jj, PH, PS) do { f32x16 a0, a1; P2_UNPK(a0, PS[0], PS[1]); P2_UNPK(a1, PS[2], PS[3]); \
        _Pragma("unroll") for (int Ip = 0; Ip < 2; ++Ip) { \
            a0 = RK_MF(__builtin_bit_cast(bf16x8, PH[(Ip * 2 + 0) * 2 + 0]), Hp[Ip][0], a0); a1 = RK_MF(__builtin_bit_cast(bf16x8, PH[(Ip * 2 + 1) * 2 + 0]), Hp[Ip][0], a1); \
            a0 = RK_MF(__builtin_bit_cast(bf16x8, PH[(Ip * 2 + 0) * 2 + 1]), Hp[Ip][1], a0); a1 = RK_MF(__builtin_bit_cast(bf16x8, PH[(Ip * 2 + 1) * 2 + 1]), Hp[Ip][1], a1); } \
        Hp[0][0] = pack<0>(a0); Hp[0][1] = pack<1>(a0); Hp[1][0] = pack<0>(a1); Hp[1][1] = pack<1>(a1); \
        u32x4* st_ = (u32x4*)(ws + WS_HALF + H_PSI) + (size_t)(q * NSUB + chain_unit(dir, (jj))) * 512 + jv * 128 + lane;        \
        st_[0] = __builtin_bit_cast(u32x4, Hp[0][0]); st_[64] = __builtin_bit_cast(u32x4, Hp[0][1]); st_[256] = __builtin_bit_cast(u32x4, Hp[1][0]); st_[320] = __builtin_bit_cast(u32x4, Hp[1][1]); } while (0)
    u32x4 phA[8], psA[4], phB[8], psB[4], phC[8], psC[4];
    P2_LD(0, phA, psA); P2_LD(1, phB, psB);
#pragma unroll 1
    for (int j = 0; j < NSUB - 1; j += 3) {
        P2_LD(j + 2, phC, psC); P2_STEP(j, phA, psA);
        P2_LD(j + 3, phA, psA); P2_STEP(j + 1, phB, psB);
        P2_LD(j + 4, phB, psB); P2_STEP(j + 2, phC, psC);
    }
#undef P2_LD
#undef P2_UNPK
#undef P2_STEP
}
RK_DI void pass3_dir(const int DIR, unsigned char* ws, LAS unsigned char* sb, int l, int bl, int hd, int c32, int lane, f32x16 (&Y)[2], float& bons) {
    Ctx c; setup_ctx(c, ws, sb, l, bl, hd, DIR, c32, lane);
    const int r = c.r, h = c.h;
    Tilde T; build_tilde<true>(c, T); __builtin_amdgcn_sched_barrier(0);
    bons += T.bon + __shfl_xor(T.bon, 32);
    bf16x8 Lk[2], Mp[2]; grams_la(c, T, Lk, Mp); __builtin_amdgcn_sched_barrier(0);
    bf16x8 Ab[2], Ak[2];
    {   f32x16 gb = f32x16{}, gk = f32x16{};
#pragma unroll
        for (int Ik = 0; Ik < 2; ++Ik)
#pragma unroll
            for (int S = 0; S < 2; ++S) { gb = RK_MF(T.Bt[Ik][S], T.Rt[Ik][S], gb); gk = RK_MF(T.Kt[Ik][S], T.Rt[Ik][S], gk); }
        tmask<false>(gb, r, h, DIR); tmask<false>(gk, r, h, DIR);
        Ab[0] = pack<0>(gb); Ab[1] = pack<1>(gb); Ak[0] = pack<0>(gk); Ak[1] = pack<1>(gk); }
    RK_STAGE(Ak[1]);
    bf16x8 H0p[2][2][2];
    { const int q = (bl * 8 + hd) * 2 + DIR, j = chain_pos(DIR, c32);
      if (j > 0) { const u32x4* st = (const u32x4*)(ws + WS_HALF + H_PSI) + (size_t)(q * NSUB + chain_unit(DIR, j - 1)) * 512 + lane;
#pragma unroll
          for (int I = 0; I < 2; ++I)
#pragma unroll
              for (int J = 0; J < 2; ++J) { H0p[I][J][0] = __builtin_bit_cast(bf16x8, st[((I * 2 + J) * 2 + 0) * 64]); H0p[I][J][1] = __builtin_bit_cast(bf16x8, st[((I * 2 + J) * 2 + 1) * 64]); } }
      else {
#pragma unroll
          for (int I = 0; I < 2; ++I)
#pragma unroll
              for (int J = 0; J < 2; ++J) { H0p[I][J][0] = bf16x8{}; H0p[I][J][1] = bf16x8{}; } } }
    bf16x8 Up[2][2];
    {   f32x16 xs[2];
#pragma unroll
        for (int Jv = 0; Jv < 2; ++Jv) {
            f32x16 x = RK_MF(Lk[0], T.Vp[Jv][0], f32x16{}); x = RK_MF(Lk[1], T.Vp[Jv][1], x);
#pragma unroll
            for (int Ik = 0; Ik < 2; ++Ik) { x = RK_MF(T.At[Ik][0], H0p[Ik][Jv][0], x); x = RK_MF(T.At[Ik][1], H0p[Ik][Jv][1], x); }
            xs[Jv] = x; }
        if (DIR) solve32p<1>(xs[0], xs[1], Mp); else solve32p<0>(xs[0], xs[1], Mp);
#pragma unroll
        for (int Jv = 0; Jv < 2; ++Jv) { Up[Jv][0] = pack<0>(xs[Jv]); Up[Jv][1] = pack<1>(xs[Jv]); }
        __builtin_amdgcn_sched_barrier(0); }
    __builtin_amdgcn_sched_barrier(0);
#pragma unroll
    for (int Iv = 0; Iv < 2; ++Iv) {
        f32x16 y = f32x16{};
#pragma unroll
        for (int Ik = 0; Ik < 2; ++Ik) { y = RK_MF(H0p[Ik][Iv][0], T.Rt[Ik][0], y); y = RK_MF(H0p[Ik][Iv][1], T.Rt[Ik][1], y); }
        y = RK_MF(Up[Iv][0], Ab[0], y); y = RK_MF(Up[Iv][1], Ab[1], y); y = RK_MF(T.Vp[Iv][0], Ak[0], y); y = RK_MF(T.Vp[Iv][1], Ak[1], y);
        Y[Iv] = y; }
}
RK_DI void pass3_unit(unsigned char* ws, LAS unsigned char* sb, int l, int v3, int lane, unsigned* ypark) {
    const int c32 = v3 % NSUB, bh = v3 / NSUB, bl = bh >> 3, hd = bh & 7, r = lane & 31, h = lane >> 5;
    float bons = 0.f;
    LAS float* ylds = (LAS float*)(sb + SBUF);
#pragma unroll 1
    for (int dir = 0; dir < 2; ++dir) {
        int lane_ = lane; asm volatile("" : "+v"(lane_));
        f32x16 Y[2]; pass3_dir(dir, ws, sb, l, bl, hd, c32, lane_, Y, bons);
        if (dir == 0) {
#pragma unroll
            for (int Iv = 0; Iv < 2; ++Iv)
#pragma unroll
                for (int d = 0; d < 8; ++d) ypark[(Iv * 8 + d) * 64 + lane] = cvt2(Y[Iv][2 * d], Y[Iv][2 * d + 1]); }
        else {
#pragma unroll
            for (int Iv = 0; Iv < 2; ++Iv)
#pragma unroll
                for (int reg = 0; reg < 16; ++reg) ylds[(Iv * 16 + reg) * 64 + lane] = Y[Iv][reg]; }
        __builtin_amdgcn_sched_barrier(0); }
    f32x16 YT[2];
#pragma unroll
    for (int Iv = 0; Iv < 2; ++Iv)
#pragma unroll
        for (int d = 0; d < 8; ++d) { const unsigned w = ypark[(Iv * 8 + d) * 64 + lane]; YT[Iv][2 * d] = ylds[(Iv * 16 + 2 * d) * 64 + lane] + lo16(w); YT[Iv][2 * d + 1] = ylds[(Iv * 16 + 2 * d + 1) * 64 + lane] + hi16(w); }
    Ctx c; setup_ctx(c, ws, sb, l, bl, hd, 0, c32, lane);
    RK_WAIT_LDS(); stage_slice(c, 1, RW_GD); stage_slice(c, 2, RW_GD + 64); RK_WAIT_DMA();
    float sm = 0.f;
#pragma unroll
    for (int Iv = 0; Iv < 2; ++Iv)
#pragma unroll
        for (int reg = 0; reg < 16; ++reg) sm += YT[Iv][reg];
    sm += __shfl_xor(sm, 32); const float mean = sm * (1.f / 64.f); float vq = 0.f;
#pragma unroll
    for (int Iv = 0; Iv < 2; ++Iv)
#pragma unroll
        for (int reg = 0; reg < 16; ++reg) { YT[Iv][reg] -= mean; vq += YT[Iv][reg] * YT[Iv][reg]; }
    vq += __shfl_xor(vq, 32); const float rstd = 1.f / sqrtf(vq * (1.f / 64.f) + LNX_EPS);
    const bf16* g2P = (const bf16*)(ws + WS_TAB + 524288) + (size_t)hd * 8192;
    const float* lnw = inp(I_LNW) + l * 512 + hd * 64; const float* lnb = inp(I_LNB) + l * 512 + hd * 64;
    bf16x8 sgp[4][2];
#pragma unroll
    for (int Ii = 0; Ii < 4; ++Ii) { f32x16 t = load_o2(c, 1 + (Ii >> 1), Ii & 1, RW_GD + 32 * Ii);
#pragma unroll
        for (int reg = 0; reg < 16; ++reg) t[reg] = sigm(t[reg]);
        sgp[Ii][0] = pack<0>(t); sgp[Ii][1] = pack<1>(t); __builtin_amdgcn_sched_barrier(0); }
    RK_WAIT_LDS(); LAS unsigned char* st = c.sb + SBUF;
#pragma unroll
    for (int Iv = 0; Iv < 2; ++Iv) {
        f32x16 gt = f32x16{};
#pragma unroll
        for (int Ii = 0; Ii < 4; ++Ii)
#pragma unroll
            for (int S = 0; S < 2; ++S) { gt = RK_MF(*(const bf16x8*)(g2P + ((Ii * 2 + Iv) * 2 + S) * 512 + c.lofs), sgp[Ii][S], gt); if (S) RK_STAGE(gt); }
        const f32x16 vt = load_o2(c, 0, Iv, RW_V + hd * 64 + 32 * Iv);
#pragma unroll
        for (int g = 0; g < 4; ++g) { const int v0 = 32 * Iv + 8 * g + 4 * h; const f32x4 lw = *(const f32x4*)(lnw + v0), lb = *(const f32x4*)(lnb + v0); float o[4];
#pragma unroll
            for (int j = 0; j < 4; ++j) { const int reg = 4 * g + j; o[j] = (YT[Iv][reg] * rstd * lw[j] + lb[j] + bons * vt[reg]) * gt[reg]; }
            *(LAS unsigned long long*)(st + r * 144 + 2 * v0) = (unsigned long long)cvt2(o[0], o[1]) | ((unsigned long long)cvt2(o[2], o[3]) << 32); }
    }
    asm volatile("s_waitcnt lgkmcnt(0)" ::: "memory");
    bf16* RO = (bf16*)(ws + WS_HALF + H_PP) + (size_t)c.m0 * PPW + C_QD + hd * 64;
#pragma unroll
    for (int i = 0; i < 4; ++i) { const int id = i * 64 + lane, row = id >> 3, ch = id & 7; const u32x4 v = *(const LAS u32x4*)(st + row * 144 + ch * 16); *(u32x4*)(RO + (size_t)row * PPW + ch * 8) = v; }
    asm volatile("s_waitcnt lgkmcnt(0)" ::: "memory");
}
}

__device__ __forceinline__ void ph_rwkv1(Frame& F, int l) {
    const int gw = F.bid * NWAVES + FWAVE(), NGW = F.G * NWAVES; LAS unsigned char* sb = F.lds + FWAVE() * (4 * rk::SBUF);
#pragma unroll 1
    for (int u = gw; u < NUNIT; u += NGW) rk::pass1_unit(F.ws, sb, l, u, otid() & 63);
    asm volatile("s_waitcnt vmcnt(0) lgkmcnt(0)" ::: "memory");
}
__device__ __forceinline__ void ph_rwkv3(Frame& F, int l, bool ctx_emit) {
    const int gw = F.bid * NWAVES + FWAVE(), NGW = F.G * NWAVES; LAS unsigned char* sb = F.lds + FWAVE() * (4 * rk::SBUF);
    unsigned* ypark = (unsigned*)(F.ws + WS_END) + (size_t)gw * 1024;
    const int per = ctx_emit ? rk::NSUB : rk::NSUB - 8, nun = 16 * per;
#pragma unroll 1
    for (int j = gw; j < nun; j += NGW) { const int v3 = (j / per) * rk::NSUB + (rk::NSUB - per) + j % per; rk::pass3_unit(F.ws, sb, l, v3, otid() & 63, ypark); }
    asm volatile("s_waitcnt vmcnt(0) lgkmcnt(0)" ::: "memory");
}
__device__ __forceinline__ void ph_mixer(Frame& F, int l, int half, int rep) {
    const bool ctx_out = (l == 0);
#ifdef EXTRA_P2
    if (F.bid < 4 && rep == 0) rk::pass2_chain(F.ws, F.bid * 8 + FWAVE(), otid() & 63, false);
#endif
    if (F.bid < 16 && rep == 0 && FWAVE() < 4) { const int ch = F.bid * 4 + FWAVE(); rk::pass2_half(F.ws, ch >> 1, ch & 1, otid() & 63); }
    __syncthreads();
    unsigned* ctr = F.ctl + CW_ATT + ((l * 2 + half) * 2 + rep) * 64;
    LAS unsigned* slot = (LAS unsigned*)(F.lds + MISC_OFF);
    const bf16* PP = (const bf16*)(F.ws + WS_HALF + H_PP); const bf16* QM = (const bf16*)(F.ws + WS_HALF + H_QM); const bf16* KVM = (const bf16*)(F.ws + WS_HALF + H_KVM);
    bf16* MO = (bf16*)(F.ws + WS_HALF + H_MO); bf16* DUM = (bf16*)(F.ws + WS_END);
    const int nunits = ctx_out ? 544 : 512;
    for (;;) {
        if (FTID() == 0) slot[0] = atomicAdd(ctr, 1u);
        __syncthreads();
        const int u = (int)slot[0];
        __syncthreads();
        if (u >= nunits) break;
        int type, bl, h, qb, nkeys, qrow0;
        if (u < 512) { type = u >> 8; const int v = u & 255; bl = v >> 7; h = (v >> 4) & 7; qb = v & 15; nkeys = RPB; qrow0 = bl * RPB + CTX + qb * 256; }
        else { const int v = u - 512; type = v >> 4; bl = (v >> 3) & 1; h = v & 7; qb = 0; nkeys = CTX; qrow0 = bl * RPB; }
        const int krow0 = bl * RPB;
        att::Args a;
        if (type == 0) {
            a.Q = QM + (size_t)qrow0 * 768 + h * 96; a.ldq = 768; a.K0 = KVM + (size_t)krow0 * 1024 + h * 128; a.ldk0 = 1024; a.K1 = PP + (size_t)krow0 * PPW + C_KR; a.ldk1 = PPW;
            a.V = KVM + (size_t)krow0 * 1024 + h * 128 + 64; a.ldv = 1024; a.O = (rep ? DUM : MO) + (size_t)qrow0 * 512 + h * 64; a.ldo = 512; a.nkeys = nkeys;
            a.rope_t0 = (u < 512) ? qb * 256 : -1; a.tc = (const float*)(F.ws + WS_T8C); a.ts = (const float*)(F.ws + WS_T8S);
            at96::Args b; b.Q = a.Q; b.ldq = a.ldq; b.K0 = a.K0; b.ldk0 = a.ldk0; b.K1 = a.K1; b.ldk1 = a.ldk1; b.V = a.V; b.ldv = a.ldv; b.O = a.O; b.ldo = a.ldo; b.nkeys = a.nkeys;
            b.rope_t0 = a.rope_t0; b.tc = a.tc; b.ts = a.ts;
            at96::unit(b, (char*)F.ldsg);
        } else {
            const int kvh = h >> 2;
            a.Q = PP + (size_t)qrow0 * PPW + C_GQ + h * 64; a.ldq = PPW; a.K0 = PP + (size_t)krow0 * PPW + C_GK + kvh * 64; a.ldk0 = PPW; a.K1 = a.K0; a.ldk1 = PPW;
            a.V = PP + (size_t)krow0 * PPW + C_GV + kvh * 64; a.ldv = PPW; a.O = rep ? DUM + (size_t)qrow0 * 512 + h * 64 : (bf16*)PP + (size_t)qrow0 * PPW + C_GQ + h * 64; a.ldo = rep ? 512 : PPW; a.nkeys = nkeys; a.rope_t0 = -1; a.tc = nullptr; a.ts = nullptr;
            at64::Args b; b.Q = a.Q; b.ldq = a.ldq; b.K = a.K0; b.ldk = a.ldk0; b.V = a.V; b.ldv = a.ldv; b.O = a.O; b.ldo = a.ldo; b.nkeys = a.nkeys;
            at64::unit(b, (char*)F.ldsg);
        }
    }
}

enum { OP_W0 = 0, OP_NORM1, OP_INPROJ, OP_PREP, OP_UP, OP_MIXER, OP_FINISH, OP_GATE, OP_MERGE, OP_WOUT, OP_NORM2, OP_FFUP, OP_FFDOWN, OP_FINAL };
constexpr int N_PHASES = 40;
__global__ void __launch_bounds__(NWAVES * 64, 2) trunk_fwd(Args args) {
    extern __shared__ __attribute__((aligned(16))) unsigned char lds[];
    Frame F;
    F.lds = (LAS unsigned char*)lds; F.ldsg = lds;
    F.G = gridDim.x; F.bid = blockIdx.x; F.ws = args.ws; F.ctl = (unsigned*)(args.ws + WS_CTL); F.out = args.out;
    volatile LAS unsigned* MISC = (volatile LAS unsigned*)(F.lds + MISC_OFF);
    for (int u = threadIdx.x; u < 32; u += NWAVES * 64) MISC[u] = 0u;
    __syncthreads();
    const int lo = args.ph_lo, hi = args.ph_hi;
    XcdBarrier bar = xcd_barrier_post(F.ctl + CW_BAR, MISC + 8);
#ifdef EXTRA_OP
    for (int pp = 2 * lo; pp < 2 * hi; ++pp) { const int p = pp >> 1, rep = pp & 1;
#else
    for (int p = lo; p < hi; ++p) { const int rep = 0;
#endif
        GAS unsigned char* wsg_ = (GAS unsigned char*)args.ws; GAS float* outg_ = (GAS float*)args.out; int bid_ = blockIdx.x, G_ = gridDim.x;
        asm volatile("" : "+s"(wsg_), "+s"(outg_), "+s"(bid_), "+s"(G_));
        unsigned char* ws = (unsigned char*)wsg_; float* outp = (float*)outg_;
        F.ws = ws; F.out = outp; F.bid = bid_; F.G = G_; F.ctl = (unsigned*)(ws + WS_CTL);
        unsigned char* wt = ws + WS_WT; const bf16* XN = (const bf16*)(ws + WS_XN); float* ctxx = (float*)(ws + WS_CTXX);
        int op, l = 0, half = 0;
        if (p == 0) op = OP_W0; else if (p == N_PHASES - 1) op = OP_FINAL;
        else { const int q = p - 1, r = q % 19; l = q / 19; if (r == 0) op = OP_NORM1; else if (r <= 8) { half = 0; op = OP_INPROJ + (r - 1); } else if (r <= 15) { half = 1; op = OP_PREP + (r - 9); } else op = OP_NORM2 + (r - 16); }
#ifdef ONLY_OP
        op = ONLY_OP;
#endif
#ifdef EXTRA_OP
        if (rep && op != EXTRA_OP) continue;
#endif
        const float* xl = (l == 0) ? inp(I_X) : F.out; const float* xc = (l == 0) ? inp(I_CTX) : ctxx;
        const bool ctx_out = (l == 0);
        const int nMf = ctx_out ? 68 : 64, nMh = ctx_out ? 34 : 32, skipf = ctx_out ? 0 : 1;
        switch (op) {
        case OP_W0: ph_weights(F, 0); break;
        case OP_NORM1: if (l == 1) ph_weights(F, 1); ph_norm(F, l, xl, xc, inp(I_G1) + l * DM, 0, false, (l == 1) ? (const float*)(ws + WS_END) : nullptr); break;
#define RUN_INPROJ(hh) do { pg8::Gemm g_{XN + (size_t)(hh) * HM * DM, (const bf16*)(wt + WT_IN), DM, DM, DM}; pg8::TileOrder S_; S_.init(HM / 256, PPW / 256, F.G, F.bid, 0); \
            pg8::Epi<pg8::EPI_BF16> E_{}; E_.O = (bf16*)(ws + WS_HALF + H_PP); E_.ldc = PPW; pg8::gemm_phase<pg8::Epi<pg8::EPI_BF16>, pg8::TileOrder, true>(F.lds, g_, S_, E_); } while (0)
        case OP_INPROJ: RUN_INPROJ(half); break;
        case OP_PREP: if (rep == 0) ph_prep(F, l, half); ph_rwkv1(F, l); break;
        case OP_UP: {
            { pg8::Gemm g{(const bf16*)(ws + WS_HALF + H_PP) + C_QD, (const bf16*)(wt + WT_QU), PPW, 384, 384}; pg8::TileOrder S; S.init(HM / 256, 3, F.G, F.bid, 0);
              pg8::Epi<pg8::EPI_ROWSCALE> E{}; E.O = (bf16*)(ws + WS_HALF + H_QM); E.ldc = 768; E.rs = (const float*)(ws + WS_RSQ);
              pg8::gemm_phase<pg8::Epi<pg8::EPI_ROWSCALE>, pg8::TileOrder, true>(F.lds, g, S, E); }
            { pg8::Gemm g{(const bf16*)(ws + WS_HALF + H_PP) + C_KVD, (const bf16*)(wt + WT_KVU), PPW, 256, 256}; pg8::TileOrder S; S.init(HM / 256, 4, F.G, (F.bid + 102) % F.G, 0);
              pg8::Epi<pg8::EPI_ROWSCALE> E{}; E.O = (bf16*)(ws + WS_HALF + H_KVM); E.ldc = 1024; E.rs = (const float*)(ws + WS_RSKV);
              pg8::gemm_phase<pg8::Epi<pg8::EPI_ROWSCALE>, pg8::TileOrder, true>(F.lds, g, S, E); } } break;
        case OP_MIXER: ph_mixer(F, l, half, rep); break;
        case OP_FINISH: ph_rwkv3(F, l, ctx_out); if (ctx_out) __syncthreads(); break;
        case OP_GATE: {
            const int gs = ctx_out ? 16 : 0;
            if (F.bid >= gs) { pg8::Gemm g{XN + (size_t)half * HM * DM, (const bf16*)(wt + WT_G), DM, DM, DM}; pg8::TileOrder S; S.init(nMh, 12, F.G - gs, F.bid - gs, skipf);
                pg8::Epi<pg8::EPI_SIGMOID> E{}; E.O = (bf16*)(ws + WS_G0); E.O1 = (bf16*)(ws + WS_G1); E.O2 = (bf16*)(ws + WS_G2); E.ldc = DM;
                pg8::gemm_phase<pg8::Epi<pg8::EPI_SIGMOID>, pg8::TileOrder, true>(F.lds, g, S, E); } } break;
        case OP_MERGE: {
            for (int i = 0; i < 3; ++i) {
                const bf16* A = (i == 0) ? (const bf16*)(ws + WS_HALF + H_PP) + C_GQ : (i == 1) ? (const bf16*)(ws + WS_HALF + H_PP) + C_QD : (const bf16*)(ws + WS_HALF + H_MO);
                pg8::Gemm g{A, (const bf16*)(wt + WT_BR) + (size_t)i * DM * 512, (i == 2) ? 512 : PPW, 512, 512}; pg8::TileOrder S; S.init(nMh, 4, F.G, F.bid, skipf);
                pg8::Epi<pg8::EPI_GATEMUL> E{}; E.O = (bf16*)(ws + WS_MIX); E.ldc = DM; E.G = (const bf16*)(ws + ((i == 0) ? WS_G0 : (i == 1) ? WS_G1 : WS_G2)); E.ldg = DM; E.first = (i == 0);
                pg8::gemm_phase<pg8::Epi<pg8::EPI_GATEMUL>, pg8::TileOrder, true>(F.lds, g, S, E); }
            } break;
        case OP_WOUT: {
            pg8::Gemm g{(const bf16*)(ws + WS_MIX), (const bf16*)(wt + WT_OUT), DM, DM, DM}; pg8::TileOrder S; S.init(nMh, 4, F.G, F.bid, skipf);
            pg8::Epi<pg8::EPI_RESID> E{}; E.xsl = xl; E.xsc = xc; E.xdl = F.out; E.xdc = ctxx; E.gate = (const float*)(ws + WS_MOD) + (size_t)l * 5 * 6144 + 2048; E.pm_off = half * 34; E.part = nullptr; E.kslice = 1;
            pg8::gemm_phase<pg8::Epi<pg8::EPI_RESID>, pg8::TileOrder, true>(F.lds, g, S, E);
            if (half == 0) RUN_INPROJ(1);
            } break;
        case OP_NORM2: ph_norm(F, l, F.out, ctxx, inp(I_G2) + l * DM, 1, !ctx_out); break;
        case OP_FFUP: {
            pg8::Gemm g{XN, (const bf16*)(wt + WT_F1), DM, DM, DM}; pg8::TileOrder S; S.init(nMf, 16, F.G, F.bid, skipf);
            pg8::Epi<pg8::EPI_RELU2> E{}; E.O = (bf16*)(ws + WS_HID); E.ldc = DFF;
            pg8::gemm_phase<pg8::Epi<pg8::EPI_RELU2>, pg8::TileOrder, true>(F.lds, g, S, E); } break;
        case OP_FFDOWN: {
            pg8::Gemm g{(const bf16*)(ws + WS_HID), (const bf16*)(wt + WT_F2), DFF, DFF, DFF}; pg8::TileOrder S; S.init(64, 4, F.G, F.bid, 1);
            pg8::Epi<pg8::EPI_RESID> E{}; E.xsl = F.out; E.xsc = ctxx; E.xdl = F.out; E.xdc = ctxx; E.gate = (const float*)(ws + WS_MOD) + (size_t)l * 5 * 6144 + 5120; E.pm_off = 0; E.part = nullptr; E.kslice = 1;
            pg8::gemm_phase<pg8::Epi<pg8::EPI_RESID>, pg8::TileOrder, true>(F.lds, g, S, E);
            if (ctx_out) { pg8::Gemm g2{(const bf16*)(ws + WS_HID), (const bf16*)(wt + WT_F2), DFF, DFF, DFF / 4}; pg8::CtxSplitOrder S2; S2.init(F.G, F.bid, DFF / 4);
                E.part = (float*)(ws + WS_END); E.kslice = DFF / 4; pg8::gemm_phase<pg8::Epi<pg8::EPI_RESID>, pg8::CtxSplitOrder, true>(F.lds, g2, S2, E); } } break;
        default: ph_final(F); break;
        }
        if (op == OP_FINISH && ctx_out) continue;
#ifdef EXTRA_OP
        if (pp + 1 < 2 * hi) xcd_barrier(bar);
#else
        if (p + 1 < hi) xcd_barrier(bar);
#endif
    }
}

extern "C" void kernel_launch(void* const* d_in, const int* in_sizes, int n_in, void* d_out, int out_size, void* d_ws, size_t ws_size, hipStream_t stream) {
    static int grid = 0;
    if (grid == 0) {
        if (n_in != 31 || out_size != NB * SEQ * DM || ws_size < WS_END + 12 * MiB) { fprintf(stderr, "kernel_launch: unexpected shapes (n_in %d out %d ws %zu, need ws >= %zu)\n", n_in, out_size, ws_size, (size_t)WS_END); grid = -1; return; }
        int dev = 0, cus = 0;
        if (hipGetDevice(&dev) != hipSuccess || hipDeviceGetAttribute(&cus, hipDeviceAttributeMultiprocessorCount, dev) != hipSuccess) { grid = -1; return; }
        if (hipFuncSetAttribute((const void*)trunk_fwd, hipFuncAttributeMaxDynamicSharedMemorySize, LDS_BYTES) != hipSuccess) { fprintf(stderr, "kernel_launch: hipFuncSetAttribute failed\n"); grid = -1; return; }
        grid = cus;
    }
    if (grid < 0) return;
    (void)hipMemsetAsync((char*)d_ws + WS_CTL, 0, CTL_BYTES, stream);
    Args a{};
    for (int i = 0; i < 31; ++i) a.in[i] = (const float*)d_in[i];
    a.out = (float*)d_out; a.ws = (unsigned char*)d_ws;
#if ONE_LAUNCH
    a.ph_lo = 0; a.ph_hi = N_PHASES;
    hipLaunchKernelGGL(trunk_fwd, dim3(grid), dim3(NWAVES * 64), LDS_BYTES, stream, a);
#else
    for (int p = 0; p < N_PHASES; ++p) { a.ph_lo = p; a.ph_hi = p + 1; hipLaunchKernelGGL(trunk_fwd, dim3(grid), dim3(NWAVES * 64), LDS_BYTES, stream, a); }
#endif
}
```

```cpp
#include <hip/hip_runtime.h>
#include <hip/hip_bf16.h>
#include <cstdio>
#include <cstdint>

#ifndef ONE_LAUNCH
#define ONE_LAUNCH 1
#define P2_WGS 8
#endif

constexpr int DM = 1024, NB = 4, SEQ = 4096, CTX = 256, RPB = SEQ + CTX  , MROWS = NB * RPB  , HM = 2 * RPB  ;
constexpr int NIN = 6432, PPW = 3584  , NGATE = 3072;
constexpr int C_GQ = 0, C_GK = 512, C_GV = 640, C_RW = 768, C_QD = 2688, C_KVD = 3072, C_KR = 3328, C_GATE = 3360;
constexpr int RW_R = 0, RW_K = 512, RW_V = 1024, RW_WD = 1536, RW_AD = 1664, RW_GD = 1792, RWIN = 1920;
constexpr int DFF = 4096;
constexpr float NORM_EPS = 1e-6f, LNX_EPS = 64e-5f;

__device__ __forceinline__ int otid() { int t = threadIdx.x; asm volatile("" : "+v"(t)); return t; }
namespace pg8 {
#define PG8_LAS __attribute__((address_space(3)))
typedef unsigned short bf16_t;
typedef short bf16x8 __attribute__((ext_vector_type(8)));
typedef float f32x4 __attribute__((ext_vector_type(4)));
typedef unsigned u32x4 __attribute__((ext_vector_type(4)));
constexpr int BM = 256, BK = 64, HALF = 128, HTB = HALF * BK * 2, STAGE_BYTES = 8 * HTB, NXCD = 8, WGM = 8;

__host__ __device__ __forceinline__ int lds_byte(int r, int c) { const int st = (r >> 4) * 2 + (c >> 5), rr = r & 15, cc = c & 31, ob = rr * 64 + cc * 2; return st * 1024 + (ob ^ (((ob >> 9) & 1) << 5)); }
__host__ __device__ __forceinline__ void stage_rc(int b, int& R, int& C) { const int st = b / 1024, sb = b % 1024, swz = sb ^ (((sb >> 9) & 1) << 5); R = (st >> 1) * 16 + swz / 64; C = (st & 1) * 32 + (swz % 64) / 2; }
__host__ __device__ __forceinline__ int perm32(int rho) { const int n = rho >> 4, i = rho & 15; return 8 * (i >> 2) + 4 * n + (i & 3); }

struct Unit { int pm, pn, ka; };
struct Gemm { const bf16_t* A; const bf16_t* Bt; int lda, ldb, K; };

struct TileOrder {
    int nM, nN, nwg, G, c, skipctx;
    __device__ void init(int nM_, int nN_, int G_, int c_, int skip_) { nM = nM_; nN = nN_; nwg = nM * nN; G = G_; c = c_; skipctx = skip_; }
    __device__ bool next(int i, Unit& u) const {
        const long L = (long)i * G + c; if (L >= nwg) return false;
        int wgid = (int)L; { const int q = nwg / NXCD, r = nwg % NXCD, xcd = wgid % NXCD, off = wgid / NXCD; wgid = (xcd < r ? xcd * (q + 1) : r * (q + 1) + (xcd - r) * q) + off; }
        const int nig = WGM * nN, gid = wgid / nig, fm = gid * WGM, gsz = (nM - fm) < WGM ? (nM - fm) : WGM;
        u.pm = fm + ((wgid % nig) % gsz); u.pn = (wgid % nig) / gsz; u.ka = 0;
        if (skipctx) u.pm = u.pm + u.pm / 16 + 1;
        return true;
    }
    __device__ __forceinline__ void a_ready(const Unit&) const {}
    __device__ __forceinline__ void done(const Unit&) const {}
};

struct CtxSplitOrder {
    int G, c, kslice;
    __device__ void init(int G_, int c_, int kslice_) { G = G_; c = c_; kslice = kslice_; }
    __device__ bool next(int i, Unit& u) const { const int L = i * G + c; if (L >= 64) return false; const int t = L >> 2; u.pm = (t >> 2) * 17; u.pn = t & 3; u.ka = (L & 3) * kslice; return true; }
    __device__ __forceinline__ void a_ready(const Unit&) const {}
    __device__ __forceinline__ void done(const Unit&) const {}
};
__device__ __forceinline__ unsigned cvt_pk_bf16(float lo, float hi) { unsigned r; asm volatile("v_cvt_pk_bf16_f32 %0, %1, %2" : "=v"(r) : "v"(lo), "v"(hi)); return r; }
__device__ __forceinline__ float bf_lo(unsigned w) { return __uint_as_float(w << 16); }
__device__ __forceinline__ float bf_hi(unsigned w) { return __uint_as_float(w & 0xffff0000u); }

enum { EPI_BF16 = 0, EPI_RELU2 = 1, EPI_SIGMOID = 2, EPI_ROWSCALE = 3, EPI_MLAQ = 4, EPI_GATEMUL0 = 5, EPI_GATEMUL = 6, EPI_RESID = 7 };
template <int MODE> struct Epi {
    static constexpr bool PERM = true, AFTER_DRAIN = false;
    bf16_t* O; int ldc;
    bf16_t* O1; bf16_t* O2;
    const float* rs;
    const bf16_t* G; int ldg;
    const float* tc; const float* ts;
    int first;
    int pm_off, kslice;
    float* part;
    const float* xsl; const float* xsc; float* xdl; float* xdc; const float* gate;
    __device__ __forceinline__ void operator()(const f32x4 (&acc)[2][2][4][2], const Unit& u, int wr, int wc, int fr, int fq) const {
        const int col0 = u.pn * BM + wc * 32 + 8 * fq;
        if constexpr (MODE == EPI_RESID) {
            const int gpm = u.pm + pm_off, b = gpm / 17, t = gpm % 17;
            const float* xs = (t == 0) ? xsc + (size_t)(b * CTX) * DM : xsl + (size_t)(b * SEQ + (t - 1) * 256) * DM;
            float* xd = (t == 0) ? xdc + (size_t)(b * CTX) * DM : xdl + (size_t)(b * SEQ + (t - 1) * 256) * DM;
            const float* gv = gate + (size_t)((t == 0) ? 4 : b) * 6144;
            f32x4 g[2][2];
#pragma unroll
            for (int bj = 0; bj < 2; ++bj)
#pragma unroll
                for (int n = 0; n < 2; ++n) g[bj][n] = *(const f32x4*)(gv + col0 + bj * HALF + 4 * n);
#pragma unroll
            for (int ai = 0; ai < 2; ++ai)
#pragma unroll
                for (int m = 0; m < 4; ++m) { const size_t ro = (size_t)(ai * HALF + wr * 64 + m * 16 + fr) * DM + col0;
#pragma unroll
                    for (int bj = 0; bj < 2; ++bj)
#pragma unroll
                        for (int n = 0; n < 2; ++n) {
                            if (u.ka != 0) *(f32x4*)(part + (size_t)(u.ka / kslice - 1) * 1048576 + (size_t)(b * CTX) * DM + ro + bj * HALF + 4 * n) = g[bj][n] * acc[ai][bj][m][n];
                            else { const f32x4 xv = *(const f32x4*)(xs + ro + bj * HALF + 4 * n);
                                *(f32x4*)(xd + ro + bj * HALF + 4 * n) = xv + g[bj][n] * acc[ai][bj][m][n]; } } }
        } else {
            const int row0 = u.pm * BM + wr * 64 + fr;
#pragma unroll
            for (int ai = 0; ai < 2; ++ai)
#pragma unroll
                for (int m = 0; m < 4; ++m) { const int row = row0 + ai * HALF + m * 16; bf16_t* rowp = O + (size_t)row * ldc + col0;
                    if constexpr (MODE == EPI_SIGMOID) { const int bi = u.pn >> 2; rowp += (long)(bi & 1) * (O1 - O) + (long)(bi >> 1) * (O2 - O) - bi * 4 * BM; }
                    float rsc = 1.f; int pr = 0, pc = 0; bool lat = false;
                    if constexpr (MODE == EPI_ROWSCALE || MODE == EPI_MLAQ) rsc = rs[row];
                    if constexpr (MODE == EPI_MLAQ) { const int s = row % RPB; lat = s >= CTX; const int tt = s - CTX; pr = (tt >> 6) & 63; pc = tt & 63; }
#pragma unroll
                    for (int bj = 0; bj < 2; ++bj) { f32x4 v0 = acc[ai][bj][m][0], v1 = acc[ai][bj][m][1];
                        if constexpr (MODE == EPI_RELU2) {
#pragma unroll
                            for (int e = 0; e < 4; ++e) { float a = fmaxf(v0[e], 0.f), b = fmaxf(v1[e], 0.f); v0[e] = a * a; v1[e] = b * b; } }
                        if constexpr (MODE == EPI_SIGMOID) {
#pragma unroll
                            for (int e = 0; e < 4; ++e) { v0[e] = 1.f / (1.f + __expf(-v0[e])); v1[e] = 1.f / (1.f + __expf(-v1[e])); } }
                        if constexpr (MODE == EPI_ROWSCALE || MODE == EPI_MLAQ) { v0 = v0 * rsc; v1 = v1 * rsc; }
                        if constexpr (MODE == EPI_MLAQ) {
                            const int g32 = u.pn * 8 + bj * 4 + wc;
                            if (g32 % 3 == 2) {
                                f32x4 p0, p1;
#pragma unroll
                                for (int e = 0; e < 4; ++e) { p0[e] = __shfl_xor(v0[e], 16); p1[e] = __shfl_xor(v1[e], 16); }
                                if (lat) { const int pos = (fq < 2) ? pr : pc; const f32x4 c0 = *(const f32x4*)(tc + pos * 8), c1 = *(const f32x4*)(tc + pos * 8 + 4), s0 = *(const f32x4*)(ts + pos * 8), s1 = *(const f32x4*)(ts + pos * 8 + 4);
                                    if ((fq & 1) == 0) { v0 = v0 * c0 - p0 * s0; v1 = v1 * c1 - p1 * s1; } else { v0 = p0 * s0 + v0 * c0; v1 = p1 * s1 + v1 * c1; } }
                            } }
                        if constexpr (MODE == EPI_GATEMUL0 || MODE == EPI_GATEMUL) {
                            const u32x4 gw = *(const u32x4*)(G + (size_t)row * ldg + col0 + bj * HALF);
                            v0[0] *= bf_lo(gw.x); v0[1] *= bf_hi(gw.x); v0[2] *= bf_lo(gw.y); v0[3] *= bf_hi(gw.y); v1[0] *= bf_lo(gw.z); v1[1] *= bf_hi(gw.z); v1[2] *= bf_lo(gw.w); v1[3] *= bf_hi(gw.w);
                            if (MODE == EPI_GATEMUL && !first) { const u32x4 ow = *(const u32x4*)(rowp + bj * HALF);
                                v0[0] += bf_lo(ow.x); v0[1] += bf_hi(ow.x); v0[2] += bf_lo(ow.y); v0[3] += bf_hi(ow.y); v1[0] += bf_lo(ow.z); v1[1] += bf_hi(ow.z); v1[2] += bf_lo(ow.w); v1[3] += bf_hi(ow.w); } }
                        u32x4 w; w.x = cvt_pk_bf16(v0[0], v0[1]); w.y = cvt_pk_bf16(v0[2], v0[3]); w.z = cvt_pk_bf16(v1[0], v1[1]); w.w = cvt_pk_bf16(v1[2], v1[3]);
                        *(u32x4*)(rowp + bj * HALF) = w; } }
        }
    }
};

template <class EpiT, class Sched, bool ALIGN_EPI>
__device__ __forceinline__ void gemm_phase(PG8_LAS unsigned char* lds, const Gemm g, const Sched& S, const EpiT& E) {
    const int tid = otid(), wid = __builtin_amdgcn_readfirstlane(tid >> 6), lane = tid & 63, wr = wid >> 2, wc = wid & 3, fr = lane & 15, fq = lane >> 4;
    const int nt = g.K / BK;
    unsigned voffA[2], voffB[2];
#pragma unroll
    for (int i = 0; i < 2; ++i) { int R, C; stage_rc(tid * 16 + i * 8192, R, C); const int Rb = EpiT::PERM ? ((R & ~31) + perm32(R & 31)) : R;
        voffA[i] = (unsigned)(R * g.lda + C) * 2u; voffB[i] = (unsigned)(Rb * g.ldb + C) * 2u; }
    const size_t kstep = (size_t)(BK * 2);
    const size_t hsA = (size_t)HALF * g.lda * 2, hsB = (size_t)HALF * g.ldb * 2, tsA = 2 * hsA, tsB = 2 * hsB;
    const unsigned ldsw = (unsigned)wid * 1024u;
    const int aoff = lds_byte(wr * 64 + fr, fq * 8), boff = lds_byte(wc * 32 + fr, fq * 8);
#define PG8_SA(b, h) (((b) * 2 + (h)) * HTB)
#define PG8_SB(b, h) ((4 + (b) * 2 + (h)) * HTB)
#define PG8_STAGE(bufoff, gbase, voff) do { _Pragma("unroll") for (int _i = 0; _i < 2; ++_i) \
        __builtin_amdgcn_global_load_lds((const unsigned*)((const char*)(gbase) + (voff)[_i]), (PG8_LAS unsigned*)(lds + (bufoff) + ldsw + _i * 8192), 16, 0, 0); } while (0)
#define PG8_LDA(dst, b, h) do { _Pragma("unroll") for (int m = 0; m < 4; ++m) _Pragma("unroll") for (int k = 0; k < 2; ++k) dst[m][k] = *(const PG8_LAS bf16x8*)(lds + PG8_SA(b, h) + aoff + m * 2048 + k * 1024); } while (0)
#define PG8_LDB(dst, b, h) do { _Pragma("unroll") for (int n = 0; n < 2; ++n) _Pragma("unroll") for (int k = 0; k < 2; ++k) dst[n][k] = *(const PG8_LAS bf16x8*)(lds + PG8_SB(b, h) + boff + n * 2048 + k * 1024); } while (0)
#define PG8_MMA(ai, bj, At, Bt) do { __builtin_amdgcn_s_setprio(1); _Pragma("unroll") for (int m = 0; m < 4; ++m) _Pragma("unroll") for (int n = 0; n < 2; ++n) _Pragma("unroll") for (int k = 0; k < 2; ++k) \
        acc[ai][bj][m][n] = __builtin_amdgcn_mfma_f32_16x16x32_bf16(Bt[n][k], At[m][k], acc[ai][bj][m][n], 0, 0, 0); __builtin_amdgcn_s_setprio(0); } while (0)
#define PG8_WAIT_V(n) asm volatile("s_waitcnt vmcnt(" #n ")" ::: "memory")
#define PG8_WAIT_L(n) asm volatile("s_waitcnt lgkmcnt(" #n ")" ::: "memory")
#define PG8_BAR __builtin_amdgcn_s_barrier()
#define PG8_SCHED __builtin_amdgcn_sched_barrier(0)
    Unit cur, nxt; int ui = 0;
    if (!S.next(0, cur)) return;
    f32x4 acc[2][2][4][2];
    float zf; asm volatile("v_mov_b32 %0, 0" : "=v"(zf));
#pragma unroll
    for (int a = 0; a < 2; ++a)
#pragma unroll
        for (int b = 0; b < 2; ++b)
#pragma unroll
            for (int m = 0; m < 4; ++m)
#pragma unroll
                for (int n = 0; n < 2; ++n) acc[a][b][m][n] = (f32x4){zf, zf, zf, zf};
    bf16x8 At[4][2], B0[2][2], B1[2][2];
    const char* cA = (const char*)g.A + (size_t)cur.pm * tsA + (size_t)cur.ka * 2; const char* cB = (const char*)g.Bt + (size_t)cur.pn * tsB + (size_t)cur.ka * 2;
    S.a_ready(cur);
    PG8_STAGE(PG8_SB(0, 0), cB, voffB); PG8_STAGE(PG8_SB(0, 1), cB + hsB, voffB); PG8_STAGE(PG8_SA(0, 0), cA, voffA); PG8_STAGE(PG8_SA(0, 1), cA + hsA, voffA);
    if (wr == 1) PG8_BAR;
    PG8_WAIT_V(2); PG8_BAR;
    PG8_STAGE(PG8_SB(1, 0), cB + kstep, voffB); PG8_STAGE(PG8_SA(1, 0), cA + kstep, voffA); PG8_STAGE(PG8_SB(1, 1), cB + hsB + kstep, voffB);
    PG8_WAIT_V(6); PG8_BAR;
    for (;;) {
        const bool has_next = S.next(ui + 1, nxt);
        const char* nA = has_next ? (const char*)g.A + (size_t)nxt.pm * tsA + (size_t)nxt.ka * 2 : cA; const char* nB = has_next ? (const char*)g.Bt + (size_t)nxt.pn * tsB + (size_t)nxt.ka * 2 : cB;
        for (int t = 0; t < nt; t += 2) {
            const bool last = (t == nt - 2);
            const char* a1 = cA + (size_t)(t + 1) * kstep;
            const char* a2 = last ? nA : cA + (size_t)(t + 2) * kstep; const char* b2 = last ? nB : cB + (size_t)(t + 2) * kstep;
            const char* a3 = a2 + kstep; const char* b3 = b2 + kstep;
            if (last && has_next) S.a_ready(nxt);
            PG8_LDB(B0, 0, 0); PG8_LDB(B1, 0, 1); PG8_SCHED; PG8_LDA(At, 0, 0); PG8_STAGE(PG8_SA(1, 1), a1 + hsA, voffA);
            PG8_WAIT_V(8); PG8_WAIT_L(0); PG8_BAR; PG8_MMA(0, 0, At, B0); PG8_MMA(0, 1, At, B1); PG8_BAR; PG8_SCHED;
            PG8_LDA(At, 0, 1); PG8_STAGE(PG8_SB(0, 0), b2, voffB); PG8_STAGE(PG8_SB(0, 1), b2 + hsB, voffB); PG8_STAGE(PG8_SA(0, 0), a2, voffA);
            PG8_WAIT_V(8); PG8_WAIT_L(0); PG8_BAR; PG8_MMA(1, 0, At, B0); PG8_MMA(1, 1, At, B1); PG8_BAR; PG8_SCHED;
            PG8_LDB(B0, 1, 0); PG8_LDB(B1, 1, 1); PG8_SCHED; PG8_LDA(At, 1, 0); PG8_STAGE(PG8_SA(0, 1), a2 + hsA, voffA);
            PG8_WAIT_V(8); PG8_WAIT_L(0); PG8_BAR; PG8_MMA(0, 0, At, B0); PG8_MMA(0, 1, At, B1); PG8_BAR; PG8_SCHED;
            PG8_LDA(At, 1, 1); PG8_STAGE(PG8_SB(1, 0), b3, voffB); PG8_STAGE(PG8_SB(1, 1), b3 + hsB, voffB); PG8_STAGE(PG8_SA(1, 0), a3, voffA);
            PG8_WAIT_V(8); PG8_WAIT_L(0); PG8_BAR; PG8_MMA(1, 0, At, B0); PG8_MMA(1, 1, At, B1); PG8_BAR; PG8_SCHED;
        }
        if constexpr (ALIGN_EPI) { if (wr == 0) PG8_BAR; }
        E(acc, cur, wr, wc, fr, fq); S.done(cur);
        if (!has_next) break;
        asm volatile("v_mov_b32 %0, 0" : "=v"(zf));
#pragma unroll
        for (int a = 0; a < 2; ++a)
#pragma unroll
            for (int b = 0; b < 2; ++b)
#pragma unroll
                for (int m = 0; m < 4; ++m)
#pragma unroll
                    for (int n = 0; n < 2; ++n) acc[a][b][m][n] = (f32x4){zf, zf, zf, zf};
        cur = nxt; cA = nA; cB = nB; ++ui;
        if constexpr (ALIGN_EPI) { if (wr == 1) PG8_BAR; }
    }
    PG8_WAIT_V(0);
    if constexpr (!ALIGN_EPI) { if (wr == 0) PG8_BAR; }
    PG8_BAR;
#undef PG8_SA
#undef PG8_SB
#undef PG8_STAGE
#undef PG8_LDA
#undef PG8_LDB
#undef PG8_MMA
#undef PG8_WAIT_V
#undef PG8_WAIT_L
#undef PG8_BAR
#undef PG8_SCHED
}
}

namespace att {
using bf16 = unsigned short;
using bf16x8 = __attribute__((ext_vector_type(8))) short;
using s16x4 = __attribute__((ext_vector_type(4))) short;
using f32x16 = __attribute__((ext_vector_type(16))) float;
using u32x4 = __attribute__((ext_vector_type(4))) unsigned;
constexpr int NW = 8, QBLK = 32, KVBLK = 64;
constexpr float THR = 8.f;
#define SBAR() __builtin_amdgcn_sched_barrier(0)
__device__ __forceinline__ int crow(int r, int hi) { return (r & 3) + 8 * (r >> 2) + 4 * hi; }
__device__ __forceinline__ unsigned cvtpk(float lo, float hi) { unsigned r; asm volatile("v_cvt_pk_bf16_f32 %0, %1, %2" : "=v"(r) : "v"(lo), "v"(hi)); return r; }
template <int DQ> __device__ __forceinline__ int kaddr(int row, int c) {
    if constexpr (DQ == 64) return row * 128 + ((c ^ ((row >> 1) & 7)) << 4); else return row * 208 + c * 16; }
template <int DQ> constexpr int ktile_bytes() { return DQ == 64 ? 64 * 128 : 64 * 208; }
constexpr int VTILE = 64 * 64 * 2;
template <int DQ> constexpr int lds_bytes() { return 2 * ktile_bytes<DQ>() + 2 * VTILE + NW * 64 * 4; }

template <bool FIRST> __device__ __forceinline__ void partialSM(f32x16& p0, f32x16& p1, f32x16& nm16, float& alpha) {
    float pmax = p0[0];
#pragma unroll
    for (int r = 1; r < 16; ++r) pmax = fmaxf(pmax, p0[r]);
#pragma unroll
    for (int r = 0; r < 16; ++r) pmax = fmaxf(pmax, p1[r]);
    { auto rr = __builtin_amdgcn_permlane32_swap(__float_as_uint(pmax), __float_as_uint(pmax), false, false);
      pmax = fmaxf(__uint_as_float(rr[0]), __uint_as_float(rr[1])); }
    alpha = 1.f;
    if (FIRST || !__builtin_expect(__all(pmax <= THR), 1)) {
        const float dl = FIRST ? pmax : fmaxf(pmax, 0.f); if (!FIRST) alpha = __builtin_amdgcn_exp2f(-dl);
#pragma unroll
        for (int r = 0; r < 16; ++r) { nm16[r] -= dl; p0[r] -= dl; p1[r] -= dl; } }
#pragma unroll
    for (int r = 0; r < 16; ++r) p0[r] = __builtin_amdgcn_exp2f(p0[r]);
}
__device__ __forceinline__ void finishSM(f32x16& p0, f32x16& p1, float alpha, float& l_reg, bf16x8& pa0, bf16x8& pa1, bf16x8& pa2, bf16x8& pa3) {
#pragma unroll
    for (int r = 0; r < 16; ++r) p1[r] = __builtin_amdgcn_exp2f(p1[r]);
    float ps = 0;
#pragma unroll
    for (int r = 0; r < 16; ++r) ps += p0[r];
#pragma unroll
    for (int r = 0; r < 16; ++r) ps += p1[r];
    { auto rr = __builtin_amdgcn_permlane32_swap(__float_as_uint(ps), __float_as_uint(ps), false, false);
      ps = __uint_as_float(rr[0]) + __uint_as_float(rr[1]); }
    l_reg = l_reg * alpha + ps;
#define PK4(P, BASE, OUT) do { unsigned a0 = cvtpk(P[BASE + 0], P[BASE + 1]), a1 = cvtpk(P[BASE + 2], P[BASE + 3]);   \
    unsigned b0 = cvtpk(P[BASE + 4], P[BASE + 5]), b1 = cvtpk(P[BASE + 6], P[BASE + 7]);                              \
    auto r0 = __builtin_amdgcn_permlane32_swap(a0, b0, false, false); auto r1 = __builtin_amdgcn_permlane32_swap(a1, b1, false, false); \
    u32x4 w = {r0[0], r1[0], r0[1], r1[1]}; OUT = *reinterpret_cast<bf16x8*>(&w); } while (0)
    PK4(p0, 0, pa0); PK4(p0, 8, pa1); PK4(p1, 0, pa2); PK4(p1, 8, pa3);
#undef PK4
}
template <int DQ> __device__ __forceinline__ void qkt(f32x16& p0, f32x16& p1, const char* Ks, const bf16x8* qr, int r32, int hi, const f32x16& nm16) {
    p0 = nm16; p1 = nm16;
#pragma unroll
    for (int d0 = 0; d0 < DQ / 16; ++d0) { const int c = d0 * 2 + hi;
        const bf16x8 b0 = *reinterpret_cast<const bf16x8*>(Ks + kaddr<DQ>(r32, c));
        const bf16x8 b1 = *reinterpret_cast<const bf16x8*>(Ks + kaddr<DQ>(32 + r32, c));
        p0 = __builtin_amdgcn_mfma_f32_32x32x16_bf16(b0, qr[d0], p0, 0, 0, 0);
        p1 = __builtin_amdgcn_mfma_f32_32x32x16_bf16(b1, qr[d0], p1, 0, 0, 0); }
}
__device__ __forceinline__ int v_st(int k, int c) { const int kk = (k & ~0xC) | ((k & 4) << 1) | ((k & 8) >> 1); return ((kk >> 3) * 2 + (c >> 5)) * 512 + ((kk & 7) * 32 + (c & 31)) * 2; }
__device__ __forceinline__ int v_rd_base(int lane) { return ((lane & 3) << 3) | (((lane >> 2) & 3) << 6) | (((lane >> 4) & 1) << 5) | (((lane >> 5) & 1) << 8); }
constexpr int v_rd_off(int d0, int ks, int half) { return d0 * 512 + ks * 2048 + half * 1024; }
template <int OFF> __device__ __forceinline__ s16x4 tr_read(int vb) { s16x4 r; asm volatile("ds_read_b64_tr_b16 %0, %1 offset:%2" : "=&v"(r) : "v"(vb), "i"(OFF) : "memory"); return r; }
template <int D0> __device__ __forceinline__ void pv_one(f32x16& od, int vb, bf16x8 pa0, bf16x8 pa1, bf16x8 pa2, bf16x8 pa3) {
    const s16x4 l0 = tr_read<v_rd_off(D0, 0, 0)>(vb), h0 = tr_read<v_rd_off(D0, 0, 1)>(vb), l1 = tr_read<v_rd_off(D0, 1, 0)>(vb), h1 = tr_read<v_rd_off(D0, 1, 1)>(vb);
    const s16x4 l2 = tr_read<v_rd_off(D0, 2, 0)>(vb), h2 = tr_read<v_rd_off(D0, 2, 1)>(vb), l3 = tr_read<v_rd_off(D0, 3, 0)>(vb), h3 = tr_read<v_rd_off(D0, 3, 1)>(vb);
    asm volatile("s_waitcnt lgkmcnt(0)" ::: "memory"); SBAR();
#define PK(L, H) (bf16x8){L[0], L[1], L[2], L[3], H[0], H[1], H[2], H[3]}
    od = __builtin_amdgcn_mfma_f32_32x32x16_bf16(pa0, PK(l0, h0), od, 0, 0, 0);
    od = __builtin_amdgcn_mfma_f32_32x32x16_bf16(pa1, PK(l1, h1), od, 0, 0, 0);
    od = __builtin_amdgcn_mfma_f32_32x32x16_bf16(pa2, PK(l2, h2), od, 0, 0, 0);
    od = __builtin_amdgcn_mfma_f32_32x32x16_bf16(pa3, PK(l3, h3), od, 0, 0, 0);
#undef PK
}
struct Args { const bf16* Q; int ldq; const bf16* K0; int ldk0; const bf16* K1; int ldk1; const bf16* V; int ldv; bf16* O; int ldo; int nkeys; int rope_t0; const float* tc; const float* ts; };
template <int DQ>
__device__ __forceinline__ void attn_unit(const Args a, char* lds) {
    constexpr int KT = ktile_bytes<DQ>(), NLD = (DQ == 64) ? 2 : 3;
    const int tid = otid(), wid = tid >> 6, lane = tid & 63, r32 = lane & 31, hi = lane >> 5;
    char* V_lds = lds; char* K_lds = lds + 2 * VTILE;
    float* ws = (float*)(lds + 2 * VTILE + 2 * KT) + wid * 64; float* li_l = ws; float* al_l = ws + 32;
    float l_reg = 0; f32x16 o[2] = {}; f32x16 nm16 = {}; bf16x8 qr[DQ / 16];
    const bf16* Qw = a.Q + (long)(wid * QBLK + r32) * a.ldq + hi * 8;
#pragma unroll
    for (int d0 = 0; d0 < DQ / 16; ++d0) qr[d0] = *reinterpret_cast<const bf16x8*>(Qw + d0 * 16);
    if constexpr (DQ == 96) { if (a.rope_t0 >= 0) {
        const int tq = a.rope_t0 + wid * QBLK + r32, pr = (tq >> 6) & 63, pc = tq & 63;
#pragma unroll
        for (int f = 4; f < 6; ++f) { const int pos = (f == 4) ? pr : pc; u32x4 w = *reinterpret_cast<u32x4*>(&qr[f]); u32x4 o;
#pragma unroll
            for (int e = 0; e < 4; ++e) { const unsigned mine = w[e], oth = (unsigned)__shfl_xor((int)mine, 32);
                const float m0 = __uint_as_float(mine << 16), m1 = __uint_as_float(mine & 0xffff0000u), o0 = __uint_as_float(oth << 16), o1 = __uint_as_float(oth & 0xffff0000u);
                const float c0 = a.tc[pos * 8 + 2 * e], c1 = a.tc[pos * 8 + 2 * e + 1], s0 = a.ts[pos * 8 + 2 * e], s1 = a.ts[pos * 8 + 2 * e + 1];
                const float r0 = (hi == 0) ? m0 * c0 - o0 * s0 : o0 * s0 + m0 * c0, r1 = (hi == 0) ? m1 * c1 - o1 * s1 : o1 * s1 + m1 * c1;
                o[e] = cvtpk(r0, r1); }
            qr[f] = *reinterpret_cast<bf16x8*>(&o); } } }
    const int vrow = tid >> 3, vcol = (tid & 7) * 8, vst = v_st(vrow, vcol);
    const bf16* vsrc = a.V + (long)vrow * a.ldv + vcol; const long vstep = (long)KVBLK * a.ldv;
    int kr0, kc0, kr1 = 0, kc1 = 0;
    if constexpr (DQ == 64) { kr0 = tid >> 3; kc0 = tid & 7; } else { kr0 = tid / 12; kc0 = tid % 12; const int id1 = 512 + (tid & 255); kr1 = id1 / 12; kc1 = id1 % 12; }
    const bf16* ksrc0 = (kc0 < 8) ? a.K0 + (long)kr0 * a.ldk0 + kc0 * 8 : a.K1 + (long)kr0 * a.ldk1 + (kc0 - 8) * 8; const long kstep0 = (long)KVBLK * ((kc0 < 8) ? a.ldk0 : a.ldk1);
    const bf16* ksrc1 = ksrc0; long kstep1 = kstep0;
    if constexpr (DQ == 96) { ksrc1 = (kc1 < 8) ? a.K0 + (long)kr1 * a.ldk0 + kc1 * 8 : a.K1 + (long)kr1 * a.ldk1 + (kc1 - 8) * 8; kstep1 = (long)KVBLK * ((kc1 < 8) ? a.ldk0 : a.ldk1); }
    const int kst0 = kaddr<DQ>(kr0, kc0), kst1 = kaddr<DQ>(kr1, kc1);
    const int vb0 = (int)(uintptr_t)V_lds + v_rd_base(lane);
    struct { bf16x8 vs, ks0, ks1; } sr_[2];
#define SLOAD(i, t) do { sr_[i].vs = *reinterpret_cast<const bf16x8*>(vsrc + (long)(t) * vstep); sr_[i].ks0 = *reinterpret_cast<const bf16x8*>(ksrc0 + (long)(t) * kstep0); \
    if constexpr (DQ == 96) sr_[i].ks1 = *reinterpret_cast<const bf16x8*>(ksrc1 + (long)(t) * kstep1); } while (0)
#define SWRITE(b, i) do { *(bf16x8*)(V_lds + (b) * VTILE + vst) = sr_[i].vs; *(bf16x8*)(K_lds + (b) * KT + kst0) = sr_[i].ks0; \
    if constexpr (DQ == 96) *(bf16x8*)(K_lds + (b) * KT + kst1) = sr_[i].ks1; } while (0)
#define SWAIT() do { if constexpr (NLD == 2) asm volatile("s_waitcnt vmcnt(2)" ::: "memory"); else asm volatile("s_waitcnt vmcnt(3)" ::: "memory"); } while (0)
#define RESC(al) do { if (__any((al) < 1.f)) { if (hi == 0) al_l[r32] = (al); asm volatile("s_waitcnt lgkmcnt(0)" ::: "memory"); \
    _Pragma("unroll") for (int d = 0; d < 2; ++d) _Pragma("unroll") for (int r = 0; r < 16; ++r) o[d][r] *= al_l[crow(r, hi)]; } } while (0)
    f32x16 pA0, pA1, pB0, pB1; float alA, alB; bf16x8 pa0, pa1, pa2, pa3; const int NT = a.nkeys / KVBLK;
    constexpr int SE = 0, SO = 1;
    SLOAD(SE, 0); asm volatile("s_waitcnt vmcnt(0)" ::: "memory"); SWRITE(0, SE); __syncthreads();
    qkt<DQ>(pA0, pA1, K_lds, qr, r32, hi, nm16); partialSM<true>(pA0, pA1, nm16, alA);
    SLOAD(SO, 1); if (2 < NT) SLOAD(SE, 2);
    SWAIT(); SWRITE(1, SO); __syncthreads();
    for (int j = 1; j + 1 < NT; j += 2) {
        SBAR(); qkt<DQ>(pB0, pB1, K_lds + KT, qr, r32, hi, nm16);
        finishSM(pA0, pA1, alA, l_reg, pa0, pa1, pa2, pa3); SBAR();
        SLOAD(SO, j + 2); SBAR();
        pv_one<0>(o[0], vb0, pa0, pa1, pa2, pa3); pv_one<1>(o[1], vb0, pa0, pa1, pa2, pa3); partialSM<false>(pB0, pB1, nm16, alB);
        __syncthreads(); SWAIT(); SWRITE(0, SE);
        RESC(alB); __syncthreads();
        SBAR(); qkt<DQ>(pA0, pA1, K_lds, qr, r32, hi, nm16);
        finishSM(pB0, pB1, alB, l_reg, pa0, pa1, pa2, pa3); SBAR();
        if (j + 3 < NT) SLOAD(SE, j + 3); SBAR();
        pv_one<0>(o[0], vb0 + VTILE, pa0, pa1, pa2, pa3); pv_one<1>(o[1], vb0 + VTILE, pa0, pa1, pa2, pa3); partialSM<false>(pA0, pA1, nm16, alA);
        __syncthreads(); SWAIT(); SWRITE(1, SO);
        RESC(alA); __syncthreads();
    }
    SBAR(); qkt<DQ>(pB0, pB1, K_lds + KT, qr, r32, hi, nm16);
    finishSM(pA0, pA1, alA, l_reg, pa0, pa1, pa2, pa3); SBAR();
    pv_one<0>(o[0], vb0, pa0, pa1, pa2, pa3); pv_one<1>(o[1], vb0, pa0, pa1, pa2, pa3); partialSM<false>(pB0, pB1, nm16, alB);
    __syncthreads(); RESC(alB);
    finishSM(pB0, pB1, alB, l_reg, pa0, pa1, pa2, pa3); SBAR();
    pv_one<0>(o[0], vb0 + VTILE, pa0, pa1, pa2, pa3); pv_one<1>(o[1], vb0 + VTILE, pa0, pa1, pa2, pa3);
    if (hi == 0) li_l[r32] = l_reg; asm volatile("s_waitcnt lgkmcnt(0)" ::: "memory");
    float rli[16];
#pragma unroll
    for (int r = 0; r < 16; ++r) rli[r] = __builtin_amdgcn_rcpf(li_l[crow(r, hi)]);
    __syncthreads();
    { unsigned short* stg = (unsigned short*)(lds) + wid * 2048;
#pragma unroll
      for (int r = 0; r < 16; ++r) { const int orow = crow(r, hi);
#pragma unroll
        for (int d0 = 0; d0 < 2; ++d0) { const float v = o[d0][r] * rli[r]; const unsigned u = __float_as_uint(v); stg[orow * 64 + d0 * 32 + r32] = (unsigned short)((u + 0x7fffu + ((u >> 16) & 1u)) >> 16); } }
      asm volatile("s_waitcnt lgkmcnt(0)" ::: "memory");
      bf16* Ow = a.O + (long)(wid * QBLK) * a.ldo;
#pragma unroll
      for (int i = 0; i < 4; ++i) { const int row = i * 8 + (lane >> 3), ch = lane & 7; const u32x4 v = *(const u32x4*)(stg + row * 64 + ch * 8); *(u32x4*)(Ow + (long)row * a.ldo + ch * 8) = v; } }
    __syncthreads();
#undef SLOAD
#undef SWRITE
#undef SWAIT
#undef RESC
}
#undef SBAR
}

namespace at64 {
using att::bf16; using att::bf16x8; using att::s16x4; using att::f32x16; using att::u32x4;
constexpr int NW = 8, QBLK = 32, KVBLK = 64;
constexpr float C2 = 0.125f * 1.4426950408889634f;
constexpr float THR = 8.f;
constexpr int SLOTB = 8192, LDS_K = 0, LDS_V = 3 * SLOTB, LDS_WS = 6 * SLOTB, LDS_OST = LDS_WS + NW * 256, LDS_TOT = LDS_OST + NW * 4096;
#define A6_SBAR() __builtin_amdgcn_sched_barrier(0)
#define A6_PIN(x) asm volatile("" : "+v"(x))
#define A6_MFMA(a, b, c) __builtin_amdgcn_mfma_f32_32x32x16_bf16(a, b, c, 0, 0, 0)
#define A6_WAIT_BAR(N) asm volatile("s_waitcnt vmcnt(" #N ") lgkmcnt(0)\n\ts_barrier" ::: "memory")
__device__ __forceinline__ int crow(int r, int hi) { return (r & 3) + 8 * (r >> 2) + 4 * hi; }
__device__ __forceinline__ unsigned cvtpk(float lo, float hi) { unsigned r; asm("v_cvt_pk_bf16_f32 %0, %1, %2" : "=v"(r) : "v"(lo), "v"(hi)); return r; }
__device__ __forceinline__ void glds16(const void* g, unsigned lds_base) {
    unsigned sv; asm volatile("s_mov_b32 %0, m0\n\ts_mov_b32 m0, %2\n\ts_nop 0\n\tglobal_load_lds_dwordx4 %1, off\n\ts_mov_b32 m0, %0" : "=&s"(sv) : "v"(g), "s"(lds_base) : "memory"); }
typedef __attribute__((address_space(3))) const char* lds_cptr;
typedef short v4i16_t __attribute__((ext_vector_type(4)));
__device__ __forceinline__ void kload2(bf16x8* kf, lds_cptr kp, int d0) { kf[2 * d0] = *(const __attribute__((address_space(3))) bf16x8*)(kp + d0 * 2048); kf[2 * d0 + 1] = *(const __attribute__((address_space(3))) bf16x8*)(kp + d0 * 2048 + 512); }
__device__ __forceinline__ s16x4 vtr(lds_cptr p) { return __builtin_bit_cast(s16x4, __builtin_amdgcn_ds_read_tr16_b64_v4i16((__attribute__((address_space(3))) v4i16_t*)p)); }
#define A6_MX3(a, b, c) __builtin_fmaxf(__builtin_fmaxf((a), (b)), (c))
__device__ __forceinline__ float rowmax(const f32x16& p0, const f32x16& p1) {
    float a = A6_MX3(p0[0], p0[1], p1[0]), b = A6_MX3(p0[2], p0[3], p1[1]); a = A6_MX3(a, p1[2], p1[3]);
#pragma unroll
    for (int r = 4; r < 16; r += 4) { a = A6_MX3(a, p0[r], p0[r + 1]); b = A6_MX3(b, p0[r + 2], p0[r + 3]); a = A6_MX3(a, p1[r], p1[r + 1]); b = A6_MX3(b, p1[r + 2], p1[r + 3]); }
    float m = __builtin_fmaxf(a, b); auto rr = __builtin_amdgcn_permlane32_swap(__float_as_uint(m), __float_as_uint(m), false, false);
    return __builtin_fmaxf(__uint_as_float(rr[0]), __uint_as_float(rr[1])); }
struct Args { const bf16* Q; int ldq; const bf16* K; int ldk; const bf16* V; int ldv; bf16* O; int ldo; int nkeys; };
__device__ __forceinline__ void unit(const Args a, char* lds) {
    const int tid = otid(), lane = tid & 63, r32 = lane & 31, hi = lane >> 5; const int wid = __builtin_amdgcn_readfirstlane(tid >> 6);
    const int NT = a.nkeys / KVBLK;
    const bf16* Qw = a.Q + (long)(wid * QBLK) * a.ldq;
    const unsigned lds0 = (unsigned)(uintptr_t)lds; float* wsf = (float*)(lds + LDS_WS) + wid * 64;
    const bf16* ksrc = a.K + (long)lane * a.ldk + wid * 8; const long kstep = (long)KVBLK * a.ldk;
    const bf16* vsrc = a.V + (long)(16 * (wid & 3) + (lane >> 2)) * a.ldv + (wid >> 2) * 32 + (lane & 3) * 8; const long vstep = (long)KVBLK * a.ldv;
    const unsigned kdst = lds0 + LDS_K + wid * 1024, vdst = lds0 + LDS_V + wid * 1024;
#define DMA_K(t, slot) glds16(ksrc + (long)(t) * kstep, (unsigned)__builtin_amdgcn_readfirstlane(kdst + (slot)))
#define DMA_V(t, slot) glds16(vsrc + (long)(t) * vstep, (unsigned)__builtin_amdgcn_readfirstlane(vdst + (slot)))
    const lds_cptr vp0 = (lds_cptr)lds + LDS_V + ((lane >> 4) & 1) * 32 + (lane & 3) * 8 + (4 * hi + ((lane & 15) >> 2)) * 64;
    const lds_cptr kp0 = (lds_cptr)lds + LDS_K + hi * 1024 + r32 * 16;
    DMA_K(0, 0); DMA_V(0, 0); DMA_K(1, SLOTB);
    bf16x8 qr[4];
#pragma unroll
    for (int d0 = 0; d0 < 4; ++d0) qr[d0] = *reinterpret_cast<const bf16x8*>(&Qw[(long)r32 * a.ldq + d0 * 16 + hi * 8]);
    float l_reg = 0.f; f32x16 o[2]; o[0] = f32x16{}; o[1] = f32x16{};
    f32x16 nmh16 = f32x16{}; A6_PIN(nmh16);
    bool resc = false;
    f32x16 pA0, pA1, pB0, pB1; bf16x8 kf[8]; s16x4 vlo[8], vhi[8]; u32x4 pw0, pw1, pw2, pw3;
    int sl_prev = 0, sl_cur = 0, sl_next = SLOTB;
#define ROT() do { sl_prev = sl_cur; sl_cur = sl_next; sl_next = (sl_next == 2 * SLOTB) ? 0 : sl_next + SLOTB; } while (0)
#define EX(v) __builtin_amdgcn_exp2f(v)
#define RESC() do { if (resc) { _Pragma("unroll") for (int d_ = 0; d_ < 2; ++d_) _Pragma("unroll") for (int r = 0; r < 16; ++r) o[d_][r] *= wsf[crow(r, hi)]; } } while (0)
    DMA_K(2, 2 * SLOTB);
    A6_WAIT_BAR(3);
    _Pragma("unroll") for (int d0 = 0; d0 < 4; ++d0) kload2(kf, kp0, d0);
    pA0 = A6_MFMA(kf[0], qr[0], nmh16); pA1 = A6_MFMA(kf[1], qr[0], nmh16); pA0 = A6_MFMA(kf[2], qr[1], pA0); pA1 = A6_MFMA(kf[3], qr[1], pA1);
    pA0 = A6_MFMA(kf[4], qr[2], pA0); pA1 = A6_MFMA(kf[5], qr[2], pA1); pA0 = A6_MFMA(kf[6], qr[3], pA0); pA1 = A6_MFMA(kf[7], qr[3], pA1);
    { const float rm = rowmax(pA0, pA1);
#pragma unroll
      for (int r = 0; r < 16; ++r) { nmh16[r] = -rm; pA0[r] = EX(pA0[r] - rm); pA1[r] = EX(pA1[r] - rm); } }
    A6_WAIT_BAR(0);
    DMA_K(3, 0); DMA_V(1, SLOTB); ROT();
    _Pragma("unroll") for (int d0 = 0; d0 < 4; ++d0) kload2(kf, kp0 + sl_cur, d0);
    A6_WAIT_BAR(2);
#define PKW(P, i) cvtpk(P[i], P[i + 1])
#define PAF(k) __builtin_bit_cast(bf16x8, pw##k)
#define VFR(i) (bf16x8){vlo[i][0], vlo[i][1], vlo[i][2], vlo[i][3], vhi[i][0], vhi[i][1], vhi[i][2], vhi[i][3]}
#define VRD(i) do { vlo[i] = vtr(vp_ + (((i) >> 2) * 4096 + ((i) & 3) * 1024)); vhi[i] = vtr(vp_ + (((i) >> 2) * 4096 + ((i) & 3) * 1024 + 512)); } while (0)
#define KRD(G, d0) do { if (G) { kload2(kf, kp0 + sl_next, d0); A6_SBAR(); } } while (0)
#define GAPA(MF, a0, a1, a2, a3, W0, W1, PW) do { MF; sacc += a0; sacc += a1; sacc += a2; sacc += a3; W0; W1; A6_PIN(PW); A6_PIN(sacc); A6_SBAR(); } while (0)
#define GAPB(MF, X, i) do { MF; X[i] = EX(X[i]); X[i + 1] = EX(X[i + 1]); X[i + 2] = EX(X[i + 2]); X[i + 3] = EX(X[i + 3]); A6_PIN(X); A6_SBAR(); } while (0)
#define STEP(C0, C1, P0, P1, t, GK, GV, GL) do { A6_SBAR(); \
    const lds_cptr vp_ = vp0 + sl_prev; \
    VRD(0); A6_SBAR(); float sacc = P0[0] + P0[1]; \
                       GAPA(C0 = A6_MFMA(kf[0], qr[0], nmh16), P0[2], P0[3], P0[4], P0[5],     pw0[0] = PKW(P0, 0),  pw0[1] = PKW(P0, 2),  pw0); \
    VRD(4); A6_SBAR(); GAPA(C1 = A6_MFMA(kf[1], qr[0], nmh16), P0[6], P0[7], P0[8], P0[9],     pw0[2] = PKW(P0, 4),  pw0[3] = PKW(P0, 6),  pw0); \
    VRD(1); A6_SBAR(); GAPA(C0 = A6_MFMA(kf[2], qr[1], C0),    P0[10], P0[11], P0[12], P0[13], pw1[0] = PKW(P0, 8),  pw1[1] = PKW(P0, 10), pw1); \
    VRD(5); A6_SBAR(); GAPA(C1 = A6_MFMA(kf[3], qr[1], C1),    P0[14], P0[15], P1[0], P1[1],   pw1[2] = PKW(P0, 12), pw1[3] = PKW(P0, 14), pw1); \
    VRD(2); A6_SBAR(); GAPA(C0 = A6_MFMA(kf[4], qr[2], C0),    P1[2], P1[3], P1[4], P1[5],     pw2[0] = PKW(P1, 0),  pw2[1] = PKW(P1, 2),  pw2); \
    VRD(6); A6_SBAR(); GAPA(C1 = A6_MFMA(kf[5], qr[2], C1),    P1[6], P1[7], P1[8], P1[9],     pw2[2] = PKW(P1, 4),  pw2[3] = PKW(P1, 6),  pw2); \
    VRD(3); A6_SBAR(); GAPA(C0 = A6_MFMA(kf[6], qr[3], C0),    P1[10], P1[11], P1[12], P1[13], pw3[0] = PKW(P1, 8),  pw3[1] = PKW(P1, 10), pw3); \
    VRD(7); A6_SBAR(); GAPA(C1 = A6_MFMA(kf[7], qr[3], C1),    P1[14], P1[15], 0.f, 0.f,       pw3[2] = PKW(P1, 12), pw3[3] = PKW(P1, 14), pw3); \
    l_reg += sacc; \
    if (GK) DMA_K((t) + 3, sl_cur); if (GV) DMA_V((t) + 1, sl_next); \
    { const float rm = rowmax(C0, C1); resc = false; \
      if (__builtin_expect(__any(rm > THR), 0)) { const float dl = __builtin_fmaxf(rm, 0.f); \
          _Pragma("unroll") for (int r_ = 0; r_ < 16; ++r_) { nmh16[r_] -= dl; C0[r_] -= dl; C1[r_] -= dl; } \
          const float f = __builtin_amdgcn_exp2f(-dl); l_reg *= f; if (hi == 0) wsf[r32] = f; resc = true; } } \
    A6_SBAR(); \
    GAPB(o[0] = A6_MFMA(PAF(0), VFR(0), o[0]), C0, 0);              GAPB(o[1] = A6_MFMA(PAF(0), VFR(4), o[1]), C0, 4); \
    KRD(GL, 0); GAPB(o[0] = A6_MFMA(PAF(1), VFR(1), o[0]), C0, 8);  KRD(GL, 1); GAPB(o[1] = A6_MFMA(PAF(1), VFR(5), o[1]), C0, 12); \
    KRD(GL, 2); GAPB(o[0] = A6_MFMA(PAF(2), VFR(2), o[0]), C1, 0);  KRD(GL, 3); GAPB(o[1] = A6_MFMA(PAF(2), VFR(6), o[1]), C1, 4); \
    GAPB(o[0] = A6_MFMA(PAF(3), VFR(3), o[0]), C1, 8);              GAPB(o[1] = A6_MFMA(PAF(3), VFR(7), o[1]), C1, 12); \
    } while (0)
    int t = 1;
    for (; t + 5 < NT; t += 2) {
        STEP(pB0, pB1, pA0, pA1, t, true, true, true);     A6_WAIT_BAR(2); RESC(); ROT();
        STEP(pA0, pA1, pB0, pB1, t + 1, true, true, true); A6_WAIT_BAR(2); RESC(); ROT();
    }
#define ENDW(tt) do { if ((tt) + 3 < NT) { A6_WAIT_BAR(2); } else if ((tt) + 2 < NT) { A6_WAIT_BAR(1); } else { A6_WAIT_BAR(0); } } while (0)
    for (; t + 1 < NT; t += 2) {
        STEP(pB0, pB1, pA0, pA1, t, (t + 3 < NT), (t + 1 < NT), (t + 1 < NT));         ENDW(t);     RESC(); ROT();
        STEP(pA0, pA1, pB0, pB1, t + 1, (t + 4 < NT), (t + 2 < NT), (t + 2 < NT));     ENDW(t + 1); RESC(); ROT();
    }
    STEP(pB0, pB1, pA0, pA1, NT - 1, false, false, false); RESC();
    { float sacc = pB0[0] + pB0[1];
#pragma unroll
      for (int r = 2; r < 16; ++r) sacc += pB0[r];
#pragma unroll
      for (int r = 0; r < 16; ++r) sacc += pB1[r];
      l_reg += sacc;
      pw0 = (u32x4){PKW(pB0, 0), PKW(pB0, 2), PKW(pB0, 4), PKW(pB0, 6)}; pw1 = (u32x4){PKW(pB0, 8), PKW(pB0, 10), PKW(pB0, 12), PKW(pB0, 14)};
      pw2 = (u32x4){PKW(pB1, 0), PKW(pB1, 2), PKW(pB1, 4), PKW(pB1, 6)}; pw3 = (u32x4){PKW(pB1, 8), PKW(pB1, 10), PKW(pB1, 12), PKW(pB1, 14)};
      const lds_cptr vp_ = vp0 + sl_cur; _Pragma("unroll") for (int i = 0; i < 8; ++i) VRD(i);
      o[0] = A6_MFMA(PAF(0), VFR(0), o[0]); o[1] = A6_MFMA(PAF(0), VFR(4), o[1]); o[0] = A6_MFMA(PAF(1), VFR(1), o[0]); o[1] = A6_MFMA(PAF(1), VFR(5), o[1]);
      o[0] = A6_MFMA(PAF(2), VFR(2), o[0]); o[1] = A6_MFMA(PAF(2), VFR(6), o[1]); o[0] = A6_MFMA(PAF(3), VFR(3), o[0]); o[1] = A6_MFMA(PAF(3), VFR(7), o[1]); }
    { auto rr = __builtin_amdgcn_permlane32_swap(__float_as_uint(l_reg), __float_as_uint(l_reg), false, false); l_reg = __uint_as_float(rr[0]) + __uint_as_float(rr[1]); }
    if (hi == 0) wsf[32 + r32] = l_reg; asm volatile("s_waitcnt lgkmcnt(0)" ::: "memory");
    float rli[16];
#pragma unroll
    for (int r = 0; r < 16; ++r) rli[r] = __builtin_amdgcn_rcpf(wsf[32 + crow(r, hi)]);
    bf16* Ow = a.O + (long)(wid * QBLK) * a.ldo; unsigned short* stg = (unsigned short*)(lds + LDS_OST) + wid * 2048;
#pragma unroll
    for (int r = 0; r < 16; ++r) { const int orow = crow(r, hi);
#pragma unroll
        for (int d0 = 0; d0 < 2; ++d0) { const float v = o[d0][r] * rli[r]; const unsigned u = __float_as_uint(v); stg[orow * 64 + d0 * 32 + r32] = (unsigned short)((u + 0x7fffu + ((u >> 16) & 1u)) >> 16); } }
    asm volatile("s_waitcnt lgkmcnt(0)" ::: "memory");
#pragma unroll
    for (int i = 0; i < 4; ++i) { const int row = i * 8 + (lane >> 3), ch = lane & 7; *(u32x4*)(Ow + (long)row * a.ldo + ch * 8) = *(const u32x4*)(stg + row * 64 + ch * 8); }
    asm volatile("s_waitcnt lgkmcnt(0)\n\ts_barrier" ::: "memory");
#undef DMA_K
#undef DMA_V
#undef ROT
#undef EX
#undef RESC
#undef PKW
#undef PAF
#undef VFR
#undef VRD
#undef KRD
#undef ENDW
#undef GAPA
#undef GAPB
#undef STEP
}
#undef A6_SBAR
#undef A6_PIN
#undef A6_MFMA
#undef A6_WAIT_BAR
#undef A6_MX3
}

namespace at96 {
using att::bf16; using att::bf16x8; using att::s16x4; using att::f32x16; using att::u32x4;
using at64::crow; using at64::cvtpk; using at64::glds16; using at64::lds_cptr; using at64::kload2; using at64::vtr; using at64::rowmax;
constexpr int NW = 8, QBLK = 32, KVBLK = 64;
constexpr float THR = 8.f;
constexpr int SLOTB = 8192, SLOTR = 4096, LDS_K = 0, LDS_V = 3 * SLOTB, LDS_R = 6 * SLOTB, LDS_WS = LDS_R + 4 * SLOTR, LDS_OST = LDS_WS + NW * 256, LDS_TOT = LDS_OST + NW * 4096;
#define A9_SBAR() __builtin_amdgcn_sched_barrier(0)
#define A9_PIN(x) asm volatile("" : "+v"(x))
#define A9_MFMA(a, b, c) __builtin_amdgcn_mfma_f32_32x32x16_bf16(a, b, c, 0, 0, 0)
#define A9_WAIT_BAR(N) asm volatile("s_waitcnt vmcnt(" #N ") lgkmcnt(0)\n\ts_barrier" ::: "memory")
struct Args { const bf16* Q; int ldq; const bf16* K0; int ldk0; const bf16* K1; int ldk1; const bf16* V; int ldv; bf16* O; int ldo; int nkeys; int rope_t0; const float* tc; const float* ts; };
__device__ __forceinline__ void unit(const Args a, char* lds) {
    const int tid = otid(), lane = tid & 63, r32 = lane & 31, hi = lane >> 5; const int wid = __builtin_amdgcn_readfirstlane(tid >> 6);
    const int NT = a.nkeys / KVBLK;
    const bf16* Qw = a.Q + (long)(wid * QBLK) * a.ldq;
    const unsigned lds0 = (unsigned)(uintptr_t)lds; float* wsf = (float*)(lds + LDS_WS) + wid * 64;
    const bf16* ksrc = a.K0 + (long)lane * a.ldk0 + wid * 8; const long kstep = (long)KVBLK * a.ldk0;
    const bf16* rsrc = a.K1 + (long)(32 * (wid & 1) + r32) * a.ldk1 + (wid >> 1) * 8; const long rstep = (long)KVBLK * a.ldk1;
    const bf16* vsrc = a.V + (long)(16 * (wid & 3) + (lane >> 2)) * a.ldv + (wid >> 2) * 32 + (lane & 3) * 8; const long vstep = (long)KVBLK * a.ldv;
    const unsigned kdst = lds0 + LDS_K + wid * 1024, vdst = lds0 + LDS_V + wid * 1024, rdst = lds0 + LDS_R + (wid >> 1) * 1024 + (wid & 1) * 512;
#define DMA_K(t, slot, rslot) do { glds16(ksrc + (long)(t) * kstep, (unsigned)__builtin_amdgcn_readfirstlane(kdst + (slot))); \
        if (lane < 32) glds16(rsrc + (long)(t) * rstep, (unsigned)__builtin_amdgcn_readfirstlane(rdst + (rslot))); } while (0)
#define DMA_V(t, slot) glds16(vsrc + (long)(t) * vstep, (unsigned)__builtin_amdgcn_readfirstlane(vdst + (slot)))
    const lds_cptr vp0 = (lds_cptr)lds + LDS_V + ((lane >> 4) & 1) * 32 + (lane & 3) * 8 + (4 * hi + ((lane & 15) >> 2)) * 64;
    const lds_cptr kp0 = (lds_cptr)lds + LDS_K + hi * 1024 + r32 * 16;
    const lds_cptr rp0 = (lds_cptr)lds + LDS_R + hi * 1024 + r32 * 16;
    DMA_K(0, 0, 0); DMA_V(0, 0); DMA_K(1, SLOTB, SLOTR);
    bf16x8 qr[6];
#pragma unroll
    for (int d0 = 0; d0 < 6; ++d0) qr[d0] = *reinterpret_cast<const bf16x8*>(&Qw[(long)r32 * a.ldq + d0 * 16 + hi * 8]);
    if (a.rope_t0 >= 0) {
        const int tq = a.rope_t0 + wid * QBLK + r32, pr = (tq >> 6) & 63, pc = tq & 63;
#pragma unroll
        for (int f = 4; f < 6; ++f) { const int pos = (f == 4) ? pr : pc; u32x4 w = *reinterpret_cast<u32x4*>(&qr[f]); u32x4 o_;
#pragma unroll
            for (int e = 0; e < 4; ++e) { const unsigned mine = w[e], oth = (unsigned)__shfl_xor((int)mine, 32);
                const float m0 = __uint_as_float(mine << 16), m1 = __uint_as_float(mine & 0xffff0000u), o0 = __uint_as_float(oth << 16), o1 = __uint_as_float(oth & 0xffff0000u);
                const float c0 = a.tc[pos * 8 + 2 * e], c1 = a.tc[pos * 8 + 2 * e + 1], s0 = a.ts[pos * 8 + 2 * e], s1 = a.ts[pos * 8 + 2 * e + 1];
                const float r0 = (hi == 0) ? m0 * c0 - o0 * s0 : o0 * s0 + m0 * c0, r1 = (hi == 0) ? m1 * c1 - o1 * s1 : o1 * s1 + m1 * c1;
                o_[e] = cvtpk(r0, r1); }
            qr[f] = *reinterpret_cast<bf16x8*>(&o_); } }
    float l_reg = 0.f; f32x16 o[2]; o[0] = f32x16{}; o[1] = f32x16{};
    f32x16 nmh16 = f32x16{}; A9_PIN(nmh16);
    bool resc = false;
    f32x16 pA0, pA1, pB0, pB1; bf16x8 kf[8], kr[4]; s16x4 vlo[8], vhi[8]; u32x4 pw0, pw1, pw2, pw3;
    int sl_prev = 0, sl_cur = 0, sl_next = SLOTB, rs_cur = 0;
#define ROT() do { sl_prev = sl_cur; sl_cur = sl_next; sl_next = (sl_next == 2 * SLOTB) ? 0 : sl_next + SLOTB; rs_cur = (rs_cur + SLOTR) & (4 * SLOTR - 1); } while (0)
#define RS3() ((rs_cur + 3 * SLOTR) & (4 * SLOTR - 1))
#define EX(v) __builtin_amdgcn_exp2f(v)
#define RESC() do { if (resc) { _Pragma("unroll") for (int d_ = 0; d_ < 2; ++d_) _Pragma("unroll") for (int r = 0; r < 16; ++r) o[d_][r] *= wsf[crow(r, hi)]; } } while (0)
    DMA_K(2, 2 * SLOTB, 2 * SLOTR);
    A9_WAIT_BAR(5);
    _Pragma("unroll") for (int d0 = 0; d0 < 4; ++d0) kload2(kf, kp0, d0);
    kload2(kr, rp0, 0); kload2(kr, rp0, 1);
    pA0 = A9_MFMA(kf[0], qr[0], nmh16); pA1 = A9_MFMA(kf[1], qr[0], nmh16); pA0 = A9_MFMA(kf[2], qr[1], pA0); pA1 = A9_MFMA(kf[3], qr[1], pA1);
    pA0 = A9_MFMA(kf[4], qr[2], pA0); pA1 = A9_MFMA(kf[5], qr[2], pA1); pA0 = A9_MFMA(kf[6], qr[3], pA0); pA1 = A9_MFMA(kf[7], qr[3], pA1);
    pA0 = A9_MFMA(kr[0], qr[4], pA0); pA1 = A9_MFMA(kr[1], qr[4], pA1); pA0 = A9_MFMA(kr[2], qr[5], pA0); pA1 = A9_MFMA(kr[3], qr[5], pA1);
    { const float rm = rowmax(pA0, pA1);
#pragma unroll
      for (int r = 0; r < 16; ++r) { nmh16[r] = -rm; pA0[r] = EX(pA0[r] - rm); pA1[r] = EX(pA1[r] - rm); } }
    A9_WAIT_BAR(0);
    DMA_K(3, 0, 3 * SLOTR); DMA_V(1, SLOTB); ROT();
    _Pragma("unroll") for (int d0 = 0; d0 < 4; ++d0) kload2(kf, kp0 + sl_cur, d0);
    A9_WAIT_BAR(3);
#define PKW(P, i) cvtpk(P[i], P[i + 1])
#define PAF(k) __builtin_bit_cast(bf16x8, pw##k)
#define VFR(i) (bf16x8){vlo[i][0], vlo[i][1], vlo[i][2], vlo[i][3], vhi[i][0], vhi[i][1], vhi[i][2], vhi[i][3]}
#define VRD(i) do { vlo[i] = vtr(vp_ + (((i) >> 2) * 4096 + ((i) & 3) * 1024)); vhi[i] = vtr(vp_ + (((i) >> 2) * 4096 + ((i) & 3) * 1024 + 512)); } while (0)
#define KRD(G, d0) do { if (G) { kload2(kf, kp0 + sl_next, d0); A9_SBAR(); } } while (0)
#define GAP3(MF, a0, a1, a2, W0, PW) do { MF; sacc += a0; sacc += a1; sacc += a2; W0; A9_PIN(PW); A9_PIN(sacc); A9_SBAR(); } while (0)
#define GAP2(MF, a0, a1, W0, W1, PW) do { MF; sacc += a0; sacc += a1; W0; W1; A9_PIN(PW); A9_PIN(sacc); A9_SBAR(); } while (0)
#define GAPB(MF, X, i) do { MF; X[i] = EX(X[i]); X[i + 1] = EX(X[i + 1]); X[i + 2] = EX(X[i + 2]); X[i + 3] = EX(X[i + 3]); A9_PIN(X); A9_SBAR(); } while (0)
#define STEP(C0, C1, P0, P1, t, GK, GV, GL) do { A9_SBAR(); \
    const lds_cptr vp_ = vp0 + sl_prev; const lds_cptr rp_ = rp0 + rs_cur; \
    VRD(0); kload2(kr, rp_, 0); A9_SBAR(); float sacc = P0[0] + P0[1]; \
                       GAP3(C0 = A9_MFMA(kf[0], qr[0], nmh16), P0[2], P0[3], P0[4],    pw0[0] = PKW(P0, 0), pw0); \
    VRD(4); kload2(kr, rp_, 1); A9_SBAR(); \
                       GAP3(C1 = A9_MFMA(kf[1], qr[0], nmh16), P0[5], P0[6], P0[7],    pw0[1] = PKW(P0, 2), pw0); \
    VRD(1); A9_SBAR(); GAP2(C0 = A9_MFMA(kf[2], qr[1], C0),    P0[8], P0[9],           pw0[2] = PKW(P0, 4), pw0[3] = PKW(P0, 6), pw0); \
    VRD(5); A9_SBAR(); GAP3(C1 = A9_MFMA(kf[3], qr[1], C1),    P0[10], P0[11], P0[12], pw1[0] = PKW(P0, 8), pw1); \
    VRD(2); A9_SBAR(); GAP3(C0 = A9_MFMA(kf[4], qr[2], C0),    P0[13], P0[14], P0[15], pw1[1] = PKW(P0, 10), pw1); \
    VRD(6); A9_SBAR(); GAP2(C1 = A9_MFMA(kf[5], qr[2], C1),    P1[0], P1[1],           pw1[2] = PKW(P0, 12), pw1[3] = PKW(P0, 14), pw1); \
    VRD(3); A9_SBAR(); GAP3(C0 = A9_MFMA(kf[6], qr[3], C0),    P1[2], P1[3], P1[4],    pw2[0] = PKW(P1, 0), pw2); \
    VRD(7); A9_SBAR(); GAP3(C1 = A9_MFMA(kf[7], qr[3], C1),    P1[5], P1[6], P1[7],    pw2[1] = PKW(P1, 2), pw2); \
                       GAP2(C0 = A9_MFMA(kr[0], qr[4], C0),    P1[8], P1[9],           pw2[2] = PKW(P1, 4), pw2[3] = PKW(P1, 6), pw2); \
                       GAP3(C1 = A9_MFMA(kr[1], qr[4], C1),    P1[10], P1[11], P1[12], pw3[0] = PKW(P1, 8), pw3); \
                       GAP3(C0 = A9_MFMA(kr[2], qr[5], C0),    P1[13], P1[14], P1[15], pw3[1] = PKW(P1, 10), pw3); \
                       GAP2(C1 = A9_MFMA(kr[3], qr[5], C1),    0.f, 0.f,               pw3[2] = PKW(P1, 12), pw3[3] = PKW(P1, 14), pw3); \
    l_reg += sacc; \
    if (GK) DMA_K((t) + 3, sl_cur, RS3()); if (GV) DMA_V((t) + 1, sl_next); \
    { const float rm = rowmax(C0, C1); resc = false; \
      if (__builtin_expect(__any(rm > THR), 0)) { const float dl = __builtin_fmaxf(rm, 0.f); \
          _Pragma("unroll") for (int r_ = 0; r_ < 16; ++r_) { nmh16[r_] -= dl; C0[r_] -= dl; C1[r_] -= dl; } \
          const float f = __builtin_amdgcn_exp2f(-dl); l_reg *= f; if (hi == 0) wsf[r32] = f; resc = true; } } \
    A9_SBAR(); \
    GAPB(o[0] = A9_MFMA(PAF(0), VFR(0), o[0]), C0, 0);              GAPB(o[1] = A9_MFMA(PAF(0), VFR(4), o[1]), C0, 4); \
    KRD(GL, 0); GAPB(o[0] = A9_MFMA(PAF(1), VFR(1), o[0]), C0, 8);  KRD(GL, 1); GAPB(o[1] = A9_MFMA(PAF(1), VFR(5), o[1]), C0, 12); \
    KRD(GL, 2); GAPB(o[0] = A9_MFMA(PAF(2), VFR(2), o[0]), C1, 0);  KRD(GL, 3); GAPB(o[1] = A9_MFMA(PAF(2), VFR(6), o[1]), C1, 4); \
    GAPB(o[0] = A9_MFMA(PAF(3), VFR(3), o[0]), C1, 8);              GAPB(o[1] = A9_MFMA(PAF(3), VFR(7), o[1]), C1, 12); \
    } while (0)
    int t = 1;
    for (; t + 5 < NT; t += 2) {
        STEP(pB0, pB1, pA0, pA1, t, true, true, true);     A9_WAIT_BAR(3); RESC(); ROT();
        STEP(pA0, pA1, pB0, pB1, t + 1, true, true, true); A9_WAIT_BAR(3); RESC(); ROT();
    }
#define ENDW(tt) do { if ((tt) + 3 < NT) { A9_WAIT_BAR(3); } else if ((tt) + 2 < NT) { A9_WAIT_BAR(1); } else { A9_WAIT_BAR(0); } } while (0)
    for (; t + 1 < NT; t += 2) {
        STEP(pB0, pB1, pA0, pA1, t, (t + 3 < NT), (t + 1 < NT), (t + 1 < NT));         ENDW(t);     RESC(); ROT();
        STEP(pA0, pA1, pB0, pB1, t + 1, (t + 4 < NT), (t + 2 < NT), (t + 2 < NT));     ENDW(t + 1); RESC(); ROT();
    }
    STEP(pB0, pB1, pA0, pA1, NT - 1, false, false, false); RESC();
    { float sacc = pB0[0] + pB0[1];
#pragma unroll
      for (int r = 2; r < 16; ++r) sacc += pB0[r];
#pragma unroll
      for (int r = 0; r < 16; ++r) sacc += pB1[r];
      l_reg += sacc;
      pw0 = (u32x4){PKW(pB0, 0), PKW(pB0, 2), PKW(pB0, 4), PKW(pB0, 6)}; pw1 = (u32x4){PKW(pB0, 8), PKW(pB0, 10), PKW(pB0, 12), PKW(pB0, 14)};
      pw2 = (u32x4){PKW(pB1, 0), PKW(pB1, 2), PKW(pB1, 4), PKW(pB1, 6)}; pw3 = (u32x4){PKW(pB1, 8), PKW(pB1, 10), PKW(pB1, 12), PKW(pB1, 14)};
      const lds_cptr vp_ = vp0 + sl_cur; _Pragma("unroll") for (int i = 0; i < 8; ++i) VRD(i);
      o[0] = A9_MFMA(PAF(0), VFR(0), o[0]); o[1] = A9_MFMA(PAF(0), VFR(4), o[1]); o[0] = A9_MFMA(PAF(1), VFR(1), o[0]); o[1] = A9_MFMA(PAF(1), VFR(5), o[1]);
      o[0] = A9_MFMA(PAF(2), VFR(2), o[0]); o[1] = A9_MFMA(PAF(2), VFR(6), o[1]); o[0] = A9_MFMA(PAF(3), VFR(3), o[0]); o[1] = A9_MFMA(PAF(3), VFR(7), o[1]); }
    { auto rr = __builtin_amdgcn_permlane32_swap(__float_as_uint(l_reg), __float_as_uint(l_reg), false, false); l_reg = __uint_as_float(rr[0]) + __uint_as_float(rr[1]); }
    if (hi == 0) wsf[32 + r32] = l_reg; asm volatile("s_waitcnt lgkmcnt(0)" ::: "memory");
    float rli[16];
#pragma unroll
    for (int r = 0; r < 16; ++r) rli[r] = __builtin_amdgcn_rcpf(wsf[32 + crow(r, hi)]);
    bf16* Ow = a.O + (long)(wid * QBLK) * a.ldo; unsigned short* stg = (unsigned short*)(lds + LDS_OST) + wid * 2048;
#pragma unroll
    for (int r = 0; r < 16; ++r) { const int orow = crow(r, hi);
#pragma unroll
        for (int d0 = 0; d0 < 2; ++d0) { const float v = o[d0][r] * rli[r]; const unsigned u = __float_as_uint(v); stg[orow * 64 + d0 * 32 + r32] = (unsigned short)((u + 0x7fffu + ((u >> 16) & 1u)) >> 16); } }
    asm volatile("s_waitcnt lgkmcnt(0)" ::: "memory");
#pragma unroll
    for (int i = 0; i < 4; ++i) { const int row = i * 8 + (lane >> 3), ch = lane & 7; *(u32x4*)(Ow + (long)row * a.ldo + ch * 8) = *(const u32x4*)(stg + row * 64 + ch * 8); }
    asm volatile("s_waitcnt lgkmcnt(0)\n\ts_barrier" ::: "memory");
#undef DMA_K
#undef DMA_V
#undef ROT
#undef RS3
#undef EX
#undef RESC
#undef PKW
#undef PAF
#undef VFR
#undef VRD
#undef KRD
#undef ENDW
#undef GAP3
#undef GAP2
#undef GAPB
#undef STEP
}
#undef A9_SBAR
#undef A9_PIN
#undef A9_MFMA
#undef A9_WAIT_BAR
}

constexpr size_t MiB = 1u << 20;
constexpr size_t WS_CTL = 0, CTL_BYTES = 1 * MiB;
constexpr size_t WS_MOD = 1 * MiB;
constexpr size_t WS_T16C = WS_MOD + 256 * 1024, WS_T16S = WS_T16C + 4096, WS_T8C = WS_T16S + 4096, WS_T8S = WS_T8C + 2048;
constexpr size_t WS_RSQ = WS_MOD + 320 * 1024, WS_RSKV = WS_RSQ + 64 * 1024;
constexpr size_t WS_TAB = WS_MOD + 512 * 1024;
constexpr size_t WS_WT = 3 * MiB;
constexpr size_t WT_IN = 0, WT_G = WT_IN + (size_t)PPW * DM * 2, WT_QU = WT_G + (size_t)NGATE * DM * 2, WT_KVU = WT_QU + (size_t)768 * 384 * 2, WT_BR = WT_KVU + (size_t)1024 * 256 * 2,
                 WT_OUT = WT_BR + (size_t)3 * DM * 512 * 2, WT_F1 = WT_OUT + (size_t)DM * DM * 2, WT_F2 = WT_F1 + (size_t)DFF * DM * 2, WT_END = WT_F2 + (size_t)DM * DFF * 2;
static_assert(WT_END <= 36 * MiB, "weights");
constexpr size_t WS_CTXX = WS_WT + 36 * MiB;
constexpr size_t WS_XN = WS_CTXX + 4 * MiB;
constexpr size_t WS_HALF = WS_XN + 34 * MiB;
constexpr int NUNIT = 32 * (RPB / 32);
constexpr size_t H_PP = 0, H_QM = H_PP + (size_t)HM * PPW * 2, H_KVM = H_QM + (size_t)HM * 768 * 2, H_MO = H_KVM + (size_t)HM * 1024 * 2, H_PHI = H_MO + (size_t)HM * 512 * 2,
                 H_PSI = H_PHI + (size_t)NUNIT * 8192, H_GC = H_PSI + (size_t)NUNIT * 8192, H_END = H_GC + (size_t)NUNIT * 256;
constexpr size_t WS_END = WS_HALF + H_END;
static_assert(WS_END + 12 * MiB <= 256 * MiB, "workspace (the 12 MiB after WS_END hold transient scratch: pass-3 parking / split-K slabs)");
constexpr size_t WS_GB = WS_HALF + H_PHI, WS_MIX = WS_GB + (size_t)HM * 3 * DM * 2;
constexpr size_t WS_G0 = WS_HALF + H_KVM, WS_G1 = WS_HALF + H_PHI, WS_G2 = WS_G1 + (size_t)HM * DM * 2;
static_assert(WS_G2 + (size_t)HM * DM * 2 <= WS_HALF + H_PSI, "gate buffers");
constexpr size_t WS_HID = WS_HALF;
static_assert(WS_MIX + (size_t)HM * DM * 2 <= WS_HALF + H_GC && WS_HID + (size_t)MROWS * DFF * 2 <= WS_END, "overlays");
constexpr int CW_BAR = 4096, CW_ATT = 16384;

#define GAS __attribute__((address_space(1)))
#define LAS __attribute__((address_space(3)))
typedef unsigned short bf16;
typedef unsigned v4u __attribute__((ext_vector_type(4)));
typedef float f32x4 __attribute__((ext_vector_type(4)));
typedef float f32x8 __attribute__((ext_vector_type(8)));
#define LDS_WAIT() asm volatile("s_waitcnt lgkmcnt(0)" ::: "memory")
__device__ __forceinline__ unsigned f2bf(float f) { unsigned u = __builtin_bit_cast(unsigned, f); return (u + 0x7fffu + ((u >> 16) & 1u)) >> 16; }
__device__ __forceinline__ unsigned pk2(float lo, float hi) { return f2bf(lo) | (f2bf(hi) << 16); }
__device__ __forceinline__ float bf2f(unsigned short h) { return __uint_as_float((unsigned)h << 16); }

#define XB_TMO      128
#define XB_XCNT(j)  (256  + 64 * (j))
#define XB_XSUB(j)  (1280 + 64 * (j))
#define XB_XGEN(j)  (2304 + 64 * (j))
#define XB_TOP      3328
#define XB_TOPGEN   3392
#define XCD_BAR_WORDS 3456
#define XB_SPIN_CAP (1u << 22)
__device__ __forceinline__ unsigned xb_ld(unsigned* p)              { return __hip_atomic_load(p, __ATOMIC_RELAXED, __HIP_MEMORY_SCOPE_AGENT); }
__device__ __forceinline__ unsigned xb_add(unsigned* p, unsigned v) { return __hip_atomic_fetch_add(p, v, __ATOMIC_RELAXED, __HIP_MEMORY_SCOPE_AGENT); }
__device__ __forceinline__ unsigned xb_xcc_id() { return (unsigned)__builtin_amdgcn_s_getreg((3 << 11) | 20) & 0xFu; }
#define XB_SPIN(cond, bar) do { unsigned _sp = 0; while (cond) { __builtin_amdgcn_s_sleep(1); \
    if ((++_sp & 255u) == 0u) { if (xb_ld(&(bar)[XB_TMO])) break; if (_sp > XB_SPIN_CAP) { atomicAdd(&(bar)[XB_TMO], 1u); break; } } } } while (0)
struct XcdBarrier { unsigned* bar; unsigned x; volatile LAS unsigned* st; };
__device__ __forceinline__ XcdBarrier xcd_barrier_post(unsigned* bar, volatile LAS unsigned* st) {
    XcdBarrier b; b.bar = bar; b.x = xb_xcc_id(); b.st = st;
    if (threadIdx.x == 0) (void)xb_add(&bar[XB_XCNT(b.x)], 1u);
    return b;
}
__device__ __forceinline__ void xcd_barrier_complete(unsigned* bar, unsigned x, unsigned& nloc, unsigned& nx) {
    const unsigned G = gridDim.x * gridDim.y * gridDim.z;
    unsigned sum, cnt, mine, sp = 0u;
    for (;;) {
        sum = 0u; cnt = 0u; mine = 0u;
#pragma unroll
        for (unsigned j = 0; j < 16; ++j) { const unsigned c = xb_ld(&bar[XB_XCNT(j)]); sum += c; cnt += (c > 0u) ? 1u : 0u; mine = (j == x) ? c : mine; }
        if (sum == G) break;
        __builtin_amdgcn_s_sleep(1);
        if ((++sp & 255u) == 0u) { if (xb_ld(&bar[XB_TMO])) break; if (sp > XB_SPIN_CAP) { atomicAdd(&bar[XB_TMO], 1u); break; } }
    }
    nloc = mine > 0u ? mine : 1u; nx = cnt > 0u ? cnt : 1u;
}
__device__ __forceinline__ void xcd_barrier(const XcdBarrier& b) {
    asm volatile("s_waitcnt vmcnt(0)" ::: "memory");
    __syncthreads();
    if (threadIdx.x == 0) {
        unsigned* bar = b.bar; asm volatile("" : "+s"(bar));
        __builtin_amdgcn_s_waitcnt(0);
        unsigned nloc = b.st[0], nx = b.st[1];
        if (nloc == 0u) { xcd_barrier_complete(bar, b.x, nloc, nx); b.st[0] = nloc; b.st[1] = nx; }
        const unsigned old = xb_add(&bar[XB_XSUB(b.x)], 1u);
        const unsigned gen = old / nloc;
        if (old + 1u == (gen + 1u) * nloc) {
            __builtin_amdgcn_fence(__ATOMIC_RELEASE, "agent");
            asm volatile("s_waitcnt vmcnt(0)" ::: "memory");
            const unsigned og = xb_add(&bar[XB_TOP], 1u);
            const unsigned tg = og / nx;
            if (og + 1u == (tg + 1u) * nx) xb_add(&bar[XB_TOPGEN], 1u);
            else XB_SPIN(xb_ld(&bar[XB_TOPGEN]) == tg, bar);
            __builtin_amdgcn_fence(__ATOMIC_ACQUIRE, "agent");
            xb_add(&bar[XB_XGEN(b.x)], 1u);
            asm volatile("s_waitcnt vmcnt(0)" ::: "memory");
        } else {
            XB_SPIN(xb_ld(&bar[XB_XGEN(b.x)]) == gen, bar);
            __builtin_amdgcn_fence(__ATOMIC_ACQUIRE, "agent");
            asm volatile("s_waitcnt vmcnt(0)" ::: "memory");
        }
    }
    __syncthreads();
}

constexpr int NWAVES = 8, RING_BYTES = 131072, LDS_BYTES = 163840, MISC_OFF = LDS_BYTES - 512;
struct Args { const float* in[31]; float* out; unsigned char* ws; int ph_lo, ph_hi; };
enum { I_X = 0, I_C, I_CTX, I_CCTX, I_WMOD, I_BMOD, I_G1, I_G2, I_WIN, I_QGAIN, I_KGAIN, I_MU, I_W0, I_W2, I_A0, I_A2, I_G2R, I_KK, I_KA, I_RK, I_LNW, I_LNB, I_QNORM, I_QUP, I_KVNORM, I_KVUP, I_WBR, I_WOUT, I_FF1, I_FF2, I_GFIN };
#define CAS __attribute__((address_space(4)))
__device__ __forceinline__ const float* inp(int i) { const CAS Args* ap = (const CAS Args*)__builtin_amdgcn_kernarg_segment_ptr(); asm volatile("" : "+s"(ap)); return ap->in[i]; }
struct Frame {
    LAS unsigned char* lds; unsigned char* ldsg;
    unsigned* ctl; unsigned char* ws; float* out;
    int G, bid;
};
#define FTID() otid()
#define FLANE() (otid() & 63)
#define FWAVE() __builtin_amdgcn_readfirstlane(otid() >> 6)
__device__ __forceinline__ float wave_sum(float v) {
#pragma unroll
    for (int o = 1; o < 64; o <<= 1) v += __shfl_xor(v, o);
    return v;
}
__device__ __forceinline__ const float* xrow_ptr(const float* xl, const float* xc, int m) { const int b = m / RPB, s = m % RPB; return (s < CTX) ? xc + (size_t)(b * CTX + s) * DM : xl + (size_t)(b * SEQ + s - CTX) * DM; }

__device__ __forceinline__ void p0_transpose_item(const float* W, int ldw, int col0, int Kd, int N, bf16* WT, const float* kscale, LAS unsigned* scr, int item, int lane, int ldwt) {
    const int nblk = (N + 63) / 64, kb = item / nblk, nb = item % nblk, k0 = 64 * kb, n0 = 64 * nb, c = lane & 15, r4 = lane >> 4;
    const bool valid = n0 + 4 * c < N;
#pragma unroll
    for (int i = 0; i < 8; ++i) { const int k = 8 * i + 2 * r4; f32x4 a = (f32x4){0.f, 0.f, 0.f, 0.f}, bq = a;
        if (valid) { a = *(const f32x4*)(W + (size_t)(k0 + k) * ldw + col0 + n0 + 4 * c); bq = *(const f32x4*)(W + (size_t)(k0 + k + 1) * ldw + col0 + n0 + 4 * c); }
        if (kscale) { a = a * kscale[k0 + k]; bq = bq * kscale[k0 + k + 1]; }
#pragma unroll
        for (int e = 0; e < 4; ++e) scr[(4 * c + e) * 33 + (k >> 1)] = pk2(a[e], bq[e]); }
    LDS_WAIT(); asm volatile("" ::: "memory");
#pragma unroll
    for (int t = 0; t < 8; ++t) { const int n = (lane >> 3) + 8 * t, j = lane & 7; const LAS unsigned* p = scr + n * 33 + 4 * j;
        v4u o; o.x = p[0]; o.y = p[1]; o.z = p[2]; o.w = p[3];
        if (n0 + n < N) *(v4u*)(WT + (size_t)(n0 + n) * ldwt + k0 + 8 * j) = o; }
    LDS_WAIT(); asm volatile("" ::: "memory");
}

__device__ __forceinline__ void ph_weights(Frame& F, int l) {
    unsigned char* wt = F.ws + WS_WT;
    if (l == 0) {
        LAS float* sl = (LAS float*)F.lds;
        LAS float* red = (LAS float*)(F.lds + 32768);
        for (int i = FTID(); i < 5 * 1024; i += 512) { const int j = i >> 10, k = i & 1023; const float c = (j < 4) ? inp(I_C)[j * 1024 + k] : inp(I_CCTX)[k]; sl[i] = c / (1.f + __expf(-c)); }
        __syncthreads();
        for (int it = F.bid; it < 2 * 96; it += F.G) {
            const int ll = it / 96, n0 = (it % 96) * 64;
            const float* wm = inp(I_WMOD) + (size_t)ll * 1024 * 6144 + n0 + FLANE();
            float a0 = 0, a1 = 0, a2 = 0, a3 = 0, a4 = 0;
            for (int k0 = FWAVE() * 128; k0 < FWAVE() * 128 + 128; k0 += 32) { float w[32];
#pragma unroll
                for (int u = 0; u < 32; ++u) w[u] = wm[(size_t)(k0 + u) * 6144];
#pragma unroll
                for (int u = 0; u < 32; ++u) { const int k = k0 + u; a0 += sl[k] * w[u]; a1 += sl[1024 + k] * w[u]; a2 += sl[2048 + k] * w[u]; a3 += sl[3072 + k] * w[u]; a4 += sl[4096 + k] * w[u]; } }
            LAS float* r = red + FWAVE() * 320 + FLANE(); r[0] = a0; r[64] = a1; r[128] = a2; r[192] = a3; r[256] = a4;
            __syncthreads();
            if (FTID() < 320) { float s = 0; for (int w = 0; w < 8; ++w) s += red[w * 320 + FTID()]; const int j = FTID() >> 6, n = n0 + (FTID() & 63);
                ((float*)(F.ws + WS_MOD))[(size_t)(ll * 5 + j) * 6144 + n] = s + inp(I_BMOD)[ll * 6144 + n]; }
            __syncthreads();
        }
        if (F.bid == F.G - 1) {
            for (int i = FTID(); i < 64 * 16; i += 512) { const int pos = i >> 4, f = i & 15; const float ang = (float)pos * powf(10000.f, -(float)f / 16.f); ((float*)(F.ws + WS_T16C))[i] = cosf(ang); ((float*)(F.ws + WS_T16S))[i] = sinf(ang); }
            for (int i = FTID(); i < 64 * 8; i += 512) { const int pos = i >> 3, f = i & 7; const float ang = (float)pos * powf(10000.f, -(float)f / 8.f); ((float*)(F.ws + WS_T8C))[i] = cosf(ang); ((float*)(F.ws + WS_T8S))[i] = sinf(ang); }
        }
        __syncthreads();
    }
    {
        bf16* w2P = (bf16*)(F.ws + WS_TAB); bf16* a2B = (bf16*)(F.ws + WS_TAB + 131072); bf16* g2P = (bf16*)(F.ws + WS_TAB + 524288);
        const float* w2 = inp(I_W2) + (size_t)l * 2 * 64 * 512; const float* a2 = inp(I_A2) + (size_t)l * 2 * 64 * 512; const float* g2 = inp(I_G2R) + (size_t)l * 128 * 512;
        const float* mu = inp(I_MU) + (size_t)l * 2 * RWIN;
        for (int idx = F.bid * 512 + FTID(); idx < 65536; idx += F.G * 512) {
            { const int dh = idx >> 12, d = dh >> 3, hd = dh & 7, rem = idx & 4095, Ii = rem >> 11, J = (rem >> 10) & 1, S = (rem >> 9) & 1, ln = (rem >> 3) & 63, e = rem & 7;
              const int i = 32 * Ii + 16 * S + 8 * (e >> 2) + 4 * (ln >> 5) + (e & 3), k = 32 * J + (ln & 31);
              w2P[idx] = (bf16)f2bf(w2[(size_t)(d * 64 + i) * 512 + hd * 64 + k]); }
            { const int hd = idx >> 13, rem = idx & 8191, Ii = rem >> 11, Iv = (rem >> 10) & 1, S = (rem >> 9) & 1, ln = (rem >> 3) & 63, e = rem & 7;
              const int i = 32 * Ii + 16 * S + 8 * (e >> 2) + 4 * (ln >> 5) + (e & 3), v = 32 * Iv + (ln & 31);
              g2P[idx] = (bf16)f2bf(g2[(size_t)i * 512 + hd * 64 + v]); } }
        {   bf16* DF = (bf16*)(F.ws + WS_TAB + 655360);
            for (int idx = F.bid * 512 + FTID(); idx < 60 * 3 * 2 * 64 * 8; idx += F.G * 512) {
                const int e = idx & 7, ln = (idx >> 3) & 63, q = (idx >> 9) & 1, w = (idx >> 10) % 3, blk = idx / 3072, r = ln & 31, h = ln >> 5, cc = 32 * blk + r;
                const float m0 = mu[cc], m1 = mu[RWIN + cc]; const float cf = (w == 0) ? 1.f - m0 - m1 : (w == 1 ? m0 : m1);
                DF[idx] = (r == 16 * q + 8 * h + e) ? (bf16)f2bf(cf) : (bf16)0; } }
        for (int idx = F.bid * 512 + FTID(); idx < 196608; idx += F.G * 512) {
            const int dh = idx / 12288, rem = idx % 12288, w = rem >> 12, k = (rem >> 6) & 63, i = rem & 63, d = dh >> 3, hd = dh & 7;
            const float m0 = mu[RW_AD + d * 64 + i], m1 = mu[RWIN + RW_AD + d * 64 + i]; const float cf = (w == 0) ? 1.f - m0 - m1 : (w == 1 ? m0 : m1);
            a2B[idx] = (bf16)f2bf(a2[(size_t)(d * 64 + i) * 512 + hd * 64 + k] * cf); } }
    LAS unsigned* scr = (LAS unsigned*)(F.lds + FWAVE() * 16384);
    const int gw = F.bid * NWAVES + FWAVE(), NGW = F.G * NWAVES;
    const float* win = inp(I_WIN) + (size_t)l * DM * NIN;
    constexpr int I_A = 16 * 53, I_B = 16 * 48, I_C2 = 6 * 12, I_D = 4 * 16, I_E = 8 * 16, I_F = 16 * 16, I_G = 16 * 64, I_H = 64 * 16;
    constexpr int NITEMS = I_A + I_B + I_C2 + I_D + 3 * I_E + I_F + I_G + I_H;
    for (int it = gw; it < NITEMS; it += NGW) {
        int r = it; const int lane = FLANE();
        if (r < I_A) { p0_transpose_item(win, NIN, 0, DM, 3360, (bf16*)(wt + WT_IN), nullptr, scr, r, lane, DM); continue; } r -= I_A;
        if (r < I_B) { p0_transpose_item(win, NIN, C_GATE, DM, NGATE, (bf16*)(wt + WT_G), nullptr, scr, r, lane, DM); continue; } r -= I_B;
        if (r < I_C2) { p0_transpose_item(inp(I_QUP) + (size_t)l * 384 * 768, 768, 0, 384, 768, (bf16*)(wt + WT_QU), inp(I_QNORM) + l * 384, scr, r, lane, 384); continue; } r -= I_C2;
        if (r < I_D) { p0_transpose_item(inp(I_KVUP) + (size_t)l * 256 * 1024, 1024, 0, 256, 1024, (bf16*)(wt + WT_KVU), inp(I_KVNORM) + l * 256, scr, r, lane, 256); continue; } r -= I_D;
        if (r < 3 * I_E) { const int i = r / I_E; p0_transpose_item(inp(I_WBR) + (size_t)(l * 3 + i) * 512 * DM, DM, 0, 512, DM, (bf16*)(wt + WT_BR) + (size_t)i * DM * 512, nullptr, scr, r % I_E, lane, 512); continue; } r -= 3 * I_E;
        if (r < I_F) { p0_transpose_item(inp(I_WOUT) + (size_t)l * DM * DM, DM, 0, DM, DM, (bf16*)(wt + WT_OUT), nullptr, scr, r, lane, DM); continue; } r -= I_F;
        if (r < I_G) { p0_transpose_item(inp(I_FF1) + (size_t)l * DM * DFF, DFF, 0, DM, DFF, (bf16*)(wt + WT_F1), nullptr, scr, r, lane, DM); continue; } r -= I_G;
        p0_transpose_item(inp(I_FF2) + (size_t)l * DFF * DM, DM, 0, DFF, DM, (bf16*)(wt + WT_F2), nullptr, scr, r, lane, DFF);
    }
    { v4u* z = (v4u*)((bf16*)(wt + WT_IN) + (size_t)3360 * DM); const int nz = 224 * DM * 2 / 16; unsigned z0; asm volatile("v_mov_b32 %0, 0" : "=v"(z0));
      for (int i = F.bid * 512 + FTID(); i < nz; i += F.G * 512) z[i] = (v4u){z0, z0, z0, z0}; }
}

__device__ __forceinline__ void ph_norm(Frame& F, int l, const float* xl, const float* xc, const float* g, int which, bool skipctx, const float* part = nullptr) {
    const int gw = F.bid * NWAVES + FWAVE(), NGW = F.G * NWAVES;
    const float* mod = (const float*)(F.ws + WS_MOD) + (size_t)l * 5 * 6144;
    bf16* XN = (bf16*)(F.ws + WS_XN);
    for (int m = gw; m < MROWS; m += NGW) {
        const int b = m / RPB, s = m % RPB; if (skipctx && s < CTX) continue;
        const f32x4* xr = (const f32x4*)xrow_ptr(xl, xc, m) + FLANE();
        const float* mv = mod + (size_t)((s < CTX) ? 4 : b) * 6144 + which * 3072;
        f32x4 v[4]; float ss = 0.f;
#pragma unroll
        for (int j = 0; j < 4; ++j) { v[j] = xr[64 * j];
            if (part && s < CTX) { const f32x4* pr = (const f32x4*)(part + (size_t)(b * CTX + s) * DM) + FLANE() + 64 * j; v[j] = v[j] + pr[0] + pr[262144] + pr[524288]; }
            ss += (v[j].x * v[j].x + v[j].y * v[j].y) + (v[j].z * v[j].z + v[j].w * v[j].w); }
        const float rstd = 1.f / sqrtf(wave_sum(ss) * (1.f / DM) + NORM_EPS);
        unsigned long long* o8 = (unsigned long long*)(XN + (size_t)m * DM) + FLANE();
#pragma unroll
        for (int j = 0; j < 4; ++j) { const int c = 4 * FLANE() + 256 * j; const f32x4 gg = *(const f32x4*)(g + c), sh = *(const f32x4*)(mv + c), sc = *(const f32x4*)(mv + 1024 + c);
            const f32x4 y = v[j] * rstd * gg * (sc + 1.0f) + sh;
            o8[64 * j] = (unsigned long long)pk2(y.x, y.y) | ((unsigned long long)pk2(y.z, y.w) << 32); }
    }
}
__device__ __forceinline__ void ph_final(Frame& F) {
    const int gw = F.bid * NWAVES + FWAVE(), NGW = F.G * NWAVES; const float* g = inp(I_GFIN);
    for (int m = gw; m < NB * SEQ; m += NGW) {
        f32x4* xr = (f32x4*)(F.out + (size_t)m * DM) + FLANE(); f32x4 v[4]; float ss = 0.f;
#pragma unroll
        for (int j = 0; j < 4; ++j) { v[j] = xr[64 * j]; ss += (v[j].x * v[j].x + v[j].y * v[j].y) + (v[j].z * v[j].z + v[j].w * v[j].w); }
        const float rstd = 1.f / sqrtf(wave_sum(ss) * (1.f / DM) + NORM_EPS);
#pragma unroll
        for (int j = 0; j < 4; ++j) { const f32x4 gg = *(const f32x4*)(g + 4 * FLANE() + 256 * j); xr[64 * j] = v[j] * rstd * gg; }
    }
}

__device__ __forceinline__ void ph_prep(Frame& F, int l, int half) {
    const int gw = F.bid * NWAVES + FWAVE(), NGW = F.G * NWAVES, lane = FLANE();
    bf16* PP = (bf16*)(F.ws + WS_HALF + H_PP);
    const float* t16c = (const float*)(F.ws + WS_T16C); const float* t16s = (const float*)(F.ws + WS_T16S); const float* t8c = (const float*)(F.ws + WS_T8C); const float* t8s = (const float*)(F.ws + WS_T8S);
    float* rsq = (float*)(F.ws + WS_RSQ); float* rskv = (float*)(F.ws + WS_RSKV);
    const float* qg = inp(I_QGAIN) + l * 64; const float* kg = inp(I_KGAIN) + l * 64;
    const int n3 = NUNIT - 2 * NGW; const bool skew = n3 > 0 && n3 < NGW; const int wp = skew ? gw - n3 : gw, NWP = skew ? NGW - n3 : NGW;
    for (int m = wp; m < HM; m += NWP) {
        if (wp < 0) break;
        const int s = m % RPB; const bool lat = s >= CTX; const int tt = s - CTX, pr = (tt >> 6) & 63, pc = tt & 63;
        bf16* row = PP + (size_t)m * PPW;
        for (int part = 0; part < 2; ++part) {
            if (part == 1 && lane >= 16) break;
            bf16* p = row + (part == 0 ? C_GQ : C_GK) + lane * 8; const float* gain = part == 0 ? qg : kg;
            const v4u w = *(const v4u*)p; float v[8] = {pg8::bf_lo(w.x), pg8::bf_hi(w.x), pg8::bf_lo(w.y), pg8::bf_hi(w.y), pg8::bf_lo(w.z), pg8::bf_hi(w.z), pg8::bf_lo(w.w), pg8::bf_hi(w.w)};
            float ss = 0; for (int e = 0; e < 8; ++e) ss += v[e] * v[e];
            ss += __shfl_xor(ss, 1); ss += __shfl_xor(ss, 2); ss += __shfl_xor(ss, 4);
            const float rstd = 1.f / sqrtf(ss * (1.f / 64.f) + NORM_EPS); const int j = lane & 7;
            const float qs = (part == 0) ? 0.125f * 1.4426950408889634f : 1.f;
            for (int e = 0; e < 8; ++e) v[e] = v[e] * (rstd * qs) * gain[j * 8 + e];
            float pv[8]; for (int e = 0; e < 8; ++e) pv[e] = __shfl_xor(v[e], 2);
            if (lat) { const int pos = (j < 4) ? pr : pc; const int f0 = 8 * (j & 1);
                for (int e = 0; e < 8; ++e) { const float c = t16c[pos * 16 + f0 + e], sn = t16s[pos * 16 + f0 + e]; v[e] = ((j & 2) == 0) ? v[e] * c - pv[e] * sn : pv[e] * sn + v[e] * c; } }
            v4u o; o.x = pk2(v[0], v[1]); o.y = pk2(v[2], v[3]); o.z = pk2(v[4], v[5]); o.w = pk2(v[6], v[7]); *(v4u*)p = o;
        }
        if (lane < 4) {
            bf16* p = row + C_KR + lane * 8; const v4u w = *(const v4u*)p; float v[8] = {pg8::bf_lo(w.x), pg8::bf_hi(w.x), pg8::bf_lo(w.y), pg8::bf_hi(w.y), pg8::bf_lo(w.z), pg8::bf_hi(w.z), pg8::bf_lo(w.w), pg8::bf_hi(w.w)};
            float pv[8]; for (int e = 0; e < 8; ++e) pv[e] = __shfl_xor(v[e], 1);
            if (lat) { const int pos = (lane < 2) ? pr : pc;
                for (int e = 0; e < 8; ++e) { const float c = t8c[pos * 8 + e], sn = t8s[pos * 8 + e]; v[e] = ((lane & 1) == 0) ? v[e] * c - pv[e] * sn : pv[e] * sn + v[e] * c; } }
            v4u o; o.x = pk2(v[0], v[1]); o.y = pk2(v[2], v[3]); o.z = pk2(v[4], v[5]); o.w = pk2(v[6], v[7]); *(v4u*)p = o;
        }
        { float sq = 0, skv = 0;
          if (lane < 48) { const v4u w = *(const v4u*)(row + C_QD + lane * 8); const float v[8] = {pg8::bf_lo(w.x), pg8::bf_hi(w.x), pg8::bf_lo(w.y), pg8::bf_hi(w.y), pg8::bf_lo(w.z), pg8::bf_hi(w.z), pg8::bf_lo(w.w), pg8::bf_hi(w.w)}; for (int e = 0; e < 8; ++e) sq += v[e] * v[e]; }
          if (lane < 32) { const v4u w = *(const v4u*)(row + C_KVD + lane * 8); const float v[8] = {pg8::bf_lo(w.x), pg8::bf_hi(w.x), pg8::bf_lo(w.y), pg8::bf_hi(w.y), pg8::bf_lo(w.z), pg8::bf_hi(w.z), pg8::bf_lo(w.w), pg8::bf_hi(w.w)}; for (int e = 0; e < 8; ++e) skv += v[e] * v[e]; }
          sq = wave_sum(sq); skv = wave_sum(skv);
          if (lane == 0) { rsq[m] = (0.10206207261596575f * 1.4426950408889634f) / sqrtf(sq * (1.f / 384.f) + NORM_EPS);     rskv[m] = 1.f / sqrtf(skv * (1.f / 256.f) + NORM_EPS); } }
    }
}
__device__ __forceinline__ void shifted8(const bf16* PP, int m, int cc0, const float* mu, float (&u)[8]) {
    const int s = m % RPB; const float fp = (s != 0 && s != CTX) ? 1.f : 0.f, fn = (s != CTX - 1 && s != RPB - 1) ? 1.f : 0.f;
    const int mp = m > 0 ? m - 1 : 0, mn = m < HM - 1 ? m + 1 : HM - 1;
    const v4u w = *(const v4u*)(PP + (size_t)m * PPW + C_RW + cc0), wp = *(const v4u*)(PP + (size_t)mp * PPW + C_RW + cc0), wn = *(const v4u*)(PP + (size_t)mn * PPW + C_RW + cc0);
    const f32x4 m0a = *(const f32x4*)(mu + cc0), m0b = *(const f32x4*)(mu + cc0 + 4), m1a = *(const f32x4*)(mu + RWIN + cc0), m1b = *(const f32x4*)(mu + RWIN + cc0 + 4);
    const float c[8] = {pg8::bf_lo(w.x), pg8::bf_hi(w.x), pg8::bf_lo(w.y), pg8::bf_hi(w.y), pg8::bf_lo(w.z), pg8::bf_hi(w.z), pg8::bf_lo(w.w), pg8::bf_hi(w.w)};
    const float a[8] = {pg8::bf_lo(wp.x), pg8::bf_hi(wp.x), pg8::bf_lo(wp.y), pg8::bf_hi(wp.y), pg8::bf_lo(wp.z), pg8::bf_hi(wp.z), pg8::bf_lo(wp.w), pg8::bf_hi(wp.w)};
    const float n[8] = {pg8::bf_lo(wn.x), pg8::bf_hi(wn.x), pg8::bf_lo(wn.y), pg8::bf_hi(wn.y), pg8::bf_lo(wn.z), pg8::bf_hi(wn.z), pg8::bf_lo(wn.w), pg8::bf_hi(wn.w)};
#pragma unroll
    for (int e = 0; e < 8; ++e) { const float m0 = (e < 4 ? m0a[e & 3] : m0b[e & 3]), m1 = (e < 4 ? m1a[e & 3] : m1b[e & 3]); u[e] = c[e] + m0 * (fp * a[e] - c[e]) + m1 * (fn * n[e] - c[e]); }
}
namespace rk {
using bf16x8 = __attribute__((ext_vector_type(8))) short;
using f32x16 = __attribute__((ext_vector_type(16))) float;
using u32x4 = __attribute__((ext_vector_type(4))) unsigned;
typedef float f32x2_t __attribute__((ext_vector_type(2))); typedef __bf16 bf16x2_t __attribute__((ext_vector_type(2)));
#define RK_DI __device__ __forceinline__
RK_DI f32x16 RK_MF(bf16x8 a, bf16x8 b, f32x16 c) { return __builtin_amdgcn_mfma_f32_32x32x16_bf16(a, b, c, 0, 0, 0); }
constexpr int NH = 8;
RK_DI unsigned cvt2(float lo, float hi) { f32x2_t v = {lo, hi}; bf16x2_t b = __builtin_convertvector(v, bf16x2_t); return __builtin_bit_cast(unsigned, b); }
RK_DI float lo16(unsigned w) { return __uint_as_float(w << 16); }
RK_DI float hi16(unsigned w) { return __uint_as_float(w & 0xffff0000u); }
RK_DI int crow(int reg, int h) { return (reg & 3) + 8 * (reg >> 2) + 4 * h; }
RK_DI int krow(int s, int h, int e) { return 16 * s + 8 * (e >> 2) + 4 * h + (e & 3); }
template <int S> RK_DI bf16x8 pack(const f32x16& x) { u32x4 p = {cvt2(x[8 * S], x[8 * S + 1]), cvt2(x[8 * S + 2], x[8 * S + 3]), cvt2(x[8 * S + 4], x[8 * S + 5]), cvt2(x[8 * S + 6], x[8 * S + 7])}; return __builtin_bit_cast(bf16x8, p); }
RK_DI bf16x8 pack8(const float (&u)[8]) { u32x4 p = {cvt2(u[0], u[1]), cvt2(u[2], u[3]), cvt2(u[4], u[5]), cvt2(u[6], u[7])}; return __builtin_bit_cast(bf16x8, p); }
RK_DI void unpack8(bf16x8 v, float (&u)[8]) { const u32x4 p = __builtin_bit_cast(u32x4, v); u[0] = lo16(p.x); u[1] = hi16(p.x); u[2] = lo16(p.y); u[3] = hi16(p.y); u[4] = lo16(p.z); u[5] = hi16(p.z); u[6] = lo16(p.w); u[7] = hi16(p.w); }
constexpr short ONE = (short)0x3F80;
template <int K> RK_DI bf16x8 idn(int r, int h) { bf16x8 v;
#pragma unroll
    for (int e = 0; e < 8; ++e) v[e] = (r == 16 * K + 8 * h + e) ? ONE : (short)0; return v; }
template <int S> RK_DI bf16x8 idp(int r, int h) { bf16x8 v;
#pragma unroll
    for (int e = 0; e < 8; ++e) v[e] = (r == krow(S, h, e)) ? ONE : (short)0; return v; }
RK_DI bf16x8 idn_q(int q, int r, int h) { return q ? idn<1>(r, h) : idn<0>(r, h); }
template <int S, bool STRICT> RK_DI bf16x8 incp(int r, int h, int flip) { bf16x8 v;
#pragma unroll
    for (int e = 0; e < 8; ++e) { const int s = krow(S, h, e); const bool on = flip ? (STRICT ? s > r : s >= r) : (STRICT ? s < r : s <= r); v[e] = on ? ONE : (short)0; } return v; }
template <bool STRICT> RK_DI void tmask(f32x16& g, int r, int h, int flip) {
#pragma unroll
    for (int reg = 0; reg < 16; ++reg) { const int s = crow(reg, h); const bool on = flip ? (STRICT ? s > r : s >= r) : (STRICT ? s < r : s <= r); g[reg] = on ? g[reg] : 0.f; } }
template <int FLIP> RK_DI void solve32(f32x16& x, const bf16x8 (&Mp)[2]) {
    constexpr int F1 = FLIP ? 1 : 0, F2 = 1 - F1;
    f32x16 base = x;
#pragma unroll 1
    for (int it = 0; it < NH; ++it) { const f32x16 t = RK_MF(Mp[F1], pack<F1>(x), base);
#pragma unroll
        for (int e = 0; e < 8; ++e) x[8 * F1 + e] = t[8 * F1 + e]; }
    { const f32x16 t = RK_MF(Mp[F1], pack<F1>(x), base); x = t; base = t; }
#pragma unroll 1
    for (int it = 0; it < NH; ++it) { const f32x16 t = RK_MF(Mp[F2], pack<F2>(x), base);
#pragma unroll
        for (int e = 0; e < 8; ++e) x[8 * F2 + e] = t[8 * F2 + e]; }
}
template <int FLIP> RK_DI void solve32p(f32x16& x, f32x16& y, const bf16x8 (&Mp)[2]) {
    constexpr int F1 = FLIP ? 1 : 0, F2 = 1 - F1;
    f32x16 bx = x, by = y;
#pragma unroll 1
    for (int it = 0; it < NH; ++it) { const f32x16 t = RK_MF(Mp[F1], pack<F1>(x), bx); const f32x16 u = RK_MF(Mp[F1], pack<F1>(y), by);
#pragma unroll
        for (int e = 0; e < 8; ++e) { x[8 * F1 + e] = t[8 * F1 + e]; y[8 * F1 + e] = u[8 * F1 + e]; } }
    { const f32x16 t = RK_MF(Mp[F1], pack<F1>(x), bx); const f32x16 u = RK_MF(Mp[F1], pack<F1>(y), by); x = t; bx = t; y = u; by = u; }
#pragma unroll 1
    for (int it = 0; it < NH; ++it) { const f32x16 t = RK_MF(Mp[F2], pack<F2>(x), bx); const f32x16 u = RK_MF(Mp[F2], pack<F2>(y), by);
#pragma unroll
        for (int e = 0; e < 8; ++e) { x[8 * F2 + e] = t[8 * F2 + e]; y[8 * F2 + e] = u[8 * F2 + e]; } }
}
RK_DI float sigm(float x) { return __builtin_amdgcn_rcpf(1.f + __expf(-x)); }
RK_DI float tanh_f(float x) { return 2.f * __builtin_amdgcn_rcpf(1.f + __expf(-2.f * x)) - 1.f; }

struct Ctx {
    unsigned char* ws; LAS unsigned char* sb; int m0, r, h, hd, dir, l, flip;
    int cofs, dofs;
    int zt;
    int lofs;
    unsigned mp, mn; int rowc, rowp, rown;
};
#define C_PP(c) ((const bf16*)((c).ws + WS_HALF + H_PP))
#define C_MU(c) (inp(I_MU) + (size_t)(c).l * 2 * RWIN)
#define C_W2P(c) ((const bf16*)((c).ws + WS_TAB) + (size_t)((c).dir * 8 + (c).hd) * 4096)
#define C_A2B(c) ((const bf16*)((c).ws + WS_TAB + 131072) + (size_t)((c).dir * 8 + (c).hd) * 3 * 4096)
constexpr int SBUF = 34 * 128;
RK_DI void stage_slice(const Ctx& c, int buf, int cc0) {
    const int lane = c.r + 32 * c.h, p = lane & 7, q4 = lane >> 4;
    const bf16* base = C_PP(c) + (ptrdiff_t)(c.m0 - 1 + (lane >> 3)) * PPW + C_RW + cc0;
    const int oe = (p ^ q4) << 3, oo = (p ^ (4 + q4)) << 3;
#pragma unroll
    for (int j = 0; j < 5; ++j) { const bf16* src = base + (ptrdiff_t)j * 8 * PPW + ((j & 1) ? oo : oe);
        if (j < 4 || lane < 16) __builtin_amdgcn_global_load_lds((const unsigned*)src, (LAS unsigned*)(c.sb + buf * SBUF + j * 1024), 16, 0, 0); }
}
#define RK_WAIT_DMA() asm volatile("s_waitcnt vmcnt(0)" ::: "memory")
#define RK_WAIT_LDS() asm volatile("s_waitcnt lgkmcnt(0)" ::: "memory")
RK_DI bf16x8 rawfrag(const Ctx& c, int buf, int ch, int w) {
    const int rho = c.r + (w == 0 ? 1 : (w == 1 ? 0 : 2)); const unsigned m = (w == 0) ? 0xffffffffu : (w == 1 ? c.mp : c.mn);
    u32x4 v = *(const LAS u32x4*)(c.sb + buf * SBUF + rho * 128 + ((ch ^ ((rho >> 1) & 7)) << 4) + c.zt); v.x &= m; v.y &= m; v.z &= m; v.w &= m; return __builtin_bit_cast(bf16x8, v); }
RK_DI bf16x8 dfrag(const Ctx& c, int cc32, int w, int q) { return *(const bf16x8*)((const bf16*)(c.ws + WS_TAB + 655360) + (((cc32 >> 5) * 3 + w) * 2 + q) * 512 + c.lofs); }
RK_DI f32x16 load_o2(Ctx& c, int buf, int lblk, int cc32) { f32x16 z = f32x16{};
#pragma unroll
    for (int q = 0; q < 2; ++q) {
#pragma unroll
        for (int w = 0; w < 3; ++w) z = RK_MF(dfrag(c, cc32, w, q), rawfrag(c, buf, 4 * lblk + 2 * q + c.h, w), z); }
    asm volatile("" : "+v"(c.lofs), "+v"(c.zt), "+v"(z));
    return z; }
RK_DI f32x16 load_o1(Ctx& c, int buf, int lblk, int cc32) { f32x16 z = f32x16{};
#pragma unroll
    for (int q = 0; q < 2; ++q) {
#pragma unroll
        for (int w = 0; w < 3; ++w) z = RK_MF(rawfrag(c, buf, 4 * lblk + 2 * q + c.h, w), dfrag(c, cc32, w, q), z); }
    asm volatile("" : "+v"(c.lofs), "+v"(c.zt), "+v"(z));
    return z; }

struct Tilde { bf16x8 At[2][2], Bt[2][2], Kt[2][2], Rt[2][2], Vp[2][2]; float gtot[2]; float bon; };
#define RK_STAGE(x) asm volatile("" : "+v"(c.lofs), "+v"(c.zt), "+v"(x))
template <bool NEED_R> RK_DI void build_tilde(Ctx& c, Tilde& T) {
    const int r = c.r, h = c.h;
    stage_slice(c, 0, RW_WD + c.dir * 64); stage_slice(c, 1, RW_K + c.hd * 64); stage_slice(c, 2, RW_AD + c.dir * 64); if constexpr (NEED_R) stage_slice(c, 3, RW_R + c.hd * 64);
    RK_WAIT_DMA();
    bf16x8 lwp[2][2];
    {   bf16x8 twp[2][2];
#pragma unroll
        for (int Ii = 0; Ii < 2; ++Ii) { f32x16 t = load_o2(c, 0, Ii, RW_WD + c.dir * 64 + 32 * Ii);
#pragma unroll
            for (int reg = 0; reg < 16; ++reg) t[reg] = tanh_f(t[reg]);
            twp[Ii][0] = pack<0>(t); twp[Ii][1] = pack<1>(t); RK_STAGE(twp[Ii][1]); }
#pragma unroll
        for (int J = 0; J < 2; ++J) { f32x16 wl = f32x16{};
#pragma unroll
            for (int Ii = 0; Ii < 2; ++Ii)
#pragma unroll
                for (int S = 0; S < 2; ++S) wl = RK_MF(twp[Ii][S], *(const bf16x8*)(C_W2P(c) + ((Ii * 2 + J) * 2 + S) * 512 + c.lofs), wl);
            const float w0 = inp(I_W0)[c.dofs + 32 * J + r]; float gs = 0.f;
#pragma unroll
            for (int reg = 0; reg < 16; ++reg) wl[reg] = -0.6065306597126334f * sigm(wl[reg] + w0);
            lwp[J][0] = pack<0>(wl); lwp[J][1] = pack<1>(wl);
            { float q[8]; unpack8(lwp[J][0], q);
#pragma unroll
              for (int e = 0; e < 8; ++e) gs += q[e]; unpack8(lwp[J][1], q);
#pragma unroll
              for (int e = 0; e < 8; ++e) gs += q[e]; }
            gs += __shfl_xor(gs, 32); T.gtot[J] = gs; RK_STAGE(lwp[J][1]); } }
    RK_WAIT_LDS(); stage_slice(c, 0, RW_V + c.hd * 64);
    float rinv;
    {   float ss = 0.f;
#pragma unroll
        for (int Ik = 0; Ik < 2; ++Ik) { const f32x16 kt = load_o2(c, 1, Ik, RW_K + c.hd * 64 + 32 * Ik);
#pragma unroll
            for (int g = 0; g < 4; ++g) { const f32x4 kk = *(const f32x4*)(inp(I_KK) + c.cofs + 32 * Ik + 8 * g + 4 * h);
#pragma unroll
                for (int j = 0; j < 4; ++j) { const float q = kt[4 * g + j] * kk[j]; ss += q * q; } }
            RK_STAGE(ss); }
        ss += __shfl_xor(ss, 32); rinv = 1.f / fmaxf(sqrtf(ss), 1e-12f); RK_STAGE(rinv); }
    float bon = 0.f;
#pragma unroll
    for (int Ik = 0; Ik < 2; ++Ik) {
        f32x16 em, ep;
        { em = RK_MF(lwp[Ik][0], incp<0, false>(r, h, c.flip), f32x16{}); em = RK_MF(lwp[Ik][1], incp<1, false>(r, h, c.flip), em);
          ep = RK_MF(lwp[Ik][0], incp<0, true>(r, h, c.flip), f32x16{}); ep = RK_MF(lwp[Ik][1], incp<1, true>(r, h, c.flip), ep);
#pragma unroll
          for (int reg = 0; reg < 16; ++reg) { em[reg] = __expf(-em[reg]); ep[reg] = __expf(ep[reg]); } }
        RK_STAGE(ep);
        f32x16 kt = load_o2(c, 1, Ik, RW_K + c.hd * 64 + 32 * Ik); f32x16 kn;
#pragma unroll
        for (int g = 0; g < 4; ++g) { const f32x4 kk = *(const f32x4*)(inp(I_KK) + c.cofs + 32 * Ik + 8 * g + 4 * h);
#pragma unroll
            for (int j = 0; j < 4; ++j) { const int reg = 4 * g + j; kn[reg] = kt[reg] * kk[j] * rinv; ep[reg] = -kn[reg] * ep[reg]; } }
        T.At[Ik][0] = pack<0>(ep); T.At[Ik][1] = pack<1>(ep);
        RK_STAGE(T.At[Ik][1]);
        f32x16 as = f32x16{};
#pragma unroll
        for (int w = 0; w < 3; ++w) {
#pragma unroll
            for (int sp = 0; sp < 4; ++sp) as = RK_MF(*(const bf16x8*)(C_A2B(c) + w * 4096 + (32 * Ik + r) * 64 + 16 * sp + 8 * h), rawfrag(c, 2, 2 * sp + h, w), as);
            RK_STAGE(as); }
#pragma unroll
        for (int g = 0; g < 4; ++g) { const f32x4 a0 = *(const f32x4*)(inp(I_A0) + c.dofs + 32 * Ik + 8 * g + 4 * h);
#pragma unroll
            for (int j = 0; j < 4; ++j) { const int reg = 4 * g + j; as[reg] = sigm(as[reg] + a0[j]); kn[reg] = kn[reg] * as[reg] * em[reg]; } }
        T.Bt[Ik][0] = pack<0>(kn); T.Bt[Ik][1] = pack<1>(kn);
        RK_STAGE(T.Bt[Ik][1]);
#pragma unroll
        for (int g = 0; g < 4; ++g) { const f32x4 ka = *(const f32x4*)(inp(I_KA) + c.cofs + 32 * Ik + 8 * g + 4 * h);
#pragma unroll
            for (int j = 0; j < 4; ++j) { const int reg = 4 * g + j; kt[reg] = kt[reg] * (1.f + (as[reg] - 1.f) * ka[j]); as[reg] = kt[reg] * em[reg]; } }
        T.Kt[Ik][0] = pack<0>(as); T.Kt[Ik][1] = pack<1>(as);
        RK_STAGE(T.Kt[Ik][1]);
        if constexpr (NEED_R) {
            f32x16 rt = load_o2(c, 3, Ik, RW_R + c.hd * 64 + 32 * Ik);
#pragma unroll
            for (int g = 0; g < 4; ++g) { const f32x4 rk = *(const f32x4*)(inp(I_RK) + c.cofs + 32 * Ik + 8 * g + 4 * h);
#pragma unroll
                for (int j = 0; j < 4; ++j) { const int reg = 4 * g + j; bon += rt[reg] * kt[reg] * rk[j]; rt[reg] = rt[reg] * __builtin_amdgcn_rcpf(em[reg]); } }
            T.Rt[Ik][0] = pack<0>(rt); T.Rt[Ik][1] = pack<1>(rt); RK_STAGE(T.Rt[Ik][1]); }
    }
    T.bon = bon;
    RK_WAIT_DMA();
#pragma unroll
    for (int J = 0; J < 2; ++J) { const f32x16 va = load_o1(c, 0, J, RW_V + c.hd * 64 + 32 * J); T.Vp[J][0] = pack<0>(va); T.Vp[J][1] = pack<1>(va); RK_STAGE(T.Vp[J][1]); }
}
RK_DI void grams_la(const Ctx& c, const Tilde& T, bf16x8 (&Lk)[2], bf16x8 (&Mp)[2]) {
    f32x16 g = f32x16{}, m = f32x16{};
#pragma unroll
    for (int Ik = 0; Ik < 2; ++Ik)
#pragma unroll
        for (int S = 0; S < 2; ++S) { g = RK_MF(T.Kt[Ik][S], T.At[Ik][S], g); m = RK_MF(T.Bt[Ik][S], T.At[Ik][S], m); }
    tmask<true>(g, c.r, c.h, c.flip); tmask<true>(m, c.r, c.h, c.flip);
    Lk[0] = pack<0>(g); Lk[1] = pack<1>(g); Mp[0] = pack<0>(m); Mp[1] = pack<1>(m);
}
}

namespace rk {
constexpr int NSUB = RPB / 32;
RK_DI int chain_unit(int dir, int j) { return dir == 0 ? j : (j < 8 ? 7 - j : 143 - j); }
RK_DI int chain_pos(int dir, int c) { return dir == 0 ? c : (c < 8 ? 7 - c : 143 - c); }
RK_DI void setup_ctx(Ctx& c, unsigned char* ws, LAS unsigned char* sb, int l, int bl, int hd, int dir, int c32, int lane) {
    c.ws = ws; c.sb = sb; c.m0 = bl * RPB + 32 * c32; c.r = lane & 31; c.h = lane >> 5; c.hd = hd; c.dir = dir; c.l = l; c.flip = dir;
    c.cofs = l * 512 + hd * 64; c.dofs = (l * 2 + dir) * 512 + hd * 64;
    const int m = c.m0 + c.r, sg = m % RPB;
    c.mp = (sg != 0 && sg != CTX) ? 0xffffffffu : 0u; c.mn = (sg != CTX - 1 && sg != RPB - 1) ? 0xffffffffu : 0u;
    c.rowc = m; c.rowp = m > 0 ? m - 1 : 0; c.rown = m < HM - 1 ? m + 1 : HM - 1; c.lofs = (c.r + 32 * c.h) * 8; asm volatile("v_mov_b32 %0, 0" : "=v"(c.zt));
}
RK_DI void pass1_unit(unsigned char* ws, LAS unsigned char* sb, int l, int u, int lane) {
    const int q = u / NSUB, c32 = u % NSUB, bl = q >> 4, hd = (q >> 1) & 7, dir = q & 1;
    Ctx c; setup_ctx(c, ws, sb, l, bl, hd, dir, c32, lane);
    Tilde T; build_tilde<false>(c, T); __builtin_amdgcn_sched_barrier(0);
    const int r = c.r, h = c.h;
    bf16x8 Lk[2], Mp[2]; grams_la(c, T, Lk, Mp); __builtin_amdgcn_sched_barrier(0);
    const bf16x8 P0 = idp<0>(r, h), P1 = idp<1>(r, h);
    bf16x8 W1p[2][2], W2p[2][2], Bop[2][2], Kop[2][2];
#pragma unroll
    for (int J = 0; J < 2; ++J) {
        f32x16 x = RK_MF(T.At[J][0], P0, f32x16{}); x = RK_MF(T.At[J][1], P1, x);
        f32x16 y = RK_MF(Lk[0], T.Vp[J][0], f32x16{}); y = RK_MF(Lk[1], T.Vp[J][1], y);
        if (c.flip) solve32p<1>(x, y, Mp); else solve32p<0>(x, y, Mp);
        W1p[J][0] = pack<0>(x); W1p[J][1] = pack<1>(x);
        W2p[J][0] = pack<0>(y); W2p[J][1] = pack<1>(y);
        const float gcj = __expf(T.gtot[J]);
        f32x16 b = RK_MF(T.Bt[J][0], P0, f32x16{}); b = RK_MF(T.Bt[J][1], P1, b);
        f32x16 k = RK_MF(T.Kt[J][0], P0, f32x16{}); k = RK_MF(T.Kt[J][1], P1, k);
#pragma unroll
        for (int reg = 0; reg < 16; ++reg) { b[reg] *= gcj; k[reg] *= gcj; }
        Bop[J][0] = pack<0>(b); Bop[J][1] = pack<1>(b); Kop[J][0] = pack<0>(k); Kop[J][1] = pack<1>(k);
    }
    u32x4* phi = (u32x4*)(ws + WS_HALF + H_PHI) + (size_t)u * 512 + lane;
    u32x4* psi = (u32x4*)(ws + WS_HALF + H_PSI) + (size_t)u * 512 + lane;
#pragma unroll
    for (int I = 0; I < 2; ++I)
#pragma unroll
        for (int J = 0; J < 2; ++J) {
            f32x16 a = RK_MF(W1p[I][0], Bop[J][0], f32x16{}); a = RK_MF(W1p[I][1], Bop[J][1], a);
            if (I == J) {
#pragma unroll
                for (int reg = 0; reg < 16; ++reg) a[reg] += (crow(reg, h) == r) ? __expf(T.gtot[J]) : 0.f; }
            phi[((I * 2 + J) * 2 + 0) * 64] = __builtin_bit_cast(u32x4, pack<0>(a)); phi[((I * 2 + J) * 2 + 1) * 64] = __builtin_bit_cast(u32x4, pack<1>(a));
            f32x16 p = RK_MF(Bop[I][0], W2p[J][0], f32x16{}); p = RK_MF(Bop[I][1], W2p[J][1], p); p = RK_MF(Kop[I][0], T.Vp[J][0], p); p = RK_MF(Kop[I][1], T.Vp[J][1], p);
            psi[((I * 2 + J) * 2 + 0) * 64] = (u32x4){cvt2(p[0], p[1]), cvt2(p[2], p[3]), cvt2(p[4], p[5]), cvt2(p[6], p[7])};
            psi[((I * 2 + J) * 2 + 1) * 64] = (u32x4){cvt2(p[8], p[9]), cvt2(p[10], p[11]), cvt2(p[12], p[13]), cvt2(p[14], p[15])};
        }
}
RK_DI void pass2_chain(unsigned char* ws, int q, int lane, bool do_store) {
    const int dir = q & 1;
    f32x16 H[2][2] = {{f32x16{}, f32x16{}}, {f32x16{}, f32x16{}}};
    u32x4 phi[8], psi[8];
    { const int u0 = q * NSUB + chain_unit(dir, 0);
      const u32x4* ph = (const u32x4*)(ws + WS_HALF + H_PHI) + (size_t)u0 * 512 + lane; const u32x4* ps = (const u32x4*)(ws + WS_HALF + H_PSI) + (size_t)u0 * 512 + lane;
#pragma unroll
      for (int f = 0; f < 8; ++f) { phi[f] = ph[f * 64]; psi[f] = ps[f * 64]; } }
    int uprev = q * NSUB + chain_unit(dir, 0);
#pragma unroll 1
    for (int j = 0; j < NSUB - 1; ++j) {
        const int un = q * NSUB + chain_unit(dir, j + 1 < NSUB - 1 ? j + 1 : j);
        u32x4 nphi[8], npsi[8];
        { const u32x4* ph = (const u32x4*)(ws + WS_HALF + H_PHI) + (size_t)un * 512 + lane; const u32x4* ps = (const u32x4*)(ws + WS_HALF + H_PSI) + (size_t)un * 512 + lane;
#pragma unroll
          for (int f = 0; f < 8; ++f) { nphi[f] = ph[f * 64]; npsi[f] = ps[f * 64]; } }
        bf16x8 Hp[2][2][2];
#pragma unroll
        for (int I = 0; I < 2; ++I)
#pragma unroll
            for (int J = 0; J < 2; ++J) { Hp[I][J][0] = pack<0>(H[I][J]); Hp[I][J][1] = pack<1>(H[I][J]); }
#pragma unroll
        for (int Ik = 0; Ik < 2; ++Ik)
#pragma unroll
            for (int Jv = 0; Jv < 2; ++Jv) {
                f32x16 a; const u32x4 p0 = psi[(Ik * 2 + Jv) * 2], p1 = psi[(Ik * 2 + Jv) * 2 + 1];
                a[0] = lo16(p0.x); a[1] = hi16(p0.x); a[2] = lo16(p0.y); a[3] = hi16(p0.y); a[4] = lo16(p0.z); a[5] = hi16(p0.z); a[6] = lo16(p0.w); a[7] = hi16(p0.w);
                a[8] = lo16(p1.x); a[9] = hi16(p1.x); a[10] = lo16(p1.y); a[11] = hi16(p1.y); a[12] = lo16(p1.z); a[13] = hi16(p1.z); a[14] = lo16(p1.w); a[15] = hi16(p1.w);
#pragma unroll
                for (int Ip = 0; Ip < 2; ++Ip) { a = RK_MF(__builtin_bit_cast(bf16x8, phi[(Ip * 2 + Ik) * 2 + 0]), Hp[Ip][Jv][0], a); a = RK_MF(__builtin_bit_cast(bf16x8, phi[(Ip * 2 + Ik) * 2 + 1]), Hp[Ip][Jv][1], a); }
                H[Ik][Jv] = a; }
        if (do_store) { u32x4* st = (u32x4*)(ws + WS_HALF + H_PSI) + (size_t)uprev * 512 + lane;
#pragma unroll
            for (int I = 0; I < 2; ++I)
#pragma unroll
                for (int J = 0; J < 2; ++J) { st[((I * 2 + J) * 2 + 0) * 64] = __builtin_bit_cast(u32x4, pack<0>(H[I][J])); st[((I * 2 + J) * 2 + 1) * 64] = __builtin_bit_cast(u32x4, pack<1>(H[I][J])); } }
        uprev = un;
#pragma unroll
        for (int f = 0; f < 8; ++f) { phi[f] = nphi[f]; psi[f] = npsi[f]; }
    }
    if (!do_store) { float chk = 0.f;
#pragma unroll
        for (int I = 0; I < 2; ++I)
#pragma unroll
            for (int J = 0; J < 2; ++J)
#pragma unroll
                for (int reg = 0; reg < 16; ++reg) chk += H[I][J][reg];
        if (chk == 123456.789f) ((float*)(ws + WS_END))[lane] = chk; }
}
RK_DI void pass2_half(unsigned char* ws, int q, int jv, int lane) {
    static_assert((NSUB - 1) % 3 == 0, "three-step rotation");
    const int dir = q & 1;
    bf16x8 Hp[2][2] = {{bf16x8{}, bf16x8{}}, {bf16x8{}, bf16x8{}}};
#define P2_LD(jj, PH, PS) do { const int jc_ = (jj) < NSUB - 1 ? (jj) : NSUB - 2; const int un_ = q * NSUB + chain_unit(dir, jc_); \
        const u32x4* ph_ = (const u32x4*)(ws + WS_HALF + H_PHI) + (size_t)un_ * 512 + lane; const u32x4* ps_ = (const u32x4*)(ws + WS_HALF + H_PSI) + (size_t)un_ * 512 + jv * 128 + lane; \
        _Pragma("unroll") for (int f = 0; f < 8; ++f) PH[f] = ph_[f * 64]; \
        PS[0] = ps_[0]; PS[1] = ps_[64]; PS[2] = ps_[256]; PS[3] = ps_[320]; } while (0)
#define P2_UNPK(A, p0, p1) do { A[0] = lo16(p0.x); A[1] = hi16(p0.x); A[2] = lo16(p0.y); A[3] = hi16(p0.y); A[4] = lo16(p0.z); A[5] = hi16(p0.z); A[6] = lo16(p0.w); A[7] = hi16(p0.w); \
        A[8] = lo16(p1.x); A[9] = hi16(p1.x); A[10] = lo16(p1.y); A[11] = hi16(p1.y); A[12] = lo16(p1.z); A[13] = hi16(p1.z); A[14] = lo16(p1.w); A[15] = hi16(p1.w); } while (0)
#define P2_STEP(jj, PH, PS) do { f32x16 a0, a1; P2_UNPK(a0, PS[0], PS[1]); P2_UNPK(a1, PS[2], PS[3]); \
        _Pragma("unroll") for (int Ip = 0; Ip < 2; ++Ip) { \
            a0 = RK_MF(__builtin_bit_cast(bf16x8, PH[(Ip * 2 + 0) * 2 + 0]), Hp[Ip][0], a0); a1 = RK_MF(__builtin_bit_cast(bf16x8, PH[(Ip * 2 + 1) * 2 + 0]), Hp[Ip][0], a1); \
            a0 = RK_MF(__builtin_bit_cast(bf16x8, PH[(Ip * 2 + 0) * 2 + 1]), Hp[Ip][1], a0); a1 = RK_MF(__builtin_bit_cast(bf16x8, PH[(Ip * 2 + 1) * 2 + 1]), Hp[Ip][1], a1); } \
        Hp[0][0] = pack<0>(a0); Hp[0][1] = pack<1>(a0); Hp[1][0] = pack<0>(a1); Hp[1][1] = pack<1>(a1); \
        u32x4* st_ = (u32x4*)(ws + WS_HALF + H_PSI) + (size_t)(q * NSUB + chain_unit(dir, (jj))) * 512 + jv * 128 + lane;        \
        st_[0] = __builtin_bit_cast(u32x4, Hp[0][0]); st_[64] = __builtin_bit_cast(u32x4, Hp[0][1]); st_[256] = __builtin_bit_cast(u32x4, Hp[1][0]); st_[320] = __builtin_bit_cast(u32x4, Hp[1][1]); } while (0)
    u32x4 phA[8], psA[4], phB[8], psB[4], phC[8], psC[4];
    P2_LD(0, phA, psA); P2_LD(1, phB, psB);
#pragma unroll 1
    for (int j = 0; j < NSUB - 1; j += 3) {
        P2_LD(j + 2, phC, psC); P2_STEP(j, phA, psA);
        P2_LD(j + 3, phA, psA); P2_STEP(j + 1, phB, psB);
        P2_LD(j + 4, phB, psB); P2_STEP(j + 2, phC, psC);
    }
#undef P2_LD
#undef P2_UNPK
#undef P2_STEP
}
RK_DI void pass3_dir(const int DIR, unsigned char* ws, LAS unsigned char* sb, int l, int bl, int hd, int c32, int lane, f32x16 (&Y)[2], float& bons) {
    Ctx c; setup_ctx(c, ws, sb, l, bl, hd, DIR, c32, lane);
    const int r = c.r, h = c.h;
    Tilde T; build_tilde<true>(c, T); __builtin_amdgcn_sched_barrier(0);
    bons += T.bon + __shfl_xor(T.bon, 32);
    bf16x8 Lk[2], Mp[2]; grams_la(c, T, Lk, Mp); __builtin_amdgcn_sched_barrier(0);
    bf16x8 Ab[2], Ak[2];
    {   f32x16 gb = f32x16{}, gk = f32x16{};
#pragma unroll
        for (int Ik = 0; Ik < 2; ++Ik)
#pragma unroll
            for (int S = 0; S < 2; ++S) { gb = RK_MF(T.Bt[Ik][S], T.Rt[Ik][S], gb); gk = RK_MF(T.Kt[Ik][S], T.Rt[Ik][S], gk); }
        tmask<false>(gb, r, h, DIR); tmask<false>(gk, r, h, DIR);
        Ab[0] = pack<0>(gb); Ab[1] = pack<1>(gb); Ak[0] = pack<0>(gk); Ak[1] = pack<1>(gk); }
    RK_STAGE(Ak[1]);
    bf16x8 H0p[2][2][2];
    { const int q = (bl * 8 + hd) * 2 + DIR, j = chain_pos(DIR, c32);
      if (j > 0) { const u32x4* st = (const u32x4*)(ws + WS_HALF + H_PSI) + (size_t)(q * NSUB + chain_unit(DIR, j - 1)) * 512 + lane;
#pragma unroll
          for (int I = 0; I < 2; ++I)
#pragma unroll
              for (int J = 0; J < 2; ++J) { H0p[I][J][0] = __builtin_bit_cast(bf16x8, st[((I * 2 + J) * 2 + 0) * 64]); H0p[I][J][1] = __builtin_bit_cast(bf16x8, st[((I * 2 + J) * 2 + 1) * 64]); } }
      else {
#pragma unroll
          for (int I = 0; I < 2; ++I)
#pragma unroll
              for (int J = 0; J < 2; ++J) { H0p[I][J][0] = bf16x8{}; H0p[I][J][1] = bf16x8{}; } } }
    bf16x8 Up[2][2];
    {   f32x16 xs[2];
#pragma unroll
        for (int Jv = 0; Jv < 2; ++Jv) {
            f32x16 x = RK_MF(Lk[0], T.Vp[Jv][0], f32x16{}); x = RK_MF(Lk[1], T.Vp[Jv][1], x);
#pragma unroll
            for (int Ik = 0; Ik < 2; ++Ik) { x = RK_MF(T.At[Ik][0], H0p[Ik][Jv][0], x); x = RK_MF(T.At[Ik][1], H0p[Ik][Jv][1], x); }
            xs[Jv] = x; }
        if (DIR) solve32p<1>(xs[0], xs[1], Mp); else solve32p<0>(xs[0], xs[1], Mp);
#pragma unroll
        for (int Jv = 0; Jv < 2; ++Jv) { Up[Jv][0] = pack<0>(xs[Jv]); Up[Jv][1] = pack<1>(xs[Jv]); }
        __builtin_amdgcn_sched_barrier(0); }
    __builtin_amdgcn_sched_barrier(0);
#pragma unroll
    for (int Iv = 0; Iv < 2; ++Iv) {
        f32x16 y = f32x16{};
#pragma unroll
        for (int Ik = 0; Ik < 2; ++Ik) { y = RK_MF(H0p[Ik][Iv][0], T.Rt[Ik][0], y); y = RK_MF(H0p[Ik][Iv][1], T.Rt[Ik][1], y); }
        y = RK_MF(Up[Iv][0], Ab[0], y); y = RK_MF(Up[Iv][1], Ab[1], y); y = RK_MF(T.Vp[Iv][0], Ak[0], y); y = RK_MF(T.Vp[Iv][1], Ak[1], y);
        Y[Iv] = y; }
}
RK_DI void pass3_unit(unsigned char* ws, LAS unsigned char* sb, int l, int v3, int lane, unsigned* ypark) {
    const int c32 = v3 % NSUB, bh = v3 / NSUB, bl = bh >> 3, hd = bh & 7, r = lane & 31, h = lane >> 5;
    float bons = 0.f;
    LAS float* ylds = (LAS float*)(sb + SBUF);
#pragma unroll 1
    for (int dir = 0; dir < 2; ++dir) {
        int lane_ = lane; asm volatile("" : "+v"(lane_));
        f32x16 Y[2]; pass3_dir(dir, ws, sb, l, bl, hd, c32, lane_, Y, bons);
        if (dir == 0) {
#pragma unroll
            for (int Iv = 0; Iv < 2; ++Iv)
#pragma unroll
                for (int d = 0; d < 8; ++d) ypark[(Iv * 8 + d) * 64 + lane] = cvt2(Y[Iv][2 * d], Y[Iv][2 * d + 1]); }
        else {
#pragma unroll
            for (int Iv = 0; Iv < 2; ++Iv)
#pragma unroll
                for (int reg = 0; reg < 16; ++reg) ylds[(Iv * 16 + reg) * 64 + lane] = Y[Iv][reg]; }
        __builtin_amdgcn_sched_barrier(0); }
    f32x16 YT[2];
#pragma unroll
    for (int Iv = 0; Iv < 2; ++Iv)
#pragma unroll
        for (int d = 0; d < 8; ++d) { const unsigned w = ypark[(Iv * 8 + d) * 64 + lane]; YT[Iv][2 * d] = ylds[(Iv * 16 + 2 * d) * 64 + lane] + lo16(w); YT[Iv][2 * d + 1] = ylds[(Iv * 16 + 2 * d + 1) * 64 + lane] + hi16(w); }
    Ctx c; setup_ctx(c, ws, sb, l, bl, hd, 0, c32, lane);
    RK_WAIT_LDS(); stage_slice(c, 1, RW_GD); stage_slice(c, 2, RW_GD + 64); RK_WAIT_DMA();
    float sm = 0.f;
#pragma unroll
    for (int Iv = 0; Iv < 2; ++Iv)
#pragma unroll
        for (int reg = 0; reg < 16; ++reg) sm += YT[Iv][reg];
    sm += __shfl_xor(sm, 32); const float mean = sm * (1.f / 64.f); float vq = 0.f;
#pragma unroll
    for (int Iv = 0; Iv < 2; ++Iv)
#pragma unroll
        for (int reg = 0; reg < 16; ++reg) { YT[Iv][reg] -= mean; vq += YT[Iv][reg] * YT[Iv][reg]; }
    vq += __shfl_xor(vq, 32); const float rstd = 1.f / sqrtf(vq * (1.f / 64.f) + LNX_EPS);
    const bf16* g2P = (const bf16*)(ws + WS_TAB + 524288) + (size_t)hd * 8192;
    const float* lnw = inp(I_LNW) + l * 512 + hd * 64; const float* lnb = inp(I_LNB) + l * 512 + hd * 64;
    bf16x8 sgp[4][2];
#pragma unroll
    for (int Ii = 0; Ii < 4; ++Ii) { f32x16 t = load_o2(c, 1 + (Ii >> 1), Ii & 1, RW_GD + 32 * Ii);
#pragma unroll
        for (int reg = 0; reg < 16; ++reg) t[reg] = sigm(t[reg]);
        sgp[Ii][0] = pack<0>(t); sgp[Ii][1] = pack<1>(t); __builtin_amdgcn_sched_barrier(0); }
    RK_WAIT_LDS(); LAS unsigned char* st = c.sb + SBUF;
#pragma unroll
    for (int Iv = 0; Iv < 2; ++Iv) {
        f32x16 gt = f32x16{};
#pragma unroll
        for (int Ii = 0; Ii < 4; ++Ii)
#pragma unroll
            for (int S = 0; S < 2; ++S) { gt = RK_MF(*(const bf16x8*)(g2P + ((Ii * 2 + Iv) * 2 + S) * 512 + c.lofs), sgp[Ii][S], gt); if (S) RK_STAGE(gt); }
        const f32x16 vt = load_o2(c, 0, Iv, RW_V + hd * 64 + 32 * Iv);
#pragma unroll
        for (int g = 0; g < 4; ++g) { const int v0 = 32 * Iv + 8 * g + 4 * h; const f32x4 lw = *(const f32x4*)(lnw + v0), lb = *(const f32x4*)(lnb + v0); float o[4];
#pragma unroll
            for (int j = 0; j < 4; ++j) { const int reg = 4 * g + j; o[j] = (YT[Iv][reg] * rstd * lw[j] + lb[j] + bons * vt[reg]) * gt[reg]; }
            *(LAS unsigned long long*)(st + r * 144 + 2 * v0) = (unsigned long long)cvt2(o[0], o[1]) | ((unsigned long long)cvt2(o[2], o[3]) << 32); }
    }
    asm volatile("s_waitcnt lgkmcnt(0)" ::: "memory");
    bf16* RO = (bf16*)(ws + WS_HALF + H_PP) + (size_t)c.m0 * PPW + C_QD + hd * 64;
#pragma unroll
    for (int i = 0; i < 4; ++i) { const int id = i * 64 + lane, row = id >> 3, ch = id & 7; const u32x4 v = *(const LAS u32x4*)(st + row * 144 + ch * 16); *(u32x4*)(RO + (size_t)row * PPW + ch * 8) = v; }
    asm volatile("s_waitcnt lgkmcnt(0)" ::: "memory");
}
}

__device__ __forceinline__ void ph_rwkv1(Frame& F, int l) {
    const int gw = F.bid * NWAVES + FWAVE(), NGW = F.G * NWAVES; LAS unsigned char* sb = F.lds + FWAVE() * (4 * rk::SBUF);
#pragma unroll 1
    for (int u = gw; u < NUNIT; u += NGW) rk::pass1_unit(F.ws, sb, l, u, otid() & 63);
    asm volatile("s_waitcnt vmcnt(0) lgkmcnt(0)" ::: "memory");
}
__device__ __forceinline__ void ph_rwkv3(Frame& F, int l, bool ctx_emit) {
    const int gw = F.bid * NWAVES + FWAVE(), NGW = F.G * NWAVES; LAS unsigned char* sb = F.lds + FWAVE() * (4 * rk::SBUF);
    unsigned* ypark = (unsigned*)(F.ws + WS_END) + (size_t)gw * 1024;
    const int per = ctx_emit ? rk::NSUB : rk::NSUB - 8, nun = 16 * per;
#pragma unroll 1
    for (int j = gw; j < nun; j += NGW) { const int v3 = (j / per) * rk::NSUB + (rk::NSUB - per) + j % per; rk::pass3_unit(F.ws, sb, l, v3, otid() & 63, ypark); }
    asm volatile("s_waitcnt vmcnt(0) lgkmcnt(0)" ::: "memory");
}
__device__ __forceinline__ void ph_mixer(Frame& F, int l, int half, int rep) {
    const bool ctx_out = (l == 0);
#ifdef EXTRA_P2
    if (F.bid < 4 && rep == 0) rk::pass2_chain(F.ws, F.bid * 8 + FWAVE(), otid() & 63, false);
#endif
    if (F.bid < 16 && rep == 0 && FWAVE() < 4) { const int ch = F.bid * 4 + FWAVE(); rk::pass2_half(F.ws, ch >> 1, ch & 1, otid() & 63); }
    __syncthreads();
    unsigned* ctr = F.ctl + CW_ATT + ((l * 2 + half) * 2 + rep) * 64;
    LAS unsigned* slot = (LAS unsigned*)(F.lds + MISC_OFF);
    const bf16* PP = (const bf16*)(F.ws + WS_HALF + H_PP); const bf16* QM = (const bf16*)(F.ws + WS_HALF + H_QM); const bf16* KVM = (const bf16*)(F.ws + WS_HALF + H_KVM);
    bf16* MO = (bf16*)(F.ws + WS_HALF + H_MO); bf16* DUM = (bf16*)(F.ws + WS_END);
    const int nunits = ctx_out ? 544 : 512;
    for (;;) {
        if (FTID() == 0) slot[0] = atomicAdd(ctr, 1u);
        __syncthreads();
        const int u = (int)slot[0];
        __syncthreads();
        if (u >= nunits) break;
        int type, bl, h, qb, nkeys, qrow0;
        if (u < 512) { type = u >> 8; const int v = u & 255; bl = v >> 7; h = (v >> 4) & 7; qb = v & 15; nkeys = RPB; qrow0 = bl * RPB + CTX + qb * 256; }
        else { const int v = u - 512; type = v >> 4; bl = (v >> 3) & 1; h = v & 7; qb = 0; nkeys = CTX; qrow0 = bl * RPB; }
        const int krow0 = bl * RPB;
        att::Args a;
        if (type == 0) {
            a.Q = QM + (size_t)qrow0 * 768 + h * 96; a.ldq = 768; a.K0 = KVM + (size_t)krow0 * 1024 + h * 128; a.ldk0 = 1024; a.K1 = PP + (size_t)krow0 * PPW + C_KR; a.ldk1 = PPW;
            a.V = KVM + (size_t)krow0 * 1024 + h * 128 + 64; a.ldv = 1024; a.O = (rep ? DUM : MO) + (size_t)qrow0 * 512 + h * 64; a.ldo = 512; a.nkeys = nkeys;
            a.rope_t0 = (u < 512) ? qb * 256 : -1; a.tc = (const float*)(F.ws + WS_T8C); a.ts = (const float*)(F.ws + WS_T8S);
            at96::Args b; b.Q = a.Q; b.ldq = a.ldq; b.K0 = a.K0; b.ldk0 = a.ldk0; b.K1 = a.K1; b.ldk1 = a.ldk1; b.V = a.V; b.ldv = a.ldv; b.O = a.O; b.ldo = a.ldo; b.nkeys = a.nkeys;
            b.rope_t0 = a.rope_t0; b.tc = a.tc; b.ts = a.ts;
            at96::unit(b, (char*)F.ldsg);
        } else {
            const int kvh = h >> 2;
            a.Q = PP + (size_t)qrow0 * PPW + C_GQ + h * 64; a.ldq = PPW; a.K0 = PP + (size_t)krow0 * PPW + C_GK + kvh * 64; a.ldk0 = PPW; a.K1 = a.K0; a.ldk1 = PPW;
            a.V = PP + (size_t)krow0 * PPW + C_GV + kvh * 64; a.ldv = PPW; a.O = rep ? DUM + (size_t)qrow0 * 512 + h * 64 : (bf16*)PP + (size_t)qrow0 * PPW + C_GQ + h * 64; a.ldo = rep ? 512 : PPW; a.nkeys = nkeys; a.rope_t0 = -1; a.tc = nullptr; a.ts = nullptr;
            at64::Args b; b.Q = a.Q; b.ldq = a.ldq; b.K = a.K0; b.ldk = a.ldk0; b.V = a.V; b.ldv = a.ldv; b.O = a.O; b.ldo = a.ldo; b.nkeys = a.nkeys;
            at64::unit(b, (char*)F.ldsg);
        }
    }
}

enum { OP_W0 = 0, OP_NORM1, OP_INPROJ, OP_PREP, OP_UP, OP_MIXER, OP_FINISH, OP_GATE, OP_MERGE, OP_WOUT, OP_NORM2, OP_FFUP, OP_FFDOWN, OP_FINAL };
constexpr int N_PHASES = 40;
__global__ void __launch_bounds__(NWAVES * 64, 2) trunk_fwd(Args args) {
    extern __shared__ __attribute__((aligned(16))) unsigned char lds[];
    Frame F;
    F.lds = (LAS unsigned char*)lds; F.ldsg = lds;
    F.G = gridDim.x; F.bid = blockIdx.x; F.ws = args.ws; F.ctl = (unsigned*)(args.ws + WS_CTL); F.out = args.out;
    volatile LAS unsigned* MISC = (volatile LAS unsigned*)(F.lds + MISC_OFF);
    for (int u = threadIdx.x; u < 32; u += NWAVES * 64) MISC[u] = 0u;
    __syncthreads();
    const int lo = args.ph_lo, hi = args.ph_hi;
    XcdBarrier bar = xcd_barrier_post(F.ctl + CW_BAR, MISC + 8);
#ifdef EXTRA_OP
    for (int pp = 2 * lo; pp < 2 * hi; ++pp) { const int p = pp >> 1, rep = pp & 1;
#else
    for (int p = lo; p < hi; ++p) { const int rep = 0;
#endif
        GAS unsigned char* wsg_ = (GAS unsigned char*)args.ws; GAS float* outg_ = (GAS float*)args.out; int bid_ = blockIdx.x, G_ = gridDim.x;
        asm volatile("" : "+s"(wsg_), "+s"(outg_), "+s"(bid_), "+s"(G_));
        unsigned char* ws = (unsigned char*)wsg_; float* outp = (float*)outg_;
        F.ws = ws; F.out = outp; F.bid = bid_; F.G = G_; F.ctl = (unsigned*)(ws + WS_CTL);
        unsigned char* wt = ws + WS_WT; const bf16* XN = (const bf16*)(ws + WS_XN); float* ctxx = (float*)(ws + WS_CTXX);
        int op, l = 0, half = 0;
        if (p == 0) op = OP_W0; else if (p == N_PHASES - 1) op = OP_FINAL;
        else { const int q = p - 1, r = q % 19; l = q / 19; if (r == 0) op = OP_NORM1; else if (r <= 8) { half = 0; op = OP_INPROJ + (r - 1); } else if (r <= 15) { half = 1; op = OP_PREP + (r - 9); } else op = OP_NORM2 + (r - 16); }
#ifdef ONLY_OP
        op = ONLY_OP;
#endif
#ifdef EXTRA_OP
        if (rep && op != EXTRA_OP) continue;
#endif
        const float* xl = (l == 0) ? inp(I_X) : F.out; const float* xc = (l == 0) ? inp(I_CTX) : ctxx;
        const bool ctx_out = (l == 0);
        const int nMf = ctx_out ? 68 : 64, nMh = ctx_out ? 34 : 32, skipf = ctx_out ? 0 : 1;
        switch (op) {
        case OP_W0: ph_weights(F, 0); break;
        case OP_NORM1: if (l == 1) ph_weights(F, 1); ph_norm(F, l, xl, xc, inp(I_G1) + l * DM, 0, false, (l == 1) ? (const float*)(ws + WS_END) : nullptr); break;
#define RUN_INPROJ(hh) do { pg8::Gemm g_{XN + (size_t)(hh) * HM * DM, (const bf16*)(wt + WT_IN), DM, DM, DM}; pg8::TileOrder S_; S_.init(HM / 256, PPW / 256, F.G, F.bid, 0); \
            pg8::Epi<pg8::EPI_BF16> E_{}; E_.O = (bf16*)(ws + WS_HALF + H_PP); E_.ldc = PPW; pg8::gemm_phase<pg8::Epi<pg8::EPI_BF16>, pg8::TileOrder, true>(F.lds, g_, S_, E_); } while (0)
        case OP_INPROJ: RUN_INPROJ(half); break;
        case OP_PREP: if (rep == 0) ph_prep(F, l, half); ph_rwkv1(F, l); break;
        case OP_UP: {
            { pg8::Gemm g{(const bf16*)(ws + WS_HALF + H_PP) + C_QD, (const bf16*)(wt + WT_QU), PPW, 384, 384}; pg8::TileOrder S; S.init(HM / 256, 3, F.G, F.bid, 0);
              pg8::Epi<pg8::EPI_ROWSCALE> E{}; E.O = (bf16*)(ws + WS_HALF + H_QM); E.ldc = 768; E.rs = (const float*)(ws + WS_RSQ);
              pg8::gemm_phase<pg8::Epi<pg8::EPI_ROWSCALE>, pg8::TileOrder, true>(F.lds, g, S, E); }
            { pg8::Gemm g{(const bf16*)(ws + WS_HALF + H_PP) + C_KVD, (const bf16*)(wt + WT_KVU), PPW, 256, 256}; pg8::TileOrder S; S.init(HM / 256, 4, F.G, (F.bid + 102) % F.G, 0);
              pg8::Epi<pg8::EPI_ROWSCALE> E{}; E.O = (bf16*)(ws + WS_HALF + H_KVM); E.ldc = 1024; E.rs = (const float*)(ws + WS_RSKV);
              pg8::gemm_phase<pg8::Epi<pg8::EPI_ROWSCALE>, pg8::TileOrder, true>(F.lds, g, S, E); } } break;
        case OP_MIXER: ph_mixer(F, l, half, rep); break;
        case OP_FINISH: ph_rwkv3(F, l, ctx_out); if (ctx_out) __syncthreads(); break;
        case OP_GATE: {
            const int gs = ctx_out ? 16 : 0;
            if (F.bid >= gs) { pg8::Gemm g{XN + (size_t)half * HM * DM, (const bf16*)(wt + WT_G), DM, DM, DM}; pg8::TileOrder S; S.init(nMh, 12, F.G - gs, F.bid - gs, skipf);
                pg8::Epi<pg8::EPI_SIGMOID> E{}; E.O = (bf16*)(ws + WS_G0); E.O1 = (bf16*)(ws + WS_G1); E.O2 = (bf16*)(ws + WS_G2); E.ldc = DM;
                pg8::gemm_phase<pg8::Epi<pg8::EPI_SIGMOID>, pg8::TileOrder, true>(F.lds, g, S, E); } } break;
        case OP_MERGE: {
            for (int i = 0; i < 3; ++i) {
                const bf16* A = (i == 0) ? (const bf16*)(ws + WS_HALF + H_PP) + C_GQ : (i == 1) ? (const bf16*)(ws + WS_HALF + H_PP) + C_QD : (const bf16*)(ws + WS_HALF + H_MO);
                pg8::Gemm g{A, (const bf16*)(wt + WT_BR) + (size_t)i * DM * 512, (i == 2) ? 512 : PPW, 512, 512}; pg8::TileOrder S; S.init(nMh, 4, F.G, F.bid, skipf);
                pg8::Epi<pg8::EPI_GATEMUL> E{}; E.O = (bf16*)(ws + WS_MIX); E.ldc = DM; E.G = (const bf16*)(ws + ((i == 0) ? WS_G0 : (i == 1) ? WS_G1 : WS_G2)); E.ldg = DM; E.first = (i == 0);
                pg8::gemm_phase<pg8::Epi<pg8::EPI_GATEMUL>, pg8::TileOrder, true>(F.lds, g, S, E); }
            } break;
        case OP_WOUT: {
            pg8::Gemm g{(const bf16*)(ws + WS_MIX), (const bf16*)(wt + WT_OUT), DM, DM, DM}; pg8::TileOrder S; S.init(nMh, 4, F.G, F.bid, skipf);
            pg8::Epi<pg8::EPI_RESID> E{}; E.xsl = xl; E.xsc = xc; E.xdl = F.out; E.xdc = ctxx; E.gate = (const float*)(ws + WS_MOD) + (size_t)l * 5 * 6144 + 2048; E.pm_off = half * 34; E.part = nullptr; E.kslice = 1;
            pg8::gemm_phase<pg8::Epi<pg8::EPI_RESID>, pg8::TileOrder, true>(F.lds, g, S, E);
            if (half == 0) RUN_INPROJ(1);
            } break;
        case OP_NORM2: ph_norm(F, l, F.out, ctxx, inp(I_G2) + l * DM, 1, !ctx_out); break;
        case OP_FFUP: {
            pg8::Gemm g{XN, (const bf16*)(wt + WT_F1), DM, DM, DM}; pg8::TileOrder S; S.init(nMf, 16, F.G, F.bid, skipf);
            pg8::Epi<pg8::EPI_RELU2> E{}; E.O = (bf16*)(ws + WS_HID); E.ldc = DFF;
            pg8::gemm_phase<pg8::Epi<pg8::EPI_RELU2>, pg8::TileOrder, true>(F.lds, g, S, E); } break;
        case OP_FFDOWN: {
            pg8::Gemm g{(const bf16*)(ws + WS_HID), (const bf16*)(wt + WT_F2), DFF, DFF, DFF}; pg8::TileOrder S; S.init(64, 4, F.G, F.bid, 1);
            pg8::Epi<pg8::EPI_RESID> E{}; E.xsl = F.out; E.xsc = ctxx; E.xdl = F.out; E.xdc = ctxx; E.gate = (const float*)(ws + WS_MOD) + (size_t)l * 5 * 6144 + 5120; E.pm_off = 0; E.part = nullptr; E.kslice = 1;
            pg8::gemm_phase<pg8::Epi<pg8::EPI_RESID>, pg8::TileOrder, true>(F.lds, g, S, E);
            if (ctx_out) { pg8::Gemm g2{(const bf16*)(ws + WS_HID), (const bf16*)(wt + WT_F2), DFF, DFF, DFF / 4}; pg8::CtxSplitOrder S2; S2.init(F.G, F.bid, DFF / 4);
                E.part = (float*)(ws + WS_END); E.kslice = DFF / 4; pg8::gemm_phase<pg8::Epi<pg8::EPI_RESID>, pg8::CtxSplitOrder, true>(F.lds, g2, S2, E); } } break;
        default: ph_final(F); break;
        }
        if (op == OP_FINISH && ctx_out) continue;
#ifdef EXTRA_OP
        if (pp + 1 < 2 * hi) xcd_barrier(bar);
#else
        if (p + 1 < hi) xcd_barrier(bar);
#endif
    }
}

extern "C" void kernel_launch(void* const* d_in, const int* in_sizes, int n_in, void* d_out, int out_size, void* d_ws, size_t ws_size, hipStream_t stream) {
    static int grid = 0;
    if (grid == 0) {
        if (n_in != 31 || out_size != NB * SEQ * DM || ws_size < WS_END + 12 * MiB) { fprintf(stderr, "kernel_launch: unexpected shapes (n_in %d out %d ws %zu, need ws >= %zu)\n", n_in, out_size, ws_size, (size_t)WS_END); grid = -1; return; }
        int dev = 0, cus = 0;
        if (hipGetDevice(&dev) != hipSuccess || hipDeviceGetAttribute(&cus, hipDeviceAttributeMultiprocessorCount, dev) != hipSuccess) { grid = -1; return; }
        if (hipFuncSetAttribute((const void*)trunk_fwd, hipFuncAttributeMaxDynamicSharedMemorySize, LDS_BYTES) != hipSuccess) { fprintf(stderr, "kernel_launch: hipFuncSetAttribute failed\n"); grid = -1; return; }
        grid = cus;
    }
    if (grid < 0) return;
    (void)hipMemsetAsync((char*)d_ws + WS_CTL, 0, CTL_BYTES, stream);
    Args a{};
    for (int i = 0; i < 31; ++i) a.in[i] = (const float*)d_in[i];
    a.out = (float*)d_out; a.ws = (unsigned char*)d_ws;
#if ONE_LAUNCH
    a.ph_lo = 0; a.ph_hi = N_PHASES;
    hipLaunchKernelGGL(trunk_fwd, dim3(grid), dim3(NWAVES * 64), LDS_BYTES, stream, a);
#else
    for (int p = 0; p < N_PHASES; ++p) { a.ph_lo = p; a.ph_hi = p + 1; hipLaunchKernelGGL(trunk_fwd, dim3(grid), dim3(NWAVES * 64), LDS_BYTES, stream, a); }
#endif
}
```

```cpp
#include <hip/hip_runtime.h>
#include <hip/hip_bf16.h>
#include <cstdio>
#include <cstdint>

#ifndef ONE_LAUNCH
#define ONE_LAUNCH 1
#define P3X_WGS 32
#define P2_WGS 8
#endif

constexpr int DM = 1024, NB = 4, SEQ = 4096, CTX = 256, RPB = SEQ + CTX  , MROWS = NB * RPB  , HM = 2 * RPB  ;
constexpr int NIN = 6432, PPW = 3584  , NGATE = 3072;
constexpr int C_GQ = 0, C_GK = 512, C_GV = 640, C_RW = 768, C_QD = 2688, C_KVD = 3072, C_KR = 3328, C_GATE = 3360;
constexpr int RW_R = 0, RW_K = 512, RW_V = 1024, RW_WD = 1536, RW_AD = 1664, RW_GD = 1792, RWIN = 1920;
constexpr int DFF = 4096;
constexpr float NORM_EPS = 1e-6f, LNX_EPS = 64e-5f;

__device__ __forceinline__ int otid() { int t = threadIdx.x; asm volatile("" : "+v"(t)); return t; }
namespace pg8 {
#define PG8_LAS __attribute__((address_space(3)))
typedef unsigned short bf16_t;
typedef short bf16x8 __attribute__((ext_vector_type(8)));
typedef float f32x4 __attribute__((ext_vector_type(4)));
typedef unsigned u32x4 __attribute__((ext_vector_type(4)));
constexpr int BM = 256, BK = 64, HALF = 128, HTB = HALF * BK * 2, STAGE_BYTES = 8 * HTB, NXCD = 8, WGM = 8;

__host__ __device__ __forceinline__ int lds_byte(int r, int c) { const int st = (r >> 4) * 2 + (c >> 5), rr = r & 15, cc = c & 31, ob = rr * 64 + cc * 2; return st * 1024 + (ob ^ (((ob >> 9) & 1) << 5)); }
__host__ __device__ __forceinline__ void stage_rc(int b, int& R, int& C) { const int st = b / 1024, sb = b % 1024, swz = sb ^ (((sb >> 9) & 1) << 5); R = (st >> 1) * 16 + swz / 64; C = (st & 1) * 32 + (swz % 64) / 2; }
__host__ __device__ __forceinline__ int perm32(int rho) { const int n = rho >> 4, i = rho & 15; return 8 * (i >> 2) + 4 * n + (i & 3); }

struct Unit { int pm, pn, ka; };
struct Gemm { const bf16_t* A; const bf16_t* Bt; int lda, ldb, K; };

struct TileOrder {
    int nM, nN, nwg, G, c, skipctx;
    __device__ void init(int nM_, int nN_, int G_, int c_, int skip_) { nM = nM_; nN = nN_; nwg = nM * nN; G = G_; c = c_; skipctx = skip_; }
    __device__ bool next(int i, Unit& u) const {
        const long L = (long)i * G + c; if (L >= nwg) return false;
        int wgid = (int)L; { const int q = nwg / NXCD, r = nwg % NXCD, xcd = wgid % NXCD, off = wgid / NXCD; wgid = (xcd < r ? xcd * (q + 1) : r * (q + 1) + (xcd - r) * q) + off; }
        const int nig = WGM * nN, gid = wgid / nig, fm = gid * WGM, gsz = (nM - fm) < WGM ? (nM - fm) : WGM;
        u.pm = fm + ((wgid % nig) % gsz); u.pn = (wgid % nig) / gsz; u.ka = 0;
        if (skipctx) u.pm = u.pm + u.pm / 16 + 1;
        return true;
    }
    __device__ __forceinline__ void a_ready(const Unit&) const {}
    __device__ __forceinline__ void done(const Unit&) const {}
};

struct CtxSplitOrder {
    int G, c, kslice;
    __device__ void init(int G_, int c_, int kslice_) { G = G_; c = c_; kslice = kslice_; }
    __device__ bool next(int i, Unit& u) const { const int L = i * G + c; if (L >= 64) return false; const int t = L >> 2; u.pm = (t >> 2) * 17; u.pn = t & 3; u.ka = (L & 3) * kslice; return true; }
    __device__ __forceinline__ void a_ready(const Unit&) const {}
    __device__ __forceinline__ void done(const Unit&) const {}
};
__device__ __forceinline__ unsigned cvt_pk_bf16(float lo, float hi) { unsigned r; asm volatile("v_cvt_pk_bf16_f32 %0, %1, %2" : "=v"(r) : "v"(lo), "v"(hi)); return r; }
__device__ __forceinline__ float bf_lo(unsigned w) { return __uint_as_float(w << 16); }
__device__ __forceinline__ float bf_hi(unsigned w) { return __uint_as_float(w & 0xffff0000u); }

enum { EPI_BF16 = 0, EPI_RELU2 = 1, EPI_SIGMOID = 2, EPI_ROWSCALE = 3, EPI_MLAQ = 4, EPI_GATEMUL0 = 5, EPI_GATEMUL = 6, EPI_RESID = 7 };
template <int MODE> struct Epi {
    static constexpr bool PERM = true, AFTER_DRAIN = false;
    bf16_t* O; int ldc;
    bf16_t* O1; bf16_t* O2;
    const float* rs;
    const bf16_t* G; int ldg;
    const float* tc; const float* ts;
    int first;
    int pm_off, kslice;
    float* part;
    const float* xsl; const float* xsc; float* xdl; float* xdc; const float* gate;
    __device__ __forceinline__ void operator()(const f32x4 (&acc)[2][2][4][2], const Unit& u, int wr, int wc, int fr, int fq) const {
        const int col0 = u.pn * BM + wc * 32 + 8 * fq;
        if constexpr (MODE == EPI_RESID) {
            const int gpm = u.pm + pm_off, b = gpm / 17, t = gpm % 17;
            const float* xs = (t == 0) ? xsc + (size_t)(b * CTX) * DM : xsl + (size_t)(b * SEQ + (t - 1) * 256) * DM;
            float* xd = (t == 0) ? xdc + (size_t)(b * CTX) * DM : xdl + (size_t)(b * SEQ + (t - 1) * 256) * DM;
            const float* gv = gate + (size_t)((t == 0) ? 4 : b) * 6144;
            f32x4 g[2][2];
#pragma unroll
            for (int bj = 0; bj < 2; ++bj)
#pragma unroll
                for (int n = 0; n < 2; ++n) g[bj][n] = *(const f32x4*)(gv + col0 + bj * HALF + 4 * n);
#pragma unroll
            for (int ai = 0; ai < 2; ++ai)
#pragma unroll
                for (int m = 0; m < 4; ++m) { const size_t ro = (size_t)(ai * HALF + wr * 64 + m * 16 + fr) * DM + col0;
#pragma unroll
                    for (int bj = 0; bj < 2; ++bj)
#pragma unroll
                        for (int n = 0; n < 2; ++n) {
                            if (u.ka != 0) *(f32x4*)(part + (size_t)(u.ka / kslice - 1) * 1048576 + (size_t)(b * CTX) * DM + ro + bj * HALF + 4 * n) = g[bj][n] * acc[ai][bj][m][n];
                            else { const f32x4 xv = *(const f32x4*)(xs + ro + bj * HALF + 4 * n);
                                *(f32x4*)(xd + ro + bj * HALF + 4 * n) = xv + g[bj][n] * acc[ai][bj][m][n]; } } }
        } else {
            const int row0 = u.pm * BM + wr * 64 + fr;
#pragma unroll
            for (int ai = 0; ai < 2; ++ai)
#pragma unroll
                for (int m = 0; m < 4; ++m) { const int row = row0 + ai * HALF + m * 16; bf16_t* rowp = O + (size_t)row * ldc + col0;
                    if constexpr (MODE == EPI_SIGMOID) { const int bi = u.pn >> 2; rowp += (long)(bi & 1) * (O1 - O) + (long)(bi >> 1) * (O2 - O) - bi * 4 * BM; }
                    float rsc = 1.f; int pr = 0, pc = 0; bool lat = false;
                    if constexpr (MODE == EPI_ROWSCALE || MODE == EPI_MLAQ) rsc = rs[row];
                    if constexpr (MODE == EPI_MLAQ) { const int s = row % RPB; lat = s >= CTX; const int tt = s - CTX; pr = (tt >> 6) & 63; pc = tt & 63; }
#pragma unroll
                    for (int bj = 0; bj < 2; ++bj) { f32x4 v0 = acc[ai][bj][m][0], v1 = acc[ai][bj][m][1];
                        if constexpr (MODE == EPI_RELU2) {
#pragma unroll
                            for (int e = 0; e < 4; ++e) { float a = fmaxf(v0[e], 0.f), b = fmaxf(v1[e], 0.f); v0[e] = a * a; v1[e] = b * b; } }
                        if constexpr (MODE == EPI_SIGMOID) {
#pragma unroll
                            for (int e = 0; e < 4; ++e) { v0[e] = 1.f / (1.f + __expf(-v0[e])); v1[e] = 1.f / (1.f + __expf(-v1[e])); } }
                        if constexpr (MODE == EPI_ROWSCALE || MODE == EPI_MLAQ) { v0 = v0 * rsc; v1 = v1 * rsc; }
                        if constexpr (MODE == EPI_MLAQ) {
                            const int g32 = u.pn * 8 + bj * 4 + wc;
                            if (g32 % 3 == 2) {
                                f32x4 p0, p1;
#pragma unroll
                                for (int e = 0; e < 4; ++e) { p0[e] = __shfl_xor(v0[e], 16); p1[e] = __shfl_xor(v1[e], 16); }
                                if (lat) { const int pos = (fq < 2) ? pr : pc; const f32x4 c0 = *(const f32x4*)(tc + pos * 8), c1 = *(const f32x4*)(tc + pos * 8 + 4), s0 = *(const f32x4*)(ts + pos * 8), s1 = *(const f32x4*)(ts + pos * 8 + 4);
                                    if ((fq & 1) == 0) { v0 = v0 * c0 - p0 * s0; v1 = v1 * c1 - p1 * s1; } else { v0 = p0 * s0 + v0 * c0; v1 = p1 * s1 + v1 * c1; } }
                            } }
                        if constexpr (MODE == EPI_GATEMUL0 || MODE == EPI_GATEMUL) {
                            const u32x4 gw = *(const u32x4*)(G + (size_t)row * ldg + col0 + bj * HALF);
                            v0[0] *= bf_lo(gw.x); v0[1] *= bf_hi(gw.x); v0[2] *= bf_lo(gw.y); v0[3] *= bf_hi(gw.y); v1[0] *= bf_lo(gw.z); v1[1] *= bf_hi(gw.z); v1[2] *= bf_lo(gw.w); v1[3] *= bf_hi(gw.w);
                            if (MODE == EPI_GATEMUL && !first) { const u32x4 ow = *(const u32x4*)(rowp + bj * HALF);
                                v0[0] += bf_lo(ow.x); v0[1] += bf_hi(ow.x); v0[2] += bf_lo(ow.y); v0[3] += bf_hi(ow.y); v1[0] += bf_lo(ow.z); v1[1] += bf_hi(ow.z); v1[2] += bf_lo(ow.w); v1[3] += bf_hi(ow.w); } }
                        u32x4 w; w.x = cvt_pk_bf16(v0[0], v0[1]); w.y = cvt_pk_bf16(v0[2], v0[3]); w.z = cvt_pk_bf16(v1[0], v1[1]); w.w = cvt_pk_bf16(v1[2], v1[3]);
                        *(u32x4*)(rowp + bj * HALF) = w; } }
        }
    }
};

template <class EpiT, class Sched, bool ALIGN_EPI>
__device__ __forceinline__ void gemm_phase(PG8_LAS unsigned char* lds, const Gemm g, const Sched& S, const EpiT& E) {
    const int tid = otid(), wid = __builtin_amdgcn_readfirstlane(tid >> 6), lane = tid & 63, wr = wid >> 2, wc = wid & 3, fr = lane & 15, fq = lane >> 4;
    const int nt = g.K / BK;
    unsigned voffA[2], voffB[2];
#pragma unroll
    for (int i = 0; i < 2; ++i) { int R, C; stage_rc(tid * 16 + i * 8192, R, C); const int Rb = EpiT::PERM ? ((R & ~31) + perm32(R & 31)) : R;
        voffA[i] = (unsigned)(R * g.lda + C) * 2u; voffB[i] = (unsigned)(Rb * g.ldb + C) * 2u; }
    const size_t kstep = (size_t)(BK * 2);
    const size_t hsA = (size_t)HALF * g.lda * 2, hsB = (size_t)HALF * g.ldb * 2, tsA = 2 * hsA, tsB = 2 * hsB;
    const unsigned ldsw = (unsigned)wid * 1024u;
    const int aoff = lds_byte(wr * 64 + fr, fq * 8), boff = lds_byte(wc * 32 + fr, fq * 8);
#define PG8_SA(b, h) (((b) * 2 + (h)) * HTB)
#define PG8_SB(b, h) ((4 + (b) * 2 + (h)) * HTB)
#define PG8_STAGE(bufoff, gbase, voff) do { _Pragma("unroll") for (int _i = 0; _i < 2; ++_i) \
        __builtin_amdgcn_global_load_lds((const unsigned*)((const char*)(gbase) + (voff)[_i]), (PG8_LAS unsigned*)(lds + (bufoff) + ldsw + _i * 8192), 16, 0, 0); } while (0)
#define PG8_LDA(dst, b, h) do { _Pragma("unroll") for (int m = 0; m < 4; ++m) _Pragma("unroll") for (int k = 0; k < 2; ++k) dst[m][k] = *(const PG8_LAS bf16x8*)(lds + PG8_SA(b, h) + aoff + m * 2048 + k * 1024); } while (0)
#define PG8_LDB(dst, b, h) do { _Pragma("unroll") for (int n = 0; n < 2; ++n) _Pragma("unroll") for (int k = 0; k < 2; ++k) dst[n][k] = *(const PG8_LAS bf16x8*)(lds + PG8_SB(b, h) + boff + n * 2048 + k * 1024); } while (0)
#define PG8_MMA(ai, bj, At, Bt) do { __builtin_amdgcn_s_setprio(1); _Pragma("unroll") for (int m = 0; m < 4; ++m) _Pragma("unroll") for (int n = 0; n < 2; ++n) _Pragma("unroll") for (int k = 0; k < 2; ++k) \
        acc[ai][bj][m][n] = __builtin_amdgcn_mfma_f32_16x16x32_bf16(Bt[n][k], At[m][k], acc[ai][bj][m][n], 0, 0, 0); __builtin_amdgcn_s_setprio(0); } while (0)
#define PG8_WAIT_V(n) asm volatile("s_waitcnt vmcnt(" #n ")" ::: "memory")
#define PG8_WAIT_L(n) asm volatile("s_waitcnt lgkmcnt(" #n ")" ::: "memory")
#define PG8_BAR __builtin_amdgcn_s_barrier()
#define PG8_SCHED __builtin_amdgcn_sched_barrier(0)
    Unit cur, nxt; int ui = 0;
    if (!S.next(0, cur)) return;
    f32x4 acc[2][2][4][2];
    float zf; asm volatile("v_mov_b32 %0, 0" : "=v"(zf));
#pragma unroll
    for (int a = 0; a < 2; ++a)
#pragma unroll
        for (int b = 0; b < 2; ++b)
#pragma unroll
            for (int m = 0; m < 4; ++m)
#pragma unroll
                for (int n = 0; n < 2; ++n) acc[a][b][m][n] = (f32x4){zf, zf, zf, zf};
    bf16x8 At[4][2], B0[2][2], B1[2][2];
    const char* cA = (const char*)g.A + (size_t)cur.pm * tsA + (size_t)cur.ka * 2; const char* cB = (const char*)g.Bt + (size_t)cur.pn * tsB + (size_t)cur.ka * 2;
    S.a_ready(cur);
    PG8_STAGE(PG8_SB(0, 0), cB, voffB); PG8_STAGE(PG8_SB(0, 1), cB + hsB, voffB); PG8_STAGE(PG8_SA(0, 0), cA, voffA); PG8_STAGE(PG8_SA(0, 1), cA + hsA, voffA);
    if (wr == 1) PG8_BAR;
    PG8_WAIT_V(2); PG8_BAR;
    PG8_STAGE(PG8_SB(1, 0), cB + kstep, voffB); PG8_STAGE(PG8_SA(1, 0), cA + kstep, voffA); PG8_STAGE(PG8_SB(1, 1), cB + hsB + kstep, voffB);
    PG8_WAIT_V(6); PG8_BAR;
    for (;;) {
        const bool has_next = S.next(ui + 1, nxt);
        const char* nA = has_next ? (const char*)g.A + (size_t)nxt.pm * tsA + (size_t)nxt.ka * 2 : cA; const char* nB = has_next ? (const char*)g.Bt + (size_t)nxt.pn * tsB + (size_t)nxt.ka * 2 : cB;
        for (int t = 0; t < nt; t += 2) {
            const bool last = (t == nt - 2);
            const char* a1 = cA + (size_t)(t + 1) * kstep;
            const char* a2 = last ? nA : cA + (size_t)(t + 2) * kstep; const char* b2 = last ? nB : cB + (size_t)(t + 2) * kstep;
            const char* a3 = a2 + kstep; const char* b3 = b2 + kstep;
            if (last && has_next) S.a_ready(nxt);
            PG8_LDB(B0, 0, 0); PG8_LDB(B1, 0, 1); PG8_SCHED; PG8_LDA(At, 0, 0); PG8_STAGE(PG8_SA(1, 1), a1 + hsA, voffA);
            PG8_WAIT_V(8); PG8_WAIT_L(0); PG8_BAR; PG8_MMA(0, 0, At, B0); PG8_MMA(0, 1, At, B1); PG8_BAR; PG8_SCHED;
            PG8_LDA(At, 0, 1); PG8_STAGE(PG8_SB(0, 0), b2, voffB); PG8_STAGE(PG8_SB(0, 1), b2 + hsB, voffB); PG8_STAGE(PG8_SA(0, 0), a2, voffA);
            PG8_WAIT_V(8); PG8_WAIT_L(0); PG8_BAR; PG8_MMA(1, 0, At, B0); PG8_MMA(1, 1, At, B1); PG8_BAR; PG8_SCHED;
            PG8_LDB(B0, 1, 0); PG8_LDB(B1, 1, 1); PG8_SCHED; PG8_LDA(At, 1, 0); PG8_STAGE(PG8_SA(0, 1), a2 + hsA, voffA);
            PG8_WAIT_V(8); PG8_WAIT_L(0); PG8_BAR; PG8_MMA(0, 0, At, B0); PG8_MMA(0, 1, At, B1); PG8_BAR; PG8_SCHED;
            PG8_LDA(At, 1, 1); PG8_STAGE(PG8_SB(1, 0), b3, voffB); PG8_STAGE(PG8_SB(1, 1), b3 + hsB, voffB); PG8_STAGE(PG8_SA(1, 0), a3, voffA);
            PG8_WAIT_V(8); PG8_WAIT_L(0); PG8_BAR; PG8_MMA(1, 0, At, B0); PG8_MMA(1, 1, At, B1); PG8_BAR; PG8_SCHED;
        }
        if constexpr (ALIGN_EPI) { if (wr == 0) PG8_BAR; }
        E(acc, cur, wr, wc, fr, fq); S.done(cur);
        if (!has_next) break;
        asm volatile("v_mov_b32 %0, 0" : "=v"(zf));
#pragma unroll
        for (int a = 0; a < 2; ++a)
#pragma unroll
            for (int b = 0; b < 2; ++b)
#pragma unroll
                for (int m = 0; m < 4; ++m)
#pragma unroll
                    for (int n = 0; n < 2; ++n) acc[a][b][m][n] = (f32x4){zf, zf, zf, zf};
        cur = nxt; cA = nA; cB = nB; ++ui;
        if constexpr (ALIGN_EPI) { if (wr == 1) PG8_BAR; }
    }
    PG8_WAIT_V(0);
    if constexpr (!ALIGN_EPI) { if (wr == 0) PG8_BAR; }
    PG8_BAR;
#undef PG8_SA
#undef PG8_SB
#undef PG8_STAGE
#undef PG8_LDA
#undef PG8_LDB
#undef PG8_MMA
#undef PG8_WAIT_V
#undef PG8_WAIT_L
#undef PG8_BAR
#undef PG8_SCHED
}
}

namespace att {
using bf16 = unsigned short;
using bf16x8 = __attribute__((ext_vector_type(8))) short;
using s16x4 = __attribute__((ext_vector_type(4))) short;
using f32x16 = __attribute__((ext_vector_type(16))) float;
using u32x4 = __attribute__((ext_vector_type(4))) unsigned;
constexpr int NW = 8, QBLK = 32, KVBLK = 64;
constexpr float THR = 8.f;
#define SBAR() __builtin_amdgcn_sched_barrier(0)
__device__ __forceinline__ int crow(int r, int hi) { return (r & 3) + 8 * (r >> 2) + 4 * hi; }
__device__ __forceinline__ unsigned cvtpk(float lo, float hi) { unsigned r; asm volatile("v_cvt_pk_bf16_f32 %0, %1, %2" : "=v"(r) : "v"(lo), "v"(hi)); return r; }
template <int DQ> __device__ __forceinline__ int kaddr(int row, int c) {
    if constexpr (DQ == 64) return row * 128 + ((c ^ ((row >> 1) & 7)) << 4); else return row * 208 + c * 16; }
template <int DQ> constexpr int ktile_bytes() { return DQ == 64 ? 64 * 128 : 64 * 208; }
constexpr int VTILE = 64 * 64 * 2;
template <int DQ> constexpr int lds_bytes() { return 2 * ktile_bytes<DQ>() + 2 * VTILE + NW * 64 * 4; }

template <bool FIRST> __device__ __forceinline__ void partialSM(f32x16& p0, f32x16& p1, f32x16& nm16, float& alpha) {
    float pmax = p0[0];
#pragma unroll
    for (int r = 1; r < 16; ++r) pmax = fmaxf(pmax, p0[r]);
#pragma unroll
    for (int r = 0; r < 16; ++r) pmax = fmaxf(pmax, p1[r]);
    { auto rr = __builtin_amdgcn_permlane32_swap(__float_as_uint(pmax), __float_as_uint(pmax), false, false);
      pmax = fmaxf(__uint_as_float(rr[0]), __uint_as_float(rr[1])); }
    alpha = 1.f;
    if (FIRST || !__builtin_expect(__all(pmax <= THR), 1)) {
        const float dl = FIRST ? pmax : fmaxf(pmax, 0.f); if (!FIRST) alpha = __builtin_amdgcn_exp2f(-dl);
#pragma unroll
        for (int r = 0; r < 16; ++r) { nm16[r] -= dl; p0[r] -= dl; p1[r] -= dl; } }
#pragma unroll
    for (int r = 0; r < 16; ++r) p0[r] = __builtin_amdgcn_exp2f(p0[r]);
}
__device__ __forceinline__ void finishSM(f32x16& p0, f32x16& p1, float alpha, float& l_reg, bf16x8& pa0, bf16x8& pa1, bf16x8& pa2, bf16x8& pa3) {
#pragma unroll
    for (int r = 0; r < 16; ++r) p1[r] = __builtin_amdgcn_exp2f(p1[r]);
    float ps = 0;
#pragma unroll
    for (int r = 0; r < 16; ++r) ps += p0[r];
#pragma unroll
    for (int r = 0; r < 16; ++r) ps += p1[r];
    { auto rr = __builtin_amdgcn_permlane32_swap(__float_as_uint(ps), __float_as_uint(ps), false, false);
      ps = __uint_as_float(rr[0]) + __uint_as_float(rr[1]); }
    l_reg = l_reg * alpha + ps;
#define PK4(P, BASE, OUT) do { unsigned a0 = cvtpk(P[BASE + 0], P[BASE + 1]), a1 = cvtpk(P[BASE + 2], P[BASE + 3]);   \
    unsigned b0 = cvtpk(P[BASE + 4], P[BASE + 5]), b1 = cvtpk(P[BASE + 6], P[BASE + 7]);                              \
    auto r0 = __builtin_amdgcn_permlane32_swap(a0, b0, false, false); auto r1 = __builtin_amdgcn_permlane32_swap(a1, b1, false, false); \
    u32x4 w = {r0[0], r1[0], r0[1], r1[1]}; OUT = *reinterpret_cast<bf16x8*>(&w); } while (0)
    PK4(p0, 0, pa0); PK4(p0, 8, pa1); PK4(p1, 0, pa2); PK4(p1, 8, pa3);
#undef PK4
}
template <int DQ> __device__ __forceinline__ void qkt(f32x16& p0, f32x16& p1, const char* Ks, const bf16x8* qr, int r32, int hi, const f32x16& nm16) {
    p0 = nm16; p1 = nm16;
#pragma unroll
    for (int d0 = 0; d0 < DQ / 16; ++d0) { const int c = d0 * 2 + hi;
        const bf16x8 b0 = *reinterpret_cast<const bf16x8*>(Ks + kaddr<DQ>(r32, c));
        const bf16x8 b1 = *reinterpret_cast<const bf16x8*>(Ks + kaddr<DQ>(32 + r32, c));
        p0 = __builtin_amdgcn_mfma_f32_32x32x16_bf16(b0, qr[d0], p0, 0, 0, 0);
        p1 = __builtin_amdgcn_mfma_f32_32x32x16_bf16(b1, qr[d0], p1, 0, 0, 0); }
}
__device__ __forceinline__ int v_st(int k, int c) { const int kk = (k & ~0xC) | ((k & 4) << 1) | ((k & 8) >> 1); return ((kk >> 3) * 2 + (c >> 5)) * 512 + ((kk & 7) * 32 + (c & 31)) * 2; }
__device__ __forceinline__ int v_rd_base(int lane) { return ((lane & 3) << 3) | (((lane >> 2) & 3) << 6) | (((lane >> 4) & 1) << 5) | (((lane >> 5) & 1) << 8); }
constexpr int v_rd_off(int d0, int ks, int half) { return d0 * 512 + ks * 2048 + half * 1024; }
template <int OFF> __device__ __forceinline__ s16x4 tr_read(int vb) { s16x4 r; asm volatile("ds_read_b64_tr_b16 %0, %1 offset:%2" : "=&v"(r) : "v"(vb), "i"(OFF) : "memory"); return r; }
template <int D0> __device__ __forceinline__ void pv_one(f32x16& od, int vb, bf16x8 pa0, bf16x8 pa1, bf16x8 pa2, bf16x8 pa3) {
    const s16x4 l0 = tr_read<v_rd_off(D0, 0, 0)>(vb), h0 = tr_read<v_rd_off(D0, 0, 1)>(vb), l1 = tr_read<v_rd_off(D0, 1, 0)>(vb), h1 = tr_read<v_rd_off(D0, 1, 1)>(vb);
    const s16x4 l2 = tr_read<v_rd_off(D0, 2, 0)>(vb), h2 = tr_read<v_rd_off(D0, 2, 1)>(vb), l3 = tr_read<v_rd_off(D0, 3, 0)>(vb), h3 = tr_read<v_rd_off(D0, 3, 1)>(vb);
    asm volatile("s_waitcnt lgkmcnt(0)" ::: "memory"); SBAR();
#define PK(L, H) (bf16x8){L[0], L[1], L[2], L[3], H[0], H[1], H[2], H[3]}
    od = __builtin_amdgcn_mfma_f32_32x32x16_bf16(pa0, PK(l0, h0), od, 0, 0, 0);
    od = __builtin_amdgcn_mfma_f32_32x32x16_bf16(pa1, PK(l1, h1), od, 0, 0, 0);
    od = __builtin_amdgcn_mfma_f32_32x32x16_bf16(pa2, PK(l2, h2), od, 0, 0, 0);
    od = __builtin_amdgcn_mfma_f32_32x32x16_bf16(pa3, PK(l3, h3), od, 0, 0, 0);
#undef PK
}
struct Args { const bf16* Q; int ldq; const bf16* K0; int ldk0; const bf16* K1; int ldk1; const bf16* V; int ldv; bf16* O; int ldo; int nkeys; int rope_t0; const float* tc; const float* ts; };
template <int DQ>
__device__ __forceinline__ void attn_unit(const Args a, char* lds) {
    constexpr int KT = ktile_bytes<DQ>(), NLD = (DQ == 64) ? 2 : 3;
    const int tid = otid(), wid = tid >> 6, lane = tid & 63, r32 = lane & 31, hi = lane >> 5;
    char* V_lds = lds; char* K_lds = lds + 2 * VTILE;
    float* ws = (float*)(lds + 2 * VTILE + 2 * KT) + wid * 64; float* li_l = ws; float* al_l = ws + 32;
    float l_reg = 0; f32x16 o[2] = {}; f32x16 nm16 = {}; bf16x8 qr[DQ / 16];
    const bf16* Qw = a.Q + (long)(wid * QBLK + r32) * a.ldq + hi * 8;
#pragma unroll
    for (int d0 = 0; d0 < DQ / 16; ++d0) qr[d0] = *reinterpret_cast<const bf16x8*>(Qw + d0 * 16);
    if constexpr (DQ == 96) { if (a.rope_t0 >= 0) {
        const int tq = a.rope_t0 + wid * QBLK + r32, pr = (tq >> 6) & 63, pc = tq & 63;
#pragma unroll
        for (int f = 4; f < 6; ++f) { const int pos = (f == 4) ? pr : pc; u32x4 w = *reinterpret_cast<u32x4*>(&qr[f]); u32x4 o;
#pragma unroll
            for (int e = 0; e < 4; ++e) { const unsigned mine = w[e], oth = (unsigned)__shfl_xor((int)mine, 32);
                const float m0 = __uint_as_float(mine << 16), m1 = __uint_as_float(mine & 0xffff0000u), o0 = __uint_as_float(oth << 16), o1 = __uint_as_float(oth & 0xffff0000u);
                const float c0 = a.tc[pos * 8 + 2 * e], c1 = a.tc[pos * 8 + 2 * e + 1], s0 = a.ts[pos * 8 + 2 * e], s1 = a.ts[pos * 8 + 2 * e + 1];
                const float r0 = (hi == 0) ? m0 * c0 - o0 * s0 : o0 * s0 + m0 * c0, r1 = (hi == 0) ? m1 * c1 - o1 * s1 : o1 * s1 + m1 * c1;
                o[e] = cvtpk(r0, r1); }
            qr[f] = *reinterpret_cast<bf16x8*>(&o); } } }
    const int vrow = tid >> 3, vcol = (tid & 7) * 8, vst = v_st(vrow, vcol);
    const bf16* vsrc = a.V + (long)vrow * a.ldv + vcol; const long vstep = (long)KVBLK * a.ldv;
    int kr0, kc0, kr1 = 0, kc1 = 0;
    if constexpr (DQ == 64) { kr0 = tid >> 3; kc0 = tid & 7; } else { kr0 = tid / 12; kc0 = tid % 12; const int id1 = 512 + (tid & 255); kr1 = id1 / 12; kc1 = id1 % 12; }
    const bf16* ksrc0 = (kc0 < 8) ? a.K0 + (long)kr0 * a.ldk0 + kc0 * 8 : a.K1 + (long)kr0 * a.ldk1 + (kc0 - 8) * 8; const long kstep0 = (long)KVBLK * ((kc0 < 8) ? a.ldk0 : a.ldk1);
    const bf16* ksrc1 = ksrc0; long kstep1 = kstep0;
    if constexpr (DQ == 96) { ksrc1 = (kc1 < 8) ? a.K0 + (long)kr1 * a.ldk0 + kc1 * 8 : a.K1 + (long)kr1 * a.ldk1 + (kc1 - 8) * 8; kstep1 = (long)KVBLK * ((kc1 < 8) ? a.ldk0 : a.ldk1); }
    const int kst0 = kaddr<DQ>(kr0, kc0), kst1 = kaddr<DQ>(kr1, kc1);
    const int vb0 = (int)(uintptr_t)V_lds + v_rd_base(lane);
    struct { bf16x8 vs, ks0, ks1; } sr_[2];
#define SLOAD(i, t) do { sr_[i].vs = *reinterpret_cast<const bf16x8*>(vsrc + (long)(t) * vstep); sr_[i].ks0 = *reinterpret_cast<const bf16x8*>(ksrc0 + (long)(t) * kstep0); \
    if constexpr (DQ == 96) sr_[i].ks1 = *reinterpret_cast<const bf16x8*>(ksrc1 + (long)(t) * kstep1); } while (0)
#define SWRITE(b, i) do { *(bf16x8*)(V_lds + (b) * VTILE + vst) = sr_[i].vs; *(bf16x8*)(K_lds + (b) * KT + kst0) = sr_[i].ks0; \
    if constexpr (DQ == 96) *(bf16x8*)(K_lds + (b) * KT + kst1) = sr_[i].ks1; } while (0)
#define SWAIT() do { if constexpr (NLD == 2) asm volatile("s_waitcnt vmcnt(2)" ::: "memory"); else asm volatile("s_waitcnt vmcnt(3)" ::: "memory"); } while (0)
#define RESC(al) do { if (__any((al) < 1.f)) { if (hi == 0) al_l[r32] = (al); asm volatile("s_waitcnt lgkmcnt(0)" ::: "memory"); \
    _Pragma("unroll") for (int d = 0; d < 2; ++d) _Pragma("unroll") for (int r = 0; r < 16; ++r) o[d][r] *= al_l[crow(r, hi)]; } } while (0)
    f32x16 pA0, pA1, pB0, pB1; float alA, alB; bf16x8 pa0, pa1, pa2, pa3; const int NT = a.nkeys / KVBLK;
    constexpr int SE = 0, SO = 1;
    SLOAD(SE, 0); asm volatile("s_waitcnt vmcnt(0)" ::: "memory"); SWRITE(0, SE); __syncthreads();
    qkt<DQ>(pA0, pA1, K_lds, qr, r32, hi, nm16); partialSM<true>(pA0, pA1, nm16, alA);
    SLOAD(SO, 1); if (2 < NT) SLOAD(SE, 2);
    SWAIT(); SWRITE(1, SO); __syncthreads();
    for (int j = 1; j + 1 < NT; j += 2) {
        SBAR(); qkt<DQ>(pB0, pB1, K_lds + KT, qr, r32, hi, nm16);
        finishSM(pA0, pA1, alA, l_reg, pa0, pa1, pa2, pa3); SBAR();
        SLOAD(SO, j + 2); SBAR();
        pv_one<0>(o[0], vb0, pa0, pa1, pa2, pa3); pv_one<1>(o[1], vb0, pa0, pa1, pa2, pa3); partialSM<false>(pB0, pB1, nm16, alB);
        __syncthreads(); SWAIT(); SWRITE(0, SE);
        RESC(alB); __syncthreads();
        SBAR(); qkt<DQ>(pA0, pA1, K_lds, qr, r32, hi, nm16);
        finishSM(pB0, pB1, alB, l_reg, pa0, pa1, pa2, pa3); SBAR();
        if (j + 3 < NT) SLOAD(SE, j + 3); SBAR();
        pv_one<0>(o[0], vb0 + VTILE, pa0, pa1, pa2, pa3); pv_one<1>(o[1], vb0 + VTILE, pa0, pa1, pa2, pa3); partialSM<false>(pA0, pA1, nm16, alA);
        __syncthreads(); SWAIT(); SWRITE(1, SO);
        RESC(alA); __syncthreads();
    }
    SBAR(); qkt<DQ>(pB0, pB1, K_lds + KT, qr, r32, hi, nm16);
    finishSM(pA0, pA1, alA, l_reg, pa0, pa1, pa2, pa3); SBAR();
    pv_one<0>(o[0], vb0, pa0, pa1, pa2, pa3); pv_one<1>(o[1], vb0, pa0, pa1, pa2, pa3); partialSM<false>(pB0, pB1, nm16, alB);
    __syncthreads(); RESC(alB);
    finishSM(pB0, pB1, alB, l_reg, pa0, pa1, pa2, pa3); SBAR();
    pv_one<0>(o[0], vb0 + VTILE, pa0, pa1, pa2, pa3); pv_one<1>(o[1], vb0 + VTILE, pa0, pa1, pa2, pa3);
    if (hi == 0) li_l[r32] = l_reg; asm volatile("s_waitcnt lgkmcnt(0)" ::: "memory");
    float rli[16];
#pragma unroll
    for (int r = 0; r < 16; ++r) rli[r] = __builtin_amdgcn_rcpf(li_l[crow(r, hi)]);
    __syncthreads();
    { unsigned short* stg = (unsigned short*)(lds) + wid * 2048;
#pragma unroll
      for (int r = 0; r < 16; ++r) { const int orow = crow(r, hi);
#pragma unroll
        for (int d0 = 0; d0 < 2; ++d0) { const float v = o[d0][r] * rli[r]; const unsigned u = __float_as_uint(v); stg[orow * 64 + d0 * 32 + r32] = (unsigned short)((u + 0x7fffu + ((u >> 16) & 1u)) >> 16); } }
      asm volatile("s_waitcnt lgkmcnt(0)" ::: "memory");
      bf16* Ow = a.O + (long)(wid * QBLK) * a.ldo;
#pragma unroll
      for (int i = 0; i < 4; ++i) { const int row = i * 8 + (lane >> 3), ch = lane & 7; const u32x4 v = *(const u32x4*)(stg + row * 64 + ch * 8); *(u32x4*)(Ow + (long)row * a.ldo + ch * 8) = v; } }
    __syncthreads();
#undef SLOAD
#undef SWRITE
#undef SWAIT
#undef RESC
}
#undef SBAR
}

namespace at64 {
using att::bf16; using att::bf16x8; using att::s16x4; using att::f32x16; using att::u32x4;
constexpr int NW = 8, QBLK = 32, KVBLK = 64;
constexpr float C2 = 0.125f * 1.4426950408889634f;
constexpr float THR = 8.f;
constexpr int SLOTB = 8192, LDS_K = 0, LDS_V = 3 * SLOTB, LDS_WS = 6 * SLOTB, LDS_OST = LDS_WS + NW * 256, LDS_TOT = LDS_OST + NW * 4096;
#define A6_SBAR() __builtin_amdgcn_sched_barrier(0)
#define A6_PIN(x) asm volatile("" : "+v"(x))
#define A6_MFMA(a, b, c) __builtin_amdgcn_mfma_f32_32x32x16_bf16(a, b, c, 0, 0, 0)
#define A6_WAIT_BAR(N) asm volatile("s_waitcnt vmcnt(" #N ") lgkmcnt(0)\n\ts_barrier" ::: "memory")
__device__ __forceinline__ int crow(int r, int hi) { return (r & 3) + 8 * (r >> 2) + 4 * hi; }
__device__ __forceinline__ unsigned cvtpk(float lo, float hi) { unsigned r; asm("v_cvt_pk_bf16_f32 %0, %1, %2" : "=v"(r) : "v"(lo), "v"(hi)); return r; }
__device__ __forceinline__ void glds16(const void* g, unsigned lds_base) {
    unsigned sv; asm volatile("s_mov_b32 %0, m0\n\ts_mov_b32 m0, %2\n\ts_nop 0\n\tglobal_load_lds_dwordx4 %1, off\n\ts_mov_b32 m0, %0" : "=&s"(sv) : "v"(g), "s"(lds_base) : "memory"); }
typedef __attribute__((address_space(3))) const char* lds_cptr;
typedef short v4i16_t __attribute__((ext_vector_type(4)));
__device__ __forceinline__ void kload2(bf16x8* kf, lds_cptr kp, int d0) { kf[2 * d0] = *(const __attribute__((address_space(3))) bf16x8*)(kp + d0 * 2048); kf[2 * d0 + 1] = *(const __attribute__((address_space(3))) bf16x8*)(kp + d0 * 2048 + 512); }
__device__ __forceinline__ s16x4 vtr(lds_cptr p) { return __builtin_bit_cast(s16x4, __builtin_amdgcn_ds_read_tr16_b64_v4i16((__attribute__((address_space(3))) v4i16_t*)p)); }
#define A6_MX3(a, b, c) __builtin_fmaxf(__builtin_fmaxf((a), (b)), (c))
__device__ __forceinline__ float rowmax(const f32x16& p0, const f32x16& p1) {
    float a = A6_MX3(p0[0], p0[1], p1[0]), b = A6_MX3(p0[2], p0[3], p1[1]); a = A6_MX3(a, p1[2], p1[3]);
#pragma unroll
    for (int r = 4; r < 16; r += 4) { a = A6_MX3(a, p0[r], p0[r + 1]); b = A6_MX3(b, p0[r + 2], p0[r + 3]); a = A6_MX3(a, p1[r], p1[r + 1]); b = A6_MX3(b, p1[r + 2], p1[r + 3]); }
    float m = __builtin_fmaxf(a, b); auto rr = __builtin_amdgcn_permlane32_swap(__float_as_uint(m), __float_as_uint(m), false, false);
    return __builtin_fmaxf(__uint_as_float(rr[0]), __uint_as_float(rr[1])); }
struct Args { const bf16* Q; int ldq; const bf16* K; int ldk; const bf16* V; int ldv; bf16* O; int ldo; int nkeys; };
__device__ __forceinline__ void unit(const Args a, char* lds) {
    const int tid = otid(), lane = tid & 63, r32 = lane & 31, hi = lane >> 5; const int wid = __builtin_amdgcn_readfirstlane(tid >> 6);
    const int NT = a.nkeys / KVBLK;
    const bf16* Qw = a.Q + (long)(wid * QBLK) * a.ldq;
    const unsigned lds0 = (unsigned)(uintptr_t)lds; float* wsf = (float*)(lds + LDS_WS) + wid * 64;
    const bf16* ksrc = a.K + (long)lane * a.ldk + wid * 8; const long kstep = (long)KVBLK * a.ldk;
    const bf16* vsrc = a.V + (long)(16 * (wid & 3) + (lane >> 2)) * a.ldv + (wid >> 2) * 32 + (lane & 3) * 8; const long vstep = (long)KVBLK * a.ldv;
    const unsigned kdst = lds0 + LDS_K + wid * 1024, vdst = lds0 + LDS_V + wid * 1024;
#define DMA_K(t, slot) glds16(ksrc + (long)(t) * kstep, (unsigned)__builtin_amdgcn_readfirstlane(kdst + (slot)))
#define DMA_V(t, slot) glds16(vsrc + (long)(t) * vstep, (unsigned)__builtin_amdgcn_readfirstlane(vdst + (slot)))
    const lds_cptr vp0 = (lds_cptr)lds + LDS_V + ((lane >> 4) & 1) * 32 + (lane & 3) * 8 + (4 * hi + ((lane & 15) >> 2)) * 64;
    const lds_cptr kp0 = (lds_cptr)lds + LDS_K + hi * 1024 + r32 * 16;
    DMA_K(0, 0); DMA_V(0, 0); DMA_K(1, SLOTB);
    bf16x8 qr[4];
#pragma unroll
    for (int d0 = 0; d0 < 4; ++d0) qr[d0] = *reinterpret_cast<const bf16x8*>(&Qw[(long)r32 * a.ldq + d0 * 16 + hi * 8]);
    float l_reg = 0.f; f32x16 o[2]; o[0] = f32x16{}; o[1] = f32x16{};
    f32x16 nmh16 = f32x16{}; A6_PIN(nmh16);
    bool resc = false;
    f32x16 pA0, pA1, pB0, pB1; bf16x8 kf[8]; s16x4 vlo[8], vhi[8]; u32x4 pw0, pw1, pw2, pw3;
    int sl_prev = 0, sl_cur = 0, sl_next = SLOTB;
#define ROT() do { sl_prev = sl_cur; sl_cur = sl_next; sl_next = (sl_next == 2 * SLOTB) ? 0 : sl_next + SLOTB; } while (0)
#define EX(v) __builtin_amdgcn_exp2f(v)
#define RESC() do { if (resc) { _Pragma("unroll") for (int d_ = 0; d_ < 2; ++d_) _Pragma("unroll") for (int r = 0; r < 16; ++r) o[d_][r] *= wsf[crow(r, hi)]; } } while (0)
    DMA_K(2, 2 * SLOTB);
    A6_WAIT_BAR(3);
    _Pragma("unroll") for (int d0 = 0; d0 < 4; ++d0) kload2(kf, kp0, d0);
    pA0 = A6_MFMA(kf[0], qr[0], nmh16); pA1 = A6_MFMA(kf[1], qr[0], nmh16); pA0 = A6_MFMA(kf[2], qr[1], pA0); pA1 = A6_MFMA(kf[3], qr[1], pA1);
    pA0 = A6_MFMA(kf[4], qr[2], pA0); pA1 = A6_MFMA(kf[5], qr[2], pA1); pA0 = A6_MFMA(kf[6], qr[3], pA0); pA1 = A6_MFMA(kf[7], qr[3], pA1);
    { const float rm = rowmax(pA0, pA1);
#pragma unroll
      for (int r = 0; r < 16; ++r) { nmh16[r] = -rm; pA0[r] = EX(pA0[r] - rm); pA1[r] = EX(pA1[r] - rm); } }
    A6_WAIT_BAR(0);
    DMA_K(3, 0); DMA_V(1, SLOTB); ROT();
    _Pragma("unroll") for (int d0 = 0; d0 < 4; ++d0) kload2(kf, kp0 + sl_cur, d0);
    A6_WAIT_BAR(2);
#define PKW(P, i) cvtpk(P[i], P[i + 1])
#define PAF(k) __builtin_bit_cast(bf16x8, pw##k)
#define VFR(i) (bf16x8){vlo[i][0], vlo[i][1], vlo[i][2], vlo[i][3], vhi[i][0], vhi[i][1], vhi[i][2], vhi[i][3]}
#define VRD(i) do { vlo[i] = vtr(vp_ + (((i) >> 2) * 4096 + ((i) & 3) * 1024)); vhi[i] = vtr(vp_ + (((i) >> 2) * 4096 + ((i) & 3) * 1024 + 512)); } while (0)
#define KRD(G, d0) do { if (G) { kload2(kf, kp0 + sl_next, d0); A6_SBAR(); } } while (0)
#define GAPA(MF, a0, a1, a2, a3, W0, W1, PW) do { MF; sacc += a0; sacc += a1; sacc += a2; sacc += a3; W0; W1; A6_PIN(PW); A6_PIN(sacc); A6_SBAR(); } while (0)
#define GAPB(MF, X, i) do { MF; X[i] = EX(X[i]); X[i + 1] = EX(X[i + 1]); X[i + 2] = EX(X[i + 2]); X[i + 3] = EX(X[i + 3]); A6_PIN(X); A6_SBAR(); } while (0)
#define STEP(C0, C1, P0, P1, t, GK, GV, GL) do { A6_SBAR(); \
    const lds_cptr vp_ = vp0 + sl_prev; \
    VRD(0); A6_SBAR(); float sacc = P0[0] + P0[1]; \
                       GAPA(C0 = A6_MFMA(kf[0], qr[0], nmh16), P0[2], P0[3], P0[4], P0[5],     pw0[0] = PKW(P0, 0),  pw0[1] = PKW(P0, 2),  pw0); \
    VRD(4); A6_SBAR(); GAPA(C1 = A6_MFMA(kf[1], qr[0], nmh16), P0[6], P0[7], P0[8], P0[9],     pw0[2] = PKW(P0, 4),  pw0[3] = PKW(P0, 6),  pw0); \
    VRD(1); A6_SBAR(); GAPA(C0 = A6_MFMA(kf[2], qr[1], C0),    P0[10], P0[11], P0[12], P0[13], pw1[0] = PKW(P0, 8),  pw1[1] = PKW(P0, 10), pw1); \
    VRD(5); A6_SBAR(); GAPA(C1 = A6_MFMA(kf[3], qr[1], C1),    P0[14], P0[15], P1[0], P1[1],   pw1[2] = PKW(P0, 12), pw1[3] = PKW(P0, 14), pw1); \
    VRD(2); A6_SBAR(); GAPA(C0 = A6_MFMA(kf[4], qr[2], C0),    P1[2], P1[3], P1[4], P1[5],     pw2[0] = PKW(P1, 0),  pw2[1] = PKW(P1, 2),  pw2); \
    VRD(6); A6_SBAR(); GAPA(C1 = A6_MFMA(kf[5], qr[2], C1),    P1[6], P1[7], P1[8], P1[9],     pw2[2] = PKW(P1, 4),  pw2[3] = PKW(P1, 6),  pw2); \
    VRD(3); A6_SBAR(); GAPA(C0 = A6_MFMA(kf[6], qr[3], C0),    P1[10], P1[11], P1[12], P1[13], pw3[0] = PKW(P1, 8),  pw3[1] = PKW(P1, 10), pw3); \
    VRD(7); A6_SBAR(); GAPA(C1 = A6_MFMA(kf[7], qr[3], C1),    P1[14], P1[15], 0.f, 0.f,       pw3[2] = PKW(P1, 12), pw3[3] = PKW(P1, 14), pw3); \
    l_reg += sacc; \
    if (GK) DMA_K((t) + 3, sl_cur); if (GV) DMA_V((t) + 1, sl_next); \
    { const float rm = rowmax(C0, C1); resc = false; \
      if (__builtin_expect(__any(rm > THR), 0)) { const float dl = __builtin_fmaxf(rm, 0.f); \
          _Pragma("unroll") for (int r_ = 0; r_ < 16; ++r_) { nmh16[r_] -= dl; C0[r_] -= dl; C1[r_] -= dl; } \
          const float f = __builtin_amdgcn_exp2f(-dl); l_reg *= f; if (hi == 0) wsf[r32] = f; resc = true; } } \
    A6_SBAR(); \
    GAPB(o[0] = A6_MFMA(PAF(0), VFR(0), o[0]), C0, 0);              GAPB(o[1] = A6_MFMA(PAF(0), VFR(4), o[1]), C0, 4); \
    KRD(GL, 0); GAPB(o[0] = A6_MFMA(PAF(1), VFR(1), o[0]), C0, 8);  KRD(GL, 1); GAPB(o[1] = A6_MFMA(PAF(1), VFR(5), o[1]), C0, 12); \
    KRD(GL, 2); GAPB(o[0] = A6_MFMA(PAF(2), VFR(2), o[0]), C1, 0);  KRD(GL, 3); GAPB(o[1] = A6_MFMA(PAF(2), VFR(6), o[1]), C1, 4); \
    GAPB(o[0] = A6_MFMA(PAF(3), VFR(3), o[0]), C1, 8);              GAPB(o[1] = A6_MFMA(PAF(3), VFR(7), o[1]), C1, 12); \
    } while (0)
    int t = 1;
    for (; t + 5 < NT; t += 2) {
        STEP(pB0, pB1, pA0, pA1, t, true, true, true);     A6_WAIT_BAR(2); RESC(); ROT();
        STEP(pA0, pA1, pB0, pB1, t + 1, true, true, true); A6_WAIT_BAR(2); RESC(); ROT();
    }
#define ENDW(tt) do { if ((tt) + 3 < NT) { A6_WAIT_BAR(2); } else if ((tt) + 2 < NT) { A6_WAIT_BAR(1); } else { A6_WAIT_BAR(0); } } while (0)
    for (; t + 1 < NT; t += 2) {
        STEP(pB0, pB1, pA0, pA1, t, (t + 3 < NT), (t + 1 < NT), (t + 1 < NT));         ENDW(t);     RESC(); ROT();
        STEP(pA0, pA1, pB0, pB1, t + 1, (t + 4 < NT), (t + 2 < NT), (t + 2 < NT));     ENDW(t + 1); RESC(); ROT();
    }
    STEP(pB0, pB1, pA0, pA1, NT - 1, false, false, false); RESC();
    { float sacc = pB0[0] + pB0[1];
#pragma unroll
      for (int r = 2; r < 16; ++r) sacc += pB0[r];
#pragma unroll
      for (int r = 0; r < 16; ++r) sacc += pB1[r];
      l_reg += sacc;
      pw0 = (u32x4){PKW(pB0, 0), PKW(pB0, 2), PKW(pB0, 4), PKW(pB0, 6)}; pw1 = (u32x4){PKW(pB0, 8), PKW(pB0, 10), PKW(pB0, 12), PKW(pB0, 14)};
      pw2 = (u32x4){PKW(pB1, 0), PKW(pB1, 2), PKW(pB1, 4), PKW(pB1, 6)}; pw3 = (u32x4){PKW(pB1, 8), PKW(pB1, 10), PKW(pB1, 12), PKW(pB1, 14)};
      const lds_cptr vp_ = vp0 + sl_cur; _Pragma("unroll") for (int i = 0; i < 8; ++i) VRD(i);
      o[0] = A6_MFMA(PAF(0), VFR(0), o[0]); o[1] = A6_MFMA(PAF(0), VFR(4), o[1]); o[0] = A6_MFMA(PAF(1), VFR(1), o[0]); o[1] = A6_MFMA(PAF(1), VFR(5), o[1]);
      o[0] = A6_MFMA(PAF(2), VFR(2), o[0]); o[1] = A6_MFMA(PAF(2), VFR(6), o[1]); o[0] = A6_MFMA(PAF(3), VFR(3), o[0]); o[1] = A6_MFMA(PAF(3), VFR(7), o[1]); }
    { auto rr = __builtin_amdgcn_permlane32_swap(__float_as_uint(l_reg), __float_as_uint(l_reg), false, false); l_reg = __uint_as_float(rr[0]) + __uint_as_float(rr[1]); }
    if (hi == 0) wsf[32 + r32] = l_reg; asm volatile("s_waitcnt lgkmcnt(0)" ::: "memory");
    float rli[16];
#pragma unroll
    for (int r = 0; r < 16; ++r) rli[r] = __builtin_amdgcn_rcpf(wsf[32 + crow(r, hi)]);
    bf16* Ow = a.O + (long)(wid * QBLK) * a.ldo; unsigned short* stg = (unsigned short*)(lds + LDS_OST) + wid * 2048;
#pragma unroll
    for (int r = 0; r < 16; ++r) { const int orow = crow(r, hi);
#pragma unroll
        for (int d0 = 0; d0 < 2; ++d0) { const float v = o[d0][r] * rli[r]; const unsigned u = __float_as_uint(v); stg[orow * 64 + d0 * 32 + r32] = (unsigned short)((u + 0x7fffu + ((u >> 16) & 1u)) >> 16); } }
    asm volatile("s_waitcnt lgkmcnt(0)" ::: "memory");
#pragma unroll
    for (int i = 0; i < 4; ++i) { const int row = i * 8 + (lane >> 3), ch = lane & 7; *(u32x4*)(Ow + (long)row * a.ldo + ch * 8) = *(const u32x4*)(stg + row * 64 + ch * 8); }
    asm volatile("s_waitcnt lgkmcnt(0)\n\ts_barrier" ::: "memory");
#undef DMA_K
#undef DMA_V
#undef ROT
#undef EX
#undef RESC
#undef PKW
#undef PAF
#undef VFR
#undef VRD
#undef KRD
#undef ENDW
#undef GAPA
#undef GAPB
#undef STEP
}
#undef A6_SBAR
#undef A6_PIN
#undef A6_MFMA
#undef A6_WAIT_BAR
#undef A6_MX3
}

namespace at96 {
using att::bf16; using att::bf16x8; using att::s16x4; using att::f32x16; using att::u32x4;
using at64::crow; using at64::cvtpk; using at64::glds16; using at64::lds_cptr; using at64::kload2; using at64::vtr; using at64::rowmax;
constexpr int NW = 8, QBLK = 32, KVBLK = 64;
constexpr float THR = 8.f;
constexpr int SLOTB = 8192, SLOTR = 4096, LDS_K = 0, LDS_V = 3 * SLOTB, LDS_R = 6 * SLOTB, LDS_WS = LDS_R + 4 * SLOTR, LDS_OST = LDS_WS + NW * 256, LDS_TOT = LDS_OST + NW * 4096;
#define A9_SBAR() __builtin_amdgcn_sched_barrier(0)
#define A9_PIN(x) asm volatile("" : "+v"(x))
#define A9_MFMA(a, b, c) __builtin_amdgcn_mfma_f32_32x32x16_bf16(a, b, c, 0, 0, 0)
#define A9_WAIT_BAR(N) asm volatile("s_waitcnt vmcnt(" #N ") lgkmcnt(0)\n\ts_barrier" ::: "memory")
struct Args { const bf16* Q; int ldq; const bf16* K0; int ldk0; const bf16* K1; int ldk1; const bf16* V; int ldv; bf16* O; int ldo; int nkeys; int rope_t0; const float* tc; const float* ts; };
__device__ __forceinline__ void unit(const Args a, char* lds) {
    const int tid = otid(), lane = tid & 63, r32 = lane & 31, hi = lane >> 5; const int wid = __builtin_amdgcn_readfirstlane(tid >> 6);
    const int NT = a.nkeys / KVBLK;
    const bf16* Qw = a.Q + (long)(wid * QBLK) * a.ldq;
    const unsigned lds0 = (unsigned)(uintptr_t)lds; float* wsf = (float*)(lds + LDS_WS) + wid * 64;
    const bf16* ksrc = a.K0 + (long)lane * a.ldk0 + wid * 8; const long kstep = (long)KVBLK * a.ldk0;
    const bf16* rsrc = a.K1 + (long)(32 * (wid & 1) + r32) * a.ldk1 + (wid >> 1) * 8; const long rstep = (long)KVBLK * a.ldk1;
    const bf16* vsrc = a.V + (long)(16 * (wid & 3) + (lane >> 2)) * a.ldv + (wid >> 2) * 32 + (lane & 3) * 8; const long vstep = (long)KVBLK * a.ldv;
    const unsigned kdst = lds0 + LDS_K + wid * 1024, vdst = lds0 + LDS_V + wid * 1024, rdst = lds0 + LDS_R + (wid >> 1) * 1024 + (wid & 1) * 512;
#define DMA_K(t, slot, rslot) do { glds16(ksrc + (long)(t) * kstep, (unsigned)__builtin_amdgcn_readfirstlane(kdst + (slot))); \
        if (lane < 32) glds16(rsrc + (long)(t) * rstep, (unsigned)__builtin_amdgcn_readfirstlane(rdst + (rslot))); } while (0)
#define DMA_V(t, slot) glds16(vsrc + (long)(t) * vstep, (unsigned)__builtin_amdgcn_readfirstlane(vdst + (slot)))
    const lds_cptr vp0 = (lds_cptr)lds + LDS_V + ((lane >> 4) & 1) * 32 + (lane & 3) * 8 + (4 * hi + ((lane & 15) >> 2)) * 64;
    const lds_cptr kp0 = (lds_cptr)lds + LDS_K + hi * 1024 + r32 * 16;
    const lds_cptr rp0 = (lds_cptr)lds + LDS_R + hi * 1024 + r32 * 16;
    DMA_K(0, 0, 0); DMA_V(0, 0); DMA_K(1, SLOTB, SLOTR);
    bf16x8 qr[6];
#pragma unroll
    for (int d0 = 0; d0 < 6; ++d0) qr[d0] = *reinterpret_cast<const bf16x8*>(&Qw[(long)r32 * a.ldq + d0 * 16 + hi * 8]);
    if (a.rope_t0 >= 0) {
        const int tq = a.rope_t0 + wid * QBLK + r32, pr = (tq >> 6) & 63, pc = tq & 63;
#pragma unroll
        for (int f = 4; f < 6; ++f) { const int pos = (f == 4) ? pr : pc; u32x4 w = *reinterpret_cast<u32x4*>(&qr[f]); u32x4 o_;
#pragma unroll
            for (int e = 0; e < 4; ++e) { const unsigned mine = w[e], oth = (unsigned)__shfl_xor((int)mine, 32);
                const float m0 = __uint_as_float(mine << 16), m1 = __uint_as_float(mine & 0xffff0000u), o0 = __uint_as_float(oth << 16), o1 = __uint_as_float(oth & 0xffff0000u);
                const float c0 = a.tc[pos * 8 + 2 * e], c1 = a.tc[pos * 8 + 2 * e + 1], s0 = a.ts[pos * 8 + 2 * e], s1 = a.ts[pos * 8 + 2 * e + 1];
                const float r0 = (hi == 0) ? m0 * c0 - o0 * s0 : o0 * s0 + m0 * c0, r1 = (hi == 0) ? m1 * c1 - o1 * s1 : o1 * s1 + m1 * c1;
                o_[e] = cvtpk(r0, r1); }
            qr[f] = *reinterpret_cast<bf16x8*>(&o_); } }
    float l_reg = 0.f; f32x16 o[2]; o[0] = f32x16{}; o[1] = f32x16{};
    f32x16 nmh16 = f32x16{}; A9_PIN(nmh16);
    bool resc = false;
    f32x16 pA0, pA1, pB0, pB1; bf16x8 kf[8], kr[4]; s16x4 vlo[8], vhi[8]; u32x4 pw0, pw1, pw2, pw3;
    int sl_prev = 0, sl_cur = 0, sl_next = SLOTB, rs_cur = 0;
#define ROT() do { sl_prev = sl_cur; sl_cur = sl_next; sl_next = (sl_next == 2 * SLOTB) ? 0 : sl_next + SLOTB; rs_cur = (rs_cur + SLOTR) & (4 * SLOTR - 1); } while (0)
#define RS3() ((rs_cur + 3 * SLOTR) & (4 * SLOTR - 1))
#define EX(v) __builtin_amdgcn_exp2f(v)
#define RESC() do { if (resc) { _Pragma("unroll") for (int d_ = 0; d_ < 2; ++d_) _Pragma("unroll") for (int r = 0; r < 16; ++r) o[d_][r] *= wsf[crow(r, hi)]; } } while (0)
    DMA_K(2, 2 * SLOTB, 2 * SLOTR);
    A9_WAIT_BAR(5);
    _Pragma("unroll") for (int d0 = 0; d0 < 4; ++d0) kload2(kf, kp0, d0);
    kload2(kr, rp0, 0); kload2(kr, rp0, 1);
    pA0 = A9_MFMA(kf[0], qr[0], nmh16); pA1 = A9_MFMA(kf[1], qr[0], nmh16); pA0 = A9_MFMA(kf[2], qr[1], pA0); pA1 = A9_MFMA(kf[3], qr[1], pA1);
    pA0 = A9_MFMA(kf[4], qr[2], pA0); pA1 = A9_MFMA(kf[5], qr[2], pA1); pA0 = A9_MFMA(kf[6], qr[3], pA0); pA1 = A9_MFMA(kf[7], qr[3], pA1);
    pA0 = A9_MFMA(kr[0], qr[4], pA0); pA1 = A9_MFMA(kr[1], qr[4], pA1); pA0 = A9_MFMA(kr[2], qr[5], pA0); pA1 = A9_MFMA(kr[3], qr[5], pA1);
    { const float rm = rowmax(pA0, pA1);
#pragma unroll
      for (int r = 0; r < 16; ++r) { nmh16[r] = -rm; pA0[r] = EX(pA0[r] - rm); pA1[r] = EX(pA1[r] - rm); } }
    A9_WAIT_BAR(0);
    DMA_K(3, 0, 3 * SLOTR); DMA_V(1, SLOTB); ROT();
    _Pragma("unroll") for (int d0 = 0; d0 < 4; ++d0) kload2(kf, kp0 + sl_cur, d0);
    A9_WAIT_BAR(3);
#define PKW(P, i) cvtpk(P[i], P[i + 1])
#define PAF(k) __builtin_bit_cast(bf16x8, pw##k)
#define VFR(i) (bf16x8){vlo[i][0], vlo[i][1], vlo[i][2], vlo[i][3], vhi[i][0], vhi[i][1], vhi[i][2], vhi[i][3]}
#define VRD(i) do { vlo[i] = vtr(vp_ + (((i) >> 2) * 4096 + ((i) & 3) * 1024)); vhi[i] = vtr(vp_ + (((i) >> 2) * 4096 + ((i) & 3) * 1024 + 512)); } while (0)
#define KRD(G, d0) do { if (G) { kload2(kf, kp0 + sl_next, d0); A9_SBAR(); } } while (0)
#define GAP3(MF, a0, a1, a2, W0, PW) do { MF; sacc += a0; sacc += a1; sacc += a2; W0; A9_PIN(PW); A9_PIN(sacc); A9_SBAR(); } while (0)
#define GAP2(MF, a0, a1, W0, W1, PW) do { MF; sacc += a0; sacc += a1; W0; W1; A9_PIN(PW); A9_PIN(sacc); A9_SBAR(); } while (0)
#define GAPB(MF, X, i) do { MF; X[i] = EX(X[i]); X[i + 1] = EX(X[i + 1]); X[i + 2] = EX(X[i + 2]); X[i + 3] = EX(X[i + 3]); A9_PIN(X); A9_SBAR(); } while (0)
#define STEP(C0, C1, P0, P1, t, GK, GV, GL) do { A9_SBAR(); \
    const lds_cptr vp_ = vp0 + sl_prev; const lds_cptr rp_ = rp0 + rs_cur; \
    VRD(0); kload2(kr, rp_, 0); A9_SBAR(); float sacc = P0[0] + P0[1]; \
                       GAP3(C0 = A9_MFMA(kf[0], qr[0], nmh16), P0[2], P0[3], P0[4],    pw0[0] = PKW(P0, 0), pw0); \
    VRD(4); kload2(kr, rp_, 1); A9_SBAR(); \
                       GAP3(C1 = A9_MFMA(kf[1], qr[0], nmh16), P0[5], P0[6], P0[7],    pw0[1] = PKW(P0, 2), pw0); \
    VRD(1); A9_SBAR(); GAP2(C0 = A9_MFMA(kf[2], qr[1], C0),    P0[8], P0[9],           pw0[2] = PKW(P0, 4), pw0[3] = PKW(P0, 6), pw0); \
    VRD(5); A9_SBAR(); GAP3(C1 = A9_MFMA(kf[3], qr[1], C1),    P0[10], P0[11], P0[12], pw1[0] = PKW(P0, 8), pw1); \
    VRD(2); A9_SBAR(); GAP3(C0 = A9_MFMA(kf[4], qr[2], C0),    P0[13], P0[14], P0[15], pw1[1] = PKW(P0, 10), pw1); \
    VRD(6); A9_SBAR(); GAP2(C1 = A9_MFMA(kf[5], qr[2], C1),    P1[0], P1[1],           pw1[2] = PKW(P0, 12), pw1[3] = PKW(P0, 14), pw1); \
    VRD(3); A9_SBAR(); GAP3(C0 = A9_MFMA(kf[6], qr[3], C0),    P1[2], P1[3], P1[4],    pw2[0] = PKW(P1, 0), pw2); \
    VRD(7); A9_SBAR(); GAP3(C1 = A9_MFMA(kf[7], qr[3], C1),    P1[5], P1[6], P1[7],    pw2[1] = PKW(P1, 2), pw2); \
                       GAP2(C0 = A9_MFMA(kr[0], qr[4], C0),    P1[8], P1[9],           pw2[2] = PKW(P1, 4), pw2[3] = PKW(P1, 6), pw2); \
                       GAP3(C1 = A9_MFMA(kr[1], qr[4], C1),    P1[10], P1[11], P1[12], pw3[0] = PKW(P1, 8), pw3); \
                       GAP3(C0 = A9_MFMA(kr[2], qr[5], C0),    P1[13], P1[14], P1[15], pw3[1] = PKW(P1, 10), pw3); \
                       GAP2(C1 = A9_MFMA(kr[3], qr[5], C1),    0.f, 0.f,               pw3[2] = PKW(P1, 12), pw3[3] = PKW(P1, 14), pw3); \
    l_reg += sacc; \
    if (GK) DMA_K((t) + 3, sl_cur, RS3()); if (GV) DMA_V((t) + 1, sl_next); \
    { const float rm = rowmax(C0, C1); resc = false; \
      if (__builtin_expect(__any(rm > THR), 0)) { const float dl = __builtin_fmaxf(rm, 0.f); \
          _Pragma("unroll") for (int r_ = 0; r_ < 16; ++r_) { nmh16[r_] -= dl; C0[r_] -= dl; C1[r_] -= dl; } \
          const float f = __builtin_amdgcn_exp2f(-dl); l_reg *= f; if (hi == 0) wsf[r32] = f; resc = true; } } \
    A9_SBAR(); \
    GAPB(o[0] = A9_MFMA(PAF(0), VFR(0), o[0]), C0, 0);              GAPB(o[1] = A9_MFMA(PAF(0), VFR(4), o[1]), C0, 4); \
    KRD(GL, 0); GAPB(o[0] = A9_MFMA(PAF(1), VFR(1), o[0]), C0, 8);  KRD(GL, 1); GAPB(o[1] = A9_MFMA(PAF(1), VFR(5), o[1]), C0, 12); \
    KRD(GL, 2); GAPB(o[0] = A9_MFMA(PAF(2), VFR(2), o[0]), C1, 0);  KRD(GL, 3); GAPB(o[1] = A9_MFMA(PAF(2), VFR(6), o[1]), C1, 4); \
    GAPB(o[0] = A9_MFMA(PAF(3), VFR(3), o[0]), C1, 8);              GAPB(o[1] = A9_MFMA(PAF(3), VFR(7), o[1]), C1, 12); \
    } while (0)
    int t = 1;
    for (; t + 5 < NT; t += 2) {
        STEP(pB0, pB1, pA0, pA1, t, true, true, true);     A9_WAIT_BAR(3); RESC(); ROT();
        STEP(pA0, pA1, pB0, pB1, t + 1, true, true, true); A9_WAIT_BAR(3); RESC(); ROT();
    }
#define ENDW(tt) do { if ((tt) + 3 < NT) { A9_WAIT_BAR(3); } else if ((tt) + 2 < NT) { A9_WAIT_BAR(1); } else { A9_WAIT_BAR(0); } } while (0)
    for (; t + 1 < NT; t += 2) {
        STEP(pB0, pB1, pA0, pA1, t, (t + 3 < NT), (t + 1 < NT), (t + 1 < NT));         ENDW(t);     RESC(); ROT();
        STEP(pA0, pA1, pB0, pB1, t + 1, (t + 4 < NT), (t + 2 < NT), (t + 2 < NT));     ENDW(t + 1); RESC(); ROT();
    }
    STEP(pB0, pB1, pA0, pA1, NT - 1, false, false, false); RESC();
    { float sacc = pB0[0] + pB0[1];
#pragma unroll
      for (int r = 2; r < 16; ++r) sacc += pB0[r];
#pragma unroll
      for (int r = 0; r < 16; ++r) sacc += pB1[r];
      l_reg += sacc;
      pw0 = (u32x4){PKW(pB0, 0), PKW(pB0, 2), PKW(pB0, 4), PKW(pB0, 6)}; pw1 = (u32x4){PKW(pB0, 8), PKW(pB0, 10), PKW(pB0, 12), PKW(pB0, 14)};
      pw2 = (u32x4){PKW(pB1, 0), PKW(pB1, 2), PKW(pB1, 4), PKW(pB1, 6)}; pw3 = (u32x4){PKW(pB1, 8), PKW(pB1, 10), PKW(pB1, 12), PKW(pB1, 14)};
      const lds_cptr vp_ = vp0 + sl_cur; _Pragma("unroll") for (int i = 0; i < 8; ++i) VRD(i);
      o[0] = A9_MFMA(PAF(0), VFR(0), o[0]); o[1] = A9_MFMA(PAF(0), VFR(4), o[1]); o[0] = A9_MFMA(PAF(1), VFR(1), o[0]); o[1] = A9_MFMA(PAF(1), VFR(5), o[1]);
      o[0] = A9_MFMA(PAF(2), VFR(2), o[0]); o[1] = A9_MFMA(PAF(2), VFR(6), o[1]); o[0] = A9_MFMA(PAF(3), VFR(3), o[0]); o[1] = A9_MFMA(PAF(3), VFR(7), o[1]); }
    { auto rr = __builtin_amdgcn_permlane32_swap(__float_as_uint(l_reg), __float_as_uint(l_reg), false, false); l_reg = __uint_as_float(rr[0]) + __uint_as_float(rr[1]); }
    if (hi == 0) wsf[32 + r32] = l_reg; asm volatile("s_waitcnt lgkmcnt(0)" ::: "memory");
    float rli[16];
#pragma unroll
    for (int r = 0; r < 16; ++r) rli[r] = __builtin_amdgcn_rcpf(wsf[32 + crow(r, hi)]);
    bf16* Ow = a.O + (long)(wid * QBLK) * a.ldo; unsigned short* stg = (unsigned short*)(lds + LDS_OST) + wid * 2048;
#pragma unroll
    for (int r = 0; r < 16; ++r) { const int orow = crow(r, hi);
#pragma unroll
        for (int d0 = 0; d0 < 2; ++d0) { const float v = o[d0][r] * rli[r]; const unsigned u = __float_as_uint(v); stg[orow * 64 + d0 * 32 + r32] = (unsigned short)((u + 0x7fffu + ((u >> 16) & 1u)) >> 16); } }
    asm volatile("s_waitcnt lgkmcnt(0)" ::: "memory");
#pragma unroll
    for (int i = 0; i < 4; ++i) { const int row = i * 8 + (lane >> 3), ch = lane & 7; *(u32x4*)(Ow + (long)row * a.ldo + ch * 8) = *(const u32x4*)(stg + row * 64 + ch * 8); }
    asm volatile("s_waitcnt lgkmcnt(0)\n\ts_barrier" ::: "memory");
#undef DMA_K
#undef DMA_V
#undef ROT
#undef RS3
#undef EX
#undef RESC
#undef PKW
#undef PAF
#undef VFR
#undef VRD
#undef KRD
#undef ENDW
#undef GAP3
#undef GAP2
#undef GAPB
#undef STEP
}
#undef A9_SBAR
#undef A9_PIN
#undef A9_MFMA
#undef A9_WAIT_BAR
}

constexpr size_t MiB = 1u << 20;
constexpr size_t WS_CTL = 0, CTL_BYTES = 1 * MiB;
constexpr size_t WS_MOD = 1 * MiB;
constexpr size_t WS_T16C = WS_MOD + 256 * 1024, WS_T16S = WS_T16C + 4096, WS_T8C = WS_T16S + 4096, WS_T8S = WS_T8C + 2048;
constexpr size_t WS_RSQ = WS_MOD + 320 * 1024, WS_RSKV = WS_RSQ + 64 * 1024;
constexpr size_t WS_TAB = WS_MOD + 512 * 1024;
constexpr size_t WS_WT = 3 * MiB;
constexpr size_t WT_IN = 0, WT_G = WT_IN + (size_t)PPW * DM * 2, WT_QU = WT_G + (size_t)NGATE * DM * 2, WT_KVU = WT_QU + (size_t)768 * 384 * 2, WT_BR = WT_KVU + (size_t)1024 * 256 * 2,
                 WT_OUT = WT_BR + (size_t)3 * DM * 512 * 2, WT_F1 = WT_OUT + (size_t)DM * DM * 2, WT_F2 = WT_F1 + (size_t)DFF * DM * 2, WT_END = WT_F2 + (size_t)DM * DFF * 2;
static_assert(WT_END <= 36 * MiB, "weights");
constexpr size_t WS_CTXX = WS_WT + 36 * MiB;
constexpr size_t WS_XN = WS_CTXX + 4 * MiB;
constexpr size_t WS_HALF = WS_XN + 34 * MiB;
constexpr int NUNIT = 32 * (RPB / 32);
constexpr int KVP = 1088;
constexpr size_t H_PP = 0, H_QM = H_PP + (size_t)HM * PPW * 2, H_KVM = H_QM + (size_t)HM * 768 * 2, H_MO = H_KVM + (size_t)HM * KVP * 2, H_PHI = H_MO + (size_t)HM * 512 * 2,
                 H_PSI = H_PHI + (size_t)NUNIT * 8192, H_GC = H_PSI + (size_t)NUNIT * 8192, H_END = H_GC;
constexpr size_t WS_END = WS_HALF + H_END;
static_assert(WS_END + 12 * MiB <= 256 * MiB, "workspace (the 12 MiB after WS_END hold transient scratch: pass-3 parking / split-K slabs)");
constexpr size_t WS_GB = WS_HALF + H_PHI, WS_MIX = WS_GB + (size_t)HM * 3 * DM * 2;
constexpr size_t WS_G0 = WS_HALF + H_KVM, WS_G1 = WS_HALF + H_PHI, WS_G2 = WS_G1 + (size_t)HM * DM * 2;
static_assert(WS_G2 + (size_t)HM * DM * 2 <= WS_HALF + H_PSI, "gate buffers");
constexpr size_t WS_HID = WS_HALF;
static_assert(WS_MIX + (size_t)HM * DM * 2 <= WS_HALF + H_GC && WS_HID + (size_t)MROWS * DFF * 2 <= WS_END, "overlays");
constexpr int CW_BAR = 4096, CW_ATT = 16384;

#define GAS __attribute__((address_space(1)))
#define LAS __attribute__((address_space(3)))
typedef unsigned short bf16;
typedef unsigned v4u __attribute__((ext_vector_type(4)));
typedef float f32x4 __attribute__((ext_vector_type(4)));
typedef float f32x8 __attribute__((ext_vector_type(8)));
#define LDS_WAIT() asm volatile("s_waitcnt lgkmcnt(0)" ::: "memory")
__device__ __forceinline__ unsigned f2bf(float f) { unsigned u = __builtin_bit_cast(unsigned, f); return (u + 0x7fffu + ((u >> 16) & 1u)) >> 16; }
__device__ __forceinline__ unsigned pk2(float lo, float hi) { return f2bf(lo) | (f2bf(hi) << 16); }
__device__ __forceinline__ float bf2f(unsigned short h) { return __uint_as_float((unsigned)h << 16); }

#define XB_TMO      128
#define XB_XCNT(j)  (256  + 64 * (j))
#define XB_XSUB(j)  (1280 + 64 * (j))
#define XB_XGEN(j)  (2304 + 64 * (j))
#define XB_TOP      3328
#define XB_TOPGEN   3392
#define XCD_BAR_WORDS 3456
#define XB_SPIN_CAP (1u << 22)
__device__ __forceinline__ unsigned xb_ld(unsigned* p)              { return __hip_atomic_load(p, __ATOMIC_RELAXED, __HIP_MEMORY_SCOPE_AGENT); }
__device__ __forceinline__ unsigned xb_add(unsigned* p, unsigned v) { return __hip_atomic_fetch_add(p, v, __ATOMIC_RELAXED, __HIP_MEMORY_SCOPE_AGENT); }
__device__ __forceinline__ unsigned xb_xcc_id() { return (unsigned)__builtin_amdgcn_s_getreg((3 << 11) | 20) & 0xFu; }
#define XB_SPIN(cond, bar) do { unsigned _sp = 0; while (cond) { __builtin_amdgcn_s_sleep(1); \
    if ((++_sp & 255u) == 0u) { if (xb_ld(&(bar)[XB_TMO])) break; if (_sp > XB_SPIN_CAP) { atomicAdd(&(bar)[XB_TMO], 1u); break; } } } } while (0)
struct XcdBarrier { unsigned* bar; unsigned x; volatile LAS unsigned* st; };
__device__ __forceinline__ XcdBarrier xcd_barrier_post(unsigned* bar, volatile LAS unsigned* st) {
    XcdBarrier b; b.bar = bar; b.x = xb_xcc_id(); b.st = st;
    if (threadIdx.x == 0) (void)xb_add(&bar[XB_XCNT(b.x)], 1u);
    return b;
}
__device__ __forceinline__ void xcd_barrier_complete(unsigned* bar, unsigned x, unsigned& nloc, unsigned& nx) {
    const unsigned G = gridDim.x * gridDim.y * gridDim.z;
    unsigned sum, cnt, mine, sp = 0u;
    for (;;) {
        sum = 0u; cnt = 0u; mine = 0u;
#pragma unroll
        for (unsigned j = 0; j < 16; ++j) { const unsigned c = xb_ld(&bar[XB_XCNT(j)]); sum += c; cnt += (c > 0u) ? 1u : 0u; mine = (j == x) ? c : mine; }
        if (sum == G) break;
        __builtin_amdgcn_s_sleep(1);
        if ((++sp & 255u) == 0u) { if (xb_ld(&bar[XB_TMO])) break; if (sp > XB_SPIN_CAP) { atomicAdd(&bar[XB_TMO], 1u); break; } }
    }
    nloc = mine > 0u ? mine : 1u; nx = cnt > 0u ? cnt : 1u;
}
__device__ __forceinline__ void xcd_barrier(const XcdBarrier& b) {
    asm volatile("s_waitcnt vmcnt(0)" ::: "memory");
    __syncthreads();
    if (threadIdx.x == 0) {
        unsigned* bar = b.bar; asm volatile("" : "+s"(bar));
        __builtin_amdgcn_s_waitcnt(0);
        unsigned nloc = b.st[0], nx = b.st[1];
        if (nloc == 0u) { xcd_barrier_complete(bar, b.x, nloc, nx); b.st[0] = nloc; b.st[1] = nx; }
        const unsigned old = xb_add(&bar[XB_XSUB(b.x)], 1u);
        const unsigned gen = old / nloc;
        if (old + 1u == (gen + 1u) * nloc) {
            __builtin_amdgcn_fence(__ATOMIC_RELEASE, "agent");
            asm volatile("s_waitcnt vmcnt(0)" ::: "memory");
            const unsigned og = xb_add(&bar[XB_TOP], 1u);
            const unsigned tg = og / nx;
            if (og + 1u == (tg + 1u) * nx) xb_add(&bar[XB_TOPGEN], 1u);
            else XB_SPIN(xb_ld(&bar[XB_TOPGEN]) == tg, bar);
            __builtin_amdgcn_fence(__ATOMIC_ACQUIRE, "agent");
            xb_add(&bar[XB_XGEN(b.x)], 1u);
            asm volatile("s_waitcnt vmcnt(0)" ::: "memory");
        } else {
            XB_SPIN(xb_ld(&bar[XB_XGEN(b.x)]) == gen, bar);
            __builtin_amdgcn_fence(__ATOMIC_ACQUIRE, "agent");
            asm volatile("s_waitcnt vmcnt(0)" ::: "memory");
        }
    }
    __syncthreads();
}

constexpr int NWAVES = 8, RING_BYTES = 131072, LDS_BYTES = 163840, MISC_OFF = LDS_BYTES - 512;
struct Args { const float* in[31]; float* out; unsigned char* ws; int ph_lo, ph_hi; };
enum { I_X = 0, I_C, I_CTX, I_CCTX, I_WMOD, I_BMOD, I_G1, I_G2, I_WIN, I_QGAIN, I_KGAIN, I_MU, I_W0, I_W2, I_A0, I_A2, I_G2R, I_KK, I_KA, I_RK, I_LNW, I_LNB, I_QNORM, I_QUP, I_KVNORM, I_KVUP, I_WBR, I_WOUT, I_FF1, I_FF2, I_GFIN };
#define CAS __attribute__((address_space(4)))
__device__ __forceinline__ const float* inp(int i) { const CAS Args* ap = (const CAS Args*)__builtin_amdgcn_kernarg_segment_ptr(); asm volatile("" : "+s"(ap)); return ap->in[i]; }
struct Frame {
    LAS unsigned char* lds; unsigned char* ldsg;
    unsigned* ctl; unsigned char* ws; float* out;
    int G, bid;
};
#define FTID() otid()
#define FLANE() (otid() & 63)
#define FWAVE() __builtin_amdgcn_readfirstlane(otid() >> 6)
__device__ __forceinline__ float wave_sum(float v) {
#pragma unroll
    for (int o = 1; o < 64; o <<= 1) v += __shfl_xor(v, o);
    return v;
}
__device__ __forceinline__ const float* xrow_ptr(const float* xl, const float* xc, int m) { const int b = m / RPB, s = m % RPB; return (s < CTX) ? xc + (size_t)(b * CTX + s) * DM : xl + (size_t)(b * SEQ + s - CTX) * DM; }

__device__ __forceinline__ void p0_transpose_item(const float* W, int ldw, int col0, int Kd, int N, bf16* WT, const float* kscale, LAS unsigned* scr, int item, int lane, int ldwt) {
    const int nblk = (N + 63) / 64, kb = item / nblk, nb = item % nblk, k0 = 64 * kb, n0 = 64 * nb, c = lane & 15, r4 = lane >> 4;
    const bool valid = n0 + 4 * c < N;
#pragma unroll
    for (int i = 0; i < 8; ++i) { const int k = 8 * i + 2 * r4; f32x4 a = (f32x4){0.f, 0.f, 0.f, 0.f}, bq = a;
        if (valid) { a = *(const f32x4*)(W + (size_t)(k0 + k) * ldw + col0 + n0 + 4 * c); bq = *(const f32x4*)(W + (size_t)(k0 + k + 1) * ldw + col0 + n0 + 4 * c); }
        if (kscale) { a = a * kscale[k0 + k]; bq = bq * kscale[k0 + k + 1]; }
#pragma unroll
        for (int e = 0; e < 4; ++e) scr[(4 * c + e) * 33 + (k >> 1)] = pk2(a[e], bq[e]); }
    LDS_WAIT(); asm volatile("" ::: "memory");
#pragma unroll
    for (int t = 0; t < 8; ++t) { const int n = (lane >> 3) + 8 * t, j = lane & 7; const LAS unsigned* p = scr + n * 33 + 4 * j;
        v4u o; o.x = p[0]; o.y = p[1]; o.z = p[2]; o.w = p[3];
        if (n0 + n < N) *(v4u*)(WT + (size_t)(n0 + n) * ldwt + k0 + 8 * j) = o; }
    LDS_WAIT(); asm volatile("" ::: "memory");
}

__device__ __forceinline__ void ph_weights(Frame& F, int l) {
    unsigned char* wt = F.ws + WS_WT;
    if (l == 0) {
        LAS float* sl = (LAS float*)F.lds;
        LAS float* red = (LAS float*)(F.lds + 32768);
        for (int i = FTID(); i < 5 * 1024; i += 512) { const int j = i >> 10, k = i & 1023; const float c = (j < 4) ? inp(I_C)[j * 1024 + k] : inp(I_CCTX)[k]; sl[i] = c / (1.f + __expf(-c)); }
        __syncthreads();
        for (int it = F.bid; it < 2 * 96; it += F.G) {
            const int ll = it / 96, n0 = (it % 96) * 64;
            const float* wm = inp(I_WMOD) + (size_t)ll * 1024 * 6144 + n0 + FLANE();
            float a0 = 0, a1 = 0, a2 = 0, a3 = 0, a4 = 0;
            for (int k0 = FWAVE() * 128; k0 < FWAVE() * 128 + 128; k0 += 32) { float w[32];
#pragma unroll
                for (int u = 0; u < 32; ++u) w[u] = wm[(size_t)(k0 + u) * 6144];
#pragma unroll
                for (int u = 0; u < 32; ++u) { const int k = k0 + u; a0 += sl[k] * w[u]; a1 += sl[1024 + k] * w[u]; a2 += sl[2048 + k] * w[u]; a3 += sl[3072 + k] * w[u]; a4 += sl[4096 + k] * w[u]; } }
            LAS float* r = red + FWAVE() * 320 + FLANE(); r[0] = a0; r[64] = a1; r[128] = a2; r[192] = a3; r[256] = a4;
            __syncthreads();
            if (FTID() < 320) { float s = 0; for (int w = 0; w < 8; ++w) s += red[w * 320 + FTID()]; const int j = FTID() >> 6, n = n0 + (FTID() & 63);
                ((float*)(F.ws + WS_MOD))[(size_t)(ll * 5 + j) * 6144 + n] = s + inp(I_BMOD)[ll * 6144 + n]; }
            __syncthreads();
        }
        if (F.bid == F.G - 1) {
            for (int i = FTID(); i < 64 * 16; i += 512) { const int pos = i >> 4, f = i & 15; const float ang = (float)pos * powf(10000.f, -(float)f / 16.f); ((float*)(F.ws + WS_T16C))[i] = cosf(ang); ((float*)(F.ws + WS_T16S))[i] = sinf(ang); }
            for (int i = FTID(); i < 64 * 8; i += 512) { const int pos = i >> 3, f = i & 7; const float ang = (float)pos * powf(10000.f, -(float)f / 8.f); ((float*)(F.ws + WS_T8C))[i] = cosf(ang); ((float*)(F.ws + WS_T8S))[i] = sinf(ang); }
        }
        __syncthreads();
    }
    {
        bf16* w2P = (bf16*)(F.ws + WS_TAB); bf16* a2B = (bf16*)(F.ws + WS_TAB + 131072); bf16* g2P = (bf16*)(F.ws + WS_TAB + 524288);
        const float* w2 = inp(I_W2) + (size_t)l * 2 * 64 * 512; const float* a2 = inp(I_A2) + (size_t)l * 2 * 64 * 512; const float* g2 = inp(I_G2R) + (size_t)l * 128 * 512;
        const float* mu = inp(I_MU) + (size_t)l * 2 * RWIN;
        for (int idx = F.bid * 512 + FTID(); idx < 65536; idx += F.G * 512) {
            { const int dh = idx >> 12, d = dh >> 3, hd = dh & 7, rem = idx & 4095, Ii = rem >> 11, J = (rem >> 10) & 1, S = (rem >> 9) & 1, ln = (rem >> 3) & 63, e = rem & 7;
              const int i = 32 * Ii + 16 * S + 8 * (e >> 2) + 4 * (ln >> 5) + (e & 3), k = 32 * J + (ln & 31);
              w2P[idx] = (bf16)f2bf(w2[(size_t)(d * 64 + i) * 512 + hd * 64 + k]); }
            { const int hd = idx >> 13, rem = idx & 8191, Ii = rem >> 11, Iv = (rem >> 10) & 1, S = (rem >> 9) & 1, ln = (rem >> 3) & 63, e = rem & 7;
              const int i = 32 * Ii + 16 * S + 8 * (e >> 2) + 4 * (ln >> 5) + (e & 3), v = 32 * Iv + (ln & 31);
              g2P[idx] = (bf16)f2bf(g2[(size_t)i * 512 + hd * 64 + v]); } }
        {   bf16* DF = (bf16*)(F.ws + WS_TAB + 655360);
            for (int idx = F.bid * 512 + FTID(); idx < 60 * 3 * 2 * 64 * 8; idx += F.G * 512) {
                const int e = idx & 7, ln = (idx >> 3) & 63, q = (idx >> 9) & 1, w = (idx >> 10) % 3, blk = idx / 3072, r = ln & 31, h = ln >> 5, cc = 32 * blk + r;
                const float m0 = mu[cc], m1 = mu[RWIN + cc]; const float cf = (w == 0) ? 1.f - m0 - m1 : (w == 1 ? m0 : m1);
                DF[idx] = (r == 16 * q + 8 * h + e) ? (bf16)f2bf(cf) : (bf16)0; } }
        for (int idx = F.bid * 512 + FTID(); idx < 196608; idx += F.G * 512) {
            const int dh = idx / 12288, rem = idx % 12288, w = rem >> 12, k = (rem >> 6) & 63, i = rem & 63, d = dh >> 3, hd = dh & 7;
            const float m0 = mu[RW_AD + d * 64 + i], m1 = mu[RWIN + RW_AD + d * 64 + i]; const float cf = (w == 0) ? 1.f - m0 - m1 : (w == 1 ? m0 : m1);
            a2B[idx] = (bf16)f2bf(a2[(size_t)(d * 64 + i) * 512 + hd * 64 + k] * cf); } }
    LAS unsigned* scr = (LAS unsigned*)(F.lds + FWAVE() * 16384);
    const int gw = F.bid * NWAVES + FWAVE(), NGW = F.G * NWAVES;
    const float* win = inp(I_WIN) + (size_t)l * DM * NIN;
    constexpr int I_A = 16 * 53, I_B = 16 * 48, I_C2 = 6 * 12, I_D = 4 * 16, I_E = 8 * 16, I_F = 16 * 16, I_G = 16 * 64, I_H = 64 * 16;
    constexpr int NITEMS = I_A + I_B + I_C2 + I_D + 3 * I_E + I_F + I_G + I_H;
    for (int it = gw; it < NITEMS; it += NGW) {
        int r = it; const int lane = FLANE();
        if (r < I_A) { p0_transpose_item(win, NIN, 0, DM, 3360, (bf16*)(wt + WT_IN), nullptr, scr, r, lane, DM); continue; } r -= I_A;
        if (r < I_B) { p0_transpose_item(win, NIN, C_GATE, DM, NGATE, (bf16*)(wt + WT_G), nullptr, scr, r, lane, DM); continue; } r -= I_B;
        if (r < I_C2) { p0_transpose_item(inp(I_QUP) + (size_t)l * 384 * 768, 768, 0, 384, 768, (bf16*)(wt + WT_QU), inp(I_QNORM) + l * 384, scr, r, lane, 384); continue; } r -= I_C2;
        if (r < I_D) { p0_transpose_item(inp(I_KVUP) + (size_t)l * 256 * 1024, 1024, 0, 256, 1024, (bf16*)(wt + WT_KVU), inp(I_KVNORM) + l * 256, scr, r, lane, 256); continue; } r -= I_D;
        if (r < 3 * I_E) { const int i = r / I_E; p0_transpose_item(inp(I_WBR) + (size_t)(l * 3 + i) * 512 * DM, DM, 0, 512, DM, (bf16*)(wt + WT_BR) + (size_t)i * DM * 512, nullptr, scr, r % I_E, lane, 512); continue; } r -= 3 * I_E;
        if (r < I_F) { p0_transpose_item(inp(I_WOUT) + (size_t)l * DM * DM, DM, 0, DM, DM, (bf16*)(wt + WT_OUT), nullptr, scr, r, lane, DM); continue; } r -= I_F;
        if (r < I_G) { p0_transpose_item(inp(I_FF1) + (size_t)l * DM * DFF, DFF, 0, DM, DFF, (bf16*)(wt + WT_F1), nullptr, scr, r, lane, DM); continue; } r -= I_G;
        p0_transpose_item(inp(I_FF2) + (size_t)l * DFF * DM, DM, 0, DFF, DM, (bf16*)(wt + WT_F2), nullptr, scr, r, lane, DFF);
    }
    { v4u* z = (v4u*)((bf16*)(wt + WT_IN) + (size_t)3360 * DM); const int nz = 224 * DM * 2 / 16; unsigned z0; asm volatile("v_mov_b32 %0, 0" : "=v"(z0));
      for (int i = F.bid * 512 + FTID(); i < nz; i += F.G * 512) z[i] = (v4u){z0, z0, z0, z0}; }
}

__device__ __forceinline__ void ph_norm(Frame& F, int l, const float* xl, const float* xc, const float* g, int which, bool skipctx, const float* part = nullptr) {
    const int gw = F.bid * NWAVES + FWAVE(), NGW = F.G * NWAVES;
    const float* mod = (const float*)(F.ws + WS_MOD) + (size_t)l * 5 * 6144;
    bf16* XN = (bf16*)(F.ws + WS_XN);
    for (int m = gw; m < MROWS; m += NGW) {
        const int b = m / RPB, s = m % RPB; if (skipctx && s < CTX) continue;
        const f32x4* xr = (const f32x4*)xrow_ptr(xl, xc, m) + FLANE();
        const float* mv = mod + (size_t)((s < CTX) ? 4 : b) * 6144 + which * 3072;
        f32x4 v[4]; float ss = 0.f;
#pragma unroll
        for (int j = 0; j < 4; ++j) { v[j] = xr[64 * j];
            if (part && s < CTX) { const f32x4* pr = (const f32x4*)(part + (size_t)(b * CTX + s) * DM) + FLANE() + 64 * j; v[j] = v[j] + pr[0] + pr[262144] + pr[524288]; }
            ss += (v[j].x * v[j].x + v[j].y * v[j].y) + (v[j].z * v[j].z + v[j].w * v[j].w); }
        const float rstd = 1.f / sqrtf(wave_sum(ss) * (1.f / DM) + NORM_EPS);
        unsigned long long* o8 = (unsigned long long*)(XN + (size_t)m * DM) + FLANE();
#pragma unroll
        for (int j = 0; j < 4; ++j) { const int c = 4 * FLANE() + 256 * j; const f32x4 gg = *(const f32x4*)(g + c), sh = *(const f32x4*)(mv + c), sc = *(const f32x4*)(mv + 1024 + c);
            const f32x4 y = v[j] * rstd * gg * (sc + 1.0f) + sh;
            o8[64 * j] = (unsigned long long)pk2(y.x, y.y) | ((unsigned long long)pk2(y.z, y.w) << 32); }
    }
}
__device__ __forceinline__ void ph_final(Frame& F) {
    const int gw = F.bid * NWAVES + FWAVE(), NGW = F.G * NWAVES; const float* g = inp(I_GFIN);
    for (int m = gw; m < NB * SEQ; m += NGW) {
        f32x4* xr = (f32x4*)(F.out + (size_t)m * DM) + FLANE(); f32x4 v[4]; float ss = 0.f;
#pragma unroll
        for (int j = 0; j < 4; ++j) { v[j] = xr[64 * j]; ss += (v[j].x * v[j].x + v[j].y * v[j].y) + (v[j].z * v[j].z + v[j].w * v[j].w); }
        const float rstd = 1.f / sqrtf(wave_sum(ss) * (1.f / DM) + NORM_EPS);
#pragma unroll
        for (int j = 0; j < 4; ++j) { const f32x4 gg = *(const f32x4*)(g + 4 * FLANE() + 256 * j); xr[64 * j] = v[j] * rstd * gg; }
    }
}

__device__ __forceinline__ void ph_prep(Frame& F, int l, int half) {
    const int gw = F.bid * NWAVES + FWAVE(), NGW = F.G * NWAVES, lane = FLANE();
    bf16* PP = (bf16*)(F.ws + WS_HALF + H_PP);
    const float* t16c = (const float*)(F.ws + WS_T16C); const float* t16s = (const float*)(F.ws + WS_T16S); const float* t8c = (const float*)(F.ws + WS_T8C); const float* t8s = (const float*)(F.ws + WS_T8S);
    float* rsq = (float*)(F.ws + WS_RSQ); float* rskv = (float*)(F.ws + WS_RSKV);
    const float* qg = inp(I_QGAIN) + l * 64; const float* kg = inp(I_KGAIN) + l * 64;
    const bool skew = NGW == 2048; const int wv = FWAVE(); const bool third = skew && F.bid < 64 && wv < 4;
    const int wp = !skew ? gw : third ? -1 : (F.bid < 64 ? F.bid * 4 + (wv - 4) : 256 + (F.bid - 64) * 8 + wv), NWP = skew ? NGW - 256 : NGW;
    for (int m = wp; m < HM; m += NWP) {
        if (wp < 0) break;
        const int s = m % RPB; const bool lat = s >= CTX; const int tt = s - CTX, pr = (tt >> 6) & 63, pc = tt & 63;
        bf16* row = PP + (size_t)m * PPW;
        for (int part = 0; part < 2; ++part) {
            if (part == 1 && lane >= 16) break;
            bf16* p = row + (part == 0 ? C_GQ : C_GK) + lane * 8; const float* gain = part == 0 ? qg : kg;
            const v4u w = *(const v4u*)p; float v[8] = {pg8::bf_lo(w.x), pg8::bf_hi(w.x), pg8::bf_lo(w.y), pg8::bf_hi(w.y), pg8::bf_lo(w.z), pg8::bf_hi(w.z), pg8::bf_lo(w.w), pg8::bf_hi(w.w)};
            float ss = 0; for (int e = 0; e < 8; ++e) ss += v[e] * v[e];
            ss += __shfl_xor(ss, 1); ss += __shfl_xor(ss, 2); ss += __shfl_xor(ss, 4);
            const float rstd = 1.f / sqrtf(ss * (1.f / 64.f) + NORM_EPS); const int j = lane & 7;
            const float qs = (part == 0) ? 0.125f * 1.4426950408889634f : 1.f;
            for (int e = 0; e < 8; ++e) v[e] = v[e] * (rstd * qs) * gain[j * 8 + e];
            float pv[8]; for (int e = 0; e < 8; ++e) pv[e] = __shfl_xor(v[e], 2);
            if (lat) { const int pos = (j < 4) ? pr : pc; const int f0 = 8 * (j & 1);
                for (int e = 0; e < 8; ++e) { const float c = t16c[pos * 16 + f0 + e], sn = t16s[pos * 16 + f0 + e]; v[e] = ((j & 2) == 0) ? v[e] * c - pv[e] * sn : pv[e] * sn + v[e] * c; } }
            v4u o; o.x = pk2(v[0], v[1]); o.y = pk2(v[2], v[3]); o.z = pk2(v[4], v[5]); o.w = pk2(v[6], v[7]); *(v4u*)p = o;
        }
        if (lane < 4) {
            bf16* p = row + C_KR + lane * 8; const v4u w = *(const v4u*)p; float v[8] = {pg8::bf_lo(w.x), pg8::bf_hi(w.x), pg8::bf_lo(w.y), pg8::bf_hi(w.y), pg8::bf_lo(w.z), pg8::bf_hi(w.z), pg8::bf_lo(w.w), pg8::bf_hi(w.w)};
            float pv[8]; for (int e = 0; e < 8; ++e) pv[e] = __shfl_xor(v[e], 1);
            if (lat) { const int pos = (lane < 2) ? pr : pc;
                for (int e = 0; e < 8; ++e) { const float c = t8c[pos * 8 + e], sn = t8s[pos * 8 + e]; v[e] = ((lane & 1) == 0) ? v[e] * c - pv[e] * sn : pv[e] * sn + v[e] * c; } }
            v4u o; o.x = pk2(v[0], v[1]); o.y = pk2(v[2], v[3]); o.z = pk2(v[4], v[5]); o.w = pk2(v[6], v[7]); *(v4u*)p = o;
        }
        { float sq = 0, skv = 0;
          if (lane < 48) { const v4u w = *(const v4u*)(row + C_QD + lane * 8); const float v[8] = {pg8::bf_lo(w.x), pg8::bf_hi(w.x), pg8::bf_lo(w.y), pg8::bf_hi(w.y), pg8::bf_lo(w.z), pg8::bf_hi(w.z), pg8::bf_lo(w.w), pg8::bf_hi(w.w)}; for (int e = 0; e < 8; ++e) sq += v[e] * v[e]; }
          if (lane < 32) { const v4u w = *(const v4u*)(row + C_KVD + lane * 8); const float v[8] = {pg8::bf_lo(w.x), pg8::bf_hi(w.x), pg8::bf_lo(w.y), pg8::bf_hi(w.y), pg8::bf_lo(w.z), pg8::bf_hi(w.z), pg8::bf_lo(w.w), pg8::bf_hi(w.w)}; for (int e = 0; e < 8; ++e) skv += v[e] * v[e]; }
          sq = wave_sum(sq); skv = wave_sum(skv);
          if (lane == 0) { rsq[m] = (0.10206207261596575f * 1.4426950408889634f) / sqrtf(sq * (1.f / 384.f) + NORM_EPS);     rskv[m] = 1.f / sqrtf(skv * (1.f / 256.f) + NORM_EPS); } }
    }
}
__device__ __forceinline__ void shifted8(const bf16* PP, int m, int cc0, const float* mu, float (&u)[8]) {
    const int s = m % RPB; const float fp = (s != 0 && s != CTX) ? 1.f : 0.f, fn = (s != CTX - 1 && s != RPB - 1) ? 1.f : 0.f;
    const int mp = m > 0 ? m - 1 : 0, mn = m < HM - 1 ? m + 1 : HM - 1;
    const v4u w = *(const v4u*)(PP + (size_t)m * PPW + C_RW + cc0), wp = *(const v4u*)(PP + (size_t)mp * PPW + C_RW + cc0), wn = *(const v4u*)(PP + (size_t)mn * PPW + C_RW + cc0);
    const f32x4 m0a = *(const f32x4*)(mu + cc0), m0b = *(const f32x4*)(mu + cc0 + 4), m1a = *(const f32x4*)(mu + RWIN + cc0), m1b = *(const f32x4*)(mu + RWIN + cc0 + 4);
    const float c[8] = {pg8::bf_lo(w.x), pg8::bf_hi(w.x), pg8::bf_lo(w.y), pg8::bf_hi(w.y), pg8::bf_lo(w.z), pg8::bf_hi(w.z), pg8::bf_lo(w.w), pg8::bf_hi(w.w)};
    const float a[8] = {pg8::bf_lo(wp.x), pg8::bf_hi(wp.x), pg8::bf_lo(wp.y), pg8::bf_hi(wp.y), pg8::bf_lo(wp.z), pg8::bf_hi(wp.z), pg8::bf_lo(wp.w), pg8::bf_hi(wp.w)};
    const float n[8] = {pg8::bf_lo(wn.x), pg8::bf_hi(wn.x), pg8::bf_lo(wn.y), pg8::bf_hi(wn.y), pg8::bf_lo(wn.z), pg8::bf_hi(wn.z), pg8::bf_lo(wn.w), pg8::bf_hi(wn.w)};
#pragma unroll
    for (int e = 0; e < 8; ++e) { const float m0 = (e < 4 ? m0a[e & 3] : m0b[e & 3]), m1 = (e < 4 ? m1a[e & 3] : m1b[e & 3]); u[e] = c[e] + m0 * (fp * a[e] - c[e]) + m1 * (fn * n[e] - c[e]); }
}
namespace rk {
using bf16x8 = __attribute__((ext_vector_type(8))) short;
using f32x16 = __attribute__((ext_vector_type(16))) float;
using u32x4 = __attribute__((ext_vector_type(4))) unsigned;
typedef float f32x2_t __attribute__((ext_vector_type(2))); typedef __bf16 bf16x2_t __attribute__((ext_vector_type(2)));
#define RK_DI __device__ __forceinline__
RK_DI f32x16 RK_MF(bf16x8 a, bf16x8 b, f32x16 c) { return __builtin_amdgcn_mfma_f32_32x32x16_bf16(a, b, c, 0, 0, 0); }
constexpr int NH = 8;
RK_DI unsigned cvt2(float lo, float hi) { f32x2_t v = {lo, hi}; bf16x2_t b = __builtin_convertvector(v, bf16x2_t); return __builtin_bit_cast(unsigned, b); }
RK_DI float lo16(unsigned w) { return __uint_as_float(w << 16); }
RK_DI float hi16(unsigned w) { return __uint_as_float(w & 0xffff0000u); }
RK_DI int crow(int reg, int h) { return (reg & 3) + 8 * (reg >> 2) + 4 * h; }
RK_DI int krow(int s, int h, int e) { return 16 * s + 8 * (e >> 2) + 4 * h + (e & 3); }
template <int S> RK_DI bf16x8 pack(const f32x16& x) { u32x4 p = {cvt2(x[8 * S], x[8 * S + 1]), cvt2(x[8 * S + 2], x[8 * S + 3]), cvt2(x[8 * S + 4], x[8 * S + 5]), cvt2(x[8 * S + 6], x[8 * S + 7])}; return __builtin_bit_cast(bf16x8, p); }
RK_DI bf16x8 pack8(const float (&u)[8]) { u32x4 p = {cvt2(u[0], u[1]), cvt2(u[2], u[3]), cvt2(u[4], u[5]), cvt2(u[6], u[7])}; return __builtin_bit_cast(bf16x8, p); }
RK_DI void unpack8(bf16x8 v, float (&u)[8]) { const u32x4 p = __builtin_bit_cast(u32x4, v); u[0] = lo16(p.x); u[1] = hi16(p.x); u[2] = lo16(p.y); u[3] = hi16(p.y); u[4] = lo16(p.z); u[5] = hi16(p.z); u[6] = lo16(p.w); u[7] = hi16(p.w); }
constexpr short ONE = (short)0x3F80;
template <int K> RK_DI bf16x8 idn(int r, int h) { bf16x8 v;
#pragma unroll
    for (int e = 0; e < 8; ++e) v[e] = (r == 16 * K + 8 * h + e) ? ONE : (short)0; return v; }
template <int S> RK_DI bf16x8 idp(int r, int h) { bf16x8 v;
#pragma unroll
    for (int e = 0; e < 8; ++e) v[e] = (r == krow(S, h, e)) ? ONE : (short)0; return v; }
RK_DI bf16x8 idn_q(int q, int r, int h) { return q ? idn<1>(r, h) : idn<0>(r, h); }
template <int S, bool STRICT> RK_DI bf16x8 incp(int r, int h, int flip) { bf16x8 v;
#pragma unroll
    for (int e = 0; e < 8; ++e) { const int s = krow(S, h, e); const bool on = flip ? (STRICT ? s > r : s >= r) : (STRICT ? s < r : s <= r); v[e] = on ? ONE : (short)0; } return v; }
template <bool STRICT> RK_DI void tmask(f32x16& g, int r, int h, int flip) {
#pragma unroll
    for (int reg = 0; reg < 16; ++reg) { const int s = crow(reg, h); const bool on = flip ? (STRICT ? s > r : s >= r) : (STRICT ? s < r : s <= r); g[reg] = on ? g[reg] : 0.f; } }
template <int FLIP> RK_DI void solve32(f32x16& x, const bf16x8 (&Mp)[2]) {
    constexpr int F1 = FLIP ? 1 : 0, F2 = 1 - F1;
    f32x16 base = x;
#pragma unroll 1
    for (int it = 0; it < NH; ++it) { const f32x16 t = RK_MF(Mp[F1], pack<F1>(x), base);
#pragma unroll
        for (int e = 0; e < 8; ++e) x[8 * F1 + e] = t[8 * F1 + e]; }
    { const f32x16 t = RK_MF(Mp[F1], pack<F1>(x), base); x = t; base = t; }
#pragma unroll 1
    for (int it = 0; it < NH; ++it) { const f32x16 t = RK_MF(Mp[F2], pack<F2>(x), base);
#pragma unroll
        for (int e = 0; e < 8; ++e) x[8 * F2 + e] = t[8 * F2 + e]; }
}
template <int FLIP> RK_DI void solve32p(f32x16& x, f32x16& y, const bf16x8 (&Mp)[2]) {
    constexpr int F1 = FLIP ? 1 : 0, F2 = 1 - F1;
    f32x16 bx = x, by = y;
#pragma unroll 1
    for (int it = 0; it < NH; ++it) { const f32x16 t = RK_MF(Mp[F1], pack<F1>(x), bx); const f32x16 u = RK_MF(Mp[F1], pack<F1>(y), by);
#pragma unroll
        for (int e = 0; e < 8; ++e) { x[8 * F1 + e] = t[8 * F1 + e]; y[8 * F1 + e] = u[8 * F1 + e]; } }
    { const f32x16 t = RK_MF(Mp[F1], pack<F1>(x), bx); const f32x16 u = RK_MF(Mp[F1], pack<F1>(y), by); x = t; bx = t; y = u; by = u; }
#pragma unroll 1
    for (int it = 0; it < NH; ++it) { const f32x16 t = RK_MF(Mp[F2], pack<F2>(x), bx); const f32x16 u = RK_MF(Mp[F2], pack<F2>(y), by);
#pragma unroll
        for (int e = 0; e < 8; ++e) { x[8 * F2 + e] = t[8 * F2 + e]; y[8 * F2 + e] = u[8 * F2 + e]; } }
}
RK_DI float sigm(float x) { return __builtin_amdgcn_rcpf(1.f + __expf(-x)); }
RK_DI float tanh_f(float x) { return 2.f * __builtin_amdgcn_rcpf(1.f + __expf(-2.f * x)) - 1.f; }

struct Ctx {
    unsigned char* ws; LAS unsigned char* sb; int m0, r, h, hd, dir, l, flip;
    int cofs, dofs;
    int zt;
    int lofs;
    unsigned mp, mn; int rowc, rowp, rown;
};
#define C_PP(c) ((const bf16*)((c).ws + WS_HALF + H_PP))
#define C_MU(c) (inp(I_MU) + (size_t)(c).l * 2 * RWIN)
#define C_W2P(c) ((const bf16*)((c).ws + WS_TAB) + (size_t)((c).dir * 8 + (c).hd) * 4096)
#define C_A2B(c) ((const bf16*)((c).ws + WS_TAB + 131072) + (size_t)((c).dir * 8 + (c).hd) * 3 * 4096)
constexpr int SBUF = 34 * 128;
RK_DI void stage_slice(const Ctx& c, int buf, int cc0) {
    const int lane = c.r + 32 * c.h, p = lane & 7, q4 = lane >> 4;
    const bf16* base = C_PP(c) + (ptrdiff_t)(c.m0 - 1 + (lane >> 3)) * PPW + C_RW + cc0;
    const int oe = (p ^ q4) << 3, oo = (p ^ (4 + q4)) << 3;
#pragma unroll
    for (int j = 0; j < 5; ++j) { const bf16* src = base + (ptrdiff_t)j * 8 * PPW + ((j & 1) ? oo : oe);
        if (j < 4 || lane < 16) __builtin_amdgcn_global_load_lds((const unsigned*)src, (LAS unsigned*)(c.sb + buf * SBUF + j * 1024), 16, 0, 0); }
}
#define RK_WAIT_DMA() asm volatile("s_waitcnt vmcnt(0)" ::: "memory")
#define RK_WAIT_LDS() asm volatile("s_waitcnt lgkmcnt(0)" ::: "memory")
RK_DI bf16x8 rawfrag(const Ctx& c, int buf, int ch, int w) {
    const int rho = c.r + (w == 0 ? 1 : (w == 1 ? 0 : 2)); const unsigned m = (w == 0) ? 0xffffffffu : (w == 1 ? c.mp : c.mn);
    u32x4 v = *(const LAS u32x4*)(c.sb + buf * SBUF + rho * 128 + ((ch ^ ((rho >> 1) & 7)) << 4) + c.zt); v.x &= m; v.y &= m; v.z &= m; v.w &= m; return __builtin_bit_cast(bf16x8, v); }
RK_DI bf16x8 dfrag(const Ctx& c, int cc32, int w, int q) { return *(const bf16x8*)((const bf16*)(c.ws + WS_TAB + 655360) + (((cc32 >> 5) * 3 + w) * 2 + q) * 512 + c.lofs); }
RK_DI f32x16 load_o2(Ctx& c, int buf, int lblk, int cc32) { f32x16 z = f32x16{};
#pragma unroll
    for (int q = 0; q < 2; ++q) {
#pragma unroll
        for (int w = 0; w < 3; ++w) z = RK_MF(dfrag(c, cc32, w, q), rawfrag(c, buf, 4 * lblk + 2 * q + c.h, w), z); }
    asm volatile("" : "+v"(c.lofs), "+v"(c.zt), "+v"(z));
    return z; }
RK_DI f32x16 load_o1(Ctx& c, int buf, int lblk, int cc32) { f32x16 z = f32x16{};
#pragma unroll
    for (int q = 0; q < 2; ++q) {
#pragma unroll
        for (int w = 0; w < 3; ++w) z = RK_MF(rawfrag(c, buf, 4 * lblk + 2 * q + c.h, w), dfrag(c, cc32, w, q), z); }
    asm volatile("" : "+v"(c.lofs), "+v"(c.zt), "+v"(z));
    return z; }

struct Tilde { bf16x8 At[2][2], Bt[2][2], Kt[2][2], Rt[2][2], Vp[2][2]; float gtot[2]; float bon; };
#define RK_STAGE(x) asm volatile("" : "+v"(c.lofs), "+v"(c.zt), "+v"(x))
template <bool NEED_R> RK_DI void build_tilde(Ctx& c, Tilde& T) {
    const int r = c.r, h = c.h;
    stage_slice(c, 0, RW_WD + c.dir * 64); stage_slice(c, 1, RW_K + c.hd * 64); stage_slice(c, 2, RW_AD + c.dir * 64); if constexpr (NEED_R) stage_slice(c, 3, RW_R + c.hd * 64);
    RK_WAIT_DMA();
    bf16x8 lwp[2][2];
    {   bf16x8 twp[2][2];
#pragma unroll
        for (int Ii = 0; Ii < 2; ++Ii) { f32x16 t = load_o2(c, 0, Ii, RW_WD + c.dir * 64 + 32 * Ii);
#pragma unroll
            for (int reg = 0; reg < 16; ++reg) t[reg] = tanh_f(t[reg]);
            twp[Ii][0] = pack<0>(t); twp[Ii][1] = pack<1>(t); RK_STAGE(twp[Ii][1]); }
#pragma unroll
        for (int J = 0; J < 2; ++J) { f32x16 wl = f32x16{};
#pragma unroll
            for (int Ii = 0; Ii < 2; ++Ii)
#pragma unroll
                for (int S = 0; S < 2; ++S) wl = RK_MF(twp[Ii][S], *(const bf16x8*)(C_W2P(c) + ((Ii * 2 + J) * 2 + S) * 512 + c.lofs), wl);
            const float w0 = inp(I_W0)[c.dofs + 32 * J + r]; float gs = 0.f;
#pragma unroll
            for (int reg = 0; reg < 16; ++reg) wl[reg] = -0.6065306597126334f * sigm(wl[reg] + w0);
            lwp[J][0] = pack<0>(wl); lwp[J][1] = pack<1>(wl);
            { float q[8]; unpack8(lwp[J][0], q);
#pragma unroll
              for (int e = 0; e < 8; ++e) gs += q[e]; unpack8(lwp[J][1], q);
#pragma unroll
              for (int e = 0; e < 8; ++e) gs += q[e]; }
            gs += __shfl_xor(gs, 32); T.gtot[J] = gs; RK_STAGE(lwp[J][1]); } }
    RK_WAIT_LDS(); stage_slice(c, 0, RW_V + c.hd * 64);
    float rinv;
    {   float ss = 0.f;
#pragma unroll
        for (int Ik = 0; Ik < 2; ++Ik) { const f32x16 kt = load_o2(c, 1, Ik, RW_K + c.hd * 64 + 32 * Ik);
#pragma unroll
            for (int g = 0; g < 4; ++g) { const f32x4 kk = *(const f32x4*)(inp(I_KK) + c.cofs + 32 * Ik + 8 * g + 4 * h);
#pragma unroll
                for (int j = 0; j < 4; ++j) { const float q = kt[4 * g + j] * kk[j]; ss += q * q; } }
            RK_STAGE(ss); }
        ss += __shfl_xor(ss, 32); rinv = 1.f / fmaxf(sqrtf(ss), 1e-12f); RK_STAGE(rinv); }
    float bon = 0.f;
#pragma unroll
    for (int Ik = 0; Ik < 2; ++Ik) {
        f32x16 em, ep;
        { em = RK_MF(lwp[Ik][0], incp<0, false>(r, h, c.flip), f32x16{}); em = RK_MF(lwp[Ik][1], incp<1, false>(r, h, c.flip), em);
          ep = RK_MF(lwp[Ik][0], incp<0, true>(r, h, c.flip), f32x16{}); ep = RK_MF(lwp[Ik][1], incp<1, true>(r, h, c.flip), ep);
#pragma unroll
          for (int reg = 0; reg < 16; ++reg) { em[reg] = __expf(-em[reg]); ep[reg] = __expf(ep[reg]); } }
        RK_STAGE(ep);
        f32x16 kt = load_o2(c, 1, Ik, RW_K + c.hd * 64 + 32 * Ik); f32x16 kn;
#pragma unroll
        for (int g = 0; g < 4; ++g) { const f32x4 kk = *(const f32x4*)(inp(I_KK) + c.cofs + 32 * Ik + 8 * g + 4 * h);
#pragma unroll
            for (int j = 0; j < 4; ++j) { const int reg = 4 * g + j; kn[reg] = kt[reg] * kk[j] * rinv; ep[reg] = -kn[reg] * ep[reg]; } }
        T.At[Ik][0] = pack<0>(ep); T.At[Ik][1] = pack<1>(ep);
        RK_STAGE(T.At[Ik][1]);
        f32x16 as = f32x16{};
#pragma unroll
        for (int w = 0; w < 3; ++w) {
#pragma unroll
            for (int sp = 0; sp < 4; ++sp) as = RK_MF(*(const bf16x8*)(C_A2B(c) + w * 4096 + (32 * Ik + r) * 64 + 16 * sp + 8 * h), rawfrag(c, 2, 2 * sp + h, w), as);
            RK_STAGE(as); }
#pragma unroll
        for (int g = 0; g < 4; ++g) { const f32x4 a0 = *(const f32x4*)(inp(I_A0) + c.dofs + 32 * Ik + 8 * g + 4 * h);
#pragma unroll
            for (int j = 0; j < 4; ++j) { const int reg = 4 * g + j; as[reg] = sigm(as[reg] + a0[j]); kn[reg] = kn[reg] * as[reg] * em[reg]; } }
        T.Bt[Ik][0] = pack<0>(kn); T.Bt[Ik][1] = pack<1>(kn);
        RK_STAGE(T.Bt[Ik][1]);
#pragma unroll
        for (int g = 0; g < 4; ++g) { const f32x4 ka = *(const f32x4*)(inp(I_KA) + c.cofs + 32 * Ik + 8 * g + 4 * h);
#pragma unroll
            for (int j = 0; j < 4; ++j) { const int reg = 4 * g + j; kt[reg] = kt[reg] * (1.f + (as[reg] - 1.f) * ka[j]); as[reg] = kt[reg] * em[reg]; } }
        T.Kt[Ik][0] = pack<0>(as); T.Kt[Ik][1] = pack<1>(as);
        RK_STAGE(T.Kt[Ik][1]);
        if constexpr (NEED_R) {
            f32x16 rt = load_o2(c, 3, Ik, RW_R + c.hd * 64 + 32 * Ik);
#pragma unroll
            for (int g = 0; g < 4; ++g) { const f32x4 rk = *(const f32x4*)(inp(I_RK) + c.cofs + 32 * Ik + 8 * g + 4 * h);
#pragma unroll
                for (int j = 0; j < 4; ++j) { const int reg = 4 * g + j; bon += rt[reg] * kt[reg] * rk[j]; rt[reg] = rt[reg] * __builtin_amdgcn_rcpf(em[reg]); } }
            T.Rt[Ik][0] = pack<0>(rt); T.Rt[Ik][1] = pack<1>(rt); RK_STAGE(T.Rt[Ik][1]); }
    }
    T.bon = bon;
    RK_WAIT_DMA();
#pragma unroll
    for (int J = 0; J < 2; ++J) { const f32x16 va = load_o1(c, 0, J, RW_V + c.hd * 64 + 32 * J); T.Vp[J][0] = pack<0>(va); T.Vp[J][1] = pack<1>(va); RK_STAGE(T.Vp[J][1]); }
}
RK_DI void grams_la(const Ctx& c, const Tilde& T, bf16x8 (&Lk)[2], bf16x8 (&Mp)[2]) {
    f32x16 g = f32x16{}, m = f32x16{};
#pragma unroll
    for (int Ik = 0; Ik < 2; ++Ik)
#pragma unroll
        for (int S = 0; S < 2; ++S) { g = RK_MF(T.Kt[Ik][S], T.At[Ik][S], g); m = RK_MF(T.Bt[Ik][S], T.At[Ik][S], m); }
    tmask<true>(g, c.r, c.h, c.flip); tmask<true>(m, c.r, c.h, c.flip);
    Lk[0] = pack<0>(g); Lk[1] = pack<1>(g); Mp[0] = pack<0>(m); Mp[1] = pack<1>(m);
}
}

namespace rk {
constexpr int NSUB = RPB / 32;
RK_DI int chain_unit(int dir, int j) { return dir == 0 ? j : (j < 8 ? 7 - j : 143 - j); }
RK_DI int chain_pos(int dir, int c) { return dir == 0 ? c : (c < 8 ? 7 - c : 143 - c); }
RK_DI void setup_ctx(Ctx& c, unsigned char* ws, LAS unsigned char* sb, int l, int bl, int hd, int dir, int c32, int lane) {
    c.ws = ws; c.sb = sb; c.m0 = bl * RPB + 32 * c32; c.r = lane & 31; c.h = lane >> 5; c.hd = hd; c.dir = dir; c.l = l; c.flip = dir;
    c.cofs = l * 512 + hd * 64; c.dofs = (l * 2 + dir) * 512 + hd * 64;
    const int m = c.m0 + c.r, sg = m % RPB;
    c.mp = (sg != 0 && sg != CTX) ? 0xffffffffu : 0u; c.mn = (sg != CTX - 1 && sg != RPB - 1) ? 0xffffffffu : 0u;
    c.rowc = m; c.rowp = m > 0 ? m - 1 : 0; c.rown = m < HM - 1 ? m + 1 : HM - 1; c.lofs = (c.r + 32 * c.h) * 8; asm volatile("v_mov_b32 %0, 0" : "=v"(c.zt));
}
RK_DI void pass1_unit(unsigned char* ws, LAS unsigned char* sb, int l, int u, int lane) {
    const int q = u / NSUB, c32 = u % NSUB, bl = q >> 4, hd = (q >> 1) & 7, dir = q & 1;
    Ctx c; setup_ctx(c, ws, sb, l, bl, hd, dir, c32, lane);
    Tilde T; build_tilde<false>(c, T); __builtin_amdgcn_sched_barrier(0);
    const int r = c.r, h = c.h;
    bf16x8 Lk[2], Mp[2]; grams_la(c, T, Lk, Mp); __builtin_amdgcn_sched_barrier(0);
    const bf16x8 P0 = idp<0>(r, h), P1 = idp<1>(r, h);
    bf16x8 W1p[2][2], W2p[2][2], Bop[2][2], Kop[2][2];
#pragma unroll
    for (int J = 0; J < 2; ++J) {
        f32x16 x = RK_MF(T.At[J][0], P0, f32x16{}); x = RK_MF(T.At[J][1], P1, x);
        f32x16 y = RK_MF(Lk[0], T.Vp[J][0], f32x16{}); y = RK_MF(Lk[1], T.Vp[J][1], y);
        if (c.flip) solve32p<1>(x, y, Mp); else solve32p<0>(x, y, Mp);
        W1p[J][0] = pack<0>(x); W1p[J][1] = pack<1>(x);
        W2p[J][0] = pack<0>(y); W2p[J][1] = pack<1>(y);
        const float gcj = __expf(T.gtot[J]);
        f32x16 b = RK_MF(T.Bt[J][0], P0, f32x16{}); b = RK_MF(T.Bt[J][1], P1, b);
        f32x16 k = RK_MF(T.Kt[J][0], P0, f32x16{}); k = RK_MF(T.Kt[J][1], P1, k);
#pragma unroll
        for (int reg = 0; reg < 16; ++reg) { b[reg] *= gcj; k[reg] *= gcj; }
        Bop[J][0] = pack<0>(b); Bop[J][1] = pack<1>(b); Kop[J][0] = pack<0>(k); Kop[J][1] = pack<1>(k);
    }
    u32x4* phi = (u32x4*)(ws + WS_HALF + H_PHI) + (size_t)u * 512 + lane;
    u32x4* psi = (u32x4*)(ws + WS_HALF + H_PSI) + (size_t)u * 512 + lane;
#pragma unroll
    for (int I = 0; I < 2; ++I)
#pragma unroll
        for (int J = 0; J < 2; ++J) {
            f32x16 a = RK_MF(W1p[I][0], Bop[J][0], f32x16{}); a = RK_MF(W1p[I][1], Bop[J][1], a);
            if (I == J) {
#pragma unroll
                for (int reg = 0; reg < 16; ++reg) a[reg] += (crow(reg, h) == r) ? __expf(T.gtot[J]) : 0.f; }
            phi[((I * 2 + J) * 2 + 0) * 64] = __builtin_bit_cast(u32x4, pack<0>(a)); phi[((I * 2 + J) * 2 + 1) * 64] = __builtin_bit_cast(u32x4, pack<1>(a));
            f32x16 p = RK_MF(Bop[I][0], W2p[J][0], f32x16{}); p = RK_MF(Bop[I][1], W2p[J][1], p); p = RK_MF(Kop[I][0], T.Vp[J][0], p); p = RK_MF(Kop[I][1], T.Vp[J][1], p);
            psi[((I * 2 + J) * 2 + 0) * 64] = (u32x4){cvt2(p[0], p[1]), cvt2(p[2], p[3]), cvt2(p[4], p[5]), cvt2(p[6], p[7])};
            psi[((I * 2 + J) * 2 + 1) * 64] = (u32x4){cvt2(p[8], p[9]), cvt2(p[10], p[11]), cvt2(p[12], p[13]), cvt2(p[14], p[15])};
        }
}
RK_DI void pass2_chain(unsigned char* ws, int q, int lane, bool do_store) {
    const int dir = q & 1;
    f32x16 H[2][2] = {{f32x16{}, f32x16{}}, {f32x16{}, f32x16{}}};
    u32x4 phi[8], psi[8];
    { const int u0 = q * NSUB + chain_unit(dir, 0);
      const u32x4* ph = (const u32x4*)(ws + WS_HALF + H_PHI) + (size_t)u0 * 512 + lane; const u32x4* ps = (const u32x4*)(ws + WS_HALF + H_PSI) + (size_t)u0 * 512 + lane;
#pragma unroll
      for (int f = 0; f < 8; ++f) { phi[f] = ph[f * 64]; psi[f] = ps[f * 64]; } }
    int uprev = q * NSUB + chain_unit(dir, 0);
#pragma unroll 1
    for (int j = 0; j < NSUB - 1; ++j) {
        const int un = q * NSUB + chain_unit(dir, j + 1 < NSUB - 1 ? j + 1 : j);
        u32x4 nphi[8], npsi[8];
        { const u32x4* ph = (const u32x4*)(ws + WS_HALF + H_PHI) + (size_t)un * 512 + lane; const u32x4* ps = (const u32x4*)(ws + WS_HALF + H_PSI) + (size_t)un * 512 + lane;
#pragma unroll
          for (int f = 0; f < 8; ++f) { nphi[f] = ph[f * 64]; npsi[f] = ps[f * 64]; } }
        bf16x8 Hp[2][2][2];
#pragma unroll
        for (int I = 0; I < 2; ++I)
#pragma unroll
            for (int J = 0; J < 2; ++J) { Hp[I][J][0] = pack<0>(H[I][J]); Hp[I][J][1] = pack<1>(H[I][J]); }
#pragma unroll
        for (int Ik = 0; Ik < 2; ++Ik)
#pragma unroll
            for (int Jv = 0; Jv < 2; ++Jv) {
                f32x16 a; const u32x4 p0 = psi[(Ik * 2 + Jv) * 2], p1 = psi[(Ik * 2 + Jv) * 2 + 1];
                a[0] = lo16(p0.x); a[1] = hi16(p0.x); a[2] = lo16(p0.y); a[3] = hi16(p0.y); a[4] = lo16(p0.z); a[5] = hi16(p0.z); a[6] = lo16(p0.w); a[7] = hi16(p0.w);
                a[8] = lo16(p1.x); a[9] = hi16(p1.x); a[10] = lo16(p1.y); a[11] = hi16(p1.y); a[12] = lo16(p1.z); a[13] = hi16(p1.z); a[14] = lo16(p1.w); a[15] = hi16(p1.w);
#pragma unroll
                for (int Ip = 0; Ip < 2; ++Ip) { a = RK_MF(__builtin_bit_cast(bf16x8, phi[(Ip * 2 + Ik) * 2 + 0]), Hp[Ip][Jv][0], a); a = RK_MF(__builtin_bit_cast(bf16x8, phi[(Ip * 2 + Ik) * 2 + 1]), Hp[Ip][Jv][1], a); }
                H[Ik][Jv] = a; }
        if (do_store) { u32x4* st = (u32x4*)(ws + WS_HALF + H_PSI) + (size_t)uprev * 512 + lane;
#pragma unroll
            for (int I = 0; I < 2; ++I)
#pragma unroll
                for (int J = 0; J < 2; ++J) { st[((I * 2 + J) * 2 + 0) * 64] = __builtin_bit_cast(u32x4, pack<0>(H[I][J])); st[((I * 2 + J) * 2 + 1) * 64] = __builtin_bit_cast(u32x4, pack<1>(H[I][J])); } }
        uprev = un;
#pragma unroll
        for (int f = 0; f < 8; ++f) { phi[f] = nphi[f]; psi[f] = npsi[f]; }
    }
    if (!do_store) { float chk = 0.f;
#pragma unroll
        for (int I = 0; I < 2; ++I)
#pragma unroll
            for (int J = 0; J < 2; ++J)
#pragma unroll
                for (int reg = 0; reg < 16; ++reg) chk += H[I][J][reg];
        if (chk == 123456.789f) ((float*)(ws + WS_END))[lane] = chk; }
}
RK_DI void pass2_half(unsigned char* ws, int q, int jv, int lane) {
    static_assert((NSUB - 1) % 3 == 0, "three-step rotation");
    const int dir = q & 1;
    bf16x8 Hp[2][2] = {{bf16x8{}, bf16x8{}}, {bf16x8{}, bf16x8{}}};
#define P2_LD(jj, PH, PS) do { const int jc_ = (jj) < NSUB - 1 ? (jj) : NSUB - 2; const int un_ = q * NSUB + chain_unit(dir, jc_); \
        const u32x4* ph_ = (const u32x4*)(ws + WS_HALF + H_PHI) + (size_t)un_ * 512 + lane; const u32x4* ps_ = (const u32x4*)(ws + WS_HALF + H_PSI) + (size_t)un_ * 512 + jv * 128 + lane; \
        _Pragma("unroll") for (int f = 0; f < 8; ++f) PH[f] = ph_[f * 64]; \
        PS[0] = ps_[0]; PS[1] = ps_[64]; PS[2] = ps_[256]; PS[3] = ps_[320]; } while (0)
#define P2_UNPK(A, p0, p1) do { A[0] = lo16(p0.x); A[1] = hi16(p0.x); A[2] = lo16(p0.y); A[3] = hi16(p0.y); A[4] = lo16(p0.z); A[5] = hi16(p0.z); A[6] = lo16(p0.w); A[7] = hi16(p0.w); \
        A[8] = lo16(p1.x); A[9] = hi16(p1.x); A[10] = lo16(p1.y); A[11] = hi16(p1.y); A[12] = lo16(p1.z); A[13] = hi16(p1.z); A[14] = lo16(p1.w); A[15] = hi16(p1.w); } while (0)
#define P2_STEP(jj, PH, PS) do { f32x16 a0, a1; P2_UNPK(a0, PS[0], PS[1]); P2_UNPK(a1, PS[2], PS[3]); \
        _Pragma("unroll") for (int Ip = 0; Ip < 2; ++Ip) { \
            a0 = RK_MF(__builtin_bit_cast(bf16x8, PH[(Ip * 2 + 0) * 2 + 0]), Hp[Ip][0], a0); a1 = RK_MF(__builtin_bit_cast(bf16x8, PH[(Ip * 2 + 1) * 2 + 0]), Hp[Ip][0], a1); \
            a0 = RK_MF(__builtin_bit_cast(bf16x8, PH[(Ip * 2 + 0) * 2 + 1]), Hp[Ip][1], a0); a1 = RK_MF(__builtin_bit_cast(bf16x8, PH[(Ip * 2 + 1) * 2 + 1]), Hp[Ip][1], a1); } \
        Hp[0][0] = pack<0>(a0); Hp[0][1] = pack<1>(a0); Hp[1][0] = pack<0>(a1); Hp[1][1] = pack<1>(a1); \
        u32x4* st_ = (u32x4*)(ws + WS_HALF + H_PSI) + (size_t)(q * NSUB + chain_unit(dir, (jj))) * 512 + jv * 128 + lane;        \
        st_[0] = __builtin_bit_cast(u32x4, Hp[0][0]); st_[64] = __builtin_bit_cast(u32x4, Hp[0][1]); st_[256] = __builtin_bit_cast(u32x4, Hp[1][0]); st_[320] = __builtin_bit_cast(u32x4, Hp[1][1]); } while (0)
    u32x4 phA[8], psA[4], phB[8], psB[4], phC[8], psC[4];
    P2_LD(0, phA, psA); P2_LD(1, phB, psB);
#pragma unroll 1
    for (int j = 0; j < NSUB - 1; j += 3) {
        P2_LD(j + 2, phC, psC); P2_STEP(j, phA, psA);
        P2_LD(j + 3, phA, psA); P2_STEP(j + 1, phB, psB);
        P2_LD(j + 4, phB, psB); P2_STEP(j + 2, phC, psC);
    }
#undef P2_LD
#undef P2_UNPK
#undef P2_STEP
}
RK_DI void pass3_dir(const int DIR, unsigned char* ws, LAS unsigned char* sb, int l, int bl, int hd, int c32, int lane, f32x16 (&Y)[2], float& bons) {
    Ctx c; setup_ctx(c, ws, sb, l, bl, hd, DIR, c32, lane);
    const int r = c.r, h = c.h;
    Tilde T; build_tilde<true>(c, T); __builtin_amdgcn_sched_barrier(0);
    bons += T.bon + __shfl_xor(T.bon, 32);
    bf16x8 Lk[2], Mp[2]; grams_la(c, T, Lk, Mp); __builtin_amdgcn_sched_barrier(0);
    bf16x8 Ab[2], Ak[2];
    {   f32x16 gb = f32x16{}, gk = f32x16{};
#pragma unroll
        for (int Ik = 0; Ik < 2; ++Ik)
#pragma unroll
            for (int S = 0; S < 2; ++S) { gb = RK_MF(T.Bt[Ik][S], T.Rt[Ik][S], gb); gk = RK_MF(T.Kt[Ik][S], T.Rt[Ik][S], gk); }
        tmask<false>(gb, r, h, DIR); tmask<false>(gk, r, h, DIR);
        Ab[0] = pack<0>(gb); Ab[1] = pack<1>(gb); Ak[0] = pack<0>(gk); Ak[1] = pack<1>(gk); }
    RK_STAGE(Ak[1]);
    bf16x8 H0p[2][2][2];
    { const int q = (bl * 8 + hd) * 2 + DIR, j = chain_pos(DIR, c32);
      if (j > 0) { const u32x4* st = (const u32x4*)(ws + WS_HALF + H_PSI) + (size_t)(q * NSUB + chain_unit(DIR, j - 1)) * 512 + lane;
#pragma unroll
          for (int I = 0; I < 2; ++I)
#pragma unroll
              for (int J = 0; J < 2; ++J) { H0p[I][J][0] = __builtin_bit_cast(bf16x8, st[((I * 2 + J) * 2 + 0) * 64]); H0p[I][J][1] = __builtin_bit_cast(bf16x8, st[((I * 2 + J) * 2 + 1) * 64]); } }
      else {
#pragma unroll
          for (int I = 0; I < 2; ++I)
#pragma unroll
              for (int J = 0; J < 2; ++J) { H0p[I][J][0] = bf16x8{}; H0p[I][J][1] = bf16x8{}; } } }
    bf16x8 Up[2][2];
    {   f32x16 xs[2];
#pragma unroll
        for (int Jv = 0; Jv < 2; ++Jv) {
            f32x16 x = RK_MF(Lk[0], T.Vp[Jv][0], f32x16{}); x = RK_MF(Lk[1], T.Vp[Jv][1], x);
#pragma unroll
            for (int Ik = 0; Ik < 2; ++Ik) { x = RK_MF(T.At[Ik][0], H0p[Ik][Jv][0], x); x = RK_MF(T.At[Ik][1], H0p[Ik][Jv][1], x); }
            xs[Jv] = x; }
        if (DIR) solve32p<1>(xs[0], xs[1], Mp); else solve32p<0>(xs[0], xs[1], Mp);
#pragma unroll
        for (int Jv = 0; Jv < 2; ++Jv) { Up[Jv][0] = pack<0>(xs[Jv]); Up[Jv][1] = pack<1>(xs[Jv]); }
        __builtin_amdgcn_sched_barrier(0); }
    __builtin_amdgcn_sched_barrier(0);
#pragma unroll
    for (int Iv = 0; Iv < 2; ++Iv) {
        f32x16 y = f32x16{};
#pragma unroll
        for (int Ik = 0; Ik < 2; ++Ik) { y = RK_MF(H0p[Ik][Iv][0], T.Rt[Ik][0], y); y = RK_MF(H0p[Ik][Iv][1], T.Rt[Ik][1], y); }
        y = RK_MF(Up[Iv][0], Ab[0], y); y = RK_MF(Up[Iv][1], Ab[1], y); y = RK_MF(T.Vp[Iv][0], Ak[0], y); y = RK_MF(T.Vp[Iv][1], Ak[1], y);
        Y[Iv] = y; }
}
RK_DI void pass3_unit(unsigned char* ws, LAS unsigned char* sb, int l, int v3, int lane, unsigned* ypark) {
    const int c32 = v3 % NSUB, bh = v3 / NSUB, bl = bh >> 3, hd = bh & 7, r = lane & 31, h = lane >> 5;
    float bons = 0.f;
    LAS float* ylds = (LAS float*)(sb + SBUF);
#pragma unroll 1
    for (int dir = 0; dir < 2; ++dir) {
        int lane_ = lane; asm volatile("" : "+v"(lane_));
        f32x16 Y[2]; pass3_dir(dir, ws, sb, l, bl, hd, c32, lane_, Y, bons);
        if (dir == 0) {
#pragma unroll
            for (int Iv = 0; Iv < 2; ++Iv)
#pragma unroll
                for (int d = 0; d < 8; ++d) ypark[(Iv * 8 + d) * 64 + lane] = cvt2(Y[Iv][2 * d], Y[Iv][2 * d + 1]); }
        else {
#pragma unroll
            for (int Iv = 0; Iv < 2; ++Iv)
#pragma unroll
                for (int reg = 0; reg < 16; ++reg) ylds[(Iv * 16 + reg) * 64 + lane] = Y[Iv][reg]; }
        __builtin_amdgcn_sched_barrier(0); }
    f32x16 YT[2];
#pragma unroll
    for (int Iv = 0; Iv < 2; ++Iv)
#pragma unroll
        for (int d = 0; d < 8; ++d) { const unsigned w = ypark[(Iv * 8 + d) * 64 + lane]; YT[Iv][2 * d] = ylds[(Iv * 16 + 2 * d) * 64 + lane] + lo16(w); YT[Iv][2 * d + 1] = ylds[(Iv * 16 + 2 * d + 1) * 64 + lane] + hi16(w); }
    Ctx c; setup_ctx(c, ws, sb, l, bl, hd, 0, c32, lane);
    RK_WAIT_LDS(); stage_slice(c, 1, RW_GD); stage_slice(c, 2, RW_GD + 64); RK_WAIT_DMA();
    float sm = 0.f;
#pragma unroll
    for (int Iv = 0; Iv < 2; ++Iv)
#pragma unroll
        for (int reg = 0; reg < 16; ++reg) sm += YT[Iv][reg];
    sm += __shfl_xor(sm, 32); const float mean = sm * (1.f / 64.f); float vq = 0.f;
#pragma unroll
    for (int Iv = 0; Iv < 2; ++Iv)
#pragma unroll
        for (int reg = 0; reg < 16; ++reg) { YT[Iv][reg] -= mean; vq += YT[Iv][reg] * YT[Iv][reg]; }
    vq += __shfl_xor(vq, 32); const float rstd = 1.f / sqrtf(vq * (1.f / 64.f) + LNX_EPS);
    const bf16* g2P = (const bf16*)(ws + WS_TAB + 524288) + (size_t)hd * 8192;
    const float* lnw = inp(I_LNW) + l * 512 + hd * 64; const float* lnb = inp(I_LNB) + l * 512 + hd * 64;
    bf16x8 sgp[4][2];
#pragma unroll
    for (int Ii = 0; Ii < 4; ++Ii) { f32x16 t = load_o2(c, 1 + (Ii >> 1), Ii & 1, RW_GD + 32 * Ii);
#pragma unroll
        for (int reg = 0; reg < 16; ++reg) t[reg] = sigm(t[reg]);
        sgp[Ii][0] = pack<0>(t); sgp[Ii][1] = pack<1>(t); __builtin_amdgcn_sched_barrier(0); }
    RK_WAIT_LDS(); LAS unsigned char* st = c.sb + SBUF;
#pragma unroll
    for (int Iv = 0; Iv < 2; ++Iv) {
        f32x16 gt = f32x16{};
#pragma unroll
        for (int Ii = 0; Ii < 4; ++Ii)
#pragma unroll
            for (int S = 0; S < 2; ++S) { gt = RK_MF(*(const bf16x8*)(g2P + ((Ii * 2 + Iv) * 2 + S) * 512 + c.lofs), sgp[Ii][S], gt); if (S) RK_STAGE(gt); }
        const f32x16 vt = load_o2(c, 0, Iv, RW_V + hd * 64 + 32 * Iv);
#pragma unroll
        for (int g = 0; g < 4; ++g) { const int v0 = 32 * Iv + 8 * g + 4 * h; const f32x4 lw = *(const f32x4*)(lnw + v0), lb = *(const f32x4*)(lnb + v0); float o[4];
#pragma unroll
            for (int j = 0; j < 4; ++j) { const int reg = 4 * g + j; o[j] = (YT[Iv][reg] * rstd * lw[j] + lb[j] + bons * vt[reg]) * gt[reg]; }
            *(LAS unsigned long long*)(st + r * 144 + 2 * v0) = (unsigned long long)cvt2(o[0], o[1]) | ((unsigned long long)cvt2(o[2], o[3]) << 32); }
    }
    asm volatile("s_waitcnt lgkmcnt(0)" ::: "memory");
    bf16* RO = (bf16*)(ws + WS_HALF + H_PP) + (size_t)c.m0 * PPW + C_QD + hd * 64;
#pragma unroll
    for (int i = 0; i < 4; ++i) { const int id = i * 64 + lane, row = id >> 3, ch = id & 7; const u32x4 v = *(const LAS u32x4*)(st + row * 144 + ch * 16); *(u32x4*)(RO + (size_t)row * PPW + ch * 8) = v; }
    asm volatile("s_waitcnt lgkmcnt(0)" ::: "memory");
}
}

__device__ __forceinline__ void ph_rwkv1(Frame& F, int l) {
    const int gw = F.bid * NWAVES + FWAVE(), NGW = F.G * NWAVES; LAS unsigned char* sb = F.lds + FWAVE() * (4 * rk::SBUF);
    const bool skew = NGW == 2048;
#pragma unroll 1
    for (int r = 0;; ++r) {
        int u = gw + r * NGW;
        if (skew && r == 2) u = (F.bid < 64 && FWAVE() < 4) ? 2 * NGW + F.bid * 4 + FWAVE() : NUNIT;
        if (u >= NUNIT) break;
        rk::pass1_unit(F.ws, sb, l, u, otid() & 63);
    }
    asm volatile("s_waitcnt vmcnt(0) lgkmcnt(0)" ::: "memory");
}
__device__ __forceinline__ void ph_rwkv3(Frame& F, int l, bool ctx_emit) {
    const int gw = F.bid * NWAVES + FWAVE(), NGW = F.G * NWAVES; LAS unsigned char* sb = F.lds + FWAVE() * (4 * rk::SBUF);
    unsigned* ypark = (unsigned*)(F.ws + WS_END) + (size_t)gw * 1024;
    const int per = ctx_emit ? rk::NSUB : rk::NSUB - 8, nun = 16 * per;
#pragma unroll 1
    for (int r = 0;; ++r) {
        int j = gw + r * NGW;
        if (r == 1 && NGW == 2048) j = (F.bid < P3X_WGS && FWAVE() < 4) ? NGW + F.bid * 4 + FWAVE() : nun;
        if (j >= nun) break;
        const int v3 = (j / per) * rk::NSUB + (rk::NSUB - per) + j % per; rk::pass3_unit(F.ws, sb, l, v3, otid() & 63, ypark); }
    asm volatile("s_waitcnt vmcnt(0) lgkmcnt(0)" ::: "memory");
}
__device__ __forceinline__ void ph_mixer(Frame& F, int l, int half, int rep) {
    const bool ctx_out = (l == 0);
#ifdef EXTRA_P2
    if (F.bid < 4 && rep == 0) rk::pass2_chain(F.ws, F.bid * 8 + FWAVE(), otid() & 63, false);
#endif
    if (F.bid < 16 && rep == 0 && FWAVE() < 4) { const int ch = F.bid * 4 + FWAVE(); rk::pass2_half(F.ws, ch >> 1, ch & 1, otid() & 63); }
    __syncthreads();
    unsigned* ctr0 = F.ctl + CW_ATT + ((l * 2 + half) * 2 + rep) * 8 * 64;
    LAS unsigned* slot = (LAS unsigned*)(F.lds + MISC_OFF);
    const bf16* PP = (const bf16*)(F.ws + WS_HALF + H_PP); const bf16* QM = (const bf16*)(F.ws + WS_HALF + H_QM); const bf16* KVM = (const bf16*)(F.ws + WS_HALF + H_KVM);
    bf16* MO = (bf16*)(F.ws + WS_HALF + H_MO); bf16* DUM = (bf16*)(F.ws + WS_END);
    const int nper = ctx_out ? 68 : 64;
    int xk = 0;
    for (;;) {
        const int xq = (F.bid + xk) & 7;
        if (FTID() == 0) slot[0] = atomicAdd(ctr0 + xq * 64, 1u);
        __syncthreads();
        const int v = (int)slot[0];
        __syncthreads();
        if (v >= nper) { if (++xk == 8) break; continue; }
        int type, bl, h, qb, nkeys, qrow0; const bool lat_u = v < 64;
        { int p; if (lat_u) { type = v >> 5; p = 2 * xq + ((v >> 4) & 1); qb = v & 15; nkeys = RPB; } else { const int w = v - 64; type = w >> 1; p = 2 * xq + (w & 1); qb = 0; nkeys = CTX; }
          bl = p >> 3; h = p & 7; qrow0 = lat_u ? bl * RPB + CTX + qb * 256 : bl * RPB; }
        const int krow0 = bl * RPB;
        att::Args a;
        if (type == 0) {
            a.Q = QM + (size_t)qrow0 * 768 + h * 96; a.ldq = 768; a.K0 = KVM + (size_t)krow0 * KVP + h * 128; a.ldk0 = KVP; a.K1 = PP + (size_t)krow0 * PPW + C_KR; a.ldk1 = PPW;
            a.V = KVM + (size_t)krow0 * KVP + h * 128 + 64; a.ldv = KVP; a.O = (rep ? DUM : MO) + (size_t)qrow0 * 512 + h * 64; a.ldo = 512; a.nkeys = nkeys;
            a.rope_t0 = lat_u ? qb * 256 : -1; a.tc = (const float*)(F.ws + WS_T8C); a.ts = (const float*)(F.ws + WS_T8S);
            at96::Args b; b.Q = a.Q; b.ldq = a.ldq; b.K0 = a.K0; b.ldk0 = a.ldk0; b.K1 = a.K1; b.ldk1 = a.ldk1; b.V = a.V; b.ldv = a.ldv; b.O = a.O; b.ldo = a.ldo; b.nkeys = a.nkeys;
            b.rope_t0 = a.rope_t0; b.tc = a.tc; b.ts = a.ts;
            at96::unit(b, (char*)F.ldsg);
        } else {
            const int kvh = h >> 2;
            a.Q = PP + (size_t)qrow0 * PPW + C_GQ + h * 64; a.ldq = PPW; a.K0 = PP + (size_t)krow0 * PPW + C_GK + kvh * 64; a.ldk0 = PPW; a.K1 = a.K0; a.ldk1 = PPW;
            a.V = PP + (size_t)krow0 * PPW + C_GV + kvh * 64; a.ldv = PPW; a.O = rep ? DUM + (size_t)qrow0 * 512 + h * 64 : (bf16*)PP + (size_t)qrow0 * PPW + C_GQ + h * 64; a.ldo = rep ? 512 : PPW; a.nkeys = nkeys; a.rope_t0 = -1; a.tc = nullptr; a.ts = nullptr;
            at64::Args b; b.Q = a.Q; b.ldq = a.ldq; b.K = a.K0; b.ldk = a.ldk0; b.V = a.V; b.ldv = a.ldv; b.O = a.O; b.ldo = a.ldo; b.nkeys = a.nkeys;
            at64::unit(b, (char*)F.ldsg);
        }
    }
}

enum { OP_W0 = 0, OP_NORM1, OP_INPROJ, OP_PREP, OP_UP, OP_MIXER, OP_FINISH, OP_GATE, OP_MERGE, OP_WOUT, OP_NORM2, OP_FFUP, OP_FFDOWN, OP_FINAL };
constexpr int N_PHASES = 40;
__global__ void __launch_bounds__(NWAVES * 64, 2) trunk_fwd(Args args) {
    extern __shared__ __attribute__((aligned(16))) unsigned char lds[];
    Frame F;
    F.lds = (LAS unsigned char*)lds; F.ldsg = lds;
    F.G = gridDim.x; F.bid = blockIdx.x; F.ws = args.ws; F.ctl = (unsigned*)(args.ws + WS_CTL); F.out = args.out;
    volatile LAS unsigned* MISC = (volatile LAS unsigned*)(F.lds + MISC_OFF);
    for (int u = threadIdx.x; u < 32; u += NWAVES * 64) MISC[u] = 0u;
    __syncthreads();
    const int lo = args.ph_lo, hi = args.ph_hi;
    XcdBarrier bar = xcd_barrier_post(F.ctl + CW_BAR, MISC + 8);
#ifdef EXTRA_OP
    for (int pp = 2 * lo; pp < 2 * hi; ++pp) { const int p = pp >> 1, rep = pp & 1;
#else
    for (int p = lo; p < hi; ++p) { const int rep = 0;
#endif
        GAS unsigned char* wsg_ = (GAS unsigned char*)args.ws; GAS float* outg_ = (GAS float*)args.out; int bid_ = blockIdx.x, G_ = gridDim.x;
        asm volatile("" : "+s"(wsg_), "+s"(outg_), "+s"(bid_), "+s"(G_));
        unsigned char* ws = (unsigned char*)wsg_; float* outp = (float*)outg_;
        F.ws = ws; F.out = outp; F.bid = bid_; F.G = G_; F.ctl = (unsigned*)(ws + WS_CTL);
        unsigned char* wt = ws + WS_WT; const bf16* XN = (const bf16*)(ws + WS_XN); float* ctxx = (float*)(ws + WS_CTXX);
        int op, l = 0, half = 0;
        if (p == 0) op = OP_W0; else if (p == N_PHASES - 1) op = OP_FINAL;
        else { const int q = p - 1, r = q % 19; l = q / 19; if (r == 0) op = OP_NORM1; else if (r <= 8) { half = 0; op = OP_INPROJ + (r - 1); } else if (r <= 15) { half = 1; op = OP_PREP + (r - 9); } else op = OP_NORM2 + (r - 16); }
#ifdef ONLY_OP
        op = ONLY_OP;
#endif
#ifdef EXTRA_OP
        if (rep && op != EXTRA_OP) continue;
#endif
        const float* xl = (l == 0) ? inp(I_X) : F.out; const float* xc = (l == 0) ? inp(I_CTX) : ctxx;
        const bool ctx_out = (l == 0);
        const int nMf = ctx_out ? 68 : 64, nMh = ctx_out ? 34 : 32, skipf = ctx_out ? 0 : 1;
        switch (op) {
        case OP_W0: ph_weights(F, 0); break;
        case OP_NORM1: if (l == 1) ph_weights(F, 1); ph_norm(F, l, xl, xc, inp(I_G1) + l * DM, 0, false, (l == 1) ? (const float*)(ws + WS_END) : nullptr); break;
#define RUN_INPROJ(hh) do { pg8::Gemm g_{XN + (size_t)(hh) * HM * DM, (const bf16*)(wt + WT_IN), DM, DM, DM}; pg8::TileOrder S_; S_.init(HM / 256, PPW / 256, F.G, F.bid, 0); \
            pg8::Epi<pg8::EPI_BF16> E_{}; E_.O = (bf16*)(ws + WS_HALF + H_PP); E_.ldc = PPW; pg8::gemm_phase<pg8::Epi<pg8::EPI_BF16>, pg8::TileOrder, true>(F.lds, g_, S_, E_); } while (0)
        case OP_INPROJ: RUN_INPROJ(half); break;
        case OP_PREP: if (rep == 0) ph_prep(F, l, half); ph_rwkv1(F, l); break;
        case OP_UP: {
            { pg8::Gemm g{(const bf16*)(ws + WS_HALF + H_PP) + C_QD, (const bf16*)(wt + WT_QU), PPW, 384, 384}; pg8::TileOrder S; S.init(HM / 256, 3, F.G, F.bid, 0);
              pg8::Epi<pg8::EPI_ROWSCALE> E{}; E.O = (bf16*)(ws + WS_HALF + H_QM); E.ldc = 768; E.rs = (const float*)(ws + WS_RSQ);
              pg8::gemm_phase<pg8::Epi<pg8::EPI_ROWSCALE>, pg8::TileOrder, true>(F.lds, g, S, E); }
            { pg8::Gemm g{(const bf16*)(ws + WS_HALF + H_PP) + C_KVD, (const bf16*)(wt + WT_KVU), PPW, 256, 256}; pg8::TileOrder S; S.init(HM / 256, 4, F.G, (F.bid + 102) % F.G, 0);
              pg8::Epi<pg8::EPI_ROWSCALE> E{}; E.O = (bf16*)(ws + WS_HALF + H_KVM); E.ldc = KVP; E.rs = (const float*)(ws + WS_RSKV);
              pg8::gemm_phase<pg8::Epi<pg8::EPI_ROWSCALE>, pg8::TileOrder, true>(F.lds, g, S, E); } } break;
        case OP_MIXER: ph_mixer(F, l, half, rep); break;
        case OP_FINISH: ph_rwkv3(F, l, ctx_out); if (ctx_out) __syncthreads(); break;
        case OP_GATE: {
            const int gs = ctx_out ? P3X_WGS : 0;
            if (F.bid >= gs) { pg8::Gemm g{XN + (size_t)half * HM * DM, (const bf16*)(wt + WT_G), DM, DM, DM}; pg8::TileOrder S; S.init(nMh, 12, F.G - gs, F.bid - gs, skipf);
                pg8::Epi<pg8::EPI_SIGMOID> E{}; E.O = (bf16*)(ws + WS_G0); E.O1 = (bf16*)(ws + WS_G1); E.O2 = (bf16*)(ws + WS_G2); E.ldc = DM;
                pg8::gemm_phase<pg8::Epi<pg8::EPI_SIGMOID>, pg8::TileOrder, true>(F.lds, g, S, E); } } break;
        case OP_MERGE: {
            for (int i = 0; i < 3; ++i) {
                const bf16* A = (i == 0) ? (const bf16*)(ws + WS_HALF + H_PP) + C_GQ : (i == 1) ? (const bf16*)(ws + WS_HALF + H_PP) + C_QD : (const bf16*)(ws + WS_HALF + H_MO);
                pg8::Gemm g{A, (const bf16*)(wt + WT_BR) + (size_t)i * DM * 512, (i == 2) ? 512 : PPW, 512, 512}; pg8::TileOrder S; S.init(nMh, 4, F.G, F.bid, skipf);
                pg8::Epi<pg8::EPI_GATEMUL> E{}; E.O = (bf16*)(ws + WS_MIX); E.ldc = DM; E.G = (const bf16*)(ws + ((i == 0) ? WS_G0 : (i == 1) ? WS_G1 : WS_G2)); E.ldg = DM; E.first = (i == 0);
                pg8::gemm_phase<pg8::Epi<pg8::EPI_GATEMUL>, pg8::TileOrder, true>(F.lds, g, S, E); }
            } break;
        case OP_WOUT: {
            pg8::Gemm g{(const bf16*)(ws + WS_MIX), (const bf16*)(wt + WT_OUT), DM, DM, DM}; pg8::TileOrder S; S.init(nMh, 4, F.G, F.bid, skipf);
            pg8::Epi<pg8::EPI_RESID> E{}; E.xsl = xl; E.xsc = xc; E.xdl = F.out; E.xdc = ctxx; E.gate = (const float*)(ws + WS_MOD) + (size_t)l * 5 * 6144 + 2048; E.pm_off = half * 34; E.part = nullptr; E.kslice = 1;
            pg8::gemm_phase<pg8::Epi<pg8::EPI_RESID>, pg8::TileOrder, true>(F.lds, g, S, E);
            if (half == 0) RUN_INPROJ(1);
            } break;
        case OP_NORM2: ph_norm(F, l, F.out, ctxx, inp(I_G2) + l * DM, 1, !ctx_out); break;
        case OP_FFUP: {
            pg8::Gemm g{XN, (const bf16*)(wt + WT_F1), DM, DM, DM}; pg8::TileOrder S; S.init(nMf, 16, F.G, F.bid, skipf);
            pg8::Epi<pg8::EPI_RELU2> E{}; E.O = (bf16*)(ws + WS_HID); E.ldc = DFF;
            pg8::gemm_phase<pg8::Epi<pg8::EPI_RELU2>, pg8::TileOrder, true>(F.lds, g, S, E); } break;
        case OP_FFDOWN: {
            pg8::Gemm g{(const bf16*)(ws + WS_HID), (const bf16*)(wt + WT_F2), DFF, DFF, DFF}; pg8::TileOrder S; S.init(64, 4, F.G, F.bid, 1);
            pg8::Epi<pg8::EPI_RESID> E{}; E.xsl = F.out; E.xsc = ctxx; E.xdl = F.out; E.xdc = ctxx; E.gate = (const float*)(ws + WS_MOD) + (size_t)l * 5 * 6144 + 5120; E.pm_off = 0; E.part = nullptr; E.kslice = 1;
            pg8::gemm_phase<pg8::Epi<pg8::EPI_RESID>, pg8::TileOrder, true>(F.lds, g, S, E);
            if (ctx_out) { pg8::Gemm g2{(const bf16*)(ws + WS_HID), (const bf16*)(wt + WT_F2), DFF, DFF, DFF / 4}; pg8::CtxSplitOrder S2; S2.init(F.G, F.bid, DFF / 4);
                E.part = (float*)(ws + WS_END); E.kslice = DFF / 4; pg8::gemm_phase<pg8::Epi<pg8::EPI_RESID>, pg8::CtxSplitOrder, true>(F.lds, g2, S2, E); } } break;
        default: ph_final(F); break;
        }
        if (op == OP_FINISH && ctx_out) continue;
#ifdef EXTRA_OP
        if (pp + 1 < 2 * hi) xcd_barrier(bar);
#else
        if (p + 1 < hi) xcd_barrier(bar);
#endif
    }
}

extern "C" void kernel_launch(void* const* d_in, const int* in_sizes, int n_in, void* d_out, int out_size, void* d_ws, size_t ws_size, hipStream_t stream) {
    static int grid = 0;
    if (grid == 0) {
        if (n_in != 31 || out_size != NB * SEQ * DM || ws_size < WS_END + 12 * MiB) { fprintf(stderr, "kernel_launch: unexpected shapes (n_in %d out %d ws %zu, need ws >= %zu)\n", n_in, out_size, ws_size, (size_t)WS_END); grid = -1; return; }
        int dev = 0, cus = 0;
        if (hipGetDevice(&dev) != hipSuccess || hipDeviceGetAttribute(&cus, hipDeviceAttributeMultiprocessorCount, dev) != hipSuccess) { grid = -1; return; }
        if (hipFuncSetAttribute((const void*)trunk_fwd, hipFuncAttributeMaxDynamicSharedMemorySize, LDS_BYTES) != hipSuccess) { fprintf(stderr, "kernel_launch: hipFuncSetAttribute failed\n"); grid = -1; return; }
        grid = cus;
    }
    if (grid < 0) return;
    (void)hipMemsetAsync((char*)d_ws + WS_CTL, 0, CTL_BYTES, stream);
    Args a{};
    for (int i = 0; i < 31; ++i) a.in[i] = (const float*)d_in[i];
    a.out = (float*)d_out; a.ws = (unsigned char*)d_ws;
#if ONE_LAUNCH
    a.ph_lo = 0; a.ph_hi = N_PHASES;
    hipLaunchKernelGGL(trunk_fwd, dim3(grid), dim3(NWAVES * 64), LDS_BYTES, stream, a);
#else
    for (int p = 0; p < N_PHASES; ++p) { a.ph_lo = p; a.ph_hi = p + 1; hipLaunchKernelGGL(trunk_fwd, dim3(grid), dim3(NWAVES * 64), LDS_BYTES, stream, a); }
#endif
}
```

```cpp
#include <hip/hip_runtime.h>
#include <hip/hip_bf16.h>
#include <cstdio>
#include <cstdint>

#ifndef ONE_LAUNCH
#define ONE_LAUNCH 1
#define P3X_WGS 32
#define P2_WGS 8
#endif

constexpr int DM = 1024, NB = 4, SEQ = 4096, CTX = 256, RPB = SEQ + CTX  , MROWS = NB * RPB  , HM = 2 * RPB  ;
constexpr int NIN = 6432, PPW = 3584  , NGATE = 3072;
constexpr int C_GQ = 0, C_GK = 512, C_GV = 640, C_RW = 768, C_QD = 2688, C_KVD = 3072, C_KR = 3328, C_GATE = 3360;
constexpr int RW_R = 0, RW_K = 512, RW_V = 1024, RW_WD = 1536, RW_AD = 1664, RW_GD = 1792, RWIN = 1920;
constexpr int DFF = 4096;
constexpr float NORM_EPS = 1e-6f, LNX_EPS = 64e-5f;

__device__ __forceinline__ int otid() { int t = threadIdx.x; asm volatile("" : "+v"(t)); return t; }
namespace pg8 {
#define PG8_LAS __attribute__((address_space(3)))
typedef unsigned short bf16_t;
typedef short bf16x8 __attribute__((ext_vector_type(8)));
typedef float f32x4 __attribute__((ext_vector_type(4)));
typedef unsigned u32x4 __attribute__((ext_vector_type(4)));
constexpr int BM = 256, BK = 64, HALF = 128, HTB = HALF * BK * 2, STAGE_BYTES = 8 * HTB, NXCD = 8, WGM = 8;

__host__ __device__ __forceinline__ int lds_byte(int r, int c) { const int st = (r >> 4) * 2 + (c >> 5), rr = r & 15, cc = c & 31, ob = rr * 64 + cc * 2; return st * 1024 + (ob ^ (((ob >> 9) & 1) << 5)); }
__host__ __device__ __forceinline__ void stage_rc(int b, int& R, int& C) { const int st = b / 1024, sb = b % 1024, swz = sb ^ (((sb >> 9) & 1) << 5); R = (st >> 1) * 16 + swz / 64; C = (st & 1) * 32 + (swz % 64) / 2; }
__host__ __device__ __forceinline__ int perm32(int rho) { const int n = rho >> 4, i = rho & 15; return 8 * (i >> 2) + 4 * n + (i & 3); }

struct Unit { int pm, pn, ka, set; };
struct Gemm { const bf16_t* A; const bf16_t* Bt; int lda, ldb, K; };

struct TileOrder {
    static constexpr bool MULTI = false;
    int nM, nN, nwg, G, c, skipctx;
    __device__ __forceinline__ void init(int nM_, int nN_, int G_, int c_, int skip_) { nM = nM_; nN = nN_; nwg = nM * nN; G = G_; c = c_; skipctx = skip_; }
    __device__ __forceinline__ bool next(int i, Unit& u) const {
        const long L = (long)i * G + c; if (L >= nwg) return false;
        int wgid = (int)L; { const int q = nwg / NXCD, r = nwg % NXCD, xcd = wgid % NXCD, off = wgid / NXCD; wgid = (xcd < r ? xcd * (q + 1) : r * (q + 1) + (xcd - r) * q) + off; }
        const int nig = WGM * nN, gid = wgid / nig, fm = gid * WGM, gsz = (nM - fm) < WGM ? (nM - fm) : WGM;
        u.pm = fm + ((wgid % nig) % gsz); u.pn = (wgid % nig) / gsz; u.ka = 0; u.set = 0;
        if (skipctx) u.pm = u.pm + u.pm / 16 + 1;
        return true;
    }
    __device__ __forceinline__ void a_ready(const Unit&) const {}
    __device__ __forceinline__ void done(const Unit&) const {}
};

struct BranchOrder {
    static constexpr bool MULTI = true;
    TileOrder T; long dA1, dA2, dB; int lda0, dlda;
    __device__ __forceinline__ bool next(int i, Unit& u) const { if (i >= 3) return false; if (!T.next(0, u)) return false; u.set = i; return true; }
    __device__ __forceinline__ void opnd(const Unit& u, const Gemm& g, const bf16_t*& A, int& lda, const bf16_t*& Bt) const {
        A = g.A + (long)(u.set & 1) * dA1 + (long)(u.set >> 1) * dA2; lda = lda0 - (u.set >> 1) * dlda; Bt = g.Bt + (long)u.set * dB; }
    __device__ __forceinline__ void a_ready(const Unit&) const {}
    __device__ __forceinline__ void done(const Unit&) const {}
};
struct CtxSplitOrder {
    static constexpr bool MULTI = false;
    int G, c, kslice;
    __device__ __forceinline__ void init(int G_, int c_, int kslice_) { G = G_; c = c_; kslice = kslice_; }
    __device__ __forceinline__ bool next(int i, Unit& u) const { const int L = i * G + c; if (L >= 64) return false; const int t = L >> 2; u.pm = (t >> 2) * 17; u.pn = t & 3; u.ka = (L & 3) * kslice; u.set = 0; return true; }
    __device__ __forceinline__ void a_ready(const Unit&) const {}
    __device__ __forceinline__ void done(const Unit&) const {}
};
struct CtxTilesOrder {
    static constexpr bool MULTI = false;
    int G, c, nN;
    __device__ __forceinline__ void init(int G_, int c_, int nN_) { G = G_; c = c_; nN = nN_; }
    __device__ __forceinline__ bool next(int i, Unit& u) const { const int L = i * G + c; if (L >= 4 * nN) return false; u.pm = (L / nN) * 17; u.pn = L % nN; u.ka = 0; u.set = 0; return true; }
    __device__ __forceinline__ void a_ready(const Unit&) const {}
    __device__ __forceinline__ void done(const Unit&) const {}
};
__device__ __forceinline__ unsigned cvt_pk_bf16(float lo, float hi) { unsigned r; asm volatile("v_cvt_pk_bf16_f32 %0, %1, %2" : "=v"(r) : "v"(lo), "v"(hi)); return r; }
__device__ __forceinline__ float bf_lo(unsigned w) { return __uint_as_float(w << 16); }
__device__ __forceinline__ float bf_hi(unsigned w) { return __uint_as_float(w & 0xffff0000u); }

enum { EPI_BF16 = 0, EPI_RELU2 = 1, EPI_SIGMOID = 2, EPI_ROWSCALE = 3, EPI_MLAQ = 4, EPI_GATEMUL0 = 5, EPI_GATEMUL = 6, EPI_RESID = 7 };
template <int MODE, bool HN = false> struct Epi {
    static constexpr bool PERM = true, AFTER_DRAIN = false; static constexpr int NBJ = HN ? 1 : 2;
    bf16_t* O; int ldc;
    bf16_t* O1; bf16_t* O2;
    const float* rs;
    const PG8_LAS float* rsl;
    const bf16_t* G; int ldg;
    long dG1, dG2; int multi;
    const float* tc; const float* ts;
    int first;
    int pm_off, kslice;
    float* part;
    const void* xsl; const void* xsc; bf16_t* xdl; bf16_t* xdc; const float* gate; int sbf;
    __device__ __forceinline__ void operator()(const f32x4 (&acc)[2][2][4][2], const Unit& u, int wr, int wc, int fr, int fq) const {
        const int col0 = u.pn * (HN ? HALF : BM) + wc * 32 + 8 * fq;
        if constexpr (MODE == EPI_RESID) {
            int fro = fr; asm volatile("" : "+v"(fro));
            const int gpm = __builtin_amdgcn_readfirstlane(u.pm + pm_off), b = gpm / 17, t = gpm % 17;
            const size_t xo = (t == 0) ? (size_t)(b * CTX) * DM : (size_t)(b * SEQ + (t - 1) * 256) * DM;
            const long dsrc = (const char*)xsc - (const char*)xsl, ddst = (const char*)xdc - (const char*)xdl;
            const char* sbase = (const char*)xsl + ((t == 0) ? dsrc : 0L);
            const float* xs = (const float*)sbase + xo; const bf16_t* xb = (const bf16_t*)sbase + xo;
            bf16_t* xd = (bf16_t*)((char*)xdl + ((t == 0) ? ddst : 0L)) + xo;
            const float* gv = gate + (size_t)((t == 0) ? 4 : b) * 6144;
            f32x4 g[2][2];
#pragma unroll
            for (int bj = 0; bj < NBJ; ++bj)
#pragma unroll
                for (int n = 0; n < 2; ++n) g[bj][n] = *(const f32x4*)(gv + col0 + bj * HALF + 4 * n);
            if (u.ka != 0) {
                float* pp = part + (size_t)(u.ka / kslice - 1) * 1048576 + (size_t)(b * CTX) * DM;
#pragma unroll
                for (int ai = 0; ai < 2; ++ai)
#pragma unroll
                    for (int m = 0; m < 4; ++m) { const size_t ro = (size_t)(ai * HALF + wr * 64 + m * 16 + fro) * DM + col0;
#pragma unroll
                        for (int bj = 0; bj < NBJ; ++bj)
#pragma unroll
                            for (int n = 0; n < 2; ++n) *(f32x4*)(pp + ro + bj * HALF + 4 * n) = g[bj][n] * acc[ai][bj][m][n]; }
            } else {
#pragma unroll
                for (int am = 0; am < 4; ++am) { const int ai = am >> 1, m0 = (am & 1) * 2; f32x4 xv[2][2][2];
                    if (sbf) { u32x4 xw[2][2];
#pragma unroll
                        for (int mm = 0; mm < 2; ++mm) { const size_t ro = (size_t)(ai * HALF + wr * 64 + (m0 + mm) * 16 + fro) * DM + col0;
#pragma unroll
                            for (int bj = 0; bj < NBJ; ++bj) xw[mm][bj] = *(const u32x4*)(xb + ro + bj * HALF); }
#pragma unroll
                        for (int mm = 0; mm < 2; ++mm)
#pragma unroll
                            for (int bj = 0; bj < NBJ; ++bj) { const u32x4 w = xw[mm][bj];
                                xv[mm][bj][0] = (f32x4){bf_lo(w.x), bf_hi(w.x), bf_lo(w.y), bf_hi(w.y)}; xv[mm][bj][1] = (f32x4){bf_lo(w.z), bf_hi(w.z), bf_lo(w.w), bf_hi(w.w)}; } }
                    else {
#pragma unroll
                        for (int mm = 0; mm < 2; ++mm) { const size_t ro = (size_t)(ai * HALF + wr * 64 + (m0 + mm) * 16 + fro) * DM + col0;
#pragma unroll
                            for (int bj = 0; bj < NBJ; ++bj)
#pragma unroll
                                for (int n = 0; n < 2; ++n) xv[mm][bj][n] = *(const f32x4*)(xs + ro + bj * HALF + 4 * n); } }
#pragma unroll
                    for (int mm = 0; mm < 2; ++mm) { const size_t ro = (size_t)(ai * HALF + wr * 64 + (m0 + mm) * 16 + fro) * DM + col0;
#pragma unroll
                        for (int bj = 0; bj < NBJ; ++bj) { const f32x4 y0 = xv[mm][bj][0] + g[bj][0] * acc[ai][bj][m0 + mm][0], y1 = xv[mm][bj][1] + g[bj][1] * acc[ai][bj][m0 + mm][1];
                            u32x4 w; w.x = cvt_pk_bf16(y0[0], y0[1]); w.y = cvt_pk_bf16(y0[2], y0[3]); w.z = cvt_pk_bf16(y1[0], y1[1]); w.w = cvt_pk_bf16(y1[2], y1[3]);
                            *(u32x4*)(xd + ro + bj * HALF) = w; } } } }
        } else {
            const int row0 = u.pm * BM + wr * 64 + fr;
#pragma unroll
            for (int am = 0; am < 4; ++am) { const int ai = am >> 1, m0 = (am & 1) * 2;
                float rsv[4] = {1.f, 1.f, 1.f, 1.f}; u32x4 gwv[4][2], owv[4][2]; bool accum = false;
                if constexpr (MODE == EPI_ROWSCALE || MODE == EPI_MLAQ) {
#pragma unroll
                    for (int m = m0; m < m0 + 2; ++m) rsv[m] = rsl ? rsl[ai * HALF + wr * 64 + m * 16 + fr] : rs[row0 + ai * HALF + m * 16]; }
                if constexpr (MODE == EPI_GATEMUL0 || MODE == EPI_GATEMUL) {
                    const bf16_t* Gs = multi ? G + (long)(u.set & 1) * dG1 + (long)(u.set >> 1) * dG2 : G; accum = (MODE == EPI_GATEMUL) && !(multi ? u.set == 0 : first);
#pragma unroll
                    for (int m = m0; m < m0 + 2; ++m)
#pragma unroll
                        for (int bj = 0; bj < NBJ; ++bj) { const int row = row0 + ai * HALF + m * 16; gwv[m][bj] = *(const u32x4*)(Gs + (size_t)row * ldg + col0 + bj * HALF);
                            if (accum) owv[m][bj] = *(const u32x4*)(O + (size_t)row * ldc + col0 + bj * HALF); }
                    asm volatile("" ::: "memory"); }
#pragma unroll
                for (int m = m0; m < m0 + 2; ++m) { const int row = row0 + ai * HALF + m * 16; bf16_t* rowp = O + (size_t)row * ldc + col0;
                    if constexpr (MODE == EPI_SIGMOID && !HN) { const int bi = u.pn >> 2; rowp += (long)(bi & 1) * (O1 - O) + (long)(bi >> 1) * (O2 - O) - bi * 4 * BM; }
                    float rsc = 1.f; int pr = 0, pc = 0; bool lat = false;
                    if constexpr (MODE == EPI_ROWSCALE || MODE == EPI_MLAQ) rsc = rsv[m];
                    if constexpr (MODE == EPI_MLAQ) { const int s = row % RPB; lat = s >= CTX; const int tt = s - CTX; pr = (tt >> 6) & 63; pc = tt & 63; }
#pragma unroll
                    for (int bj = 0; bj < NBJ; ++bj) { f32x4 v0 = acc[ai][bj][m][0], v1 = acc[ai][bj][m][1];
                        if constexpr (MODE == EPI_RELU2) {
#pragma unroll
                            for (int e = 0; e < 4; ++e) { float a = fmaxf(v0[e], 0.f), b = fmaxf(v1[e], 0.f); v0[e] = a * a; v1[e] = b * b; } }
                        if constexpr (MODE == EPI_SIGMOID) {
#pragma unroll
                            for (int e = 0; e < 4; ++e) { v0[e] = 1.f / (1.f + __expf(-v0[e])); v1[e] = 1.f / (1.f + __expf(-v1[e])); } }
                        if constexpr (MODE == EPI_ROWSCALE || MODE == EPI_MLAQ) { v0 = v0 * rsc; v1 = v1 * rsc; }
                        if constexpr (MODE == EPI_MLAQ) {
                            const int g32 = u.pn * 8 + bj * 4 + wc;
                            if (g32 % 3 == 2) {
                                f32x4 p0, p1;
#pragma unroll
                                for (int e = 0; e < 4; ++e) { p0[e] = __shfl_xor(v0[e], 16); p1[e] = __shfl_xor(v1[e], 16); }
                                if (lat) { const int pos = (fq < 2) ? pr : pc; const f32x4 c0 = *(const f32x4*)(tc + pos * 8), c1 = *(const f32x4*)(tc + pos * 8 + 4), s0 = *(const f32x4*)(ts + pos * 8), s1 = *(const f32x4*)(ts + pos * 8 + 4);
                                    if ((fq & 1) == 0) { v0 = v0 * c0 - p0 * s0; v1 = v1 * c1 - p1 * s1; } else { v0 = p0 * s0 + v0 * c0; v1 = p1 * s1 + v1 * c1; } }
                            } }
                        if constexpr (MODE == EPI_GATEMUL0 || MODE == EPI_GATEMUL) {
                            const u32x4 gw = gwv[m][bj];
                            v0[0] *= bf_lo(gw.x); v0[1] *= bf_hi(gw.x); v0[2] *= bf_lo(gw.y); v0[3] *= bf_hi(gw.y); v1[0] *= bf_lo(gw.z); v1[1] *= bf_hi(gw.z); v1[2] *= bf_lo(gw.w); v1[3] *= bf_hi(gw.w);
                            if (accum) { const u32x4 ow = owv[m][bj];
                                v0[0] += bf_lo(ow.x); v0[1] += bf_hi(ow.x); v0[2] += bf_lo(ow.y); v0[3] += bf_hi(ow.y); v1[0] += bf_lo(ow.z); v1[1] += bf_hi(ow.z); v1[2] += bf_lo(ow.w); v1[3] += bf_hi(ow.w); } }
                        u32x4 w; w.x = cvt_pk_bf16(v0[0], v0[1]); w.y = cvt_pk_bf16(v0[2], v0[3]); w.z = cvt_pk_bf16(v1[0], v1[1]); w.w = cvt_pk_bf16(v1[2], v1[3]);
                        *(u32x4*)(rowp + bj * HALF) = w; } } }
        }
    }
};

template <class EpiT, class Sched, bool ALIGN_EPI, bool HN = false>
__device__ __forceinline__ void gemm_phase(PG8_LAS unsigned char* lds, const Gemm g, const Sched& S, const EpiT& E) {
    const int tid = otid(), wid = __builtin_amdgcn_readfirstlane(tid >> 6), lane = tid & 63, wr = wid >> 2, wc = wid & 3, fr = lane & 15, fq = lane >> 4;
    const int nt = g.K / BK;
    unsigned voffA[2], voffB[2]; int stR[2], stC[2];
#pragma unroll
    for (int i = 0; i < 2; ++i) { int R, C; stage_rc(tid * 16 + i * 8192, R, C); const int Rb = EpiT::PERM ? ((R & ~31) + perm32(R & 31)) : R; stR[i] = R; stC[i] = C;
        voffA[i] = (unsigned)(R * g.lda + C) * 2u; voffB[i] = (unsigned)(Rb * g.ldb + C) * 2u; }
    const size_t kstep = (size_t)(BK * 2);
    size_t hsA = (size_t)HALF * g.lda * 2; const size_t hsB = (size_t)HALF * g.ldb * 2, tsB = 2 * hsB;
#define PG8_OPND(u, pA, pB, vA, hA) do { if constexpr (Sched::MULTI) { const bf16_t* A_; const bf16_t* B_; int l_; S.opnd(u, g, A_, l_, B_); hA = (size_t)HALF * l_ * 2; \
            vA[0] = (unsigned)(stR[0] * l_ + stC[0]) * 2u; vA[1] = (unsigned)(stR[1] * l_ + stC[1]) * 2u; \
            pA = (const char*)A_ + (size_t)(u).pm * 2 * hA + (size_t)(u).ka * 2; pB = (const char*)B_ + (size_t)(u).pn * (HN ? hsB : tsB) + (size_t)(u).ka * 2; } \
        else { hA = (size_t)HALF * g.lda * 2; vA[0] = voffA[0]; vA[1] = voffA[1]; pA = (const char*)g.A + (size_t)(u).pm * 2 * hA + (size_t)(u).ka * 2; pB = (const char*)g.Bt + (size_t)(u).pn * (HN ? hsB : tsB) + (size_t)(u).ka * 2; } } while (0)
    const unsigned ldsw = (unsigned)wid * 1024u;
    const int aoff = lds_byte(wr * 64 + fr, fq * 8), boff = lds_byte(wc * 32 + fr, fq * 8);
#define PG8_SA(b, h) (((b) * 2 + (h)) * HTB)
#define PG8_SB(b, h) ((4 + (b) * 2 + (h)) * HTB)
#define PG8_STAGE(bufoff, gbase, voff) do { _Pragma("unroll") for (int _i = 0; _i < 2; ++_i) \
        __builtin_amdgcn_global_load_lds((const unsigned*)((const char*)(gbase) + (voff)[_i]), (PG8_LAS unsigned*)(lds + (bufoff) + ldsw + _i * 8192), 16, 0, 0); } while (0)
#define PG8_LDA(dst, b, h) do { _Pragma("unroll") for (int m = 0; m < 4; ++m) _Pragma("unroll") for (int k = 0; k < 2; ++k) dst[m][k] = *(const PG8_LAS bf16x8*)(lds + PG8_SA(b, h) + aoff + m * 2048 + k * 1024); } while (0)
#define PG8_LDB(dst, b, h) do { _Pragma("unroll") for (int n = 0; n < 2; ++n) _Pragma("unroll") for (int k = 0; k < 2; ++k) dst[n][k] = *(const PG8_LAS bf16x8*)(lds + PG8_SB(b, h) + boff + n * 2048 + k * 1024); } while (0)
#define PG8_MMA(ai, bj, At, Bt) do { __builtin_amdgcn_s_setprio(1); _Pragma("unroll") for (int m = 0; m < 4; ++m) _Pragma("unroll") for (int n = 0; n < 2; ++n) _Pragma("unroll") for (int k = 0; k < 2; ++k) \
        acc[ai][bj][m][n] = __builtin_amdgcn_mfma_f32_16x16x32_bf16(Bt[n][k], At[m][k], acc[ai][bj][m][n], 0, 0, 0); __builtin_amdgcn_s_setprio(0); } while (0)
#define PG8_WAIT_V(n) asm volatile("s_waitcnt vmcnt(" #n ")" ::: "memory")
#define PG8_WAIT_L(n) asm volatile("s_waitcnt lgkmcnt(" #n ")" ::: "memory")
#define PG8_BAR __builtin_amdgcn_s_barrier()
#define PG8_SCHED __builtin_amdgcn_sched_barrier(0)
    Unit cur, nxt; int ui = 0;
    if (!S.next(0, cur)) return;
    f32x4 acc[2][2][4][2];
    float zf; asm volatile("v_mov_b32 %0, 0" : "=v"(zf));
#pragma unroll
    for (int a = 0; a < 2; ++a)
#pragma unroll
        for (int b = 0; b < 2; ++b)
#pragma unroll
            for (int m = 0; m < 4; ++m)
#pragma unroll
                for (int n = 0; n < 2; ++n) acc[a][b][m][n] = (f32x4){zf, zf, zf, zf};
    bf16x8 At[4][2], B0[2][2], B1[2][2];
    const char* cA; const char* cB; PG8_OPND(cur, cA, cB, voffA, hsA);
    S.a_ready(cur);
    PG8_STAGE(PG8_SB(0, 0), cB, voffB); if constexpr (!HN) PG8_STAGE(PG8_SB(0, 1), cB + hsB, voffB); PG8_STAGE(PG8_SA(0, 0), cA, voffA); PG8_STAGE(PG8_SA(0, 1), cA + hsA, voffA);
    if (wr == 1) PG8_BAR;
    PG8_WAIT_V(2); PG8_BAR;
    PG8_STAGE(PG8_SB(1, 0), cB + kstep, voffB); PG8_STAGE(PG8_SA(1, 0), cA + kstep, voffA); if constexpr (!HN) PG8_STAGE(PG8_SB(1, 1), cB + hsB + kstep, voffB);
    if constexpr (HN) PG8_WAIT_V(4); else PG8_WAIT_V(6); PG8_BAR;
    for (;;) {
        const bool has_next = S.next(ui + 1, nxt);
        const char* nA = cA; const char* nB = cB; unsigned voffAn[2] = {voffA[0], voffA[1]}; size_t hsAn = hsA;
        if (has_next) PG8_OPND(nxt, nA, nB, voffAn, hsAn);
        for (int t = 0; t < nt; t += 2) {
            const bool last = (t == nt - 2);
            const char* a1 = cA + (size_t)(t + 1) * kstep;
            const char* a2 = last ? nA : cA + (size_t)(t + 2) * kstep; const char* b2 = last ? nB : cB + (size_t)(t + 2) * kstep;
            const char* a3 = a2 + kstep; const char* b3 = b2 + kstep;
            if (last && has_next) S.a_ready(nxt);
            unsigned vq[2] = {voffA[0], voffA[1]}; size_t hq = hsA;
            if constexpr (Sched::MULTI) { if (last) { vq[0] = voffAn[0]; vq[1] = voffAn[1]; hq = hsAn; } }
#define PG8_WAIT_G() do { if constexpr (HN) PG8_WAIT_V(6); else PG8_WAIT_V(8); } while (0)
            PG8_LDB(B0, 0, 0); if constexpr (!HN) PG8_LDB(B1, 0, 1); PG8_SCHED; PG8_LDA(At, 0, 0); PG8_STAGE(PG8_SA(1, 1), a1 + hsA, voffA);
            PG8_WAIT_G(); PG8_WAIT_L(0); PG8_BAR; PG8_MMA(0, 0, At, B0); if constexpr (!HN) PG8_MMA(0, 1, At, B1); PG8_BAR; PG8_SCHED;
            PG8_LDA(At, 0, 1); PG8_STAGE(PG8_SB(0, 0), b2, voffB); if constexpr (!HN) PG8_STAGE(PG8_SB(0, 1), b2 + hsB, voffB); PG8_STAGE(PG8_SA(0, 0), a2, vq);
            PG8_WAIT_G(); PG8_WAIT_L(0); PG8_BAR; PG8_MMA(1, 0, At, B0); if constexpr (!HN) PG8_MMA(1, 1, At, B1); PG8_BAR; PG8_SCHED;
            PG8_LDB(B0, 1, 0); if constexpr (!HN) PG8_LDB(B1, 1, 1); PG8_SCHED; PG8_LDA(At, 1, 0); PG8_STAGE(PG8_SA(0, 1), a2 + hq, vq);
            PG8_WAIT_G(); PG8_WAIT_L(0); PG8_BAR; PG8_MMA(0, 0, At, B0); if constexpr (!HN) PG8_MMA(0, 1, At, B1); PG8_BAR; PG8_SCHED;
            PG8_LDA(At, 1, 1); PG8_STAGE(PG8_SB(1, 0), b3, voffB); if constexpr (!HN) PG8_STAGE(PG8_SB(1, 1), b3 + hsB, voffB); PG8_STAGE(PG8_SA(1, 0), a3, vq);
            PG8_WAIT_G(); PG8_WAIT_L(0); PG8_BAR; PG8_MMA(1, 0, At, B0); if constexpr (!HN) PG8_MMA(1, 1, At, B1); PG8_BAR; PG8_SCHED;
#undef PG8_WAIT_G
        }
        if constexpr (ALIGN_EPI) { if (wr == 0) PG8_BAR; }
        E(acc, cur, wr, wc, fr, fq); S.done(cur);
        if (!has_next) break;
        asm volatile("v_mov_b32 %0, 0" : "=v"(zf));
#pragma unroll
        for (int a = 0; a < 2; ++a)
#pragma unroll
            for (int b = 0; b < 2; ++b)
#pragma unroll
                for (int m = 0; m < 4; ++m)
#pragma unroll
                    for (int n = 0; n < 2; ++n) acc[a][b][m][n] = (f32x4){zf, zf, zf, zf};
        cur = nxt; cA = nA; cB = nB; ++ui; voffA[0] = voffAn[0]; voffA[1] = voffAn[1]; hsA = hsAn;
        if constexpr (ALIGN_EPI) { if (wr == 1) PG8_BAR; }
    }
    PG8_WAIT_V(0);
    if constexpr (!ALIGN_EPI) { if (wr == 0) PG8_BAR; }
    PG8_BAR;
#undef PG8_OPND
#undef PG8_SA
#undef PG8_SB
#undef PG8_STAGE
#undef PG8_LDA
#undef PG8_LDB
#undef PG8_MMA
#undef PG8_WAIT_V
#undef PG8_WAIT_L
#undef PG8_BAR
#undef PG8_SCHED
}
}

namespace att {
using bf16 = unsigned short;
using bf16x8 = __attribute__((ext_vector_type(8))) short;
using s16x4 = __attribute__((ext_vector_type(4))) short;
using f32x16 = __attribute__((ext_vector_type(16))) float;
using u32x4 = __attribute__((ext_vector_type(4))) unsigned;
constexpr int NW = 8, QBLK = 32, KVBLK = 64;
constexpr float THR = 8.f;
#define SBAR() __builtin_amdgcn_sched_barrier(0)
__device__ __forceinline__ int crow(int r, int hi) { return (r & 3) + 8 * (r >> 2) + 4 * hi; }
__device__ __forceinline__ unsigned cvtpk(float lo, float hi) { unsigned r; asm volatile("v_cvt_pk_bf16_f32 %0, %1, %2" : "=v"(r) : "v"(lo), "v"(hi)); return r; }
template <int DQ> __device__ __forceinline__ int kaddr(int row, int c) {
    if constexpr (DQ == 64) return row * 128 + ((c ^ ((row >> 1) & 7)) << 4); else return row * 208 + c * 16; }
template <int DQ> constexpr int ktile_bytes() { return DQ == 64 ? 64 * 128 : 64 * 208; }
constexpr int VTILE = 64 * 64 * 2;
template <int DQ> constexpr int lds_bytes() { return 2 * ktile_bytes<DQ>() + 2 * VTILE + NW * 64 * 4; }

template <bool FIRST> __device__ __forceinline__ void partialSM(f32x16& p0, f32x16& p1, f32x16& nm16, float& alpha) {
    float pmax = p0[0];
#pragma unroll
    for (int r = 1; r < 16; ++r) pmax = fmaxf(pmax, p0[r]);
#pragma unroll
    for (int r = 0; r < 16; ++r) pmax = fmaxf(pmax, p1[r]);
    { auto rr = __builtin_amdgcn_permlane32_swap(__float_as_uint(pmax), __float_as_uint(pmax), false, false);
      pmax = fmaxf(__uint_as_float(rr[0]), __uint_as_float(rr[1])); }
    alpha = 1.f;
    if (FIRST || !__builtin_expect(__all(pmax <= THR), 1)) {
        const float dl = FIRST ? pmax : fmaxf(pmax, 0.f); if (!FIRST) alpha = __builtin_amdgcn_exp2f(-dl);
#pragma unroll
        for (int r = 0; r < 16; ++r) { nm16[r] -= dl; p0[r] -= dl; p1[r] -= dl; } }
#pragma unroll
    for (int r = 0; r < 16; ++r) p0[r] = __builtin_amdgcn_exp2f(p0[r]);
}
__device__ __forceinline__ void finishSM(f32x16& p0, f32x16& p1, float alpha, float& l_reg, bf16x8& pa0, bf16x8& pa1, bf16x8& pa2, bf16x8& pa3) {
#pragma unroll
    for (int r = 0; r < 16; ++r) p1[r] = __builtin_amdgcn_exp2f(p1[r]);
    float ps = 0;
#pragma unroll
    for (int r = 0; r < 16; ++r) ps += p0[r];
#pragma unroll
    for (int r = 0; r < 16; ++r) ps += p1[r];
    { auto rr = __builtin_amdgcn_permlane32_swap(__float_as_uint(ps), __float_as_uint(ps), false, false);
      ps = __uint_as_float(rr[0]) + __uint_as_float(rr[1]); }
    l_reg = l_reg * alpha + ps;
#define PK4(P, BASE, OUT) do { unsigned a0 = cvtpk(P[BASE + 0], P[BASE + 1]), a1 = cvtpk(P[BASE + 2], P[BASE + 3]);   \
    unsigned b0 = cvtpk(P[BASE + 4], P[BASE + 5]), b1 = cvtpk(P[BASE + 6], P[BASE + 7]);                              \
    auto r0 = __builtin_amdgcn_permlane32_swap(a0, b0, false, false); auto r1 = __builtin_amdgcn_permlane32_swap(a1, b1, false, false); \
    u32x4 w = {r0[0], r1[0], r0[1], r1[1]}; OUT = *reinterpret_cast<bf16x8*>(&w); } while (0)
    PK4(p0, 0, pa0); PK4(p0, 8, pa1); PK4(p1, 0, pa2); PK4(p1, 8, pa3);
#undef PK4
}
template <int DQ> __device__ __forceinline__ void qkt(f32x16& p0, f32x16& p1, const char* Ks, const bf16x8* qr, int r32, int hi, const f32x16& nm16) {
    p0 = nm16; p1 = nm16;
#pragma unroll
    for (int d0 = 0; d0 < DQ / 16; ++d0) { const int c = d0 * 2 + hi;
        const bf16x8 b0 = *reinterpret_cast<const bf16x8*>(Ks + kaddr<DQ>(r32, c));
        const bf16x8 b1 = *reinterpret_cast<const bf16x8*>(Ks + kaddr<DQ>(32 + r32, c));
        p0 = __builtin_amdgcn_mfma_f32_32x32x16_bf16(b0, qr[d0], p0, 0, 0, 0);
        p1 = __builtin_amdgcn_mfma_f32_32x32x16_bf16(b1, qr[d0], p1, 0, 0, 0); }
}
__device__ __forceinline__ int v_st(int k, int c) { const int kk = (k & ~0xC) | ((k & 4) << 1) | ((k & 8) >> 1); return ((kk >> 3) * 2 + (c >> 5)) * 512 + ((kk & 7) * 32 + (c & 31)) * 2; }
__device__ __forceinline__ int v_rd_base(int lane) { return ((lane & 3) << 3) | (((lane >> 2) & 3) << 6) | (((lane >> 4) & 1) << 5) | (((lane >> 5) & 1) << 8); }
constexpr int v_rd_off(int d0, int ks, int half) { return d0 * 512 + ks * 2048 + half * 1024; }
template <int OFF> __device__ __forceinline__ s16x4 tr_read(int vb) { s16x4 r; asm volatile("ds_read_b64_tr_b16 %0, %1 offset:%2" : "=&v"(r) : "v"(vb), "i"(OFF) : "memory"); return r; }
template <int D0> __device__ __forceinline__ void pv_one(f32x16& od, int vb, bf16x8 pa0, bf16x8 pa1, bf16x8 pa2, bf16x8 pa3) {
    const s16x4 l0 = tr_read<v_rd_off(D0, 0, 0)>(vb), h0 = tr_read<v_rd_off(D0, 0, 1)>(vb), l1 = tr_read<v_rd_off(D0, 1, 0)>(vb), h1 = tr_read<v_rd_off(D0, 1, 1)>(vb);
    const s16x4 l2 = tr_read<v_rd_off(D0, 2, 0)>(vb), h2 = tr_read<v_rd_off(D0, 2, 1)>(vb), l3 = tr_read<v_rd_off(D0, 3, 0)>(vb), h3 = tr_read<v_rd_off(D0, 3, 1)>(vb);
    asm volatile("s_waitcnt lgkmcnt(0)" ::: "memory"); SBAR();
#define PK(L, H) (bf16x8){L[0], L[1], L[2], L[3], H[0], H[1], H[2], H[3]}
    od = __builtin_amdgcn_mfma_f32_32x32x16_bf16(pa0, PK(l0, h0), od, 0, 0, 0);
    od = __builtin_amdgcn_mfma_f32_32x32x16_bf16(pa1, PK(l1, h1), od, 0, 0, 0);
    od = __builtin_amdgcn_mfma_f32_32x32x16_bf16(pa2, PK(l2, h2), od, 0, 0, 0);
    od = __builtin_amdgcn_mfma_f32_32x32x16_bf16(pa3, PK(l3, h3), od, 0, 0, 0);
#undef PK
}
struct Args { const bf16* Q; int ldq; const bf16* K0; int ldk0; const bf16* K1; int ldk1; const bf16* V; int ldv; bf16* O; int ldo; int nkeys; int rope_t0; const float* tc; const float* ts; };
template <int DQ>
__device__ __forceinline__ void attn_unit(const Args a, char* lds) {
    constexpr int KT = ktile_bytes<DQ>(), NLD = (DQ == 64) ? 2 : 3;
    const int tid = otid(), wid = tid >> 6, lane = tid & 63, r32 = lane & 31, hi = lane >> 5;
    char* V_lds = lds; char* K_lds = lds + 2 * VTILE;
    float* ws = (float*)(lds + 2 * VTILE + 2 * KT) + wid * 64; float* li_l = ws; float* al_l = ws + 32;
    float l_reg = 0; f32x16 o[2] = {}; f32x16 nm16 = {}; bf16x8 qr[DQ / 16];
    const bf16* Qw = a.Q + (long)(wid * QBLK + r32) * a.ldq + hi * 8;
#pragma unroll
    for (int d0 = 0; d0 < DQ / 16; ++d0) qr[d0] = *reinterpret_cast<const bf16x8*>(Qw + d0 * 16);
    if constexpr (DQ == 96) { if (a.rope_t0 >= 0) {
        const int tq = a.rope_t0 + wid * QBLK + r32, pr = (tq >> 6) & 63, pc = tq & 63;
#pragma unroll
        for (int f = 4; f < 6; ++f) { const int pos = (f == 4) ? pr : pc; u32x4 w = *reinterpret_cast<u32x4*>(&qr[f]); u32x4 o;
#pragma unroll
            for (int e = 0; e < 4; ++e) { const unsigned mine = w[e], oth = (unsigned)__shfl_xor((int)mine, 32);
                const float m0 = __uint_as_float(mine << 16), m1 = __uint_as_float(mine & 0xffff0000u), o0 = __uint_as_float(oth << 16), o1 = __uint_as_float(oth & 0xffff0000u);
                const float c0 = a.tc[pos * 8 + 2 * e], c1 = a.tc[pos * 8 + 2 * e + 1], s0 = a.ts[pos * 8 + 2 * e], s1 = a.ts[pos * 8 + 2 * e + 1];
                const float r0 = (hi == 0) ? m0 * c0 - o0 * s0 : o0 * s0 + m0 * c0, r1 = (hi == 0) ? m1 * c1 - o1 * s1 : o1 * s1 + m1 * c1;
                o[e] = cvtpk(r0, r1); }
            qr[f] = *reinterpret_cast<bf16x8*>(&o); } } }
    const int vrow = tid >> 3, vcol = (tid & 7) * 8, vst = v_st(vrow, vcol);
    const bf16* vsrc = a.V + (long)vrow * a.ldv + vcol; const long vstep = (long)KVBLK * a.ldv;
    int kr0, kc0, kr1 = 0, kc1 = 0;
    if constexpr (DQ == 64) { kr0 = tid >> 3; kc0 = tid & 7; } else { kr0 = tid / 12; kc0 = tid % 12; const int id1 = 512 + (tid & 255); kr1 = id1 / 12; kc1 = id1 % 12; }
    const bf16* ksrc0 = (kc0 < 8) ? a.K0 + (long)kr0 * a.ldk0 + kc0 * 8 : a.K1 + (long)kr0 * a.ldk1 + (kc0 - 8) * 8; const long kstep0 = (long)KVBLK * ((kc0 < 8) ? a.ldk0 : a.ldk1);
    const bf16* ksrc1 = ksrc0; long kstep1 = kstep0;
    if constexpr (DQ == 96) { ksrc1 = (kc1 < 8) ? a.K0 + (long)kr1 * a.ldk0 + kc1 * 8 : a.K1 + (long)kr1 * a.ldk1 + (kc1 - 8) * 8; kstep1 = (long)KVBLK * ((kc1 < 8) ? a.ldk0 : a.ldk1); }
    const int kst0 = kaddr<DQ>(kr0, kc0), kst1 = kaddr<DQ>(kr1, kc1);
    const int vb0 = (int)(uintptr_t)V_lds + v_rd_base(lane);
    struct { bf16x8 vs, ks0, ks1; } sr_[2];
#define SLOAD(i, t) do { sr_[i].vs = *reinterpret_cast<const bf16x8*>(vsrc + (long)(t) * vstep); sr_[i].ks0 = *reinterpret_cast<const bf16x8*>(ksrc0 + (long)(t) * kstep0); \
    if constexpr (DQ == 96) sr_[i].ks1 = *reinterpret_cast<const bf16x8*>(ksrc1 + (long)(t) * kstep1); } while (0)
#define SWRITE(b, i) do { *(bf16x8*)(V_lds + (b) * VTILE + vst) = sr_[i].vs; *(bf16x8*)(K_lds + (b) * KT + kst0) = sr_[i].ks0; \
    if constexpr (DQ == 96) *(bf16x8*)(K_lds + (b) * KT + kst1) = sr_[i].ks1; } while (0)
#define SWAIT() do { if constexpr (NLD == 2) asm volatile("s_waitcnt vmcnt(2)" ::: "memory"); else asm volatile("s_waitcnt vmcnt(3)" ::: "memory"); } while (0)
#define RESC(al) do { if (__any((al) < 1.f)) { if (hi == 0) al_l[r32] = (al); asm volatile("s_waitcnt lgkmcnt(0)" ::: "memory"); \
    _Pragma("unroll") for (int d = 0; d < 2; ++d) _Pragma("unroll") for (int r = 0; r < 16; ++r) o[d][r] *= al_l[crow(r, hi)]; } } while (0)
    f32x16 pA0, pA1, pB0, pB1; float alA, alB; bf16x8 pa0, pa1, pa2, pa3; const int NT = a.nkeys / KVBLK;
    constexpr int SE = 0, SO = 1;
    SLOAD(SE, 0); asm volatile("s_waitcnt vmcnt(0)" ::: "memory"); SWRITE(0, SE); __syncthreads();
    qkt<DQ>(pA0, pA1, K_lds, qr, r32, hi, nm16); partialSM<true>(pA0, pA1, nm16, alA);
    SLOAD(SO, 1); if (2 < NT) SLOAD(SE, 2);
    SWAIT(); SWRITE(1, SO); __syncthreads();
    for (int j = 1; j + 1 < NT; j += 2) {
        SBAR(); qkt<DQ>(pB0, pB1, K_lds + KT, qr, r32, hi, nm16);
        finishSM(pA0, pA1, alA, l_reg, pa0, pa1, pa2, pa3); SBAR();
        SLOAD(SO, j + 2); SBAR();
        pv_one<0>(o[0], vb0, pa0, pa1, pa2, pa3); pv_one<1>(o[1], vb0, pa0, pa1, pa2, pa3); partialSM<false>(pB0, pB1, nm16, alB);
        __syncthreads(); SWAIT(); SWRITE(0, SE);
        RESC(alB); __syncthreads();
        SBAR(); qkt<DQ>(pA0, pA1, K_lds, qr, r32, hi, nm16);
        finishSM(pB0, pB1, alB, l_reg, pa0, pa1, pa2, pa3); SBAR();
        if (j + 3 < NT) SLOAD(SE, j + 3); SBAR();
        pv_one<0>(o[0], vb0 + VTILE, pa0, pa1, pa2, pa3); pv_one<1>(o[1], vb0 + VTILE, pa0, pa1, pa2, pa3); partialSM<false>(pA0, pA1, nm16, alA);
        __syncthreads(); SWAIT(); SWRITE(1, SO);
        RESC(alA); __syncthreads();
    }
    SBAR(); qkt<DQ>(pB0, pB1, K_lds + KT, qr, r32, hi, nm16);
    finishSM(pA0, pA1, alA, l_reg, pa0, pa1, pa2, pa3); SBAR();
    pv_one<0>(o[0], vb0, pa0, pa1, pa2, pa3); pv_one<1>(o[1], vb0, pa0, pa1, pa2, pa3); partialSM<false>(pB0, pB1, nm16, alB);
    __syncthreads(); RESC(alB);
    finishSM(pB0, pB1, alB, l_reg, pa0, pa1, pa2, pa3); SBAR();
    pv_one<0>(o[0], vb0 + VTILE, pa0, pa1, pa2, pa3); pv_one<1>(o[1], vb0 + VTILE, pa0, pa1, pa2, pa3);
    if (hi == 0) li_l[r32] = l_reg; asm volatile("s_waitcnt lgkmcnt(0)" ::: "memory");
    float rli[16];
#pragma unroll
    for (int r = 0; r < 16; ++r) rli[r] = __builtin_amdgcn_rcpf(li_l[crow(r, hi)]);
    __syncthreads();
    { unsigned short* stg = (unsigned short*)(lds) + wid * 2048;
#pragma unroll
      for (int r = 0; r < 16; ++r) { const int orow = crow(r, hi);
#pragma unroll
        for (int d0 = 0; d0 < 2; ++d0) { const float v = o[d0][r] * rli[r]; const unsigned u = __float_as_uint(v); stg[orow * 64 + d0 * 32 + r32] = (unsigned short)((u + 0x7fffu + ((u >> 16) & 1u)) >> 16); } }
      asm volatile("s_waitcnt lgkmcnt(0)" ::: "memory");
      bf16* Ow = a.O + (long)(wid * QBLK) * a.ldo;
#pragma unroll
      for (int i = 0; i < 4; ++i) { const int row = i * 8 + (lane >> 3), ch = lane & 7; const u32x4 v = *(const u32x4*)(stg + row * 64 + ch * 8); *(u32x4*)(Ow + (long)row * a.ldo + ch * 8) = v; } }
    __syncthreads();
#undef SLOAD
#undef SWRITE
#undef SWAIT
#undef RESC
}
#undef SBAR
}

namespace at64 {
using att::bf16; using att::bf16x8; using att::s16x4; using att::f32x16; using att::u32x4;
constexpr int NW = 8, QBLK = 32, KVBLK = 64;
constexpr float C2 = 0.125f * 1.4426950408889634f;
constexpr float THR = 8.f;
constexpr int SLOTB = 8192, LDS_K = 0, LDS_V = 3 * SLOTB, LDS_WS = 6 * SLOTB, LDS_OST = LDS_WS + NW * 256, LDS_TOT = LDS_OST + NW * 4096;
#define A6_SBAR() __builtin_amdgcn_sched_barrier(0)
#define A6_PIN(x) asm volatile("" : "+v"(x))
#define A6_MFMA(a, b, c) __builtin_amdgcn_mfma_f32_32x32x16_bf16(a, b, c, 0, 0, 0)
#define A6_WAIT_BAR(N) asm volatile("s_waitcnt vmcnt(" #N ") lgkmcnt(0)\n\ts_barrier" ::: "memory")
__device__ __forceinline__ int crow(int r, int hi) { return (r & 3) + 8 * (r >> 2) + 4 * hi; }
__device__ __forceinline__ unsigned cvtpk(float lo, float hi) { unsigned r; asm("v_cvt_pk_bf16_f32 %0, %1, %2" : "=v"(r) : "v"(lo), "v"(hi)); return r; }
__device__ __forceinline__ void glds16(const void* g, unsigned lds_base) {
    unsigned sv; asm volatile("s_mov_b32 %0, m0\n\ts_mov_b32 m0, %2\n\ts_nop 0\n\tglobal_load_lds_dwordx4 %1, off\n\ts_mov_b32 m0, %0" : "=&s"(sv) : "v"(g), "s"(lds_base) : "memory"); }
typedef __attribute__((address_space(3))) const char* lds_cptr;
typedef short v4i16_t __attribute__((ext_vector_type(4)));
__device__ __forceinline__ void kload2(bf16x8* kf, lds_cptr kp, int d0) { kf[2 * d0] = *(const __attribute__((address_space(3))) bf16x8*)(kp + d0 * 2048); kf[2 * d0 + 1] = *(const __attribute__((address_space(3))) bf16x8*)(kp + d0 * 2048 + 512); }
__device__ __forceinline__ s16x4 vtr(lds_cptr p) { return __builtin_bit_cast(s16x4, __builtin_amdgcn_ds_read_tr16_b64_v4i16((__attribute__((address_space(3))) v4i16_t*)p)); }
#define A6_MX3(a, b, c) __builtin_fmaxf(__builtin_fmaxf((a), (b)), (c))
__device__ __forceinline__ float rowmax(const f32x16& p0, const f32x16& p1) {
    float a = A6_MX3(p0[0], p0[1], p1[0]), b = A6_MX3(p0[2], p0[3], p1[1]); a = A6_MX3(a, p1[2], p1[3]);
#pragma unroll
    for (int r = 4; r < 16; r += 4) { a = A6_MX3(a, p0[r], p0[r + 1]); b = A6_MX3(b, p0[r + 2], p0[r + 3]); a = A6_MX3(a, p1[r], p1[r + 1]); b = A6_MX3(b, p1[r + 2], p1[r + 3]); }
    float m = __builtin_fmaxf(a, b); auto rr = __builtin_amdgcn_permlane32_swap(__float_as_uint(m), __float_as_uint(m), false, false);
    return __builtin_fmaxf(__uint_as_float(rr[0]), __uint_as_float(rr[1])); }
struct Args { const bf16* Q; int ldq; const bf16* K; int ldk; const bf16* V; int ldv; bf16* O; int ldo; int nkeys; float* lse; };
__device__ __forceinline__ void unit(const Args a, char* lds) {
    const int tid = otid(), lane = tid & 63, r32 = lane & 31, hi = lane >> 5; const int wid = __builtin_amdgcn_readfirstlane(tid >> 6);
    const int NT = a.nkeys / KVBLK;
    const bf16* Qw = a.Q + (long)(wid * QBLK) * a.ldq;
    const unsigned lds0 = (unsigned)(uintptr_t)lds; float* wsf = (float*)(lds + LDS_WS) + wid * 64;
    const bf16* ksrc = a.K + (long)lane * a.ldk + wid * 8; const long kstep = (long)KVBLK * a.ldk;
    const bf16* vsrc = a.V + (long)(16 * (wid & 3) + (lane >> 2)) * a.ldv + (wid >> 2) * 32 + (lane & 3) * 8; const long vstep = (long)KVBLK * a.ldv;
    const unsigned kdst = lds0 + LDS_K + wid * 1024, vdst = lds0 + LDS_V + wid * 1024;
#define DMA_K(t, slot) glds16(ksrc + (long)(t) * kstep, (unsigned)__builtin_amdgcn_readfirstlane(kdst + (slot)))
#define DMA_V(t, slot) glds16(vsrc + (long)(t) * vstep, (unsigned)__builtin_amdgcn_readfirstlane(vdst + (slot)))
    const lds_cptr vp0 = (lds_cptr)lds + LDS_V + ((lane >> 4) & 1) * 32 + (lane & 3) * 8 + (4 * hi + ((lane & 15) >> 2)) * 64;
    const lds_cptr kp0 = (lds_cptr)lds + LDS_K + hi * 1024 + r32 * 16;
    DMA_K(0, 0); DMA_V(0, 0); DMA_K(1, SLOTB);
    bf16x8 qr[4];
#pragma unroll
    for (int d0 = 0; d0 < 4; ++d0) qr[d0] = *reinterpret_cast<const bf16x8*>(&Qw[(long)r32 * a.ldq + d0 * 16 + hi * 8]);
    float l_reg = 0.f; f32x16 o[2]; o[0] = f32x16{}; o[1] = f32x16{};
    f32x16 nmh16 = f32x16{}; A6_PIN(nmh16);
    bool resc = false;
    f32x16 pA0, pA1, pB0, pB1; bf16x8 kf[8]; s16x4 vlo[8], vhi[8]; u32x4 pw0, pw1, pw2, pw3;
    int sl_prev = 0, sl_cur = 0, sl_next = SLOTB;
#define ROT() do { sl_prev = sl_cur; sl_cur = sl_next; sl_next = (sl_next == 2 * SLOTB) ? 0 : sl_next + SLOTB; } while (0)
#define EX(v) __builtin_amdgcn_exp2f(v)
#define RESC() do { if (resc) { _Pragma("unroll") for (int d_ = 0; d_ < 2; ++d_) _Pragma("unroll") for (int r = 0; r < 16; ++r) o[d_][r] *= wsf[crow(r, hi)]; } } while (0)
    DMA_K(2, 2 * SLOTB);
    A6_WAIT_BAR(3);
    _Pragma("unroll") for (int d0 = 0; d0 < 4; ++d0) kload2(kf, kp0, d0);
    pA0 = A6_MFMA(kf[0], qr[0], nmh16); pA1 = A6_MFMA(kf[1], qr[0], nmh16); pA0 = A6_MFMA(kf[2], qr[1], pA0); pA1 = A6_MFMA(kf[3], qr[1], pA1);
    pA0 = A6_MFMA(kf[4], qr[2], pA0); pA1 = A6_MFMA(kf[5], qr[2], pA1); pA0 = A6_MFMA(kf[6], qr[3], pA0); pA1 = A6_MFMA(kf[7], qr[3], pA1);
    { const float rm = rowmax(pA0, pA1);
#pragma unroll
      for (int r = 0; r < 16; ++r) { nmh16[r] = -rm; pA0[r] = EX(pA0[r] - rm); pA1[r] = EX(pA1[r] - rm); } }
    A6_WAIT_BAR(0);
    DMA_K(3, 0); DMA_V(1, SLOTB); ROT();
    _Pragma("unroll") for (int d0 = 0; d0 < 4; ++d0) kload2(kf, kp0 + sl_cur, d0);
    A6_WAIT_BAR(2);
#define PKW(P, i) cvtpk(P[i], P[i + 1])
#define PAF(k) __builtin_bit_cast(bf16x8, pw##k)
#define VFR(i) (bf16x8){vlo[i][0], vlo[i][1], vlo[i][2], vlo[i][3], vhi[i][0], vhi[i][1], vhi[i][2], vhi[i][3]}
#define VRD(i) do { vlo[i] = vtr(vp_ + (((i) >> 2) * 4096 + ((i) & 3) * 1024)); vhi[i] = vtr(vp_ + (((i) >> 2) * 4096 + ((i) & 3) * 1024 + 512)); } while (0)
#define KRD(G, d0) do { if (G) { kload2(kf, kp0 + sl_next, d0); A6_SBAR(); } } while (0)
#define GAPA(MF, a0, a1, a2, a3, W0, W1, PW) do { MF; sacc += a0; sacc += a1; sacc += a2; sacc += a3; W0; W1; A6_PIN(PW); A6_PIN(sacc); A6_SBAR(); } while (0)
#define GAPB(MF, X, i) do { MF; X[i] = EX(X[i]); X[i + 1] = EX(X[i + 1]); X[i + 2] = EX(X[i + 2]); X[i + 3] = EX(X[i + 3]); A6_PIN(X); A6_SBAR(); } while (0)
#define STEP(C0, C1, P0, P1, t, GK, GV, GL) do { A6_SBAR(); \
    const lds_cptr vp_ = vp0 + sl_prev; \
    VRD(0); A6_SBAR(); float sacc = P0[0] + P0[1]; \
                       GAPA(C0 = A6_MFMA(kf[0], qr[0], nmh16), P0[2], P0[3], P0[4], P0[5],     pw0[0] = PKW(P0, 0),  pw0[1] = PKW(P0, 2),  pw0); \
    VRD(4); A6_SBAR(); GAPA(C1 = A6_MFMA(kf[1], qr[0], nmh16), P0[6], P0[7], P0[8], P0[9],     pw0[2] = PKW(P0, 4),  pw0[3] = PKW(P0, 6),  pw0); \
    VRD(1); A6_SBAR(); GAPA(C0 = A6_MFMA(kf[2], qr[1], C0),    P0[10], P0[11], P0[12], P0[13], pw1[0] = PKW(P0, 8),  pw1[1] = PKW(P0, 10), pw1); \
    VRD(5); A6_SBAR(); GAPA(C1 = A6_MFMA(kf[3], qr[1], C1),    P0[14], P0[15], P1[0], P1[1],   pw1[2] = PKW(P0, 12), pw1[3] = PKW(P0, 14), pw1); \
    VRD(2); A6_SBAR(); GAPA(C0 = A6_MFMA(kf[4], qr[2], C0),    P1[2], P1[3], P1[4], P1[5],     pw2[0] = PKW(P1, 0),  pw2[1] = PKW(P1, 2),  pw2); \
    VRD(6); A6_SBAR(); GAPA(C1 = A6_MFMA(kf[5], qr[2], C1),    P1[6], P1[7], P1[8], P1[9],     pw2[2] = PKW(P1, 4),  pw2[3] = PKW(P1, 6),  pw2); \
    VRD(3); A6_SBAR(); GAPA(C0 = A6_MFMA(kf[6], qr[3], C0),    P1[10], P1[11], P1[12], P1[13], pw3[0] = PKW(P1, 8),  pw3[1] = PKW(P1, 10), pw3); \
    VRD(7); A6_SBAR(); GAPA(C1 = A6_MFMA(kf[7], qr[3], C1),    P1[14], P1[15], 0.f, 0.f,       pw3[2] = PKW(P1, 12), pw3[3] = PKW(P1, 14), pw3); \
    l_reg += sacc; \
    if (GK) DMA_K((t) + 3, sl_cur); if (GV) DMA_V((t) + 1, sl_next); \
    { const float rm = rowmax(C0, C1); resc = false; \
      if (__builtin_expect(__any(rm > THR), 0)) { const float dl = __builtin_fmaxf(rm, 0.f); \
          _Pragma("unroll") for (int r_ = 0; r_ < 16; ++r_) { nmh16[r_] -= dl; C0[r_] -= dl; C1[r_] -= dl; } \
          const float f = __builtin_amdgcn_exp2f(-dl); l_reg *= f; if (hi == 0) wsf[r32] = f; resc = true; } } \
    A6_SBAR(); \
    GAPB(o[0] = A6_MFMA(PAF(0), VFR(0), o[0]), C0, 0);              GAPB(o[1] = A6_MFMA(PAF(0), VFR(4), o[1]), C0, 4); \
    KRD(GL, 0); GAPB(o[0] = A6_MFMA(PAF(1), VFR(1), o[0]), C0, 8);  KRD(GL, 1); GAPB(o[1] = A6_MFMA(PAF(1), VFR(5), o[1]), C0, 12); \
    KRD(GL, 2); GAPB(o[0] = A6_MFMA(PAF(2), VFR(2), o[0]), C1, 0);  KRD(GL, 3); GAPB(o[1] = A6_MFMA(PAF(2), VFR(6), o[1]), C1, 4); \
    GAPB(o[0] = A6_MFMA(PAF(3), VFR(3), o[0]), C1, 8);              GAPB(o[1] = A6_MFMA(PAF(3), VFR(7), o[1]), C1, 12); \
    } while (0)
    int t = 1;
    for (; t + 5 < NT; t += 2) {
        STEP(pB0, pB1, pA0, pA1, t, true, true, true);     A6_WAIT_BAR(2); RESC(); ROT();
        STEP(pA0, pA1, pB0, pB1, t + 1, true, true, true); A6_WAIT_BAR(2); RESC(); ROT();
    }
#define ENDW(tt) do { if ((tt) + 3 < NT) { A6_WAIT_BAR(2); } else if ((tt) + 2 < NT) { A6_WAIT_BAR(1); } else { A6_WAIT_BAR(0); } } while (0)
    for (; t + 1 < NT; t += 2) {
        STEP(pB0, pB1, pA0, pA1, t, (t + 3 < NT), (t + 1 < NT), (t + 1 < NT));         ENDW(t);     RESC(); ROT();
        STEP(pA0, pA1, pB0, pB1, t + 1, (t + 4 < NT), (t + 2 < NT), (t + 2 < NT));     ENDW(t + 1); RESC(); ROT();
    }
    STEP(pB0, pB1, pA0, pA1, NT - 1, false, false, false); RESC();
    { float sacc = pB0[0] + pB0[1];
#pragma unroll
      for (int r = 2; r < 16; ++r) sacc += pB0[r];
#pragma unroll
      for (int r = 0; r < 16; ++r) sacc += pB1[r];
      l_reg += sacc;
      pw0 = (u32x4){PKW(pB0, 0), PKW(pB0, 2), PKW(pB0, 4), PKW(pB0, 6)}; pw1 = (u32x4){PKW(pB0, 8), PKW(pB0, 10), PKW(pB0, 12), PKW(pB0, 14)};
      pw2 = (u32x4){PKW(pB1, 0), PKW(pB1, 2), PKW(pB1, 4), PKW(pB1, 6)}; pw3 = (u32x4){PKW(pB1, 8), PKW(pB1, 10), PKW(pB1, 12), PKW(pB1, 14)};
      const lds_cptr vp_ = vp0 + sl_cur; _Pragma("unroll") for (int i = 0; i < 8; ++i) VRD(i);
      o[0] = A6_MFMA(PAF(0), VFR(0), o[0]); o[1] = A6_MFMA(PAF(0), VFR(4), o[1]); o[0] = A6_MFMA(PAF(1), VFR(1), o[0]); o[1] = A6_MFMA(PAF(1), VFR(5), o[1]);
      o[0] = A6_MFMA(PAF(2), VFR(2), o[0]); o[1] = A6_MFMA(PAF(2), VFR(6), o[1]); o[0] = A6_MFMA(PAF(3), VFR(3), o[0]); o[1] = A6_MFMA(PAF(3), VFR(7), o[1]); }
    { auto rr = __builtin_amdgcn_permlane32_swap(__float_as_uint(l_reg), __float_as_uint(l_reg), false, false); l_reg = __uint_as_float(rr[0]) + __uint_as_float(rr[1]); }
    if (hi == 0) wsf[32 + r32] = l_reg; asm volatile("s_waitcnt lgkmcnt(0)" ::: "memory");
    if (a.lse != nullptr && hi == 0) a.lse[wid * QBLK + r32] = __builtin_amdgcn_logf(l_reg) - nmh16[0];
    float rli[16];
#pragma unroll
    for (int r = 0; r < 16; ++r) rli[r] = __builtin_amdgcn_rcpf(wsf[32 + crow(r, hi)]);
    bf16* Ow = a.O + (long)(wid * QBLK) * a.ldo; unsigned short* stg = (unsigned short*)(lds + LDS_OST) + wid * 2048;
#pragma unroll
    for (int r = 0; r < 16; ++r) { const int orow = crow(r, hi);
#pragma unroll
        for (int d0 = 0; d0 < 2; ++d0) { const float v = o[d0][r] * rli[r]; const unsigned u = __float_as_uint(v); stg[orow * 64 + d0 * 32 + r32] = (unsigned short)((u + 0x7fffu + ((u >> 16) & 1u)) >> 16); } }
    asm volatile("s_waitcnt lgkmcnt(0)" ::: "memory");
#pragma unroll
    for (int i = 0; i < 4; ++i) { const int row = i * 8 + (lane >> 3), ch = lane & 7; *(u32x4*)(Ow + (long)row * a.ldo + ch * 8) = *(const u32x4*)(stg + row * 64 + ch * 8); }
    asm volatile("s_waitcnt lgkmcnt(0)\n\ts_barrier" ::: "memory");
#undef DMA_K
#undef DMA_V
#undef ROT
#undef EX
#undef RESC
#undef PKW
#undef PAF
#undef VFR
#undef VRD
#undef KRD
#undef ENDW
#undef GAPA
#undef GAPB
#undef STEP
}
#undef A6_SBAR
#undef A6_PIN
#undef A6_MFMA
#undef A6_WAIT_BAR
#undef A6_MX3
}

namespace at96 {
using att::bf16; using att::bf16x8; using att::s16x4; using att::f32x16; using att::u32x4;
using at64::crow; using at64::cvtpk; using at64::glds16; using at64::lds_cptr; using at64::kload2; using at64::vtr; using at64::rowmax;
constexpr int NW = 8, QBLK = 32, KVBLK = 64;
constexpr float THR = 8.f;
constexpr int SLOTB = 8192, SLOTR = 4096, LDS_K = 0, LDS_V = 3 * SLOTB, LDS_R = 6 * SLOTB, LDS_WS = LDS_R + 4 * SLOTR, LDS_OST = LDS_WS + NW * 256, LDS_TOT = LDS_OST + NW * 4096;
#define A9_SBAR() __builtin_amdgcn_sched_barrier(0)
#define A9_PIN(x) asm volatile("" : "+v"(x))
#define A9_MFMA(a, b, c) __builtin_amdgcn_mfma_f32_32x32x16_bf16(a, b, c, 0, 0, 0)
#define A9_WAIT_BAR(N) asm volatile("s_waitcnt vmcnt(" #N ") lgkmcnt(0)\n\ts_barrier" ::: "memory")
struct Args { const bf16* Q; int ldq; const bf16* K0; int ldk0; const bf16* K1; int ldk1; const bf16* V; int ldv; bf16* O; int ldo; int nkeys; int rope_t0; const float* tc; const float* ts; };
__device__ __forceinline__ void unit(const Args a, char* lds) {
    const int tid = otid(), lane = tid & 63, r32 = lane & 31, hi = lane >> 5; const int wid = __builtin_amdgcn_readfirstlane(tid >> 6);
    const int NT = a.nkeys / KVBLK;
    const bf16* Qw = a.Q + (long)(wid * QBLK) * a.ldq;
    const unsigned lds0 = (unsigned)(uintptr_t)lds; float* wsf = (float*)(lds + LDS_WS) + wid * 64;
    const bf16* ksrc = a.K0 + (long)lane * a.ldk0 + wid * 8; const long kstep = (long)KVBLK * a.ldk0;
    const bf16* rsrc = a.K1 + (long)(32 * (wid & 1) + r32) * a.ldk1 + (wid >> 1) * 8; const long rstep = (long)KVBLK * a.ldk1;
    const bf16* vsrc = a.V + (long)(16 * (wid & 3) + (lane >> 2)) * a.ldv + (wid >> 2) * 32 + (lane & 3) * 8; const long vstep = (long)KVBLK * a.ldv;
    const unsigned kdst = lds0 + LDS_K + wid * 1024, vdst = lds0 + LDS_V + wid * 1024, rdst = lds0 + LDS_R + (wid >> 1) * 1024 + (wid & 1) * 512;
#define DMA_K(t, slot, rslot) do { glds16(ksrc + (long)(t) * kstep, (unsigned)__builtin_amdgcn_readfirstlane(kdst + (slot))); \
        if (lane < 32) glds16(rsrc + (long)(t) * rstep, (unsigned)__builtin_amdgcn_readfirstlane(rdst + (rslot))); } while (0)
#define DMA_V(t, slot) glds16(vsrc + (long)(t) * vstep, (unsigned)__builtin_amdgcn_readfirstlane(vdst + (slot)))
    const lds_cptr vp0 = (lds_cptr)lds + LDS_V + ((lane >> 4) & 1) * 32 + (lane & 3) * 8 + (4 * hi + ((lane & 15) >> 2)) * 64;
    const lds_cptr kp0 = (lds_cptr)lds + LDS_K + hi * 1024 + r32 * 16;
    const lds_cptr rp0 = (lds_cptr)lds + LDS_R + hi * 1024 + r32 * 16;
    DMA_K(0, 0, 0); DMA_V(0, 0); DMA_K(1, SLOTB, SLOTR);
    bf16x8 qr[6];
#pragma unroll
    for (int d0 = 0; d0 < 6; ++d0) qr[d0] = *reinterpret_cast<const bf16x8*>(&Qw[(long)r32 * a.ldq + d0 * 16 + hi * 8]);
    if (a.rope_t0 >= 0) {
        const int tq = a.rope_t0 + wid * QBLK + r32, pr = (tq >> 6) & 63, pc = tq & 63;
#pragma unroll
        for (int f = 4; f < 6; ++f) { const int pos = (f == 4) ? pr : pc; u32x4 w = *reinterpret_cast<u32x4*>(&qr[f]); u32x4 o_;
            typedef float f32x4_ __attribute__((ext_vector_type(4)));
            const f32x4_ tc0 = *(const f32x4_*)(a.tc + pos * 8), tc1 = *(const f32x4_*)(a.tc + pos * 8 + 4), ts0 = *(const f32x4_*)(a.ts + pos * 8), ts1 = *(const f32x4_*)(a.ts + pos * 8 + 4);
            const float tcv[8] = {tc0[0], tc0[1], tc0[2], tc0[3], tc1[0], tc1[1], tc1[2], tc1[3]}, tsv[8] = {ts0[0], ts0[1], ts0[2], ts0[3], ts1[0], ts1[1], ts1[2], ts1[3]};
#pragma unroll
            for (int e = 0; e < 4; ++e) { const unsigned mine = w[e], oth = (unsigned)__shfl_xor((int)mine, 32);
                const float m0 = __uint_as_float(mine << 16), m1 = __uint_as_float(mine & 0xffff0000u), o0 = __uint_as_float(oth << 16), o1 = __uint_as_float(oth & 0xffff0000u);
                const float c0 = tcv[2 * e], c1 = tcv[2 * e + 1], s0 = tsv[2 * e], s1 = tsv[2 * e + 1];
                const float r0 = (hi == 0) ? m0 * c0 - o0 * s0 : o0 * s0 + m0 * c0, r1 = (hi == 0) ? m1 * c1 - o1 * s1 : o1 * s1 + m1 * c1;
                o_[e] = cvtpk(r0, r1); }
            qr[f] = *reinterpret_cast<bf16x8*>(&o_); } }
    float l_reg = 0.f; f32x16 o[2]; o[0] = f32x16{}; o[1] = f32x16{};
    f32x16 nmh16 = f32x16{}; A9_PIN(nmh16);
    bool resc = false;
    f32x16 pA0, pA1, pB0, pB1; bf16x8 kf[8], kr[4]; s16x4 vlo[8], vhi[8]; u32x4 pw0, pw1, pw2, pw3;
    int sl_prev = 0, sl_cur = 0, sl_next = SLOTB, rs_cur = 0;
#define ROT() do { sl_prev = sl_cur; sl_cur = sl_next; sl_next = (sl_next == 2 * SLOTB) ? 0 : sl_next + SLOTB; rs_cur = (rs_cur + SLOTR) & (4 * SLOTR - 1); } while (0)
#define RS3() ((rs_cur + 3 * SLOTR) & (4 * SLOTR - 1))
#define EX(v) __builtin_amdgcn_exp2f(v)
#define RESC() do { if (resc) { _Pragma("unroll") for (int d_ = 0; d_ < 2; ++d_) _Pragma("unroll") for (int r = 0; r < 16; ++r) o[d_][r] *= wsf[crow(r, hi)]; } } while (0)
    DMA_K(2, 2 * SLOTB, 2 * SLOTR);
    A9_WAIT_BAR(5);
    _Pragma("unroll") for (int d0 = 0; d0 < 4; ++d0) kload2(kf, kp0, d0);
    kload2(kr, rp0, 0); kload2(kr, rp0, 1);
    pA0 = A9_MFMA(kf[0], qr[0], nmh16); pA1 = A9_MFMA(kf[1], qr[0], nmh16); pA0 = A9_MFMA(kf[2], qr[1], pA0); pA1 = A9_MFMA(kf[3], qr[1], pA1);
    pA0 = A9_MFMA(kf[4], qr[2], pA0); pA1 = A9_MFMA(kf[5], qr[2], pA1); pA0 = A9_MFMA(kf[6], qr[3], pA0); pA1 = A9_MFMA(kf[7], qr[3], pA1);
    pA0 = A9_MFMA(kr[0], qr[4], pA0); pA1 = A9_MFMA(kr[1], qr[4], pA1); pA0 = A9_MFMA(kr[2], qr[5], pA0); pA1 = A9_MFMA(kr[3], qr[5], pA1);
    { const float rm = rowmax(pA0, pA1);
#pragma unroll
      for (int r = 0; r < 16; ++r) { nmh16[r] = -rm; pA0[r] = EX(pA0[r] - rm); pA1[r] = EX(pA1[r] - rm); } }
    A9_WAIT_BAR(0);
    DMA_K(3, 0, 3 * SLOTR); DMA_V(1, SLOTB); ROT();
    _Pragma("unroll") for (int d0 = 0; d0 < 4; ++d0) kload2(kf, kp0 + sl_cur, d0);
    A9_WAIT_BAR(3);
#define PKW(P, i) cvtpk(P[i], P[i + 1])
#define PAF(k) __builtin_bit_cast(bf16x8, pw##k)
#define VFR(i) (bf16x8){vlo[i][0], vlo[i][1], vlo[i][2], vlo[i][3], vhi[i][0], vhi[i][1], vhi[i][2], vhi[i][3]}
#define VRD(i) do { vlo[i] = vtr(vp_ + (((i) >> 2) * 4096 + ((i) & 3) * 1024)); vhi[i] = vtr(vp_ + (((i) >> 2) * 4096 + ((i) & 3) * 1024 + 512)); } while (0)
#define KRD(G, d0) do { if (G) { kload2(kf, kp0 + sl_next, d0); A9_SBAR(); } } while (0)
#define GAP3(MF, a0, a1, a2, W0, PW) do { MF; sacc += a0; sacc += a1; sacc += a2; W0; A9_PIN(PW); A9_PIN(sacc); A9_SBAR(); } while (0)
#define GAP2(MF, a0, a1, W0, W1, PW) do { MF; sacc += a0; sacc += a1; W0; W1; A9_PIN(PW); A9_PIN(sacc); A9_SBAR(); } while (0)
#define GAPB(MF, X, i) do { MF; X[i] = EX(X[i]); X[i + 1] = EX(X[i + 1]); X[i + 2] = EX(X[i + 2]); X[i + 3] = EX(X[i + 3]); A9_PIN(X); A9_SBAR(); } while (0)
#define STEP(C0, C1, P0, P1, t, GK, GV, GL) do { A9_SBAR(); \
    const lds_cptr vp_ = vp0 + sl_prev; const lds_cptr rp_ = rp0 + rs_cur; \
    VRD(0); kload2(kr, rp_, 0); A9_SBAR(); float sacc = P0[0] + P0[1]; \
                       GAP3(C0 = A9_MFMA(kf[0], qr[0], nmh16), P0[2], P0[3], P0[4],    pw0[0] = PKW(P0, 0), pw0); \
    VRD(4); kload2(kr, rp_, 1); A9_SBAR(); \
                       GAP3(C1 = A9_MFMA(kf[1], qr[0], nmh16), P0[5], P0[6], P0[7],    pw0[1] = PKW(P0, 2), pw0); \
    VRD(1); A9_SBAR(); GAP2(C0 = A9_MFMA(kf[2], qr[1], C0),    P0[8], P0[9],           pw0[2] = PKW(P0, 4), pw0[3] = PKW(P0, 6), pw0); \
    VRD(5); A9_SBAR(); GAP3(C1 = A9_MFMA(kf[3], qr[1], C1),    P0[10], P0[11], P0[12], pw1[0] = PKW(P0, 8), pw1); \
    VRD(2); A9_SBAR(); GAP3(C0 = A9_MFMA(kf[4], qr[2], C0),    P0[13], P0[14], P0[15], pw1[1] = PKW(P0, 10), pw1); \
    VRD(6); A9_SBAR(); GAP2(C1 = A9_MFMA(kf[5], qr[2], C1),    P1[0], P1[1],           pw1[2] = PKW(P0, 12), pw1[3] = PKW(P0, 14), pw1); \
    VRD(3); A9_SBAR(); GAP3(C0 = A9_MFMA(kf[6], qr[3], C0),    P1[2], P1[3], P1[4],    pw2[0] = PKW(P1, 0), pw2); \
    VRD(7); A9_SBAR(); GAP3(C1 = A9_MFMA(kf[7], qr[3], C1),    P1[5], P1[6], P1[7],    pw2[1] = PKW(P1, 2), pw2); \
                       GAP2(C0 = A9_MFMA(kr[0], qr[4], C0),    P1[8], P1[9],           pw2[2] = PKW(P1, 4), pw2[3] = PKW(P1, 6), pw2); \
                       GAP3(C1 = A9_MFMA(kr[1], qr[4], C1),    P1[10], P1[11], P1[12], pw3[0] = PKW(P1, 8), pw3); \
                       GAP3(C0 = A9_MFMA(kr[2], qr[5], C0),    P1[13], P1[14], P1[15], pw3[1] = PKW(P1, 10), pw3); \
                       GAP2(C1 = A9_MFMA(kr[3], qr[5], C1),    0.f, 0.f,               pw3[2] = PKW(P1, 12), pw3[3] = PKW(P1, 14), pw3); \
    l_reg += sacc; \
    if (GK) DMA_K((t) + 3, sl_cur, RS3()); if (GV) DMA_V((t) + 1, sl_next); \
    { const float rm = rowmax(C0, C1); resc = false; \
      if (__builtin_expect(__any(rm > THR), 0)) { const float dl = __builtin_fmaxf(rm, 0.f); \
          _Pragma("unroll") for (int r_ = 0; r_ < 16; ++r_) { nmh16[r_] -= dl; C0[r_] -= dl; C1[r_] -= dl; } \
          const float f = __builtin_amdgcn_exp2f(-dl); l_reg *= f; if (hi == 0) wsf[r32] = f; resc = true; } } \
    A9_SBAR(); \
    GAPB(o[0] = A9_MFMA(PAF(0), VFR(0), o[0]), C0, 0);              GAPB(o[1] = A9_MFMA(PAF(0), VFR(4), o[1]), C0, 4); \
    KRD(GL, 0); GAPB(o[0] = A9_MFMA(PAF(1), VFR(1), o[0]), C0, 8);  KRD(GL, 1); GAPB(o[1] = A9_MFMA(PAF(1), VFR(5), o[1]), C0, 12); \
    KRD(GL, 2); GAPB(o[0] = A9_MFMA(PAF(2), VFR(2), o[0]), C1, 0);  KRD(GL, 3); GAPB(o[1] = A9_MFMA(PAF(2), VFR(6), o[1]), C1, 4); \
    GAPB(o[0] = A9_MFMA(PAF(3), VFR(3), o[0]), C1, 8);              GAPB(o[1] = A9_MFMA(PAF(3), VFR(7), o[1]), C1, 12); \
    } while (0)
    int t = 1;
    for (; t + 5 < NT; t += 2) {
        STEP(pB0, pB1, pA0, pA1, t, true, true, true);     A9_WAIT_BAR(3); RESC(); ROT();
        STEP(pA0, pA1, pB0, pB1, t + 1, true, true, true); A9_WAIT_BAR(3); RESC(); ROT();
    }
#define ENDW(tt) do { if ((tt) + 3 < NT) { A9_WAIT_BAR(3); } else if ((tt) + 2 < NT) { A9_WAIT_BAR(1); } else { A9_WAIT_BAR(0); } } while (0)
    for (; t + 1 < NT; t += 2) {
        STEP(pB0, pB1, pA0, pA1, t, (t + 3 < NT), (t + 1 < NT), (t + 1 < NT));         ENDW(t);     RESC(); ROT();
        STEP(pA0, pA1, pB0, pB1, t + 1, (t + 4 < NT), (t + 2 < NT), (t + 2 < NT));     ENDW(t + 1); RESC(); ROT();
    }
    STEP(pB0, pB1, pA0, pA1, NT - 1, false, false, false); RESC();
    { float sacc = pB0[0] + pB0[1];
#pragma unroll
      for (int r = 2; r < 16; ++r) sacc += pB0[r];
#pragma unroll
      for (int r = 0; r < 16; ++r) sacc += pB1[r];
      l_reg += sacc;
      pw0 = (u32x4){PKW(pB0, 0), PKW(pB0, 2), PKW(pB0, 4), PKW(pB0, 6)}; pw1 = (u32x4){PKW(pB0, 8), PKW(pB0, 10), PKW(pB0, 12), PKW(pB0, 14)};
      pw2 = (u32x4){PKW(pB1, 0), PKW(pB1, 2), PKW(pB1, 4), PKW(pB1, 6)}; pw3 = (u32x4){PKW(pB1, 8), PKW(pB1, 10), PKW(pB1, 12), PKW(pB1, 14)};
      const lds_cptr vp_ = vp0 + sl_cur; _Pragma("unroll") for (int i = 0; i < 8; ++i) VRD(i);
      o[0] = A9_MFMA(PAF(0), VFR(0), o[0]); o[1] = A9_MFMA(PAF(0), VFR(4), o[1]); o[0] = A9_MFMA(PAF(1), VFR(1), o[0]); o[1] = A9_MFMA(PAF(1), VFR(5), o[1]);
      o[0] = A9_MFMA(PAF(2), VFR(2), o[0]); o[1] = A9_MFMA(PAF(2), VFR(6), o[1]); o[0] = A9_MFMA(PAF(3), VFR(3), o[0]); o[1] = A9_MFMA(PAF(3), VFR(7), o[1]); }
    { auto rr = __builtin_amdgcn_permlane32_swap(__float_as_uint(l_reg), __float_as_uint(l_reg), false, false); l_reg = __uint_as_float(rr[0]) + __uint_as_float(rr[1]); }
    if (hi == 0) wsf[32 + r32] = l_reg; asm volatile("s_waitcnt lgkmcnt(0)" ::: "memory");
    float rli[16];
#pragma unroll
    for (int r = 0; r < 16; ++r) rli[r] = __builtin_amdgcn_rcpf(wsf[32 + crow(r, hi)]);
    bf16* Ow = a.O + (long)(wid * QBLK) * a.ldo; unsigned short* stg = (unsigned short*)(lds + LDS_OST) + wid * 2048;
#pragma unroll
    for (int r = 0; r < 16; ++r) { const int orow = crow(r, hi);
#pragma unroll
        for (int d0 = 0; d0 < 2; ++d0) { const float v = o[d0][r] * rli[r]; const unsigned u = __float_as_uint(v); stg[orow * 64 + d0 * 32 + r32] = (unsigned short)((u + 0x7fffu + ((u >> 16) & 1u)) >> 16); } }
    asm volatile("s_waitcnt lgkmcnt(0)" ::: "memory");
#pragma unroll
    for (int i = 0; i < 4; ++i) { const int row = i * 8 + (lane >> 3), ch = lane & 7; *(u32x4*)(Ow + (long)row * a.ldo + ch * 8) = *(const u32x4*)(stg + row * 64 + ch * 8); }
    asm volatile("s_waitcnt lgkmcnt(0)\n\ts_barrier" ::: "memory");
#undef DMA_K
#undef DMA_V
#undef ROT
#undef RS3
#undef EX
#undef RESC
#undef PKW
#undef PAF
#undef VFR
#undef VRD
#undef KRD
#undef ENDW
#undef GAP3
#undef GAP2
#undef GAPB
#undef STEP
}
#undef A9_SBAR
#undef A9_PIN
#undef A9_MFMA
#undef A9_WAIT_BAR
}

constexpr size_t MiB = 1u << 20;
constexpr size_t WS_CTL = 0, CTL_BYTES = 1 * MiB;
constexpr size_t WS_MOD = 1 * MiB;
constexpr size_t WS_T16C = WS_MOD + 256 * 1024, WS_T16S = WS_T16C + 4096, WS_T8C = WS_T16S + 4096, WS_T8S = WS_T8C + 2048;
constexpr size_t WS_RSQ = WS_MOD + 320 * 1024, WS_RSKV = WS_RSQ + 64 * 1024;
constexpr size_t WS_TAB = WS_MOD + 512 * 1024;
constexpr size_t WS_WT = 3 * MiB;
constexpr size_t WT_IN = 0, WT_G = WT_IN + (size_t)PPW * DM * 2, WT_QU = WT_G + (size_t)NGATE * DM * 2, WT_KVU = WT_QU + (size_t)768 * 384 * 2, WT_BR = WT_KVU + (size_t)1024 * 256 * 2,
                 WT_OUT = WT_BR + (size_t)3 * DM * 512 * 2, WT_F1 = WT_OUT + (size_t)DM * DM * 2, WT_F2 = WT_F1 + (size_t)DFF * DM * 2, WT_END = WT_F2 + (size_t)DM * DFF * 2;
static_assert(WT_END <= 36 * MiB, "weights");
constexpr size_t WS_CTXX = WS_WT + 36 * MiB;
constexpr size_t WS_XN = WS_CTXX + 4 * MiB;
constexpr size_t WS_HALF = WS_XN + 34 * MiB;
constexpr int NUNIT = 32 * (RPB / 32);
constexpr int KVP = 1088;
constexpr size_t H_PP = 0, H_QM = H_PP + (size_t)HM * PPW * 2, H_KVM = H_QM + (size_t)HM * 768 * 2, H_MO = H_KVM + (size_t)HM * KVP * 2, H_PHI = H_MO + (size_t)HM * 512 * 2,
                 H_PSI = H_PHI + (size_t)NUNIT * 8192, H_GC = H_PSI + (size_t)NUNIT * 8192, H_END = H_GC;
constexpr size_t WS_END = WS_HALF + H_END;
static_assert(WS_END + 12 * MiB <= 256 * MiB, "workspace (the 12 MiB after WS_END hold transient scratch: pass-3 parking / split-K slabs)");
constexpr size_t WS_GB = WS_HALF + H_PHI, WS_MIX = WS_GB + (size_t)HM * 3 * DM * 2;
constexpr size_t WS_G0 = WS_HALF + H_KVM, WS_G1 = WS_HALF + H_PHI, WS_G2 = WS_G1 + (size_t)HM * DM * 2;
static_assert(WS_G2 + (size_t)HM * DM * 2 <= WS_HALF + H_PSI, "gate buffers");
constexpr size_t WS_HID = WS_HALF;
static_assert(WS_MIX + (size_t)HM * DM * 2 <= WS_HALF + H_GC && WS_HID + (size_t)MROWS * DFF * 2 <= WS_END, "overlays");
constexpr size_t WS_SPLIT = WS_END + 8 * MiB; constexpr int SPLIT_BYTES = 32768 + 1024;
static_assert(16 * 4 * SPLIT_BYTES <= 4 * MiB, "split scratch");
constexpr int CW_BAR = 4096, CW_ATT = 16384;

#define GAS __attribute__((address_space(1)))
#define LAS __attribute__((address_space(3)))
typedef unsigned short bf16;
typedef unsigned v4u __attribute__((ext_vector_type(4)));
typedef float f32x4 __attribute__((ext_vector_type(4)));
typedef float f32x8 __attribute__((ext_vector_type(8)));
#define LDS_WAIT() asm volatile("s_waitcnt lgkmcnt(0)" ::: "memory")
__device__ __forceinline__ unsigned f2bf(float f) { unsigned u = __builtin_bit_cast(unsigned, f); return (u + 0x7fffu + ((u >> 16) & 1u)) >> 16; }
__device__ __forceinline__ unsigned pk2(float lo, float hi) { return f2bf(lo) | (f2bf(hi) << 16); }
__device__ __forceinline__ float bf2f(unsigned short h) { return __uint_as_float((unsigned)h << 16); }

#define XB_TMO      128
#define XB_XCNT(j)  (256  + 64 * (j))
#define XB_XSUB(j)  (1280 + 64 * (j))
#define XB_XGEN(j)  (2304 + 64 * (j))
#define XB_TOP      3328
#define XB_TOPGEN   3392
#define XCD_BAR_WORDS 3456
#define XB_SPIN_CAP (1u << 22)
__device__ __forceinline__ unsigned xb_ld(unsigned* p)              { return __hip_atomic_load(p, __ATOMIC_RELAXED, __HIP_MEMORY_SCOPE_AGENT); }
__device__ __forceinline__ unsigned xb_add(unsigned* p, unsigned v) { return __hip_atomic_fetch_add(p, v, __ATOMIC_RELAXED, __HIP_MEMORY_SCOPE_AGENT); }
__device__ __forceinline__ unsigned xb_xcc_id() { return (unsigned)__builtin_amdgcn_s_getreg((3 << 11) | 20) & 0xFu; }
#define XB_SPIN(cond, bar) do { unsigned _sp = 0; while (cond) { __builtin_amdgcn_s_sleep(1); \
    if ((++_sp & 255u) == 0u) { if (xb_ld(&(bar)[XB_TMO])) break; if (_sp > XB_SPIN_CAP) { atomicAdd(&(bar)[XB_TMO], 1u); break; } } } } while (0)
struct XcdBarrier { unsigned* bar; unsigned x; volatile LAS unsigned* st; };
__device__ __forceinline__ XcdBarrier xcd_barrier_post(unsigned* bar, volatile LAS unsigned* st) {
    XcdBarrier b; b.bar = bar; b.x = xb_xcc_id(); b.st = st;
    if (threadIdx.x == 0) (void)xb_add(&bar[XB_XCNT(b.x)], 1u);
    return b;
}
__device__ __forceinline__ void xcd_barrier_complete(unsigned* bar, unsigned x, unsigned& nloc, unsigned& nx) {
    const unsigned G = gridDim.x * gridDim.y * gridDim.z;
    unsigned sum, cnt, mine, sp = 0u;
    for (;;) {
        sum = 0u; cnt = 0u; mine = 0u;
#pragma unroll
        for (unsigned j = 0; j < 16; ++j) { const unsigned c = xb_ld(&bar[XB_XCNT(j)]); sum += c; cnt += (c > 0u) ? 1u : 0u; mine = (j == x) ? c : mine; }
        if (sum == G) break;
        __builtin_amdgcn_s_sleep(1);
        if ((++sp & 255u) == 0u) { if (xb_ld(&bar[XB_TMO])) break; if (sp > XB_SPIN_CAP) { atomicAdd(&bar[XB_TMO], 1u); break; } }
    }
    nloc = mine > 0u ? mine : 1u; nx = cnt > 0u ? cnt : 1u;
}
__device__ __forceinline__ void xcd_barrier(const XcdBarrier& b) {
    asm volatile("s_waitcnt vmcnt(0)" ::: "memory");
    __syncthreads();
    if (threadIdx.x == 0) {
        unsigned* bar = b.bar; asm volatile("" : "+s"(bar));
        __builtin_amdgcn_s_waitcnt(0);
        unsigned nloc = b.st[0], nx = b.st[1];
        if (nloc == 0u) { xcd_barrier_complete(bar, b.x, nloc, nx); b.st[0] = nloc; b.st[1] = nx; }
        const unsigned old = xb_add(&bar[XB_XSUB(b.x)], 1u);
        const unsigned gen = old / nloc;
        if (old + 1u == (gen + 1u) * nloc) {
            __builtin_amdgcn_fence(__ATOMIC_RELEASE, "agent");
            asm volatile("s_waitcnt vmcnt(0)" ::: "memory");
            const unsigned og = xb_add(&bar[XB_TOP], 1u);
            const unsigned tg = og / nx;
            if (og + 1u == (tg + 1u) * nx) xb_add(&bar[XB_TOPGEN], 1u);
            else XB_SPIN(xb_ld(&bar[XB_TOPGEN]) == tg, bar);
            __builtin_amdgcn_fence(__ATOMIC_ACQUIRE, "agent");
            xb_add(&bar[XB_XGEN(b.x)], 1u);
            asm volatile("s_waitcnt vmcnt(0)" ::: "memory");
        } else {
            XB_SPIN(xb_ld(&bar[XB_XGEN(b.x)]) == gen, bar);
            __builtin_amdgcn_fence(__ATOMIC_ACQUIRE, "agent");
            asm volatile("s_waitcnt vmcnt(0)" ::: "memory");
        }
    }
    __syncthreads();
}

constexpr int NWAVES = 8, RING_BYTES = 131072, LDS_BYTES = 163840, MISC_OFF = LDS_BYTES - 512;
struct Args { const float* in[31]; float* out; unsigned char* ws; int ph_lo, ph_hi; };
enum { I_X = 0, I_C, I_CTX, I_CCTX, I_WMOD, I_BMOD, I_G1, I_G2, I_WIN, I_QGAIN, I_KGAIN, I_MU, I_W0, I_W2, I_A0, I_A2, I_G2R, I_KK, I_KA, I_RK, I_LNW, I_LNB, I_QNORM, I_QUP, I_KVNORM, I_KVUP, I_WBR, I_WOUT, I_FF1, I_FF2, I_GFIN };
#define CAS __attribute__((address_space(4)))
__device__ __forceinline__ const float* inp(int i) { const CAS Args* ap = (const CAS Args*)__builtin_amdgcn_kernarg_segment_ptr(); asm volatile("" : "+s"(ap)); return ap->in[i]; }
struct Frame {
    LAS unsigned char* lds; unsigned char* ldsg;
    unsigned* ctl; unsigned char* ws; float* out;
    int G, bid;
};
#define FTID() otid()
#define FLANE() (otid() & 63)
#define FWAVE() __builtin_amdgcn_readfirstlane(otid() >> 6)
__device__ __forceinline__ float wave_sum(float v) {
#pragma unroll
    for (int o = 1; o < 64; o <<= 1) v += __shfl_xor(v, o);
    return v;
}
__device__ __forceinline__ const float* xrow_ptr(const float* xl, const float* xc, int m) { const int b = m / RPB, s = m % RPB; return (s < CTX) ? xc + (size_t)(b * CTX + s) * DM : xl + (size_t)(b * SEQ + s - CTX) * DM; }

__device__ __forceinline__ void p0_transpose_item(const float* W, int ldw, int col0, int Kd, int N, bf16* WT, const float* kscale, LAS unsigned* scr, int item, int lane, int ldwt) {
    const int nblk = (N + 63) / 64, kb = item / nblk, nb = item % nblk, k0 = 64 * kb, n0 = 64 * nb, c = lane & 15, r4 = lane >> 4;
    const bool valid = n0 + 4 * c < N;
    const int cn = valid ? n0 + 4 * c : N - 4;
    const float vz = valid ? 1.f : 0.f;
#pragma unroll
    for (int i = 0; i < 8; ++i) { const int k = 8 * i + 2 * r4;
        f32x4 a = *(const f32x4*)(W + (size_t)(k0 + k) * ldw + col0 + cn), bq = *(const f32x4*)(W + (size_t)(k0 + k + 1) * ldw + col0 + cn);
        a = a * vz; bq = bq * vz;
        if (kscale) { a = a * kscale[k0 + k]; bq = bq * kscale[k0 + k + 1]; }
#pragma unroll
        for (int e = 0; e < 4; ++e) scr[(4 * c + e) * 33 + (k >> 1)] = pk2(a[e], bq[e]); }
    LDS_WAIT(); asm volatile("" ::: "memory");
#pragma unroll
    for (int t = 0; t < 8; ++t) { const int n = (lane >> 3) + 8 * t, j = lane & 7; const LAS unsigned* p = scr + n * 33 + 4 * j;
        v4u o; o.x = p[0]; o.y = p[1]; o.z = p[2]; o.w = p[3];
        if (n0 + n < N) *(v4u*)(WT + (size_t)(n0 + n) * ldwt + k0 + 8 * j) = o; }
    LDS_WAIT(); asm volatile("" ::: "memory");
}

__device__ __forceinline__ void ph_weights(Frame& F, int l) {
    unsigned char* wt = F.ws + WS_WT;
    if (l == 0) {
        LAS float* sl = (LAS float*)F.lds;
        LAS float* red = (LAS float*)(F.lds + 32768);
        for (int i = FTID(); i < 5 * 1024; i += 512) { const int j = i >> 10, k = i & 1023; const float c = (j < 4) ? inp(I_C)[j * 1024 + k] : inp(I_CCTX)[k]; sl[i] = c / (1.f + __expf(-c)); }
        __syncthreads();
        for (int it = F.bid; it < 2 * 96; it += F.G) {
            const int ll = it / 96, n0 = (it % 96) * 64;
            const float* wm = inp(I_WMOD) + (size_t)ll * 1024 * 6144 + n0 + FLANE();
            float a0 = 0, a1 = 0, a2 = 0, a3 = 0, a4 = 0;
            for (int k0 = FWAVE() * 128; k0 < FWAVE() * 128 + 128; k0 += 64) { float w[64];
#pragma unroll
                for (int u = 0; u < 64; ++u) w[u] = wm[(size_t)(k0 + u) * 6144];
#pragma unroll
                for (int u = 0; u < 64; ++u) { const int k = k0 + u; a0 += sl[k] * w[u]; a1 += sl[1024 + k] * w[u]; a2 += sl[2048 + k] * w[u]; a3 += sl[3072 + k] * w[u]; a4 += sl[4096 + k] * w[u]; } }
            LAS float* r = red + FWAVE() * 320 + FLANE(); r[0] = a0; r[64] = a1; r[128] = a2; r[192] = a3; r[256] = a4;
            __syncthreads();
            if (FTID() < 320) { float s = 0; for (int w = 0; w < 8; ++w) s += red[w * 320 + FTID()]; const int j = FTID() >> 6, n = n0 + (FTID() & 63);
                ((float*)(F.ws + WS_MOD))[(size_t)(ll * 5 + j) * 6144 + n] = s + inp(I_BMOD)[ll * 6144 + n]; }
            __syncthreads();
        }
        if (F.bid == F.G - 1) {
            for (int i = FTID(); i < 64 * 16; i += 512) { const int pos = i >> 4, f = i & 15; const float ang = (float)pos * powf(10000.f, -(float)f / 16.f); ((float*)(F.ws + WS_T16C))[i] = cosf(ang); ((float*)(F.ws + WS_T16S))[i] = sinf(ang); }
            for (int i = FTID(); i < 64 * 8; i += 512) { const int pos = i >> 3, f = i & 7; const float ang = (float)pos * powf(10000.f, -(float)f / 8.f); ((float*)(F.ws + WS_T8C))[i] = cosf(ang); ((float*)(F.ws + WS_T8S))[i] = sinf(ang); }
        }
        __syncthreads();
    }
    {
        bf16* w2P = (bf16*)(F.ws + WS_TAB); bf16* a2B = (bf16*)(F.ws + WS_TAB + 131072); bf16* g2P = (bf16*)(F.ws + WS_TAB + 524288);
        const float* w2 = inp(I_W2) + (size_t)l * 2 * 64 * 512; const float* a2 = inp(I_A2) + (size_t)l * 2 * 64 * 512; const float* g2 = inp(I_G2R) + (size_t)l * 128 * 512;
        const float* mu = inp(I_MU) + (size_t)l * 2 * RWIN;
        bf16* DF = (bf16*)(F.ws + WS_TAB + 655360);
        const int tstride = F.G * 512;
        for (int base = F.bid * 512 + FTID(); base < 196608; base += 2 * tstride) {
            float vw[2], vg[2], vd0[2], vd1[2], va[2], vm0[2], vm1[2];
#pragma unroll
            for (int j = 0; j < 2; ++j) { const int idx0 = base + j * tstride;
                { const int idx = idx0 < 65536 ? idx0 : 65535;
                  { const int dh = idx >> 12, d = dh >> 3, hd = dh & 7, rem = idx & 4095, Ii = rem >> 11, J = (rem >> 10) & 1, S = (rem >> 9) & 1, ln = (rem >> 3) & 63, e = rem & 7;
                    const int i = 32 * Ii + 16 * S + 8 * (e >> 2) + 4 * (ln >> 5) + (e & 3), k = 32 * J + (ln & 31);
                    vw[j] = w2[(size_t)(d * 64 + i) * 512 + hd * 64 + k]; }
                  { const int hd = idx >> 13, rem = idx & 8191, Ii = rem >> 11, Iv = (rem >> 10) & 1, S = (rem >> 9) & 1, ln = (rem >> 3) & 63, e = rem & 7;
                    const int i = 32 * Ii + 16 * S + 8 * (e >> 2) + 4 * (ln >> 5) + (e & 3), v = 32 * Iv + (ln & 31);
                    vg[j] = g2[(size_t)i * 512 + hd * 64 + v]; } }
                { const int idx = idx0 < 60 * 3 * 2 * 64 * 8 ? idx0 : 60 * 3 * 2 * 64 * 8 - 1; const int ln = (idx >> 3) & 63, blk = idx / 3072, r = ln & 31, cc = 32 * blk + r;
                  vd0[j] = mu[cc]; vd1[j] = mu[RWIN + cc]; }
                { const int idx = idx0 < 196608 ? idx0 : 196607; const int dh = idx / 12288, rem = idx % 12288, k = (rem >> 6) & 63, i = rem & 63, d = dh >> 3, hd = dh & 7;
                  va[j] = a2[(size_t)(d * 64 + i) * 512 + hd * 64 + k]; vm0[j] = mu[RW_AD + d * 64 + i]; vm1[j] = mu[RWIN + RW_AD + d * 64 + i]; } }
#pragma unroll
            for (int j = 0; j < 2; ++j) { const int idx = base + j * tstride;
                if (idx < 65536) { w2P[idx] = (bf16)f2bf(vw[j]); g2P[idx] = (bf16)f2bf(vg[j]); }
                if (idx < 60 * 3 * 2 * 64 * 8) { const int e = idx & 7, ln = (idx >> 3) & 63, q = (idx >> 9) & 1, w = (idx >> 10) % 3, r = ln & 31, h = ln >> 5;
                    const float m0 = vd0[j], m1 = vd1[j]; const float cf = (w == 0) ? 1.f - m0 - m1 : (w == 1 ? m0 : m1);
                    DF[idx] = (r == 16 * q + 8 * h + e) ? (bf16)f2bf(cf) : (bf16)0; }
                if (idx < 196608) { const int w = (idx % 12288) >> 12; const float m0 = vm0[j], m1 = vm1[j]; const float cf = (w == 0) ? 1.f - m0 - m1 : (w == 1 ? m0 : m1);
                    a2B[idx] = (bf16)f2bf(va[j] * cf); } } } }
    LAS unsigned* scr = (LAS unsigned*)(F.lds + FWAVE() * 16384);
    const int gw = F.bid * NWAVES + FWAVE(), NGW = F.G * NWAVES;
    const float* win = inp(I_WIN) + (size_t)l * DM * NIN;
    constexpr int I_A = 16 * 53, I_B = 16 * 48, I_C2 = 6 * 12, I_D = 4 * 16, I_E = 8 * 16, I_F = 16 * 16, I_G = 16 * 64, I_H = 64 * 16;
    constexpr int NITEMS = I_A + I_B + I_C2 + I_D + 3 * I_E + I_F + I_G + I_H;
    for (int kr = 0; ; ++kr) {
        const int it = (kr < 2) ? gw + kr * NGW : kr * NGW + (gw + NGW - (192 * NWAVES) % NGW) % NGW;
        if (it >= NITEMS) { if (kr < 2) continue; break; }
        int r = it; const int lane = FLANE();
        if (r < I_A) { p0_transpose_item(win, NIN, 0, DM, 3360, (bf16*)(wt + WT_IN), nullptr, scr, r, lane, DM); continue; } r -= I_A;
        if (r < I_B) { p0_transpose_item(win, NIN, C_GATE, DM, NGATE, (bf16*)(wt + WT_G), nullptr, scr, r, lane, DM); continue; } r -= I_B;
        if (r < I_C2) { p0_transpose_item(inp(I_QUP) + (size_t)l * 384 * 768, 768, 0, 384, 768, (bf16*)(wt + WT_QU), inp(I_QNORM) + l * 384, scr, r, lane, 384); continue; } r -= I_C2;
        if (r < I_D) { p0_transpose_item(inp(I_KVUP) + (size_t)l * 256 * 1024, 1024, 0, 256, 1024, (bf16*)(wt + WT_KVU), inp(I_KVNORM) + l * 256, scr, r, lane, 256); continue; } r -= I_D;
        if (r < 3 * I_E) { const int i = r / I_E; p0_transpose_item(inp(I_WBR) + (size_t)(l * 3 + i) * 512 * DM, DM, 0, 512, DM, (bf16*)(wt + WT_BR) + (size_t)i * DM * 512, nullptr, scr, r % I_E, lane, 512); continue; } r -= 3 * I_E;
        if (r < I_F) { p0_transpose_item(inp(I_WOUT) + (size_t)l * DM * DM, DM, 0, DM, DM, (bf16*)(wt + WT_OUT), nullptr, scr, r, lane, DM); continue; } r -= I_F;
        if (r < I_G) { p0_transpose_item(inp(I_FF1) + (size_t)l * DM * DFF, DFF, 0, DM, DFF, (bf16*)(wt + WT_F1), nullptr, scr, r, lane, DM); continue; } r -= I_G;
        p0_transpose_item(inp(I_FF2) + (size_t)l * DFF * DM, DM, 0, DFF, DM, (bf16*)(wt + WT_F2), nullptr, scr, r, lane, DFF);
    }
    { v4u* z = (v4u*)((bf16*)(wt + WT_IN) + (size_t)3360 * DM); const int nz = 224 * DM * 2 / 16; unsigned z0; asm volatile("v_mov_b32 %0, 0" : "=v"(z0));
      for (int i = F.bid * 512 + FTID(); i < nz; i += F.G * 512) z[i] = (v4u){z0, z0, z0, z0}; }
}

__device__ __forceinline__ void ph_norm(Frame& F, int l, const void* xl, const void* xc, bool src_bf, const float* g, int which, bool skipctx, const float* part = nullptr) {
    const int gw = F.bid * NWAVES + FWAVE(), NGW = F.G * NWAVES;
    const float* mod = (const float*)(F.ws + WS_MOD) + (size_t)l * 5 * 6144;
    bf16* XN = (bf16*)(F.ws + WS_XN);
    f32x4 gg[4];
#pragma unroll
    for (int j = 0; j < 4; ++j) gg[j] = *(const f32x4*)(g + 4 * FLANE() + 256 * j);
#define NORM_NEXT(m_) do { (m_) += NGW; } while ((m_) < MROWS && skipctx && ((m_) % RPB) < CTX)
#define NORM_LOAD(m_, V, SH, SC) do { const int b_ = (m_) / RPB, s_ = (m_) % RPB; const size_t xo_ = (s_ < CTX) ? (size_t)(b_ * CTX + s_) * DM : (size_t)(b_ * SEQ + s_ - CTX) * DM; \
        const f32x4* xr_ = (const f32x4*)((const float*)((s_ < CTX) ? xc : xl) + xo_) + FLANE(); const uint2* xh_ = (const uint2*)((const bf16*)((s_ < CTX) ? xc : xl) + xo_) + FLANE(); \
        const float* mv_ = mod + (size_t)((s_ < CTX) ? 4 : b_) * 6144 + which * 3072 + 4 * FLANE(); \
        if (src_bf) { _Pragma("unroll") for (int j = 0; j < 4; ++j) { const uint2 w_ = xh_[64 * j]; V[j] = (f32x4){pg8::bf_lo(w_.x), pg8::bf_hi(w_.x), pg8::bf_lo(w_.y), pg8::bf_hi(w_.y)}; } } \
        else { _Pragma("unroll") for (int j = 0; j < 4; ++j) V[j] = xr_[64 * j]; } \
        _Pragma("unroll") for (int j = 0; j < 4; ++j) { SH[j] = *(const f32x4*)(mv_ + 256 * j); SC[j] = *(const f32x4*)(mv_ + 1024 + 256 * j); } \
        if (part && s_ < CTX) { _Pragma("unroll") for (int j = 0; j < 4; ++j) { const f32x4* pr_ = (const f32x4*)(part + (size_t)(b_ * CTX + s_) * DM) + FLANE() + 64 * j; V[j] = V[j] + pr_[0] + pr_[262144] + pr_[524288]; } } } while (0)
    int m = gw; if (skipctx && (m % RPB) < CTX) NORM_NEXT(m);
    f32x4 v[4], sh[4], sc[4];
    if (m < MROWS) NORM_LOAD(m, v, sh, sc);
    while (m < MROWS) {
        int mn = m; NORM_NEXT(mn);
        f32x4 vn[4], shn[4], scn[4];
#pragma unroll
        for (int j = 0; j < 4; ++j) { vn[j] = v[j]; shn[j] = sh[j]; scn[j] = sc[j]; }
        if (mn < MROWS) NORM_LOAD(mn, vn, shn, scn);
        asm volatile("" ::: "memory");
        float ss = 0.f;
#pragma unroll
        for (int j = 0; j < 4; ++j) ss += (v[j].x * v[j].x + v[j].y * v[j].y) + (v[j].z * v[j].z + v[j].w * v[j].w);
        const float rstd = 1.f / sqrtf(wave_sum(ss) * (1.f / DM) + NORM_EPS);
        unsigned long long* o8 = (unsigned long long*)(XN + (size_t)m * DM) + FLANE();
#pragma unroll
        for (int j = 0; j < 4; ++j) { const f32x4 y = v[j] * rstd * gg[j] * (sc[j] + 1.0f) + sh[j];
            o8[64 * j] = (unsigned long long)pk2(y.x, y.y) | ((unsigned long long)pk2(y.z, y.w) << 32); }
#pragma unroll
        for (int j = 0; j < 4; ++j) { v[j] = vn[j]; sh[j] = shn[j]; sc[j] = scn[j]; }
        m = mn;
    }
#undef NORM_NEXT
#undef NORM_LOAD
}
__device__ __forceinline__ void ph_final(Frame& F) {
    const int gw = F.bid * NWAVES + FWAVE(), NGW = F.G * NWAVES; const float* g = inp(I_GFIN);
    const bf16* XL = (const bf16*)(F.ws + WS_XN);
    f32x4 gg[4];
#pragma unroll
    for (int j = 0; j < 4; ++j) gg[j] = *(const f32x4*)(g + 4 * FLANE() + 256 * j);
    int m = gw; uint2 w[4];
    if (m < NB * SEQ) { const uint2* xr = (const uint2*)(XL + (size_t)m * DM) + FLANE();
#pragma unroll
        for (int j = 0; j < 4; ++j) w[j] = xr[64 * j]; }
    while (m < NB * SEQ) {
        const int mn = m + NGW; uint2 wn[4];
#pragma unroll
        for (int j = 0; j < 4; ++j) wn[j] = w[j];
        if (mn < NB * SEQ) { const uint2* xr = (const uint2*)(XL + (size_t)mn * DM) + FLANE();
#pragma unroll
            for (int j = 0; j < 4; ++j) wn[j] = xr[64 * j]; }
        asm volatile("" ::: "memory");
        f32x4 v[4]; float ss = 0.f;
#pragma unroll
        for (int j = 0; j < 4; ++j) v[j] = (f32x4){pg8::bf_lo(w[j].x), pg8::bf_hi(w[j].x), pg8::bf_lo(w[j].y), pg8::bf_hi(w[j].y)};
#pragma unroll
        for (int j = 0; j < 4; ++j) ss += (v[j].x * v[j].x + v[j].y * v[j].y) + (v[j].z * v[j].z + v[j].w * v[j].w);
        const float rstd = 1.f / sqrtf(wave_sum(ss) * (1.f / DM) + NORM_EPS);
        f32x4* xo = (f32x4*)(F.out + (size_t)m * DM) + FLANE();
#pragma unroll
        for (int j = 0; j < 4; ++j) xo[64 * j] = v[j] * rstd * gg[j];
#pragma unroll
        for (int j = 0; j < 4; ++j) w[j] = wn[j];
        m = mn;
    }
}

__device__ __forceinline__ void ph_prep(Frame& F, int l, int half) {
    const int gw = F.bid * NWAVES + FWAVE(), NGW = F.G * NWAVES, lane = FLANE();
    bf16* PP = (bf16*)(F.ws + WS_HALF + H_PP);
    const float* t16c = (const float*)(F.ws + WS_T16C); const float* t16s = (const float*)(F.ws + WS_T16S); const float* t8c = (const float*)(F.ws + WS_T8C); const float* t8s = (const float*)(F.ws + WS_T8S);
    const float* qg = inp(I_QGAIN) + l * 64; const float* kg = inp(I_KGAIN) + l * 64;
    const bool skew = NGW == 2048; const int wv = FWAVE(); const bool third = skew && F.bid < 64 && wv < 4;
    const int wp = !skew ? gw : third ? -1 : (F.bid < 64 ? F.bid * 4 + (wv - 4) : 256 + (F.bid - 64) * 8 + wv), NWP = skew ? NGW - 256 : NGW;
    const int j = lane & 7, f0 = 8 * (j & 1);
    const f32x4 gq0 = *(const f32x4*)(qg + j * 8), gq1 = *(const f32x4*)(qg + j * 8 + 4), gk0 = *(const f32x4*)(kg + j * 8), gk1 = *(const f32x4*)(kg + j * 8 + 4);
    for (int m = wp; m < HM; m += NWP) {
        if (wp < 0) break;
        const int s = m % RPB; const bool lat = s >= CTX; const int tt = s - CTX, pr = (tt >> 6) & 63, pc = tt & 63;
        bf16* row = PP + (size_t)m * PPW;
        bf16* pq = row + C_GQ + lane * 8; bf16* pk = row + C_GK + (lane & 15) * 8; bf16* pkr = row + C_KR + (lane & 3) * 8;
        const int pos16 = lat ? ((j < 4) ? pr : pc) : 0, pos8 = lat ? (((lane & 3) < 2) ? pr : pc) : 0;
        const v4u wq = *(const v4u*)pq, wk = *(const v4u*)pk, wkr = *(const v4u*)pkr;
        const f32x4 c16a = *(const f32x4*)(t16c + pos16 * 16 + f0), c16b = *(const f32x4*)(t16c + pos16 * 16 + f0 + 4), s16a = *(const f32x4*)(t16s + pos16 * 16 + f0), s16b = *(const f32x4*)(t16s + pos16 * 16 + f0 + 4);
        const f32x4 c8a = *(const f32x4*)(t8c + pos8 * 8), c8b = *(const f32x4*)(t8c + pos8 * 8 + 4), s8a = *(const f32x4*)(t8s + pos8 * 8), s8b = *(const f32x4*)(t8s + pos8 * 8 + 4);
        asm volatile("" ::: "memory");
        const float c16[8] = {c16a.x, c16a.y, c16a.z, c16a.w, c16b.x, c16b.y, c16b.z, c16b.w}, s16[8] = {s16a.x, s16a.y, s16a.z, s16a.w, s16b.x, s16b.y, s16b.z, s16b.w};
#pragma unroll
        for (int part = 0; part < 2; ++part) {
            const v4u w = part == 0 ? wq : wk;
            const f32x4 ga = part == 0 ? gq0 : gk0, gb = part == 0 ? gq1 : gk1; const float gain[8] = {ga.x, ga.y, ga.z, ga.w, gb.x, gb.y, gb.z, gb.w};
            float v[8] = {pg8::bf_lo(w.x), pg8::bf_hi(w.x), pg8::bf_lo(w.y), pg8::bf_hi(w.y), pg8::bf_lo(w.z), pg8::bf_hi(w.z), pg8::bf_lo(w.w), pg8::bf_hi(w.w)};
            float ss = 0;
#pragma unroll
            for (int e = 0; e < 8; ++e) ss += v[e] * v[e];
            ss += __shfl_xor(ss, 1); ss += __shfl_xor(ss, 2); ss += __shfl_xor(ss, 4);
            const float rstd = 1.f / sqrtf(ss * (1.f / 64.f) + NORM_EPS);
            const float qs = (part == 0) ? 0.125f * 1.4426950408889634f : 1.f;
#pragma unroll
            for (int e = 0; e < 8; ++e) v[e] = v[e] * (rstd * qs) * gain[e];
            float pv[8];
#pragma unroll
            for (int e = 0; e < 8; ++e) pv[e] = __shfl_xor(v[e], 2);
            if (lat) {
#pragma unroll
                for (int e = 0; e < 8; ++e) { const float c = c16[e], sn = s16[e]; v[e] = ((j & 2) == 0) ? v[e] * c - pv[e] * sn : pv[e] * sn + v[e] * c; } }
            v4u o; o.x = pk2(v[0], v[1]); o.y = pk2(v[2], v[3]); o.z = pk2(v[4], v[5]); o.w = pk2(v[6], v[7]);
            if (part == 0) *(v4u*)pq = o; else if (lane < 16) *(v4u*)pk = o;
        }
        {   const v4u w = wkr; float v[8] = {pg8::bf_lo(w.x), pg8::bf_hi(w.x), pg8::bf_lo(w.y), pg8::bf_hi(w.y), pg8::bf_lo(w.z), pg8::bf_hi(w.z), pg8::bf_lo(w.w), pg8::bf_hi(w.w)};
            const float c8[8] = {c8a.x, c8a.y, c8a.z, c8a.w, c8b.x, c8b.y, c8b.z, c8b.w}, s8[8] = {s8a.x, s8a.y, s8a.z, s8a.w, s8b.x, s8b.y, s8b.z, s8b.w};
            float pv[8];
#pragma unroll
            for (int e = 0; e < 8; ++e) pv[e] = __shfl_xor(v[e], 1);
            if (lat) {
#pragma unroll
                for (int e = 0; e < 8; ++e) { const float c = c8[e], sn = s8[e]; v[e] = ((lane & 1) == 0) ? v[e] * c - pv[e] * sn : pv[e] * sn + v[e] * c; } }
            v4u o; o.x = pk2(v[0], v[1]); o.y = pk2(v[2], v[3]); o.z = pk2(v[4], v[5]); o.w = pk2(v[6], v[7]);
            if (lane < 4) *(v4u*)pkr = o;
        }
    }
}
__device__ __forceinline__ void shifted8(const bf16* PP, int m, int cc0, const float* mu, float (&u)[8]) {
    const int s = m % RPB; const float fp = (s != 0 && s != CTX) ? 1.f : 0.f, fn = (s != CTX - 1 && s != RPB - 1) ? 1.f : 0.f;
    const int mp = m > 0 ? m - 1 : 0, mn = m < HM - 1 ? m + 1 : HM - 1;
    const v4u w = *(const v4u*)(PP + (size_t)m * PPW + C_RW + cc0), wp = *(const v4u*)(PP + (size_t)mp * PPW + C_RW + cc0), wn = *(const v4u*)(PP + (size_t)mn * PPW + C_RW + cc0);
    const f32x4 m0a = *(const f32x4*)(mu + cc0), m0b = *(const f32x4*)(mu + cc0 + 4), m1a = *(const f32x4*)(mu + RWIN + cc0), m1b = *(const f32x4*)(mu + RWIN + cc0 + 4);
    const float c[8] = {pg8::bf_lo(w.x), pg8::bf_hi(w.x), pg8::bf_lo(w.y), pg8::bf_hi(w.y), pg8::bf_lo(w.z), pg8::bf_hi(w.z), pg8::bf_lo(w.w), pg8::bf_hi(w.w)};
    const float a[8] = {pg8::bf_lo(wp.x), pg8::bf_hi(wp.x), pg8::bf_lo(wp.y), pg8::bf_hi(wp.y), pg8::bf_lo(wp.z), pg8::bf_hi(wp.z), pg8::bf_lo(wp.w), pg8::bf_hi(wp.w)};
    const float n[8] = {pg8::bf_lo(wn.x), pg8::bf_hi(wn.x), pg8::bf_lo(wn.y), pg8::bf_hi(wn.y), pg8::bf_lo(wn.z), pg8::bf_hi(wn.z), pg8::bf_lo(wn.w), pg8::bf_hi(wn.w)};
#pragma unroll
    for (int e = 0; e < 8; ++e) { const float m0 = (e < 4 ? m0a[e & 3] : m0b[e & 3]), m1 = (e < 4 ? m1a[e & 3] : m1b[e & 3]); u[e] = c[e] + m0 * (fp * a[e] - c[e]) + m1 * (fn * n[e] - c[e]); }
}
namespace rk {
using bf16x8 = __attribute__((ext_vector_type(8))) short;
using f32x16 = __attribute__((ext_vector_type(16))) float;
using u32x4 = __attribute__((ext_vector_type(4))) unsigned;
typedef float f32x2_t __attribute__((ext_vector_type(2))); typedef __bf16 bf16x2_t __attribute__((ext_vector_type(2)));
#define RK_DI __device__ __forceinline__
RK_DI f32x16 RK_MF(bf16x8 a, bf16x8 b, f32x16 c) { return __builtin_amdgcn_mfma_f32_32x32x16_bf16(a, b, c, 0, 0, 0); }
constexpr int NH = 8;
RK_DI unsigned cvt2(float lo, float hi) { f32x2_t v = {lo, hi}; bf16x2_t b = __builtin_convertvector(v, bf16x2_t); return __builtin_bit_cast(unsigned, b); }
RK_DI float lo16(unsigned w) { return __uint_as_float(w << 16); }
RK_DI float hi16(unsigned w) { return __uint_as_float(w & 0xffff0000u); }
RK_DI int crow(int reg, int h) { return (reg & 3) + 8 * (reg >> 2) + 4 * h; }
RK_DI int krow(int s, int h, int e) { return 16 * s + 8 * (e >> 2) + 4 * h + (e & 3); }
template <int S> RK_DI bf16x8 pack(const f32x16& x) { u32x4 p = {cvt2(x[8 * S], x[8 * S + 1]), cvt2(x[8 * S + 2], x[8 * S + 3]), cvt2(x[8 * S + 4], x[8 * S + 5]), cvt2(x[8 * S + 6], x[8 * S + 7])}; return __builtin_bit_cast(bf16x8, p); }
RK_DI bf16x8 pack8(const float (&u)[8]) { u32x4 p = {cvt2(u[0], u[1]), cvt2(u[2], u[3]), cvt2(u[4], u[5]), cvt2(u[6], u[7])}; return __builtin_bit_cast(bf16x8, p); }
RK_DI void unpack8(bf16x8 v, float (&u)[8]) { const u32x4 p = __builtin_bit_cast(u32x4, v); u[0] = lo16(p.x); u[1] = hi16(p.x); u[2] = lo16(p.y); u[3] = hi16(p.y); u[4] = lo16(p.z); u[5] = hi16(p.z); u[6] = lo16(p.w); u[7] = hi16(p.w); }
constexpr short ONE = (short)0x3F80;
template <int K> RK_DI bf16x8 idn(int r, int h) { bf16x8 v;
#pragma unroll
    for (int e = 0; e < 8; ++e) v[e] = (r == 16 * K + 8 * h + e) ? ONE : (short)0; return v; }
template <int S> RK_DI bf16x8 idp(int r, int h) { bf16x8 v;
#pragma unroll
    for (int e = 0; e < 8; ++e) v[e] = (r == krow(S, h, e)) ? ONE : (short)0; return v; }
RK_DI bf16x8 idn_q(int q, int r, int h) { return q ? idn<1>(r, h) : idn<0>(r, h); }
template <int S, bool STRICT> RK_DI bf16x8 incp(int r, int h, int flip) { bf16x8 v;
#pragma unroll
    for (int e = 0; e < 8; ++e) { const int s = krow(S, h, e); const bool on = flip ? (STRICT ? s > r : s >= r) : (STRICT ? s < r : s <= r); v[e] = on ? ONE : (short)0; } return v; }
template <bool STRICT> RK_DI void tmask(f32x16& g, int r, int h, int flip) {
#pragma unroll
    for (int reg = 0; reg < 16; ++reg) { const int s = crow(reg, h); const bool on = flip ? (STRICT ? s > r : s >= r) : (STRICT ? s < r : s <= r); g[reg] = on ? g[reg] : 0.f; } }
template <int FLIP> RK_DI void solve32(f32x16& x, const bf16x8 (&Mp)[2]) {
    constexpr int F1 = FLIP ? 1 : 0, F2 = 1 - F1;
    f32x16 base = x;
#pragma unroll 1
    for (int it = 0; it < NH; ++it) { const f32x16 t = RK_MF(Mp[F1], pack<F1>(x), base);
#pragma unroll
        for (int e = 0; e < 8; ++e) x[8 * F1 + e] = t[8 * F1 + e]; }
    { const f32x16 t = RK_MF(Mp[F1], pack<F1>(x), base); x = t; base = t; }
#pragma unroll 1
    for (int it = 0; it < NH; ++it) { const f32x16 t = RK_MF(Mp[F2], pack<F2>(x), base);
#pragma unroll
        for (int e = 0; e < 8; ++e) x[8 * F2 + e] = t[8 * F2 + e]; }
}
template <int FLIP> RK_DI void solve32p(f32x16& x, f32x16& y, const bf16x8 (&Mp)[2]) {
    constexpr int F1 = FLIP ? 1 : 0, F2 = 1 - F1;
    f32x16 bx = x, by = y;
#pragma unroll 1
    for (int it = 0; it < NH; ++it) { const f32x16 t = RK_MF(Mp[F1], pack<F1>(x), bx); const f32x16 u = RK_MF(Mp[F1], pack<F1>(y), by);
#pragma unroll
        for (int e = 0; e < 8; ++e) { x[8 * F1 + e] = t[8 * F1 + e]; y[8 * F1 + e] = u[8 * F1 + e]; } }
    { const f32x16 t = RK_MF(Mp[F1], pack<F1>(x), bx); const f32x16 u = RK_MF(Mp[F1], pack<F1>(y), by); x = t; bx = t; y = u; by = u; }
#pragma unroll 1
    for (int it = 0; it < NH; ++it) { const f32x16 t = RK_MF(Mp[F2], pack<F2>(x), bx); const f32x16 u = RK_MF(Mp[F2], pack<F2>(y), by);
#pragma unroll
        for (int e = 0; e < 8; ++e) { x[8 * F2 + e] = t[8 * F2 + e]; y[8 * F2 + e] = u[8 * F2 + e]; } }
}
RK_DI float sigm(float x) { return __builtin_amdgcn_rcpf(1.f + __expf(-x)); }
RK_DI float tanh_f(float x) { return 2.f * __builtin_amdgcn_rcpf(1.f + __expf(-2.f * x)) - 1.f; }

struct Ctx {
    unsigned char* ws; LAS unsigned char* sb; int m0, r, h, hd, dir, l, flip;
    int cofs, dofs;
    int zt;
    int lofs;
    unsigned mp, mn; int rowc, rowp, rown;
};
#define C_PP(c) ((const bf16*)((c).ws + WS_HALF + H_PP))
#define C_MU(c) (inp(I_MU) + (size_t)(c).l * 2 * RWIN)
#define C_W2P(c) ((const bf16*)((c).ws + WS_TAB) + (size_t)((c).dir * 8 + (c).hd) * 4096)
#define C_A2B(c) ((const bf16*)((c).ws + WS_TAB + 131072) + (size_t)((c).dir * 8 + (c).hd) * 3 * 4096)
constexpr int SBUF = 34 * 128;
RK_DI void stage_slice(const Ctx& c, int buf, int cc0) {
    const int lane = c.r + 32 * c.h, p = lane & 7, q4 = lane >> 4;
    const bf16* base = C_PP(c) + (ptrdiff_t)(c.m0 - 1 + (lane >> 3)) * PPW + C_RW + cc0;
    const int oe = (p ^ q4) << 3, oo = (p ^ (4 + q4)) << 3;
#pragma unroll
    for (int j = 0; j < 5; ++j) { const bf16* src = base + (ptrdiff_t)j * 8 * PPW + ((j & 1) ? oo : oe);
        if (j < 4 || lane < 16) __builtin_amdgcn_global_load_lds((const unsigned*)src, (LAS unsigned*)(c.sb + buf * SBUF + j * 1024), 16, 0, 0); }
}
#define RK_WAIT_DMA() asm volatile("s_waitcnt vmcnt(0)" ::: "memory")
#define RK_WAIT_LDS() asm volatile("s_waitcnt lgkmcnt(0)" ::: "memory")
RK_DI bf16x8 rawfrag(const Ctx& c, int buf, int ch, int w) {
    const int rho = c.r + (w == 0 ? 1 : (w == 1 ? 0 : 2)); const unsigned m = (w == 0) ? 0xffffffffu : (w == 1 ? c.mp : c.mn);
    u32x4 v = *(const LAS u32x4*)(c.sb + buf * SBUF + rho * 128 + ((ch ^ ((rho >> 1) & 7)) << 4) + c.zt); v.x &= m; v.y &= m; v.z &= m; v.w &= m; return __builtin_bit_cast(bf16x8, v); }
RK_DI bf16x8 dfrag(const Ctx& c, int cc32, int w, int q) { return *(const bf16x8*)((const bf16*)(c.ws + WS_TAB + 655360) + (((cc32 >> 5) * 3 + w) * 2 + q) * 512 + c.lofs); }
#define RK_PIN6(d) asm volatile("" : "+v"(d[0][0]), "+v"(d[0][1]), "+v"(d[0][2]), "+v"(d[1][0]), "+v"(d[1][1]), "+v"(d[1][2]))
RK_DI f32x16 load_o2(Ctx& c, int buf, int lblk, int cc32) { f32x16 z = f32x16{};
    bf16x8 d[2][3];
#pragma unroll
    for (int q = 0; q < 2; ++q)
#pragma unroll
        for (int w = 0; w < 3; ++w) d[q][w] = dfrag(c, cc32, w, q);
    bf16x8 f[2][3];
#pragma unroll
    for (int q = 0; q < 2; ++q)
#pragma unroll
        for (int w = 0; w < 3; ++w) f[q][w] = rawfrag(c, buf, 4 * lblk + 2 * q + c.h, w);
    RK_PIN6(d); RK_PIN6(f);
#pragma unroll
    for (int q = 0; q < 2; ++q) {
#pragma unroll
        for (int w = 0; w < 3; ++w) z = RK_MF(d[q][w], f[q][w], z); }
    asm volatile("" : "+v"(c.lofs), "+v"(c.zt), "+v"(z));
    return z; }
RK_DI void dpre(const Ctx& c, int cc32, bf16x8 (&d)[2][3]) {
#pragma unroll
    for (int q = 0; q < 2; ++q)
#pragma unroll
        for (int w = 0; w < 3; ++w) d[q][w] = dfrag(c, cc32, w, q);
    __builtin_amdgcn_sched_barrier(0); }
RK_DI f32x16 load_o2p(Ctx& c, int buf, int lblk, bf16x8 (&d)[2][3]) { f32x16 z = f32x16{};
    bf16x8 f[2][3];
#pragma unroll
    for (int q = 0; q < 2; ++q)
#pragma unroll
        for (int w = 0; w < 3; ++w) f[q][w] = rawfrag(c, buf, 4 * lblk + 2 * q + c.h, w);
    RK_PIN6(d); RK_PIN6(f);
#pragma unroll
    for (int q = 0; q < 2; ++q) {
#pragma unroll
        for (int w = 0; w < 3; ++w) z = RK_MF(d[q][w], f[q][w], z); }
    asm volatile("" : "+v"(c.lofs), "+v"(c.zt), "+v"(z));
    return z; }
RK_DI f32x16 load_o1p(Ctx& c, int buf, int lblk, bf16x8 (&d)[2][3]) { f32x16 z = f32x16{};
    bf16x8 f[2][3];
#pragma unroll
    for (int q = 0; q < 2; ++q)
#pragma unroll
        for (int w = 0; w < 3; ++w) f[q][w] = rawfrag(c, buf, 4 * lblk + 2 * q + c.h, w);
    RK_PIN6(d); RK_PIN6(f);
#pragma unroll
    for (int q = 0; q < 2; ++q) {
#pragma unroll
        for (int w = 0; w < 3; ++w) z = RK_MF(f[q][w], d[q][w], z); }
    asm volatile("" : "+v"(c.lofs), "+v"(c.zt), "+v"(z));
    return z; }
RK_DI f32x16 load_o1(Ctx& c, int buf, int lblk, int cc32) { f32x16 z = f32x16{};
    bf16x8 d[2][3];
#pragma unroll
    for (int q = 0; q < 2; ++q)
#pragma unroll
        for (int w = 0; w < 3; ++w) d[q][w] = dfrag(c, cc32, w, q);
    bf16x8 f[2][3];
#pragma unroll
    for (int q = 0; q < 2; ++q)
#pragma unroll
        for (int w = 0; w < 3; ++w) f[q][w] = rawfrag(c, buf, 4 * lblk + 2 * q + c.h, w);
    RK_PIN6(d); RK_PIN6(f);
#pragma unroll
    for (int q = 0; q < 2; ++q) {
#pragma unroll
        for (int w = 0; w < 3; ++w) z = RK_MF(f[q][w], d[q][w], z); }
    asm volatile("" : "+v"(c.lofs), "+v"(c.zt), "+v"(z));
    return z; }

struct Tilde { bf16x8 At[2][2], Bt[2][2], Kt[2][2], Rt[2][2], Vp[2][2]; float gtot[2]; float bon; };
#define RK_STAGE(x) asm volatile("" : "+v"(c.lofs), "+v"(c.zt), "+v"(x))
template <bool NEED_R> RK_DI void build_tilde(Ctx& c, Tilde& T) {
    const int r = c.r, h = c.h;
    stage_slice(c, 0, RW_WD + c.dir * 64); stage_slice(c, 1, RW_K + c.hd * 64); stage_slice(c, 2, RW_AD + c.dir * 64); if constexpr (NEED_R) stage_slice(c, 3, RW_R + c.hd * 64);
    RK_WAIT_DMA();
    bf16x8 lwp[2][2];
    bf16x8 dq0[2][3], dq1[2][3]; dpre(c, RW_WD + c.dir * 64, dq0);
    {   bf16x8 twp[2][2];
#pragma unroll
        for (int Ii = 0; Ii < 2; ++Ii) { if (Ii == 0) dpre(c, RW_WD + c.dir * 64 + 32, dq1); else dpre(c, RW_K + c.hd * 64, dq0);
            f32x16 t = load_o2p(c, 0, Ii, Ii == 0 ? dq0 : dq1);
#pragma unroll
            for (int reg = 0; reg < 16; ++reg) t[reg] = tanh_f(t[reg]);
            twp[Ii][0] = pack<0>(t); twp[Ii][1] = pack<1>(t); RK_STAGE(twp[Ii][1]); }
#pragma unroll
        for (int J = 0; J < 2; ++J) { f32x16 wl = f32x16{}; bf16x8 wf[2][2];
#pragma unroll
            for (int Ii = 0; Ii < 2; ++Ii)
#pragma unroll
                for (int S = 0; S < 2; ++S) wf[Ii][S] = *(const bf16x8*)(C_W2P(c) + ((Ii * 2 + J) * 2 + S) * 512 + c.lofs);
            asm volatile("" : "+v"(wf[0][0]), "+v"(wf[0][1]), "+v"(wf[1][0]), "+v"(wf[1][1]));
#pragma unroll
            for (int Ii = 0; Ii < 2; ++Ii)
#pragma unroll
                for (int S = 0; S < 2; ++S) wl = RK_MF(twp[Ii][S], wf[Ii][S], wl);
            const float w0 = inp(I_W0)[c.dofs + 32 * J + r]; float gs = 0.f;
#pragma unroll
            for (int reg = 0; reg < 16; ++reg) wl[reg] = -0.6065306597126334f * sigm(wl[reg] + w0);
            lwp[J][0] = pack<0>(wl); lwp[J][1] = pack<1>(wl);
            { float q[8]; unpack8(lwp[J][0], q);
#pragma unroll
              for (int e = 0; e < 8; ++e) gs += q[e]; unpack8(lwp[J][1], q);
#pragma unroll
              for (int e = 0; e < 8; ++e) gs += q[e]; }
            gs += __shfl_xor(gs, 32); T.gtot[J] = gs; RK_STAGE(lwp[J][1]); } }
    RK_WAIT_LDS(); stage_slice(c, 0, RW_V + c.hd * 64);
    float rinv; f32x16 ktk[2];
    {   float ss = 0.f;
#pragma unroll
        for (int Ik = 0; Ik < 2; ++Ik) { if (Ik == 0) dpre(c, RW_K + c.hd * 64 + 32, dq1);
            const f32x16 kt = load_o2p(c, 1, Ik, Ik == 0 ? dq0 : dq1); ktk[Ik] = kt;
f32x4 kk_v[4]; { const float* pv_ = inp(I_KK) + c.cofs + 32 * Ik + 4 * h;
  _Pragma("unroll") for (int g = 0; g < 4; ++g) kk_v[g] = *(const f32x4*)(pv_ + 8 * g); }
#pragma unroll
            for (int g = 0; g < 4; ++g) { const f32x4 kk = kk_v[g];
#pragma unroll
                for (int j = 0; j < 4; ++j) { const float q = kt[4 * g + j] * kk[j]; ss += q * q; } }
            RK_STAGE(ss); }
        ss += __shfl_xor(ss, 32); rinv = 1.f / fmaxf(sqrtf(ss), 1e-12f); RK_STAGE(rinv); }
    float bon = 0.f;
#pragma unroll
    for (int Ik = 0; Ik < 2; ++Ik) {
        f32x16 em, ep;
f32x4 kk_v[4]; { const float* pv_ = inp(I_KK) + c.cofs + 32 * Ik + 4 * h;
  _Pragma("unroll") for (int g = 0; g < 4; ++g) kk_v[g] = *(const f32x4*)(pv_ + 8 * g); }
        __builtin_amdgcn_sched_barrier(0);
        { em = RK_MF(lwp[Ik][0], incp<0, false>(r, h, c.flip), f32x16{}); em = RK_MF(lwp[Ik][1], incp<1, false>(r, h, c.flip), em);
          ep = RK_MF(lwp[Ik][0], incp<0, true>(r, h, c.flip), f32x16{}); ep = RK_MF(lwp[Ik][1], incp<1, true>(r, h, c.flip), ep);
#pragma unroll
          for (int reg = 0; reg < 16; ++reg) { em[reg] = __expf(-em[reg]); ep[reg] = __expf(ep[reg]); } }
        RK_STAGE(ep);
        f32x16 kt = ktk[Ik]; f32x16 kn;
#pragma unroll
        for (int g = 0; g < 4; ++g) { const f32x4 kk = kk_v[g];
#pragma unroll
            for (int j = 0; j < 4; ++j) { const int reg = 4 * g + j; kn[reg] = kt[reg] * kk[j] * rinv; ep[reg] = -kn[reg] * ep[reg]; } }
        T.At[Ik][0] = pack<0>(ep); T.At[Ik][1] = pack<1>(ep);
        RK_STAGE(T.At[Ik][1]);
f32x4 a0_v[4]; { const float* pv_ = inp(I_A0) + c.dofs + 32 * Ik + 4 * h;
  _Pragma("unroll") for (int g = 0; g < 4; ++g) a0_v[g] = *(const f32x4*)(pv_ + 8 * g); }
        __builtin_amdgcn_sched_barrier(0);
        f32x16 as = f32x16{};
        bf16x8 af[4];
#pragma unroll
        for (int sp = 0; sp < 4; ++sp) af[sp] = *(const bf16x8*)(C_A2B(c) + (32 * Ik + r) * 64 + 16 * sp + 8 * h);
#pragma unroll
        for (int w = 0; w < 3; ++w) { bf16x8 an[4];
#pragma unroll
            for (int sp = 0; sp < 4; ++sp) an[sp] = af[sp];
            if (w < 2) {
#pragma unroll
                for (int sp = 0; sp < 4; ++sp) an[sp] = *(const bf16x8*)(C_A2B(c) + (w + 1) * 4096 + (32 * Ik + r) * 64 + 16 * sp + 8 * h); }
            __builtin_amdgcn_sched_barrier(0);
            asm volatile("" : "+v"(af[0]), "+v"(af[1]), "+v"(af[2]), "+v"(af[3]));
#pragma unroll
            for (int sp = 0; sp < 4; ++sp) as = RK_MF(af[sp], rawfrag(c, 2, 2 * sp + h, w), as);
            RK_STAGE(as);
#pragma unroll
            for (int sp = 0; sp < 4; ++sp) af[sp] = an[sp]; }
f32x4 ka_v[4]; { const float* pv_ = inp(I_KA) + c.cofs + 32 * Ik + 4 * h;
  _Pragma("unroll") for (int g = 0; g < 4; ++g) ka_v[g] = *(const f32x4*)(pv_ + 8 * g); }
        __builtin_amdgcn_sched_barrier(0);
#pragma unroll
        for (int g = 0; g < 4; ++g) { const f32x4 a0 = a0_v[g];
#pragma unroll
            for (int j = 0; j < 4; ++j) { const int reg = 4 * g + j; as[reg] = sigm(as[reg] + a0[j]); kn[reg] = kn[reg] * as[reg] * em[reg]; } }
        T.Bt[Ik][0] = pack<0>(kn); T.Bt[Ik][1] = pack<1>(kn);
        RK_STAGE(T.Bt[Ik][1]);
        f32x4 rk_v[4]; if constexpr (NEED_R) { const float* pv_ = inp(I_RK) + c.cofs + 32 * Ik + 4 * h;
  _Pragma("unroll") for (int g = 0; g < 4; ++g) rk_v[g] = *(const f32x4*)(pv_ + 8 * g); }
        __builtin_amdgcn_sched_barrier(0);
#pragma unroll
        for (int g = 0; g < 4; ++g) { const f32x4 ka = ka_v[g];
#pragma unroll
            for (int j = 0; j < 4; ++j) { const int reg = 4 * g + j; kt[reg] = kt[reg] * (1.f + (as[reg] - 1.f) * ka[j]); as[reg] = kt[reg] * em[reg]; } }
        T.Kt[Ik][0] = pack<0>(as); T.Kt[Ik][1] = pack<1>(as);
        RK_STAGE(T.Kt[Ik][1]);
        if constexpr (NEED_R) {
            f32x16 rt = load_o2(c, 3, Ik, RW_R + c.hd * 64 + 32 * Ik);
#pragma unroll
            for (int g = 0; g < 4; ++g) { const f32x4 rk = rk_v[g];
#pragma unroll
                for (int j = 0; j < 4; ++j) { const int reg = 4 * g + j; bon += rt[reg] * kt[reg] * rk[j]; rt[reg] = rt[reg] * __builtin_amdgcn_rcpf(em[reg]); } }
            T.Rt[Ik][0] = pack<0>(rt); T.Rt[Ik][1] = pack<1>(rt); RK_STAGE(T.Rt[Ik][1]); }
    }
    T.bon = bon;
    RK_WAIT_DMA();
    dpre(c, RW_V + c.hd * 64, dq0);
#pragma unroll
    for (int J = 0; J < 2; ++J) { if (J == 0) dpre(c, RW_V + c.hd * 64 + 32, dq1);
        const f32x16 va = load_o1p(c, 0, J, J == 0 ? dq0 : dq1); T.Vp[J][0] = pack<0>(va); T.Vp[J][1] = pack<1>(va); RK_STAGE(T.Vp[J][1]); }
}
RK_DI void grams_la(const Ctx& c, const Tilde& T, bf16x8 (&Lk)[2], bf16x8 (&Mp)[2]) {
    f32x16 g = f32x16{}, m = f32x16{};
#pragma unroll
    for (int Ik = 0; Ik < 2; ++Ik)
#pragma unroll
        for (int S = 0; S < 2; ++S) { g = RK_MF(T.Kt[Ik][S], T.At[Ik][S], g); m = RK_MF(T.Bt[Ik][S], T.At[Ik][S], m); }
    tmask<true>(g, c.r, c.h, c.flip); tmask<true>(m, c.r, c.h, c.flip);
    Lk[0] = pack<0>(g); Lk[1] = pack<1>(g); Mp[0] = pack<0>(m); Mp[1] = pack<1>(m);
}
}

namespace rk {
constexpr int NSUB = RPB / 32;
RK_DI int chain_unit(int dir, int j) { return dir == 0 ? j : (j < 8 ? 7 - j : 143 - j); }
RK_DI int chain_pos(int dir, int c) { return dir == 0 ? c : (c < 8 ? 7 - c : 143 - c); }
RK_DI void setup_ctx(Ctx& c, unsigned char* ws, LAS unsigned char* sb, int l, int bl, int hd, int dir, int c32, int lane) {
    c.ws = ws; c.sb = sb; c.m0 = bl * RPB + 32 * c32; c.r = lane & 31; c.h = lane >> 5; c.hd = hd; c.dir = dir; c.l = l; c.flip = dir;
    c.cofs = l * 512 + hd * 64; c.dofs = (l * 2 + dir) * 512 + hd * 64;
    const int m = c.m0 + c.r, sg = m % RPB;
    c.mp = (sg != 0 && sg != CTX) ? 0xffffffffu : 0u; c.mn = (sg != CTX - 1 && sg != RPB - 1) ? 0xffffffffu : 0u;
    c.rowc = m; c.rowp = m > 0 ? m - 1 : 0; c.rown = m < HM - 1 ? m + 1 : HM - 1; c.lofs = (c.r + 32 * c.h) * 8; asm volatile("v_mov_b32 %0, 0" : "=v"(c.zt));
}
RK_DI void pass1_unit(unsigned char* ws, LAS unsigned char* sb, int l, int u, int lane) {
    const int q = u / NSUB, c32 = u % NSUB, bl = q >> 4, hd = (q >> 1) & 7, dir = q & 1;
    Ctx c; setup_ctx(c, ws, sb, l, bl, hd, dir, c32, lane);
    Tilde T; build_tilde<false>(c, T); __builtin_amdgcn_sched_barrier(0);
    const int r = c.r, h = c.h;
    bf16x8 Lk[2], Mp[2]; grams_la(c, T, Lk, Mp); __builtin_amdgcn_sched_barrier(0);
    const bf16x8 P0 = idp<0>(r, h), P1 = idp<1>(r, h);
    bf16x8 W1p[2][2], W2p[2][2], Bop[2][2], Kop[2][2];
#pragma unroll
    for (int J = 0; J < 2; ++J) {
        f32x16 x = RK_MF(T.At[J][0], P0, f32x16{}); x = RK_MF(T.At[J][1], P1, x);
        f32x16 y = RK_MF(Lk[0], T.Vp[J][0], f32x16{}); y = RK_MF(Lk[1], T.Vp[J][1], y);
        if (c.flip) solve32p<1>(x, y, Mp); else solve32p<0>(x, y, Mp);
        W1p[J][0] = pack<0>(x); W1p[J][1] = pack<1>(x);
        W2p[J][0] = pack<0>(y); W2p[J][1] = pack<1>(y);
        const float gcj = __expf(T.gtot[J]);
        f32x16 b = RK_MF(T.Bt[J][0], P0, f32x16{}); b = RK_MF(T.Bt[J][1], P1, b);
        f32x16 k = RK_MF(T.Kt[J][0], P0, f32x16{}); k = RK_MF(T.Kt[J][1], P1, k);
#pragma unroll
        for (int reg = 0; reg < 16; ++reg) { b[reg] *= gcj; k[reg] *= gcj; }
        Bop[J][0] = pack<0>(b); Bop[J][1] = pack<1>(b); Kop[J][0] = pack<0>(k); Kop[J][1] = pack<1>(k);
    }
    u32x4* phi = (u32x4*)(ws + WS_HALF + H_PHI) + (size_t)u * 512 + lane;
    u32x4* psi = (u32x4*)(ws + WS_HALF + H_PSI) + (size_t)u * 512 + lane;
#pragma unroll
    for (int I = 0; I < 2; ++I)
#pragma unroll
        for (int J = 0; J < 2; ++J) {
            f32x16 a = RK_MF(W1p[I][0], Bop[J][0], f32x16{}); a = RK_MF(W1p[I][1], Bop[J][1], a);
            if (I == J) {
#pragma unroll
                for (int reg = 0; reg < 16; ++reg) a[reg] += (crow(reg, h) == r) ? __expf(T.gtot[J]) : 0.f; }
            phi[((I * 2 + J) * 2 + 0) * 64] = __builtin_bit_cast(u32x4, pack<0>(a)); phi[((I * 2 + J) * 2 + 1) * 64] = __builtin_bit_cast(u32x4, pack<1>(a));
            f32x16 p = RK_MF(Bop[I][0], W2p[J][0], f32x16{}); p = RK_MF(Bop[I][1], W2p[J][1], p); p = RK_MF(Kop[I][0], T.Vp[J][0], p); p = RK_MF(Kop[I][1], T.Vp[J][1], p);
            psi[((I * 2 + J) * 2 + 0) * 64] = (u32x4){cvt2(p[0], p[1]), cvt2(p[2], p[3]), cvt2(p[4], p[5]), cvt2(p[6], p[7])};
            psi[((I * 2 + J) * 2 + 1) * 64] = (u32x4){cvt2(p[8], p[9]), cvt2(p[10], p[11]), cvt2(p[12], p[13]), cvt2(p[14], p[15])};
        }
}
RK_DI void pass2_chain(unsigned char* ws, int q, int lane, bool do_store) {
    const int dir = q & 1;
    f32x16 H[2][2] = {{f32x16{}, f32x16{}}, {f32x16{}, f32x16{}}};
    u32x4 phi[8], psi[8];
    { const int u0 = q * NSUB + chain_unit(dir, 0);
      const u32x4* ph = (const u32x4*)(ws + WS_HALF + H_PHI) + (size_t)u0 * 512 + lane; const u32x4* ps = (const u32x4*)(ws + WS_HALF + H_PSI) + (size_t)u0 * 512 + lane;
#pragma unroll
      for (int f = 0; f < 8; ++f) { phi[f] = ph[f * 64]; psi[f] = ps[f * 64]; } }
    int uprev = q * NSUB + chain_unit(dir, 0);
#pragma unroll 1
    for (int j = 0; j < NSUB - 1; ++j) {
        const int un = q * NSUB + chain_unit(dir, j + 1 < NSUB - 1 ? j + 1 : j);
        u32x4 nphi[8], npsi[8];
        { const u32x4* ph = (const u32x4*)(ws + WS_HALF + H_PHI) + (size_t)un * 512 + lane; const u32x4* ps = (const u32x4*)(ws + WS_HALF + H_PSI) + (size_t)un * 512 + lane;
#pragma unroll
          for (int f = 0; f < 8; ++f) { nphi[f] = ph[f * 64]; npsi[f] = ps[f * 64]; } }
        bf16x8 Hp[2][2][2];
#pragma unroll
        for (int I = 0; I < 2; ++I)
#pragma unroll
            for (int J = 0; J < 2; ++J) { Hp[I][J][0] = pack<0>(H[I][J]); Hp[I][J][1] = pack<1>(H[I][J]); }
#pragma unroll
        for (int Ik = 0; Ik < 2; ++Ik)
#pragma unroll
            for (int Jv = 0; Jv < 2; ++Jv) {
                f32x16 a; const u32x4 p0 = psi[(Ik * 2 + Jv) * 2], p1 = psi[(Ik * 2 + Jv) * 2 + 1];
                a[0] = lo16(p0.x); a[1] = hi16(p0.x); a[2] = lo16(p0.y); a[3] = hi16(p0.y); a[4] = lo16(p0.z); a[5] = hi16(p0.z); a[6] = lo16(p0.w); a[7] = hi16(p0.w);
                a[8] = lo16(p1.x); a[9] = hi16(p1.x); a[10] = lo16(p1.y); a[11] = hi16(p1.y); a[12] = lo16(p1.z); a[13] = hi16(p1.z); a[14] = lo16(p1.w); a[15] = hi16(p1.w);
#pragma unroll
                for (int Ip = 0; Ip < 2; ++Ip) { a = RK_MF(__builtin_bit_cast(bf16x8, phi[(Ip * 2 + Ik) * 2 + 0]), Hp[Ip][Jv][0], a); a = RK_MF(__builtin_bit_cast(bf16x8, phi[(Ip * 2 + Ik) * 2 + 1]), Hp[Ip][Jv][1], a); }
                H[Ik][Jv] = a; }
        if (do_store) { u32x4* st = (u32x4*)(ws + WS_HALF + H_PSI) + (size_t)uprev * 512 + lane;
#pragma unroll
            for (int I = 0; I < 2; ++I)
#pragma unroll
                for (int J = 0; J < 2; ++J) { st[((I * 2 + J) * 2 + 0) * 64] = __builtin_bit_cast(u32x4, pack<0>(H[I][J])); st[((I * 2 + J) * 2 + 1) * 64] = __builtin_bit_cast(u32x4, pack<1>(H[I][J])); } }
        uprev = un;
#pragma unroll
        for (int f = 0; f < 8; ++f) { phi[f] = nphi[f]; psi[f] = npsi[f]; }
    }
    if (!do_store) { float chk = 0.f;
#pragma unroll
        for (int I = 0; I < 2; ++I)
#pragma unroll
            for (int J = 0; J < 2; ++J)
#pragma unroll
                for (int reg = 0; reg < 16; ++reg) chk += H[I][J][reg];
        if (chk == 123456.789f) ((float*)(ws + WS_END))[lane] = chk; }
}
RK_DI void pass2_half(unsigned char* ws, int q, int jv, int lane) {
    static_assert((NSUB - 1) % 3 == 0, "three-step rotation");
    const int dir = q & 1;
    bf16x8 Hp[2][2] = {{bf16x8{}, bf16x8{}}, {bf16x8{}, bf16x8{}}};
#define P2_LD(jj, PH, PS) do { const int jc_ = (jj) < NSUB - 1 ? (jj) : NSUB - 2; const int un_ = q * NSUB + chain_unit(dir, jc_); \
        const u32x4* ph_ = (const u32x4*)(ws + WS_HALF + H_PHI) + (size_t)un_ * 512 + lane; const u32x4* ps_ = (const u32x4*)(ws + WS_HALF + H_PSI) + (size_t)un_ * 512 + jv * 128 + lane; \
        _Pragma("unroll") for (int f = 0; f < 8; ++f) PH[f] = ph_[f * 64]; \
        PS[0] = ps_[0]; PS[1] = ps_[64]; PS[2] = ps_[256]; PS[3] = ps_[320]; } while (0)
#define P2_UNPK(A, p0, p1) do { A[0] = lo16(p0.x); A[1] = hi16(p0.x); A[2] = lo16(p0.y); A[3] = hi16(p0.y); A[4] = lo16(p0.z); A[5] = hi16(p0.z); A[6] = lo16(p0.w); A[7] = hi16(p0.w); \
        A[8] = lo16(p1.x); A[9] = hi16(p1.x); A[10] = lo16(p1.y); A[11] = hi16(p1.y); A[12] = lo16(p1.z); A[13] = hi16(p1.z); A[14] = lo16(p1.w); A[15] = hi16(p1.w); } while (0)
#define P2_STEP(jj, PH, PS) do { f32x16 a0, a1; P2_UNPK(a0, PS[0], PS[1]); P2_UNPK(a1, PS[2], PS[3]); \
        _Pragma("unroll") for (int Ip = 0; Ip < 2; ++Ip) { \
            a0 = RK_MF(__builtin_bit_cast(bf16x8, PH[(Ip * 2 + 0) * 2 + 0]), Hp[Ip][0], a0); a1 = RK_MF(__builtin_bit_cast(bf16x8, PH[(Ip * 2 + 1) * 2 + 0]), Hp[Ip][0], a1); \
            a0 = RK_MF(__builtin_bit_cast(bf16x8, PH[(Ip * 2 + 0) * 2 + 1]), Hp[Ip][1], a0); a1 = RK_MF(__builtin_bit_cast(bf16x8, PH[(Ip * 2 + 1) * 2 + 1]), Hp[Ip][1], a1); } \
        Hp[0][0] = pack<0>(a0); Hp[0][1] = pack<1>(a0); Hp[1][0] = pack<0>(a1); Hp[1][1] = pack<1>(a1); \
        u32x4* st_ = (u32x4*)(ws + WS_HALF + H_PSI) + (size_t)(q * NSUB + chain_unit(dir, (jj))) * 512 + jv * 128 + lane;        \
        st_[0] = __builtin_bit_cast(u32x4, Hp[0][0]); st_[64] = __builtin_bit_cast(u32x4, Hp[0][1]); st_[256] = __builtin_bit_cast(u32x4, Hp[1][0]); st_[320] = __builtin_bit_cast(u32x4, Hp[1][1]); } while (0)
    u32x4 phA[8], psA[4], phB[8], psB[4], phC[8], psC[4];
    P2_LD(0, phA, psA); P2_LD(1, phB, psB);
#pragma unroll 1
    for (int j = 0; j < NSUB - 1; j += 3) {
        P2_LD(j + 2, phC, psC); P2_STEP(j, phA, psA);
        P2_LD(j + 3, phA, psA); P2_STEP(j + 1, phB, psB);
        P2_LD(j + 4, phB, psB); P2_STEP(j + 2, phC, psC);
    }
#undef P2_LD
#undef P2_UNPK
#undef P2_STEP
}
RK_DI void pass3_dir(const int DIR, unsigned char* ws, LAS unsigned char* sb, int l, int bl, int hd, int c32, int lane, f32x16 (&Y)[2], float& bons) {
    Ctx c; setup_ctx(c, ws, sb, l, bl, hd, DIR, c32, lane);
    const int r = c.r, h = c.h;
    Tilde T; build_tilde<true>(c, T); __builtin_amdgcn_sched_barrier(0);
    bons += T.bon + __shfl_xor(T.bon, 32);
    bf16x8 Lk[2], Mp[2]; grams_la(c, T, Lk, Mp); __builtin_amdgcn_sched_barrier(0);
    bf16x8 Ab[2], Ak[2];
    {   f32x16 gb = f32x16{}, gk = f32x16{};
#pragma unroll
        for (int Ik = 0; Ik < 2; ++Ik)
#pragma unroll
            for (int S = 0; S < 2; ++S) { gb = RK_MF(T.Bt[Ik][S], T.Rt[Ik][S], gb); gk = RK_MF(T.Kt[Ik][S], T.Rt[Ik][S], gk); }
        tmask<false>(gb, r, h, DIR); tmask<false>(gk, r, h, DIR);
        Ab[0] = pack<0>(gb); Ab[1] = pack<1>(gb); Ak[0] = pack<0>(gk); Ak[1] = pack<1>(gk); }
    RK_STAGE(Ak[1]);
    bf16x8 H0p[2][2][2];
    { const int q = (bl * 8 + hd) * 2 + DIR, j = chain_pos(DIR, c32);
      if (j > 0) { const u32x4* st = (const u32x4*)(ws + WS_HALF + H_PSI) + (size_t)(q * NSUB + chain_unit(DIR, j - 1)) * 512 + lane;
#pragma unroll
          for (int I = 0; I < 2; ++I)
#pragma unroll
              for (int J = 0; J < 2; ++J) { H0p[I][J][0] = __builtin_bit_cast(bf16x8, st[((I * 2 + J) * 2 + 0) * 64]); H0p[I][J][1] = __builtin_bit_cast(bf16x8, st[((I * 2 + J) * 2 + 1) * 64]); } }
      else {
#pragma unroll
          for (int I = 0; I < 2; ++I)
#pragma unroll
              for (int J = 0; J < 2; ++J) { H0p[I][J][0] = bf16x8{}; H0p[I][J][1] = bf16x8{}; } } }
    bf16x8 Up[2][2];
    {   f32x16 xs[2];
#pragma unroll
        for (int Jv = 0; Jv < 2; ++Jv) {
            f32x16 x = RK_MF(Lk[0], T.Vp[Jv][0], f32x16{}); x = RK_MF(Lk[1], T.Vp[Jv][1], x);
#pragma unroll
            for (int Ik = 0; Ik < 2; ++Ik) { x = RK_MF(T.At[Ik][0], H0p[Ik][Jv][0], x); x = RK_MF(T.At[Ik][1], H0p[Ik][Jv][1], x); }
            xs[Jv] = x; }
        if (DIR) solve32p<1>(xs[0], xs[1], Mp); else solve32p<0>(xs[0], xs[1], Mp);
#pragma unroll
        for (int Jv = 0; Jv < 2; ++Jv) { Up[Jv][0] = pack<0>(xs[Jv]); Up[Jv][1] = pack<1>(xs[Jv]); }
        __builtin_amdgcn_sched_barrier(0); }
    __builtin_amdgcn_sched_barrier(0);
#pragma unroll
    for (int Iv = 0; Iv < 2; ++Iv) {
        f32x16 y = f32x16{};
#pragma unroll
        for (int Ik = 0; Ik < 2; ++Ik) { y = RK_MF(H0p[Ik][Iv][0], T.Rt[Ik][0], y); y = RK_MF(H0p[Ik][Iv][1], T.Rt[Ik][1], y); }
        y = RK_MF(Up[Iv][0], Ab[0], y); y = RK_MF(Up[Iv][1], Ab[1], y); y = RK_MF(T.Vp[Iv][0], Ak[0], y); y = RK_MF(T.Vp[Iv][1], Ak[1], y);
        Y[Iv] = y; }
}
RK_DI void pass3_unit(unsigned char* ws, LAS unsigned char* sb, int l, int v3, int lane, unsigned* ypark) {
    const int c32 = v3 % NSUB, bh = v3 / NSUB, bl = bh >> 3, hd = bh & 7, r = lane & 31, h = lane >> 5;
    float bons = 0.f;
    LAS float* ylds = (LAS float*)(sb + SBUF);
#pragma unroll 1
    for (int dir = 0; dir < 2; ++dir) {
        int lane_ = lane; asm volatile("" : "+v"(lane_));
        f32x16 Y[2]; pass3_dir(dir, ws, sb, l, bl, hd, c32, lane_, Y, bons);
        if (dir == 0) {
#pragma unroll
            for (int Iv = 0; Iv < 2; ++Iv)
#pragma unroll
                for (int d = 0; d < 8; ++d) ypark[(Iv * 8 + d) * 64 + lane] = cvt2(Y[Iv][2 * d], Y[Iv][2 * d + 1]); }
        else {
#pragma unroll
            for (int Iv = 0; Iv < 2; ++Iv)
#pragma unroll
                for (int reg = 0; reg < 16; ++reg) ylds[(Iv * 16 + reg) * 64 + lane] = Y[Iv][reg]; }
        __builtin_amdgcn_sched_barrier(0); }
    f32x16 YT[2];
#pragma unroll
    for (int Iv = 0; Iv < 2; ++Iv)
#pragma unroll
        for (int d = 0; d < 8; ++d) { const unsigned w = ypark[(Iv * 8 + d) * 64 + lane]; YT[Iv][2 * d] = ylds[(Iv * 16 + 2 * d) * 64 + lane] + lo16(w); YT[Iv][2 * d + 1] = ylds[(Iv * 16 + 2 * d + 1) * 64 + lane] + hi16(w); }
    Ctx c; setup_ctx(c, ws, sb, l, bl, hd, 0, c32, lane);
    RK_WAIT_LDS(); stage_slice(c, 1, RW_GD); stage_slice(c, 2, RW_GD + 64); RK_WAIT_DMA();
    float sm = 0.f;
#pragma unroll
    for (int Iv = 0; Iv < 2; ++Iv)
#pragma unroll
        for (int reg = 0; reg < 16; ++reg) sm += YT[Iv][reg];
    sm += __shfl_xor(sm, 32); const float mean = sm * (1.f / 64.f); float vq = 0.f;
#pragma unroll
    for (int Iv = 0; Iv < 2; ++Iv)
#pragma unroll
        for (int reg = 0; reg < 16; ++reg) { YT[Iv][reg] -= mean; vq += YT[Iv][reg] * YT[Iv][reg]; }
    vq += __shfl_xor(vq, 32); const float rstd = 1.f / sqrtf(vq * (1.f / 64.f) + LNX_EPS);
    const bf16* g2P = (const bf16*)(ws + WS_TAB + 524288) + (size_t)hd * 8192;
    const float* lnw = inp(I_LNW) + l * 512 + hd * 64; const float* lnb = inp(I_LNB) + l * 512 + hd * 64;
    bf16x8 sgp[4][2];
#pragma unroll
    for (int Ii = 0; Ii < 4; ++Ii) { f32x16 t = load_o2(c, 1 + (Ii >> 1), Ii & 1, RW_GD + 32 * Ii);
#pragma unroll
        for (int reg = 0; reg < 16; ++reg) t[reg] = sigm(t[reg]);
        sgp[Ii][0] = pack<0>(t); sgp[Ii][1] = pack<1>(t); __builtin_amdgcn_sched_barrier(0); }
    RK_WAIT_LDS(); LAS unsigned char* st = c.sb + SBUF;
#pragma unroll
    for (int Iv = 0; Iv < 2; ++Iv) {
        f32x16 gt = f32x16{};
#pragma unroll
        for (int Ip = 0; Ip < 2; ++Ip) { bf16x8 gf[2][2];
#pragma unroll
            for (int Iq = 0; Iq < 2; ++Iq)
#pragma unroll
                for (int S = 0; S < 2; ++S) gf[Iq][S] = *(const bf16x8*)(g2P + (((2 * Ip + Iq) * 2 + Iv) * 2 + S) * 512 + c.lofs);
            asm volatile("" : "+v"(gf[0][0]), "+v"(gf[0][1]), "+v"(gf[1][0]), "+v"(gf[1][1]));
#pragma unroll
            for (int Iq = 0; Iq < 2; ++Iq)
#pragma unroll
                for (int S = 0; S < 2; ++S) gt = RK_MF(gf[Iq][S], sgp[2 * Ip + Iq][S], gt);
            RK_STAGE(gt); }
        const f32x16 vt = load_o2(c, 0, Iv, RW_V + hd * 64 + 32 * Iv);
        f32x4 lwv[4], lbv[4];
#pragma unroll
        for (int g = 0; g < 4; ++g) { const int v0 = 32 * Iv + 8 * g + 4 * h; lwv[g] = *(const f32x4*)(lnw + v0); lbv[g] = *(const f32x4*)(lnb + v0); }
        asm volatile("" : "+v"(lwv[0]), "+v"(lwv[1]), "+v"(lwv[2]), "+v"(lwv[3]), "+v"(lbv[0]), "+v"(lbv[1]), "+v"(lbv[2]), "+v"(lbv[3]));
#pragma unroll
        for (int g = 0; g < 4; ++g) { const int v0 = 32 * Iv + 8 * g + 4 * h; const f32x4 lw = lwv[g], lb = lbv[g]; float o[4];
#pragma unroll
            for (int j = 0; j < 4; ++j) { const int reg = 4 * g + j; o[j] = (YT[Iv][reg] * rstd * lw[j] + lb[j] + bons * vt[reg]) * gt[reg]; }
            *(LAS unsigned long long*)(st + r * 144 + 2 * v0) = (unsigned long long)cvt2(o[0], o[1]) | ((unsigned long long)cvt2(o[2], o[3]) << 32); }
    }
    asm volatile("s_waitcnt lgkmcnt(0)" ::: "memory");
    bf16* RO = (bf16*)(ws + WS_HALF + H_PP) + (size_t)c.m0 * PPW + C_QD + hd * 64;
#pragma unroll
    for (int i = 0; i < 4; ++i) { const int id = i * 64 + lane, row = id >> 3, ch = id & 7; const u32x4 v = *(const LAS u32x4*)(st + row * 144 + ch * 16); *(u32x4*)(RO + (size_t)row * PPW + ch * 8) = v; }
    asm volatile("s_waitcnt lgkmcnt(0)" ::: "memory");
}
}

__device__ __forceinline__ void ph_rwkv1(Frame& F, int l) {
    const int gw = F.bid * NWAVES + FWAVE(), NGW = F.G * NWAVES; LAS unsigned char* sb = F.lds + FWAVE() * (4 * rk::SBUF);
    const bool skew = NGW == 2048;
#pragma unroll 1
    for (int r = 0;; ++r) {
        int u = gw + r * NGW;
        if (skew && r == 2) u = (F.bid < 64 && FWAVE() < 4) ? 2 * NGW + F.bid * 4 + FWAVE() : NUNIT;
        if (u >= NUNIT) break;
        rk::pass1_unit(F.ws, sb, l, u, otid() & 63);
    }
    asm volatile("s_waitcnt vmcnt(0) lgkmcnt(0)" ::: "memory");
}
__device__ __forceinline__ void ph_rwkv3(Frame& F, int l, bool ctx_emit) {
    const int gw = F.bid * NWAVES + FWAVE(), NGW = F.G * NWAVES; LAS unsigned char* sb = F.lds + FWAVE() * (4 * rk::SBUF);
    {
        bf16* PP = (bf16*)(F.ws + WS_HALF + H_PP); const int lane = FLANE();
        for (int rr = gw; rr < 16 * 256; rr += NGW) { const int sidx = rr >> 8, row = rr & 255, xq = sidx >> 1, p = 2 * xq + 1, qb = 14 + (sidx & 1), bl = p >> 3, h = p & 7;
            const unsigned char* sp = F.ws + WS_SPLIT + (size_t)(sidx * 4) * SPLIT_BYTES;
            float ls[4], ov[4], mx = -1e30f;
#pragma unroll
            for (int i = 0; i < 4; ++i) { ls[i] = ((const float*)(sp + (size_t)i * SPLIT_BYTES + 32768))[row]; ov[i] = bf2f(((const bf16*)(sp + (size_t)i * SPLIT_BYTES))[row * 64 + lane]); }
            asm volatile("" : "+v"(ls[0]), "+v"(ls[1]), "+v"(ls[2]), "+v"(ls[3]), "+v"(ov[0]), "+v"(ov[1]), "+v"(ov[2]), "+v"(ov[3]));
#pragma unroll
            for (int i = 0; i < 4; ++i) mx = fmaxf(mx, ls[i]);
            float ws_ = 0.f, acc = 0.f;
#pragma unroll
            for (int i = 0; i < 4; ++i) { const float w = __builtin_amdgcn_exp2f(ls[i] - mx); ws_ += w; acc += w * ov[i]; }
            PP[(size_t)(bl * RPB + CTX + qb * 256 + row) * PPW + C_GQ + h * 64 + lane] = (bf16)f2bf(acc / ws_); } }
    unsigned* ypark = (unsigned*)(F.ws + WS_END) + (size_t)gw * 1024;
    const int per = ctx_emit ? rk::NSUB : rk::NSUB - 8, nun = 16 * per;
#pragma unroll 1
    for (int r = 0;; ++r) {
        int j = gw + r * NGW;
        if (r == 1 && NGW == 2048) j = (F.bid < P3X_WGS && FWAVE() < 4) ? NGW + F.bid * 4 + FWAVE() : nun;
        if (j >= nun) break;
        const int v3 = (j / per) * rk::NSUB + (rk::NSUB - per) + j % per; rk::pass3_unit(F.ws, sb, l, v3, otid() & 63, ypark); }
    asm volatile("s_waitcnt vmcnt(0) lgkmcnt(0)" ::: "memory");
}
__device__ __forceinline__ void ph_mixer(Frame& F, int l, int half, int rep) {
    const bool ctx_out = (l == 0);
#ifdef EXTRA_P2
    if (F.bid < 4 && rep == 0) rk::pass2_chain(F.ws, F.bid * 8 + FWAVE(), otid() & 63, false);
#endif
    if (F.bid < 16 && rep == 0 && FWAVE() < 4) { const int ch = F.bid * 4 + FWAVE(); rk::pass2_half(F.ws, ch >> 1, ch & 1, otid() & 63); }
    __syncthreads();
    unsigned* ctr0 = F.ctl + CW_ATT + ((l * 2 + half) * 2 + rep) * 8 * 64;
    LAS unsigned* slot = (LAS unsigned*)(F.lds + MISC_OFF);
    const bf16* PP = (const bf16*)(F.ws + WS_HALF + H_PP); const bf16* QM = (const bf16*)(F.ws + WS_HALF + H_QM); const bf16* KVM = (const bf16*)(F.ws + WS_HALF + H_KVM);
    bf16* MO = (bf16*)(F.ws + WS_HALF + H_MO); bf16* DUM = (bf16*)(F.ws + WS_END);
    const int nper = ctx_out ? 74 : 70;
    int xk = 0;
    for (;;) {
        const int xq = (F.bid + xk) & 7;
        if (FTID() == 0) slot[0] = atomicAdd(ctr0 + xq * 64, 1u);
        __syncthreads();
        const int v = (int)slot[0];
        __syncthreads();
        if (v >= nper) { if (++xk == 8) break; continue; }
        int type, bl, h, qb, nkeys, qrow0, part = -1, sidx = 0; const bool lat_u = v < 70;
        { int p; if (v < 62) { type = v >> 5; p = 2 * xq + ((v >> 4) & 1); qb = v & 15; nkeys = RPB; }
          else if (lat_u) { const int w = v - 62; type = 1; p = 2 * xq + 1; qb = 14 + (w >> 2); part = w & 3; sidx = xq * 2 + (w >> 2); nkeys = RPB; }
          else { const int w = v - 70; type = w >> 1; p = 2 * xq + (w & 1); qb = 0; nkeys = CTX; }
          bl = p >> 3; h = p & 7; qrow0 = lat_u ? bl * RPB + CTX + qb * 256 : bl * RPB; }
        const int krow0 = bl * RPB;
        att::Args a;
        if (type == 0) {
            a.Q = QM + (size_t)qrow0 * 768 + h * 96; a.ldq = 768; a.K0 = KVM + (size_t)krow0 * KVP + h * 128; a.ldk0 = KVP; a.K1 = PP + (size_t)krow0 * PPW + C_KR; a.ldk1 = PPW;
            a.V = KVM + (size_t)krow0 * KVP + h * 128 + 64; a.ldv = KVP; a.O = (rep ? DUM : MO) + (size_t)qrow0 * 512 + h * 64; a.ldo = 512; a.nkeys = nkeys;
            a.rope_t0 = lat_u ? qb * 256 : -1; a.tc = (const float*)(F.ws + WS_T8C); a.ts = (const float*)(F.ws + WS_T8S);
            at96::Args b; b.Q = a.Q; b.ldq = a.ldq; b.K0 = a.K0; b.ldk0 = a.ldk0; b.K1 = a.K1; b.ldk1 = a.ldk1; b.V = a.V; b.ldv = a.ldv; b.O = a.O; b.ldo = a.ldo; b.nkeys = a.nkeys;
            b.rope_t0 = a.rope_t0; b.tc = a.tc; b.ts = a.ts;
            at96::unit(b, (char*)F.ldsg);
        } else {
            const int kvh = h >> 2;
            a.Q = PP + (size_t)qrow0 * PPW + C_GQ + h * 64; a.ldq = PPW; a.K0 = PP + (size_t)krow0 * PPW + C_GK + kvh * 64; a.ldk0 = PPW; a.K1 = a.K0; a.ldk1 = PPW;
            a.V = PP + (size_t)krow0 * PPW + C_GV + kvh * 64; a.ldv = PPW; a.O = rep ? DUM + (size_t)qrow0 * 512 + h * 64 : (bf16*)PP + (size_t)qrow0 * PPW + C_GQ + h * 64; a.ldo = rep ? 512 : PPW; a.nkeys = nkeys; a.rope_t0 = -1; a.tc = nullptr; a.ts = nullptr;
            at64::Args b; b.Q = a.Q; b.ldq = a.ldq; b.K = a.K0; b.ldk = a.ldk0; b.V = a.V; b.ldv = a.ldv; b.O = a.O; b.ldo = a.ldo; b.nkeys = a.nkeys; b.lse = nullptr;
            if (part >= 0) { const int k0 = (part < 2) ? part * 1152 : 2304 + (part - 2) * 1024; b.nkeys = (part < 2) ? 1152 : 1024;
                b.K = a.K0 + (size_t)k0 * a.ldk0; b.V = a.V + (size_t)k0 * a.ldv;
                unsigned char* sp = F.ws + WS_SPLIT + (size_t)(sidx * 4 + part) * SPLIT_BYTES; b.O = (bf16*)sp; b.ldo = 64; b.lse = (float*)(sp + 32768); }
            at64::unit(b, (char*)F.ldsg);
        }
    }
}

enum { OP_W0 = 0, OP_NORM1, OP_INPROJ, OP_PREP, OP_MIXER, OP_FINISH, OP_GATE, OP_MERGE, OP_WOUT, OP_NORM2, OP_FFUP, OP_FFDOWN, OP_FINAL };
constexpr int N_PHASES = 36;
__global__ void __launch_bounds__(NWAVES * 64, 2) trunk_fwd(Args args) {
    extern __shared__ __attribute__((aligned(16))) unsigned char lds[];
    Frame F;
    F.lds = (LAS unsigned char*)lds; F.ldsg = lds;
    F.G = gridDim.x; F.bid = blockIdx.x; F.ws = args.ws; F.ctl = (unsigned*)(args.ws + WS_CTL); F.out = args.out;
    volatile LAS unsigned* MISC = (volatile LAS unsigned*)(F.lds + MISC_OFF);
    for (int u = threadIdx.x; u < 32; u += NWAVES * 64) MISC[u] = 0u;
    __syncthreads();
    const int lo = args.ph_lo, hi = args.ph_hi;
    XcdBarrier bar = xcd_barrier_post(F.ctl + CW_BAR, MISC + 8);
#ifdef EXTRA_OP
    for (int pp = 2 * lo; pp < 2 * hi; ++pp) { const int p = pp >> 1, rep = pp & 1;
#else
    for (int p = lo; p < hi; ++p) { const int rep = 0;
#endif
        GAS unsigned char* wsg_ = (GAS unsigned char*)args.ws; GAS float* outg_ = (GAS float*)args.out; int bid_ = blockIdx.x, G_ = gridDim.x;
        asm volatile("" : "+s"(wsg_), "+s"(outg_), "+s"(bid_), "+s"(G_));
        unsigned char* ws = (unsigned char*)wsg_; float* outp = (float*)outg_;
        F.ws = ws; F.out = outp; F.bid = bid_; F.G = G_; F.ctl = (unsigned*)(ws + WS_CTL);
        unsigned char* wt = ws + WS_WT; const bf16* XN = (const bf16*)(ws + WS_XN); bf16* ctxx = (bf16*)(ws + WS_CTXX); bf16* XB = (bf16*)outp;
        int op, l = 0, half = 0;
        if (p == 0) op = OP_W0; else if (p == N_PHASES - 1) op = OP_FINAL;
        else { const int q = p - 1, r = q % 17; l = q / 17; if (r == 0) op = OP_NORM1; else if (r <= 7) { half = 0; op = OP_INPROJ + (r - 1); } else if (r <= 13) { half = 1; op = OP_PREP + (r - 8); } else op = OP_NORM2 + (r - 14); }
#ifdef ONLY_OP
        op = ONLY_OP;
#endif
#ifdef EXTRA_OP
        if (rep && op != EXTRA_OP) continue;
#endif
        const void* xl = (l == 0) ? (const void*)inp(I_X) : (const void*)XB; const void* xc = (l == 0) ? (const void*)inp(I_CTX) : (const void*)ctxx; const int sbf = (l != 0);
        const bool ctx_out = (l == 0);
        const int nMf = ctx_out ? 68 : 64, nMh = ctx_out ? 34 : 32, skipf = ctx_out ? 0 : 1;
        switch (op) {
        case OP_W0: ph_weights(F, 0); break;
        case OP_NORM1: if (l == 1) ph_weights(F, 1); ph_norm(F, l, xl, xc, sbf != 0, inp(I_G1) + l * DM, 0, false, (l == 1) ? (const float*)(ws + WS_END) : nullptr); break;
#define RUN_INPROJ(hh) do { pg8::Gemm g_{XN + (size_t)(hh) * HM * DM, (const bf16*)(wt + WT_IN), DM, DM, DM}; pg8::TileOrder S_; S_.init(HM / 256, PPW / 256, F.G, F.bid, 0); \
            pg8::Epi<pg8::EPI_BF16> E_{}; E_.O = (bf16*)(ws + WS_HALF + H_PP); E_.ldc = PPW; pg8::gemm_phase<pg8::Epi<pg8::EPI_BF16>, pg8::TileOrder, true>(F.lds, g_, S_, E_); } while (0)
        case OP_INPROJ: RUN_INPROJ(half); break;
        case OP_PREP: {
            if (rep == 0) ph_prep(F, l, half); ph_rwkv1(F, l); __syncthreads();
            if (rep == 0) {
            const bool isq = F.bid >= 136; const int cQ = F.bid - 136;
            if (!isq || cQ < 102) {
                pg8::TileOrder S; if (isq) S.init(HM / 256, 3, F.G, cQ, 0); else S.init(HM / 256, 4, F.G, F.bid, 0);
                pg8::Unit u0; S.next(0, u0);
                LAS float* rsl = (LAS float*)(F.lds + 143360);
                {   const int ncol = isq ? 384 : 256, trow = FTID() >> 1, th = FTID() & 1, nch = ncol / 16;
                    const bf16* src = (const bf16*)(ws + WS_HALF + H_PP) + (size_t)(u0.pm * 256 + trow) * PPW + (isq ? C_QD : C_KVD) + th * (ncol / 2);
                    float sq = 0.f;
                    for (int c0 = 0; c0 < nch; c0 += 8) { v4u w[8];
#pragma unroll
                        for (int j = 0; j < 8; ++j) w[j] = *(const v4u*)(src + (c0 + j) * 8);
#pragma unroll
                        for (int j = 0; j < 8; ++j) { const float a0 = pg8::bf_lo(w[j].x), a1 = pg8::bf_hi(w[j].x), a2 = pg8::bf_lo(w[j].y), a3 = pg8::bf_hi(w[j].y), a4 = pg8::bf_lo(w[j].z), a5 = pg8::bf_hi(w[j].z), a6 = pg8::bf_lo(w[j].w), a7 = pg8::bf_hi(w[j].w);
                            sq += (a0 * a0 + a1 * a1) + (a2 * a2 + a3 * a3) + (a4 * a4 + a5 * a5) + (a6 * a6 + a7 * a7); } }
                    sq += __shfl_xor(sq, 1);
                    if (th == 0) rsl[trow] = (isq ? 0.10206207261596575f * 1.4426950408889634f : 1.f) / sqrtf(sq * (1.f / (float)ncol) + NORM_EPS); }
                __syncthreads();
                if (isq) { pg8::Gemm g{(const bf16*)(ws + WS_HALF + H_PP) + C_QD, (const bf16*)(wt + WT_QU), PPW, 384, 384};
                    pg8::Epi<pg8::EPI_ROWSCALE> E{}; E.O = (bf16*)(ws + WS_HALF + H_QM); E.ldc = 768; E.rsl = rsl;
                    pg8::gemm_phase<pg8::Epi<pg8::EPI_ROWSCALE>, pg8::TileOrder, true>(F.lds, g, S, E); }
                else { pg8::Gemm g{(const bf16*)(ws + WS_HALF + H_PP) + C_KVD, (const bf16*)(wt + WT_KVU), PPW, 256, 256};
                    pg8::Epi<pg8::EPI_ROWSCALE> E{}; E.O = (bf16*)(ws + WS_HALF + H_KVM); E.ldc = KVP; E.rsl = rsl;
                    pg8::gemm_phase<pg8::Epi<pg8::EPI_ROWSCALE>, pg8::TileOrder, true>(F.lds, g, S, E); } } }
            } break;
        case OP_MIXER: ph_mixer(F, l, half, rep); break;
        case OP_FINISH: ph_rwkv3(F, l, ctx_out); __syncthreads(); break;
        case OP_GATE: {
            const int gs = ctx_out ? P3X_WGS : 0;
            if (F.bid >= gs) { pg8::Gemm g{XN + (size_t)half * HM * DM, (const bf16*)(wt + WT_G), DM, DM, DM}; pg8::TileOrder S; S.init(nMh, ctx_out ? 12 : 8, F.G - gs, F.bid - gs, skipf);
                pg8::Epi<pg8::EPI_SIGMOID> E{}; E.O = (bf16*)(ws + WS_G0); E.O1 = (bf16*)(ws + WS_G1); E.O2 = (bf16*)(ws + WS_G2); E.ldc = DM;
                pg8::gemm_phase<pg8::Epi<pg8::EPI_SIGMOID>, pg8::TileOrder, true>(F.lds, g, S, E);
                if (!ctx_out) {
                    pg8::Gemm g2{XN + (size_t)half * HM * DM, (const bf16*)(wt + WT_G) + (size_t)2 * DM * DM, DM, DM, DM}; pg8::TileOrder S2; S2.init(nMh, 8, F.G, F.bid, skipf);
                    pg8::Epi<pg8::EPI_SIGMOID, true> E2{}; E2.O = (bf16*)(ws + WS_G2); E2.ldc = DM;
                    pg8::gemm_phase<pg8::Epi<pg8::EPI_SIGMOID, true>, pg8::TileOrder, true, true>(F.lds, g2, S2, E2); } } } break;
        case OP_MERGE: {
            {
                pg8::Gemm g{(const bf16*)(ws + WS_HALF + H_PP) + C_GQ, (const bf16*)(wt + WT_BR), PPW, 512, 512};
                pg8::BranchOrder S; S.dA1 = C_QD - C_GQ; S.dA2 = (long)((H_MO - H_PP) / 2) - C_GQ; S.dB = (long)DM * 512; S.lda0 = PPW; S.dlda = PPW - 512;
                if (ctx_out) { S.T.init(nMh, 4, F.G, F.bid, skipf);
                    pg8::Epi<pg8::EPI_GATEMUL> E{}; E.O = (bf16*)(ws + WS_MIX); E.ldc = DM; E.G = (const bf16*)(ws + WS_G0); E.ldg = DM; E.dG1 = (long)((WS_G1 - WS_G0) / 2); E.dG2 = (long)((WS_G2 - WS_G0) / 2); E.multi = 1; E.first = 0;
                    pg8::gemm_phase<pg8::Epi<pg8::EPI_GATEMUL>, pg8::BranchOrder, true>(F.lds, g, S, E); }
                else { S.T.init(nMh, 8, F.G, F.bid, skipf);
                    pg8::Epi<pg8::EPI_GATEMUL, true> E{}; E.O = (bf16*)(ws + WS_MIX); E.ldc = DM; E.G = (const bf16*)(ws + WS_G0); E.ldg = DM; E.dG1 = (long)((WS_G1 - WS_G0) / 2); E.dG2 = (long)((WS_G2 - WS_G0) / 2); E.multi = 1; E.first = 0;
                    pg8::gemm_phase<pg8::Epi<pg8::EPI_GATEMUL, true>, pg8::BranchOrder, true, true>(F.lds, g, S, E); } }
            } break;
        case OP_WOUT: {
            pg8::Gemm g{(const bf16*)(ws + WS_MIX), (const bf16*)(wt + WT_OUT), DM, DM, DM}; pg8::TileOrder S;
            if (ctx_out && half == 1) { S.init(nMh, 4, F.G, F.bid, skipf);
                pg8::Epi<pg8::EPI_RESID> E{}; E.xsl = xl; E.xsc = xc; E.sbf = sbf; E.xdl = XB; E.xdc = ctxx; E.gate = (const float*)(ws + WS_MOD) + (size_t)l * 5 * 6144 + 2048; E.pm_off = half * 34; E.part = nullptr; E.kslice = 1;
                pg8::gemm_phase<pg8::Epi<pg8::EPI_RESID>, pg8::TileOrder, true>(F.lds, g, S, E); }
            else { S.init(nMh, 8, F.G, ctx_out ? (F.bid + 36) % F.G : F.bid, skipf);
                pg8::Epi<pg8::EPI_RESID, true> E{}; E.xsl = xl; E.xsc = xc; E.sbf = sbf; E.xdl = XB; E.xdc = ctxx; E.gate = (const float*)(ws + WS_MOD) + (size_t)l * 5 * 6144 + 2048; E.pm_off = half * 34; E.part = nullptr; E.kslice = 1;
                pg8::gemm_phase<pg8::Epi<pg8::EPI_RESID, true>, pg8::TileOrder, true, true>(F.lds, g, S, E); }
            if (half == 0) RUN_INPROJ(1);
            } break;
        case OP_NORM2: ph_norm(F, l, XB, ctxx, true, inp(I_G2) + l * DM, 1, !ctx_out); break;
        case OP_FFUP: {
            pg8::Gemm g{XN, (const bf16*)(wt + WT_F1), DM, DM, DM}; pg8::TileOrder S; S.init(64, 16, F.G, F.bid, 1);
            pg8::Epi<pg8::EPI_RELU2> E{}; E.O = (bf16*)(ws + WS_HID); E.ldc = DFF;
            pg8::gemm_phase<pg8::Epi<pg8::EPI_RELU2>, pg8::TileOrder, true>(F.lds, g, S, E);
            if (ctx_out) {
                pg8::CtxTilesOrder S2; S2.init(F.G, F.bid, 32); pg8::Epi<pg8::EPI_RELU2, true> E2{}; E2.O = (bf16*)(ws + WS_HID); E2.ldc = DFF;
                pg8::gemm_phase<pg8::Epi<pg8::EPI_RELU2, true>, pg8::CtxTilesOrder, true, true>(F.lds, g, S2, E2); } } break;
        case OP_FFDOWN: {
            pg8::Gemm g{(const bf16*)(ws + WS_HID), (const bf16*)(wt + WT_F2), DFF, DFF, DFF}; pg8::TileOrder S; S.init(64, 4, F.G, F.bid, 1);
            pg8::Epi<pg8::EPI_RESID> E{}; E.xsl = XB; E.xsc = ctxx; E.sbf = 1; E.xdl = ctx_out ? XB : (bf16*)(ws + WS_XN); E.xdc = ctxx; E.gate = (const float*)(ws + WS_MOD) + (size_t)l * 5 * 6144 + 5120;        E.pm_off = 0; E.part = nullptr; E.kslice = 1;
            pg8::gemm_phase<pg8::Epi<pg8::EPI_RESID>, pg8::TileOrder, true>(F.lds, g, S, E);
            if (ctx_out) { pg8::Gemm g2{(const bf16*)(ws + WS_HID), (const bf16*)(wt + WT_F2), DFF, DFF, DFF / 4}; pg8::CtxSplitOrder S2; S2.init(F.G, F.bid, DFF / 4);
                E.part = (float*)(ws + WS_END); E.kslice = DFF / 4; pg8::gemm_phase<pg8::Epi<pg8::EPI_RESID>, pg8::CtxSplitOrder, true>(F.lds, g2, S2, E); } } break;
        default: ph_final(F); break;
        }
        if (op == OP_FINISH) continue;
#ifdef EXTRA_OP
        if (pp + 1 < 2 * hi) xcd_barrier(bar);
#else
        if (p + 1 < hi) xcd_barrier(bar);
#endif
    }
}

extern "C" void kernel_launch(void* const* d_in, const int* in_sizes, int n_in, void* d_out, int out_size, void* d_ws, size_t ws_size, hipStream_t stream) {
    static int grid = 0;
    if (grid == 0) {
        if (n_in != 31 || out_size != NB * SEQ * DM || ws_size < WS_END + 12 * MiB) { fprintf(stderr, "kernel_launch: unexpected shapes (n_in %d out %d ws %zu, need ws >= %zu)\n", n_in, out_size, ws_size, (size_t)WS_END); grid = -1; return; }
        int dev = 0, cus = 0;
        if (hipGetDevice(&dev) != hipSuccess || hipDeviceGetAttribute(&cus, hipDeviceAttributeMultiprocessorCount, dev) != hipSuccess) { grid = -1; return; }
        if (hipFuncSetAttribute((const void*)trunk_fwd, hipFuncAttributeMaxDynamicSharedMemorySize, LDS_BYTES) != hipSuccess) { fprintf(stderr, "kernel_launch: hipFuncSetAttribute failed\n"); grid = -1; return; }
        grid = cus;
    }
    if (grid < 0) return;
    (void)hipMemsetAsync((char*)d_ws + WS_CTL, 0, CTL_BYTES, stream);
    Args a{};
    for (int i = 0; i < 31; ++i) a.in[i] = (const float*)d_in[i];
    a.out = (float*)d_out; a.ws = (unsigned char*)d_ws;
#if ONE_LAUNCH
    a.ph_lo = 0; a.ph_hi = N_PHASES;
    hipLaunchKernelGGL(trunk_fwd, dim3(grid), dim3(NWAVES * 64), LDS_BYTES, stream, a);
#else
    for (int p = 0; p < N_PHASES; ++p) { a.ph_lo = p; a.ph_hi = p + 1; hipLaunchKernelGGL(trunk_fwd, dim3(grid), dim3(NWAVES * 64), LDS_BYTES, stream, a); }
#endif
}
```

```cpp
#include <hip/hip_runtime.h>
#include <hip/hip_bf16.h>
#include <cstdio>
#include <cstdint>

#ifndef ONE_LAUNCH
#define ONE_LAUNCH 1
#define P3X_WGS 32
#define P2_WGS 8
#endif

constexpr int DM = 1024, NB = 4, SEQ = 4096, CTX = 256, RPB = SEQ + CTX  , MROWS = NB * RPB  , HM = 2 * RPB  ;
constexpr int NIN = 6432, PPW = 3584  , NGATE = 3072;
constexpr int C_GQ = 0, C_GK = 512, C_GV = 640, C_RW = 768, C_QD = 2688, C_KVD = 3072, C_KR = 3328, C_GATE = 3360;
constexpr int RW_R = 0, RW_K = 512, RW_V = 1024, RW_WD = 1536, RW_AD = 1664, RW_GD = 1792, RWIN = 1920;
constexpr int DFF = 4096;
constexpr float NORM_EPS = 1e-6f, LNX_EPS = 64e-5f;

__device__ __forceinline__ int otid() { int t = threadIdx.x; asm volatile("" : "+v"(t)); return t; }
namespace pg8 {
#define PG8_LAS __attribute__((address_space(3)))
typedef unsigned short bf16_t;
typedef short bf16x8 __attribute__((ext_vector_type(8)));
typedef float f32x4 __attribute__((ext_vector_type(4)));
typedef unsigned u32x4 __attribute__((ext_vector_type(4)));
constexpr int BM = 256, BK = 64, HALF = 128, HTB = HALF * BK * 2, STAGE_BYTES = 8 * HTB, NXCD = 8, WGM = 8;

__host__ __device__ __forceinline__ int lds_byte(int r, int c) { const int st = (r >> 4) * 2 + (c >> 5), rr = r & 15, cc = c & 31, ob = rr * 64 + cc * 2; return st * 1024 + (ob ^ (((ob >> 9) & 1) << 5)); }
__host__ __device__ __forceinline__ void stage_rc(int b, int& R, int& C) { const int st = b / 1024, sb = b % 1024, swz = sb ^ (((sb >> 9) & 1) << 5); R = (st >> 1) * 16 + swz / 64; C = (st & 1) * 32 + (swz % 64) / 2; }
__host__ __device__ __forceinline__ int perm32(int rho) { const int n = rho >> 4, i = rho & 15; return 8 * (i >> 2) + 4 * n + (i & 3); }

struct Unit { int pm, pn, ka, set; };
struct Gemm { const bf16_t* A; const bf16_t* Bt; int lda, ldb, K; };

struct TileOrder {
    static constexpr bool MULTI = false;
    int nM, nN, nwg, G, c, skipctx;
    __device__ __forceinline__ void init(int nM_, int nN_, int G_, int c_, int skip_) { nM = nM_; nN = nN_; nwg = nM * nN; G = G_; c = c_; skipctx = skip_; }
    __device__ __forceinline__ bool next(int i, Unit& u) const {
        const long L = (long)i * G + c; if (L >= nwg) return false;
        int wgid = (int)L; { const int q = nwg / NXCD, r = nwg % NXCD, xcd = wgid % NXCD, off = wgid / NXCD; wgid = (xcd < r ? xcd * (q + 1) : r * (q + 1) + (xcd - r) * q) + off; }
        const int nig = WGM * nN, gid = wgid / nig, fm = gid * WGM, gsz = (nM - fm) < WGM ? (nM - fm) : WGM;
        u.pm = fm + ((wgid % nig) % gsz); u.pn = (wgid % nig) / gsz; u.ka = 0; u.set = 0;
        if (skipctx) u.pm = u.pm + u.pm / 16 + 1;
        return true;
    }
    __device__ __forceinline__ void a_ready(const Unit&) const {}
    __device__ __forceinline__ void done(const Unit&) const {}
};

struct BranchOrder {
    static constexpr bool MULTI = true;
    TileOrder T; long dA1, dA2, dB; int lda0, dlda;
    __device__ __forceinline__ bool next(int i, Unit& u) const { if (i >= 3) return false; if (!T.next(0, u)) return false; u.set = i; return true; }
    __device__ __forceinline__ void opnd(const Unit& u, const Gemm& g, const bf16_t*& A, int& lda, const bf16_t*& Bt) const {
        A = g.A + (long)(u.set & 1) * dA1 + (long)(u.set >> 1) * dA2; lda = lda0 - (u.set >> 1) * dlda; Bt = g.Bt + (long)u.set * dB; }
    __device__ __forceinline__ void a_ready(const Unit&) const {}
    __device__ __forceinline__ void done(const Unit&) const {}
};
struct CtxSplitOrder {
    static constexpr bool MULTI = false;
    int G, c, kslice;
    __device__ __forceinline__ void init(int G_, int c_, int kslice_) { G = G_; c = c_; kslice = kslice_; }
    __device__ __forceinline__ bool next(int i, Unit& u) const { const int L = i * G + c; if (L >= 64) return false; const int t = L >> 2; u.pm = (t >> 2) * 17; u.pn = t & 3; u.ka = (L & 3) * kslice; u.set = 0; return true; }
    __device__ __forceinline__ void a_ready(const Unit&) const {}
    __device__ __forceinline__ void done(const Unit&) const {}
};
struct CtxTilesOrder {
    static constexpr bool MULTI = false;
    int G, c, nN;
    __device__ __forceinline__ void init(int G_, int c_, int nN_) { G = G_; c = c_; nN = nN_; }
    __device__ __forceinline__ bool next(int i, Unit& u) const { const int L = i * G + c; if (L >= 4 * nN) return false; u.pm = (L / nN) * 17; u.pn = L % nN; u.ka = 0; u.set = 0; return true; }
    __device__ __forceinline__ void a_ready(const Unit&) const {}
    __device__ __forceinline__ void done(const Unit&) const {}
};
__device__ __forceinline__ unsigned cvt_pk_bf16(float lo, float hi) { unsigned r; asm volatile("v_cvt_pk_bf16_f32 %0, %1, %2" : "=v"(r) : "v"(lo), "v"(hi)); return r; }
__device__ __forceinline__ float bf_lo(unsigned w) { return __uint_as_float(w << 16); }
__device__ __forceinline__ float bf_hi(unsigned w) { return __uint_as_float(w & 0xffff0000u); }

enum { EPI_BF16 = 0, EPI_RELU2 = 1, EPI_SIGMOID = 2, EPI_ROWSCALE = 3, EPI_MLAQ = 4, EPI_GATEMUL0 = 5, EPI_GATEMUL = 6, EPI_RESID = 7 };
template <int MODE, bool HN = false> struct Epi {
    static constexpr bool PERM = true, AFTER_DRAIN = false; static constexpr int NBJ = HN ? 1 : 2;
    bf16_t* O; int ldc;
    bf16_t* O1; bf16_t* O2;
    const float* rs;
    const PG8_LAS float* rsl;
    const bf16_t* G; int ldg;
    long dG1, dG2; int multi;
    const float* tc; const float* ts;
    int first;
    int pm_off, kslice;
    float* part;
    const void* xsl; const void* xsc; bf16_t* xdl; bf16_t* xdc; const float* gate; int sbf;
    __device__ __forceinline__ void operator()(const f32x4 (&acc)[2][2][4][2], const Unit& u, int wr, int wc, int fr, int fq) const {
        const int col0 = u.pn * (HN ? HALF : BM) + wc * 32 + 8 * fq;
        if constexpr (MODE == EPI_RESID) {
            int fro = fr; asm volatile("" : "+v"(fro));
            const int gpm = __builtin_amdgcn_readfirstlane(u.pm + pm_off), b = gpm / 17, t = gpm % 17;
            const size_t xo = (t == 0) ? (size_t)(b * CTX) * DM : (size_t)(b * SEQ + (t - 1) * 256) * DM;
            const long dsrc = (const char*)xsc - (const char*)xsl, ddst = (const char*)xdc - (const char*)xdl;
            const char* sbase = (const char*)xsl + ((t == 0) ? dsrc : 0L);
            const float* xs = (const float*)sbase + xo; const bf16_t* xb = (const bf16_t*)sbase + xo;
            bf16_t* xd = (bf16_t*)((char*)xdl + ((t == 0) ? ddst : 0L)) + xo;
            const float* gv = gate + (size_t)((t == 0) ? 4 : b) * 6144;
            f32x4 g[2][2];
#pragma unroll
            for (int bj = 0; bj < NBJ; ++bj)
#pragma unroll
                for (int n = 0; n < 2; ++n) g[bj][n] = *(const f32x4*)(gv + col0 + bj * HALF + 4 * n);
            if (u.ka != 0) {
                float* pp = part + (size_t)(u.ka / kslice - 1) * 1048576 + (size_t)(b * CTX) * DM;
#pragma unroll
                for (int ai = 0; ai < 2; ++ai)
#pragma unroll
                    for (int m = 0; m < 4; ++m) { const size_t ro = (size_t)(ai * HALF + wr * 64 + m * 16 + fro) * DM + col0;
#pragma unroll
                        for (int bj = 0; bj < NBJ; ++bj)
#pragma unroll
                            for (int n = 0; n < 2; ++n) *(f32x4*)(pp + ro + bj * HALF + 4 * n) = g[bj][n] * acc[ai][bj][m][n]; }
            } else {
#pragma unroll
                for (int am = 0; am < 4; ++am) { const int ai = am >> 1, m0 = (am & 1) * 2; f32x4 xv[2][2][2];
                    if (sbf) { u32x4 xw[2][2];
#pragma unroll
                        for (int mm = 0; mm < 2; ++mm) { const size_t ro = (size_t)(ai * HALF + wr * 64 + (m0 + mm) * 16 + fro) * DM + col0;
#pragma unroll
                            for (int bj = 0; bj < NBJ; ++bj) xw[mm][bj] = *(const u32x4*)(xb + ro + bj * HALF); }
#pragma unroll
                        for (int mm = 0; mm < 2; ++mm)
#pragma unroll
                            for (int bj = 0; bj < NBJ; ++bj) { const u32x4 w = xw[mm][bj];
                                xv[mm][bj][0] = (f32x4){bf_lo(w.x), bf_hi(w.x), bf_lo(w.y), bf_hi(w.y)}; xv[mm][bj][1] = (f32x4){bf_lo(w.z), bf_hi(w.z), bf_lo(w.w), bf_hi(w.w)}; } }
                    else {
#pragma unroll
                        for (int mm = 0; mm < 2; ++mm) { const size_t ro = (size_t)(ai * HALF + wr * 64 + (m0 + mm) * 16 + fro) * DM + col0;
#pragma unroll
                            for (int bj = 0; bj < NBJ; ++bj)
#pragma unroll
                                for (int n = 0; n < 2; ++n) xv[mm][bj][n] = *(const f32x4*)(xs + ro + bj * HALF + 4 * n); } }
#pragma unroll
                    for (int mm = 0; mm < 2; ++mm) { const size_t ro = (size_t)(ai * HALF + wr * 64 + (m0 + mm) * 16 + fro) * DM + col0;
#pragma unroll
                        for (int bj = 0; bj < NBJ; ++bj) { const f32x4 y0 = xv[mm][bj][0] + g[bj][0] * acc[ai][bj][m0 + mm][0], y1 = xv[mm][bj][1] + g[bj][1] * acc[ai][bj][m0 + mm][1];
                            u32x4 w; w.x = cvt_pk_bf16(y0[0], y0[1]); w.y = cvt_pk_bf16(y0[2], y0[3]); w.z = cvt_pk_bf16(y1[0], y1[1]); w.w = cvt_pk_bf16(y1[2], y1[3]);
                            *(u32x4*)(xd + ro + bj * HALF) = w; } } } }
        } else {
            const int row0 = u.pm * BM + wr * 64 + fr;
#pragma unroll
            for (int am = 0; am < 4; ++am) { const int ai = am >> 1, m0 = (am & 1) * 2;
                float rsv[4] = {1.f, 1.f, 1.f, 1.f}; u32x4 gwv[4][2], owv[4][2]; bool accum = false;
                if constexpr (MODE == EPI_ROWSCALE || MODE == EPI_MLAQ) {
#pragma unroll
                    for (int m = m0; m < m0 + 2; ++m) rsv[m] = rsl ? rsl[ai * HALF + wr * 64 + m * 16 + fr] : rs[row0 + ai * HALF + m * 16]; }
                if constexpr (MODE == EPI_GATEMUL0 || MODE == EPI_GATEMUL) {
                    const bf16_t* Gs = multi ? G + (long)(u.set & 1) * dG1 + (long)(u.set >> 1) * dG2 : G; accum = (MODE == EPI_GATEMUL) && !(multi ? u.set == 0 : first);
#pragma unroll
                    for (int m = m0; m < m0 + 2; ++m)
#pragma unroll
                        for (int bj = 0; bj < NBJ; ++bj) { const int row = row0 + ai * HALF + m * 16; gwv[m][bj] = *(const u32x4*)(Gs + (size_t)row * ldg + col0 + bj * HALF);
                            if (accum) owv[m][bj] = *(const u32x4*)(O + (size_t)row * ldc + col0 + bj * HALF); }
                    asm volatile("" ::: "memory"); }
#pragma unroll
                for (int m = m0; m < m0 + 2; ++m) { const int row = row0 + ai * HALF + m * 16; bf16_t* rowp = O + (size_t)row * ldc + col0;
                    if constexpr (MODE == EPI_SIGMOID && !HN) { const int bi = u.pn >> 2; rowp += (long)(bi & 1) * (O1 - O) + (long)(bi >> 1) * (O2 - O) - bi * 4 * BM; }
                    float rsc = 1.f; int pr = 0, pc = 0; bool lat = false;
                    if constexpr (MODE == EPI_ROWSCALE || MODE == EPI_MLAQ) rsc = rsv[m];
                    if constexpr (MODE == EPI_MLAQ) { const int s = row % RPB; lat = s >= CTX; const int tt = s - CTX; pr = (tt >> 6) & 63; pc = tt & 63; }
#pragma unroll
                    for (int bj = 0; bj < NBJ; ++bj) { f32x4 v0 = acc[ai][bj][m][0], v1 = acc[ai][bj][m][1];
                        if constexpr (MODE == EPI_RELU2) {
#pragma unroll
                            for (int e = 0; e < 4; ++e) { float a = fmaxf(v0[e], 0.f), b = fmaxf(v1[e], 0.f); v0[e] = a * a; v1[e] = b * b; } }
                        if constexpr (MODE == EPI_SIGMOID) {
#pragma unroll
                            for (int e = 0; e < 4; ++e) { v0[e] = 1.f / (1.f + __expf(-v0[e])); v1[e] = 1.f / (1.f + __expf(-v1[e])); } }
                        if constexpr (MODE == EPI_ROWSCALE || MODE == EPI_MLAQ) { v0 = v0 * rsc; v1 = v1 * rsc; }
                        if constexpr (MODE == EPI_MLAQ) {
                            const int g32 = u.pn * 8 + bj * 4 + wc;
                            if (g32 % 3 == 2) {
                                f32x4 p0, p1;
#pragma unroll
                                for (int e = 0; e < 4; ++e) { p0[e] = __shfl_xor(v0[e], 16); p1[e] = __shfl_xor(v1[e], 16); }
                                if (lat) { const int pos = (fq < 2) ? pr : pc; const f32x4 c0 = *(const f32x4*)(tc + pos * 8), c1 = *(const f32x4*)(tc + pos * 8 + 4), s0 = *(const f32x4*)(ts + pos * 8), s1 = *(const f32x4*)(ts + pos * 8 + 4);
                                    if ((fq & 1) == 0) { v0 = v0 * c0 - p0 * s0; v1 = v1 * c1 - p1 * s1; } else { v0 = p0 * s0 + v0 * c0; v1 = p1 * s1 + v1 * c1; } }
                            } }
                        if constexpr (MODE == EPI_GATEMUL0 || MODE == EPI_GATEMUL) {
                            const u32x4 gw = gwv[m][bj];
                            v0[0] *= bf_lo(gw.x); v0[1] *= bf_hi(gw.x); v0[2] *= bf_lo(gw.y); v0[3] *= bf_hi(gw.y); v1[0] *= bf_lo(gw.z); v1[1] *= bf_hi(gw.z); v1[2] *= bf_lo(gw.w); v1[3] *= bf_hi(gw.w);
                            if (accum) { const u32x4 ow = owv[m][bj];
                                v0[0] += bf_lo(ow.x); v0[1] += bf_hi(ow.x); v0[2] += bf_lo(ow.y); v0[3] += bf_hi(ow.y); v1[0] += bf_lo(ow.z); v1[1] += bf_hi(ow.z); v1[2] += bf_lo(ow.w); v1[3] += bf_hi(ow.w); } }
                        u32x4 w; w.x = cvt_pk_bf16(v0[0], v0[1]); w.y = cvt_pk_bf16(v0[2], v0[3]); w.z = cvt_pk_bf16(v1[0], v1[1]); w.w = cvt_pk_bf16(v1[2], v1[3]);
                        *(u32x4*)(rowp + bj * HALF) = w; } } }
        }
    }
};

template <class EpiT, class Sched, bool ALIGN_EPI, bool HN = false>
__device__ __forceinline__ void gemm_phase(PG8_LAS unsigned char* lds, const Gemm g, const Sched& S, const EpiT& E) {
    const int tid = otid(), wid = __builtin_amdgcn_readfirstlane(tid >> 6), lane = tid & 63, wr = wid >> 2, wc = wid & 3, fr = lane & 15, fq = lane >> 4;
    const int nt = g.K / BK;
    unsigned voffA[2], voffB[2]; int stR[2], stC[2];
#pragma unroll
    for (int i = 0; i < 2; ++i) { int R, C; stage_rc(tid * 16 + i * 8192, R, C); const int Rb = EpiT::PERM ? ((R & ~31) + perm32(R & 31)) : R; stR[i] = R; stC[i] = C;
        voffA[i] = (unsigned)(R * g.lda + C) * 2u; voffB[i] = (unsigned)(Rb * g.ldb + C) * 2u; }
    const size_t kstep = (size_t)(BK * 2);
    size_t hsA = (size_t)HALF * g.lda * 2; const size_t hsB = (size_t)HALF * g.ldb * 2, tsB = 2 * hsB;
#define PG8_OPND(u, pA, pB, vA, hA) do { if constexpr (Sched::MULTI) { const bf16_t* A_; const bf16_t* B_; int l_; S.opnd(u, g, A_, l_, B_); hA = (size_t)HALF * l_ * 2; \
            vA[0] = (unsigned)(stR[0] * l_ + stC[0]) * 2u; vA[1] = (unsigned)(stR[1] * l_ + stC[1]) * 2u; \
            pA = (const char*)A_ + (size_t)(u).pm * 2 * hA + (size_t)(u).ka * 2; pB = (const char*)B_ + (size_t)(u).pn * (HN ? hsB : tsB) + (size_t)(u).ka * 2; } \
        else { hA = (size_t)HALF * g.lda * 2; vA[0] = voffA[0]; vA[1] = voffA[1]; pA = (const char*)g.A + (size_t)(u).pm * 2 * hA + (size_t)(u).ka * 2; pB = (const char*)g.Bt + (size_t)(u).pn * (HN ? hsB : tsB) + (size_t)(u).ka * 2; } } while (0)
    const unsigned ldsw = (unsigned)wid * 1024u;
    const int aoff = lds_byte(wr * 64 + fr, fq * 8), boff = lds_byte(wc * 32 + fr, fq * 8);
#define PG8_SA(b, h) (((b) * 2 + (h)) * HTB)
#define PG8_SB(b, h) ((4 + (b) * 2 + (h)) * HTB)
#define PG8_STAGE(bufoff, gbase, voff) do { _Pragma("unroll") for (int _i = 0; _i < 2; ++_i) \
        __builtin_amdgcn_global_load_lds((const unsigned*)((const char*)(gbase) + (voff)[_i]), (PG8_LAS unsigned*)(lds + (bufoff) + ldsw + _i * 8192), 16, 0, 0); } while (0)
#define PG8_LDA(dst, b, h) do { _Pragma("unroll") for (int m = 0; m < 4; ++m) _Pragma("unroll") for (int k = 0; k < 2; ++k) dst[m][k] = *(const PG8_LAS bf16x8*)(lds + PG8_SA(b, h) + aoff + m * 2048 + k * 1024); } while (0)
#define PG8_LDB(dst, b, h) do { _Pragma("unroll") for (int n = 0; n < 2; ++n) _Pragma("unroll") for (int k = 0; k < 2; ++k) dst[n][k] = *(const PG8_LAS bf16x8*)(lds + PG8_SB(b, h) + boff + n * 2048 + k * 1024); } while (0)
#define PG8_MMA(ai, bj, At, Bt) do { __builtin_amdgcn_s_setprio(1); _Pragma("unroll") for (int m = 0; m < 4; ++m) _Pragma("unroll") for (int n = 0; n < 2; ++n) _Pragma("unroll") for (int k = 0; k < 2; ++k) \
        acc[ai][bj][m][n] = __builtin_amdgcn_mfma_f32_16x16x32_bf16(Bt[n][k], At[m][k], acc[ai][bj][m][n], 0, 0, 0); __builtin_amdgcn_s_setprio(0); } while (0)
#define PG8_WAIT_V(n) asm volatile("s_waitcnt vmcnt(" #n ")" ::: "memory")
#define PG8_WAIT_L(n) asm volatile("s_waitcnt lgkmcnt(" #n ")" ::: "memory")
#define PG8_BAR __builtin_amdgcn_s_barrier()
#define PG8_SCHED __builtin_amdgcn_sched_barrier(0)
    Unit cur, nxt; int ui = 0;
    if (!S.next(0, cur)) return;
    f32x4 acc[2][2][4][2];
    float zf; asm volatile("v_mov_b32 %0, 0" : "=v"(zf));
#pragma unroll
    for (int a = 0; a < 2; ++a)
#pragma unroll
        for (int b = 0; b < 2; ++b)
#pragma unroll
            for (int m = 0; m < 4; ++m)
#pragma unroll
                for (int n = 0; n < 2; ++n) acc[a][b][m][n] = (f32x4){zf, zf, zf, zf};
    bf16x8 At[4][2], B0[2][2], B1[2][2];
    const char* cA; const char* cB; PG8_OPND(cur, cA, cB, voffA, hsA);
    S.a_ready(cur);
    PG8_STAGE(PG8_SB(0, 0), cB, voffB); if constexpr (!HN) PG8_STAGE(PG8_SB(0, 1), cB + hsB, voffB); PG8_STAGE(PG8_SA(0, 0), cA, voffA); PG8_STAGE(PG8_SA(0, 1), cA + hsA, voffA);
    if (wr == 1) PG8_BAR;
    PG8_WAIT_V(2); PG8_BAR;
    PG8_STAGE(PG8_SB(1, 0), cB + kstep, voffB); PG8_STAGE(PG8_SA(1, 0), cA + kstep, voffA); if constexpr (!HN) PG8_STAGE(PG8_SB(1, 1), cB + hsB + kstep, voffB);
    if constexpr (HN) PG8_WAIT_V(4); else PG8_WAIT_V(6); PG8_BAR;
    for (;;) {
        const bool has_next = S.next(ui + 1, nxt);
        const char* nA = cA; const char* nB = cB; unsigned voffAn[2] = {voffA[0], voffA[1]}; size_t hsAn = hsA;
        if (has_next) PG8_OPND(nxt, nA, nB, voffAn, hsAn);
        for (int t = 0; t < nt; t += 2) {
            const bool last = (t == nt - 2);
            const char* a1 = cA + (size_t)(t + 1) * kstep;
            const char* a2 = last ? nA : cA + (size_t)(t + 2) * kstep; const char* b2 = last ? nB : cB + (size_t)(t + 2) * kstep;
            const char* a3 = a2 + kstep; const char* b3 = b2 + kstep;
            if (last && has_next) S.a_ready(nxt);
            unsigned vq[2] = {voffA[0], voffA[1]}; size_t hq = hsA;
            if constexpr (Sched::MULTI) { if (last) { vq[0] = voffAn[0]; vq[1] = voffAn[1]; hq = hsAn; } }
#define PG8_WAIT_G() do { if constexpr (HN) PG8_WAIT_V(6); else PG8_WAIT_V(8); } while (0)
            PG8_LDB(B0, 0, 0); if constexpr (!HN) PG8_LDB(B1, 0, 1); PG8_SCHED; PG8_LDA(At, 0, 0); PG8_STAGE(PG8_SA(1, 1), a1 + hsA, voffA);
            PG8_WAIT_G(); PG8_WAIT_L(0); PG8_BAR; PG8_MMA(0, 0, At, B0); if constexpr (!HN) PG8_MMA(0, 1, At, B1); PG8_BAR; PG8_SCHED;
            PG8_LDA(At, 0, 1); PG8_STAGE(PG8_SB(0, 0), b2, voffB); if constexpr (!HN) PG8_STAGE(PG8_SB(0, 1), b2 + hsB, voffB); PG8_STAGE(PG8_SA(0, 0), a2, vq);
            PG8_WAIT_G(); PG8_WAIT_L(0); PG8_BAR; PG8_MMA(1, 0, At, B0); if constexpr (!HN) PG8_MMA(1, 1, At, B1); PG8_BAR; PG8_SCHED;
            PG8_LDB(B0, 1, 0); if constexpr (!HN) PG8_LDB(B1, 1, 1); PG8_SCHED; PG8_LDA(At, 1, 0); PG8_STAGE(PG8_SA(0, 1), a2 + hq, vq);
            PG8_WAIT_G(); PG8_WAIT_L(0); PG8_BAR; PG8_MMA(0, 0, At, B0); if constexpr (!HN) PG8_MMA(0, 1, At, B1); PG8_BAR; PG8_SCHED;
            PG8_LDA(At, 1, 1); PG8_STAGE(PG8_SB(1, 0), b3, voffB); if constexpr (!HN) PG8_STAGE(PG8_SB(1, 1), b3 + hsB, voffB); PG8_STAGE(PG8_SA(1, 0), a3, vq);
            PG8_WAIT_G(); PG8_WAIT_L(0); PG8_BAR; PG8_MMA(1, 0, At, B0); if constexpr (!HN) PG8_MMA(1, 1, At, B1); PG8_BAR; PG8_SCHED;
#undef PG8_WAIT_G
        }
        if constexpr (ALIGN_EPI) { if (wr == 0) PG8_BAR; }
        E(acc, cur, wr, wc, fr, fq); S.done(cur);
        if (!has_next) break;
        asm volatile("v_mov_b32 %0, 0" : "=v"(zf));
#pragma unroll
        for (int a = 0; a < 2; ++a)
#pragma unroll
            for (int b = 0; b < 2; ++b)
#pragma unroll
                for (int m = 0; m < 4; ++m)
#pragma unroll
                    for (int n = 0; n < 2; ++n) acc[a][b][m][n] = (f32x4){zf, zf, zf, zf};
        cur = nxt; cA = nA; cB = nB; ++ui; voffA[0] = voffAn[0]; voffA[1] = voffAn[1]; hsA = hsAn;
        if constexpr (ALIGN_EPI) { if (wr == 1) PG8_BAR; }
    }
    PG8_WAIT_V(0);
    if constexpr (!ALIGN_EPI) { if (wr == 0) PG8_BAR; }
    PG8_BAR;
#undef PG8_OPND
#undef PG8_SA
#undef PG8_SB
#undef PG8_STAGE
#undef PG8_LDA
#undef PG8_LDB
#undef PG8_MMA
#undef PG8_WAIT_V
#undef PG8_WAIT_L
#undef PG8_BAR
#undef PG8_SCHED
}
}

namespace att {
using bf16 = unsigned short;
using bf16x8 = __attribute__((ext_vector_type(8))) short;
using s16x4 = __attribute__((ext_vector_type(4))) short;
using f32x16 = __attribute__((ext_vector_type(16))) float;
using u32x4 = __attribute__((ext_vector_type(4))) unsigned;
constexpr int NW = 8, QBLK = 32, KVBLK = 64;
constexpr float THR = 8.f;
#define SBAR() __builtin_amdgcn_sched_barrier(0)
__device__ __forceinline__ int crow(int r, int hi) { return (r & 3) + 8 * (r >> 2) + 4 * hi; }
__device__ __forceinline__ unsigned cvtpk(float lo, float hi) { unsigned r; asm volatile("v_cvt_pk_bf16_f32 %0, %1, %2" : "=v"(r) : "v"(lo), "v"(hi)); return r; }
template <int DQ> __device__ __forceinline__ int kaddr(int row, int c) {
    if constexpr (DQ == 64) return row * 128 + ((c ^ ((row >> 1) & 7)) << 4); else return row * 208 + c * 16; }
template <int DQ> constexpr int ktile_bytes() { return DQ == 64 ? 64 * 128 : 64 * 208; }
constexpr int VTILE = 64 * 64 * 2;
template <int DQ> constexpr int lds_bytes() { return 2 * ktile_bytes<DQ>() + 2 * VTILE + NW * 64 * 4; }

template <bool FIRST> __device__ __forceinline__ void partialSM(f32x16& p0, f32x16& p1, f32x16& nm16, float& alpha) {
    float pmax = p0[0];
#pragma unroll
    for (int r = 1; r < 16; ++r) pmax = fmaxf(pmax, p0[r]);
#pragma unroll
    for (int r = 0; r < 16; ++r) pmax = fmaxf(pmax, p1[r]);
    { auto rr = __builtin_amdgcn_permlane32_swap(__float_as_uint(pmax), __float_as_uint(pmax), false, false);
      pmax = fmaxf(__uint_as_float(rr[0]), __uint_as_float(rr[1])); }
    alpha = 1.f;
    if (FIRST || !__builtin_expect(__all(pmax <= THR), 1)) {
        const float dl = FIRST ? pmax : fmaxf(pmax, 0.f); if (!FIRST) alpha = __builtin_amdgcn_exp2f(-dl);
#pragma unroll
        for (int r = 0; r < 16; ++r) { nm16[r] -= dl; p0[r] -= dl; p1[r] -= dl; } }
#pragma unroll
    for (int r = 0; r < 16; ++r) p0[r] = __builtin_amdgcn_exp2f(p0[r]);
}
__device__ __forceinline__ void finishSM(f32x16& p0, f32x16& p1, float alpha, float& l_reg, bf16x8& pa0, bf16x8& pa1, bf16x8& pa2, bf16x8& pa3) {
#pragma unroll
    for (int r = 0; r < 16; ++r) p1[r] = __builtin_amdgcn_exp2f(p1[r]);
    float ps = 0;
#pragma unroll
    for (int r = 0; r < 16; ++r) ps += p0[r];
#pragma unroll
    for (int r = 0; r < 16; ++r) ps += p1[r];
    { auto rr = __builtin_amdgcn_permlane32_swap(__float_as_uint(ps), __float_as_uint(ps), false, false);
      ps = __uint_as_float(rr[0]) + __uint_as_float(rr[1]); }
    l_reg = l_reg * alpha + ps;
#define PK4(P, BASE, OUT) do { unsigned a0 = cvtpk(P[BASE + 0], P[BASE + 1]), a1 = cvtpk(P[BASE + 2], P[BASE + 3]);   \
    unsigned b0 = cvtpk(P[BASE + 4], P[BASE + 5]), b1 = cvtpk(P[BASE + 6], P[BASE + 7]);                              \
    auto r0 = __builtin_amdgcn_permlane32_swap(a0, b0, false, false); auto r1 = __builtin_amdgcn_permlane32_swap(a1, b1, false, false); \
    u32x4 w = {r0[0], r1[0], r0[1], r1[1]}; OUT = *reinterpret_cast<bf16x8*>(&w); } while (0)
    PK4(p0, 0, pa0); PK4(p0, 8, pa1); PK4(p1, 0, pa2); PK4(p1, 8, pa3);
#undef PK4
}
template <int DQ> __device__ __forceinline__ void qkt(f32x16& p0, f32x16& p1, const char* Ks, const bf16x8* qr, int r32, int hi, const f32x16& nm16) {
    p0 = nm16; p1 = nm16;
#pragma unroll
    for (int d0 = 0; d0 < DQ / 16; ++d0) { const int c = d0 * 2 + hi;
        const bf16x8 b0 = *reinterpret_cast<const bf16x8*>(Ks + kaddr<DQ>(r32, c));
        const bf16x8 b1 = *reinterpret_cast<const bf16x8*>(Ks + kaddr<DQ>(32 + r32, c));
        p0 = __builtin_amdgcn_mfma_f32_32x32x16_bf16(b0, qr[d0], p0, 0, 0, 0);
        p1 = __builtin_amdgcn_mfma_f32_32x32x16_bf16(b1, qr[d0], p1, 0, 0, 0); }
}
__device__ __forceinline__ int v_st(int k, int c) { const int kk = (k & ~0xC) | ((k & 4) << 1) | ((k & 8) >> 1); return ((kk >> 3) * 2 + (c >> 5)) * 512 + ((kk & 7) * 32 + (c & 31)) * 2; }
__device__ __forceinline__ int v_rd_base(int lane) { return ((lane & 3) << 3) | (((lane >> 2) & 3) << 6) | (((lane >> 4) & 1) << 5) | (((lane >> 5) & 1) << 8); }
constexpr int v_rd_off(int d0, int ks, int half) { return d0 * 512 + ks * 2048 + half * 1024; }
template <int OFF> __device__ __forceinline__ s16x4 tr_read(int vb) { s16x4 r; asm volatile("ds_read_b64_tr_b16 %0, %1 offset:%2" : "=&v"(r) : "v"(vb), "i"(OFF) : "memory"); return r; }
template <int D0> __device__ __forceinline__ void pv_one(f32x16& od, int vb, bf16x8 pa0, bf16x8 pa1, bf16x8 pa2, bf16x8 pa3) {
    const s16x4 l0 = tr_read<v_rd_off(D0, 0, 0)>(vb), h0 = tr_read<v_rd_off(D0, 0, 1)>(vb), l1 = tr_read<v_rd_off(D0, 1, 0)>(vb), h1 = tr_read<v_rd_off(D0, 1, 1)>(vb);
    const s16x4 l2 = tr_read<v_rd_off(D0, 2, 0)>(vb), h2 = tr_read<v_rd_off(D0, 2, 1)>(vb), l3 = tr_read<v_rd_off(D0, 3, 0)>(vb), h3 = tr_read<v_rd_off(D0, 3, 1)>(vb);
    asm volatile("s_waitcnt lgkmcnt(0)" ::: "memory"); SBAR();
#define PK(L, H) (bf16x8){L[0], L[1], L[2], L[3], H[0], H[1], H[2], H[3]}
    od = __builtin_amdgcn_mfma_f32_32x32x16_bf16(pa0, PK(l0, h0), od, 0, 0, 0);
    od = __builtin_amdgcn_mfma_f32_32x32x16_bf16(pa1, PK(l1, h1), od, 0, 0, 0);
    od = __builtin_amdgcn_mfma_f32_32x32x16_bf16(pa2, PK(l2, h2), od, 0, 0, 0);
    od = __builtin_amdgcn_mfma_f32_32x32x16_bf16(pa3, PK(l3, h3), od, 0, 0, 0);
#undef PK
}
struct Args { const bf16* Q; int ldq; const bf16* K0; int ldk0; const bf16* K1; int ldk1; const bf16* V; int ldv; bf16* O; int ldo; int nkeys; int rope_t0; const float* tc; const float* ts; };
template <int DQ>
__device__ __forceinline__ void attn_unit(const Args a, char* lds) {
    constexpr int KT = ktile_bytes<DQ>(), NLD = (DQ == 64) ? 2 : 3;
    const int tid = otid(), wid = tid >> 6, lane = tid & 63, r32 = lane & 31, hi = lane >> 5;
    char* V_lds = lds; char* K_lds = lds + 2 * VTILE;
    float* ws = (float*)(lds + 2 * VTILE + 2 * KT) + wid * 64; float* li_l = ws; float* al_l = ws + 32;
    float l_reg = 0; f32x16 o[2] = {}; f32x16 nm16 = {}; bf16x8 qr[DQ / 16];
    const bf16* Qw = a.Q + (long)(wid * QBLK + r32) * a.ldq + hi * 8;
#pragma unroll
    for (int d0 = 0; d0 < DQ / 16; ++d0) qr[d0] = *reinterpret_cast<const bf16x8*>(Qw + d0 * 16);
    if constexpr (DQ == 96) { if (a.rope_t0 >= 0) {
        const int tq = a.rope_t0 + wid * QBLK + r32, pr = (tq >> 6) & 63, pc = tq & 63;
#pragma unroll
        for (int f = 4; f < 6; ++f) { const int pos = (f == 4) ? pr : pc; u32x4 w = *reinterpret_cast<u32x4*>(&qr[f]); u32x4 o;
#pragma unroll
            for (int e = 0; e < 4; ++e) { const unsigned mine = w[e], oth = (unsigned)__shfl_xor((int)mine, 32);
                const float m0 = __uint_as_float(mine << 16), m1 = __uint_as_float(mine & 0xffff0000u), o0 = __uint_as_float(oth << 16), o1 = __uint_as_float(oth & 0xffff0000u);
                const float c0 = a.tc[pos * 8 + 2 * e], c1 = a.tc[pos * 8 + 2 * e + 1], s0 = a.ts[pos * 8 + 2 * e], s1 = a.ts[pos * 8 + 2 * e + 1];
                const float r0 = (hi == 0) ? m0 * c0 - o0 * s0 : o0 * s0 + m0 * c0, r1 = (hi == 0) ? m1 * c1 - o1 * s1 : o1 * s1 + m1 * c1;
                o[e] = cvtpk(r0, r1); }
            qr[f] = *reinterpret_cast<bf16x8*>(&o); } } }
    const int vrow = tid >> 3, vcol = (tid & 7) * 8, vst = v_st(vrow, vcol);
    const bf16* vsrc = a.V + (long)vrow * a.ldv + vcol; const long vstep = (long)KVBLK * a.ldv;
    int kr0, kc0, kr1 = 0, kc1 = 0;
    if constexpr (DQ == 64) { kr0 = tid >> 3; kc0 = tid & 7; } else { kr0 = tid / 12; kc0 = tid % 12; const int id1 = 512 + (tid & 255); kr1 = id1 / 12; kc1 = id1 % 12; }
    const bf16* ksrc0 = (kc0 < 8) ? a.K0 + (long)kr0 * a.ldk0 + kc0 * 8 : a.K1 + (long)kr0 * a.ldk1 + (kc0 - 8) * 8; const long kstep0 = (long)KVBLK * ((kc0 < 8) ? a.ldk0 : a.ldk1);
    const bf16* ksrc1 = ksrc0; long kstep1 = kstep0;
    if constexpr (DQ == 96) { ksrc1 = (kc1 < 8) ? a.K0 + (long)kr1 * a.ldk0 + kc1 * 8 : a.K1 + (long)kr1 * a.ldk1 + (kc1 - 8) * 8; kstep1 = (long)KVBLK * ((kc1 < 8) ? a.ldk0 : a.ldk1); }
    const int kst0 = kaddr<DQ>(kr0, kc0), kst1 = kaddr<DQ>(kr1, kc1);
    const int vb0 = (int)(uintptr_t)V_lds + v_rd_base(lane);
    struct { bf16x8 vs, ks0, ks1; } sr_[2];
#define SLOAD(i, t) do { sr_[i].vs = *reinterpret_cast<const bf16x8*>(vsrc + (long)(t) * vstep); sr_[i].ks0 = *reinterpret_cast<const bf16x8*>(ksrc0 + (long)(t) * kstep0); \
    if constexpr (DQ == 96) sr_[i].ks1 = *reinterpret_cast<const bf16x8*>(ksrc1 + (long)(t) * kstep1); } while (0)
#define SWRITE(b, i) do { *(bf16x8*)(V_lds + (b) * VTILE + vst) = sr_[i].vs; *(bf16x8*)(K_lds + (b) * KT + kst0) = sr_[i].ks0; \
    if constexpr (DQ == 96) *(bf16x8*)(K_lds + (b) * KT + kst1) = sr_[i].ks1; } while (0)
#define SWAIT() do { if constexpr (NLD == 2) asm volatile("s_waitcnt vmcnt(2)" ::: "memory"); else asm volatile("s_waitcnt vmcnt(3)" ::: "memory"); } while (0)
#define RESC(al) do { if (__any((al) < 1.f)) { if (hi == 0) al_l[r32] = (al); asm volatile("s_waitcnt lgkmcnt(0)" ::: "memory"); \
    _Pragma("unroll") for (int d = 0; d < 2; ++d) _Pragma("unroll") for (int r = 0; r < 16; ++r) o[d][r] *= al_l[crow(r, hi)]; } } while (0)
    f32x16 pA0, pA1, pB0, pB1; float alA, alB; bf16x8 pa0, pa1, pa2, pa3; const int NT = a.nkeys / KVBLK;
    constexpr int SE = 0, SO = 1;
    SLOAD(SE, 0); asm volatile("s_waitcnt vmcnt(0)" ::: "memory"); SWRITE(0, SE); __syncthreads();
    qkt<DQ>(pA0, pA1, K_lds, qr, r32, hi, nm16); partialSM<true>(pA0, pA1, nm16, alA);
    SLOAD(SO, 1); if (2 < NT) SLOAD(SE, 2);
    SWAIT(); SWRITE(1, SO); __syncthreads();
    for (int j = 1; j + 1 < NT; j += 2) {
        SBAR(); qkt<DQ>(pB0, pB1, K_lds + KT, qr, r32, hi, nm16);
        finishSM(pA0, pA1, alA, l_reg, pa0, pa1, pa2, pa3); SBAR();
        SLOAD(SO, j + 2); SBAR();
        pv_one<0>(o[0], vb0, pa0, pa1, pa2, pa3); pv_one<1>(o[1], vb0, pa0, pa1, pa2, pa3); partialSM<false>(pB0, pB1, nm16, alB);
        __syncthreads(); SWAIT(); SWRITE(0, SE);
        RESC(alB); __syncthreads();
        SBAR(); qkt<DQ>(pA0, pA1, K_lds, qr, r32, hi, nm16);
        finishSM(pB0, pB1, alB, l_reg, pa0, pa1, pa2, pa3); SBAR();
        if (j + 3 < NT) SLOAD(SE, j + 3); SBAR();
        pv_one<0>(o[0], vb0 + VTILE, pa0, pa1, pa2, pa3); pv_one<1>(o[1], vb0 + VTILE, pa0, pa1, pa2, pa3); partialSM<false>(pA0, pA1, nm16, alA);
        __syncthreads(); SWAIT(); SWRITE(1, SO);
        RESC(alA); __syncthreads();
    }
    SBAR(); qkt<DQ>(pB0, pB1, K_lds + KT, qr, r32, hi, nm16);
    finishSM(pA0, pA1, alA, l_reg, pa0, pa1, pa2, pa3); SBAR();
    pv_one<0>(o[0], vb0, pa0, pa1, pa2, pa3); pv_one<1>(o[1], vb0, pa0, pa1, pa2, pa3); partialSM<false>(pB0, pB1, nm16, alB);
    __syncthreads(); RESC(alB);
    finishSM(pB0, pB1, alB, l_reg, pa0, pa1, pa2, pa3); SBAR();
    pv_one<0>(o[0], vb0 + VTILE, pa0, pa1, pa2, pa3); pv_one<1>(o[1], vb0 + VTILE, pa0, pa1, pa2, pa3);
    if (hi == 0) li_l[r32] = l_reg; asm volatile("s_waitcnt lgkmcnt(0)" ::: "memory");
    float rli[16];
#pragma unroll
    for (int r = 0; r < 16; ++r) rli[r] = __builtin_amdgcn_rcpf(li_l[crow(r, hi)]);
    __syncthreads();
    { unsigned short* stg = (unsigned short*)(lds) + wid * 2048;
#pragma unroll
      for (int r = 0; r < 16; ++r) { const int orow = crow(r, hi);
#pragma unroll
        for (int d0 = 0; d0 < 2; ++d0) { const float v = o[d0][r] * rli[r]; const unsigned u = __float_as_uint(v); stg[orow * 64 + d0 * 32 + r32] = (unsigned short)((u + 0x7fffu + ((u >> 16) & 1u)) >> 16); } }
      asm volatile("s_waitcnt lgkmcnt(0)" ::: "memory");
      bf16* Ow = a.O + (long)(wid * QBLK) * a.ldo;
#pragma unroll
      for (int i = 0; i < 4; ++i) { const int row = i * 8 + (lane >> 3), ch = lane & 7; const u32x4 v = *(const u32x4*)(stg + row * 64 + ch * 8); *(u32x4*)(Ow + (long)row * a.ldo + ch * 8) = v; } }
    __syncthreads();
#undef SLOAD
#undef SWRITE
#undef SWAIT
#undef RESC
}
#undef SBAR
}

namespace at64 {
using att::bf16; using att::bf16x8; using att::s16x4; using att::f32x16; using att::u32x4;
constexpr int NW = 8, QBLK = 32, KVBLK = 64;
constexpr float C2 = 0.125f * 1.4426950408889634f;
constexpr float THR = 8.f;
constexpr int SLOTB = 8192, LDS_K = 0, LDS_V = 3 * SLOTB, LDS_WS = 6 * SLOTB, LDS_OST = LDS_WS + NW * 256, LDS_TOT = LDS_OST + NW * 4096;
#define A6_SBAR() __builtin_amdgcn_sched_barrier(0)
#define A6_PIN(x) asm volatile("" : "+v"(x))
#define A6_MFMA(a, b, c) __builtin_amdgcn_mfma_f32_32x32x16_bf16(a, b, c, 0, 0, 0)
#define A6_WAIT_BAR(N) asm volatile("s_waitcnt vmcnt(" #N ") lgkmcnt(0)\n\ts_barrier" ::: "memory")
__device__ __forceinline__ int crow(int r, int hi) { return (r & 3) + 8 * (r >> 2) + 4 * hi; }
__device__ __forceinline__ unsigned cvtpk(float lo, float hi) { unsigned r; asm("v_cvt_pk_bf16_f32 %0, %1, %2" : "=v"(r) : "v"(lo), "v"(hi)); return r; }
__device__ __forceinline__ void glds16(const void* g, unsigned lds_base) {
    unsigned sv; asm volatile("s_mov_b32 %0, m0\n\ts_mov_b32 m0, %2\n\ts_nop 0\n\tglobal_load_lds_dwordx4 %1, off\n\ts_mov_b32 m0, %0" : "=&s"(sv) : "v"(g), "s"(lds_base) : "memory"); }
typedef __attribute__((address_space(3))) const char* lds_cptr;
typedef short v4i16_t __attribute__((ext_vector_type(4)));
__device__ __forceinline__ void kload2(bf16x8* kf, lds_cptr kp, int d0) { kf[2 * d0] = *(const __attribute__((address_space(3))) bf16x8*)(kp + d0 * 2048); kf[2 * d0 + 1] = *(const __attribute__((address_space(3))) bf16x8*)(kp + d0 * 2048 + 512); }
__device__ __forceinline__ s16x4 vtr(lds_cptr p) { return __builtin_bit_cast(s16x4, __builtin_amdgcn_ds_read_tr16_b64_v4i16((__attribute__((address_space(3))) v4i16_t*)p)); }
#define A6_MX3(a, b, c) __builtin_fmaxf(__builtin_fmaxf((a), (b)), (c))
__device__ __forceinline__ float rowmax(const f32x16& p0, const f32x16& p1) {
    float a = A6_MX3(p0[0], p0[1], p1[0]), b = A6_MX3(p0[2], p0[3], p1[1]); a = A6_MX3(a, p1[2], p1[3]);
#pragma unroll
    for (int r = 4; r < 16; r += 4) { a = A6_MX3(a, p0[r], p0[r + 1]); b = A6_MX3(b, p0[r + 2], p0[r + 3]); a = A6_MX3(a, p1[r], p1[r + 1]); b = A6_MX3(b, p1[r + 2], p1[r + 3]); }
    float m = __builtin_fmaxf(a, b); auto rr = __builtin_amdgcn_permlane32_swap(__float_as_uint(m), __float_as_uint(m), false, false);
    return __builtin_fmaxf(__uint_as_float(rr[0]), __uint_as_float(rr[1])); }
struct Args { const bf16* Q; int ldq; const bf16* K; int ldk; const bf16* V; int ldv; bf16* O; int ldo; int nkeys; float* lse; };
__device__ __forceinline__ void unit(const Args a, char* lds) {
    const int tid = otid(), lane = tid & 63, r32 = lane & 31, hi = lane >> 5; const int wid = __builtin_amdgcn_readfirstlane(tid >> 6);
    const int NT = a.nkeys / KVBLK;
    const bf16* Qw = a.Q + (long)(wid * QBLK) * a.ldq;
    const unsigned lds0 = (unsigned)(uintptr_t)lds; float* wsf = (float*)(lds + LDS_WS) + wid * 64;
    const bf16* ksrc = a.K + (long)lane * a.ldk + wid * 8; const long kstep = (long)KVBLK * a.ldk;
    const bf16* vsrc = a.V + (long)(16 * (wid & 3) + (lane >> 2)) * a.ldv + (wid >> 2) * 32 + (lane & 3) * 8; const long vstep = (long)KVBLK * a.ldv;
    const unsigned kdst = lds0 + LDS_K + wid * 1024, vdst = lds0 + LDS_V + wid * 1024;
#define DMA_K(t, slot) glds16(ksrc + (long)(t) * kstep, (unsigned)__builtin_amdgcn_readfirstlane(kdst + (slot)))
#define DMA_V(t, slot) glds16(vsrc + (long)(t) * vstep, (unsigned)__builtin_amdgcn_readfirstlane(vdst + (slot)))
    const lds_cptr vp0 = (lds_cptr)lds + LDS_V + ((lane >> 4) & 1) * 32 + (lane & 3) * 8 + (4 * hi + ((lane & 15) >> 2)) * 64;
    const lds_cptr kp0 = (lds_cptr)lds + LDS_K + hi * 1024 + r32 * 16;
    DMA_K(0, 0); DMA_V(0, 0); DMA_K(1, SLOTB);
    bf16x8 qr[4];
#pragma unroll
    for (int d0 = 0; d0 < 4; ++d0) qr[d0] = *reinterpret_cast<const bf16x8*>(&Qw[(long)r32 * a.ldq + d0 * 16 + hi * 8]);
    float l_reg = 0.f; f32x16 o[2]; o[0] = f32x16{}; o[1] = f32x16{};
    f32x16 nmh16 = f32x16{}; A6_PIN(nmh16);
    bool resc = false;
    f32x16 pA0, pA1, pB0, pB1; bf16x8 kf[8]; s16x4 vlo[8], vhi[8]; u32x4 pw0, pw1, pw2, pw3;
    int sl_prev = 0, sl_cur = 0, sl_next = SLOTB;
#define ROT() do { sl_prev = sl_cur; sl_cur = sl_next; sl_next = (sl_next == 2 * SLOTB) ? 0 : sl_next + SLOTB; } while (0)
#define EX(v) __builtin_amdgcn_exp2f(v)
#define RESC() do { if (resc) { _Pragma("unroll") for (int d_ = 0; d_ < 2; ++d_) _Pragma("unroll") for (int r = 0; r < 16; ++r) o[d_][r] *= wsf[crow(r, hi)]; } } while (0)
    DMA_K(2, 2 * SLOTB);
    A6_WAIT_BAR(3);
    _Pragma("unroll") for (int d0 = 0; d0 < 4; ++d0) kload2(kf, kp0, d0);
    pA0 = A6_MFMA(kf[0], qr[0], nmh16); pA1 = A6_MFMA(kf[1], qr[0], nmh16); pA0 = A6_MFMA(kf[2], qr[1], pA0); pA1 = A6_MFMA(kf[3], qr[1], pA1);
    pA0 = A6_MFMA(kf[4], qr[2], pA0); pA1 = A6_MFMA(kf[5], qr[2], pA1); pA0 = A6_MFMA(kf[6], qr[3], pA0); pA1 = A6_MFMA(kf[7], qr[3], pA1);
    { const float rm = rowmax(pA0, pA1);
#pragma unroll
      for (int r = 0; r < 16; ++r) { nmh16[r] = -rm; pA0[r] = EX(pA0[r] - rm); pA1[r] = EX(pA1[r] - rm); } }
    A6_WAIT_BAR(0);
    DMA_K(3, 0); DMA_V(1, SLOTB); ROT();
    _Pragma("unroll") for (int d0 = 0; d0 < 4; ++d0) kload2(kf, kp0 + sl_cur, d0);
    A6_WAIT_BAR(2);
#define PKW(P, i) cvtpk(P[i], P[i + 1])
#define PAF(k) __builtin_bit_cast(bf16x8, pw##k)
#define VFR(i) (bf16x8){vlo[i][0], vlo[i][1], vlo[i][2], vlo[i][3], vhi[i][0], vhi[i][1], vhi[i][2], vhi[i][3]}
#define VRD(i) do { vlo[i] = vtr(vp_ + (((i) >> 2) * 4096 + ((i) & 3) * 1024)); vhi[i] = vtr(vp_ + (((i) >> 2) * 4096 + ((i) & 3) * 1024 + 512)); } while (0)
#define KRD(G, d0) do { if (G) { kload2(kf, kp0 + sl_next, d0); A6_SBAR(); } } while (0)
#define GAPA(MF, a0, a1, a2, a3, W0, W1, PW) do { MF; sacc += a0; sacc += a1; sacc += a2; sacc += a3; W0; W1; A6_PIN(PW); A6_PIN(sacc); A6_SBAR(); } while (0)
#define GAPB(MF, X, i) do { MF; X[i] = EX(X[i]); X[i + 1] = EX(X[i + 1]); X[i + 2] = EX(X[i + 2]); X[i + 3] = EX(X[i + 3]); A6_PIN(X); A6_SBAR(); } while (0)
#define STEP(C0, C1, P0, P1, t, GK, GV, GL) do { A6_SBAR(); \
    const lds_cptr vp_ = vp0 + sl_prev; \
    VRD(0); A6_SBAR(); float sacc = P0[0] + P0[1]; \
                       GAPA(C0 = A6_MFMA(kf[0], qr[0], nmh16), P0[2], P0[3], P0[4], P0[5],     pw0[0] = PKW(P0, 0),  pw0[1] = PKW(P0, 2),  pw0); \
    VRD(4); A6_SBAR(); GAPA(C1 = A6_MFMA(kf[1], qr[0], nmh16), P0[6], P0[7], P0[8], P0[9],     pw0[2] = PKW(P0, 4),  pw0[3] = PKW(P0, 6),  pw0); \
    VRD(1); A6_SBAR(); GAPA(C0 = A6_MFMA(kf[2], qr[1], C0),    P0[10], P0[11], P0[12], P0[13], pw1[0] = PKW(P0, 8),  pw1[1] = PKW(P0, 10), pw1); \
    VRD(5); A6_SBAR(); GAPA(C1 = A6_MFMA(kf[3], qr[1], C1),    P0[14], P0[15], P1[0], P1[1],   pw1[2] = PKW(P0, 12), pw1[3] = PKW(P0, 14), pw1); \
    VRD(2); A6_SBAR(); GAPA(C0 = A6_MFMA(kf[4], qr[2], C0),    P1[2], P1[3], P1[4], P1[5],     pw2[0] = PKW(P1, 0),  pw2[1] = PKW(P1, 2),  pw2); \
    VRD(6); A6_SBAR(); GAPA(C1 = A6_MFMA(kf[5], qr[2], C1),    P1[6], P1[7], P1[8], P1[9],     pw2[2] = PKW(P1, 4),  pw2[3] = PKW(P1, 6),  pw2); \
    VRD(3); A6_SBAR(); GAPA(C0 = A6_MFMA(kf[6], qr[3], C0),    P1[10], P1[11], P1[12], P1[13], pw3[0] = PKW(P1, 8),  pw3[1] = PKW(P1, 10), pw3); \
    VRD(7); A6_SBAR(); GAPA(C1 = A6_MFMA(kf[7], qr[3], C1),    P1[14], P1[15], 0.f, 0.f,       pw3[2] = PKW(P1, 12), pw3[3] = PKW(P1, 14), pw3); \
    l_reg += sacc; \
    if (GK) DMA_K((t) + 3, sl_cur); if (GV) DMA_V((t) + 1, sl_next); \
    { const float rm = rowmax(C0, C1); resc = false; \
      if (__builtin_expect(__any(rm > THR), 0)) { const float dl = __builtin_fmaxf(rm, 0.f); \
          _Pragma("unroll") for (int r_ = 0; r_ < 16; ++r_) { nmh16[r_] -= dl; C0[r_] -= dl; C1[r_] -= dl; } \
          const float f = __builtin_amdgcn_exp2f(-dl); l_reg *= f; if (hi == 0) wsf[r32] = f; resc = true; } } \
    A6_SBAR(); \
    GAPB(o[0] = A6_MFMA(PAF(0), VFR(0), o[0]), C0, 0);              GAPB(o[1] = A6_MFMA(PAF(0), VFR(4), o[1]), C0, 4); \
    KRD(GL, 0); GAPB(o[0] = A6_MFMA(PAF(1), VFR(1), o[0]), C0, 8);  KRD(GL, 1); GAPB(o[1] = A6_MFMA(PAF(1), VFR(5), o[1]), C0, 12); \
    KRD(GL, 2); GAPB(o[0] = A6_MFMA(PAF(2), VFR(2), o[0]), C1, 0);  KRD(GL, 3); GAPB(o[1] = A6_MFMA(PAF(2), VFR(6), o[1]), C1, 4); \
    GAPB(o[0] = A6_MFMA(PAF(3), VFR(3), o[0]), C1, 8);              GAPB(o[1] = A6_MFMA(PAF(3), VFR(7), o[1]), C1, 12); \
    } while (0)
    int t = 1;
    for (; t + 5 < NT; t += 2) {
        STEP(pB0, pB1, pA0, pA1, t, true, true, true);     A6_WAIT_BAR(2); RESC(); ROT();
        STEP(pA0, pA1, pB0, pB1, t + 1, true, true, true); A6_WAIT_BAR(2); RESC(); ROT();
    }
#define ENDW(tt) do { if ((tt) + 3 < NT) { A6_WAIT_BAR(2); } else if ((tt) + 2 < NT) { A6_WAIT_BAR(1); } else { A6_WAIT_BAR(0); } } while (0)
    for (; t + 1 < NT; t += 2) {
        STEP(pB0, pB1, pA0, pA1, t, (t + 3 < NT), (t + 1 < NT), (t + 1 < NT));         ENDW(t);     RESC(); ROT();
        STEP(pA0, pA1, pB0, pB1, t + 1, (t + 4 < NT), (t + 2 < NT), (t + 2 < NT));     ENDW(t + 1); RESC(); ROT();
    }
    STEP(pB0, pB1, pA0, pA1, NT - 1, false, false, false); RESC();
    { float sacc = pB0[0] + pB0[1];
#pragma unroll
      for (int r = 2; r < 16; ++r) sacc += pB0[r];
#pragma unroll
      for (int r = 0; r < 16; ++r) sacc += pB1[r];
      l_reg += sacc;
      pw0 = (u32x4){PKW(pB0, 0), PKW(pB0, 2), PKW(pB0, 4), PKW(pB0, 6)}; pw1 = (u32x4){PKW(pB0, 8), PKW(pB0, 10), PKW(pB0, 12), PKW(pB0, 14)};
      pw2 = (u32x4){PKW(pB1, 0), PKW(pB1, 2), PKW(pB1, 4), PKW(pB1, 6)}; pw3 = (u32x4){PKW(pB1, 8), PKW(pB1, 10), PKW(pB1, 12), PKW(pB1, 14)};
      const lds_cptr vp_ = vp0 + sl_cur; _Pragma("unroll") for (int i = 0; i < 8; ++i) VRD(i);
      o[0] = A6_MFMA(PAF(0), VFR(0), o[0]); o[1] = A6_MFMA(PAF(0), VFR(4), o[1]); o[0] = A6_MFMA(PAF(1), VFR(1), o[0]); o[1] = A6_MFMA(PAF(1), VFR(5), o[1]);
      o[0] = A6_MFMA(PAF(2), VFR(2), o[0]); o[1] = A6_MFMA(PAF(2), VFR(6), o[1]); o[0] = A6_MFMA(PAF(3), VFR(3), o[0]); o[1] = A6_MFMA(PAF(3), VFR(7), o[1]); }
    { auto rr = __builtin_amdgcn_permlane32_swap(__float_as_uint(l_reg), __float_as_uint(l_reg), false, false); l_reg = __uint_as_float(rr[0]) + __uint_as_float(rr[1]); }
    if (hi == 0) wsf[32 + r32] = l_reg; asm volatile("s_waitcnt lgkmcnt(0)" ::: "memory");
    if (a.lse != nullptr && hi == 0) a.lse[wid * QBLK + r32] = __builtin_amdgcn_logf(l_reg) - nmh16[0];
    float rli[16];
#pragma unroll
    for (int r = 0; r < 16; ++r) rli[r] = __builtin_amdgcn_rcpf(wsf[32 + crow(r, hi)]);
    bf16* Ow = a.O + (long)(wid * QBLK) * a.ldo; unsigned short* stg = (unsigned short*)(lds + LDS_OST) + wid * 2048;
#pragma unroll
    for (int r = 0; r < 16; ++r) { const int orow = crow(r, hi);
#pragma unroll
        for (int d0 = 0; d0 < 2; ++d0) { const float v = o[d0][r] * rli[r]; const unsigned u = __float_as_uint(v); stg[orow * 64 + d0 * 32 + r32] = (unsigned short)((u + 0x7fffu + ((u >> 16) & 1u)) >> 16); } }
    asm volatile("s_waitcnt lgkmcnt(0)" ::: "memory");
#pragma unroll
    for (int i = 0; i < 4; ++i) { const int row = i * 8 + (lane >> 3), ch = lane & 7; *(u32x4*)(Ow + (long)row * a.ldo + ch * 8) = *(const u32x4*)(stg + row * 64 + ch * 8); }
    asm volatile("s_waitcnt lgkmcnt(0)\n\ts_barrier" ::: "memory");
#undef DMA_K
#undef DMA_V
#undef ROT
#undef EX
#undef RESC
#undef PKW
#undef PAF
#undef VFR
#undef VRD
#undef KRD
#undef ENDW
#undef GAPA
#undef GAPB
#undef STEP
}
#undef A6_SBAR
#undef A6_PIN
#undef A6_MFMA
#undef A6_WAIT_BAR
#undef A6_MX3
}

namespace at96 {
using att::bf16; using att::bf16x8; using att::s16x4; using att::f32x16; using att::u32x4;
using at64::crow; using at64::cvtpk; using at64::glds16; using at64::lds_cptr; using at64::kload2; using at64::vtr; using at64::rowmax;
constexpr int NW = 8, QBLK = 32, KVBLK = 64;
constexpr float THR = 8.f;
constexpr int SLOTB = 8192, SLOTR = 4096, LDS_K = 0, LDS_V = 3 * SLOTB, LDS_R = 6 * SLOTB, LDS_WS = LDS_R + 4 * SLOTR, LDS_OST = LDS_WS + NW * 256, LDS_TOT = LDS_OST + NW * 4096;
#define A9_SBAR() __builtin_amdgcn_sched_barrier(0)
#define A9_PIN(x) asm volatile("" : "+v"(x))
#define A9_MFMA(a, b, c) __builtin_amdgcn_mfma_f32_32x32x16_bf16(a, b, c, 0, 0, 0)
#define A9_WAIT_BAR(N) asm volatile("s_waitcnt vmcnt(" #N ") lgkmcnt(0)\n\ts_barrier" ::: "memory")
struct Args { const bf16* Q; int ldq; const bf16* K0; int ldk0; const bf16* K1; int ldk1; const bf16* V; int ldv; bf16* O; int ldo; int nkeys; int rope_t0; const float* tc; const float* ts; };
__device__ __forceinline__ void unit(const Args a, char* lds) {
    const int tid = otid(), lane = tid & 63, r32 = lane & 31, hi = lane >> 5; const int wid = __builtin_amdgcn_readfirstlane(tid >> 6);
    const int NT = a.nkeys / KVBLK;
    const bf16* Qw = a.Q + (long)(wid * QBLK) * a.ldq;
    const unsigned lds0 = (unsigned)(uintptr_t)lds; float* wsf = (float*)(lds + LDS_WS) + wid * 64;
    const bf16* ksrc = a.K0 + (long)lane * a.ldk0 + wid * 8; const long kstep = (long)KVBLK * a.ldk0;
    const bf16* rsrc = a.K1 + (long)(32 * (wid & 1) + r32) * a.ldk1 + (wid >> 1) * 8; const long rstep = (long)KVBLK * a.ldk1;
    const bf16* vsrc = a.V + (long)(16 * (wid & 3) + (lane >> 2)) * a.ldv + (wid >> 2) * 32 + (lane & 3) * 8; const long vstep = (long)KVBLK * a.ldv;
    const unsigned kdst = lds0 + LDS_K + wid * 1024, vdst = lds0 + LDS_V + wid * 1024, rdst = lds0 + LDS_R + (wid >> 1) * 1024 + (wid & 1) * 512;
#define DMA_K(t, slot, rslot) do { glds16(ksrc + (long)(t) * kstep, (unsigned)__builtin_amdgcn_readfirstlane(kdst + (slot))); \
        if (lane < 32) glds16(rsrc + (long)(t) * rstep, (unsigned)__builtin_amdgcn_readfirstlane(rdst + (rslot))); } while (0)
#define DMA_V(t, slot) glds16(vsrc + (long)(t) * vstep, (unsigned)__builtin_amdgcn_readfirstlane(vdst + (slot)))
    const lds_cptr vp0 = (lds_cptr)lds + LDS_V + ((lane >> 4) & 1) * 32 + (lane & 3) * 8 + (4 * hi + ((lane & 15) >> 2)) * 64;
    const lds_cptr kp0 = (lds_cptr)lds + LDS_K + hi * 1024 + r32 * 16;
    const lds_cptr rp0 = (lds_cptr)lds + LDS_R + hi * 1024 + r32 * 16;
    DMA_K(0, 0, 0); DMA_V(0, 0); DMA_K(1, SLOTB, SLOTR);
    bf16x8 qr[6];
#pragma unroll
    for (int d0 = 0; d0 < 6; ++d0) qr[d0] = *reinterpret_cast<const bf16x8*>(&Qw[(long)r32 * a.ldq + d0 * 16 + hi * 8]);
    if (a.rope_t0 >= 0) {
        const int tq = a.rope_t0 + wid * QBLK + r32, pr = (tq >> 6) & 63, pc = tq & 63;
#pragma unroll
        for (int f = 4; f < 6; ++f) { const int pos = (f == 4) ? pr : pc; u32x4 w = *reinterpret_cast<u32x4*>(&qr[f]); u32x4 o_;
            typedef float f32x4_ __attribute__((ext_vector_type(4)));
            const f32x4_ tc0 = *(const f32x4_*)(a.tc + pos * 8), tc1 = *(const f32x4_*)(a.tc + pos * 8 + 4), ts0 = *(const f32x4_*)(a.ts + pos * 8), ts1 = *(const f32x4_*)(a.ts + pos * 8 + 4);
            const float tcv[8] = {tc0[0], tc0[1], tc0[2], tc0[3], tc1[0], tc1[1], tc1[2], tc1[3]}, tsv[8] = {ts0[0], ts0[1], ts0[2], ts0[3], ts1[0], ts1[1], ts1[2], ts1[3]};
#pragma unroll
            for (int e = 0; e < 4; ++e) { const unsigned mine = w[e], oth = (unsigned)__shfl_xor((int)mine, 32);
                const float m0 = __uint_as_float(mine << 16), m1 = __uint_as_float(mine & 0xffff0000u), o0 = __uint_as_float(oth << 16), o1 = __uint_as_float(oth & 0xffff0000u);
                const float c0 = tcv[2 * e], c1 = tcv[2 * e + 1], s0 = tsv[2 * e], s1 = tsv[2 * e + 1];
                const float r0 = (hi == 0) ? m0 * c0 - o0 * s0 : o0 * s0 + m0 * c0, r1 = (hi == 0) ? m1 * c1 - o1 * s1 : o1 * s1 + m1 * c1;
                o_[e] = cvtpk(r0, r1); }
            qr[f] = *reinterpret_cast<bf16x8*>(&o_); } }
    float l_reg = 0.f; f32x16 o[2]; o[0] = f32x16{}; o[1] = f32x16{};
    f32x16 nmh16 = f32x16{}; A9_PIN(nmh16);
    bool resc = false;
    f32x16 pA0, pA1, pB0, pB1; bf16x8 kf[8], kr[4]; s16x4 vlo[8], vhi[8]; u32x4 pw0, pw1, pw2, pw3;
    int sl_prev = 0, sl_cur = 0, sl_next = SLOTB, rs_cur = 0;
#define ROT() do { sl_prev = sl_cur; sl_cur = sl_next; sl_next = (sl_next == 2 * SLOTB) ? 0 : sl_next + SLOTB; rs_cur = (rs_cur + SLOTR) & (4 * SLOTR - 1); } while (0)
#define RS3() ((rs_cur + 3 * SLOTR) & (4 * SLOTR - 1))
#define EX(v) __builtin_amdgcn_exp2f(v)
#define RESC() do { if (resc) { _Pragma("unroll") for (int d_ = 0; d_ < 2; ++d_) _Pragma("unroll") for (int r = 0; r < 16; ++r) o[d_][r] *= wsf[crow(r, hi)]; } } while (0)
    DMA_K(2, 2 * SLOTB, 2 * SLOTR);
    A9_WAIT_BAR(5);
    _Pragma("unroll") for (int d0 = 0; d0 < 4; ++d0) kload2(kf, kp0, d0);
    kload2(kr, rp0, 0); kload2(kr, rp0, 1);
    pA0 = A9_MFMA(kf[0], qr[0], nmh16); pA1 = A9_MFMA(kf[1], qr[0], nmh16); pA0 = A9_MFMA(kf[2], qr[1], pA0); pA1 = A9_MFMA(kf[3], qr[1], pA1);
    pA0 = A9_MFMA(kf[4], qr[2], pA0); pA1 = A9_MFMA(kf[5], qr[2], pA1); pA0 = A9_MFMA(kf[6], qr[3], pA0); pA1 = A9_MFMA(kf[7], qr[3], pA1);
    pA0 = A9_MFMA(kr[0], qr[4], pA0); pA1 = A9_MFMA(kr[1], qr[4], pA1); pA0 = A9_MFMA(kr[2], qr[5], pA0); pA1 = A9_MFMA(kr[3], qr[5], pA1);
    { const float rm = rowmax(pA0, pA1);
#pragma unroll
      for (int r = 0; r < 16; ++r) { nmh16[r] = -rm; pA0[r] = EX(pA0[r] - rm); pA1[r] = EX(pA1[r] - rm); } }
    A9_WAIT_BAR(0);
    DMA_K(3, 0, 3 * SLOTR); DMA_V(1, SLOTB); ROT();
    _Pragma("unroll") for (int d0 = 0; d0 < 4; ++d0) kload2(kf, kp0 + sl_cur, d0);
    A9_WAIT_BAR(3);
#define PKW(P, i) cvtpk(P[i], P[i + 1])
#define PAF(k) __builtin_bit_cast(bf16x8, pw##k)
#define VFR(i) (bf16x8){vlo[i][0], vlo[i][1], vlo[i][2], vlo[i][3], vhi[i][0], vhi[i][1], vhi[i][2], vhi[i][3]}
#define VRD(i) do { vlo[i] = vtr(vp_ + (((i) >> 2) * 4096 + ((i) & 3) * 1024)); vhi[i] = vtr(vp_ + (((i) >> 2) * 4096 + ((i) & 3) * 1024 + 512)); } while (0)
#define KRD(G, d0) do { if (G) { kload2(kf, kp0 + sl_next, d0); A9_SBAR(); } } while (0)
#define GAP3(MF, a0, a1, a2, W0, PW) do { MF; sacc += a0; sacc += a1; sacc += a2; W0; A9_PIN(PW); A9_PIN(sacc); A9_SBAR(); } while (0)
#define GAP2(MF, a0, a1, W0, W1, PW) do { MF; sacc += a0; sacc += a1; W0; W1; A9_PIN(PW); A9_PIN(sacc); A9_SBAR(); } while (0)
#define GAPB(MF, X, i) do { MF; X[i] = EX(X[i]); X[i + 1] = EX(X[i + 1]); X[i + 2] = EX(X[i + 2]); X[i + 3] = EX(X[i + 3]); A9_PIN(X); A9_SBAR(); } while (0)
#define STEP(C0, C1, P0, P1, t, GK, GV, GL) do { A9_SBAR(); \
    const lds_cptr vp_ = vp0 + sl_prev; const lds_cptr rp_ = rp0 + rs_cur; \
    VRD(0); kload2(kr, rp_, 0); A9_SBAR(); float sacc = P0[0] + P0[1]; \
                       GAP3(C0 = A9_MFMA(kf[0], qr[0], nmh16), P0[2], P0[3], P0[4],    pw0[0] = PKW(P0, 0), pw0); \
    VRD(4); kload2(kr, rp_, 1); A9_SBAR(); \
                       GAP3(C1 = A9_MFMA(kf[1], qr[0], nmh16), P0[5], P0[6], P0[7],    pw0[1] = PKW(P0, 2), pw0); \
    VRD(1); A9_SBAR(); GAP2(C0 = A9_MFMA(kf[2], qr[1], C0),    P0[8], P0[9],           pw0[2] = PKW(P0, 4), pw0[3] = PKW(P0, 6), pw0); \
    VRD(5); A9_SBAR(); GAP3(C1 = A9_MFMA(kf[3], qr[1], C1),    P0[10], P0[11], P0[12], pw1[0] = PKW(P0, 8), pw1); \
    VRD(2); A9_SBAR(); GAP3(C0 = A9_MFMA(kf[4], qr[2], C0),    P0[13], P0[14], P0[15], pw1[1] = PKW(P0, 10), pw1); \
    VRD(6); A9_SBAR(); GAP2(C1 = A9_MFMA(kf[5], qr[2], C1),    P1[0], P1[1],           pw1[2] = PKW(P0, 12), pw1[3] = PKW(P0, 14), pw1); \
    VRD(3); A9_SBAR(); GAP3(C0 = A9_MFMA(kf[6], qr[3], C0),    P1[2], P1[3], P1[4],    pw2[0] = PKW(P1, 0), pw2); \
    VRD(7); A9_SBAR(); GAP3(C1 = A9_MFMA(kf[7], qr[3], C1),    P1[5], P1[6], P1[7],    pw2[1] = PKW(P1, 2), pw2); \
                       GAP2(C0 = A9_MFMA(kr[0], qr[4], C0),    P1[8], P1[9],           pw2[2] = PKW(P1, 4), pw2[3] = PKW(P1, 6), pw2); \
                       GAP3(C1 = A9_MFMA(kr[1], qr[4], C1),    P1[10], P1[11], P1[12], pw3[0] = PKW(P1, 8), pw3); \
                       GAP3(C0 = A9_MFMA(kr[2], qr[5], C0),    P1[13], P1[14], P1[15], pw3[1] = PKW(P1, 10), pw3); \
                       GAP2(C1 = A9_MFMA(kr[3], qr[5], C1),    0.f, 0.f,               pw3[2] = PKW(P1, 12), pw3[3] = PKW(P1, 14), pw3); \
    l_reg += sacc; \
    if (GK) DMA_K((t) + 3, sl_cur, RS3()); if (GV) DMA_V((t) + 1, sl_next); \
    { const float rm = rowmax(C0, C1); resc = false; \
      if (__builtin_expect(__any(rm > THR), 0)) { const float dl = __builtin_fmaxf(rm, 0.f); \
          _Pragma("unroll") for (int r_ = 0; r_ < 16; ++r_) { nmh16[r_] -= dl; C0[r_] -= dl; C1[r_] -= dl; } \
          const float f = __builtin_amdgcn_exp2f(-dl); l_reg *= f; if (hi == 0) wsf[r32] = f; resc = true; } } \
    A9_SBAR(); \
    GAPB(o[0] = A9_MFMA(PAF(0), VFR(0), o[0]), C0, 0);              GAPB(o[1] = A9_MFMA(PAF(0), VFR(4), o[1]), C0, 4); \
    KRD(GL, 0); GAPB(o[0] = A9_MFMA(PAF(1), VFR(1), o[0]), C0, 8);  KRD(GL, 1); GAPB(o[1] = A9_MFMA(PAF(1), VFR(5), o[1]), C0, 12); \
    KRD(GL, 2); GAPB(o[0] = A9_MFMA(PAF(2), VFR(2), o[0]), C1, 0);  KRD(GL, 3); GAPB(o[1] = A9_MFMA(PAF(2), VFR(6), o[1]), C1, 4); \
    GAPB(o[0] = A9_MFMA(PAF(3), VFR(3), o[0]), C1, 8);              GAPB(o[1] = A9_MFMA(PAF(3), VFR(7), o[1]), C1, 12); \
    } while (0)
    int t = 1;
    for (; t + 5 < NT; t += 2) {
        STEP(pB0, pB1, pA0, pA1, t, true, true, true);     A9_WAIT_BAR(3); RESC(); ROT();
        STEP(pA0, pA1, pB0, pB1, t + 1, true, true, true); A9_WAIT_BAR(3); RESC(); ROT();
    }
#define ENDW(tt) do { if ((tt) + 3 < NT) { A9_WAIT_BAR(3); } else if ((tt) + 2 < NT) { A9_WAIT_BAR(1); } else { A9_WAIT_BAR(0); } } while (0)
    for (; t + 1 < NT; t += 2) {
        STEP(pB0, pB1, pA0, pA1, t, (t + 3 < NT), (t + 1 < NT), (t + 1 < NT));         ENDW(t);     RESC(); ROT();
        STEP(pA0, pA1, pB0, pB1, t + 1, (t + 4 < NT), (t + 2 < NT), (t + 2 < NT));     ENDW(t + 1); RESC(); ROT();
    }
    STEP(pB0, pB1, pA0, pA1, NT - 1, false, false, false); RESC();
    { float sacc = pB0[0] + pB0[1];
#pragma unroll
      for (int r = 2; r < 16; ++r) sacc += pB0[r];
#pragma unroll
      for (int r = 0; r < 16; ++r) sacc += pB1[r];
      l_reg += sacc;
      pw0 = (u32x4){PKW(pB0, 0), PKW(pB0, 2), PKW(pB0, 4), PKW(pB0, 6)}; pw1 = (u32x4){PKW(pB0, 8), PKW(pB0, 10), PKW(pB0, 12), PKW(pB0, 14)};
      pw2 = (u32x4){PKW(pB1, 0), PKW(pB1, 2), PKW(pB1, 4), PKW(pB1, 6)}; pw3 = (u32x4){PKW(pB1, 8), PKW(pB1, 10), PKW(pB1, 12), PKW(pB1, 14)};
      const lds_cptr vp_ = vp0 + sl_cur; _Pragma("unroll") for (int i = 0; i < 8; ++i) VRD(i);
      o[0] = A9_MFMA(PAF(0), VFR(0), o[0]); o[1] = A9_MFMA(PAF(0), VFR(4), o[1]); o[0] = A9_MFMA(PAF(1), VFR(1), o[0]); o[1] = A9_MFMA(PAF(1), VFR(5), o[1]);
      o[0] = A9_MFMA(PAF(2), VFR(2), o[0]); o[1] = A9_MFMA(PAF(2), VFR(6), o[1]); o[0] = A9_MFMA(PAF(3), VFR(3), o[0]); o[1] = A9_MFMA(PAF(3), VFR(7), o[1]); }
    { auto rr = __builtin_amdgcn_permlane32_swap(__float_as_uint(l_reg), __float_as_uint(l_reg), false, false); l_reg = __uint_as_float(rr[0]) + __uint_as_float(rr[1]); }
    if (hi == 0) wsf[32 + r32] = l_reg; asm volatile("s_waitcnt lgkmcnt(0)" ::: "memory");
    float rli[16];
#pragma unroll
    for (int r = 0; r < 16; ++r) rli[r] = __builtin_amdgcn_rcpf(wsf[32 + crow(r, hi)]);
    bf16* Ow = a.O + (long)(wid * QBLK) * a.ldo; unsigned short* stg = (unsigned short*)(lds + LDS_OST) + wid * 2048;
#pragma unroll
    for (int r = 0; r < 16; ++r) { const int orow = crow(r, hi);
#pragma unroll
        for (int d0 = 0; d0 < 2; ++d0) { const float v = o[d0][r] * rli[r]; const unsigned u = __float_as_uint(v); stg[orow * 64 + d0 * 32 + r32] = (unsigned short)((u + 0x7fffu + ((u >> 16) & 1u)) >> 16); } }
    asm volatile("s_waitcnt lgkmcnt(0)" ::: "memory");
#pragma unroll
    for (int i = 0; i < 4; ++i) { const int row = i * 8 + (lane >> 3), ch = lane & 7; *(u32x4*)(Ow + (long)row * a.ldo + ch * 8) = *(const u32x4*)(stg + row * 64 + ch * 8); }
    asm volatile("s_waitcnt lgkmcnt(0)\n\ts_barrier" ::: "memory");
#undef DMA_K
#undef DMA_V
#undef ROT
#undef RS3
#undef EX
#undef RESC
#undef PKW
#undef PAF
#undef VFR
#undef VRD
#undef KRD
#undef ENDW
#undef GAP3
#undef GAP2
#undef GAPB
#undef STEP
}
#undef A9_SBAR
#undef A9_PIN
#undef A9_MFMA
#undef A9_WAIT_BAR
}

constexpr size_t MiB = 1u << 20;
constexpr size_t WS_CTL = 0, CTL_BYTES = 1 * MiB;
constexpr size_t WS_MOD = 1 * MiB;
constexpr size_t WS_T16C = WS_MOD + 256 * 1024, WS_T16S = WS_T16C + 4096, WS_T8C = WS_T16S + 4096, WS_T8S = WS_T8C + 2048;
constexpr size_t WS_RSQ = WS_MOD + 320 * 1024, WS_RSKV = WS_RSQ + 64 * 1024;
constexpr size_t WS_TAB = WS_MOD + 512 * 1024;
constexpr size_t WS_WT = 3 * MiB;
constexpr size_t WT_IN = 0, WT_G = WT_IN + (size_t)PPW * DM * 2, WT_QU = WT_G + (size_t)NGATE * DM * 2, WT_KVU = WT_QU + (size_t)768 * 384 * 2, WT_BR = WT_KVU + (size_t)1024 * 256 * 2,
                 WT_OUT = WT_BR + (size_t)3 * DM * 512 * 2, WT_F1 = WT_OUT + (size_t)DM * DM * 2, WT_F2 = WT_F1 + (size_t)DFF * DM * 2, WT_END = WT_F2 + (size_t)DM * DFF * 2;
static_assert(WT_END <= 36 * MiB, "weights");
constexpr size_t WS_CTXX = WS_WT + 36 * MiB;
constexpr size_t WS_XN = WS_CTXX + 4 * MiB;
constexpr size_t WS_HALF = WS_XN + 34 * MiB;
constexpr int NUNIT = 32 * (RPB / 32);
constexpr int KVP = 1088;
constexpr size_t H_PP = 0, H_QM = H_PP + (size_t)HM * PPW * 2, H_KVM = H_QM + (size_t)HM * 768 * 2, H_MO = H_KVM + (size_t)HM * KVP * 2, H_PHI = H_MO + (size_t)HM * 512 * 2,
                 H_PSI = H_PHI + (size_t)NUNIT * 8192, H_GC = H_PSI + (size_t)NUNIT * 8192, H_END = H_GC;
constexpr size_t WS_END = WS_HALF + H_END;
static_assert(WS_END + 12 * MiB <= 256 * MiB, "workspace (the 12 MiB after WS_END hold transient scratch: pass-3 parking / split-K slabs)");
constexpr size_t WS_GB = WS_HALF + H_PHI, WS_MIX = WS_GB + (size_t)HM * 3 * DM * 2;
constexpr size_t WS_G0 = WS_HALF + H_KVM, WS_G1 = WS_HALF + H_PHI, WS_G2 = WS_G1 + (size_t)HM * DM * 2;
static_assert(WS_G2 + (size_t)HM * DM * 2 <= WS_HALF + H_PSI, "gate buffers");
constexpr size_t WS_HID = WS_HALF;
static_assert(WS_MIX + (size_t)HM * DM * 2 <= WS_HALF + H_GC && WS_HID + (size_t)MROWS * DFF * 2 <= WS_END, "overlays");
constexpr size_t WS_SPLIT = WS_END + 8 * MiB; constexpr int SPLIT_BYTES = 32768 + 1024;
static_assert(16 * 4 * SPLIT_BYTES <= 4 * MiB, "split scratch");
constexpr int CW_BAR = 4096, CW_ATT = 16384;

#define GAS __attribute__((address_space(1)))
#define LAS __attribute__((address_space(3)))
typedef unsigned short bf16;
typedef unsigned v4u __attribute__((ext_vector_type(4)));
typedef float f32x4 __attribute__((ext_vector_type(4)));
typedef float f32x8 __attribute__((ext_vector_type(8)));
#define LDS_WAIT() asm volatile("s_waitcnt lgkmcnt(0)" ::: "memory")
__device__ __forceinline__ unsigned f2bf(float f) { unsigned u = __builtin_bit_cast(unsigned, f); return (u + 0x7fffu + ((u >> 16) & 1u)) >> 16; }
__device__ __forceinline__ unsigned pk2(float lo, float hi) { return f2bf(lo) | (f2bf(hi) << 16); }
__device__ __forceinline__ float bf2f(unsigned short h) { return __uint_as_float((unsigned)h << 16); }

#define XB_TMO      128
#define XB_XCNT(j)  (256  + 64 * (j))
#define XB_XSUB(j)  (1280 + 64 * (j))
#define XB_XGEN(j)  (2304 + 64 * (j))
#define XB_TOP      3328
#define XB_TOPGEN   3392
#define XCD_BAR_WORDS 3456
#define XB_SPIN_CAP (1u << 22)
__device__ __forceinline__ unsigned xb_ld(unsigned* p)              { return __hip_atomic_load(p, __ATOMIC_RELAXED, __HIP_MEMORY_SCOPE_AGENT); }
__device__ __forceinline__ unsigned xb_add(unsigned* p, unsigned v) { return __hip_atomic_fetch_add(p, v, __ATOMIC_RELAXED, __HIP_MEMORY_SCOPE_AGENT); }
__device__ __forceinline__ unsigned xb_xcc_id() { return (unsigned)__builtin_amdgcn_s_getreg((3 << 11) | 20) & 0xFu; }
#define XB_SPIN(cond, bar) do { unsigned _sp = 0; while (cond) { __builtin_amdgcn_s_sleep(1); \
    if ((++_sp & 255u) == 0u) { if (xb_ld(&(bar)[XB_TMO])) break; if (_sp > XB_SPIN_CAP) { atomicAdd(&(bar)[XB_TMO], 1u); break; } } } } while (0)
struct XcdBarrier { unsigned* bar; unsigned x; volatile LAS unsigned* st; };
__device__ __forceinline__ XcdBarrier xcd_barrier_post(unsigned* bar, volatile LAS unsigned* st) {
    XcdBarrier b; b.bar = bar; b.x = xb_xcc_id(); b.st = st;
    if (threadIdx.x == 0) (void)xb_add(&bar[XB_XCNT(b.x)], 1u);
    return b;
}
__device__ __forceinline__ void xcd_barrier_complete(unsigned* bar, unsigned x, unsigned& nloc, unsigned& nx) {
    const unsigned G = gridDim.x * gridDim.y * gridDim.z;
    unsigned sum, cnt, mine, sp = 0u;
    for (;;) {
        sum = 0u; cnt = 0u; mine = 0u;
#pragma unroll
        for (unsigned j = 0; j < 16; ++j) { const unsigned c = xb_ld(&bar[XB_XCNT(j)]); sum += c; cnt += (c > 0u) ? 1u : 0u; mine = (j == x) ? c : mine; }
        if (sum == G) break;
        __builtin_amdgcn_s_sleep(1);
        if ((++sp & 255u) == 0u) { if (xb_ld(&bar[XB_TMO])) break; if (sp > XB_SPIN_CAP) { atomicAdd(&bar[XB_TMO], 1u); break; } }
    }
    nloc = mine > 0u ? mine : 1u; nx = cnt > 0u ? cnt : 1u;
}
__device__ __forceinline__ void xcd_barrier(const XcdBarrier& b) {
    asm volatile("s_waitcnt vmcnt(0)" ::: "memory");
    __syncthreads();
    if (threadIdx.x == 0) {
        unsigned* bar = b.bar; asm volatile("" : "+s"(bar));
        __builtin_amdgcn_s_waitcnt(0);
        unsigned nloc = b.st[0], nx = b.st[1];
        if (nloc == 0u) { xcd_barrier_complete(bar, b.x, nloc, nx); b.st[0] = nloc; b.st[1] = nx; }
        const unsigned old = xb_add(&bar[XB_XSUB(b.x)], 1u);
        const unsigned gen = old / nloc;
        if (old + 1u == (gen + 1u) * nloc) {
            __builtin_amdgcn_fence(__ATOMIC_RELEASE, "agent");
            asm volatile("s_waitcnt vmcnt(0)" ::: "memory");
            const unsigned og = xb_add(&bar[XB_TOP], 1u);
            const unsigned tg = og / nx;
            if (og + 1u == (tg + 1u) * nx) xb_add(&bar[XB_TOPGEN], 1u);
            else XB_SPIN(xb_ld(&bar[XB_TOPGEN]) == tg, bar);
            __builtin_amdgcn_fence(__ATOMIC_ACQUIRE, "agent");
            xb_add(&bar[XB_XGEN(b.x)], 1u);
            asm volatile("s_waitcnt vmcnt(0)" ::: "memory");
        } else {
            XB_SPIN(xb_ld(&bar[XB_XGEN(b.x)]) == gen, bar);
            __builtin_amdgcn_fence(__ATOMIC_ACQUIRE, "agent");
            asm volatile("s_waitcnt vmcnt(0)" ::: "memory");
        }
    }
    __syncthreads();
}

constexpr int NWAVES = 8, RING_BYTES = 131072, LDS_BYTES = 163840, MISC_OFF = LDS_BYTES - 512;
struct Args { const float* in[31]; float* out; unsigned char* ws; int ph_lo, ph_hi; };
enum { I_X = 0, I_C, I_CTX, I_CCTX, I_WMOD, I_BMOD, I_G1, I_G2, I_WIN, I_QGAIN, I_KGAIN, I_MU, I_W0, I_W2, I_A0, I_A2, I_G2R, I_KK, I_KA, I_RK, I_LNW, I_LNB, I_QNORM, I_QUP, I_KVNORM, I_KVUP, I_WBR, I_WOUT, I_FF1, I_FF2, I_GFIN };
#define CAS __attribute__((address_space(4)))
__device__ __forceinline__ const float* inp(int i) { const CAS Args* ap = (const CAS Args*)__builtin_amdgcn_kernarg_segment_ptr(); asm volatile("" : "+s"(ap)); return ap->in[i]; }
struct Frame {
    LAS unsigned char* lds; unsigned char* ldsg;
    unsigned* ctl; unsigned char* ws; float* out;
    int G, bid;
};
#define FTID() otid()
#define FLANE() (otid() & 63)
#define FWAVE() __builtin_amdgcn_readfirstlane(otid() >> 6)
__device__ __forceinline__ float wave_sum(float v) {
#pragma unroll
    for (int o = 1; o < 64; o <<= 1) v += __shfl_xor(v, o);
    return v;
}
__device__ __forceinline__ const float* xrow_ptr(const float* xl, const float* xc, int m) { const int b = m / RPB, s = m % RPB; return (s < CTX) ? xc + (size_t)(b * CTX + s) * DM : xl + (size_t)(b * SEQ + s - CTX) * DM; }

__device__ __forceinline__ void p0_transpose_item(const float* W, int ldw, int col0, int Kd, int N, bf16* WT, const float* kscale, LAS unsigned* scr, int item, int lane, int ldwt) {
    const int nblk = (N + 63) / 64, kb = item / nblk, nb = item % nblk, k0 = 64 * kb, n0 = 64 * nb, c = lane & 15, r4 = lane >> 4;
    const bool valid = n0 + 4 * c < N;
    const int cn = valid ? n0 + 4 * c : N - 4;
    const float vz = valid ? 1.f : 0.f;
#pragma unroll
    for (int i = 0; i < 8; ++i) { const int k = 8 * i + 2 * r4;
        f32x4 a = *(const f32x4*)(W + (size_t)(k0 + k) * ldw + col0 + cn), bq = *(const f32x4*)(W + (size_t)(k0 + k + 1) * ldw + col0 + cn);
        a = a * vz; bq = bq * vz;
        if (kscale) { a = a * kscale[k0 + k]; bq = bq * kscale[k0 + k + 1]; }
#pragma unroll
        for (int e = 0; e < 4; ++e) scr[(4 * c + e) * 33 + (k >> 1)] = pk2(a[e], bq[e]); }
    LDS_WAIT(); asm volatile("" ::: "memory");
#pragma unroll
    for (int t = 0; t < 8; ++t) { const int n = (lane >> 3) + 8 * t, j = lane & 7; const LAS unsigned* p = scr + n * 33 + 4 * j;
        v4u o; o.x = p[0]; o.y = p[1]; o.z = p[2]; o.w = p[3];
        if (n0 + n < N) *(v4u*)(WT + (size_t)(n0 + n) * ldwt + k0 + 8 * j) = o; }
    LDS_WAIT(); asm volatile("" ::: "memory");
}

__device__ __forceinline__ void ph_weights(Frame& F, int l) {
    unsigned char* wt = F.ws + WS_WT;
    if (l == 0) {
        LAS float* sl = (LAS float*)F.lds;
        LAS float* red = (LAS float*)(F.lds + 32768);
        for (int i = FTID(); i < 5 * 1024; i += 512) { const int j = i >> 10, k = i & 1023; const float c = (j < 4) ? inp(I_C)[j * 1024 + k] : inp(I_CCTX)[k]; sl[i] = c / (1.f + __expf(-c)); }
        __syncthreads();
        for (int it = F.bid; it < 2 * 96; it += F.G) {
            const int ll = it / 96, n0 = (it % 96) * 64;
            const float* wm = inp(I_WMOD) + (size_t)ll * 1024 * 6144 + n0 + FLANE();
            float a0 = 0, a1 = 0, a2 = 0, a3 = 0, a4 = 0;
            for (int k0 = FWAVE() * 128; k0 < FWAVE() * 128 + 128; k0 += 64) { float w[64];
#pragma unroll
                for (int u = 0; u < 64; ++u) w[u] = wm[(size_t)(k0 + u) * 6144];
#pragma unroll
                for (int u = 0; u < 64; ++u) { const int k = k0 + u; a0 += sl[k] * w[u]; a1 += sl[1024 + k] * w[u]; a2 += sl[2048 + k] * w[u]; a3 += sl[3072 + k] * w[u]; a4 += sl[4096 + k] * w[u]; } }
            LAS float* r = red + FWAVE() * 320 + FLANE(); r[0] = a0; r[64] = a1; r[128] = a2; r[192] = a3; r[256] = a4;
            __syncthreads();
            if (FTID() < 320) { float s = 0; for (int w = 0; w < 8; ++w) s += red[w * 320 + FTID()]; const int j = FTID() >> 6, n = n0 + (FTID() & 63);
                ((float*)(F.ws + WS_MOD))[(size_t)(ll * 5 + j) * 6144 + n] = s + inp(I_BMOD)[ll * 6144 + n]; }
            __syncthreads();
        }
        if (F.bid == F.G - 1) {
            for (int i = FTID(); i < 64 * 16; i += 512) { const int pos = i >> 4, f = i & 15; const float ang = (float)pos * powf(10000.f, -(float)f / 16.f); ((float*)(F.ws + WS_T16C))[i] = cosf(ang); ((float*)(F.ws + WS_T16S))[i] = sinf(ang); }
            for (int i = FTID(); i < 64 * 8; i += 512) { const int pos = i >> 3, f = i & 7; const float ang = (float)pos * powf(10000.f, -(float)f / 8.f); ((float*)(F.ws + WS_T8C))[i] = cosf(ang); ((float*)(F.ws + WS_T8S))[i] = sinf(ang); }
        }
        __syncthreads();
    }
    {
        bf16* w2P = (bf16*)(F.ws + WS_TAB); bf16* a2B = (bf16*)(F.ws + WS_TAB + 131072); bf16* g2P = (bf16*)(F.ws + WS_TAB + 524288);
        const float* w2 = inp(I_W2) + (size_t)l * 2 * 64 * 512; const float* a2 = inp(I_A2) + (size_t)l * 2 * 64 * 512; const float* g2 = inp(I_G2R) + (size_t)l * 128 * 512;
        const float* mu = inp(I_MU) + (size_t)l * 2 * RWIN;
        bf16* DF = (bf16*)(F.ws + WS_TAB + 655360);
        const int tstride = F.G * 512;
        for (int base = F.bid * 512 + FTID(); base < 196608; base += 2 * tstride) {
            float vw[2], vg[2], vd0[2], vd1[2], va[2], vm0[2], vm1[2];
#pragma unroll
            for (int j = 0; j < 2; ++j) { const int idx0 = base + j * tstride;
                { const int idx = idx0 < 65536 ? idx0 : 65535;
                  { const int dh = idx >> 12, d = dh >> 3, hd = dh & 7, rem = idx & 4095, Ii = rem >> 11, J = (rem >> 10) & 1, S = (rem >> 9) & 1, ln = (rem >> 3) & 63, e = rem & 7;
                    const int i = 32 * Ii + 16 * S + 8 * (e >> 2) + 4 * (ln >> 5) + (e & 3), k = 32 * J + (ln & 31);
                    vw[j] = w2[(size_t)(d * 64 + i) * 512 + hd * 64 + k]; }
                  { const int hd = idx >> 13, rem = idx & 8191, Ii = rem >> 11, Iv = (rem >> 10) & 1, S = (rem >> 9) & 1, ln = (rem >> 3) & 63, e = rem & 7;
                    const int i = 32 * Ii + 16 * S + 8 * (e >> 2) + 4 * (ln >> 5) + (e & 3), v = 32 * Iv + (ln & 31);
                    vg[j] = g2[(size_t)i * 512 + hd * 64 + v]; } }
                { const int idx = idx0 < 60 * 3 * 2 * 64 * 8 ? idx0 : 60 * 3 * 2 * 64 * 8 - 1; const int ln = (idx >> 3) & 63, blk = idx / 3072, r = ln & 31, cc = 32 * blk + r;
                  vd0[j] = mu[cc]; vd1[j] = mu[RWIN + cc]; }
                { const int idx = idx0 < 196608 ? idx0 : 196607; const int dh = idx / 12288, rem = idx % 12288, k = (rem >> 6) & 63, i = rem & 63, d = dh >> 3, hd = dh & 7;
                  va[j] = a2[(size_t)(d * 64 + i) * 512 + hd * 64 + k]; vm0[j] = mu[RW_AD + d * 64 + i]; vm1[j] = mu[RWIN + RW_AD + d * 64 + i]; } }
#pragma unroll
            for (int j = 0; j < 2; ++j) { const int idx = base + j * tstride;
                if (idx < 65536) { w2P[idx] = (bf16)f2bf(vw[j]); g2P[idx] = (bf16)f2bf(vg[j]); }
                if (idx < 60 * 3 * 2 * 64 * 8) { const int e = idx & 7, ln = (idx >> 3) & 63, q = (idx >> 9) & 1, w = (idx >> 10) % 3, r = ln & 31, h = ln >> 5;
                    const float m0 = vd0[j], m1 = vd1[j]; const float cf = (w == 0) ? 1.f - m0 - m1 : (w == 1 ? m0 : m1);
                    DF[idx] = (r == 16 * q + 8 * h + e) ? (bf16)f2bf(cf) : (bf16)0; }
                if (idx < 196608) { const int w = (idx % 12288) >> 12; const float m0 = vm0[j], m1 = vm1[j]; const float cf = (w == 0) ? 1.f - m0 - m1 : (w == 1 ? m0 : m1);
                    a2B[idx] = (bf16)f2bf(va[j] * cf); } } } }
    LAS unsigned* scr = (LAS unsigned*)(F.lds + FWAVE() * 16384);
    const int gw = F.bid * NWAVES + FWAVE(), NGW = F.G * NWAVES;
    const float* win = inp(I_WIN) + (size_t)l * DM * NIN;
    constexpr int I_A = 16 * 53, I_B = 16 * 48, I_C2 = 6 * 12, I_D = 4 * 16, I_E = 8 * 16, I_F = 16 * 16, I_G = 16 * 64, I_H = 64 * 16;
    constexpr int NITEMS = I_A + I_B + I_C2 + I_D + 3 * I_E + I_F + I_G + I_H;
    for (int kr = 0; ; ++kr) {
        const int it = (kr < 2) ? gw + kr * NGW : kr * NGW + (gw + NGW - (192 * NWAVES) % NGW) % NGW;
        if (it >= NITEMS) { if (kr < 2) continue; break; }
        int r = it; const int lane = FLANE();
        if (r < I_A) { p0_transpose_item(win, NIN, 0, DM, 3360, (bf16*)(wt + WT_IN), nullptr, scr, r, lane, DM); continue; } r -= I_A;
        if (r < I_B) { p0_transpose_item(win, NIN, C_GATE, DM, NGATE, (bf16*)(wt + WT_G), nullptr, scr, r, lane, DM); continue; } r -= I_B;
        if (r < I_C2) { p0_transpose_item(inp(I_QUP) + (size_t)l * 384 * 768, 768, 0, 384, 768, (bf16*)(wt + WT_QU), inp(I_QNORM) + l * 384, scr, r, lane, 384); continue; } r -= I_C2;
        if (r < I_D) { p0_transpose_item(inp(I_KVUP) + (size_t)l * 256 * 1024, 1024, 0, 256, 1024, (bf16*)(wt + WT_KVU), inp(I_KVNORM) + l * 256, scr, r, lane, 256); continue; } r -= I_D;
        if (r < 3 * I_E) { const int i = r / I_E; p0_transpose_item(inp(I_WBR) + (size_t)(l * 3 + i) * 512 * DM, DM, 0, 512, DM, (bf16*)(wt + WT_BR) + (size_t)i * DM * 512, nullptr, scr, r % I_E, lane, 512); continue; } r -= 3 * I_E;
        if (r < I_F) { p0_transpose_item(inp(I_WOUT) + (size_t)l * DM * DM, DM, 0, DM, DM, (bf16*)(wt + WT_OUT), nullptr, scr, r, lane, DM); continue; } r -= I_F;
        if (r < I_G) { p0_transpose_item(inp(I_FF1) + (size_t)l * DM * DFF, DFF, 0, DM, DFF, (bf16*)(wt + WT_F1), nullptr, scr, r, lane, DM); continue; } r -= I_G;
        p0_transpose_item(inp(I_FF2) + (size_t)l * DFF * DM, DM, 0, DFF, DM, (bf16*)(wt + WT_F2), nullptr, scr, r, lane, DFF);
    }
    { v4u* z = (v4u*)((bf16*)(wt + WT_IN) + (size_t)3360 * DM); const int nz = 224 * DM * 2 / 16; unsigned z0; asm volatile("v_mov_b32 %0, 0" : "=v"(z0));
      for (int i = F.bid * 512 + FTID(); i < nz; i += F.G * 512) z[i] = (v4u){z0, z0, z0, z0}; }
}

__device__ __forceinline__ void ph_norm(Frame& F, int l, const void* xl, const void* xc, bool src_bf, const float* g, int which, bool skipctx, const float* part = nullptr) {
    const int gw = F.bid * NWAVES + FWAVE(), NGW = F.G * NWAVES;
    const float* mod = (const float*)(F.ws + WS_MOD) + (size_t)l * 5 * 6144;
    bf16* XN = (bf16*)(F.ws + WS_XN);
    f32x4 gg[4];
#pragma unroll
    for (int j = 0; j < 4; ++j) gg[j] = *(const f32x4*)(g + 4 * FLANE() + 256 * j);
#define NORM_NEXT(m_) do { (m_) += NGW; } while ((m_) < MROWS && skipctx && ((m_) % RPB) < CTX)
#define NORM_LOAD(m_, V, SH, SC) do { const int b_ = (m_) / RPB, s_ = (m_) % RPB; const size_t xo_ = (s_ < CTX) ? (size_t)(b_ * CTX + s_) * DM : (size_t)(b_ * SEQ + s_ - CTX) * DM; \
        const f32x4* xr_ = (const f32x4*)((const float*)((s_ < CTX) ? xc : xl) + xo_) + FLANE(); const uint2* xh_ = (const uint2*)((const bf16*)((s_ < CTX) ? xc : xl) + xo_) + FLANE(); \
        const float* mv_ = mod + (size_t)((s_ < CTX) ? 4 : b_) * 6144 + which * 3072 + 4 * FLANE(); \
        if (src_bf) { _Pragma("unroll") for (int j = 0; j < 4; ++j) { const uint2 w_ = xh_[64 * j]; V[j] = (f32x4){pg8::bf_lo(w_.x), pg8::bf_hi(w_.x), pg8::bf_lo(w_.y), pg8::bf_hi(w_.y)}; } } \
        else { _Pragma("unroll") for (int j = 0; j < 4; ++j) V[j] = xr_[64 * j]; } \
        _Pragma("unroll") for (int j = 0; j < 4; ++j) { SH[j] = *(const f32x4*)(mv_ + 256 * j); SC[j] = *(const f32x4*)(mv_ + 1024 + 256 * j); } \
        if (part && s_ < CTX) { _Pragma("unroll") for (int j = 0; j < 4; ++j) { const f32x4* pr_ = (const f32x4*)(part + (size_t)(b_ * CTX + s_) * DM) + FLANE() + 64 * j; V[j] = V[j] + pr_[0] + pr_[262144] + pr_[524288]; } } } while (0)
    int m = gw; if (skipctx && (m % RPB) < CTX) NORM_NEXT(m);
    f32x4 v[4], sh[4], sc[4];
    if (m < MROWS) NORM_LOAD(m, v, sh, sc);
    while (m < MROWS) {
        int mn = m; NORM_NEXT(mn);
        f32x4 vn[4], shn[4], scn[4];
#pragma unroll
        for (int j = 0; j < 4; ++j) { vn[j] = v[j]; shn[j] = sh[j]; scn[j] = sc[j]; }
        if (mn < MROWS) NORM_LOAD(mn, vn, shn, scn);
        asm volatile("" ::: "memory");
        float ss = 0.f;
#pragma unroll
        for (int j = 0; j < 4; ++j) ss += (v[j].x * v[j].x + v[j].y * v[j].y) + (v[j].z * v[j].z + v[j].w * v[j].w);
        const float rstd = 1.f / sqrtf(wave_sum(ss) * (1.f / DM) + NORM_EPS);
        unsigned long long* o8 = (unsigned long long*)(XN + (size_t)m * DM) + FLANE();
#pragma unroll
        for (int j = 0; j < 4; ++j) { const f32x4 y = v[j] * rstd * gg[j] * (sc[j] + 1.0f) + sh[j];
            o8[64 * j] = (unsigned long long)pk2(y.x, y.y) | ((unsigned long long)pk2(y.z, y.w) << 32); }
#pragma unroll
        for (int j = 0; j < 4; ++j) { v[j] = vn[j]; sh[j] = shn[j]; sc[j] = scn[j]; }
        m = mn;
    }
#undef NORM_NEXT
#undef NORM_LOAD
}
__device__ __forceinline__ void ph_final(Frame& F) {
    const int gw = F.bid * NWAVES + FWAVE(), NGW = F.G * NWAVES; const float* g = inp(I_GFIN);
    const bf16* XL = (const bf16*)(F.ws + WS_XN);
    f32x4 gg[4];
#pragma unroll
    for (int j = 0; j < 4; ++j) gg[j] = *(const f32x4*)(g + 4 * FLANE() + 256 * j);
    int m = gw; uint2 w[4];
    if (m < NB * SEQ) { const uint2* xr = (const uint2*)(XL + (size_t)m * DM) + FLANE();
#pragma unroll
        for (int j = 0; j < 4; ++j) w[j] = xr[64 * j]; }
    while (m < NB * SEQ) {
        const int mn = m + NGW; uint2 wn[4];
#pragma unroll
        for (int j = 0; j < 4; ++j) wn[j] = w[j];
        if (mn < NB * SEQ) { const uint2* xr = (const uint2*)(XL + (size_t)mn * DM) + FLANE();
#pragma unroll
            for (int j = 0; j < 4; ++j) wn[j] = xr[64 * j]; }
        asm volatile("" ::: "memory");
        f32x4 v[4]; float ss = 0.f;
#pragma unroll
        for (int j = 0; j < 4; ++j) v[j] = (f32x4){pg8::bf_lo(w[j].x), pg8::bf_hi(w[j].x), pg8::bf_lo(w[j].y), pg8::bf_hi(w[j].y)};
#pragma unroll
        for (int j = 0; j < 4; ++j) ss += (v[j].x * v[j].x + v[j].y * v[j].y) + (v[j].z * v[j].z + v[j].w * v[j].w);
        const float rstd = 1.f / sqrtf(wave_sum(ss) * (1.f / DM) + NORM_EPS);
        f32x4* xo = (f32x4*)(F.out + (size_t)m * DM) + FLANE();
#pragma unroll
        for (int j = 0; j < 4; ++j) xo[64 * j] = v[j] * rstd * gg[j];
#pragma unroll
        for (int j = 0; j < 4; ++j) w[j] = wn[j];
        m = mn;
    }
}

__device__ __forceinline__ void ph_prep(Frame& F, int l, int half) {
    const int gw = F.bid * NWAVES + FWAVE(), NGW = F.G * NWAVES, lane = FLANE();
    bf16* PP = (bf16*)(F.ws + WS_HALF + H_PP);
    const float* t16c = (const float*)(F.ws + WS_T16C); const float* t16s = (const float*)(F.ws + WS_T16S); const float* t8c = (const float*)(F.ws + WS_T8C); const float* t8s = (const float*)(F.ws + WS_T8S);
    const float* qg = inp(I_QGAIN) + l * 64; const float* kg = inp(I_KGAIN) + l * 64;
    const bool skew = NGW == 2048; const int wv = FWAVE(); const bool third = skew && F.bid < 64 && wv < 4;
    const int wp = !skew ? gw : third ? -1 : (F.bid < 64 ? F.bid * 4 + (wv - 4) : 256 + (F.bid - 64) * 8 + wv), NWP = skew ? NGW - 256 : NGW;
    const int j = lane & 7, f0 = 8 * (j & 1);
    const f32x4 gq0 = *(const f32x4*)(qg + j * 8), gq1 = *(const f32x4*)(qg + j * 8 + 4), gk0 = *(const f32x4*)(kg + j * 8), gk1 = *(const f32x4*)(kg + j * 8 + 4);
    for (int m = wp; m < HM; m += NWP) {
        if (wp < 0) break;
        const int s = m % RPB; const bool lat = s >= CTX; const int tt = s - CTX, pr = (tt >> 6) & 63, pc = tt & 63;
        bf16* row = PP + (size_t)m * PPW;
        bf16* pq = row + C_GQ + lane * 8; bf16* pk = row + C_GK + (lane & 15) * 8; bf16* pkr = row + C_KR + (lane & 3) * 8;
        const int pos16 = lat ? ((j < 4) ? pr : pc) : 0, pos8 = lat ? (((lane & 3) < 2) ? pr : pc) : 0;
        const v4u wq = *(const v4u*)pq, wk = *(const v4u*)pk, wkr = *(const v4u*)pkr;
        const f32x4 c16a = *(const f32x4*)(t16c + pos16 * 16 + f0), c16b = *(const f32x4*)(t16c + pos16 * 16 + f0 + 4), s16a = *(const f32x4*)(t16s + pos16 * 16 + f0), s16b = *(const f32x4*)(t16s + pos16 * 16 + f0 + 4);
        const f32x4 c8a = *(const f32x4*)(t8c + pos8 * 8), c8b = *(const f32x4*)(t8c + pos8 * 8 + 4), s8a = *(const f32x4*)(t8s + pos8 * 8), s8b = *(const f32x4*)(t8s + pos8 * 8 + 4);
        asm volatile("" ::: "memory");
        const float c16[8] = {c16a.x, c16a.y, c16a.z, c16a.w, c16b.x, c16b.y, c16b.z, c16b.w}, s16[8] = {s16a.x, s16a.y, s16a.z, s16a.w, s16b.x, s16b.y, s16b.z, s16b.w};
#pragma unroll
        for (int part = 0; part < 2; ++part) {
            const v4u w = part == 0 ? wq : wk;
            const f32x4 ga = part == 0 ? gq0 : gk0, gb = part == 0 ? gq1 : gk1; const float gain[8] = {ga.x, ga.y, ga.z, ga.w, gb.x, gb.y, gb.z, gb.w};
            float v[8] = {pg8::bf_lo(w.x), pg8::bf_hi(w.x), pg8::bf_lo(w.y), pg8::bf_hi(w.y), pg8::bf_lo(w.z), pg8::bf_hi(w.z), pg8::bf_lo(w.w), pg8::bf_hi(w.w)};
            float ss = 0;
#pragma unroll
            for (int e = 0; e < 8; ++e) ss += v[e] * v[e];
            ss += __shfl_xor(ss, 1); ss += __shfl_xor(ss, 2); ss += __shfl_xor(ss, 4);
            const float rstd = 1.f / sqrtf(ss * (1.f / 64.f) + NORM_EPS);
            const float qs = (part == 0) ? 0.125f * 1.4426950408889634f : 1.f;
#pragma unroll
            for (int e = 0; e < 8; ++e) v[e] = v[e] * (rstd * qs) * gain[e];
            float pv[8];
#pragma unroll
            for (int e = 0; e < 8; ++e) pv[e] = __shfl_xor(v[e], 2);
            if (lat) {
#pragma unroll
                for (int e = 0; e < 8; ++e) { const float c = c16[e], sn = s16[e]; v[e] = ((j & 2) == 0) ? v[e] * c - pv[e] * sn : pv[e] * sn + v[e] * c; } }
            v4u o; o.x = pk2(v[0], v[1]); o.y = pk2(v[2], v[3]); o.z = pk2(v[4], v[5]); o.w = pk2(v[6], v[7]);
            if (part == 0) *(v4u*)pq = o; else if (lane < 16) *(v4u*)pk = o;
        }
        {   const v4u w = wkr; float v[8] = {pg8::bf_lo(w.x), pg8::bf_hi(w.x), pg8::bf_lo(w.y), pg8::bf_hi(w.y), pg8::bf_lo(w.z), pg8::bf_hi(w.z), pg8::bf_lo(w.w), pg8::bf_hi(w.w)};
            const float c8[8] = {c8a.x, c8a.y, c8a.z, c8a.w, c8b.x, c8b.y, c8b.z, c8b.w}, s8[8] = {s8a.x, s8a.y, s8a.z, s8a.w, s8b.x, s8b.y, s8b.z, s8b.w};
            float pv[8];
#pragma unroll
            for (int e = 0; e < 8; ++e) pv[e] = __shfl_xor(v[e], 1);
            if (lat) {
#pragma unroll
                for (int e = 0; e < 8; ++e) { const float c = c8[e], sn = s8[e]; v[e] = ((lane & 1) == 0) ? v[e] * c - pv[e] * sn : pv[e] * sn + v[e] * c; } }
            v4u o; o.x = pk2(v[0], v[1]); o.y = pk2(v[2], v[3]); o.z = pk2(v[4], v[5]); o.w = pk2(v[6], v[7]);
            if (lane < 4) *(v4u*)pkr = o;
        }
    }
}
__device__ __forceinline__ void shifted8(const bf16* PP, int m, int cc0, const float* mu, float (&u)[8]) {
    const int s = m % RPB; const float fp = (s != 0 && s != CTX) ? 1.f : 0.f, fn = (s != CTX - 1 && s != RPB - 1) ? 1.f : 0.f;
    const int mp = m > 0 ? m - 1 : 0, mn = m < HM - 1 ? m + 1 : HM - 1;
    const v4u w = *(const v4u*)(PP + (size_t)m * PPW + C_RW + cc0), wp = *(const v4u*)(PP + (size_t)mp * PPW + C_RW + cc0), wn = *(const v4u*)(PP + (size_t)mn * PPW + C_RW + cc0);
    const f32x4 m0a = *(const f32x4*)(mu + cc0), m0b = *(const f32x4*)(mu + cc0 + 4), m1a = *(const f32x4*)(mu + RWIN + cc0), m1b = *(const f32x4*)(mu + RWIN + cc0 + 4);
    const float c[8] = {pg8::bf_lo(w.x), pg8::bf_hi(w.x), pg8::bf_lo(w.y), pg8::bf_hi(w.y), pg8::bf_lo(w.z), pg8::bf_hi(w.z), pg8::bf_lo(w.w), pg8::bf_hi(w.w)};
    const float a[8] = {pg8::bf_lo(wp.x), pg8::bf_hi(wp.x), pg8::bf_lo(wp.y), pg8::bf_hi(wp.y), pg8::bf_lo(wp.z), pg8::bf_hi(wp.z), pg8::bf_lo(wp.w), pg8::bf_hi(wp.w)};
    const float n[8] = {pg8::bf_lo(wn.x), pg8::bf_hi(wn.x), pg8::bf_lo(wn.y), pg8::bf_hi(wn.y), pg8::bf_lo(wn.z), pg8::bf_hi(wn.z), pg8::bf_lo(wn.w), pg8::bf_hi(wn.w)};
#pragma unroll
    for (int e = 0; e < 8; ++e) { const float m0 = (e < 4 ? m0a[e & 3] : m0b[e & 3]), m1 = (e < 4 ? m1a[e & 3] : m1b[e & 3]); u[e] = c[e] + m0 * (fp * a[e] - c[e]) + m1 * (fn * n[e] - c[e]); }
}
namespace rk {
using bf16x8 = __attribute__((ext_vector_type(8))) short;
using f32x16 = __attribute__((ext_vector_type(16))) float;
using u32x4 = __attribute__((ext_vector_type(4))) unsigned;
typedef float f32x2_t __attribute__((ext_vector_type(2))); typedef __bf16 bf16x2_t __attribute__((ext_vector_type(2)));
#define RK_DI __device__ __forceinline__
RK_DI f32x16 RK_MF(bf16x8 a, bf16x8 b, f32x16 c) { return __builtin_amdgcn_mfma_f32_32x32x16_bf16(a, b, c, 0, 0, 0); }
constexpr int NH = 8;
RK_DI unsigned cvt2(float lo, float hi) { f32x2_t v = {lo, hi}; bf16x2_t b = __builtin_convertvector(v, bf16x2_t); return __builtin_bit_cast(unsigned, b); }
RK_DI float lo16(unsigned w) { return __uint_as_float(w << 16); }
RK_DI float hi16(unsigned w) { return __uint_as_float(w & 0xffff0000u); }
RK_DI int crow(int reg, int h) { return (reg & 3) + 8 * (reg >> 2) + 4 * h; }
RK_DI int krow(int s, int h, int e) { return 16 * s + 8 * (e >> 2) + 4 * h + (e & 3); }
template <int S> RK_DI bf16x8 pack(const f32x16& x) { u32x4 p = {cvt2(x[8 * S], x[8 * S + 1]), cvt2(x[8 * S + 2], x[8 * S + 3]), cvt2(x[8 * S + 4], x[8 * S + 5]), cvt2(x[8 * S + 6], x[8 * S + 7])}; return __builtin_bit_cast(bf16x8, p); }
RK_DI bf16x8 pack8(const float (&u)[8]) { u32x4 p = {cvt2(u[0], u[1]), cvt2(u[2], u[3]), cvt2(u[4], u[5]), cvt2(u[6], u[7])}; return __builtin_bit_cast(bf16x8, p); }
RK_DI void unpack8(bf16x8 v, float (&u)[8]) { const u32x4 p = __builtin_bit_cast(u32x4, v); u[0] = lo16(p.x); u[1] = hi16(p.x); u[2] = lo16(p.y); u[3] = hi16(p.y); u[4] = lo16(p.z); u[5] = hi16(p.z); u[6] = lo16(p.w); u[7] = hi16(p.w); }
constexpr short ONE = (short)0x3F80;
template <int K> RK_DI bf16x8 idn(int r, int h) { bf16x8 v;
#pragma unroll
    for (int e = 0; e < 8; ++e) v[e] = (r == 16 * K + 8 * h + e) ? ONE : (short)0; return v; }
template <int S> RK_DI bf16x8 idp(int r, int h) { bf16x8 v;
#pragma unroll
    for (int e = 0; e < 8; ++e) v[e] = (r == krow(S, h, e)) ? ONE : (short)0; return v; }
RK_DI bf16x8 idn_q(int q, int r, int h) { return q ? idn<1>(r, h) : idn<0>(r, h); }
template <int S, bool STRICT> RK_DI bf16x8 incp(int r, int h, int flip) { bf16x8 v;
#pragma unroll
    for (int e = 0; e < 8; ++e) { const int s = krow(S, h, e); const bool on = flip ? (STRICT ? s > r : s >= r) : (STRICT ? s < r : s <= r); v[e] = on ? ONE : (short)0; } return v; }
template <bool STRICT> RK_DI void tmask(f32x16& g, int r, int h, int flip) {
#pragma unroll
    for (int reg = 0; reg < 16; ++reg) { const int s = crow(reg, h); const bool on = flip ? (STRICT ? s > r : s >= r) : (STRICT ? s < r : s <= r); g[reg] = on ? g[reg] : 0.f; } }
template <int FLIP> RK_DI void solve32(f32x16& x, const bf16x8 (&Mp)[2]) {
    constexpr int F1 = FLIP ? 1 : 0, F2 = 1 - F1;
    f32x16 base = x;
#pragma unroll 1
    for (int it = 0; it < NH; ++it) { const f32x16 t = RK_MF(Mp[F1], pack<F1>(x), base);
#pragma unroll
        for (int e = 0; e < 8; ++e) x[8 * F1 + e] = t[8 * F1 + e]; }
    { const f32x16 t = RK_MF(Mp[F1], pack<F1>(x), base); x = t; base = t; }
#pragma unroll 1
    for (int it = 0; it < NH; ++it) { const f32x16 t = RK_MF(Mp[F2], pack<F2>(x), base);
#pragma unroll
        for (int e = 0; e < 8; ++e) x[8 * F2 + e] = t[8 * F2 + e]; }
}
template <int FLIP> RK_DI void solve32p(f32x16& x, f32x16& y, const bf16x8 (&Mp)[2]) {
    constexpr int F1 = FLIP ? 1 : 0, F2 = 1 - F1;
    f32x16 bx = x, by = y;
#pragma unroll 1
    for (int it = 0; it < NH; ++it) { const f32x16 t = RK_MF(Mp[F1], pack<F1>(x), bx); const f32x16 u = RK_MF(Mp[F1], pack<F1>(y), by);
#pragma unroll
        for (int e = 0; e < 8; ++e) { x[8 * F1 + e] = t[8 * F1 + e]; y[8 * F1 + e] = u[8 * F1 + e]; } }
    { const f32x16 t = RK_MF(Mp[F1], pack<F1>(x), bx); const f32x16 u = RK_MF(Mp[F1], pack<F1>(y), by); x = t; bx = t; y = u; by = u; }
#pragma unroll 1
    for (int it = 0; it < NH; ++it) { const f32x16 t = RK_MF(Mp[F2], pack<F2>(x), bx); const f32x16 u = RK_MF(Mp[F2], pack<F2>(y), by);
#pragma unroll
        for (int e = 0; e < 8; ++e) { x[8 * F2 + e] = t[8 * F2 + e]; y[8 * F2 + e] = u[8 * F2 + e]; } }
}
RK_DI float sigm(float x) { return __builtin_amdgcn_rcpf(1.f + __expf(-x)); }
RK_DI float tanh_f(float x) { return 2.f * __builtin_amdgcn_rcpf(1.f + __expf(-2.f * x)) - 1.f; }

struct Ctx {
    unsigned char* ws; LAS unsigned char* sb; int m0, r, h, hd, dir, l, flip;
    int cofs, dofs;
    int zt;
    int lofs;
    unsigned mp, mn; int rowc, rowp, rown;
};
#define C_PP(c) ((const bf16*)((c).ws + WS_HALF + H_PP))
#define C_MU(c) (inp(I_MU) + (size_t)(c).l * 2 * RWIN)
#define C_W2P(c) ((const bf16*)((c).ws + WS_TAB) + (size_t)((c).dir * 8 + (c).hd) * 4096)
#define C_A2B(c) ((const bf16*)((c).ws + WS_TAB + 131072) + (size_t)((c).dir * 8 + (c).hd) * 3 * 4096)
constexpr int SBUF = 34 * 128;
RK_DI void stage_slice(const Ctx& c, int buf, int cc0) {
    const int lane = c.r + 32 * c.h, p = lane & 7, q4 = lane >> 4;
    const bf16* base = C_PP(c) + (ptrdiff_t)(c.m0 - 1 + (lane >> 3)) * PPW + C_RW + cc0;
    const int oe = (p ^ q4) << 3, oo = (p ^ (4 + q4)) << 3;
#pragma unroll
    for (int j = 0; j < 5; ++j) { const bf16* src = base + (ptrdiff_t)j * 8 * PPW + ((j & 1) ? oo : oe);
        if (j < 4 || lane < 16) __builtin_amdgcn_global_load_lds((const unsigned*)src, (LAS unsigned*)(c.sb + buf * SBUF + j * 1024), 16, 0, 0); }
}
#define RK_WAIT_DMA() asm volatile("s_waitcnt vmcnt(0)" ::: "memory")
#define RK_WAIT_LDS() asm volatile("s_waitcnt lgkmcnt(0)" ::: "memory")
RK_DI bf16x8 rawfrag(const Ctx& c, int buf, int ch, int w) {
    const int rho = c.r + (w == 0 ? 1 : (w == 1 ? 0 : 2)); const unsigned m = (w == 0) ? 0xffffffffu : (w == 1 ? c.mp : c.mn);
    u32x4 v = *(const LAS u32x4*)(c.sb + buf * SBUF + rho * 128 + ((ch ^ ((rho >> 1) & 7)) << 4) + c.zt); v.x &= m; v.y &= m; v.z &= m; v.w &= m; return __builtin_bit_cast(bf16x8, v); }
RK_DI bf16x8 dfrag(const Ctx& c, int cc32, int w, int q) { return *(const bf16x8*)((const bf16*)(c.ws + WS_TAB + 655360) + (((cc32 >> 5) * 3 + w) * 2 + q) * 512 + c.lofs); }
#define RK_PIN6(d) asm volatile("" : "+v"(d[0][0]), "+v"(d[0][1]), "+v"(d[0][2]), "+v"(d[1][0]), "+v"(d[1][1]), "+v"(d[1][2]))
RK_DI f32x16 load_o2(Ctx& c, int buf, int lblk, int cc32) { f32x16 z = f32x16{};
    bf16x8 d[2][3];
#pragma unroll
    for (int q = 0; q < 2; ++q)
#pragma unroll
        for (int w = 0; w < 3; ++w) d[q][w] = dfrag(c, cc32, w, q);
    bf16x8 f[2][3];
#pragma unroll
    for (int q = 0; q < 2; ++q)
#pragma unroll
        for (int w = 0; w < 3; ++w) f[q][w] = rawfrag(c, buf, 4 * lblk + 2 * q + c.h, w);
    RK_PIN6(d); RK_PIN6(f);
#pragma unroll
    for (int q = 0; q < 2; ++q) {
#pragma unroll
        for (int w = 0; w < 3; ++w) z = RK_MF(d[q][w], f[q][w], z); }
    asm volatile("" : "+v"(c.lofs), "+v"(c.zt), "+v"(z));
    return z; }
RK_DI void dpre(const Ctx& c, int cc32, bf16x8 (&d)[2][3]) {
#pragma unroll
    for (int q = 0; q < 2; ++q)
#pragma unroll
        for (int w = 0; w < 3; ++w) d[q][w] = dfrag(c, cc32, w, q);
    __builtin_amdgcn_sched_barrier(0); }
RK_DI f32x16 load_o2p(Ctx& c, int buf, int lblk, bf16x8 (&d)[2][3]) { f32x16 z = f32x16{};
    bf16x8 f[2][3];
#pragma unroll
    for (int q = 0; q < 2; ++q)
#pragma unroll
        for (int w = 0; w < 3; ++w) f[q][w] = rawfrag(c, buf, 4 * lblk + 2 * q + c.h, w);
    RK_PIN6(d); RK_PIN6(f);
#pragma unroll
    for (int q = 0; q < 2; ++q) {
#pragma unroll
        for (int w = 0; w < 3; ++w) z = RK_MF(d[q][w], f[q][w], z); }
    asm volatile("" : "+v"(c.lofs), "+v"(c.zt), "+v"(z));
    return z; }
RK_DI f32x16 load_o1p(Ctx& c, int buf, int lblk, bf16x8 (&d)[2][3]) { f32x16 z = f32x16{};
    bf16x8 f[2][3];
#pragma unroll
    for (int q = 0; q < 2; ++q)
#pragma unroll
        for (int w = 0; w < 3; ++w) f[q][w] = rawfrag(c, buf, 4 * lblk + 2 * q + c.h, w);
    RK_PIN6(d); RK_PIN6(f);
#pragma unroll
    for (int q = 0; q < 2; ++q) {
#pragma unroll
        for (int w = 0; w < 3; ++w) z = RK_MF(f[q][w], d[q][w], z); }
    asm volatile("" : "+v"(c.lofs), "+v"(c.zt), "+v"(z));
    return z; }
RK_DI f32x16 load_o1(Ctx& c, int buf, int lblk, int cc32) { f32x16 z = f32x16{};
    bf16x8 d[2][3];
#pragma unroll
    for (int q = 0; q < 2; ++q)
#pragma unroll
        for (int w = 0; w < 3; ++w) d[q][w] = dfrag(c, cc32, w, q);
    bf16x8 f[2][3];
#pragma unroll
    for (int q = 0; q < 2; ++q)
#pragma unroll
        for (int w = 0; w < 3; ++w) f[q][w] = rawfrag(c, buf, 4 * lblk + 2 * q + c.h, w);
    RK_PIN6(d); RK_PIN6(f);
#pragma unroll
    for (int q = 0; q < 2; ++q) {
#pragma unroll
        for (int w = 0; w < 3; ++w) z = RK_MF(f[q][w], d[q][w], z); }
    asm volatile("" : "+v"(c.lofs), "+v"(c.zt), "+v"(z));
    return z; }

struct Tilde { bf16x8 At[2][2], Bt[2][2], Kt[2][2], Rt[2][2], Vp[2][2]; float gtot[2]; float bon; };
#define RK_STAGE(x) asm volatile("" : "+v"(c.lofs), "+v"(c.zt), "+v"(x))
template <bool NEED_R> RK_DI void build_tilde(Ctx& c, Tilde& T) {
    const int r = c.r, h = c.h;
    stage_slice(c, 0, RW_WD + c.dir * 64); stage_slice(c, 1, RW_K + c.hd * 64); stage_slice(c, 2, RW_AD + c.dir * 64); if constexpr (NEED_R) stage_slice(c, 3, RW_R + c.hd * 64);
    RK_WAIT_DMA();
    bf16x8 lwp[2][2];
    bf16x8 dq0[2][3], dq1[2][3]; dpre(c, RW_WD + c.dir * 64, dq0);
    {   bf16x8 twp[2][2];
#pragma unroll
        for (int Ii = 0; Ii < 2; ++Ii) { if (Ii == 0) dpre(c, RW_WD + c.dir * 64 + 32, dq1); else dpre(c, RW_K + c.hd * 64, dq0);
            f32x16 t = load_o2p(c, 0, Ii, Ii == 0 ? dq0 : dq1);
#pragma unroll
            for (int reg = 0; reg < 16; ++reg) t[reg] = tanh_f(t[reg]);
            twp[Ii][0] = pack<0>(t); twp[Ii][1] = pack<1>(t); RK_STAGE(twp[Ii][1]); }
        float w0v[2];
#pragma unroll
        for (int J = 0; J < 2; ++J) w0v[J] = inp(I_W0)[c.dofs + 32 * J + r];
        __builtin_amdgcn_sched_barrier(0);
#pragma unroll
        for (int J = 0; J < 2; ++J) { f32x16 wl = f32x16{}; bf16x8 wf[2][2];
#pragma unroll
            for (int Ii = 0; Ii < 2; ++Ii)
#pragma unroll
                for (int S = 0; S < 2; ++S) wf[Ii][S] = *(const bf16x8*)(C_W2P(c) + ((Ii * 2 + J) * 2 + S) * 512 + c.lofs);
            asm volatile("" : "+v"(wf[0][0]), "+v"(wf[0][1]), "+v"(wf[1][0]), "+v"(wf[1][1]));
#pragma unroll
            for (int Ii = 0; Ii < 2; ++Ii)
#pragma unroll
                for (int S = 0; S < 2; ++S) wl = RK_MF(twp[Ii][S], wf[Ii][S], wl);
            const float w0 = w0v[J]; float gs = 0.f;
#pragma unroll
            for (int reg = 0; reg < 16; ++reg) wl[reg] = -0.6065306597126334f * sigm(wl[reg] + w0);
            lwp[J][0] = pack<0>(wl); lwp[J][1] = pack<1>(wl);
            { float q[8]; unpack8(lwp[J][0], q);
#pragma unroll
              for (int e = 0; e < 8; ++e) gs += q[e]; unpack8(lwp[J][1], q);
#pragma unroll
              for (int e = 0; e < 8; ++e) gs += q[e]; }
            gs += __shfl_xor(gs, 32); T.gtot[J] = gs; RK_STAGE(lwp[J][1]); } }
    RK_WAIT_LDS(); stage_slice(c, 0, RW_V + c.hd * 64);
    float rinv; f32x16 ktk[2];
    {   float ss = 0.f;
#pragma unroll
        for (int Ik = 0; Ik < 2; ++Ik) { if (Ik == 0) dpre(c, RW_K + c.hd * 64 + 32, dq1);
f32x4 kk_v[4]; { const float* pv_ = inp(I_KK) + c.cofs + 32 * Ik + 4 * h;
  _Pragma("unroll") for (int g = 0; g < 4; ++g) kk_v[g] = *(const f32x4*)(pv_ + 8 * g); }
            __builtin_amdgcn_sched_barrier(0);
            const f32x16 kt = load_o2p(c, 1, Ik, Ik == 0 ? dq0 : dq1); ktk[Ik] = kt;
#pragma unroll
            for (int g = 0; g < 4; ++g) { const f32x4 kk = kk_v[g];
#pragma unroll
                for (int j = 0; j < 4; ++j) { const float q = kt[4 * g + j] * kk[j]; ss += q * q; } }
            RK_STAGE(ss); }
        ss += __shfl_xor(ss, 32); rinv = 1.f / fmaxf(sqrtf(ss), 1e-12f); RK_STAGE(rinv); }
    float bon = 0.f;
#pragma unroll
    for (int Ik = 0; Ik < 2; ++Ik) {
        f32x16 em, ep;
f32x4 kk_v[4]; { const float* pv_ = inp(I_KK) + c.cofs + 32 * Ik + 4 * h;
  _Pragma("unroll") for (int g = 0; g < 4; ++g) kk_v[g] = *(const f32x4*)(pv_ + 8 * g); }
        __builtin_amdgcn_sched_barrier(0);
        { em = RK_MF(lwp[Ik][0], incp<0, false>(r, h, c.flip), f32x16{}); em = RK_MF(lwp[Ik][1], incp<1, false>(r, h, c.flip), em);
          ep = RK_MF(lwp[Ik][0], incp<0, true>(r, h, c.flip), f32x16{}); ep = RK_MF(lwp[Ik][1], incp<1, true>(r, h, c.flip), ep);
#pragma unroll
          for (int reg = 0; reg < 16; ++reg) { em[reg] = __expf(-em[reg]); ep[reg] = __expf(ep[reg]); } }
        RK_STAGE(ep);
        f32x16 kt = ktk[Ik]; f32x16 kn;
#pragma unroll
        for (int g = 0; g < 4; ++g) { const f32x4 kk = kk_v[g];
#pragma unroll
            for (int j = 0; j < 4; ++j) { const int reg = 4 * g + j; kn[reg] = kt[reg] * kk[j] * rinv; ep[reg] = -kn[reg] * ep[reg]; } }
        T.At[Ik][0] = pack<0>(ep); T.At[Ik][1] = pack<1>(ep);
        RK_STAGE(T.At[Ik][1]);
f32x4 a0_v[4]; { const float* pv_ = inp(I_A0) + c.dofs + 32 * Ik + 4 * h;
  _Pragma("unroll") for (int g = 0; g < 4; ++g) a0_v[g] = *(const f32x4*)(pv_ + 8 * g); }
        __builtin_amdgcn_sched_barrier(0);
        f32x16 as = f32x16{};
        bf16x8 af[4];
#pragma unroll
        for (int sp = 0; sp < 4; ++sp) af[sp] = *(const bf16x8*)(C_A2B(c) + (32 * Ik + r) * 64 + 16 * sp + 8 * h);
#pragma unroll
        for (int w = 0; w < 3; ++w) { bf16x8 an[4];
#pragma unroll
            for (int sp = 0; sp < 4; ++sp) an[sp] = af[sp];
            if (w < 2) {
#pragma unroll
                for (int sp = 0; sp < 4; ++sp) an[sp] = *(const bf16x8*)(C_A2B(c) + (w + 1) * 4096 + (32 * Ik + r) * 64 + 16 * sp + 8 * h); }
            __builtin_amdgcn_sched_barrier(0);
            asm volatile("" : "+v"(af[0]), "+v"(af[1]), "+v"(af[2]), "+v"(af[3]));
#pragma unroll
            for (int sp = 0; sp < 4; ++sp) as = RK_MF(af[sp], rawfrag(c, 2, 2 * sp + h, w), as);
            RK_STAGE(as);
#pragma unroll
            for (int sp = 0; sp < 4; ++sp) af[sp] = an[sp]; }
f32x4 ka_v[4]; { const float* pv_ = inp(I_KA) + c.cofs + 32 * Ik + 4 * h;
  _Pragma("unroll") for (int g = 0; g < 4; ++g) ka_v[g] = *(const f32x4*)(pv_ + 8 * g); }
        __builtin_amdgcn_sched_barrier(0);
#pragma unroll
        for (int g = 0; g < 4; ++g) { const f32x4 a0 = a0_v[g];
#pragma unroll
            for (int j = 0; j < 4; ++j) { const int reg = 4 * g + j; as[reg] = sigm(as[reg] + a0[j]); kn[reg] = kn[reg] * as[reg] * em[reg]; } }
        T.Bt[Ik][0] = pack<0>(kn); T.Bt[Ik][1] = pack<1>(kn);
        RK_STAGE(T.Bt[Ik][1]);
        f32x4 rk_v[4]; if constexpr (NEED_R) { const float* pv_ = inp(I_RK) + c.cofs + 32 * Ik + 4 * h;
  _Pragma("unroll") for (int g = 0; g < 4; ++g) rk_v[g] = *(const f32x4*)(pv_ + 8 * g); }
        __builtin_amdgcn_sched_barrier(0);
#pragma unroll
        for (int g = 0; g < 4; ++g) { const f32x4 ka = ka_v[g];
#pragma unroll
            for (int j = 0; j < 4; ++j) { const int reg = 4 * g + j; kt[reg] = kt[reg] * (1.f + (as[reg] - 1.f) * ka[j]); as[reg] = kt[reg] * em[reg]; } }
        T.Kt[Ik][0] = pack<0>(as); T.Kt[Ik][1] = pack<1>(as);
        RK_STAGE(T.Kt[Ik][1]);
        if constexpr (NEED_R) {
            f32x16 rt = load_o2(c, 3, Ik, RW_R + c.hd * 64 + 32 * Ik);
#pragma unroll
            for (int g = 0; g < 4; ++g) { const f32x4 rk = rk_v[g];
#pragma unroll
                for (int j = 0; j < 4; ++j) { const int reg = 4 * g + j; bon += rt[reg] * kt[reg] * rk[j]; rt[reg] = rt[reg] * __builtin_amdgcn_rcpf(em[reg]); } }
            T.Rt[Ik][0] = pack<0>(rt); T.Rt[Ik][1] = pack<1>(rt); RK_STAGE(T.Rt[Ik][1]); }
    }
    T.bon = bon;
    RK_WAIT_DMA();
    dpre(c, RW_V + c.hd * 64, dq0);
#pragma unroll
    for (int J = 0; J < 2; ++J) { if (J == 0) dpre(c, RW_V + c.hd * 64 + 32, dq1);
        const f32x16 va = load_o1p(c, 0, J, J == 0 ? dq0 : dq1); T.Vp[J][0] = pack<0>(va); T.Vp[J][1] = pack<1>(va); RK_STAGE(T.Vp[J][1]); }
}
RK_DI void grams_la(const Ctx& c, const Tilde& T, bf16x8 (&Lk)[2], bf16x8 (&Mp)[2]) {
    f32x16 g = f32x16{}, m = f32x16{};
#pragma unroll
    for (int Ik = 0; Ik < 2; ++Ik)
#pragma unroll
        for (int S = 0; S < 2; ++S) { g = RK_MF(T.Kt[Ik][S], T.At[Ik][S], g); m = RK_MF(T.Bt[Ik][S], T.At[Ik][S], m); }
    tmask<true>(g, c.r, c.h, c.flip); tmask<true>(m, c.r, c.h, c.flip);
    Lk[0] = pack<0>(g); Lk[1] = pack<1>(g); Mp[0] = pack<0>(m); Mp[1] = pack<1>(m);
}
}

namespace rk {
constexpr int NSUB = RPB / 32;
RK_DI int chain_unit(int dir, int j) { return dir == 0 ? j : (j < 8 ? 7 - j : 143 - j); }
RK_DI int chain_pos(int dir, int c) { return dir == 0 ? c : (c < 8 ? 7 - c : 143 - c); }
RK_DI void setup_ctx(Ctx& c, unsigned char* ws, LAS unsigned char* sb, int l, int bl, int hd, int dir, int c32, int lane) {
    c.ws = ws; c.sb = sb; c.m0 = bl * RPB + 32 * c32; c.r = lane & 31; c.h = lane >> 5; c.hd = hd; c.dir = dir; c.l = l; c.flip = dir;
    c.cofs = l * 512 + hd * 64; c.dofs = (l * 2 + dir) * 512 + hd * 64;
    const int m = c.m0 + c.r, sg = m % RPB;
    c.mp = (sg != 0 && sg != CTX) ? 0xffffffffu : 0u; c.mn = (sg != CTX - 1 && sg != RPB - 1) ? 0xffffffffu : 0u;
    c.rowc = m; c.rowp = m > 0 ? m - 1 : 0; c.rown = m < HM - 1 ? m + 1 : HM - 1; c.lofs = (c.r + 32 * c.h) * 8; asm volatile("v_mov_b32 %0, 0" : "=v"(c.zt));
}
RK_DI void pass1_unit(unsigned char* ws, LAS unsigned char* sb, int l, int u, int lane) {
    const int q = u / NSUB, c32 = u % NSUB, bl = q >> 4, hd = (q >> 1) & 7, dir = q & 1;
    Ctx c; setup_ctx(c, ws, sb, l, bl, hd, dir, c32, lane);
    Tilde T; build_tilde<false>(c, T); __builtin_amdgcn_sched_barrier(0);
    const int r = c.r, h = c.h;
    bf16x8 Lk[2], Mp[2]; grams_la(c, T, Lk, Mp); __builtin_amdgcn_sched_barrier(0);
    const bf16x8 P0 = idp<0>(r, h), P1 = idp<1>(r, h);
    bf16x8 W1p[2][2], W2p[2][2], Bop[2][2], Kop[2][2];
#pragma unroll
    for (int J = 0; J < 2; ++J) {
        f32x16 x = RK_MF(T.At[J][0], P0, f32x16{}); x = RK_MF(T.At[J][1], P1, x);
        f32x16 y = RK_MF(Lk[0], T.Vp[J][0], f32x16{}); y = RK_MF(Lk[1], T.Vp[J][1], y);
        if (c.flip) solve32p<1>(x, y, Mp); else solve32p<0>(x, y, Mp);
        W1p[J][0] = pack<0>(x); W1p[J][1] = pack<1>(x);
        W2p[J][0] = pack<0>(y); W2p[J][1] = pack<1>(y);
        const float gcj = __expf(T.gtot[J]);
        f32x16 b = RK_MF(T.Bt[J][0], P0, f32x16{}); b = RK_MF(T.Bt[J][1], P1, b);
        f32x16 k = RK_MF(T.Kt[J][0], P0, f32x16{}); k = RK_MF(T.Kt[J][1], P1, k);
#pragma unroll
        for (int reg = 0; reg < 16; ++reg) { b[reg] *= gcj; k[reg] *= gcj; }
        Bop[J][0] = pack<0>(b); Bop[J][1] = pack<1>(b); Kop[J][0] = pack<0>(k); Kop[J][1] = pack<1>(k);
    }
    u32x4* phi = (u32x4*)(ws + WS_HALF + H_PHI) + (size_t)u * 512 + lane;
    u32x4* psi = (u32x4*)(ws + WS_HALF + H_PSI) + (size_t)u * 512 + lane;
#pragma unroll
    for (int I = 0; I < 2; ++I)
#pragma unroll
        for (int J = 0; J < 2; ++J) {
            f32x16 a = RK_MF(W1p[I][0], Bop[J][0], f32x16{}); a = RK_MF(W1p[I][1], Bop[J][1], a);
            if (I == J) {
#pragma unroll
                for (int reg = 0; reg < 16; ++reg) a[reg] += (crow(reg, h) == r) ? __expf(T.gtot[J]) : 0.f; }
            phi[((I * 2 + J) * 2 + 0) * 64] = __builtin_bit_cast(u32x4, pack<0>(a)); phi[((I * 2 + J) * 2 + 1) * 64] = __builtin_bit_cast(u32x4, pack<1>(a));
            f32x16 p = RK_MF(Bop[I][0], W2p[J][0], f32x16{}); p = RK_MF(Bop[I][1], W2p[J][1], p); p = RK_MF(Kop[I][0], T.Vp[J][0], p); p = RK_MF(Kop[I][1], T.Vp[J][1], p);
            psi[((I * 2 + J) * 2 + 0) * 64] = (u32x4){cvt2(p[0], p[1]), cvt2(p[2], p[3]), cvt2(p[4], p[5]), cvt2(p[6], p[7])};
            psi[((I * 2 + J) * 2 + 1) * 64] = (u32x4){cvt2(p[8], p[9]), cvt2(p[10], p[11]), cvt2(p[12], p[13]), cvt2(p[14], p[15])};
        }
}
RK_DI void pass2_chain(unsigned char* ws, int q, int lane, bool do_store) {
    const int dir = q & 1;
    f32x16 H[2][2] = {{f32x16{}, f32x16{}}, {f32x16{}, f32x16{}}};
    u32x4 phi[8], psi[8];
    { const int u0 = q * NSUB + chain_unit(dir, 0);
      const u32x4* ph = (const u32x4*)(ws + WS_HALF + H_PHI) + (size_t)u0 * 512 + lane; const u32x4* ps = (const u32x4*)(ws + WS_HALF + H_PSI) + (size_t)u0 * 512 + lane;
#pragma unroll
      for (int f = 0; f < 8; ++f) { phi[f] = ph[f * 64]; psi[f] = ps[f * 64]; } }
    int uprev = q * NSUB + chain_unit(dir, 0);
#pragma unroll 1
    for (int j = 0; j < NSUB - 1; ++j) {
        const int un = q * NSUB + chain_unit(dir, j + 1 < NSUB - 1 ? j + 1 : j);
        u32x4 nphi[8], npsi[8];
        { const u32x4* ph = (const u32x4*)(ws + WS_HALF + H_PHI) + (size_t)un * 512 + lane; const u32x4* ps = (const u32x4*)(ws + WS_HALF + H_PSI) + (size_t)un * 512 + lane;
#pragma unroll
          for (int f = 0; f < 8; ++f) { nphi[f] = ph[f * 64]; npsi[f] = ps[f * 64]; } }
        bf16x8 Hp[2][2][2];
#pragma unroll
        for (int I = 0; I < 2; ++I)
#pragma unroll
            for (int J = 0; J < 2; ++J) { Hp[I][J][0] = pack<0>(H[I][J]); Hp[I][J][1] = pack<1>(H[I][J]); }
#pragma unroll
        for (int Ik = 0; Ik < 2; ++Ik)
#pragma unroll
            for (int Jv = 0; Jv < 2; ++Jv) {
                f32x16 a; const u32x4 p0 = psi[(Ik * 2 + Jv) * 2], p1 = psi[(Ik * 2 + Jv) * 2 + 1];
                a[0] = lo16(p0.x); a[1] = hi16(p0.x); a[2] = lo16(p0.y); a[3] = hi16(p0.y); a[4] = lo16(p0.z); a[5] = hi16(p0.z); a[6] = lo16(p0.w); a[7] = hi16(p0.w);
                a[8] = lo16(p1.x); a[9] = hi16(p1.x); a[10] = lo16(p1.y); a[11] = hi16(p1.y); a[12] = lo16(p1.z); a[13] = hi16(p1.z); a[14] = lo16(p1.w); a[15] = hi16(p1.w);
#pragma unroll
                for (int Ip = 0; Ip < 2; ++Ip) { a = RK_MF(__builtin_bit_cast(bf16x8, phi[(Ip * 2 + Ik) * 2 + 0]), Hp[Ip][Jv][0], a); a = RK_MF(__builtin_bit_cast(bf16x8, phi[(Ip * 2 + Ik) * 2 + 1]), Hp[Ip][Jv][1], a); }
                H[Ik][Jv] = a; }
        if (do_store) { u32x4* st = (u32x4*)(ws + WS_HALF + H_PSI) + (size_t)uprev * 512 + lane;
#pragma unroll
            for (int I = 0; I < 2; ++I)
#pragma unroll
                for (int J = 0; J < 2; ++J) { st[((I * 2 + J) * 2 + 0) * 64] = __builtin_bit_cast(u32x4, pack<0>(H[I][J])); st[((I * 2 + J) * 2 + 1) * 64] = __builtin_bit_cast(u32x4, pack<1>(H[I][J])); } }
        uprev = un;
#pragma unroll
        for (int f = 0; f < 8; ++f) { phi[f] = nphi[f]; psi[f] = npsi[f]; }
    }
    if (!do_store) { float chk = 0.f;
#pragma unroll
        for (int I = 0; I < 2; ++I)
#pragma unroll
            for (int J = 0; J < 2; ++J)
#pragma unroll
                for (int reg = 0; reg < 16; ++reg) chk += H[I][J][reg];
        if (chk == 123456.789f) ((float*)(ws + WS_END))[lane] = chk; }
}
RK_DI void pass2_half(unsigned char* ws, int q, int jv, int lane) {
    static_assert((NSUB - 1) % 3 == 0, "three-step rotation");
    const int dir = q & 1;
    bf16x8 Hp[2][2] = {{bf16x8{}, bf16x8{}}, {bf16x8{}, bf16x8{}}};
#define P2_LD(jj, PH, PS) do { const int jc_ = (jj) < NSUB - 1 ? (jj) : NSUB - 2; const int un_ = q * NSUB + chain_unit(dir, jc_); \
        const u32x4* ph_ = (const u32x4*)(ws + WS_HALF + H_PHI) + (size_t)un_ * 512 + lane; const u32x4* ps_ = (const u32x4*)(ws + WS_HALF + H_PSI) + (size_t)un_ * 512 + jv * 128 + lane; \
        _Pragma("unroll") for (int f = 0; f < 8; ++f) PH[f] = ph_[f * 64]; \
        PS[0] = ps_[0]; PS[1] = ps_[64]; PS[2] = ps_[256]; PS[3] = ps_[320]; } while (0)
#define P2_UNPK(A, p0, p1) do { A[0] = lo16(p0.x); A[1] = hi16(p0.x); A[2] = lo16(p0.y); A[3] = hi16(p0.y); A[4] = lo16(p0.z); A[5] = hi16(p0.z); A[6] = lo16(p0.w); A[7] = hi16(p0.w); \
        A[8] = lo16(p1.x); A[9] = hi16(p1.x); A[10] = lo16(p1.y); A[11] = hi16(p1.y); A[12] = lo16(p1.z); A[13] = hi16(p1.z); A[14] = lo16(p1.w); A[15] = hi16(p1.w); } while (0)
#define P2_STEP(jj, PH, PS) do { f32x16 a0, a1; P2_UNPK(a0, PS[0], PS[1]); P2_UNPK(a1, PS[2], PS[3]); \
        _Pragma("unroll") for (int Ip = 0; Ip < 2; ++Ip) { \
            a0 = RK_MF(__builtin_bit_cast(bf16x8, PH[(Ip * 2 + 0) * 2 + 0]), Hp[Ip][0], a0); a1 = RK_MF(__builtin_bit_cast(bf16x8, PH[(Ip * 2 + 1) * 2 + 0]), Hp[Ip][0], a1); \
            a0 = RK_MF(__builtin_bit_cast(bf16x8, PH[(Ip * 2 + 0) * 2 + 1]), Hp[Ip][1], a0); a1 = RK_MF(__builtin_bit_cast(bf16x8, PH[(Ip * 2 + 1) * 2 + 1]), Hp[Ip][1], a1); } \
        Hp[0][0] = pack<0>(a0); Hp[0][1] = pack<1>(a0); Hp[1][0] = pack<0>(a1); Hp[1][1] = pack<1>(a1); \
        u32x4* st_ = (u32x4*)(ws + WS_HALF + H_PSI) + (size_t)(q * NSUB + chain_unit(dir, (jj))) * 512 + jv * 128 + lane;        \
        st_[0] = __builtin_bit_cast(u32x4, Hp[0][0]); st_[64] = __builtin_bit_cast(u32x4, Hp[0][1]); st_[256] = __builtin_bit_cast(u32x4, Hp[1][0]); st_[320] = __builtin_bit_cast(u32x4, Hp[1][1]); } while (0)
    u32x4 phA[8], psA[4], phB[8], psB[4], phC[8], psC[4];
    P2_LD(0, phA, psA); P2_LD(1, phB, psB);
#pragma unroll 1
    for (int j = 0; j < NSUB - 1; j += 3) {
        P2_LD(j + 2, phC, psC); P2_STEP(j, phA, psA);
        P2_LD(j + 3, phA, psA); P2_STEP(j + 1, phB, psB);
        P2_LD(j + 4, phB, psB); P2_STEP(j + 2, phC, psC);
    }
#undef P2_LD
#undef P2_UNPK
#undef P2_STEP
}
RK_DI void pass3_dir(const int DIR, unsigned char* ws, LAS unsigned char* sb, int l, int bl, int hd, int c32, int lane, f32x16 (&Y)[2], float& bons) {
    Ctx c; setup_ctx(c, ws, sb, l, bl, hd, DIR, c32, lane);
    const int r = c.r, h = c.h;
    Tilde T; build_tilde<true>(c, T); __builtin_amdgcn_sched_barrier(0);
    bons += T.bon + __shfl_xor(T.bon, 32);
    bf16x8 Lk[2], Mp[2]; grams_la(c, T, Lk, Mp); __builtin_amdgcn_sched_barrier(0);
    bf16x8 Ab[2], Ak[2];
    {   f32x16 gb = f32x16{}, gk = f32x16{};
#pragma unroll
        for (int Ik = 0; Ik < 2; ++Ik)
#pragma unroll
            for (int S = 0; S < 2; ++S) { gb = RK_MF(T.Bt[Ik][S], T.Rt[Ik][S], gb); gk = RK_MF(T.Kt[Ik][S], T.Rt[Ik][S], gk); }
        tmask<false>(gb, r, h, DIR); tmask<false>(gk, r, h, DIR);
        Ab[0] = pack<0>(gb); Ab[1] = pack<1>(gb); Ak[0] = pack<0>(gk); Ak[1] = pack<1>(gk); }
    RK_STAGE(Ak[1]);
    bf16x8 H0p[2][2][2];
    { const int q = (bl * 8 + hd) * 2 + DIR, j = chain_pos(DIR, c32);
      if (j > 0) { const u32x4* st = (const u32x4*)(ws + WS_HALF + H_PSI) + (size_t)(q * NSUB + chain_unit(DIR, j - 1)) * 512 + lane;
#pragma unroll
          for (int I = 0; I < 2; ++I)
#pragma unroll
              for (int J = 0; J < 2; ++J) { H0p[I][J][0] = __builtin_bit_cast(bf16x8, st[((I * 2 + J) * 2 + 0) * 64]); H0p[I][J][1] = __builtin_bit_cast(bf16x8, st[((I * 2 + J) * 2 + 1) * 64]); } }
      else {
#pragma unroll
          for (int I = 0; I < 2; ++I)
#pragma unroll
              for (int J = 0; J < 2; ++J) { H0p[I][J][0] = bf16x8{}; H0p[I][J][1] = bf16x8{}; } } }
    bf16x8 Up[2][2];
    {   f32x16 xs[2];
#pragma unroll
        for (int Jv = 0; Jv < 2; ++Jv) {
            f32x16 x = RK_MF(Lk[0], T.Vp[Jv][0], f32x16{}); x = RK_MF(Lk[1], T.Vp[Jv][1], x);
#pragma unroll
            for (int Ik = 0; Ik < 2; ++Ik) { x = RK_MF(T.At[Ik][0], H0p[Ik][Jv][0], x); x = RK_MF(T.At[Ik][1], H0p[Ik][Jv][1], x); }
            xs[Jv] = x; }
        if (DIR) solve32p<1>(xs[0], xs[1], Mp); else solve32p<0>(xs[0], xs[1], Mp);
#pragma unroll
        for (int Jv = 0; Jv < 2; ++Jv) { Up[Jv][0] = pack<0>(xs[Jv]); Up[Jv][1] = pack<1>(xs[Jv]); }
        __builtin_amdgcn_sched_barrier(0); }
    __builtin_amdgcn_sched_barrier(0);
#pragma unroll
    for (int Iv = 0; Iv < 2; ++Iv) {
        f32x16 y = f32x16{};
#pragma unroll
        for (int Ik = 0; Ik < 2; ++Ik) { y = RK_MF(H0p[Ik][Iv][0], T.Rt[Ik][0], y); y = RK_MF(H0p[Ik][Iv][1], T.Rt[Ik][1], y); }
        y = RK_MF(Up[Iv][0], Ab[0], y); y = RK_MF(Up[Iv][1], Ab[1], y); y = RK_MF(T.Vp[Iv][0], Ak[0], y); y = RK_MF(T.Vp[Iv][1], Ak[1], y);
        Y[Iv] = y; }
}
RK_DI void pass3_unit(unsigned char* ws, LAS unsigned char* sb, int l, int v3, int lane, unsigned* ypark) {
    const int c32 = v3 % NSUB, bh = v3 / NSUB, bl = bh >> 3, hd = bh & 7, r = lane & 31, h = lane >> 5;
    float bons = 0.f;
    LAS float* ylds = (LAS float*)(sb + SBUF);
#pragma unroll 1
    for (int dir = 0; dir < 2; ++dir) {
        int lane_ = lane; asm volatile("" : "+v"(lane_));
        f32x16 Y[2]; pass3_dir(dir, ws, sb, l, bl, hd, c32, lane_, Y, bons);
        if (dir == 0) {
#pragma unroll
            for (int Iv = 0; Iv < 2; ++Iv)
#pragma unroll
                for (int d = 0; d < 8; ++d) ypark[(Iv * 8 + d) * 64 + lane] = cvt2(Y[Iv][2 * d], Y[Iv][2 * d + 1]); }
        else {
#pragma unroll
            for (int Iv = 0; Iv < 2; ++Iv)
#pragma unroll
                for (int reg = 0; reg < 16; ++reg) ylds[(Iv * 16 + reg) * 64 + lane] = Y[Iv][reg]; }
        __builtin_amdgcn_sched_barrier(0); }
    f32x16 YT[2];
#pragma unroll
    for (int Iv = 0; Iv < 2; ++Iv)
#pragma unroll
        for (int d = 0; d < 8; ++d) { const unsigned w = ypark[(Iv * 8 + d) * 64 + lane]; YT[Iv][2 * d] = ylds[(Iv * 16 + 2 * d) * 64 + lane] + lo16(w); YT[Iv][2 * d + 1] = ylds[(Iv * 16 + 2 * d + 1) * 64 + lane] + hi16(w); }
    Ctx c; setup_ctx(c, ws, sb, l, bl, hd, 0, c32, lane);
    RK_WAIT_LDS(); stage_slice(c, 1, RW_GD); stage_slice(c, 2, RW_GD + 64); RK_WAIT_DMA();
    float sm = 0.f;
#pragma unroll
    for (int Iv = 0; Iv < 2; ++Iv)
#pragma unroll
        for (int reg = 0; reg < 16; ++reg) sm += YT[Iv][reg];
    sm += __shfl_xor(sm, 32); const float mean = sm * (1.f / 64.f); float vq = 0.f;
#pragma unroll
    for (int Iv = 0; Iv < 2; ++Iv)
#pragma unroll
        for (int reg = 0; reg < 16; ++reg) { YT[Iv][reg] -= mean; vq += YT[Iv][reg] * YT[Iv][reg]; }
    vq += __shfl_xor(vq, 32); const float rstd = 1.f / sqrtf(vq * (1.f / 64.f) + LNX_EPS);
    const bf16* g2P = (const bf16*)(ws + WS_TAB + 524288) + (size_t)hd * 8192;
    const float* lnw = inp(I_LNW) + l * 512 + hd * 64; const float* lnb = inp(I_LNB) + l * 512 + hd * 64;
    bf16x8 sgp[4][2];
    bf16x8 e0[2][3], e1[2][3]; dpre(c, RW_GD, e0);
#pragma unroll
    for (int Ii = 0; Ii < 4; ++Ii) {
        if (Ii == 0) dpre(c, RW_GD + 32, e1); else if (Ii == 1) dpre(c, RW_GD + 64, e0); else if (Ii == 2) dpre(c, RW_GD + 96, e1); else dpre(c, RW_V + hd * 64, e0);
        f32x16 t = load_o2p(c, 1 + (Ii >> 1), Ii & 1, (Ii & 1) ? e1 : e0);
#pragma unroll
        for (int reg = 0; reg < 16; ++reg) t[reg] = sigm(t[reg]);
        sgp[Ii][0] = pack<0>(t); sgp[Ii][1] = pack<1>(t); __builtin_amdgcn_sched_barrier(0); }
    RK_WAIT_LDS(); LAS unsigned char* st = c.sb + SBUF;
#pragma unroll
    for (int Iv = 0; Iv < 2; ++Iv) {
        if (Iv == 0) dpre(c, RW_V + hd * 64 + 32, e1);
        f32x4 lwv[4], lbv[4];
#pragma unroll
        for (int g = 0; g < 4; ++g) { const int v0 = 32 * Iv + 8 * g + 4 * h; lwv[g] = *(const f32x4*)(lnw + v0); lbv[g] = *(const f32x4*)(lnb + v0); }
        __builtin_amdgcn_sched_barrier(0);
        f32x16 gt = f32x16{};
#pragma unroll
        for (int Ip = 0; Ip < 2; ++Ip) { bf16x8 gf[2][2];
#pragma unroll
            for (int Iq = 0; Iq < 2; ++Iq)
#pragma unroll
                for (int S = 0; S < 2; ++S) gf[Iq][S] = *(const bf16x8*)(g2P + (((2 * Ip + Iq) * 2 + Iv) * 2 + S) * 512 + c.lofs);
            asm volatile("" : "+v"(gf[0][0]), "+v"(gf[0][1]), "+v"(gf[1][0]), "+v"(gf[1][1]));
#pragma unroll
            for (int Iq = 0; Iq < 2; ++Iq)
#pragma unroll
                for (int S = 0; S < 2; ++S) gt = RK_MF(gf[Iq][S], sgp[2 * Ip + Iq][S], gt);
            RK_STAGE(gt); }
        const f32x16 vt = load_o2p(c, 0, Iv, Iv == 0 ? e0 : e1);
        asm volatile("" : "+v"(lwv[0]), "+v"(lwv[1]), "+v"(lwv[2]), "+v"(lwv[3]), "+v"(lbv[0]), "+v"(lbv[1]), "+v"(lbv[2]), "+v"(lbv[3]));
#pragma unroll
        for (int g = 0; g < 4; ++g) { const int v0 = 32 * Iv + 8 * g + 4 * h; const f32x4 lw = lwv[g], lb = lbv[g]; float o[4];
#pragma unroll
            for (int j = 0; j < 4; ++j) { const int reg = 4 * g + j; o[j] = (YT[Iv][reg] * rstd * lw[j] + lb[j] + bons * vt[reg]) * gt[reg]; }
            *(LAS unsigned long long*)(st + r * 144 + 2 * v0) = (unsigned long long)cvt2(o[0], o[1]) | ((unsigned long long)cvt2(o[2], o[3]) << 32); }
    }
    asm volatile("s_waitcnt lgkmcnt(0)" ::: "memory");
    bf16* RO = (bf16*)(ws + WS_HALF + H_PP) + (size_t)c.m0 * PPW + C_QD + hd * 64;
#pragma unroll
    for (int i = 0; i < 4; ++i) { const int id = i * 64 + lane, row = id >> 3, ch = id & 7; const u32x4 v = *(const LAS u32x4*)(st + row * 144 + ch * 16); *(u32x4*)(RO + (size_t)row * PPW + ch * 8) = v; }
    asm volatile("s_waitcnt lgkmcnt(0)" ::: "memory");
}
}

__device__ __forceinline__ void ph_rwkv1(Frame& F, int l) {
    const int gw = F.bid * NWAVES + FWAVE(), NGW = F.G * NWAVES; LAS unsigned char* sb = F.lds + FWAVE() * (4 * rk::SBUF);
    const bool skew = NGW == 2048;
#pragma unroll 1
    for (int r = 0;; ++r) {
        int u = gw + r * NGW;
        if (skew && r == 2) u = (F.bid < 64 && FWAVE() < 4) ? 2 * NGW + F.bid * 4 + FWAVE() : NUNIT;
        if (u >= NUNIT) break;
        rk::pass1_unit(F.ws, sb, l, u, otid() & 63);
    }
    asm volatile("s_waitcnt vmcnt(0) lgkmcnt(0)" ::: "memory");
}
__device__ __forceinline__ void ph_rwkv3(Frame& F, int l, bool ctx_emit) {
    const int gw = F.bid * NWAVES + FWAVE(), NGW = F.G * NWAVES; LAS unsigned char* sb = F.lds + FWAVE() * (4 * rk::SBUF);
    {
        bf16* PP = (bf16*)(F.ws + WS_HALF + H_PP); const int lane = FLANE();
        for (int rr = gw; rr < 16 * 256; rr += NGW) { const int sidx = rr >> 8, row = rr & 255, xq = sidx >> 1, p = 2 * xq + 1, qb = 14 + (sidx & 1), bl = p >> 3, h = p & 7;
            const unsigned char* sp = F.ws + WS_SPLIT + (size_t)(sidx * 4) * SPLIT_BYTES;
            float ls[4], ov[4], mx = -1e30f;
#pragma unroll
            for (int i = 0; i < 4; ++i) { ls[i] = ((const float*)(sp + (size_t)i * SPLIT_BYTES + 32768))[row]; ov[i] = bf2f(((const bf16*)(sp + (size_t)i * SPLIT_BYTES))[row * 64 + lane]); }
            asm volatile("" : "+v"(ls[0]), "+v"(ls[1]), "+v"(ls[2]), "+v"(ls[3]), "+v"(ov[0]), "+v"(ov[1]), "+v"(ov[2]), "+v"(ov[3]));
#pragma unroll
            for (int i = 0; i < 4; ++i) mx = fmaxf(mx, ls[i]);
            float ws_ = 0.f, acc = 0.f;
#pragma unroll
            for (int i = 0; i < 4; ++i) { const float w = __builtin_amdgcn_exp2f(ls[i] - mx); ws_ += w; acc += w * ov[i]; }
            PP[(size_t)(bl * RPB + CTX + qb * 256 + row) * PPW + C_GQ + h * 64 + lane] = (bf16)f2bf(acc / ws_); } }
    unsigned* ypark = (unsigned*)(F.ws + WS_END) + (size_t)gw * 1024;
    const int per = ctx_emit ? rk::NSUB : rk::NSUB - 8, nun = 16 * per;
#pragma unroll 1
    for (int r = 0;; ++r) {
        int j = gw + r * NGW;
        if (r == 1 && NGW == 2048) j = (F.bid < P3X_WGS && FWAVE() < 4) ? NGW + F.bid * 4 + FWAVE() : nun;
        if (j >= nun) break;
        const int v3 = (j / per) * rk::NSUB + (rk::NSUB - per) + j % per; rk::pass3_unit(F.ws, sb, l, v3, otid() & 63, ypark); }
    asm volatile("s_waitcnt vmcnt(0) lgkmcnt(0)" ::: "memory");
}
__device__ __forceinline__ void ph_mixer(Frame& F, int l, int half, int rep) {
    const bool ctx_out = (l == 0);
#ifdef EXTRA_P2
    if (F.bid < 4 && rep == 0) rk::pass2_chain(F.ws, F.bid * 8 + FWAVE(), otid() & 63, false);
#endif
    if (F.bid < 16 && rep == 0 && FWAVE() < 4) { const int ch = F.bid * 4 + FWAVE(); rk::pass2_half(F.ws, ch >> 1, ch & 1, otid() & 63); }
    __syncthreads();
    unsigned* ctr0 = F.ctl + CW_ATT + ((l * 2 + half) * 2 + rep) * 8 * 64;
    LAS unsigned* slot = (LAS unsigned*)(F.lds + MISC_OFF);
    const bf16* PP = (const bf16*)(F.ws + WS_HALF + H_PP); const bf16* QM = (const bf16*)(F.ws + WS_HALF + H_QM); const bf16* KVM = (const bf16*)(F.ws + WS_HALF + H_KVM);
    bf16* MO = (bf16*)(F.ws + WS_HALF + H_MO); bf16* DUM = (bf16*)(F.ws + WS_END);
    const int nper = ctx_out ? 74 : 70;
    int xk = 0;
    for (;;) {
        const int xq = (F.bid + xk) & 7;
        if (FTID() == 0) slot[0] = atomicAdd(ctr0 + xq * 64, 1u);
        __syncthreads();
        const int v = (int)slot[0];
        __syncthreads();
        if (v >= nper) { if (++xk == 8) break; continue; }
        int type, bl, h, qb, nkeys, qrow0, part = -1, sidx = 0; const bool lat_u = v < 70;
        { int p; if (v < 62) { type = v >> 5; p = 2 * xq + ((v >> 4) & 1); qb = v & 15; nkeys = RPB; }
          else if (lat_u) { const int w = v - 62; type = 1; p = 2 * xq + 1; qb = 14 + (w >> 2); part = w & 3; sidx = xq * 2 + (w >> 2); nkeys = RPB; }
          else { const int w = v - 70; type = w >> 1; p = 2 * xq + (w & 1); qb = 0; nkeys = CTX; }
          bl = p >> 3; h = p & 7; qrow0 = lat_u ? bl * RPB + CTX + qb * 256 : bl * RPB; }
        const int krow0 = bl * RPB;
        att::Args a;
        if (type == 0) {
            a.Q = QM + (size_t)qrow0 * 768 + h * 96; a.ldq = 768; a.K0 = KVM + (size_t)krow0 * KVP + h * 128; a.ldk0 = KVP; a.K1 = PP + (size_t)krow0 * PPW + C_KR; a.ldk1 = PPW;
            a.V = KVM + (size_t)krow0 * KVP + h * 128 + 64; a.ldv = KVP; a.O = (rep ? DUM : MO) + (size_t)qrow0 * 512 + h * 64; a.ldo = 512; a.nkeys = nkeys;
            a.rope_t0 = lat_u ? qb * 256 : -1; a.tc = (const float*)(F.ws + WS_T8C); a.ts = (const float*)(F.ws + WS_T8S);
            at96::Args b; b.Q = a.Q; b.ldq = a.ldq; b.K0 = a.K0; b.ldk0 = a.ldk0; b.K1 = a.K1; b.ldk1 = a.ldk1; b.V = a.V; b.ldv = a.ldv; b.O = a.O; b.ldo = a.ldo; b.nkeys = a.nkeys;
            b.rope_t0 = a.rope_t0; b.tc = a.tc; b.ts = a.ts;
            at96::unit(b, (char*)F.ldsg);
        } else {
            const int kvh = h >> 2;
            a.Q = PP + (size_t)qrow0 * PPW + C_GQ + h * 64; a.ldq = PPW; a.K0 = PP + (size_t)krow0 * PPW + C_GK + kvh * 64; a.ldk0 = PPW; a.K1 = a.K0; a.ldk1 = PPW;
            a.V = PP + (size_t)krow0 * PPW + C_GV + kvh * 64; a.ldv = PPW; a.O = rep ? DUM + (size_t)qrow0 * 512 + h * 64 : (bf16*)PP + (size_t)qrow0 * PPW + C_GQ + h * 64; a.ldo = rep ? 512 : PPW; a.nkeys = nkeys; a.rope_t0 = -1; a.tc = nullptr; a.ts = nullptr;
            at64::Args b; b.Q = a.Q; b.ldq = a.ldq; b.K = a.K0; b.ldk = a.ldk0; b.V = a.V; b.ldv = a.ldv; b.O = a.O; b.ldo = a.ldo; b.nkeys = a.nkeys; b.lse = nullptr;
            if (part >= 0) { const int k0 = (part < 2) ? part * 1152 : 2304 + (part - 2) * 1024; b.nkeys = (part < 2) ? 1152 : 1024;
                b.K = a.K0 + (size_t)k0 * a.ldk0; b.V = a.V + (size_t)k0 * a.ldv;
                unsigned char* sp = F.ws + WS_SPLIT + (size_t)(sidx * 4 + part) * SPLIT_BYTES; b.O = (bf16*)sp; b.ldo = 64; b.lse = (float*)(sp + 32768); }
            at64::unit(b, (char*)F.ldsg);
        }
    }
}

enum { OP_W0 = 0, OP_NORM1, OP_INPROJ, OP_PREP, OP_MIXER, OP_FINISH, OP_GATE, OP_MERGE, OP_WOUT, OP_NORM2, OP_FFUP, OP_FFDOWN, OP_FINAL };
constexpr int N_PHASES = 36;
__global__ void __launch_bounds__(NWAVES * 64, 2) trunk_fwd(Args args) {
    extern __shared__ __attribute__((aligned(16))) unsigned char lds[];
    Frame F;
    F.lds = (LAS unsigned char*)lds; F.ldsg = lds;
    F.G = gridDim.x; F.bid = blockIdx.x; F.ws = args.ws; F.ctl = (unsigned*)(args.ws + WS_CTL); F.out = args.out;
    volatile LAS unsigned* MISC = (volatile LAS unsigned*)(F.lds + MISC_OFF);
    for (int u = threadIdx.x; u < 32; u += NWAVES * 64) MISC[u] = 0u;
    __syncthreads();
    const int lo = args.ph_lo, hi = args.ph_hi;
    XcdBarrier bar = xcd_barrier_post(F.ctl + CW_BAR, MISC + 8);
#ifdef EXTRA_OP
    for (int pp = 2 * lo; pp < 2 * hi; ++pp) { const int p = pp >> 1, rep = pp & 1;
#else
    for (int p = lo; p < hi; ++p) { const int rep = 0;
#endif
        GAS unsigned char* wsg_ = (GAS unsigned char*)args.ws; GAS float* outg_ = (GAS float*)args.out; int bid_ = blockIdx.x, G_ = gridDim.x;
        asm volatile("" : "+s"(wsg_), "+s"(outg_), "+s"(bid_), "+s"(G_));
        unsigned char* ws = (unsigned char*)wsg_; float* outp = (float*)outg_;
        F.ws = ws; F.out = outp; F.bid = bid_; F.G = G_; F.ctl = (unsigned*)(ws + WS_CTL);
        unsigned char* wt = ws + WS_WT; const bf16* XN = (const bf16*)(ws + WS_XN); bf16* ctxx = (bf16*)(ws + WS_CTXX); bf16* XB = (bf16*)outp;
        int op, l = 0, half = 0;
        if (p == 0) op = OP_W0; else if (p == N_PHASES - 1) op = OP_FINAL;
        else { const int q = p - 1, r = q % 17; l = q / 17; if (r == 0) op = OP_NORM1; else if (r <= 7) { half = 0; op = OP_INPROJ + (r - 1); } else if (r <= 13) { half = 1; op = OP_PREP + (r - 8); } else op = OP_NORM2 + (r - 14); }
#ifdef ONLY_OP
        op = ONLY_OP;
#endif
#ifdef EXTRA_OP
        if (rep && op != EXTRA_OP) continue;
#endif
        const void* xl = (l == 0) ? (const void*)inp(I_X) : (const void*)XB; const void* xc = (l == 0) ? (const void*)inp(I_CTX) : (const void*)ctxx; const int sbf = (l != 0);
        const bool ctx_out = (l == 0);
        const int nMf = ctx_out ? 68 : 64, nMh = ctx_out ? 34 : 32, skipf = ctx_out ? 0 : 1;
        switch (op) {
        case OP_W0: ph_weights(F, 0); break;
        case OP_NORM1: if (l == 1) ph_weights(F, 1); ph_norm(F, l, xl, xc, sbf != 0, inp(I_G1) + l * DM, 0, false, (l == 1) ? (const float*)(ws + WS_END) : nullptr); break;
#define RUN_INPROJ(hh) do { pg8::Gemm g_{XN + (size_t)(hh) * HM * DM, (const bf16*)(wt + WT_IN), DM, DM, DM}; pg8::TileOrder S_; S_.init(HM / 256, PPW / 256, F.G, F.bid, 0); \
            pg8::Epi<pg8::EPI_BF16> E_{}; E_.O = (bf16*)(ws + WS_HALF + H_PP); E_.ldc = PPW; pg8::gemm_phase<pg8::Epi<pg8::EPI_BF16>, pg8::TileOrder, true>(F.lds, g_, S_, E_); } while (0)
        case OP_INPROJ: RUN_INPROJ(half); break;
        case OP_PREP: {
            if (rep == 0) ph_prep(F, l, half); ph_rwkv1(F, l); __syncthreads();
            if (rep == 0) {
            const bool isq = F.bid >= 136; const int cQ = F.bid - 136;
            if (!isq || cQ < 102) {
                pg8::TileOrder S; if (isq) S.init(HM / 256, 3, F.G, cQ, 0); else S.init(HM / 256, 4, F.G, F.bid, 0);
                pg8::Unit u0; S.next(0, u0);
                LAS float* rsl = (LAS float*)(F.lds + 143360);
                {   const int ncol = isq ? 384 : 256, trow = FTID() >> 1, th = FTID() & 1, nch = ncol / 16;
                    const bf16* src = (const bf16*)(ws + WS_HALF + H_PP) + (size_t)(u0.pm * 256 + trow) * PPW + (isq ? C_QD : C_KVD) + th * (ncol / 2);
                    float sq = 0.f;
                    for (int c0 = 0; c0 < nch; c0 += 8) { v4u w[8];
#pragma unroll
                        for (int j = 0; j < 8; ++j) w[j] = *(const v4u*)(src + (c0 + j) * 8);
#pragma unroll
                        for (int j = 0; j < 8; ++j) { const float a0 = pg8::bf_lo(w[j].x), a1 = pg8::bf_hi(w[j].x), a2 = pg8::bf_lo(w[j].y), a3 = pg8::bf_hi(w[j].y), a4 = pg8::bf_lo(w[j].z), a5 = pg8::bf_hi(w[j].z), a6 = pg8::bf_lo(w[j].w), a7 = pg8::bf_hi(w[j].w);
                            sq += (a0 * a0 + a1 * a1) + (a2 * a2 + a3 * a3) + (a4 * a4 + a5 * a5) + (a6 * a6 + a7 * a7); } }
                    sq += __shfl_xor(sq, 1);
                    if (th == 0) rsl[trow] = (isq ? 0.10206207261596575f * 1.4426950408889634f : 1.f) / sqrtf(sq * (1.f / (float)ncol) + NORM_EPS); }
                __syncthreads();
                if (isq) { pg8::Gemm g{(const bf16*)(ws + WS_HALF + H_PP) + C_QD, (const bf16*)(wt + WT_QU), PPW, 384, 384};
                    pg8::Epi<pg8::EPI_ROWSCALE> E{}; E.O = (bf16*)(ws + WS_HALF + H_QM); E.ldc = 768; E.rsl = rsl;
                    pg8::gemm_phase<pg8::Epi<pg8::EPI_ROWSCALE>, pg8::TileOrder, true>(F.lds, g, S, E); }
                else { pg8::Gemm g{(const bf16*)(ws + WS_HALF + H_PP) + C_KVD, (const bf16*)(wt + WT_KVU), PPW, 256, 256};
                    pg8::Epi<pg8::EPI_ROWSCALE> E{}; E.O = (bf16*)(ws + WS_HALF + H_KVM); E.ldc = KVP; E.rsl = rsl;
                    pg8::gemm_phase<pg8::Epi<pg8::EPI_ROWSCALE>, pg8::TileOrder, true>(F.lds, g, S, E); } } }
            } break;
        case OP_MIXER: ph_mixer(F, l, half, rep); break;
        case OP_FINISH: ph_rwkv3(F, l, ctx_out); __syncthreads(); break;
        case OP_GATE: {
            const int gs = ctx_out ? P3X_WGS : 0;
            if (F.bid >= gs) { pg8::Gemm g{XN + (size_t)half * HM * DM, (const bf16*)(wt + WT_G), DM, DM, DM}; pg8::TileOrder S; S.init(nMh, ctx_out ? 12 : 8, F.G - gs, F.bid - gs, skipf);
                pg8::Epi<pg8::EPI_SIGMOID> E{}; E.O = (bf16*)(ws + WS_G0); E.O1 = (bf16*)(ws + WS_G1); E.O2 = (bf16*)(ws + WS_G2); E.ldc = DM;
                pg8::gemm_phase<pg8::Epi<pg8::EPI_SIGMOID>, pg8::TileOrder, true>(F.lds, g, S, E);
                if (!ctx_out) {
                    pg8::Gemm g2{XN + (size_t)half * HM * DM, (const bf16*)(wt + WT_G) + (size_t)2 * DM * DM, DM, DM, DM}; pg8::TileOrder S2; S2.init(nMh, 8, F.G, F.bid, skipf);
                    pg8::Epi<pg8::EPI_SIGMOID, true> E2{}; E2.O = (bf16*)(ws + WS_G2); E2.ldc = DM;
                    pg8::gemm_phase<pg8::Epi<pg8::EPI_SIGMOID, true>, pg8::TileOrder, true, true>(F.lds, g2, S2, E2); } } } break;
        case OP_MERGE: {
            {
                pg8::Gemm g{(const bf16*)(ws + WS_HALF + H_PP) + C_GQ, (const bf16*)(wt + WT_BR), PPW, 512, 512};
                pg8::BranchOrder S; S.dA1 = C_QD - C_GQ; S.dA2 = (long)((H_MO - H_PP) / 2) - C_GQ; S.dB = (long)DM * 512; S.lda0 = PPW; S.dlda = PPW - 512;
                if (ctx_out) { S.T.init(nMh, 4, F.G, F.bid, skipf);
                    pg8::Epi<pg8::EPI_GATEMUL> E{}; E.O = (bf16*)(ws + WS_MIX); E.ldc = DM; E.G = (const bf16*)(ws + WS_G0); E.ldg = DM; E.dG1 = (long)((WS_G1 - WS_G0) / 2); E.dG2 = (long)((WS_G2 - WS_G0) / 2); E.multi = 1; E.first = 0;
                    pg8::gemm_phase<pg8::Epi<pg8::EPI_GATEMUL>, pg8::BranchOrder, true>(F.lds, g, S, E); }
                else { S.T.init(nMh, 8, F.G, F.bid, skipf);
                    pg8::Epi<pg8::EPI_GATEMUL, true> E{}; E.O = (bf16*)(ws + WS_MIX); E.ldc = DM; E.G = (const bf16*)(ws + WS_G0); E.ldg = DM; E.dG1 = (long)((WS_G1 - WS_G0) / 2); E.dG2 = (long)((WS_G2 - WS_G0) / 2); E.multi = 1; E.first = 0;
                    pg8::gemm_phase<pg8::Epi<pg8::EPI_GATEMUL, true>, pg8::BranchOrder, true, true>(F.lds, g, S, E); } }
            } break;
        case OP_WOUT: {
            pg8::Gemm g{(const bf16*)(ws + WS_MIX), (const bf16*)(wt + WT_OUT), DM, DM, DM}; pg8::TileOrder S;
            if (ctx_out && half == 1) { S.init(nMh, 4, F.G, F.bid, skipf);
                pg8::Epi<pg8::EPI_RESID> E{}; E.xsl = xl; E.xsc = xc; E.sbf = sbf; E.xdl = XB; E.xdc = ctxx; E.gate = (const float*)(ws + WS_MOD) + (size_t)l * 5 * 6144 + 2048; E.pm_off = half * 34; E.part = nullptr; E.kslice = 1;
                pg8::gemm_phase<pg8::Epi<pg8::EPI_RESID>, pg8::TileOrder, true>(F.lds, g, S, E); }
            else { S.init(nMh, 8, F.G, ctx_out ? (F.bid + 36) % F.G : F.bid, skipf);
                pg8::Epi<pg8::EPI_RESID, true> E{}; E.xsl = xl; E.xsc = xc; E.sbf = sbf; E.xdl = XB; E.xdc = ctxx; E.gate = (const float*)(ws + WS_MOD) + (size_t)l * 5 * 6144 + 2048; E.pm_off = half * 34; E.part = nullptr; E.kslice = 1;
                pg8::gemm_phase<pg8::Epi<pg8::EPI_RESID, true>, pg8::TileOrder, true, true>(F.lds, g, S, E); }
            if (half == 0) RUN_INPROJ(1);
            } break;
        case OP_NORM2: ph_norm(F, l, XB, ctxx, true, inp(I_G2) + l * DM, 1, !ctx_out); break;
        case OP_FFUP: {
            pg8::Gemm g{XN, (const bf16*)(wt + WT_F1), DM, DM, DM}; pg8::TileOrder S; S.init(64, 16, F.G, F.bid, 1);
            pg8::Epi<pg8::EPI_RELU2> E{}; E.O = (bf16*)(ws + WS_HID); E.ldc = DFF;
            pg8::gemm_phase<pg8::Epi<pg8::EPI_RELU2>, pg8::TileOrder, true>(F.lds, g, S, E);
            if (ctx_out) {
                pg8::CtxTilesOrder S2; S2.init(F.G, F.bid, 32); pg8::Epi<pg8::EPI_RELU2, true> E2{}; E2.O = (bf16*)(ws + WS_HID); E2.ldc = DFF;
                pg8::gemm_phase<pg8::Epi<pg8::EPI_RELU2, true>, pg8::CtxTilesOrder, true, true>(F.lds, g, S2, E2); } } break;
        case OP_FFDOWN: {
            pg8::Gemm g{(const bf16*)(ws + WS_HID), (const bf16*)(wt + WT_F2), DFF, DFF, DFF}; pg8::TileOrder S; S.init(64, 4, F.G, F.bid, 1);
            pg8::Epi<pg8::EPI_RESID> E{}; E.xsl = XB; E.xsc = ctxx; E.sbf = 1; E.xdl = ctx_out ? XB : (bf16*)(ws + WS_XN); E.xdc = ctxx; E.gate = (const float*)(ws + WS_MOD) + (size_t)l * 5 * 6144 + 5120;        E.pm_off = 0; E.part = nullptr; E.kslice = 1;
            pg8::gemm_phase<pg8::Epi<pg8::EPI_RESID>, pg8::TileOrder, true>(F.lds, g, S, E);
            if (ctx_out) { pg8::Gemm g2{(const bf16*)(ws + WS_HID), (const bf16*)(wt + WT_F2), DFF, DFF, DFF / 4}; pg8::CtxSplitOrder S2; S2.init(F.G, F.bid, DFF / 4);
                E.part = (float*)(ws + WS_END); E.kslice = DFF / 4; pg8::gemm_phase<pg8::Epi<pg8::EPI_RESID>, pg8::CtxSplitOrder, true>(F.lds, g2, S2, E); } } break;
        default: ph_final(F); break;
        }
        if (op == OP_FINISH) continue;
#ifdef EXTRA_OP
        if (pp + 1 < 2 * hi) xcd_barrier(bar);
#else
        if (p + 1 < hi) xcd_barrier(bar);
#endif
    }
}

extern "C" void kernel_launch(void* const* d_in, const int* in_sizes, int n_in, void* d_out, int out_size, void* d_ws, size_t ws_size, hipStream_t stream) {
    static int grid = 0;
    if (grid == 0) {
        if (n_in != 31 || out_size != NB * SEQ * DM || ws_size < WS_END + 12 * MiB) { fprintf(stderr, "kernel_launch: unexpected shapes (n_in %d out %d ws %zu, need ws >= %zu)\n", n_in, out_size, ws_size, (size_t)WS_END); grid = -1; return; }
        int dev = 0, cus = 0;
        if (hipGetDevice(&dev) != hipSuccess || hipDeviceGetAttribute(&cus, hipDeviceAttributeMultiprocessorCount, dev) != hipSuccess) { grid = -1; return; }
        if (hipFuncSetAttribute((const void*)trunk_fwd, hipFuncAttributeMaxDynamicSharedMemorySize, LDS_BYTES) != hipSuccess) { fprintf(stderr, "kernel_launch: hipFuncSetAttribute failed\n"); grid = -1; return; }
        grid = cus;
    }
    if (grid < 0) return;
    (void)hipMemsetAsync((char*)d_ws + WS_CTL, 0, CTL_BYTES, stream);
    Args a{};
    for (int i = 0; i < 31; ++i) a.in[i] = (const float*)d_in[i];
    a.out = (float*)d_out; a.ws = (unsigned char*)d_ws;
#if ONE_LAUNCH
    a.ph_lo = 0; a.ph_hi = N_PHASES;
    hipLaunchKernelGGL(trunk_fwd, dim3(grid), dim3(NWAVES * 64), LDS_BYTES, stream, a);
#else
    for (int p = 0; p < N_PHASES; ++p) { a.ph_lo = p; a.ph_hi = p + 1; hipLaunchKernelGGL(trunk_fwd, dim3(grid), dim3(NWAVES * 64), LDS_BYTES, stream, a); }
#endif
}
```

```cpp
#include <hip/hip_runtime.h>
#include <hip/hip_bf16.h>
#include <cstdio>
#include <cstdint>

#ifndef ONE_LAUNCH
#define ONE_LAUNCH 1
#define P3X_WGS 32
#define P2_WGS 8
#endif

constexpr int DM = 1024, NB = 4, SEQ = 4096, CTX = 256, RPB = SEQ + CTX  , MROWS = NB * RPB  , HM = 2 * RPB  ;
constexpr int NIN = 6432, PPW = 3584  , NGATE = 3072;
constexpr int C_GQ = 0, C_GK = 512, C_GV = 640, C_RW = 768, C_QD = 2688, C_KVD = 3072, C_KR = 3328, C_GATE = 3360;
constexpr int RW_R = 0, RW_K = 512, RW_V = 1024, RW_WD = 1536, RW_AD = 1664, RW_GD = 1792, RWIN = 1920;
constexpr int DFF = 4096;
constexpr float NORM_EPS = 1e-6f, LNX_EPS = 64e-5f;

__device__ __forceinline__ int otid() { int t = threadIdx.x; asm volatile("" : "+v"(t)); return t; }
namespace pg8 {
#define PG8_LAS __attribute__((address_space(3)))
typedef unsigned short bf16_t;
typedef short bf16x8 __attribute__((ext_vector_type(8)));
typedef float f32x4 __attribute__((ext_vector_type(4)));
typedef unsigned u32x4 __attribute__((ext_vector_type(4)));
constexpr int BM = 256, BK = 64, HALF = 128, HTB = HALF * BK * 2, STAGE_BYTES = 8 * HTB, NXCD = 8, WGM = 8;

__host__ __device__ __forceinline__ int lds_byte(int r, int c) { const int st = (r >> 4) * 2 + (c >> 5), rr = r & 15, cc = c & 31, ob = rr * 64 + cc * 2; return st * 1024 + (ob ^ (((ob >> 9) & 1) << 5)); }
__host__ __device__ __forceinline__ void stage_rc(int b, int& R, int& C) { const int st = b / 1024, sb = b % 1024, swz = sb ^ (((sb >> 9) & 1) << 5); R = (st >> 1) * 16 + swz / 64; C = (st & 1) * 32 + (swz % 64) / 2; }
__host__ __device__ __forceinline__ int perm32(int rho) { const int n = rho >> 4, i = rho & 15; return 8 * (i >> 2) + 4 * n + (i & 3); }

struct Unit { int pm, pn, ka, set; };
struct Gemm { const bf16_t* A; const bf16_t* Bt; int lda, ldb, K; };

struct TileOrder {
    static constexpr bool MULTI = false;
    int nM, nN, nwg, G, c, skipctx;
    __device__ __forceinline__ void init(int nM_, int nN_, int G_, int c_, int skip_) { nM = nM_; nN = nN_; nwg = nM * nN; G = G_; c = c_; skipctx = skip_; }
    __device__ __forceinline__ bool next(int i, Unit& u) const {
        const long L = (long)i * G + c; if (L >= nwg) return false;
        int wgid = (int)L; { const int q = nwg / NXCD, r = nwg % NXCD, xcd = wgid % NXCD, off = wgid / NXCD; wgid = (xcd < r ? xcd * (q + 1) : r * (q + 1) + (xcd - r) * q) + off; }
        const int nig = WGM * nN, gid = wgid / nig, fm = gid * WGM, gsz = (nM - fm) < WGM ? (nM - fm) : WGM;
        u.pm = fm + ((wgid % nig) % gsz); u.pn = (wgid % nig) / gsz; u.ka = 0; u.set = 0;
        if (skipctx) u.pm = u.pm + u.pm / 16 + 1;
        return true;
    }
    __device__ __forceinline__ void a_ready(const Unit&) const {}
    __device__ __forceinline__ void done(const Unit&) const {}
};

struct BranchOrder {
    static constexpr bool MULTI = true;
    TileOrder T; long dA1, dA2, dB; int lda0, dlda;
    __device__ __forceinline__ bool next(int i, Unit& u) const { if (i >= 3) return false; if (!T.next(0, u)) return false; u.set = i; return true; }
    __device__ __forceinline__ void opnd(const Unit& u, const Gemm& g, const bf16_t*& A, int& lda, const bf16_t*& Bt) const {
        A = g.A + (long)(u.set & 1) * dA1 + (long)(u.set >> 1) * dA2; lda = lda0 - (u.set >> 1) * dlda; Bt = g.Bt + (long)u.set * dB; }
    __device__ __forceinline__ void a_ready(const Unit&) const {}
    __device__ __forceinline__ void done(const Unit&) const {}
};
struct CtxSplitOrder {
    static constexpr bool MULTI = false;
    int G, c, kslice;
    __device__ __forceinline__ void init(int G_, int c_, int kslice_) { G = G_; c = c_; kslice = kslice_; }
    __device__ __forceinline__ bool next(int i, Unit& u) const { const int L = i * G + c; if (L >= 64) return false; const int t = L >> 2; u.pm = (t >> 2) * 17; u.pn = t & 3; u.ka = (L & 3) * kslice; u.set = 0; return true; }
    __device__ __forceinline__ void a_ready(const Unit&) const {}
    __device__ __forceinline__ void done(const Unit&) const {}
};
struct CtxTilesOrder {
    static constexpr bool MULTI = false;
    int G, c, nN;
    __device__ __forceinline__ void init(int G_, int c_, int nN_) { G = G_; c = c_; nN = nN_; }
    __device__ __forceinline__ bool next(int i, Unit& u) const { const int L = i * G + c; if (L >= 4 * nN) return false; u.pm = (L / nN) * 17; u.pn = L % nN; u.ka = 0; u.set = 0; return true; }
    __device__ __forceinline__ void a_ready(const Unit&) const {}
    __device__ __forceinline__ void done(const Unit&) const {}
};
__device__ __forceinline__ unsigned cvt_pk_bf16(float lo, float hi) { unsigned r; asm volatile("v_cvt_pk_bf16_f32 %0, %1, %2" : "=v"(r) : "v"(lo), "v"(hi)); return r; }
__device__ __forceinline__ float bf_lo(unsigned w) { return __uint_as_float(w << 16); }
__device__ __forceinline__ float bf_hi(unsigned w) { return __uint_as_float(w & 0xffff0000u); }

enum { EPI_BF16 = 0, EPI_RELU2 = 1, EPI_SIGMOID = 2, EPI_ROWSCALE = 3, EPI_MLAQ = 4, EPI_GATEMUL0 = 5, EPI_GATEMUL = 6, EPI_RESID = 7 };
template <int MODE, bool HN = false> struct Epi {
    static constexpr bool PERM = true, AFTER_DRAIN = false; static constexpr int NBJ = HN ? 1 : 2;
    bf16_t* O; int ldc;
    bf16_t* O1; bf16_t* O2;
    const float* rs;
    const PG8_LAS float* rsl;
    const bf16_t* G; int ldg;
    long dG1, dG2; int multi;
    const float* tc; const float* ts;
    int first;
    int pm_off, kslice;
    float* part;
    const void* xsl; const void* xsc; bf16_t* xdl; bf16_t* xdc; const float* gate; int sbf;
    __device__ __forceinline__ void operator()(const f32x4 (&acc)[2][2][4][2], const Unit& u, int wr, int wc, int fr, int fq) const {
        const int col0 = u.pn * (HN ? HALF : BM) + wc * 32 + 8 * fq;
        if constexpr (MODE == EPI_RESID) {
            int fro = fr; asm volatile("" : "+v"(fro));
            const int gpm = __builtin_amdgcn_readfirstlane(u.pm + pm_off), b = gpm / 17, t = gpm % 17;
            const size_t xo = (t == 0) ? (size_t)(b * CTX) * DM : (size_t)(b * SEQ + (t - 1) * 256) * DM;
            const long dsrc = (const char*)xsc - (const char*)xsl, ddst = (const char*)xdc - (const char*)xdl;
            const char* sbase = (const char*)xsl + ((t == 0) ? dsrc : 0L);
            const float* xs = (const float*)sbase + xo; const bf16_t* xb = (const bf16_t*)sbase + xo;
            bf16_t* xd = (bf16_t*)((char*)xdl + ((t == 0) ? ddst : 0L)) + xo;
            const float* gv = gate + (size_t)((t == 0) ? 4 : b) * 6144;
            f32x4 g[2][2];
#pragma unroll
            for (int bj = 0; bj < NBJ; ++bj)
#pragma unroll
                for (int n = 0; n < 2; ++n) g[bj][n] = *(const f32x4*)(gv + col0 + bj * HALF + 4 * n);
            if (u.ka != 0) {
                float* pp = part + (size_t)(u.ka / kslice - 1) * 1048576 + (size_t)(b * CTX) * DM;
#pragma unroll
                for (int ai = 0; ai < 2; ++ai)
#pragma unroll
                    for (int m = 0; m < 4; ++m) { const size_t ro = (size_t)(ai * HALF + wr * 64 + m * 16 + fro) * DM + col0;
#pragma unroll
                        for (int bj = 0; bj < NBJ; ++bj)
#pragma unroll
                            for (int n = 0; n < 2; ++n) *(f32x4*)(pp + ro + bj * HALF + 4 * n) = g[bj][n] * acc[ai][bj][m][n]; }
            } else {
#pragma unroll
                for (int am = 0; am < 4; ++am) { const int ai = am >> 1, m0 = (am & 1) * 2; f32x4 xv[2][2][2];
                    if (sbf) { u32x4 xw[2][2];
#pragma unroll
                        for (int mm = 0; mm < 2; ++mm) { const size_t ro = (size_t)(ai * HALF + wr * 64 + (m0 + mm) * 16 + fro) * DM + col0;
#pragma unroll
                            for (int bj = 0; bj < NBJ; ++bj) xw[mm][bj] = *(const u32x4*)(xb + ro + bj * HALF); }
#pragma unroll
                        for (int mm = 0; mm < 2; ++mm)
#pragma unroll
                            for (int bj = 0; bj < NBJ; ++bj) { const u32x4 w = xw[mm][bj];
                                xv[mm][bj][0] = (f32x4){bf_lo(w.x), bf_hi(w.x), bf_lo(w.y), bf_hi(w.y)}; xv[mm][bj][1] = (f32x4){bf_lo(w.z), bf_hi(w.z), bf_lo(w.w), bf_hi(w.w)}; } }
                    else {
#pragma unroll
                        for (int mm = 0; mm < 2; ++mm) { const size_t ro = (size_t)(ai * HALF + wr * 64 + (m0 + mm) * 16 + fro) * DM + col0;
#pragma unroll
                            for (int bj = 0; bj < NBJ; ++bj)
#pragma unroll
                                for (int n = 0; n < 2; ++n) xv[mm][bj][n] = *(const f32x4*)(xs + ro + bj * HALF + 4 * n); } }
#pragma unroll
                    for (int mm = 0; mm < 2; ++mm) { const size_t ro = (size_t)(ai * HALF + wr * 64 + (m0 + mm) * 16 + fro) * DM + col0;
#pragma unroll
                        for (int bj = 0; bj < NBJ; ++bj) { const f32x4 y0 = xv[mm][bj][0] + g[bj][0] * acc[ai][bj][m0 + mm][0], y1 = xv[mm][bj][1] + g[bj][1] * acc[ai][bj][m0 + mm][1];
                            u32x4 w; w.x = cvt_pk_bf16(y0[0], y0[1]); w.y = cvt_pk_bf16(y0[2], y0[3]); w.z = cvt_pk_bf16(y1[0], y1[1]); w.w = cvt_pk_bf16(y1[2], y1[3]);
                            *(u32x4*)(xd + ro + bj * HALF) = w; } } } }
        } else {
            const int row0 = u.pm * BM + wr * 64 + fr;
#pragma unroll
            for (int am = 0; am < 4; ++am) { const int ai = am >> 1, m0 = (am & 1) * 2;
                float rsv[4] = {1.f, 1.f, 1.f, 1.f}; u32x4 gwv[4][2], owv[4][2]; bool accum = false;
                if constexpr (MODE == EPI_ROWSCALE || MODE == EPI_MLAQ) {
#pragma unroll
                    for (int m = m0; m < m0 + 2; ++m) rsv[m] = rsl ? rsl[ai * HALF + wr * 64 + m * 16 + fr] : rs[row0 + ai * HALF + m * 16]; }
                if constexpr (MODE == EPI_GATEMUL0 || MODE == EPI_GATEMUL) {
                    const bf16_t* Gs = multi ? G + (long)(u.set & 1) * dG1 + (long)(u.set >> 1) * dG2 : G; accum = (MODE == EPI_GATEMUL) && !(multi ? u.set == 0 : first);
#pragma unroll
                    for (int m = m0; m < m0 + 2; ++m)
#pragma unroll
                        for (int bj = 0; bj < NBJ; ++bj) { const int row = row0 + ai * HALF + m * 16; gwv[m][bj] = *(const u32x4*)(Gs + (size_t)row * ldg + col0 + bj * HALF);
                            if (accum) owv[m][bj] = *(const u32x4*)(O + (size_t)row * ldc + col0 + bj * HALF); }
                    asm volatile("" ::: "memory"); }
#pragma unroll
                for (int m = m0; m < m0 + 2; ++m) { const int row = row0 + ai * HALF + m * 16; bf16_t* rowp = O + (size_t)row * ldc + col0;
                    if constexpr (MODE == EPI_SIGMOID && !HN) { const int bi = u.pn >> 2; rowp += (long)(bi & 1) * (O1 - O) + (long)(bi >> 1) * (O2 - O) - bi * 4 * BM; }
                    float rsc = 1.f; int pr = 0, pc = 0; bool lat = false;
                    if constexpr (MODE == EPI_ROWSCALE || MODE == EPI_MLAQ) rsc = rsv[m];
                    if constexpr (MODE == EPI_MLAQ) { const int s = row % RPB; lat = s >= CTX; const int tt = s - CTX; pr = (tt >> 6) & 63; pc = tt & 63; }
#pragma unroll
                    for (int bj = 0; bj < NBJ; ++bj) { f32x4 v0 = acc[ai][bj][m][0], v1 = acc[ai][bj][m][1];
                        if constexpr (MODE == EPI_RELU2) {
#pragma unroll
                            for (int e = 0; e < 4; ++e) { float a = fmaxf(v0[e], 0.f), b = fmaxf(v1[e], 0.f); v0[e] = a * a; v1[e] = b * b; } }
                        if constexpr (MODE == EPI_SIGMOID) {
#pragma unroll
                            for (int e = 0; e < 4; ++e) { v0[e] = 1.f / (1.f + __expf(-v0[e])); v1[e] = 1.f / (1.f + __expf(-v1[e])); } }
                        if constexpr (MODE == EPI_ROWSCALE || MODE == EPI_MLAQ) { v0 = v0 * rsc; v1 = v1 * rsc; }
                        if constexpr (MODE == EPI_MLAQ) {
                            const int g32 = u.pn * 8 + bj * 4 + wc;
                            if (g32 % 3 == 2) {
                                f32x4 p0, p1;
#pragma unroll
                                for (int e = 0; e < 4; ++e) { p0[e] = __shfl_xor(v0[e], 16); p1[e] = __shfl_xor(v1[e], 16); }
                                if (lat) { const int pos = (fq < 2) ? pr : pc; const f32x4 c0 = *(const f32x4*)(tc + pos * 8), c1 = *(const f32x4*)(tc + pos * 8 + 4), s0 = *(const f32x4*)(ts + pos * 8), s1 = *(const f32x4*)(ts + pos * 8 + 4);
                                    if ((fq & 1) == 0) { v0 = v0 * c0 - p0 * s0; v1 = v1 * c1 - p1 * s1; } else { v0 = p0 * s0 + v0 * c0; v1 = p1 * s1 + v1 * c1; } }
                            } }
                        if constexpr (MODE == EPI_GATEMUL0 || MODE == EPI_GATEMUL) {
                            const u32x4 gw = gwv[m][bj];
                            v0[0] *= bf_lo(gw.x); v0[1] *= bf_hi(gw.x); v0[2] *= bf_lo(gw.y); v0[3] *= bf_hi(gw.y); v1[0] *= bf_lo(gw.z); v1[1] *= bf_hi(gw.z); v1[2] *= bf_lo(gw.w); v1[3] *= bf_hi(gw.w);
                            if (accum) { const u32x4 ow = owv[m][bj];
                                v0[0] += bf_lo(ow.x); v0[1] += bf_hi(ow.x); v0[2] += bf_lo(ow.y); v0[3] += bf_hi(ow.y); v1[0] += bf_lo(ow.z); v1[1] += bf_hi(ow.z); v1[2] += bf_lo(ow.w); v1[3] += bf_hi(ow.w); } }
                        u32x4 w; w.x = cvt_pk_bf16(v0[0], v0[1]); w.y = cvt_pk_bf16(v0[2], v0[3]); w.z = cvt_pk_bf16(v1[0], v1[1]); w.w = cvt_pk_bf16(v1[2], v1[3]);
                        *(u32x4*)(rowp + bj * HALF) = w; } } }
        }
    }
};

template <class EpiT, class Sched, bool ALIGN_EPI, bool HN = false>
__device__ __forceinline__ void gemm_phase(PG8_LAS unsigned char* lds, const Gemm g, const Sched& S, const EpiT& E) {
    const int tid = otid(), wid = __builtin_amdgcn_readfirstlane(tid >> 6), lane = tid & 63, wr = wid >> 2, wc = wid & 3, fr = lane & 15, fq = lane >> 4;
    const int nt = g.K / BK;
    unsigned voffA[2], voffB[2]; int stR[2], stC[2];
#pragma unroll
    for (int i = 0; i < 2; ++i) { int R, C; stage_rc(tid * 16 + i * 8192, R, C); const int Rb = EpiT::PERM ? ((R & ~31) + perm32(R & 31)) : R; stR[i] = R; stC[i] = C;
        voffA[i] = (unsigned)(R * g.lda + C) * 2u; voffB[i] = (unsigned)(Rb * g.ldb + C) * 2u; }
    const size_t kstep = (size_t)(BK * 2);
    size_t hsA = (size_t)HALF * g.lda * 2; const size_t hsB = (size_t)HALF * g.ldb * 2, tsB = 2 * hsB;
#define PG8_OPND(u, pA, pB, vA, hA) do { if constexpr (Sched::MULTI) { const bf16_t* A_; const bf16_t* B_; int l_; S.opnd(u, g, A_, l_, B_); hA = (size_t)HALF * l_ * 2; \
            vA[0] = (unsigned)(stR[0] * l_ + stC[0]) * 2u; vA[1] = (unsigned)(stR[1] * l_ + stC[1]) * 2u; \
            pA = (const char*)A_ + (size_t)(u).pm * 2 * hA + (size_t)(u).ka * 2; pB = (const char*)B_ + (size_t)(u).pn * (HN ? hsB : tsB) + (size_t)(u).ka * 2; } \
        else { hA = (size_t)HALF * g.lda * 2; vA[0] = voffA[0]; vA[1] = voffA[1]; pA = (const char*)g.A + (size_t)(u).pm * 2 * hA + (size_t)(u).ka * 2; pB = (const char*)g.Bt + (size_t)(u).pn * (HN ? hsB : tsB) + (size_t)(u).ka * 2; } } while (0)
    const unsigned ldsw = (unsigned)wid * 1024u;
    const int aoff = lds_byte(wr * 64 + fr, fq * 8), boff = lds_byte(wc * 32 + fr, fq * 8);
#define PG8_SA(b, h) (((b) * 2 + (h)) * HTB)
#define PG8_SB(b, h) ((4 + (b) * 2 + (h)) * HTB)
#define PG8_STAGE(bufoff, gbase, voff) do { _Pragma("unroll") for (int _i = 0; _i < 2; ++_i) \
        __builtin_amdgcn_global_load_lds((const unsigned*)((const char*)(gbase) + (voff)[_i]), (PG8_LAS unsigned*)(lds + (bufoff) + ldsw + _i * 8192), 16, 0, 0); } while (0)
#define PG8_LDA(dst, b, h) do { _Pragma("unroll") for (int m = 0; m < 4; ++m) _Pragma("unroll") for (int k = 0; k < 2; ++k) dst[m][k] = *(const PG8_LAS bf16x8*)(lds + PG8_SA(b, h) + aoff + m * 2048 + k * 1024); } while (0)
#define PG8_LDB(dst, b, h) do { _Pragma("unroll") for (int n = 0; n < 2; ++n) _Pragma("unroll") for (int k = 0; k < 2; ++k) dst[n][k] = *(const PG8_LAS bf16x8*)(lds + PG8_SB(b, h) + boff + n * 2048 + k * 1024); } while (0)
#define PG8_MMA(ai, bj, At, Bt) do { __builtin_amdgcn_s_setprio(1); _Pragma("unroll") for (int m = 0; m < 4; ++m) _Pragma("unroll") for (int n = 0; n < 2; ++n) _Pragma("unroll") for (int k = 0; k < 2; ++k) \
        acc[ai][bj][m][n] = __builtin_amdgcn_mfma_f32_16x16x32_bf16(Bt[n][k], At[m][k], acc[ai][bj][m][n], 0, 0, 0); __builtin_amdgcn_s_setprio(0); } while (0)
#define PG8_WAIT_V(n) asm volatile("s_waitcnt vmcnt(" #n ")" ::: "memory")
#define PG8_WAIT_L(n) asm volatile("s_waitcnt lgkmcnt(" #n ")" ::: "memory")
#define PG8_BAR __builtin_amdgcn_s_barrier()
#define PG8_SCHED __builtin_amdgcn_sched_barrier(0)
    Unit cur, nxt; int ui = 0;
    if (!S.next(0, cur)) return;
    f32x4 acc[2][2][4][2];
    float zf; asm volatile("v_mov_b32 %0, 0" : "=v"(zf));
#pragma unroll
    for (int a = 0; a < 2; ++a)
#pragma unroll
        for (int b = 0; b < 2; ++b)
#pragma unroll
            for (int m = 0; m < 4; ++m)
#pragma unroll
                for (int n = 0; n < 2; ++n) acc[a][b][m][n] = (f32x4){zf, zf, zf, zf};
    bf16x8 At[4][2], B0[2][2], B1[2][2];
    const char* cA; const char* cB; PG8_OPND(cur, cA, cB, voffA, hsA);
    S.a_ready(cur);
    PG8_STAGE(PG8_SB(0, 0), cB, voffB); if constexpr (!HN) PG8_STAGE(PG8_SB(0, 1), cB + hsB, voffB); PG8_STAGE(PG8_SA(0, 0), cA, voffA); PG8_STAGE(PG8_SA(0, 1), cA + hsA, voffA);
    if (wr == 1) PG8_BAR;
    PG8_WAIT_V(2); PG8_BAR;
    PG8_STAGE(PG8_SB(1, 0), cB + kstep, voffB); PG8_STAGE(PG8_SA(1, 0), cA + kstep, voffA); if constexpr (!HN) PG8_STAGE(PG8_SB(1, 1), cB + hsB + kstep, voffB);
    if constexpr (HN) PG8_WAIT_V(4); else PG8_WAIT_V(6); PG8_BAR;
    for (;;) {
        const bool has_next = S.next(ui + 1, nxt);
        const char* nA = cA; const char* nB = cB; unsigned voffAn[2] = {voffA[0], voffA[1]}; size_t hsAn = hsA;
        if (has_next) PG8_OPND(nxt, nA, nB, voffAn, hsAn);
        for (int t = 0; t < nt; t += 2) {
            const bool last = (t == nt - 2);
            const char* a1 = cA + (size_t)(t + 1) * kstep;
            const char* a2 = last ? nA : cA + (size_t)(t + 2) * kstep; const char* b2 = last ? nB : cB + (size_t)(t + 2) * kstep;
            const char* a3 = a2 + kstep; const char* b3 = b2 + kstep;
            if (last && has_next) S.a_ready(nxt);
            unsigned vq[2] = {voffA[0], voffA[1]}; size_t hq = hsA;
            if constexpr (Sched::MULTI) { if (last) { vq[0] = voffAn[0]; vq[1] = voffAn[1]; hq = hsAn; } }
#define PG8_WAIT_G() do { if constexpr (HN) PG8_WAIT_V(6); else PG8_WAIT_V(8); } while (0)
            PG8_LDB(B0, 0, 0); if constexpr (!HN) PG8_LDB(B1, 0, 1); PG8_SCHED; PG8_LDA(At, 0, 0); PG8_STAGE(PG8_SA(1, 1), a1 + hsA, voffA);
            PG8_WAIT_G(); PG8_WAIT_L(0); PG8_BAR; PG8_MMA(0, 0, At, B0); if constexpr (!HN) PG8_MMA(0, 1, At, B1); PG8_BAR; PG8_SCHED;
            PG8_LDA(At, 0, 1); PG8_STAGE(PG8_SB(0, 0), b2, voffB); if constexpr (!HN) PG8_STAGE(PG8_SB(0, 1), b2 + hsB, voffB); PG8_STAGE(PG8_SA(0, 0), a2, vq);
            PG8_WAIT_G(); PG8_WAIT_L(0); PG8_BAR; PG8_MMA(1, 0, At, B0); if constexpr (!HN) PG8_MMA(1, 1, At, B1); PG8_BAR; PG8_SCHED;
            PG8_LDB(B0, 1, 0); if constexpr (!HN) PG8_LDB(B1, 1, 1); PG8_SCHED; PG8_LDA(At, 1, 0); PG8_STAGE(PG8_SA(0, 1), a2 + hq, vq);
            PG8_WAIT_G(); PG8_WAIT_L(0); PG8_BAR; PG8_MMA(0, 0, At, B0); if constexpr (!HN) PG8_MMA(0, 1, At, B1); PG8_BAR; PG8_SCHED;
            PG8_LDA(At, 1, 1); PG8_STAGE(PG8_SB(1, 0), b3, voffB); if constexpr (!HN) PG8_STAGE(PG8_SB(1, 1), b3 + hsB, voffB); PG8_STAGE(PG8_SA(1, 0), a3, vq);
            PG8_WAIT_G(); PG8_WAIT_L(0); PG8_BAR; PG8_MMA(1, 0, At, B0); if constexpr (!HN) PG8_MMA(1, 1, At, B1); PG8_BAR; PG8_SCHED;
#undef PG8_WAIT_G
        }
        if constexpr (ALIGN_EPI) { if (wr == 0) PG8_BAR; }
        E(acc, cur, wr, wc, fr, fq); S.done(cur);
        if (!has_next) break;
        asm volatile("v_mov_b32 %0, 0" : "=v"(zf));
#pragma unroll
        for (int a = 0; a < 2; ++a)
#pragma unroll
            for (int b = 0; b < 2; ++b)
#pragma unroll
                for (int m = 0; m < 4; ++m)
#pragma unroll
                    for (int n = 0; n < 2; ++n) acc[a][b][m][n] = (f32x4){zf, zf, zf, zf};
        cur = nxt; cA = nA; cB = nB; ++ui; voffA[0] = voffAn[0]; voffA[1] = voffAn[1]; hsA = hsAn;
        if constexpr (ALIGN_EPI) { if (wr == 1) PG8_BAR; }
    }
    PG8_WAIT_V(0);
    if constexpr (!ALIGN_EPI) { if (wr == 0) PG8_BAR; }
    PG8_BAR;
#undef PG8_OPND
#undef PG8_SA
#undef PG8_SB
#undef PG8_STAGE
#undef PG8_LDA
#undef PG8_LDB
#undef PG8_MMA
#undef PG8_WAIT_V
#undef PG8_WAIT_L
#undef PG8_BAR
#undef PG8_SCHED
}
}

namespace att {
using bf16 = unsigned short;
using bf16x8 = __attribute__((ext_vector_type(8))) short;
using s16x4 = __attribute__((ext_vector_type(4))) short;
using f32x16 = __attribute__((ext_vector_type(16))) float;
using u32x4 = __attribute__((ext_vector_type(4))) unsigned;
constexpr int NW = 8, QBLK = 32, KVBLK = 64;
constexpr float THR = 8.f;
#define SBAR() __builtin_amdgcn_sched_barrier(0)
__device__ __forceinline__ int crow(int r, int hi) { return (r & 3) + 8 * (r >> 2) + 4 * hi; }
__device__ __forceinline__ unsigned cvtpk(float lo, float hi) { unsigned r; asm volatile("v_cvt_pk_bf16_f32 %0, %1, %2" : "=v"(r) : "v"(lo), "v"(hi)); return r; }
template <int DQ> __device__ __forceinline__ int kaddr(int row, int c) {
    if constexpr (DQ == 64) return row * 128 + ((c ^ ((row >> 1) & 7)) << 4); else return row * 208 + c * 16; }
template <int DQ> constexpr int ktile_bytes() { return DQ == 64 ? 64 * 128 : 64 * 208; }
constexpr int VTILE = 64 * 64 * 2;
template <int DQ> constexpr int lds_bytes() { return 2 * ktile_bytes<DQ>() + 2 * VTILE + NW * 64 * 4; }

template <bool FIRST> __device__ __forceinline__ void partialSM(f32x16& p0, f32x16& p1, f32x16& nm16, float& alpha) {
    float pmax = p0[0];
#pragma unroll
    for (int r = 1; r < 16; ++r) pmax = fmaxf(pmax, p0[r]);
#pragma unroll
    for (int r = 0; r < 16; ++r) pmax = fmaxf(pmax, p1[r]);
    { auto rr = __builtin_amdgcn_permlane32_swap(__float_as_uint(pmax), __float_as_uint(pmax), false, false);
      pmax = fmaxf(__uint_as_float(rr[0]), __uint_as_float(rr[1])); }
    alpha = 1.f;
    if (FIRST || !__builtin_expect(__all(pmax <= THR), 1)) {
        const float dl = FIRST ? pmax : fmaxf(pmax, 0.f); if (!FIRST) alpha = __builtin_amdgcn_exp2f(-dl);
#pragma unroll
        for (int r = 0; r < 16; ++r) { nm16[r] -= dl; p0[r] -= dl; p1[r] -= dl; } }
#pragma unroll
    for (int r = 0; r < 16; ++r) p0[r] = __builtin_amdgcn_exp2f(p0[r]);
}
__device__ __forceinline__ void finishSM(f32x16& p0, f32x16& p1, float alpha, float& l_reg, bf16x8& pa0, bf16x8& pa1, bf16x8& pa2, bf16x8& pa3) {
#pragma unroll
    for (int r = 0; r < 16; ++r) p1[r] = __builtin_amdgcn_exp2f(p1[r]);
    float ps = 0;
#pragma unroll
    for (int r = 0; r < 16; ++r) ps += p0[r];
#pragma unroll
    for (int r = 0; r < 16; ++r) ps += p1[r];
    { auto rr = __builtin_amdgcn_permlane32_swap(__float_as_uint(ps), __float_as_uint(ps), false, false);
      ps = __uint_as_float(rr[0]) + __uint_as_float(rr[1]); }
    l_reg = l_reg * alpha + ps;
#define PK4(P, BASE, OUT) do { unsigned a0 = cvtpk(P[BASE + 0], P[BASE + 1]), a1 = cvtpk(P[BASE + 2], P[BASE + 3]);   \
    unsigned b0 = cvtpk(P[BASE + 4], P[BASE + 5]), b1 = cvtpk(P[BASE + 6], P[BASE + 7]);                              \
    auto r0 = __builtin_amdgcn_permlane32_swap(a0, b0, false, false); auto r1 = __builtin_amdgcn_permlane32_swap(a1, b1, false, false); \
    u32x4 w = {r0[0], r1[0], r0[1], r1[1]}; OUT = *reinterpret_cast<bf16x8*>(&w); } while (0)
    PK4(p0, 0, pa0); PK4(p0, 8, pa1); PK4(p1, 0, pa2); PK4(p1, 8, pa3);
#undef PK4
}
template <int DQ> __device__ __forceinline__ void qkt(f32x16& p0, f32x16& p1, const char* Ks, const bf16x8* qr, int r32, int hi, const f32x16& nm16) {
    p0 = nm16; p1 = nm16;
#pragma unroll
    for (int d0 = 0; d0 < DQ / 16; ++d0) { const int c = d0 * 2 + hi;
        const bf16x8 b0 = *reinterpret_cast<const bf16x8*>(Ks + kaddr<DQ>(r32, c));
        const bf16x8 b1 = *reinterpret_cast<const bf16x8*>(Ks + kaddr<DQ>(32 + r32, c));
        p0 = __builtin_amdgcn_mfma_f32_32x32x16_bf16(b0, qr[d0], p0, 0, 0, 0);
        p1 = __builtin_amdgcn_mfma_f32_32x32x16_bf16(b1, qr[d0], p1, 0, 0, 0); }
}
__device__ __forceinline__ int v_st(int k, int c) { const int kk = (k & ~0xC) | ((k & 4) << 1) | ((k & 8) >> 1); return ((kk >> 3) * 2 + (c >> 5)) * 512 + ((kk & 7) * 32 + (c & 31)) * 2; }
__device__ __forceinline__ int v_rd_base(int lane) { return ((lane & 3) << 3) | (((lane >> 2) & 3) << 6) | (((lane >> 4) & 1) << 5) | (((lane >> 5) & 1) << 8); }
constexpr int v_rd_off(int d0, int ks, int half) { return d0 * 512 + ks * 2048 + half * 1024; }
template <int OFF> __device__ __forceinline__ s16x4 tr_read(int vb) { s16x4 r; asm volatile("ds_read_b64_tr_b16 %0, %1 offset:%2" : "=&v"(r) : "v"(vb), "i"(OFF) : "memory"); return r; }
template <int D0> __device__ __forceinline__ void pv_one(f32x16& od, int vb, bf16x8 pa0, bf16x8 pa1, bf16x8 pa2, bf16x8 pa3) {
    const s16x4 l0 = tr_read<v_rd_off(D0, 0, 0)>(vb), h0 = tr_read<v_rd_off(D0, 0, 1)>(vb), l1 = tr_read<v_rd_off(D0, 1, 0)>(vb), h1 = tr_read<v_rd_off(D0, 1, 1)>(vb);
    const s16x4 l2 = tr_read<v_rd_off(D0, 2, 0)>(vb), h2 = tr_read<v_rd_off(D0, 2, 1)>(vb), l3 = tr_read<v_rd_off(D0, 3, 0)>(vb), h3 = tr_read<v_rd_off(D0, 3, 1)>(vb);
    asm volatile("s_waitcnt lgkmcnt(0)" ::: "memory"); SBAR();
#define PK(L, H) (bf16x8){L[0], L[1], L[2], L[3], H[0], H[1], H[2], H[3]}
    od = __builtin_amdgcn_mfma_f32_32x32x16_bf16(pa0, PK(l0, h0), od, 0, 0, 0);
    od = __builtin_amdgcn_mfma_f32_32x32x16_bf16(pa1, PK(l1, h1), od, 0, 0, 0);
    od = __builtin_amdgcn_mfma_f32_32x32x16_bf16(pa2, PK(l2, h2), od, 0, 0, 0);
    od = __builtin_amdgcn_mfma_f32_32x32x16_bf16(pa3, PK(l3, h3), od, 0, 0, 0);
#undef PK
}
struct Args { const bf16* Q; int ldq; const bf16* K0; int ldk0; const bf16* K1; int ldk1; const bf16* V; int ldv; bf16* O; int ldo; int nkeys; int rope_t0; const float* tc; const float* ts; };
template <int DQ>
__device__ __forceinline__ void attn_unit(const Args a, char* lds) {
    constexpr int KT = ktile_bytes<DQ>(), NLD = (DQ == 64) ? 2 : 3;
    const int tid = otid(), wid = tid >> 6, lane = tid & 63, r32 = lane & 31, hi = lane >> 5;
    char* V_lds = lds; char* K_lds = lds + 2 * VTILE;
    float* ws = (float*)(lds + 2 * VTILE + 2 * KT) + wid * 64; float* li_l = ws; float* al_l = ws + 32;
    float l_reg = 0; f32x16 o[2] = {}; f32x16 nm16 = {}; bf16x8 qr[DQ / 16];
    const bf16* Qw = a.Q + (long)(wid * QBLK + r32) * a.ldq + hi * 8;
#pragma unroll
    for (int d0 = 0; d0 < DQ / 16; ++d0) qr[d0] = *reinterpret_cast<const bf16x8*>(Qw + d0 * 16);
    if constexpr (DQ == 96) { if (a.rope_t0 >= 0) {
        const int tq = a.rope_t0 + wid * QBLK + r32, pr = (tq >> 6) & 63, pc = tq & 63;
#pragma unroll
        for (int f = 4; f < 6; ++f) { const int pos = (f == 4) ? pr : pc; u32x4 w = *reinterpret_cast<u32x4*>(&qr[f]); u32x4 o;
#pragma unroll
            for (int e = 0; e < 4; ++e) { const unsigned mine = w[e], oth = (unsigned)__shfl_xor((int)mine, 32);
                const float m0 = __uint_as_float(mine << 16), m1 = __uint_as_float(mine & 0xffff0000u), o0 = __uint_as_float(oth << 16), o1 = __uint_as_float(oth & 0xffff0000u);
                const float c0 = a.tc[pos * 8 + 2 * e], c1 = a.tc[pos * 8 + 2 * e + 1], s0 = a.ts[pos * 8 + 2 * e], s1 = a.ts[pos * 8 + 2 * e + 1];
                const float r0 = (hi == 0) ? m0 * c0 - o0 * s0 : o0 * s0 + m0 * c0, r1 = (hi == 0) ? m1 * c1 - o1 * s1 : o1 * s1 + m1 * c1;
                o[e] = cvtpk(r0, r1); }
            qr[f] = *reinterpret_cast<bf16x8*>(&o); } } }
    const int vrow = tid >> 3, vcol = (tid & 7) * 8, vst = v_st(vrow, vcol);
    const bf16* vsrc = a.V + (long)vrow * a.ldv + vcol; const long vstep = (long)KVBLK * a.ldv;
    int kr0, kc0, kr1 = 0, kc1 = 0;
    if constexpr (DQ == 64) { kr0 = tid >> 3; kc0 = tid & 7; } else { kr0 = tid / 12; kc0 = tid % 12; const int id1 = 512 + (tid & 255); kr1 = id1 / 12; kc1 = id1 % 12; }
    const bf16* ksrc0 = (kc0 < 8) ? a.K0 + (long)kr0 * a.ldk0 + kc0 * 8 : a.K1 + (long)kr0 * a.ldk1 + (kc0 - 8) * 8; const long kstep0 = (long)KVBLK * ((kc0 < 8) ? a.ldk0 : a.ldk1);
    const bf16* ksrc1 = ksrc0; long kstep1 = kstep0;
    if constexpr (DQ == 96) { ksrc1 = (kc1 < 8) ? a.K0 + (long)kr1 * a.ldk0 + kc1 * 8 : a.K1 + (long)kr1 * a.ldk1 + (kc1 - 8) * 8; kstep1 = (long)KVBLK * ((kc1 < 8) ? a.ldk0 : a.ldk1); }
    const int kst0 = kaddr<DQ>(kr0, kc0), kst1 = kaddr<DQ>(kr1, kc1);
    const int vb0 = (int)(uintptr_t)V_lds + v_rd_base(lane);
    struct { bf16x8 vs, ks0, ks1; } sr_[2];
#define SLOAD(i, t) do { sr_[i].vs = *reinterpret_cast<const bf16x8*>(vsrc + (long)(t) * vstep); sr_[i].ks0 = *reinterpret_cast<const bf16x8*>(ksrc0 + (long)(t) * kstep0); \
    if constexpr (DQ == 96) sr_[i].ks1 = *reinterpret_cast<const bf16x8*>(ksrc1 + (long)(t) * kstep1); } while (0)
#define SWRITE(b, i) do { *(bf16x8*)(V_lds + (b) * VTILE + vst) = sr_[i].vs; *(bf16x8*)(K_lds + (b) * KT + kst0) = sr_[i].ks0; \
    if constexpr (DQ == 96) *(bf16x8*)(K_lds + (b) * KT + kst1) = sr_[i].ks1; } while (0)
#define SWAIT() do { if constexpr (NLD == 2) asm volatile("s_waitcnt vmcnt(2)" ::: "memory"); else asm volatile("s_waitcnt vmcnt(3)" ::: "memory"); } while (0)
#define RESC(al) do { if (__any((al) < 1.f)) { if (hi == 0) al_l[r32] = (al); asm volatile("s_waitcnt lgkmcnt(0)" ::: "memory"); \
    _Pragma("unroll") for (int d = 0; d < 2; ++d) _Pragma("unroll") for (int r = 0; r < 16; ++r) o[d][r] *= al_l[crow(r, hi)]; } } while (0)
    f32x16 pA0, pA1, pB0, pB1; float alA, alB; bf16x8 pa0, pa1, pa2, pa3; const int NT = a.nkeys / KVBLK;
    constexpr int SE = 0, SO = 1;
    SLOAD(SE, 0); asm volatile("s_waitcnt vmcnt(0)" ::: "memory"); SWRITE(0, SE); __syncthreads();
    qkt<DQ>(pA0, pA1, K_lds, qr, r32, hi, nm16); partialSM<true>(pA0, pA1, nm16, alA);
    SLOAD(SO, 1); if (2 < NT) SLOAD(SE, 2);
    SWAIT(); SWRITE(1, SO); __syncthreads();
    for (int j = 1; j + 1 < NT; j += 2) {
        SBAR(); qkt<DQ>(pB0, pB1, K_lds + KT, qr, r32, hi, nm16);
        finishSM(pA0, pA1, alA, l_reg, pa0, pa1, pa2, pa3); SBAR();
        SLOAD(SO, j + 2); SBAR();
        pv_one<0>(o[0], vb0, pa0, pa1, pa2, pa3); pv_one<1>(o[1], vb0, pa0, pa1, pa2, pa3); partialSM<false>(pB0, pB1, nm16, alB);
        __syncthreads(); SWAIT(); SWRITE(0, SE);
        RESC(alB); __syncthreads();
        SBAR(); qkt<DQ>(pA0, pA1, K_lds, qr, r32, hi, nm16);
        finishSM(pB0, pB1, alB, l_reg, pa0, pa1, pa2, pa3); SBAR();
        if (j + 3 < NT) SLOAD(SE, j + 3); SBAR();
        pv_one<0>(o[0], vb0 + VTILE, pa0, pa1, pa2, pa3); pv_one<1>(o[1], vb0 + VTILE, pa0, pa1, pa2, pa3); partialSM<false>(pA0, pA1, nm16, alA);
        __syncthreads(); SWAIT(); SWRITE(1, SO);
        RESC(alA); __syncthreads();
    }
    SBAR(); qkt<DQ>(pB0, pB1, K_lds + KT, qr, r32, hi, nm16);
    finishSM(pA0, pA1, alA, l_reg, pa0, pa1, pa2, pa3); SBAR();
    pv_one<0>(o[0], vb0, pa0, pa1, pa2, pa3); pv_one<1>(o[1], vb0, pa0, pa1, pa2, pa3); partialSM<false>(pB0, pB1, nm16, alB);
    __syncthreads(); RESC(alB);
    finishSM(pB0, pB1, alB, l_reg, pa0, pa1, pa2, pa3); SBAR();
    pv_one<0>(o[0], vb0 + VTILE, pa0, pa1, pa2, pa3); pv_one<1>(o[1], vb0 + VTILE, pa0, pa1, pa2, pa3);
    if (hi == 0) li_l[r32] = l_reg; asm volatile("s_waitcnt lgkmcnt(0)" ::: "memory");
    float rli[16];
#pragma unroll
    for (int r = 0; r < 16; ++r) rli[r] = __builtin_amdgcn_rcpf(li_l[crow(r, hi)]);
    __syncthreads();
    { unsigned short* stg = (unsigned short*)(lds) + wid * 2048;
#pragma unroll
      for (int r = 0; r < 16; ++r) { const int orow = crow(r, hi);
#pragma unroll
        for (int d0 = 0; d0 < 2; ++d0) { const float v = o[d0][r] * rli[r]; const unsigned u = __float_as_uint(v); stg[orow * 64 + d0 * 32 + r32] = (unsigned short)((u + 0x7fffu + ((u >> 16) & 1u)) >> 16); } }
      asm volatile("s_waitcnt lgkmcnt(0)" ::: "memory");
      bf16* Ow = a.O + (long)(wid * QBLK) * a.ldo;
#pragma unroll
      for (int i = 0; i < 4; ++i) { const int row = i * 8 + (lane >> 3), ch = lane & 7; const u32x4 v = *(const u32x4*)(stg + row * 64 + ch * 8); *(u32x4*)(Ow + (long)row * a.ldo + ch * 8) = v; } }
    __syncthreads();
#undef SLOAD
#undef SWRITE
#undef SWAIT
#undef RESC
}
#undef SBAR
}

namespace at64 {
using att::bf16; using att::bf16x8; using att::s16x4; using att::f32x16; using att::u32x4;
constexpr int NW = 8, QBLK = 32, KVBLK = 64;
constexpr float C2 = 0.125f * 1.4426950408889634f;
constexpr float THR = 8.f;
constexpr int SLOTB = 8192, LDS_K = 0, LDS_V = 3 * SLOTB, LDS_WS = 6 * SLOTB, LDS_OST = LDS_WS + NW * 256, LDS_TOT = LDS_OST + NW * 4096;
#define A6_SBAR() __builtin_amdgcn_sched_barrier(0)
#define A6_PIN(x) asm volatile("" : "+v"(x))
#define A6_MFMA(a, b, c) __builtin_amdgcn_mfma_f32_32x32x16_bf16(a, b, c, 0, 0, 0)
#define A6_WAIT_BAR(N) asm volatile("s_waitcnt vmcnt(" #N ") lgkmcnt(0)\n\ts_barrier" ::: "memory")
__device__ __forceinline__ int crow(int r, int hi) { return (r & 3) + 8 * (r >> 2) + 4 * hi; }
__device__ __forceinline__ unsigned cvtpk(float lo, float hi) { unsigned r; asm("v_cvt_pk_bf16_f32 %0, %1, %2" : "=v"(r) : "v"(lo), "v"(hi)); return r; }
__device__ __forceinline__ void glds16(const void* g, unsigned lds_base) {
    unsigned sv; asm volatile("s_mov_b32 %0, m0\n\ts_mov_b32 m0, %2\n\ts_nop 0\n\tglobal_load_lds_dwordx4 %1, off\n\ts_mov_b32 m0, %0" : "=&s"(sv) : "v"(g), "s"(lds_base) : "memory"); }
typedef __attribute__((address_space(3))) const char* lds_cptr;
typedef short v4i16_t __attribute__((ext_vector_type(4)));
__device__ __forceinline__ void kload2(bf16x8* kf, lds_cptr kp, int d0) { kf[2 * d0] = *(const __attribute__((address_space(3))) bf16x8*)(kp + d0 * 2048); kf[2 * d0 + 1] = *(const __attribute__((address_space(3))) bf16x8*)(kp + d0 * 2048 + 512); }
__device__ __forceinline__ s16x4 vtr(lds_cptr p) { return __builtin_bit_cast(s16x4, __builtin_amdgcn_ds_read_tr16_b64_v4i16((__attribute__((address_space(3))) v4i16_t*)p)); }
#define A6_MX3(a, b, c) __builtin_fmaxf(__builtin_fmaxf((a), (b)), (c))
__device__ __forceinline__ float rowmax(const f32x16& p0, const f32x16& p1) {
    float a = A6_MX3(p0[0], p0[1], p1[0]), b = A6_MX3(p0[2], p0[3], p1[1]); a = A6_MX3(a, p1[2], p1[3]);
#pragma unroll
    for (int r = 4; r < 16; r += 4) { a = A6_MX3(a, p0[r], p0[r + 1]); b = A6_MX3(b, p0[r + 2], p0[r + 3]); a = A6_MX3(a, p1[r], p1[r + 1]); b = A6_MX3(b, p1[r + 2], p1[r + 3]); }
    float m = __builtin_fmaxf(a, b); auto rr = __builtin_amdgcn_permlane32_swap(__float_as_uint(m), __float_as_uint(m), false, false);
    return __builtin_fmaxf(__uint_as_float(rr[0]), __uint_as_float(rr[1])); }
struct Args { const bf16* Q; int ldq; const bf16* K; int ldk; const bf16* V; int ldv; bf16* O; int ldo; int nkeys; float* lse; };
__device__ __forceinline__ void unit(const Args a, char* lds) {
    const int tid = otid(), lane = tid & 63, r32 = lane & 31, hi = lane >> 5; const int wid = __builtin_amdgcn_readfirstlane(tid >> 6);
    const int NT = a.nkeys / KVBLK;
    const bf16* Qw = a.Q + (long)(wid * QBLK) * a.ldq;
    const unsigned lds0 = (unsigned)(uintptr_t)lds; float* wsf = (float*)(lds + LDS_WS) + wid * 64;
    const bf16* ksrc = a.K + (long)lane * a.ldk + wid * 8; const long kstep = (long)KVBLK * a.ldk;
    const bf16* vsrc = a.V + (long)(16 * (wid & 3) + (lane >> 2)) * a.ldv + (wid >> 2) * 32 + (lane & 3) * 8; const long vstep = (long)KVBLK * a.ldv;
    const unsigned kdst = lds0 + LDS_K + wid * 1024, vdst = lds0 + LDS_V + wid * 1024;
#define DMA_K(t, slot) glds16(ksrc + (long)(t) * kstep, (unsigned)__builtin_amdgcn_readfirstlane(kdst + (slot)))
#define DMA_V(t, slot) glds16(vsrc + (long)(t) * vstep, (unsigned)__builtin_amdgcn_readfirstlane(vdst + (slot)))
    const lds_cptr vp0 = (lds_cptr)lds + LDS_V + ((lane >> 4) & 1) * 32 + (lane & 3) * 8 + (4 * hi + ((lane & 15) >> 2)) * 64;
    const lds_cptr kp0 = (lds_cptr)lds + LDS_K + hi * 1024 + r32 * 16;
    DMA_K(0, 0); DMA_V(0, 0); DMA_K(1, SLOTB);
    bf16x8 qr[4];
#pragma unroll
    for (int d0 = 0; d0 < 4; ++d0) qr[d0] = *reinterpret_cast<const bf16x8*>(&Qw[(long)r32 * a.ldq + d0 * 16 + hi * 8]);
    float l_reg = 0.f; f32x16 o[2]; o[0] = f32x16{}; o[1] = f32x16{};
    f32x16 nmh16 = f32x16{}; A6_PIN(nmh16);
    bool resc = false;
    f32x16 pA0, pA1, pB0, pB1; bf16x8 kf[8]; s16x4 vlo[8], vhi[8]; u32x4 pw0, pw1, pw2, pw3;
    int sl_prev = 0, sl_cur = 0, sl_next = SLOTB;
#define ROT() do { sl_prev = sl_cur; sl_cur = sl_next; sl_next = (sl_next == 2 * SLOTB) ? 0 : sl_next + SLOTB; } while (0)
#define EX(v) __builtin_amdgcn_exp2f(v)
#define RESC() do { if (resc) { _Pragma("unroll") for (int d_ = 0; d_ < 2; ++d_) _Pragma("unroll") for (int r = 0; r < 16; ++r) o[d_][r] *= wsf[crow(r, hi)]; } } while (0)
    DMA_K(2, 2 * SLOTB);
    A6_WAIT_BAR(3);
    _Pragma("unroll") for (int d0 = 0; d0 < 4; ++d0) kload2(kf, kp0, d0);
    pA0 = A6_MFMA(kf[0], qr[0], nmh16); pA1 = A6_MFMA(kf[1], qr[0], nmh16); pA0 = A6_MFMA(kf[2], qr[1], pA0); pA1 = A6_MFMA(kf[3], qr[1], pA1);
    pA0 = A6_MFMA(kf[4], qr[2], pA0); pA1 = A6_MFMA(kf[5], qr[2], pA1); pA0 = A6_MFMA(kf[6], qr[3], pA0); pA1 = A6_MFMA(kf[7], qr[3], pA1);
    { const float rm = rowmax(pA0, pA1);
#pragma unroll
      for (int r = 0; r < 16; ++r) { nmh16[r] = -rm; pA0[r] = EX(pA0[r] - rm); pA1[r] = EX(pA1[r] - rm); } }
    A6_WAIT_BAR(0);
    DMA_K(3, 0); DMA_V(1, SLOTB); ROT();
    _Pragma("unroll") for (int d0 = 0; d0 < 4; ++d0) kload2(kf, kp0 + sl_cur, d0);
    A6_WAIT_BAR(2);
#define PKW(P, i) cvtpk(P[i], P[i + 1])
#define PAF(k) __builtin_bit_cast(bf16x8, pw##k)
#define VFR(i) (bf16x8){vlo[i][0], vlo[i][1], vlo[i][2], vlo[i][3], vhi[i][0], vhi[i][1], vhi[i][2], vhi[i][3]}
#define VRD(i) do { vlo[i] = vtr(vp_ + (((i) >> 2) * 4096 + ((i) & 3) * 1024)); vhi[i] = vtr(vp_ + (((i) >> 2) * 4096 + ((i) & 3) * 1024 + 512)); } while (0)
#define KRD(G, d0) do { if (G) { kload2(kf, kp0 + sl_next, d0); A6_SBAR(); } } while (0)
#define GAPA(MF, a0, a1, a2, a3, W0, W1, PW) do { MF; sacc += a0; sacc += a1; sacc += a2; sacc += a3; W0; W1; A6_PIN(PW); A6_PIN(sacc); A6_SBAR(); } while (0)
#define GAPB(MF, X, i) do { MF; X[i] = EX(X[i]); X[i + 1] = EX(X[i + 1]); X[i + 2] = EX(X[i + 2]); X[i + 3] = EX(X[i + 3]); A6_PIN(X); A6_SBAR(); } while (0)
#define STEP(C0, C1, P0, P1, t, GK, GV, GL) do { A6_SBAR(); \
    const lds_cptr vp_ = vp0 + sl_prev; \
    VRD(0); A6_SBAR(); float sacc = P0[0] + P0[1]; \
                       GAPA(C0 = A6_MFMA(kf[0], qr[0], nmh16), P0[2], P0[3], P0[4], P0[5],     pw0[0] = PKW(P0, 0),  pw0[1] = PKW(P0, 2),  pw0); \
    VRD(4); A6_SBAR(); GAPA(C1 = A6_MFMA(kf[1], qr[0], nmh16), P0[6], P0[7], P0[8], P0[9],     pw0[2] = PKW(P0, 4),  pw0[3] = PKW(P0, 6),  pw0); \
    VRD(1); A6_SBAR(); GAPA(C0 = A6_MFMA(kf[2], qr[1], C0),    P0[10], P0[11], P0[12], P0[13], pw1[0] = PKW(P0, 8),  pw1[1] = PKW(P0, 10), pw1); \
    VRD(5); A6_SBAR(); GAPA(C1 = A6_MFMA(kf[3], qr[1], C1),    P0[14], P0[15], P1[0], P1[1],   pw1[2] = PKW(P0, 12), pw1[3] = PKW(P0, 14), pw1); \
    VRD(2); A6_SBAR(); GAPA(C0 = A6_MFMA(kf[4], qr[2], C0),    P1[2], P1[3], P1[4], P1[5],     pw2[0] = PKW(P1, 0),  pw2[1] = PKW(P1, 2),  pw2); \
    VRD(6); A6_SBAR(); GAPA(C1 = A6_MFMA(kf[5], qr[2], C1),    P1[6], P1[7], P1[8], P1[9],     pw2[2] = PKW(P1, 4),  pw2[3] = PKW(P1, 6),  pw2); \
    VRD(3); A6_SBAR(); GAPA(C0 = A6_MFMA(kf[6], qr[3], C0),    P1[10], P1[11], P1[12], P1[13], pw3[0] = PKW(P1, 8),  pw3[1] = PKW(P1, 10), pw3); \
    VRD(7); A6_SBAR(); GAPA(C1 = A6_MFMA(kf[7], qr[3], C1),    P1[14], P1[15], 0.f, 0.f,       pw3[2] = PKW(P1, 12), pw3[3] = PKW(P1, 14), pw3); \
    l_reg += sacc; \
    if (GK) DMA_K((t) + 3, sl_cur); if (GV) DMA_V((t) + 1, sl_next); \
    { const float rm = rowmax(C0, C1); resc = false; \
      if (__builtin_expect(__any(rm > THR), 0)) { const float dl = __builtin_fmaxf(rm, 0.f); \
          _Pragma("unroll") for (int r_ = 0; r_ < 16; ++r_) { nmh16[r_] -= dl; C0[r_] -= dl; C1[r_] -= dl; } \
          const float f = __builtin_amdgcn_exp2f(-dl); l_reg *= f; if (hi == 0) wsf[r32] = f; resc = true; } } \
    A6_SBAR(); \
    GAPB(o[0] = A6_MFMA(PAF(0), VFR(0), o[0]), C0, 0);              GAPB(o[1] = A6_MFMA(PAF(0), VFR(4), o[1]), C0, 4); \
    KRD(GL, 0); GAPB(o[0] = A6_MFMA(PAF(1), VFR(1), o[0]), C0, 8);  KRD(GL, 1); GAPB(o[1] = A6_MFMA(PAF(1), VFR(5), o[1]), C0, 12); \
    KRD(GL, 2); GAPB(o[0] = A6_MFMA(PAF(2), VFR(2), o[0]), C1, 0);  KRD(GL, 3); GAPB(o[1] = A6_MFMA(PAF(2), VFR(6), o[1]), C1, 4); \
    GAPB(o[0] = A6_MFMA(PAF(3), VFR(3), o[0]), C1, 8);              GAPB(o[1] = A6_MFMA(PAF(3), VFR(7), o[1]), C1, 12); \
    } while (0)
    int t = 1;
    for (; t + 5 < NT; t += 2) {
        STEP(pB0, pB1, pA0, pA1, t, true, true, true);     A6_WAIT_BAR(2); RESC(); ROT();
        STEP(pA0, pA1, pB0, pB1, t + 1, true, true, true); A6_WAIT_BAR(2); RESC(); ROT();
    }
#define ENDW(tt) do { if ((tt) + 3 < NT) { A6_WAIT_BAR(2); } else if ((tt) + 2 < NT) { A6_WAIT_BAR(1); } else { A6_WAIT_BAR(0); } } while (0)
    for (; t + 1 < NT; t += 2) {
        STEP(pB0, pB1, pA0, pA1, t, (t + 3 < NT), (t + 1 < NT), (t + 1 < NT));         ENDW(t);     RESC(); ROT();
        STEP(pA0, pA1, pB0, pB1, t + 1, (t + 4 < NT), (t + 2 < NT), (t + 2 < NT));     ENDW(t + 1); RESC(); ROT();
    }
    STEP(pB0, pB1, pA0, pA1, NT - 1, false, false, false); RESC();
    { float sacc = pB0[0] + pB0[1];
#pragma unroll
      for (int r = 2; r < 16; ++r) sacc += pB0[r];
#pragma unroll
      for (int r = 0; r < 16; ++r) sacc += pB1[r];
      l_reg += sacc;
      pw0 = (u32x4){PKW(pB0, 0), PKW(pB0, 2), PKW(pB0, 4), PKW(pB0, 6)}; pw1 = (u32x4){PKW(pB0, 8), PKW(pB0, 10), PKW(pB0, 12), PKW(pB0, 14)};
      pw2 = (u32x4){PKW(pB1, 0), PKW(pB1, 2), PKW(pB1, 4), PKW(pB1, 6)}; pw3 = (u32x4){PKW(pB1, 8), PKW(pB1, 10), PKW(pB1, 12), PKW(pB1, 14)};
      const lds_cptr vp_ = vp0 + sl_cur; _Pragma("unroll") for (int i = 0; i < 8; ++i) VRD(i);
      o[0] = A6_MFMA(PAF(0), VFR(0), o[0]); o[1] = A6_MFMA(PAF(0), VFR(4), o[1]); o[0] = A6_MFMA(PAF(1), VFR(1), o[0]); o[1] = A6_MFMA(PAF(1), VFR(5), o[1]);
      o[0] = A6_MFMA(PAF(2), VFR(2), o[0]); o[1] = A6_MFMA(PAF(2), VFR(6), o[1]); o[0] = A6_MFMA(PAF(3), VFR(3), o[0]); o[1] = A6_MFMA(PAF(3), VFR(7), o[1]); }
    { auto rr = __builtin_amdgcn_permlane32_swap(__float_as_uint(l_reg), __float_as_uint(l_reg), false, false); l_reg = __uint_as_float(rr[0]) + __uint_as_float(rr[1]); }
    if (hi == 0) wsf[32 + r32] = l_reg; asm volatile("s_waitcnt lgkmcnt(0)" ::: "memory");
    if (a.lse != nullptr && hi == 0) a.lse[wid * QBLK + r32] = __builtin_amdgcn_logf(l_reg) - nmh16[0];
    float rli[16];
#pragma unroll
    for (int r = 0; r < 16; ++r) rli[r] = __builtin_amdgcn_rcpf(wsf[32 + crow(r, hi)]);
    bf16* Ow = a.O + (long)(wid * QBLK) * a.ldo; unsigned short* stg = (unsigned short*)(lds + LDS_OST) + wid * 2048;
#pragma unroll
    for (int r = 0; r < 16; ++r) { const int orow = crow(r, hi);
#pragma unroll
        for (int d0 = 0; d0 < 2; ++d0) { const float v = o[d0][r] * rli[r]; const unsigned u = __float_as_uint(v); stg[orow * 64 + d0 * 32 + r32] = (unsigned short)((u + 0x7fffu + ((u >> 16) & 1u)) >> 16); } }
    asm volatile("s_waitcnt lgkmcnt(0)" ::: "memory");
#pragma unroll
    for (int i = 0; i < 4; ++i) { const int row = i * 8 + (lane >> 3), ch = lane & 7; *(u32x4*)(Ow + (long)row * a.ldo + ch * 8) = *(const u32x4*)(stg + row * 64 + ch * 8); }
    asm volatile("s_waitcnt lgkmcnt(0)\n\ts_barrier" ::: "memory");
#undef DMA_K
#undef DMA_V
#undef ROT
#undef EX
#undef RESC
#undef PKW
#undef PAF
#undef VFR
#undef VRD
#undef KRD
#undef ENDW
#undef GAPA
#undef GAPB
#undef STEP
}
#undef A6_SBAR
#undef A6_PIN
#undef A6_MFMA
#undef A6_WAIT_BAR
#undef A6_MX3
}

namespace at96 {
using att::bf16; using att::bf16x8; using att::s16x4; using att::f32x16; using att::u32x4;
using at64::crow; using at64::cvtpk; using at64::glds16; using at64::lds_cptr; using at64::kload2; using at64::vtr; using at64::rowmax;
constexpr int NW = 8, QBLK = 32, KVBLK = 64;
constexpr float THR = 8.f;
constexpr int SLOTB = 8192, SLOTR = 4096, LDS_K = 0, LDS_V = 3 * SLOTB, LDS_R = 6 * SLOTB, LDS_WS = LDS_R + 4 * SLOTR, LDS_OST = LDS_WS + NW * 256, LDS_TOT = LDS_OST + NW * 4096;
#define A9_SBAR() __builtin_amdgcn_sched_barrier(0)
#define A9_PIN(x) asm volatile("" : "+v"(x))
#define A9_MFMA(a, b, c) __builtin_amdgcn_mfma_f32_32x32x16_bf16(a, b, c, 0, 0, 0)
#define A9_WAIT_BAR(N) asm volatile("s_waitcnt vmcnt(" #N ") lgkmcnt(0)\n\ts_barrier" ::: "memory")
struct Args { const bf16* Q; int ldq; const bf16* K0; int ldk0; const bf16* K1; int ldk1; const bf16* V; int ldv; bf16* O; int ldo; int nkeys; int rope_t0; const float* tc; const float* ts; };
__device__ __forceinline__ void unit(const Args a, char* lds) {
    const int tid = otid(), lane = tid & 63, r32 = lane & 31, hi = lane >> 5; const int wid = __builtin_amdgcn_readfirstlane(tid >> 6);
    const int NT = a.nkeys / KVBLK;
    const bf16* Qw = a.Q + (long)(wid * QBLK) * a.ldq;
    const unsigned lds0 = (unsigned)(uintptr_t)lds; float* wsf = (float*)(lds + LDS_WS) + wid * 64;
    const bf16* ksrc = a.K0 + (long)lane * a.ldk0 + wid * 8; const long kstep = (long)KVBLK * a.ldk0;
    const bf16* rsrc = a.K1 + (long)(32 * (wid & 1) + r32) * a.ldk1 + (wid >> 1) * 8; const long rstep = (long)KVBLK * a.ldk1;
    const bf16* vsrc = a.V + (long)(16 * (wid & 3) + (lane >> 2)) * a.ldv + (wid >> 2) * 32 + (lane & 3) * 8; const long vstep = (long)KVBLK * a.ldv;
    const unsigned kdst = lds0 + LDS_K + wid * 1024, vdst = lds0 + LDS_V + wid * 1024, rdst = lds0 + LDS_R + (wid >> 1) * 1024 + (wid & 1) * 512;
#define DMA_K(t, slot, rslot) do { glds16(ksrc + (long)(t) * kstep, (unsigned)__builtin_amdgcn_readfirstlane(kdst + (slot))); \
        if (lane < 32) glds16(rsrc + (long)(t) * rstep, (unsigned)__builtin_amdgcn_readfirstlane(rdst + (rslot))); } while (0)
#define DMA_V(t, slot) glds16(vsrc + (long)(t) * vstep, (unsigned)__builtin_amdgcn_readfirstlane(vdst + (slot)))
    const lds_cptr vp0 = (lds_cptr)lds + LDS_V + ((lane >> 4) & 1) * 32 + (lane & 3) * 8 + (4 * hi + ((lane & 15) >> 2)) * 64;
    const lds_cptr kp0 = (lds_cptr)lds + LDS_K + hi * 1024 + r32 * 16;
    const lds_cptr rp0 = (lds_cptr)lds + LDS_R + hi * 1024 + r32 * 16;
    DMA_K(0, 0, 0); DMA_V(0, 0); DMA_K(1, SLOTB, SLOTR);
    bf16x8 qr[6];
#pragma unroll
    for (int d0 = 0; d0 < 6; ++d0) qr[d0] = *reinterpret_cast<const bf16x8*>(&Qw[(long)r32 * a.ldq + d0 * 16 + hi * 8]);
    if (a.rope_t0 >= 0) {
        const int tq = a.rope_t0 + wid * QBLK + r32, pr = (tq >> 6) & 63, pc = tq & 63;
#pragma unroll
        for (int f = 4; f < 6; ++f) { const int pos = (f == 4) ? pr : pc; u32x4 w = *reinterpret_cast<u32x4*>(&qr[f]); u32x4 o_;
            typedef float f32x4_ __attribute__((ext_vector_type(4)));
            const f32x4_ tc0 = *(const f32x4_*)(a.tc + pos * 8), tc1 = *(const f32x4_*)(a.tc + pos * 8 + 4), ts0 = *(const f32x4_*)(a.ts + pos * 8), ts1 = *(const f32x4_*)(a.ts + pos * 8 + 4);
            const float tcv[8] = {tc0[0], tc0[1], tc0[2], tc0[3], tc1[0], tc1[1], tc1[2], tc1[3]}, tsv[8] = {ts0[0], ts0[1], ts0[2], ts0[3], ts1[0], ts1[1], ts1[2], ts1[3]};
#pragma unroll
            for (int e = 0; e < 4; ++e) { const unsigned mine = w[e], oth = (unsigned)__shfl_xor((int)mine, 32);
                const float m0 = __uint_as_float(mine << 16), m1 = __uint_as_float(mine & 0xffff0000u), o0 = __uint_as_float(oth << 16), o1 = __uint_as_float(oth & 0xffff0000u);
                const float c0 = tcv[2 * e], c1 = tcv[2 * e + 1], s0 = tsv[2 * e], s1 = tsv[2 * e + 1];
                const float r0 = (hi == 0) ? m0 * c0 - o0 * s0 : o0 * s0 + m0 * c0, r1 = (hi == 0) ? m1 * c1 - o1 * s1 : o1 * s1 + m1 * c1;
                o_[e] = cvtpk(r0, r1); }
            qr[f] = *reinterpret_cast<bf16x8*>(&o_); } }
    float l_reg = 0.f; f32x16 o[2]; o[0] = f32x16{}; o[1] = f32x16{};
    f32x16 nmh16 = f32x16{}; A9_PIN(nmh16);
    bool resc = false;
    f32x16 pA0, pA1, pB0, pB1; bf16x8 kf[8], kr[4]; s16x4 vlo[8], vhi[8]; u32x4 pw0, pw1, pw2, pw3;
    int sl_prev = 0, sl_cur = 0, sl_next = SLOTB, rs_cur = 0;
#define ROT() do { sl_prev = sl_cur; sl_cur = sl_next; sl_next = (sl_next == 2 * SLOTB) ? 0 : sl_next + SLOTB; rs_cur = (rs_cur + SLOTR) & (4 * SLOTR - 1); } while (0)
#define RS3() ((rs_cur + 3 * SLOTR) & (4 * SLOTR - 1))
#define EX(v) __builtin_amdgcn_exp2f(v)
#define RESC() do { if (resc) { _Pragma("unroll") for (int d_ = 0; d_ < 2; ++d_) _Pragma("unroll") for (int r = 0; r < 16; ++r) o[d_][r] *= wsf[crow(r, hi)]; } } while (0)
    DMA_K(2, 2 * SLOTB, 2 * SLOTR);
    A9_WAIT_BAR(5);
    _Pragma("unroll") for (int d0 = 0; d0 < 4; ++d0) kload2(kf, kp0, d0);
    kload2(kr, rp0, 0); kload2(kr, rp0, 1);
    pA0 = A9_MFMA(kf[0], qr[0], nmh16); pA1 = A9_MFMA(kf[1], qr[0], nmh16); pA0 = A9_MFMA(kf[2], qr[1], pA0); pA1 = A9_MFMA(kf[3], qr[1], pA1);
    pA0 = A9_MFMA(kf[4], qr[2], pA0); pA1 = A9_MFMA(kf[5], qr[2], pA1); pA0 = A9_MFMA(kf[6], qr[3], pA0); pA1 = A9_MFMA(kf[7], qr[3], pA1);
    pA0 = A9_MFMA(kr[0], qr[4], pA0); pA1 = A9_MFMA(kr[1], qr[4], pA1); pA0 = A9_MFMA(kr[2], qr[5], pA0); pA1 = A9_MFMA(kr[3], qr[5], pA1);
    { const float rm = rowmax(pA0, pA1);
#pragma unroll
      for (int r = 0; r < 16; ++r) { nmh16[r] = -rm; pA0[r] = EX(pA0[r] - rm); pA1[r] = EX(pA1[r] - rm); } }
    A9_WAIT_BAR(0);
    DMA_K(3, 0, 3 * SLOTR); DMA_V(1, SLOTB); ROT();
    _Pragma("unroll") for (int d0 = 0; d0 < 4; ++d0) kload2(kf, kp0 + sl_cur, d0);
    A9_WAIT_BAR(3);
#define PKW(P, i) cvtpk(P[i], P[i + 1])
#define PAF(k) __builtin_bit_cast(bf16x8, pw##k)
#define VFR(i) (bf16x8){vlo[i][0], vlo[i][1], vlo[i][2], vlo[i][3], vhi[i][0], vhi[i][1], vhi[i][2], vhi[i][3]}
#define VRD(i) do { vlo[i] = vtr(vp_ + (((i) >> 2) * 4096 + ((i) & 3) * 1024)); vhi[i] = vtr(vp_ + (((i) >> 2) * 4096 + ((i) & 3) * 1024 + 512)); } while (0)
#define KRD(G, d0) do { if (G) { kload2(kf, kp0 + sl_next, d0); A9_SBAR(); } } while (0)
#define GAP3(MF, a0, a1, a2, W0, PW) do { MF; sacc += a0; sacc += a1; sacc += a2; W0; A9_PIN(PW); A9_PIN(sacc); A9_SBAR(); } while (0)
#define GAP2(MF, a0, a1, W0, W1, PW) do { MF; sacc += a0; sacc += a1; W0; W1; A9_PIN(PW); A9_PIN(sacc); A9_SBAR(); } while (0)
#define GAPB(MF, X, i) do { MF; X[i] = EX(X[i]); X[i + 1] = EX(X[i + 1]); X[i + 2] = EX(X[i + 2]); X[i + 3] = EX(X[i + 3]); A9_PIN(X); A9_SBAR(); } while (0)
#define STEP(C0, C1, P0, P1, t, GK, GV, GL) do { A9_SBAR(); \
    const lds_cptr vp_ = vp0 + sl_prev; const lds_cptr rp_ = rp0 + rs_cur; \
    VRD(0); kload2(kr, rp_, 0); A9_SBAR(); float sacc = P0[0] + P0[1]; \
                       GAP3(C0 = A9_MFMA(kf[0], qr[0], nmh16), P0[2], P0[3], P0[4],    pw0[0] = PKW(P0, 0), pw0); \
    VRD(4); kload2(kr, rp_, 1); A9_SBAR(); \
                       GAP3(C1 = A9_MFMA(kf[1], qr[0], nmh16), P0[5], P0[6], P0[7],    pw0[1] = PKW(P0, 2), pw0); \
    VRD(1); A9_SBAR(); GAP2(C0 = A9_MFMA(kf[2], qr[1], C0),    P0[8], P0[9],           pw0[2] = PKW(P0, 4), pw0[3] = PKW(P0, 6), pw0); \
    VRD(5); A9_SBAR(); GAP3(C1 = A9_MFMA(kf[3], qr[1], C1),    P0[10], P0[11], P0[12], pw1[0] = PKW(P0, 8), pw1); \
    VRD(2); A9_SBAR(); GAP3(C0 = A9_MFMA(kf[4], qr[2], C0),    P0[13], P0[14], P0[15], pw1[1] = PKW(P0, 10), pw1); \
    VRD(6); A9_SBAR(); GAP2(C1 = A9_MFMA(kf[5], qr[2], C1),    P1[0], P1[1],           pw1[2] = PKW(P0, 12), pw1[3] = PKW(P0, 14), pw1); \
    VRD(3); A9_SBAR(); GAP3(C0 = A9_MFMA(kf[6], qr[3], C0),    P1[2], P1[3], P1[4],    pw2[0] = PKW(P1, 0), pw2); \
    VRD(7); A9_SBAR(); GAP3(C1 = A9_MFMA(kf[7], qr[3], C1),    P1[5], P1[6], P1[7],    pw2[1] = PKW(P1, 2), pw2); \
                       GAP2(C0 = A9_MFMA(kr[0], qr[4], C0),    P1[8], P1[9],           pw2[2] = PKW(P1, 4), pw2[3] = PKW(P1, 6), pw2); \
                       GAP3(C1 = A9_MFMA(kr[1], qr[4], C1),    P1[10], P1[11], P1[12], pw3[0] = PKW(P1, 8), pw3); \
                       GAP3(C0 = A9_MFMA(kr[2], qr[5], C0),    P1[13], P1[14], P1[15], pw3[1] = PKW(P1, 10), pw3); \
                       GAP2(C1 = A9_MFMA(kr[3], qr[5], C1),    0.f, 0.f,               pw3[2] = PKW(P1, 12), pw3[3] = PKW(P1, 14), pw3); \
    l_reg += sacc; \
    if (GK) DMA_K((t) + 3, sl_cur, RS3()); if (GV) DMA_V((t) + 1, sl_next); \
    { const float rm = rowmax(C0, C1); resc = false; \
      if (__builtin_expect(__any(rm > THR), 0)) { const float dl = __builtin_fmaxf(rm, 0.f); \
          _Pragma("unroll") for (int r_ = 0; r_ < 16; ++r_) { nmh16[r_] -= dl; C0[r_] -= dl; C1[r_] -= dl; } \
          const float f = __builtin_amdgcn_exp2f(-dl); l_reg *= f; if (hi == 0) wsf[r32] = f; resc = true; } } \
    A9_SBAR(); \
    GAPB(o[0] = A9_MFMA(PAF(0), VFR(0), o[0]), C0, 0);              GAPB(o[1] = A9_MFMA(PAF(0), VFR(4), o[1]), C0, 4); \
    KRD(GL, 0); GAPB(o[0] = A9_MFMA(PAF(1), VFR(1), o[0]), C0, 8);  KRD(GL, 1); GAPB(o[1] = A9_MFMA(PAF(1), VFR(5), o[1]), C0, 12); \
    KRD(GL, 2); GAPB(o[0] = A9_MFMA(PAF(2), VFR(2), o[0]), C1, 0);  KRD(GL, 3); GAPB(o[1] = A9_MFMA(PAF(2), VFR(6), o[1]), C1, 4); \
    GAPB(o[0] = A9_MFMA(PAF(3), VFR(3), o[0]), C1, 8);              GAPB(o[1] = A9_MFMA(PAF(3), VFR(7), o[1]), C1, 12); \
    } while (0)
    int t = 1;
    for (; t + 5 < NT; t += 2) {
        STEP(pB0, pB1, pA0, pA1, t, true, true, true);     A9_WAIT_BAR(3); RESC(); ROT();
        STEP(pA0, pA1, pB0, pB1, t + 1, true, true, true); A9_WAIT_BAR(3); RESC(); ROT();
    }
#define ENDW(tt) do { if ((tt) + 3 < NT) { A9_WAIT_BAR(3); } else if ((tt) + 2 < NT) { A9_WAIT_BAR(1); } else { A9_WAIT_BAR(0); } } while (0)
    for (; t + 1 < NT; t += 2) {
        STEP(pB0, pB1, pA0, pA1, t, (t + 3 < NT), (t + 1 < NT), (t + 1 < NT));         ENDW(t);     RESC(); ROT();
        STEP(pA0, pA1, pB0, pB1, t + 1, (t + 4 < NT), (t + 2 < NT), (t + 2 < NT));     ENDW(t + 1); RESC(); ROT();
    }
    STEP(pB0, pB1, pA0, pA1, NT - 1, false, false, false); RESC();
    { float sacc = pB0[0] + pB0[1];
#pragma unroll
      for (int r = 2; r < 16; ++r) sacc += pB0[r];
#pragma unroll
      for (int r = 0; r < 16; ++r) sacc += pB1[r];
      l_reg += sacc;
      pw0 = (u32x4){PKW(pB0, 0), PKW(pB0, 2), PKW(pB0, 4), PKW(pB0, 6)}; pw1 = (u32x4){PKW(pB0, 8), PKW(pB0, 10), PKW(pB0, 12), PKW(pB0, 14)};
      pw2 = (u32x4){PKW(pB1, 0), PKW(pB1, 2), PKW(pB1, 4), PKW(pB1, 6)}; pw3 = (u32x4){PKW(pB1, 8), PKW(pB1, 10), PKW(pB1, 12), PKW(pB1, 14)};
      const lds_cptr vp_ = vp0 + sl_cur; _Pragma("unroll") for (int i = 0; i < 8; ++i) VRD(i);
      o[0] = A9_MFMA(PAF(0), VFR(0), o[0]); o[1] = A9_MFMA(PAF(0), VFR(4), o[1]); o[0] = A9_MFMA(PAF(1), VFR(1), o[0]); o[1] = A9_MFMA(PAF(1), VFR(5), o[1]);
      o[0] = A9_MFMA(PAF(2), VFR(2), o[0]); o[1] = A9_MFMA(PAF(2), VFR(6), o[1]); o[0] = A9_MFMA(PAF(3), VFR(3), o[0]); o[1] = A9_MFMA(PAF(3), VFR(7), o[1]); }
    { auto rr = __builtin_amdgcn_permlane32_swap(__float_as_uint(l_reg), __float_as_uint(l_reg), false, false); l_reg = __uint_as_float(rr[0]) + __uint_as_float(rr[1]); }
    if (hi == 0) wsf[32 + r32] = l_reg; asm volatile("s_waitcnt lgkmcnt(0)" ::: "memory");
    float rli[16];
#pragma unroll
    for (int r = 0; r < 16; ++r) rli[r] = __builtin_amdgcn_rcpf(wsf[32 + crow(r, hi)]);
    bf16* Ow = a.O + (long)(wid * QBLK) * a.ldo; unsigned short* stg = (unsigned short*)(lds + LDS_OST) + wid * 2048;
#pragma unroll
    for (int r = 0; r < 16; ++r) { const int orow = crow(r, hi);
#pragma unroll
        for (int d0 = 0; d0 < 2; ++d0) { const float v = o[d0][r] * rli[r]; const unsigned u = __float_as_uint(v); stg[orow * 64 + d0 * 32 + r32] = (unsigned short)((u + 0x7fffu + ((u >> 16) & 1u)) >> 16); } }
    asm volatile("s_waitcnt lgkmcnt(0)" ::: "memory");
#pragma unroll
    for (int i = 0; i < 4; ++i) { const int row = i * 8 + (lane >> 3), ch = lane & 7; *(u32x4*)(Ow + (long)row * a.ldo + ch * 8) = *(const u32x4*)(stg + row * 64 + ch * 8); }
    asm volatile("s_waitcnt lgkmcnt(0)\n\ts_barrier" ::: "memory");
#undef DMA_K
#undef DMA_V
#undef ROT
#undef RS3
#undef EX
#undef RESC
#undef PKW
#undef PAF
#undef VFR
#undef VRD
#undef KRD
#undef ENDW
#undef GAP3
#undef GAP2
#undef GAPB
#undef STEP
}
#undef A9_SBAR
#undef A9_PIN
#undef A9_MFMA
#undef A9_WAIT_BAR
}

constexpr size_t MiB = 1u << 20;
constexpr size_t WS_CTL = 0, CTL_BYTES = 1 * MiB;
constexpr size_t WS_MOD = 1 * MiB;
constexpr size_t WS_T16C = WS_MOD + 256 * 1024, WS_T16S = WS_T16C + 4096, WS_T8C = WS_T16S + 4096, WS_T8S = WS_T8C + 2048;
constexpr size_t WS_RSQ = WS_MOD + 320 * 1024, WS_RSKV = WS_RSQ + 64 * 1024;
constexpr size_t WS_TAB = WS_MOD + 512 * 1024;
constexpr size_t WS_WT = 3 * MiB;
constexpr size_t WT_IN = 0, WT_G = WT_IN + (size_t)PPW * DM * 2, WT_QU = WT_G + (size_t)NGATE * DM * 2, WT_KVU = WT_QU + (size_t)768 * 384 * 2, WT_BR = WT_KVU + (size_t)1024 * 256 * 2,
                 WT_OUT = WT_BR + (size_t)3 * DM * 512 * 2, WT_F1 = WT_OUT + (size_t)DM * DM * 2, WT_F2 = WT_F1 + (size_t)DFF * DM * 2, WT_END = WT_F2 + (size_t)DM * DFF * 2;
static_assert(WT_END <= 36 * MiB, "weights");
constexpr size_t WS_CTXX = WS_WT + 36 * MiB;
constexpr size_t WS_XN = WS_CTXX + 4 * MiB;
constexpr size_t WS_HALF = WS_XN + 34 * MiB;
constexpr int NUNIT = 32 * (RPB / 32);
constexpr int KVP = 1088;
constexpr size_t H_PP = 0, H_QM = H_PP + (size_t)HM * PPW * 2, H_KVM = H_QM + (size_t)HM * 768 * 2, H_MO = H_KVM + (size_t)HM * KVP * 2, H_PHI = H_MO + (size_t)HM * 512 * 2,
                 H_PSI = H_PHI + (size_t)NUNIT * 8192, H_GC = H_PSI + (size_t)NUNIT * 8192, H_END = H_GC;
constexpr size_t WS_END = WS_HALF + H_END;
static_assert(WS_END + 12 * MiB <= 256 * MiB, "workspace (the 12 MiB after WS_END hold transient scratch: pass-3 parking / split-K slabs)");
constexpr size_t WS_GB = WS_HALF + H_PHI, WS_MIX = WS_GB + (size_t)HM * 3 * DM * 2;
constexpr size_t WS_G0 = WS_HALF + H_KVM, WS_G1 = WS_HALF + H_PHI, WS_G2 = WS_G1 + (size_t)HM * DM * 2;
static_assert(WS_G2 + (size_t)HM * DM * 2 <= WS_HALF + H_PSI, "gate buffers");
constexpr size_t WS_HID = WS_HALF;
static_assert(WS_MIX + (size_t)HM * DM * 2 <= WS_HALF + H_GC && WS_HID + (size_t)MROWS * DFF * 2 <= WS_END, "overlays");
constexpr size_t WS_SPLIT = WS_END + 8 * MiB; constexpr int SPLIT_BYTES = 32768 + 1024;
static_assert(16 * 4 * SPLIT_BYTES <= 4 * MiB, "split scratch");
constexpr int CW_BAR = 4096, CW_ATT = 16384;

#define GAS __attribute__((address_space(1)))
#define LAS __attribute__((address_space(3)))
typedef unsigned short bf16;
typedef unsigned v4u __attribute__((ext_vector_type(4)));
typedef float f32x4 __attribute__((ext_vector_type(4)));
typedef float f32x8 __attribute__((ext_vector_type(8)));
#define LDS_WAIT() asm volatile("s_waitcnt lgkmcnt(0)" ::: "memory")
__device__ __forceinline__ unsigned f2bf(float f) { unsigned u = __builtin_bit_cast(unsigned, f); return (u + 0x7fffu + ((u >> 16) & 1u)) >> 16; }
__device__ __forceinline__ unsigned pk2(float lo, float hi) { return f2bf(lo) | (f2bf(hi) << 16); }
__device__ __forceinline__ float bf2f(unsigned short h) { return __uint_as_float((unsigned)h << 16); }

#define XB_TMO      128
#define XB_XCNT(j)  (256  + 64 * (j))
#define XB_XSUB(j)  (1280 + 64 * (j))
#define XB_XGEN(j)  (2304 + 64 * (j))
#define XB_TOP      3328
#define XB_TOPGEN   3392
#define XCD_BAR_WORDS 3456
#define XB_SPIN_CAP (1u << 22)
__device__ __forceinline__ unsigned xb_ld(unsigned* p)              { return __hip_atomic_load(p, __ATOMIC_RELAXED, __HIP_MEMORY_SCOPE_AGENT); }
__device__ __forceinline__ unsigned xb_add(unsigned* p, unsigned v) { return __hip_atomic_fetch_add(p, v, __ATOMIC_RELAXED, __HIP_MEMORY_SCOPE_AGENT); }
__device__ __forceinline__ unsigned xb_xcc_id() { return (unsigned)__builtin_amdgcn_s_getreg((3 << 11) | 20) & 0xFu; }
#define XB_SPIN(cond, bar) do { unsigned _sp = 0; while (cond) { __builtin_amdgcn_s_sleep(1); \
    if ((++_sp & 255u) == 0u) { if (xb_ld(&(bar)[XB_TMO])) break; if (_sp > XB_SPIN_CAP) { atomicAdd(&(bar)[XB_TMO], 1u); break; } } } } while (0)
struct XcdBarrier { unsigned* bar; unsigned x; volatile LAS unsigned* st; };
__device__ __forceinline__ XcdBarrier xcd_barrier_post(unsigned* bar, volatile LAS unsigned* st) {
    XcdBarrier b; b.bar = bar; b.x = xb_xcc_id(); b.st = st;
    if (threadIdx.x == 0) (void)xb_add(&bar[XB_XCNT(b.x)], 1u);
    return b;
}
__device__ __forceinline__ void xcd_barrier_complete(unsigned* bar, unsigned x, unsigned& nloc, unsigned& nx) {
    const unsigned G = gridDim.x * gridDim.y * gridDim.z;
    unsigned sum, cnt, mine, sp = 0u;
    for (;;) {
        sum = 0u; cnt = 0u; mine = 0u;
#pragma unroll
        for (unsigned j = 0; j < 16; ++j) { const unsigned c = xb_ld(&bar[XB_XCNT(j)]); sum += c; cnt += (c > 0u) ? 1u : 0u; mine = (j == x) ? c : mine; }
        if (sum == G) break;
        __builtin_amdgcn_s_sleep(1);
        if ((++sp & 255u) == 0u) { if (xb_ld(&bar[XB_TMO])) break; if (sp > XB_SPIN_CAP) { atomicAdd(&bar[XB_TMO], 1u); break; } }
    }
    nloc = mine > 0u ? mine : 1u; nx = cnt > 0u ? cnt : 1u;
}
__device__ __forceinline__ void xcd_barrier(const XcdBarrier& b) {
    asm volatile("s_waitcnt vmcnt(0)" ::: "memory");
    __syncthreads();
    if (threadIdx.x == 0) {
        unsigned* bar = b.bar; asm volatile("" : "+s"(bar));
        __builtin_amdgcn_s_waitcnt(0);
        unsigned nloc = b.st[0], nx = b.st[1];
        if (nloc == 0u) { xcd_barrier_complete(bar, b.x, nloc, nx); b.st[0] = nloc; b.st[1] = nx; }
        const unsigned old = xb_add(&bar[XB_XSUB(b.x)], 1u);
        const unsigned gen = old / nloc;
        if (old + 1u == (gen + 1u) * nloc) {
            __builtin_amdgcn_fence(__ATOMIC_RELEASE, "agent");
            asm volatile("s_waitcnt vmcnt(0)" ::: "memory");
            const unsigned og = xb_add(&bar[XB_TOP], 1u);
            const unsigned tg = og / nx;
            if (og + 1u == (tg + 1u) * nx) xb_add(&bar[XB_TOPGEN], 1u);
            else XB_SPIN(xb_ld(&bar[XB_TOPGEN]) == tg, bar);
            __builtin_amdgcn_fence(__ATOMIC_ACQUIRE, "agent");
            xb_add(&bar[XB_XGEN(b.x)], 1u);
            asm volatile("s_waitcnt vmcnt(0)" ::: "memory");
        } else {
            XB_SPIN(xb_ld(&bar[XB_XGEN(b.x)]) == gen, bar);
            __builtin_amdgcn_fence(__ATOMIC_ACQUIRE, "agent");
            asm volatile("s_waitcnt vmcnt(0)" ::: "memory");
        }
    }
    __syncthreads();
}

constexpr int NWAVES = 8, RING_BYTES = 131072, LDS_BYTES = 163840, MISC_OFF = LDS_BYTES - 512;
struct Args { const float* in[31]; float* out; unsigned char* ws; int ph_lo, ph_hi; };
enum { I_X = 0, I_C, I_CTX, I_CCTX, I_WMOD, I_BMOD, I_G1, I_G2, I_WIN, I_QGAIN, I_KGAIN, I_MU, I_W0, I_W2, I_A0, I_A2, I_G2R, I_KK, I_KA, I_RK, I_LNW, I_LNB, I_QNORM, I_QUP, I_KVNORM, I_KVUP, I_WBR, I_WOUT, I_FF1, I_FF2, I_GFIN };
#define CAS __attribute__((address_space(4)))
__device__ __forceinline__ const float* inp(int i) { const CAS Args* ap = (const CAS Args*)__builtin_amdgcn_kernarg_segment_ptr(); asm volatile("" : "+s"(ap)); return ap->in[i]; }
struct Frame {
    LAS unsigned char* lds; unsigned char* ldsg;
    unsigned* ctl; unsigned char* ws; float* out;
    int G, bid;
};
#define FTID() otid()
#define FLANE() (otid() & 63)
#define FWAVE() __builtin_amdgcn_readfirstlane(otid() >> 6)
__device__ __forceinline__ float wave_sum(float v) {
#pragma unroll
    for (int o = 1; o < 64; o <<= 1) v += __shfl_xor(v, o);
    return v;
}
__device__ __forceinline__ const float* xrow_ptr(const float* xl, const float* xc, int m) { const int b = m / RPB, s = m % RPB; return (s < CTX) ? xc + (size_t)(b * CTX + s) * DM : xl + (size_t)(b * SEQ + s - CTX) * DM; }

__device__ __forceinline__ void p0_transpose_item(const float* W, int ldw, int col0, int Kd, int N, bf16* WT, const float* kscale, LAS unsigned* scr, int item, int lane, int ldwt) {
    const int nblk = (N + 63) / 64, kb = item / nblk, nb = item % nblk, k0 = 64 * kb, n0 = 64 * nb, c = lane & 15, r4 = lane >> 4;
    const bool valid = n0 + 4 * c < N;
    const int cn = valid ? n0 + 4 * c : N - 4;
    const float vz = valid ? 1.f : 0.f;
#pragma unroll
    for (int i = 0; i < 8; ++i) { const int k = 8 * i + 2 * r4;
        f32x4 a = *(const f32x4*)(W + (size_t)(k0 + k) * ldw + col0 + cn), bq = *(const f32x4*)(W + (size_t)(k0 + k + 1) * ldw + col0 + cn);
        a = a * vz; bq = bq * vz;
        if (kscale) { a = a * kscale[k0 + k]; bq = bq * kscale[k0 + k + 1]; }
#pragma unroll
        for (int e = 0; e < 4; ++e) scr[(4 * c + e) * 33 + (k >> 1)] = pk2(a[e], bq[e]); }
    LDS_WAIT(); asm volatile("" ::: "memory");
#pragma unroll
    for (int t = 0; t < 8; ++t) { const int n = (lane >> 3) + 8 * t, j = lane & 7; const LAS unsigned* p = scr + n * 33 + 4 * j;
        v4u o; o.x = p[0]; o.y = p[1]; o.z = p[2]; o.w = p[3];
        if (n0 + n < N) *(v4u*)(WT + (size_t)(n0 + n) * ldwt + k0 + 8 * j) = o; }
    LDS_WAIT(); asm volatile("" ::: "memory");
}

__device__ __forceinline__ void ph_weights(Frame& F, int l) {
    unsigned char* wt = F.ws + WS_WT;
    if (l == 0) {
        LAS float* sl = (LAS float*)F.lds;
        LAS float* red = (LAS float*)(F.lds + 32768);
        for (int i = FTID(); i < 5 * 1024; i += 512) { const int j = i >> 10, k = i & 1023; const float c = (j < 4) ? inp(I_C)[j * 1024 + k] : inp(I_CCTX)[k]; sl[i] = c / (1.f + __expf(-c)); }
        __syncthreads();
        for (int it = F.bid; it < 2 * 96; it += F.G) {
            const int ll = it / 96, n0 = (it % 96) * 64;
            const float* wm = inp(I_WMOD) + (size_t)ll * 1024 * 6144 + n0 + FLANE();
            float a0 = 0, a1 = 0, a2 = 0, a3 = 0, a4 = 0;
            for (int k0 = FWAVE() * 128; k0 < FWAVE() * 128 + 128; k0 += 64) { float w[64];
#pragma unroll
                for (int u = 0; u < 64; ++u) w[u] = wm[(size_t)(k0 + u) * 6144];
#pragma unroll
                for (int u = 0; u < 64; ++u) { const int k = k0 + u; a0 += sl[k] * w[u]; a1 += sl[1024 + k] * w[u]; a2 += sl[2048 + k] * w[u]; a3 += sl[3072 + k] * w[u]; a4 += sl[4096 + k] * w[u]; } }
            LAS float* r = red + FWAVE() * 320 + FLANE(); r[0] = a0; r[64] = a1; r[128] = a2; r[192] = a3; r[256] = a4;
            __syncthreads();
            if (FTID() < 320) { float s = 0; for (int w = 0; w < 8; ++w) s += red[w * 320 + FTID()]; const int j = FTID() >> 6, n = n0 + (FTID() & 63);
                ((float*)(F.ws + WS_MOD))[(size_t)(ll * 5 + j) * 6144 + n] = s + inp(I_BMOD)[ll * 6144 + n]; }
            __syncthreads();
        }
        if (F.bid == F.G - 1) {
            for (int i = FTID(); i < 64 * 16; i += 512) { const int pos = i >> 4, f = i & 15; const float ang = (float)pos * powf(10000.f, -(float)f / 16.f); ((float*)(F.ws + WS_T16C))[i] = cosf(ang); ((float*)(F.ws + WS_T16S))[i] = sinf(ang); }
            for (int i = FTID(); i < 64 * 8; i += 512) { const int pos = i >> 3, f = i & 7; const float ang = (float)pos * powf(10000.f, -(float)f / 8.f); ((float*)(F.ws + WS_T8C))[i] = cosf(ang); ((float*)(F.ws + WS_T8S))[i] = sinf(ang); }
        }
        __syncthreads();
    }
    {
        bf16* w2P = (bf16*)(F.ws + WS_TAB); bf16* a2B = (bf16*)(F.ws + WS_TAB + 131072); bf16* g2P = (bf16*)(F.ws + WS_TAB + 524288);
        const float* w2 = inp(I_W2) + (size_t)l * 2 * 64 * 512; const float* a2 = inp(I_A2) + (size_t)l * 2 * 64 * 512; const float* g2 = inp(I_G2R) + (size_t)l * 128 * 512;
        const float* mu = inp(I_MU) + (size_t)l * 2 * RWIN;
        bf16* DF = (bf16*)(F.ws + WS_TAB + 655360);
        const int tstride = F.G * 512;
        for (int base = F.bid * 512 + FTID(); base < 196608; base += 2 * tstride) {
            float vw[2], vg[2], vd0[2], vd1[2], va[2], vm0[2], vm1[2];
#pragma unroll
            for (int j = 0; j < 2; ++j) { const int idx0 = base + j * tstride;
                { const int idx = idx0 < 65536 ? idx0 : 65535;
                  { const int dh = idx >> 12, d = dh >> 3, hd = dh & 7, rem = idx & 4095, Ii = rem >> 11, J = (rem >> 10) & 1, S = (rem >> 9) & 1, ln = (rem >> 3) & 63, e = rem & 7;
                    const int i = 32 * Ii + 16 * S + 8 * (e >> 2) + 4 * (ln >> 5) + (e & 3), k = 32 * J + (ln & 31);
                    vw[j] = w2[(size_t)(d * 64 + i) * 512 + hd * 64 + k]; }
                  { const int hd = idx >> 13, rem = idx & 8191, Ii = rem >> 11, Iv = (rem >> 10) & 1, S = (rem >> 9) & 1, ln = (rem >> 3) & 63, e = rem & 7;
                    const int i = 32 * Ii + 16 * S + 8 * (e >> 2) + 4 * (ln >> 5) + (e & 3), v = 32 * Iv + (ln & 31);
                    vg[j] = g2[(size_t)i * 512 + hd * 64 + v]; } }
                { const int idx = idx0 < 60 * 3 * 2 * 64 * 8 ? idx0 : 60 * 3 * 2 * 64 * 8 - 1; const int ln = (idx >> 3) & 63, blk = idx / 3072, r = ln & 31, cc = 32 * blk + r;
                  vd0[j] = mu[cc]; vd1[j] = mu[RWIN + cc]; }
                { const int idx = idx0 < 196608 ? idx0 : 196607; const int dh = idx / 12288, rem = idx % 12288, k = (rem >> 6) & 63, i = rem & 63, d = dh >> 3, hd = dh & 7;
                  va[j] = a2[(size_t)(d * 64 + i) * 512 + hd * 64 + k]; vm0[j] = mu[RW_AD + d * 64 + i]; vm1[j] = mu[RWIN + RW_AD + d * 64 + i]; } }
#pragma unroll
            for (int j = 0; j < 2; ++j) { const int idx = base + j * tstride;
                if (idx < 65536) { w2P[idx] = (bf16)f2bf(vw[j]); g2P[idx] = (bf16)f2bf(vg[j]); }
                if (idx < 60 * 3 * 2 * 64 * 8) { const int e = idx & 7, ln = (idx >> 3) & 63, q = (idx >> 9) & 1, w = (idx >> 10) % 3, r = ln & 31, h = ln >> 5;
                    const float m0 = vd0[j], m1 = vd1[j]; const float cf = (w == 0) ? 1.f - m0 - m1 : (w == 1 ? m0 : m1);
                    DF[idx] = (r == 16 * q + 8 * h + e) ? (bf16)f2bf(cf) : (bf16)0; }
                if (idx < 196608) { const int w = (idx % 12288) >> 12; const float m0 = vm0[j], m1 = vm1[j]; const float cf = (w == 0) ? 1.f - m0 - m1 : (w == 1 ? m0 : m1);
                    a2B[idx] = (bf16)f2bf(va[j] * cf); } } } }
    LAS unsigned* scr = (LAS unsigned*)(F.lds + FWAVE() * 16384);
    const int gw = F.bid * NWAVES + FWAVE(), NGW = F.G * NWAVES;
    const float* win = inp(I_WIN) + (size_t)l * DM * NIN;
    constexpr int I_A = 16 * 53, I_B = 16 * 48, I_C2 = 6 * 12, I_D = 4 * 16, I_E = 8 * 16, I_F = 16 * 16, I_G = 16 * 64, I_H = 64 * 16;
    constexpr int NITEMS = I_A + I_B + I_C2 + I_D + 3 * I_E + I_F + I_G + I_H;
    for (int kr = 0; ; ++kr) {
        const int it = (kr < 2) ? gw + kr * NGW : kr * NGW + (gw + NGW - (192 * NWAVES) % NGW) % NGW;
        if (it >= NITEMS) { if (kr < 2) continue; break; }
        int r = it; const int lane = FLANE();
        if (r < I_A) { p0_transpose_item(win, NIN, 0, DM, 3360, (bf16*)(wt + WT_IN), nullptr, scr, r, lane, DM); continue; } r -= I_A;
        if (r < I_B) { p0_transpose_item(win, NIN, C_GATE, DM, NGATE, (bf16*)(wt + WT_G), nullptr, scr, r, lane, DM); continue; } r -= I_B;
        if (r < I_C2) { p0_transpose_item(inp(I_QUP) + (size_t)l * 384 * 768, 768, 0, 384, 768, (bf16*)(wt + WT_QU), inp(I_QNORM) + l * 384, scr, r, lane, 384); continue; } r -= I_C2;
        if (r < I_D) { p0_transpose_item(inp(I_KVUP) + (size_t)l * 256 * 1024, 1024, 0, 256, 1024, (bf16*)(wt + WT_KVU), inp(I_KVNORM) + l * 256, scr, r, lane, 256); continue; } r -= I_D;
        if (r < 3 * I_E) { const int i = r / I_E; p0_transpose_item(inp(I_WBR) + (size_t)(l * 3 + i) * 512 * DM, DM, 0, 512, DM, (bf16*)(wt + WT_BR) + (size_t)i * DM * 512, nullptr, scr, r % I_E, lane, 512); continue; } r -= 3 * I_E;
        if (r < I_F) { p0_transpose_item(inp(I_WOUT) + (size_t)l * DM * DM, DM, 0, DM, DM, (bf16*)(wt + WT_OUT), nullptr, scr, r, lane, DM); continue; } r -= I_F;
        if (r < I_G) { p0_transpose_item(inp(I_FF1) + (size_t)l * DM * DFF, DFF, 0, DM, DFF, (bf16*)(wt + WT_F1), nullptr, scr, r, lane, DM); continue; } r -= I_G;
        p0_transpose_item(inp(I_FF2) + (size_t)l * DFF * DM, DM, 0, DFF, DM, (bf16*)(wt + WT_F2), nullptr, scr, r, lane, DFF);
    }
    { v4u* z = (v4u*)((bf16*)(wt + WT_IN) + (size_t)3360 * DM); const int nz = 224 * DM * 2 / 16; unsigned z0; asm volatile("v_mov_b32 %0, 0" : "=v"(z0));
      for (int i = F.bid * 512 + FTID(); i < nz; i += F.G * 512) z[i] = (v4u){z0, z0, z0, z0}; }
}

__device__ __forceinline__ void ph_norm(Frame& F, int l, const void* xl, const void* xc, bool src_bf, const float* g, int which, bool skipctx, const float* part = nullptr) {
    const int gw = F.bid * NWAVES + FWAVE(), NGW = F.G * NWAVES;
    const float* mod = (const float*)(F.ws + WS_MOD) + (size_t)l * 5 * 6144;
    bf16* XN = (bf16*)(F.ws + WS_XN);
    f32x4 gg[4];
#pragma unroll
    for (int j = 0; j < 4; ++j) gg[j] = *(const f32x4*)(g + 4 * FLANE() + 256 * j);
#define NORM_NEXT(m_) do { (m_) += NGW; } while ((m_) < MROWS && skipctx && ((m_) % RPB) < CTX)
#define NORM_LOAD(m_, V, SH, SC) do { const int b_ = (m_) / RPB, s_ = (m_) % RPB; const size_t xo_ = (s_ < CTX) ? (size_t)(b_ * CTX + s_) * DM : (size_t)(b_ * SEQ + s_ - CTX) * DM; \
        const f32x4* xr_ = (const f32x4*)((const float*)((s_ < CTX) ? xc : xl) + xo_) + FLANE(); const uint2* xh_ = (const uint2*)((const bf16*)((s_ < CTX) ? xc : xl) + xo_) + FLANE(); \
        const float* mv_ = mod + (size_t)((s_ < CTX) ? 4 : b_) * 6144 + which * 3072 + 4 * FLANE(); \
        if (src_bf) { _Pragma("unroll") for (int j = 0; j < 4; ++j) { const uint2 w_ = xh_[64 * j]; V[j] = (f32x4){pg8::bf_lo(w_.x), pg8::bf_hi(w_.x), pg8::bf_lo(w_.y), pg8::bf_hi(w_.y)}; } } \
        else { _Pragma("unroll") for (int j = 0; j < 4; ++j) V[j] = xr_[64 * j]; } \
        _Pragma("unroll") for (int j = 0; j < 4; ++j) { SH[j] = *(const f32x4*)(mv_ + 256 * j); SC[j] = *(const f32x4*)(mv_ + 1024 + 256 * j); } \
        if (part && s_ < CTX) { _Pragma("unroll") for (int j = 0; j < 4; ++j) { const f32x4* pr_ = (const f32x4*)(part + (size_t)(b_ * CTX + s_) * DM) + FLANE() + 64 * j; V[j] = V[j] + pr_[0] + pr_[262144] + pr_[524288]; } } } while (0)
    int m = gw; if (skipctx && (m % RPB) < CTX) NORM_NEXT(m);
    f32x4 v[4], sh[4], sc[4];
    if (m < MROWS) NORM_LOAD(m, v, sh, sc);
    while (m < MROWS) {
        int mn = m; NORM_NEXT(mn);
        f32x4 vn[4], shn[4], scn[4];
#pragma unroll
        for (int j = 0; j < 4; ++j) { vn[j] = v[j]; shn[j] = sh[j]; scn[j] = sc[j]; }
        if (mn < MROWS) NORM_LOAD(mn, vn, shn, scn);
        asm volatile("" ::: "memory");
        float ss = 0.f;
#pragma unroll
        for (int j = 0; j < 4; ++j) ss += (v[j].x * v[j].x + v[j].y * v[j].y) + (v[j].z * v[j].z + v[j].w * v[j].w);
        const float rstd = 1.f / sqrtf(wave_sum(ss) * (1.f / DM) + NORM_EPS);
        unsigned long long* o8 = (unsigned long long*)(XN + (size_t)m * DM) + FLANE();
#pragma unroll
        for (int j = 0; j < 4; ++j) { const f32x4 y = v[j] * rstd * gg[j] * (sc[j] + 1.0f) + sh[j];
            o8[64 * j] = (unsigned long long)pk2(y.x, y.y) | ((unsigned long long)pk2(y.z, y.w) << 32); }
#pragma unroll
        for (int j = 0; j < 4; ++j) { v[j] = vn[j]; sh[j] = shn[j]; sc[j] = scn[j]; }
        m = mn;
    }
#undef NORM_NEXT
#undef NORM_LOAD
}
__device__ __forceinline__ void ph_final(Frame& F) {
    const int gw = F.bid * NWAVES + FWAVE(), NGW = F.G * NWAVES; const float* g = inp(I_GFIN);
    const bf16* XL = (const bf16*)(F.ws + WS_XN);
    f32x4 gg[4];
#pragma unroll
    for (int j = 0; j < 4; ++j) gg[j] = *(const f32x4*)(g + 4 * FLANE() + 256 * j);
    int m = gw; uint2 w[4];
    if (m < NB * SEQ) { const uint2* xr = (const uint2*)(XL + (size_t)m * DM) + FLANE();
#pragma unroll
        for (int j = 0; j < 4; ++j) w[j] = xr[64 * j]; }
    while (m < NB * SEQ) {
        const int mn = m + NGW; uint2 wn[4];
#pragma unroll
        for (int j = 0; j < 4; ++j) wn[j] = w[j];
        if (mn < NB * SEQ) { const uint2* xr = (const uint2*)(XL + (size_t)mn * DM) + FLANE();
#pragma unroll
            for (int j = 0; j < 4; ++j) wn[j] = xr[64 * j]; }
        asm volatile("" ::: "memory");
        f32x4 v[4]; float ss = 0.f;
#pragma unroll
        for (int j = 0; j < 4; ++j) v[j] = (f32x4){pg8::bf_lo(w[j].x), pg8::bf_hi(w[j].x), pg8::bf_lo(w[j].y), pg8::bf_hi(w[j].y)};
#pragma unroll
        for (int j = 0; j < 4; ++j) ss += (v[j].x * v[j].x + v[j].y * v[j].y) + (v[j].z * v[j].z + v[j].w * v[j].w);
        const float rstd = 1.f / sqrtf(wave_sum(ss) * (1.f / DM) + NORM_EPS);
        f32x4* xo = (f32x4*)(F.out + (size_t)m * DM) + FLANE();
#pragma unroll
        for (int j = 0; j < 4; ++j) xo[64 * j] = v[j] * rstd * gg[j];
#pragma unroll
        for (int j = 0; j < 4; ++j) w[j] = wn[j];
        m = mn;
    }
}

__device__ __forceinline__ void ph_prep(Frame& F, int l, int half) {
    const int gw = F.bid * NWAVES + FWAVE(), NGW = F.G * NWAVES, lane = FLANE();
    bf16* PP = (bf16*)(F.ws + WS_HALF + H_PP);
    const float* t16c = (const float*)(F.ws + WS_T16C); const float* t16s = (const float*)(F.ws + WS_T16S); const float* t8c = (const float*)(F.ws + WS_T8C); const float* t8s = (const float*)(F.ws + WS_T8S);
    const float* qg = inp(I_QGAIN) + l * 64; const float* kg = inp(I_KGAIN) + l * 64;
    const bool skew = NGW == 2048; const int wv = FWAVE(); const bool third = skew && F.bid < 64 && wv < 4;
    const int wp = !skew ? gw : third ? -1 : (F.bid < 64 ? F.bid * 4 + (wv - 4) : 256 + (F.bid - 64) * 8 + wv), NWP = skew ? NGW - 256 : NGW;
    const int j = lane & 7, f0 = 8 * (j & 1);
    const f32x4 gq0 = *(const f32x4*)(qg + j * 8), gq1 = *(const f32x4*)(qg + j * 8 + 4), gk0 = *(const f32x4*)(kg + j * 8), gk1 = *(const f32x4*)(kg + j * 8 + 4);
    int m = wp; v4u wq = {0u, 0u, 0u, 0u}, wk = wq, wkr = wq;
    if (wp >= 0 && m < HM) { const bf16* row0 = PP + (size_t)m * PPW; wq = *(const v4u*)(row0 + C_GQ + lane * 8); wk = *(const v4u*)(row0 + C_GK + (lane & 15) * 8); wkr = *(const v4u*)(row0 + C_KR + (lane & 3) * 8); }
    while (wp >= 0 && m < HM) {
        const int mnx = m + NWP; v4u nq = wq, nk = wk, nkr = wkr;
        if (mnx < HM) { const bf16* rown = PP + (size_t)mnx * PPW; nq = *(const v4u*)(rown + C_GQ + lane * 8); nk = *(const v4u*)(rown + C_GK + (lane & 15) * 8); nkr = *(const v4u*)(rown + C_KR + (lane & 3) * 8); }
        const int s = m % RPB; const bool lat = s >= CTX; const int tt = s - CTX, pr = (tt >> 6) & 63, pc = tt & 63;
        bf16* row = PP + (size_t)m * PPW;
        bf16* pq = row + C_GQ + lane * 8; bf16* pk = row + C_GK + (lane & 15) * 8; bf16* pkr = row + C_KR + (lane & 3) * 8;
        const int pos16 = lat ? ((j < 4) ? pr : pc) : 0, pos8 = lat ? (((lane & 3) < 2) ? pr : pc) : 0;
        const f32x4 c16a = *(const f32x4*)(t16c + pos16 * 16 + f0), c16b = *(const f32x4*)(t16c + pos16 * 16 + f0 + 4), s16a = *(const f32x4*)(t16s + pos16 * 16 + f0), s16b = *(const f32x4*)(t16s + pos16 * 16 + f0 + 4);
        const f32x4 c8a = *(const f32x4*)(t8c + pos8 * 8), c8b = *(const f32x4*)(t8c + pos8 * 8 + 4), s8a = *(const f32x4*)(t8s + pos8 * 8), s8b = *(const f32x4*)(t8s + pos8 * 8 + 4);
        asm volatile("" ::: "memory");
        const float c16[8] = {c16a.x, c16a.y, c16a.z, c16a.w, c16b.x, c16b.y, c16b.z, c16b.w}, s16[8] = {s16a.x, s16a.y, s16a.z, s16a.w, s16b.x, s16b.y, s16b.z, s16b.w};
#pragma unroll
        for (int part = 0; part < 2; ++part) {
            const v4u w = part == 0 ? wq : wk;
            const f32x4 ga = part == 0 ? gq0 : gk0, gb = part == 0 ? gq1 : gk1; const float gain[8] = {ga.x, ga.y, ga.z, ga.w, gb.x, gb.y, gb.z, gb.w};
            float v[8] = {pg8::bf_lo(w.x), pg8::bf_hi(w.x), pg8::bf_lo(w.y), pg8::bf_hi(w.y), pg8::bf_lo(w.z), pg8::bf_hi(w.z), pg8::bf_lo(w.w), pg8::bf_hi(w.w)};
            float ss = 0;
#pragma unroll
            for (int e = 0; e < 8; ++e) ss += v[e] * v[e];
            ss += __shfl_xor(ss, 1); ss += __shfl_xor(ss, 2); ss += __shfl_xor(ss, 4);
            const float rstd = 1.f / sqrtf(ss * (1.f / 64.f) + NORM_EPS);
            const float qs = (part == 0) ? 0.125f * 1.4426950408889634f : 1.f;
#pragma unroll
            for (int e = 0; e < 8; ++e) v[e] = v[e] * (rstd * qs) * gain[e];
            float pv[8];
#pragma unroll
            for (int e = 0; e < 8; ++e) pv[e] = __shfl_xor(v[e], 2);
            if (lat) {
#pragma unroll
                for (int e = 0; e < 8; ++e) { const float c = c16[e], sn = s16[e]; v[e] = ((j & 2) == 0) ? v[e] * c - pv[e] * sn : pv[e] * sn + v[e] * c; } }
            v4u o; o.x = pk2(v[0], v[1]); o.y = pk2(v[2], v[3]); o.z = pk2(v[4], v[5]); o.w = pk2(v[6], v[7]);
            if (part == 0) *(v4u*)pq = o; else if (lane < 16) *(v4u*)pk = o;
        }
        {   const v4u w = wkr; float v[8] = {pg8::bf_lo(w.x), pg8::bf_hi(w.x), pg8::bf_lo(w.y), pg8::bf_hi(w.y), pg8::bf_lo(w.z), pg8::bf_hi(w.z), pg8::bf_lo(w.w), pg8::bf_hi(w.w)};
            const float c8[8] = {c8a.x, c8a.y, c8a.z, c8a.w, c8b.x, c8b.y, c8b.z, c8b.w}, s8[8] = {s8a.x, s8a.y, s8a.z, s8a.w, s8b.x, s8b.y, s8b.z, s8b.w};
            float pv[8];
#pragma unroll
            for (int e = 0; e < 8; ++e) pv[e] = __shfl_xor(v[e], 1);
            if (lat) {
#pragma unroll
                for (int e = 0; e < 8; ++e) { const float c = c8[e], sn = s8[e]; v[e] = ((lane & 1) == 0) ? v[e] * c - pv[e] * sn : pv[e] * sn + v[e] * c; } }
            v4u o; o.x = pk2(v[0], v[1]); o.y = pk2(v[2], v[3]); o.z = pk2(v[4], v[5]); o.w = pk2(v[6], v[7]);
            if (lane < 4) *(v4u*)pkr = o;
        }
        wq = nq; wk = nk; wkr = nkr; m = mnx;
    }
}
__device__ __forceinline__ void shifted8(const bf16* PP, int m, int cc0, const float* mu, float (&u)[8]) {
    const int s = m % RPB; const float fp = (s != 0 && s != CTX) ? 1.f : 0.f, fn = (s != CTX - 1 && s != RPB - 1) ? 1.f : 0.f;
    const int mp = m > 0 ? m - 1 : 0, mn = m < HM - 1 ? m + 1 : HM - 1;
    const v4u w = *(const v4u*)(PP + (size_t)m * PPW + C_RW + cc0), wp = *(const v4u*)(PP + (size_t)mp * PPW + C_RW + cc0), wn = *(const v4u*)(PP + (size_t)mn * PPW + C_RW + cc0);
    const f32x4 m0a = *(const f32x4*)(mu + cc0), m0b = *(const f32x4*)(mu + cc0 + 4), m1a = *(const f32x4*)(mu + RWIN + cc0), m1b = *(const f32x4*)(mu + RWIN + cc0 + 4);
    const float c[8] = {pg8::bf_lo(w.x), pg8::bf_hi(w.x), pg8::bf_lo(w.y), pg8::bf_hi(w.y), pg8::bf_lo(w.z), pg8::bf_hi(w.z), pg8::bf_lo(w.w), pg8::bf_hi(w.w)};
    const float a[8] = {pg8::bf_lo(wp.x), pg8::bf_hi(wp.x), pg8::bf_lo(wp.y), pg8::bf_hi(wp.y), pg8::bf_lo(wp.z), pg8::bf_hi(wp.z), pg8::bf_lo(wp.w), pg8::bf_hi(wp.w)};
    const float n[8] = {pg8::bf_lo(wn.x), pg8::bf_hi(wn.x), pg8::bf_lo(wn.y), pg8::bf_hi(wn.y), pg8::bf_lo(wn.z), pg8::bf_hi(wn.z), pg8::bf_lo(wn.w), pg8::bf_hi(wn.w)};
#pragma unroll
    for (int e = 0; e < 8; ++e) { const float m0 = (e < 4 ? m0a[e & 3] : m0b[e & 3]), m1 = (e < 4 ? m1a[e & 3] : m1b[e & 3]); u[e] = c[e] + m0 * (fp * a[e] - c[e]) + m1 * (fn * n[e] - c[e]); }
}
namespace rk {
using bf16x8 = __attribute__((ext_vector_type(8))) short;
using f32x16 = __attribute__((ext_vector_type(16))) float;
using u32x4 = __attribute__((ext_vector_type(4))) unsigned;
typedef float f32x2_t __attribute__((ext_vector_type(2))); typedef __bf16 bf16x2_t __attribute__((ext_vector_type(2)));
#define RK_DI __device__ __forceinline__
RK_DI f32x16 RK_MF(bf16x8 a, bf16x8 b, f32x16 c) { return __builtin_amdgcn_mfma_f32_32x32x16_bf16(a, b, c, 0, 0, 0); }
constexpr int NH = 8;
RK_DI unsigned cvt2(float lo, float hi) { f32x2_t v = {lo, hi}; bf16x2_t b = __builtin_convertvector(v, bf16x2_t); return __builtin_bit_cast(unsigned, b); }
RK_DI float lo16(unsigned w) { return __uint_as_float(w << 16); }
RK_DI float hi16(unsigned w) { return __uint_as_float(w & 0xffff0000u); }
RK_DI int crow(int reg, int h) { return (reg & 3) + 8 * (reg >> 2) + 4 * h; }
RK_DI int krow(int s, int h, int e) { return 16 * s + 8 * (e >> 2) + 4 * h + (e & 3); }
template <int S> RK_DI bf16x8 pack(const f32x16& x) { u32x4 p = {cvt2(x[8 * S], x[8 * S + 1]), cvt2(x[8 * S + 2], x[8 * S + 3]), cvt2(x[8 * S + 4], x[8 * S + 5]), cvt2(x[8 * S + 6], x[8 * S + 7])}; return __builtin_bit_cast(bf16x8, p); }
RK_DI bf16x8 pack8(const float (&u)[8]) { u32x4 p = {cvt2(u[0], u[1]), cvt2(u[2], u[3]), cvt2(u[4], u[5]), cvt2(u[6], u[7])}; return __builtin_bit_cast(bf16x8, p); }
RK_DI void unpack8(bf16x8 v, float (&u)[8]) { const u32x4 p = __builtin_bit_cast(u32x4, v); u[0] = lo16(p.x); u[1] = hi16(p.x); u[2] = lo16(p.y); u[3] = hi16(p.y); u[4] = lo16(p.z); u[5] = hi16(p.z); u[6] = lo16(p.w); u[7] = hi16(p.w); }
constexpr short ONE = (short)0x3F80;
template <int K> RK_DI bf16x8 idn(int r, int h) { bf16x8 v;
#pragma unroll
    for (int e = 0; e < 8; ++e) v[e] = (r == 16 * K + 8 * h + e) ? ONE : (short)0; return v; }
template <int S> RK_DI bf16x8 idp(int r, int h) { bf16x8 v;
#pragma unroll
    for (int e = 0; e < 8; ++e) v[e] = (r == krow(S, h, e)) ? ONE : (short)0; return v; }
RK_DI bf16x8 idn_q(int q, int r, int h) { return q ? idn<1>(r, h) : idn<0>(r, h); }
template <int S, bool STRICT> RK_DI bf16x8 incp(int r, int h, int flip) { bf16x8 v;
#pragma unroll
    for (int e = 0; e < 8; ++e) { const int s = krow(S, h, e); const bool on = flip ? (STRICT ? s > r : s >= r) : (STRICT ? s < r : s <= r); v[e] = on ? ONE : (short)0; } return v; }
template <bool STRICT> RK_DI void tmask(f32x16& g, int r, int h, int flip) {
#pragma unroll
    for (int reg = 0; reg < 16; ++reg) { const int s = crow(reg, h); const bool on = flip ? (STRICT ? s > r : s >= r) : (STRICT ? s < r : s <= r); g[reg] = on ? g[reg] : 0.f; } }
template <int FLIP> RK_DI void solve32(f32x16& x, const bf16x8 (&Mp)[2]) {
    constexpr int F1 = FLIP ? 1 : 0, F2 = 1 - F1;
    f32x16 base = x;
#pragma unroll 1
    for (int it = 0; it < NH; ++it) { const f32x16 t = RK_MF(Mp[F1], pack<F1>(x), base);
#pragma unroll
        for (int e = 0; e < 8; ++e) x[8 * F1 + e] = t[8 * F1 + e]; }
    { const f32x16 t = RK_MF(Mp[F1], pack<F1>(x), base); x = t; base = t; }
#pragma unroll 1
    for (int it = 0; it < NH; ++it) { const f32x16 t = RK_MF(Mp[F2], pack<F2>(x), base);
#pragma unroll
        for (int e = 0; e < 8; ++e) x[8 * F2 + e] = t[8 * F2 + e]; }
}
template <int FLIP> RK_DI void solve32p(f32x16& x, f32x16& y, const bf16x8 (&Mp)[2]) {
    constexpr int F1 = FLIP ? 1 : 0, F2 = 1 - F1;
    f32x16 bx = x, by = y;
#pragma unroll 1
    for (int it = 0; it < NH; ++it) { const f32x16 t = RK_MF(Mp[F1], pack<F1>(x), bx); const f32x16 u = RK_MF(Mp[F1], pack<F1>(y), by);
#pragma unroll
        for (int e = 0; e < 8; ++e) { x[8 * F1 + e] = t[8 * F1 + e]; y[8 * F1 + e] = u[8 * F1 + e]; } }
    { const f32x16 t = RK_MF(Mp[F1], pack<F1>(x), bx); const f32x16 u = RK_MF(Mp[F1], pack<F1>(y), by); x = t; bx = t; y = u; by = u; }
#pragma unroll 1
    for (int it = 0; it < NH; ++it) { const f32x16 t = RK_MF(Mp[F2], pack<F2>(x), bx); const f32x16 u = RK_MF(Mp[F2], pack<F2>(y), by);
#pragma unroll
        for (int e = 0; e < 8; ++e) { x[8 * F2 + e] = t[8 * F2 + e]; y[8 * F2 + e] = u[8 * F2 + e]; } }
}
RK_DI float sigm(float x) { return __builtin_amdgcn_rcpf(1.f + __expf(-x)); }
RK_DI float tanh_f(float x) { return 2.f * __builtin_amdgcn_rcpf(1.f + __expf(-2.f * x)) - 1.f; }

struct Ctx {
    unsigned char* ws; LAS unsigned char* sb; int m0, r, h, hd, dir, l, flip;
    int cofs, dofs;
    int zt;
    int lofs;
    unsigned mp, mn; int rowc, rowp, rown;
};
#define C_PP(c) ((const bf16*)((c).ws + WS_HALF + H_PP))
#define C_MU(c) (inp(I_MU) + (size_t)(c).l * 2 * RWIN)
#define C_W2P(c) ((const bf16*)((c).ws + WS_TAB) + (size_t)((c).dir * 8 + (c).hd) * 4096)
#define C_A2B(c) ((const bf16*)((c).ws + WS_TAB + 131072) + (size_t)((c).dir * 8 + (c).hd) * 3 * 4096)
constexpr int SBUF = 34 * 128;
RK_DI void stage_slice(const Ctx& c, int buf, int cc0) {
    const int lane = c.r + 32 * c.h, p = lane & 7, q4 = lane >> 4;
    const bf16* base = C_PP(c) + (ptrdiff_t)(c.m0 - 1 + (lane >> 3)) * PPW + C_RW + cc0;
    const int oe = (p ^ q4) << 3, oo = (p ^ (4 + q4)) << 3;
#pragma unroll
    for (int j = 0; j < 5; ++j) { const bf16* src = base + (ptrdiff_t)j * 8 * PPW + ((j & 1) ? oo : oe);
        if (j < 4 || lane < 16) __builtin_amdgcn_global_load_lds((const unsigned*)src, (LAS unsigned*)(c.sb + buf * SBUF + j * 1024), 16, 0, 0); }
}
#define RK_WAIT_DMA() do { __builtin_amdgcn_s_waitcnt(0x0F70); asm volatile("" ::: "memory"); } while (0)
#define RK_WAIT_LDS() asm volatile("s_waitcnt lgkmcnt(0)" ::: "memory")
RK_DI bf16x8 rawfrag(const Ctx& c, int buf, int ch, int w) {
    const int rho = c.r + (w == 0 ? 1 : (w == 1 ? 0 : 2)); const unsigned m = (w == 0) ? 0xffffffffu : (w == 1 ? c.mp : c.mn);
    u32x4 v = *(const LAS u32x4*)(c.sb + buf * SBUF + rho * 128 + ((ch ^ ((rho >> 1) & 7)) << 4) + c.zt); v.x &= m; v.y &= m; v.z &= m; v.w &= m; return __builtin_bit_cast(bf16x8, v); }
RK_DI bf16x8 dfrag(const Ctx& c, int cc32, int w, int q) { return *(const bf16x8*)((const bf16*)(c.ws + WS_TAB + 655360) + (((cc32 >> 5) * 3 + w) * 2 + q) * 512 + c.lofs); }
#define RK_PIN6(d) asm volatile("" : "+v"(d[0][0]), "+v"(d[0][1]), "+v"(d[0][2]), "+v"(d[1][0]), "+v"(d[1][1]), "+v"(d[1][2]))
RK_DI f32x16 load_o2(Ctx& c, int buf, int lblk, int cc32) { f32x16 z = f32x16{};
    bf16x8 d[2][3];
#pragma unroll
    for (int q = 0; q < 2; ++q)
#pragma unroll
        for (int w = 0; w < 3; ++w) d[q][w] = dfrag(c, cc32, w, q);
    bf16x8 f[2][3];
#pragma unroll
    for (int q = 0; q < 2; ++q)
#pragma unroll
        for (int w = 0; w < 3; ++w) f[q][w] = rawfrag(c, buf, 4 * lblk + 2 * q + c.h, w);
    RK_PIN6(d); RK_PIN6(f);
#pragma unroll
    for (int q = 0; q < 2; ++q) {
#pragma unroll
        for (int w = 0; w < 3; ++w) z = RK_MF(d[q][w], f[q][w], z); }
    asm volatile("" : "+v"(c.lofs), "+v"(c.zt), "+v"(z));
    return z; }
RK_DI void dpre(const Ctx& c, int cc32, bf16x8 (&d)[2][3]) {
#pragma unroll
    for (int q = 0; q < 2; ++q)
#pragma unroll
        for (int w = 0; w < 3; ++w) d[q][w] = dfrag(c, cc32, w, q);
    __builtin_amdgcn_sched_barrier(0); }
RK_DI f32x16 load_o2p(Ctx& c, int buf, int lblk, bf16x8 (&d)[2][3]) { f32x16 z = f32x16{};
    bf16x8 f[2][3];
#pragma unroll
    for (int q = 0; q < 2; ++q)
#pragma unroll
        for (int w = 0; w < 3; ++w) f[q][w] = rawfrag(c, buf, 4 * lblk + 2 * q + c.h, w);
    RK_PIN6(d); RK_PIN6(f);
#pragma unroll
    for (int q = 0; q < 2; ++q) {
#pragma unroll
        for (int w = 0; w < 3; ++w) z = RK_MF(d[q][w], f[q][w], z); }
    asm volatile("" : "+v"(c.lofs), "+v"(c.zt), "+v"(z));
    return z; }
RK_DI f32x16 load_o1p(Ctx& c, int buf, int lblk, bf16x8 (&d)[2][3]) { f32x16 z = f32x16{};
    bf16x8 f[2][3];
#pragma unroll
    for (int q = 0; q < 2; ++q)
#pragma unroll
        for (int w = 0; w < 3; ++w) f[q][w] = rawfrag(c, buf, 4 * lblk + 2 * q + c.h, w);
    RK_PIN6(d); RK_PIN6(f);
#pragma unroll
    for (int q = 0; q < 2; ++q) {
#pragma unroll
        for (int w = 0; w < 3; ++w) z = RK_MF(f[q][w], d[q][w], z); }
    asm volatile("" : "+v"(c.lofs), "+v"(c.zt), "+v"(z));
    return z; }
RK_DI f32x16 load_o1(Ctx& c, int buf, int lblk, int cc32) { f32x16 z = f32x16{};
    bf16x8 d[2][3];
#pragma unroll
    for (int q = 0; q < 2; ++q)
#pragma unroll
        for (int w = 0; w < 3; ++w) d[q][w] = dfrag(c, cc32, w, q);
    bf16x8 f[2][3];
#pragma unroll
    for (int q = 0; q < 2; ++q)
#pragma unroll
        for (int w = 0; w < 3; ++w) f[q][w] = rawfrag(c, buf, 4 * lblk + 2 * q + c.h, w);
    RK_PIN6(d); RK_PIN6(f);
#pragma unroll
    for (int q = 0; q < 2; ++q) {
#pragma unroll
        for (int w = 0; w < 3; ++w) z = RK_MF(f[q][w], d[q][w], z); }
    asm volatile("" : "+v"(c.lofs), "+v"(c.zt), "+v"(z));
    return z; }

struct Tilde { bf16x8 At[2][2], Bt[2][2], Kt[2][2], Rt[2][2], Vp[2][2]; float gtot[2]; float bon; };
#define RK_STAGE(x) asm volatile("" : "+v"(c.lofs), "+v"(c.zt), "+v"(x))
template <bool NEED_R> RK_DI void build_tilde(Ctx& c, Tilde& T) {
    const int r = c.r, h = c.h;
    stage_slice(c, 0, RW_WD + c.dir * 64); stage_slice(c, 1, RW_K + c.hd * 64); stage_slice(c, 2, RW_AD + c.dir * 64); if constexpr (NEED_R) stage_slice(c, 3, RW_R + c.hd * 64);
    bf16x8 dq0[2][3], dq1[2][3]; dpre(c, RW_WD + c.dir * 64, dq0);
    RK_WAIT_DMA();
    bf16x8 lwp[2][2];
    {   bf16x8 twp[2][2];
#pragma unroll
        for (int Ii = 0; Ii < 2; ++Ii) { if (Ii == 0) dpre(c, RW_WD + c.dir * 64 + 32, dq1); else dpre(c, RW_K + c.hd * 64, dq0);
            f32x16 t = load_o2p(c, 0, Ii, Ii == 0 ? dq0 : dq1);
#pragma unroll
            for (int reg = 0; reg < 16; ++reg) t[reg] = tanh_f(t[reg]);
            twp[Ii][0] = pack<0>(t); twp[Ii][1] = pack<1>(t); RK_STAGE(twp[Ii][1]); }
        float w0v[2];
#pragma unroll
        for (int J = 0; J < 2; ++J) w0v[J] = inp(I_W0)[c.dofs + 32 * J + r];
        bf16x8 wf[2][2];
#pragma unroll
        for (int Ii = 0; Ii < 2; ++Ii)
#pragma unroll
            for (int S = 0; S < 2; ++S) wf[Ii][S] = *(const bf16x8*)(C_W2P(c) + ((Ii * 2 + 0) * 2 + S) * 512 + c.lofs);
        __builtin_amdgcn_sched_barrier(0);
#pragma unroll
        for (int J = 0; J < 2; ++J) { f32x16 wl = f32x16{}; bf16x8 wn[2][2];
#pragma unroll
            for (int Ii = 0; Ii < 2; ++Ii)
#pragma unroll
                for (int S = 0; S < 2; ++S) wn[Ii][S] = wf[Ii][S];
            if (J == 0) {
#pragma unroll
                for (int Ii = 0; Ii < 2; ++Ii)
#pragma unroll
                    for (int S = 0; S < 2; ++S) wn[Ii][S] = *(const bf16x8*)(C_W2P(c) + ((Ii * 2 + 1) * 2 + S) * 512 + c.lofs); }
            __builtin_amdgcn_sched_barrier(0);
            asm volatile("" : "+v"(wf[0][0]), "+v"(wf[0][1]), "+v"(wf[1][0]), "+v"(wf[1][1]));
#pragma unroll
            for (int Ii = 0; Ii < 2; ++Ii)
#pragma unroll
                for (int S = 0; S < 2; ++S) wl = RK_MF(twp[Ii][S], wf[Ii][S], wl);
            const float w0 = w0v[J]; float gs = 0.f;
#pragma unroll
            for (int reg = 0; reg < 16; ++reg) wl[reg] = -0.6065306597126334f * sigm(wl[reg] + w0);
            lwp[J][0] = pack<0>(wl); lwp[J][1] = pack<1>(wl);
            { float q[8]; unpack8(lwp[J][0], q);
#pragma unroll
              for (int e = 0; e < 8; ++e) gs += q[e]; unpack8(lwp[J][1], q);
#pragma unroll
              for (int e = 0; e < 8; ++e) gs += q[e]; }
            gs += __shfl_xor(gs, 32); T.gtot[J] = gs; RK_STAGE(lwp[J][1]);
#pragma unroll
            for (int Ii = 0; Ii < 2; ++Ii)
#pragma unroll
                for (int S = 0; S < 2; ++S) wf[Ii][S] = wn[Ii][S]; } }
    RK_WAIT_LDS(); stage_slice(c, 0, RW_V + c.hd * 64);
    float rinv; f32x16 ktk[2];
    {   float ss = 0.f;
#pragma unroll
        for (int Ik = 0; Ik < 2; ++Ik) { if (Ik == 0) dpre(c, RW_K + c.hd * 64 + 32, dq1);
f32x4 kk_v[4]; { const float* pv_ = inp(I_KK) + c.cofs + 32 * Ik + 4 * h;
  _Pragma("unroll") for (int g = 0; g < 4; ++g) kk_v[g] = *(const f32x4*)(pv_ + 8 * g); }
            __builtin_amdgcn_sched_barrier(0);
            const f32x16 kt = load_o2p(c, 1, Ik, Ik == 0 ? dq0 : dq1); ktk[Ik] = kt;
#pragma unroll
            for (int g = 0; g < 4; ++g) { const f32x4 kk = kk_v[g];
#pragma unroll
                for (int j = 0; j < 4; ++j) { const float q = kt[4 * g + j] * kk[j]; ss += q * q; } }
            RK_STAGE(ss); }
        ss += __shfl_xor(ss, 32); rinv = 1.f / fmaxf(sqrtf(ss), 1e-12f); RK_STAGE(rinv); }
    float bon = 0.f;
#pragma unroll
    for (int Ik = 0; Ik < 2; ++Ik) {
        f32x16 em, ep;
        bf16x8 af[4];
#pragma unroll
        for (int sp = 0; sp < 4; ++sp) af[sp] = *(const bf16x8*)(C_A2B(c) + (32 * Ik + r) * 64 + 16 * sp + 8 * h);
f32x4 kk_v[4]; { const float* pv_ = inp(I_KK) + c.cofs + 32 * Ik + 4 * h;
  _Pragma("unroll") for (int g = 0; g < 4; ++g) kk_v[g] = *(const f32x4*)(pv_ + 8 * g); }
        __builtin_amdgcn_sched_barrier(0);
        { em = RK_MF(lwp[Ik][0], incp<0, false>(r, h, c.flip), f32x16{}); em = RK_MF(lwp[Ik][1], incp<1, false>(r, h, c.flip), em);
          ep = RK_MF(lwp[Ik][0], incp<0, true>(r, h, c.flip), f32x16{}); ep = RK_MF(lwp[Ik][1], incp<1, true>(r, h, c.flip), ep);
#pragma unroll
          for (int reg = 0; reg < 16; ++reg) { em[reg] = __expf(-em[reg]); ep[reg] = __expf(ep[reg]); } }
        RK_STAGE(ep);
        f32x16 kt = ktk[Ik]; f32x16 kn;
#pragma unroll
        for (int g = 0; g < 4; ++g) { const f32x4 kk = kk_v[g];
#pragma unroll
            for (int j = 0; j < 4; ++j) { const int reg = 4 * g + j; kn[reg] = kt[reg] * kk[j] * rinv; ep[reg] = -kn[reg] * ep[reg]; } }
        T.At[Ik][0] = pack<0>(ep); T.At[Ik][1] = pack<1>(ep);
        RK_STAGE(T.At[Ik][1]);
f32x4 a0_v[4]; { const float* pv_ = inp(I_A0) + c.dofs + 32 * Ik + 4 * h;
  _Pragma("unroll") for (int g = 0; g < 4; ++g) a0_v[g] = *(const f32x4*)(pv_ + 8 * g); }
        __builtin_amdgcn_sched_barrier(0);
        f32x16 as = f32x16{};
#pragma unroll
        for (int w = 0; w < 3; ++w) { bf16x8 an[4];
#pragma unroll
            for (int sp = 0; sp < 4; ++sp) an[sp] = af[sp];
            if (w < 2) {
#pragma unroll
                for (int sp = 0; sp < 4; ++sp) an[sp] = *(const bf16x8*)(C_A2B(c) + (w + 1) * 4096 + (32 * Ik + r) * 64 + 16 * sp + 8 * h); }
            __builtin_amdgcn_sched_barrier(0);
            asm volatile("" : "+v"(af[0]), "+v"(af[1]), "+v"(af[2]), "+v"(af[3]));
#pragma unroll
            for (int sp = 0; sp < 4; ++sp) as = RK_MF(af[sp], rawfrag(c, 2, 2 * sp + h, w), as);
            RK_STAGE(as);
#pragma unroll
            for (int sp = 0; sp < 4; ++sp) af[sp] = an[sp]; }
f32x4 ka_v[4]; { const float* pv_ = inp(I_KA) + c.cofs + 32 * Ik + 4 * h;
  _Pragma("unroll") for (int g = 0; g < 4; ++g) ka_v[g] = *(const f32x4*)(pv_ + 8 * g); }
        __builtin_amdgcn_sched_barrier(0);
#pragma unroll
        for (int g = 0; g < 4; ++g) { const f32x4 a0 = a0_v[g];
#pragma unroll
            for (int j = 0; j < 4; ++j) { const int reg = 4 * g + j; as[reg] = sigm(as[reg] + a0[j]); kn[reg] = kn[reg] * as[reg] * em[reg]; } }
        T.Bt[Ik][0] = pack<0>(kn); T.Bt[Ik][1] = pack<1>(kn);
        RK_STAGE(T.Bt[Ik][1]);
        f32x4 rk_v[4]; if constexpr (NEED_R) { const float* pv_ = inp(I_RK) + c.cofs + 32 * Ik + 4 * h;
  _Pragma("unroll") for (int g = 0; g < 4; ++g) rk_v[g] = *(const f32x4*)(pv_ + 8 * g);
  dpre(c, RW_R + c.hd * 64 + 32 * Ik, dq0); }
        __builtin_amdgcn_sched_barrier(0);
#pragma unroll
        for (int g = 0; g < 4; ++g) { const f32x4 ka = ka_v[g];
#pragma unroll
            for (int j = 0; j < 4; ++j) { const int reg = 4 * g + j; kt[reg] = kt[reg] * (1.f + (as[reg] - 1.f) * ka[j]); as[reg] = kt[reg] * em[reg]; } }
        T.Kt[Ik][0] = pack<0>(as); T.Kt[Ik][1] = pack<1>(as);
        RK_STAGE(T.Kt[Ik][1]);
        if constexpr (NEED_R) {
            f32x16 rt = load_o2p(c, 3, Ik, dq0);
#pragma unroll
            for (int g = 0; g < 4; ++g) { const f32x4 rk = rk_v[g];
#pragma unroll
                for (int j = 0; j < 4; ++j) { const int reg = 4 * g + j; bon += rt[reg] * kt[reg] * rk[j]; rt[reg] = rt[reg] * __builtin_amdgcn_rcpf(em[reg]); } }
            T.Rt[Ik][0] = pack<0>(rt); T.Rt[Ik][1] = pack<1>(rt); RK_STAGE(T.Rt[Ik][1]); }
    }
    T.bon = bon;
    RK_WAIT_DMA();
    dpre(c, RW_V + c.hd * 64, dq0);
#pragma unroll
    for (int J = 0; J < 2; ++J) { if (J == 0) dpre(c, RW_V + c.hd * 64 + 32, dq1);
        const f32x16 va = load_o1p(c, 0, J, J == 0 ? dq0 : dq1); T.Vp[J][0] = pack<0>(va); T.Vp[J][1] = pack<1>(va); RK_STAGE(T.Vp[J][1]); }
}
RK_DI void grams_la(const Ctx& c, const Tilde& T, bf16x8 (&Lk)[2], bf16x8 (&Mp)[2]) {
    f32x16 g = f32x16{}, m = f32x16{};
#pragma unroll
    for (int Ik = 0; Ik < 2; ++Ik)
#pragma unroll
        for (int S = 0; S < 2; ++S) { g = RK_MF(T.Kt[Ik][S], T.At[Ik][S], g); m = RK_MF(T.Bt[Ik][S], T.At[Ik][S], m); }
    tmask<true>(g, c.r, c.h, c.flip); tmask<true>(m, c.r, c.h, c.flip);
    Lk[0] = pack<0>(g); Lk[1] = pack<1>(g); Mp[0] = pack<0>(m); Mp[1] = pack<1>(m);
}
}

namespace rk {
constexpr int NSUB = RPB / 32;
RK_DI int chain_unit(int dir, int j) { return dir == 0 ? j : (j < 8 ? 7 - j : 143 - j); }
RK_DI int chain_pos(int dir, int c) { return dir == 0 ? c : (c < 8 ? 7 - c : 143 - c); }
RK_DI void setup_ctx(Ctx& c, unsigned char* ws, LAS unsigned char* sb, int l, int bl, int hd, int dir, int c32, int lane) {
    c.ws = ws; c.sb = sb; c.m0 = bl * RPB + 32 * c32; c.r = lane & 31; c.h = lane >> 5; c.hd = hd; c.dir = dir; c.l = l; c.flip = dir;
    c.cofs = l * 512 + hd * 64; c.dofs = (l * 2 + dir) * 512 + hd * 64;
    const int m = c.m0 + c.r, sg = m % RPB;
    c.mp = (sg != 0 && sg != CTX) ? 0xffffffffu : 0u; c.mn = (sg != CTX - 1 && sg != RPB - 1) ? 0xffffffffu : 0u;
    c.rowc = m; c.rowp = m > 0 ? m - 1 : 0; c.rown = m < HM - 1 ? m + 1 : HM - 1; c.lofs = (c.r + 32 * c.h) * 8; asm volatile("v_mov_b32 %0, 0" : "=v"(c.zt));
}
RK_DI void pass1_unit(unsigned char* ws, LAS unsigned char* sb, int l, int u, int lane) {
    const int q = u / NSUB, c32 = u % NSUB, bl = q >> 4, hd = (q >> 1) & 7, dir = q & 1;
    Ctx c; setup_ctx(c, ws, sb, l, bl, hd, dir, c32, lane);
    Tilde T; build_tilde<false>(c, T); __builtin_amdgcn_sched_barrier(0);
    const int r = c.r, h = c.h;
    bf16x8 Lk[2], Mp[2]; grams_la(c, T, Lk, Mp); __builtin_amdgcn_sched_barrier(0);
    const bf16x8 P0 = idp<0>(r, h), P1 = idp<1>(r, h);
    bf16x8 W1p[2][2], W2p[2][2], Bop[2][2], Kop[2][2];
#pragma unroll
    for (int J = 0; J < 2; ++J) {
        f32x16 x = RK_MF(T.At[J][0], P0, f32x16{}); x = RK_MF(T.At[J][1], P1, x);
        f32x16 y = RK_MF(Lk[0], T.Vp[J][0], f32x16{}); y = RK_MF(Lk[1], T.Vp[J][1], y);
        if (c.flip) solve32p<1>(x, y, Mp); else solve32p<0>(x, y, Mp);
        W1p[J][0] = pack<0>(x); W1p[J][1] = pack<1>(x);
        W2p[J][0] = pack<0>(y); W2p[J][1] = pack<1>(y);
        const float gcj = __expf(T.gtot[J]);
        f32x16 b = RK_MF(T.Bt[J][0], P0, f32x16{}); b = RK_MF(T.Bt[J][1], P1, b);
        f32x16 k = RK_MF(T.Kt[J][0], P0, f32x16{}); k = RK_MF(T.Kt[J][1], P1, k);
#pragma unroll
        for (int reg = 0; reg < 16; ++reg) { b[reg] *= gcj; k[reg] *= gcj; }
        Bop[J][0] = pack<0>(b); Bop[J][1] = pack<1>(b); Kop[J][0] = pack<0>(k); Kop[J][1] = pack<1>(k);
    }
    u32x4* phi = (u32x4*)(ws + WS_HALF + H_PHI) + (size_t)u * 512 + lane;
    u32x4* psi = (u32x4*)(ws + WS_HALF + H_PSI) + (size_t)u * 512 + lane;
#pragma unroll
    for (int I = 0; I < 2; ++I)
#pragma unroll
        for (int J = 0; J < 2; ++J) {
            f32x16 a = RK_MF(W1p[I][0], Bop[J][0], f32x16{}); a = RK_MF(W1p[I][1], Bop[J][1], a);
            if (I == J) {
#pragma unroll
                for (int reg = 0; reg < 16; ++reg) a[reg] += (crow(reg, h) == r) ? __expf(T.gtot[J]) : 0.f; }
            phi[((I * 2 + J) * 2 + 0) * 64] = __builtin_bit_cast(u32x4, pack<0>(a)); phi[((I * 2 + J) * 2 + 1) * 64] = __builtin_bit_cast(u32x4, pack<1>(a));
            f32x16 p = RK_MF(Bop[I][0], W2p[J][0], f32x16{}); p = RK_MF(Bop[I][1], W2p[J][1], p); p = RK_MF(Kop[I][0], T.Vp[J][0], p); p = RK_MF(Kop[I][1], T.Vp[J][1], p);
            psi[((I * 2 + J) * 2 + 0) * 64] = (u32x4){cvt2(p[0], p[1]), cvt2(p[2], p[3]), cvt2(p[4], p[5]), cvt2(p[6], p[7])};
            psi[((I * 2 + J) * 2 + 1) * 64] = (u32x4){cvt2(p[8], p[9]), cvt2(p[10], p[11]), cvt2(p[12], p[13]), cvt2(p[14], p[15])};
        }
}
RK_DI void pass2_chain(unsigned char* ws, int q, int lane, bool do_store) {
    const int dir = q & 1;
    f32x16 H[2][2] = {{f32x16{}, f32x16{}}, {f32x16{}, f32x16{}}};
    u32x4 phi[8], psi[8];
    { const int u0 = q * NSUB + chain_unit(dir, 0);
      const u32x4* ph = (const u32x4*)(ws + WS_HALF + H_PHI) + (size_t)u0 * 512 + lane; const u32x4* ps = (const u32x4*)(ws + WS_HALF + H_PSI) + (size_t)u0 * 512 + lane;
#pragma unroll
      for (int f = 0; f < 8; ++f) { phi[f] = ph[f * 64]; psi[f] = ps[f * 64]; } }
    int uprev = q * NSUB + chain_unit(dir, 0);
#pragma unroll 1
    for (int j = 0; j < NSUB - 1; ++j) {
        const int un = q * NSUB + chain_unit(dir, j + 1 < NSUB - 1 ? j + 1 : j);
        u32x4 nphi[8], npsi[8];
        { const u32x4* ph = (const u32x4*)(ws + WS_HALF + H_PHI) + (size_t)un * 512 + lane; const u32x4* ps = (const u32x4*)(ws + WS_HALF + H_PSI) + (size_t)un * 512 + lane;
#pragma unroll
          for (int f = 0; f < 8; ++f) { nphi[f] = ph[f * 64]; npsi[f] = ps[f * 64]; } }
        bf16x8 Hp[2][2][2];
#pragma unroll
        for (int I = 0; I < 2; ++I)
#pragma unroll
            for (int J = 0; J < 2; ++J) { Hp[I][J][0] = pack<0>(H[I][J]); Hp[I][J][1] = pack<1>(H[I][J]); }
#pragma unroll
        for (int Ik = 0; Ik < 2; ++Ik)
#pragma unroll
            for (int Jv = 0; Jv < 2; ++Jv) {
                f32x16 a; const u32x4 p0 = psi[(Ik * 2 + Jv) * 2], p1 = psi[(Ik * 2 + Jv) * 2 + 1];
                a[0] = lo16(p0.x); a[1] = hi16(p0.x); a[2] = lo16(p0.y); a[3] = hi16(p0.y); a[4] = lo16(p0.z); a[5] = hi16(p0.z); a[6] = lo16(p0.w); a[7] = hi16(p0.w);
                a[8] = lo16(p1.x); a[9] = hi16(p1.x); a[10] = lo16(p1.y); a[11] = hi16(p1.y); a[12] = lo16(p1.z); a[13] = hi16(p1.z); a[14] = lo16(p1.w); a[15] = hi16(p1.w);
#pragma unroll
                for (int Ip = 0; Ip < 2; ++Ip) { a = RK_MF(__builtin_bit_cast(bf16x8, phi[(Ip * 2 + Ik) * 2 + 0]), Hp[Ip][Jv][0], a); a = RK_MF(__builtin_bit_cast(bf16x8, phi[(Ip * 2 + Ik) * 2 + 1]), Hp[Ip][Jv][1], a); }
                H[Ik][Jv] = a; }
        if (do_store) { u32x4* st = (u32x4*)(ws + WS_HALF + H_PSI) + (size_t)uprev * 512 + lane;
#pragma unroll
            for (int I = 0; I < 2; ++I)
#pragma unroll
                for (int J = 0; J < 2; ++J) { st[((I * 2 + J) * 2 + 0) * 64] = __builtin_bit_cast(u32x4, pack<0>(H[I][J])); st[((I * 2 + J) * 2 + 1) * 64] = __builtin_bit_cast(u32x4, pack<1>(H[I][J])); } }
        uprev = un;
#pragma unroll
        for (int f = 0; f < 8; ++f) { phi[f] = nphi[f]; psi[f] = npsi[f]; }
    }
    if (!do_store) { float chk = 0.f;
#pragma unroll
        for (int I = 0; I < 2; ++I)
#pragma unroll
            for (int J = 0; J < 2; ++J)
#pragma unroll
                for (int reg = 0; reg < 16; ++reg) chk += H[I][J][reg];
        if (chk == 123456.789f) ((float*)(ws + WS_END))[lane] = chk; }
}
RK_DI void pass2_half(unsigned char* ws, int q, int jv, int lane) {
    static_assert((NSUB - 1) % 3 == 0, "three-step rotation");
    const int dir = q & 1;
    bf16x8 Hp[2][2] = {{bf16x8{}, bf16x8{}}, {bf16x8{}, bf16x8{}}};
#define P2_LD(jj, PH, PS) do { const int jc_ = (jj) < NSUB - 1 ? (jj) : NSUB - 2; const int un_ = q * NSUB + chain_unit(dir, jc_); \
        const u32x4* ph_ = (const u32x4*)(ws + WS_HALF + H_PHI) + (size_t)un_ * 512 + lane; const u32x4* ps_ = (const u32x4*)(ws + WS_HALF + H_PSI) + (size_t)un_ * 512 + jv * 128 + lane; \
        _Pragma("unroll") for (int f = 0; f < 8; ++f) PH[f] = ph_[f * 64]; \
        PS[0] = ps_[0]; PS[1] = ps_[64]; PS[2] = ps_[256]; PS[3] = ps_[320]; } while (0)
#define P2_UNPK(A, p0, p1) do { A[0] = lo16(p0.x); A[1] = hi16(p0.x); A[2] = lo16(p0.y); A[3] = hi16(p0.y); A[4] = lo16(p0.z); A[5] = hi16(p0.z); A[6] = lo16(p0.w); A[7] = hi16(p0.w); \
        A[8] = lo16(p1.x); A[9] = hi16(p1.x); A[10] = lo16(p1.y); A[11] = hi16(p1.y); A[12] = lo16(p1.z); A[13] = hi16(p1.z); A[14] = lo16(p1.w); A[15] = hi16(p1.w); } while (0)
#define P2_STEP(jj, PH, PS) do { f32x16 a0, a1; P2_UNPK(a0, PS[0], PS[1]); P2_UNPK(a1, PS[2], PS[3]); \
        _Pragma("unroll") for (int Ip = 0; Ip < 2; ++Ip) { \
            a0 = RK_MF(__builtin_bit_cast(bf16x8, PH[(Ip * 2 + 0) * 2 + 0]), Hp[Ip][0], a0); a1 = RK_MF(__builtin_bit_cast(bf16x8, PH[(Ip * 2 + 1) * 2 + 0]), Hp[Ip][0], a1); \
            a0 = RK_MF(__builtin_bit_cast(bf16x8, PH[(Ip * 2 + 0) * 2 + 1]), Hp[Ip][1], a0); a1 = RK_MF(__builtin_bit_cast(bf16x8, PH[(Ip * 2 + 1) * 2 + 1]), Hp[Ip][1], a1); } \
        Hp[0][0] = pack<0>(a0); Hp[0][1] = pack<1>(a0); Hp[1][0] = pack<0>(a1); Hp[1][1] = pack<1>(a1); \
        u32x4* st_ = (u32x4*)(ws + WS_HALF + H_PSI) + (size_t)(q * NSUB + chain_unit(dir, (jj))) * 512 + jv * 128 + lane;        \
        st_[0] = __builtin_bit_cast(u32x4, Hp[0][0]); st_[64] = __builtin_bit_cast(u32x4, Hp[0][1]); st_[256] = __builtin_bit_cast(u32x4, Hp[1][0]); st_[320] = __builtin_bit_cast(u32x4, Hp[1][1]); } while (0)
    u32x4 phA[8], psA[4], phB[8], psB[4], phC[8], psC[4];
    P2_LD(0, phA, psA); P2_LD(1, phB, psB);
    int j = 0;
#pragma unroll 1
    for (; j + 6 <= NSUB - 1; j += 6) {
        P2_LD(j + 2, phC, psC); P2_STEP(j, phA, psA);
        P2_LD(j + 3, phA, psA); P2_STEP(j + 1, phB, psB);
        P2_LD(j + 4, phB, psB); P2_STEP(j + 2, phC, psC);
        P2_LD(j + 5, phC, psC); P2_STEP(j + 3, phA, psA);
        P2_LD(j + 6, phA, psA); P2_STEP(j + 4, phB, psB);
        P2_LD(j + 7, phB, psB); P2_STEP(j + 5, phC, psC);
    }
#pragma unroll 1
    for (; j < NSUB - 1; j += 3) {
        P2_LD(j + 2, phC, psC); P2_STEP(j, phA, psA);
        P2_LD(j + 3, phA, psA); P2_STEP(j + 1, phB, psB);
        P2_LD(j + 4, phB, psB); P2_STEP(j + 2, phC, psC);
    }
#undef P2_LD
#undef P2_UNPK
#undef P2_STEP
}
RK_DI void pass3_dir(const int DIR, unsigned char* ws, LAS unsigned char* sb, int l, int bl, int hd, int c32, int lane, f32x16 (&Y)[2], float& bons) {
    Ctx c; setup_ctx(c, ws, sb, l, bl, hd, DIR, c32, lane);
    const int r = c.r, h = c.h;
    Tilde T; build_tilde<true>(c, T); __builtin_amdgcn_sched_barrier(0);
    u32x4 hw[2][2][2]; const int hj = chain_pos(DIR, c32);
    { const int q = (bl * 8 + hd) * 2 + DIR, jp = hj > 0 ? hj - 1 : 0;
      const u32x4* st = (const u32x4*)(ws + WS_HALF + H_PSI) + (size_t)(q * NSUB + chain_unit(DIR, jp)) * 512 + lane;
#pragma unroll
      for (int I = 0; I < 2; ++I)
#pragma unroll
          for (int J = 0; J < 2; ++J)
#pragma unroll
              for (int S = 0; S < 2; ++S) hw[I][J][S] = st[((I * 2 + J) * 2 + S) * 64]; }
    __builtin_amdgcn_sched_barrier(0);
    bons += T.bon + __shfl_xor(T.bon, 32);
    bf16x8 Lk[2], Mp[2]; grams_la(c, T, Lk, Mp); __builtin_amdgcn_sched_barrier(0);
    bf16x8 Ab[2], Ak[2];
    {   f32x16 gb = f32x16{}, gk = f32x16{};
#pragma unroll
        for (int Ik = 0; Ik < 2; ++Ik)
#pragma unroll
            for (int S = 0; S < 2; ++S) { gb = RK_MF(T.Bt[Ik][S], T.Rt[Ik][S], gb); gk = RK_MF(T.Kt[Ik][S], T.Rt[Ik][S], gk); }
        tmask<false>(gb, r, h, DIR); tmask<false>(gk, r, h, DIR);
        Ab[0] = pack<0>(gb); Ab[1] = pack<1>(gb); Ak[0] = pack<0>(gk); Ak[1] = pack<1>(gk); }
    RK_STAGE(Ak[1]);
    bf16x8 H0p[2][2][2];
    { const unsigned hm = hj > 0 ? 0xffffffffu : 0u;
#pragma unroll
      for (int I = 0; I < 2; ++I)
#pragma unroll
          for (int J = 0; J < 2; ++J)
#pragma unroll
              for (int S = 0; S < 2; ++S) { u32x4 w = hw[I][J][S]; w.x &= hm; w.y &= hm; w.z &= hm; w.w &= hm; H0p[I][J][S] = __builtin_bit_cast(bf16x8, w); } }
    bf16x8 Up[2][2];
    {   f32x16 xs[2];
#pragma unroll
        for (int Jv = 0; Jv < 2; ++Jv) {
            f32x16 x = RK_MF(Lk[0], T.Vp[Jv][0], f32x16{}); x = RK_MF(Lk[1], T.Vp[Jv][1], x);
#pragma unroll
            for (int Ik = 0; Ik < 2; ++Ik) { x = RK_MF(T.At[Ik][0], H0p[Ik][Jv][0], x); x = RK_MF(T.At[Ik][1], H0p[Ik][Jv][1], x); }
            xs[Jv] = x; }
        if (DIR) solve32p<1>(xs[0], xs[1], Mp); else solve32p<0>(xs[0], xs[1], Mp);
#pragma unroll
        for (int Jv = 0; Jv < 2; ++Jv) { Up[Jv][0] = pack<0>(xs[Jv]); Up[Jv][1] = pack<1>(xs[Jv]); }
        __builtin_amdgcn_sched_barrier(0); }
    __builtin_amdgcn_sched_barrier(0);
#pragma unroll
    for (int Iv = 0; Iv < 2; ++Iv) {
        f32x16 y = f32x16{};
#pragma unroll
        for (int Ik = 0; Ik < 2; ++Ik) { y = RK_MF(H0p[Ik][Iv][0], T.Rt[Ik][0], y); y = RK_MF(H0p[Ik][Iv][1], T.Rt[Ik][1], y); }
        y = RK_MF(Up[Iv][0], Ab[0], y); y = RK_MF(Up[Iv][1], Ab[1], y); y = RK_MF(T.Vp[Iv][0], Ak[0], y); y = RK_MF(T.Vp[Iv][1], Ak[1], y);
        Y[Iv] = y; }
}
RK_DI void pass3_unit(unsigned char* ws, LAS unsigned char* sb, int l, int v3, int lane, unsigned* ypark) {
    const int c32 = v3 % NSUB, bh = v3 / NSUB, bl = bh >> 3, hd = bh & 7, r = lane & 31, h = lane >> 5;
    float bons = 0.f;
    LAS float* ylds = (LAS float*)(sb + SBUF);
#pragma unroll 1
    for (int dir = 0; dir < 2; ++dir) {
        int lane_ = lane; asm volatile("" : "+v"(lane_));
        f32x16 Y[2]; pass3_dir(dir, ws, sb, l, bl, hd, c32, lane_, Y, bons);
        if (dir == 0) {
#pragma unroll
            for (int Iv = 0; Iv < 2; ++Iv)
#pragma unroll
                for (int d = 0; d < 8; ++d) ypark[(Iv * 8 + d) * 64 + lane] = cvt2(Y[Iv][2 * d], Y[Iv][2 * d + 1]); }
        else {
#pragma unroll
            for (int Iv = 0; Iv < 2; ++Iv)
#pragma unroll
                for (int reg = 0; reg < 16; ++reg) ylds[(Iv * 16 + reg) * 64 + lane] = Y[Iv][reg]; }
        __builtin_amdgcn_sched_barrier(0); }
    f32x16 YT[2];
#pragma unroll
    for (int Iv = 0; Iv < 2; ++Iv)
#pragma unroll
        for (int reg = 0; reg < 16; ++reg) YT[Iv][reg] = ylds[(Iv * 16 + reg) * 64 + lane];
    Ctx c; setup_ctx(c, ws, sb, l, bl, hd, 0, c32, lane);
    RK_WAIT_LDS(); stage_slice(c, 1, RW_GD); stage_slice(c, 2, RW_GD + 64);
    bf16x8 e0[2][3], e1[2][3]; dpre(c, RW_GD, e0);
    unsigned yw[2][8];
#pragma unroll
    for (int Iv = 0; Iv < 2; ++Iv)
#pragma unroll
        for (int d = 0; d < 8; ++d) yw[Iv][d] = ypark[(Iv * 8 + d) * 64 + lane];
    RK_WAIT_DMA();
#pragma unroll
    for (int Iv = 0; Iv < 2; ++Iv)
#pragma unroll
        for (int d = 0; d < 8; ++d) { YT[Iv][2 * d] += lo16(yw[Iv][d]); YT[Iv][2 * d + 1] += hi16(yw[Iv][d]); }
    float sm = 0.f;
#pragma unroll
    for (int Iv = 0; Iv < 2; ++Iv)
#pragma unroll
        for (int reg = 0; reg < 16; ++reg) sm += YT[Iv][reg];
    sm += __shfl_xor(sm, 32); const float mean = sm * (1.f / 64.f); float vq = 0.f;
#pragma unroll
    for (int Iv = 0; Iv < 2; ++Iv)
#pragma unroll
        for (int reg = 0; reg < 16; ++reg) { YT[Iv][reg] -= mean; vq += YT[Iv][reg] * YT[Iv][reg]; }
    vq += __shfl_xor(vq, 32); const float rstd = 1.f / sqrtf(vq * (1.f / 64.f) + LNX_EPS);
    const bf16* g2P = (const bf16*)(ws + WS_TAB + 524288) + (size_t)hd * 8192;
    const float* lnw = inp(I_LNW) + l * 512 + hd * 64; const float* lnb = inp(I_LNB) + l * 512 + hd * 64;
    bf16x8 sgp[4][2];
#pragma unroll
    for (int Ii = 0; Ii < 4; ++Ii) {
        if (Ii == 0) dpre(c, RW_GD + 32, e1); else if (Ii == 1) dpre(c, RW_GD + 64, e0); else if (Ii == 2) dpre(c, RW_GD + 96, e1); else dpre(c, RW_V + hd * 64, e0);
        f32x16 t = load_o2p(c, 1 + (Ii >> 1), Ii & 1, (Ii & 1) ? e1 : e0);
#pragma unroll
        for (int reg = 0; reg < 16; ++reg) t[reg] = sigm(t[reg]);
        sgp[Ii][0] = pack<0>(t); sgp[Ii][1] = pack<1>(t); __builtin_amdgcn_sched_barrier(0); }
    RK_WAIT_LDS(); LAS unsigned char* st = c.sb + SBUF;
#pragma unroll
    for (int Iv = 0; Iv < 2; ++Iv) {
        if (Iv == 0) dpre(c, RW_V + hd * 64 + 32, e1);
        f32x4 lwv[4], lbv[4];
#pragma unroll
        for (int g = 0; g < 4; ++g) { const int v0 = 32 * Iv + 8 * g + 4 * h; lwv[g] = *(const f32x4*)(lnw + v0); lbv[g] = *(const f32x4*)(lnb + v0); }
        __builtin_amdgcn_sched_barrier(0);
        f32x16 gt = f32x16{};
#pragma unroll
        for (int Ip = 0; Ip < 2; ++Ip) { bf16x8 gf[2][2];
#pragma unroll
            for (int Iq = 0; Iq < 2; ++Iq)
#pragma unroll
                for (int S = 0; S < 2; ++S) gf[Iq][S] = *(const bf16x8*)(g2P + (((2 * Ip + Iq) * 2 + Iv) * 2 + S) * 512 + c.lofs);
            asm volatile("" : "+v"(gf[0][0]), "+v"(gf[0][1]), "+v"(gf[1][0]), "+v"(gf[1][1]));
#pragma unroll
            for (int Iq = 0; Iq < 2; ++Iq)
#pragma unroll
                for (int S = 0; S < 2; ++S) gt = RK_MF(gf[Iq][S], sgp[2 * Ip + Iq][S], gt);
            RK_STAGE(gt); }
        const f32x16 vt = load_o2p(c, 0, Iv, Iv == 0 ? e0 : e1);
        asm volatile("" : "+v"(lwv[0]), "+v"(lwv[1]), "+v"(lwv[2]), "+v"(lwv[3]), "+v"(lbv[0]), "+v"(lbv[1]), "+v"(lbv[2]), "+v"(lbv[3]));
#pragma unroll
        for (int g = 0; g < 4; ++g) { const int v0 = 32 * Iv + 8 * g + 4 * h; const f32x4 lw = lwv[g], lb = lbv[g]; float o[4];
#pragma unroll
            for (int j = 0; j < 4; ++j) { const int reg = 4 * g + j; o[j] = (YT[Iv][reg] * rstd * lw[j] + lb[j] + bons * vt[reg]) * gt[reg]; }
            *(LAS unsigned long long*)(st + r * 144 + 2 * v0) = (unsigned long long)cvt2(o[0], o[1]) | ((unsigned long long)cvt2(o[2], o[3]) << 32); }
    }
    asm volatile("s_waitcnt lgkmcnt(0)" ::: "memory");
    bf16* RO = (bf16*)(ws + WS_HALF + H_PP) + (size_t)c.m0 * PPW + C_QD + hd * 64;
#pragma unroll
    for (int i = 0; i < 4; ++i) { const int id = i * 64 + lane, row = id >> 3, ch = id & 7; const u32x4 v = *(const LAS u32x4*)(st + row * 144 + ch * 16); *(u32x4*)(RO + (size_t)row * PPW + ch * 8) = v; }
    asm volatile("s_waitcnt lgkmcnt(0)" ::: "memory");
}
}

__device__ __forceinline__ void ph_rwkv1(Frame& F, int l) {
    const int gw = F.bid * NWAVES + FWAVE(), NGW = F.G * NWAVES; LAS unsigned char* sb = F.lds + FWAVE() * (4 * rk::SBUF);
    const bool skew = NGW == 2048;
#pragma unroll 1
    for (int r = 0;; ++r) {
        int u = gw + r * NGW;
        if (skew && r == 2) u = (F.bid < 64 && FWAVE() < 4) ? 2 * NGW + F.bid * 4 + FWAVE() : NUNIT;
        if (u >= NUNIT) break;
        rk::pass1_unit(F.ws, sb, l, u, otid() & 63);
    }
    asm volatile("s_waitcnt vmcnt(0) lgkmcnt(0)" ::: "memory");
}
__device__ __forceinline__ void ph_rwkv3(Frame& F, int l, bool ctx_emit) {
    const int gw = F.bid * NWAVES + FWAVE(), NGW = F.G * NWAVES; LAS unsigned char* sb = F.lds + FWAVE() * (4 * rk::SBUF);
    {
        bf16* PP = (bf16*)(F.ws + WS_HALF + H_PP); const int lane = FLANE();
        for (int rr = gw; rr < 16 * 256; rr += NGW) { const int sidx = rr >> 8, row = rr & 255, xq = sidx >> 1, p = 2 * xq + 1, qb = 14 + (sidx & 1), bl = p >> 3, h = p & 7;
            const unsigned char* sp = F.ws + WS_SPLIT + (size_t)(sidx * 4) * SPLIT_BYTES;
            float ls[4], ov[4], mx = -1e30f;
#pragma unroll
            for (int i = 0; i < 4; ++i) { ls[i] = ((const float*)(sp + (size_t)i * SPLIT_BYTES + 32768))[row]; ov[i] = bf2f(((const bf16*)(sp + (size_t)i * SPLIT_BYTES))[row * 64 + lane]); }
            asm volatile("" : "+v"(ls[0]), "+v"(ls[1]), "+v"(ls[2]), "+v"(ls[3]), "+v"(ov[0]), "+v"(ov[1]), "+v"(ov[2]), "+v"(ov[3]));
#pragma unroll
            for (int i = 0; i < 4; ++i) mx = fmaxf(mx, ls[i]);
            float ws_ = 0.f, acc = 0.f;
#pragma unroll
            for (int i = 0; i < 4; ++i) { const float w = __builtin_amdgcn_exp2f(ls[i] - mx); ws_ += w; acc += w * ov[i]; }
            PP[(size_t)(bl * RPB + CTX + qb * 256 + row) * PPW + C_GQ + h * 64 + lane] = (bf16)f2bf(acc / ws_); } }
    unsigned* ypark = (unsigned*)(F.ws + WS_END) + (size_t)gw * 1024;
    const int per = ctx_emit ? rk::NSUB : rk::NSUB - 8, nun = 16 * per;
#pragma unroll 1
    for (int r = 0;; ++r) {
        int j = gw + r * NGW;
        if (r == 1 && NGW == 2048) j = (F.bid < P3X_WGS && FWAVE() < 4) ? NGW + F.bid * 4 + FWAVE() : nun;
        if (j >= nun) break;
        const int v3 = (j / per) * rk::NSUB + (rk::NSUB - per) + j % per; rk::pass3_unit(F.ws, sb, l, v3, otid() & 63, ypark); }
    asm volatile("s_waitcnt vmcnt(0) lgkmcnt(0)" ::: "memory");
}
__device__ __forceinline__ void ph_mixer(Frame& F, int l, int half, int rep) {
    const bool ctx_out = (l == 0);
#ifdef EXTRA_P2
    if (F.bid < 4 && rep == 0) rk::pass2_chain(F.ws, F.bid * 8 + FWAVE(), otid() & 63, false);
#endif
    if (F.bid < 16 && rep == 0 && FWAVE() < 4) { const int ch = F.bid * 4 + FWAVE(); rk::pass2_half(F.ws, ch >> 1, ch & 1, otid() & 63); }
    __syncthreads();
    unsigned* ctr0 = F.ctl + CW_ATT + ((l * 2 + half) * 2 + rep) * 8 * 64;
    LAS unsigned* slot = (LAS unsigned*)(F.lds + MISC_OFF);
    const bf16* PP = (const bf16*)(F.ws + WS_HALF + H_PP); const bf16* QM = (const bf16*)(F.ws + WS_HALF + H_QM); const bf16* KVM = (const bf16*)(F.ws + WS_HALF + H_KVM);
    bf16* MO = (bf16*)(F.ws + WS_HALF + H_MO); bf16* DUM = (bf16*)(F.ws + WS_END);
    const int nper = ctx_out ? 74 : 70;
    int xk = 0;
    for (;;) {
        const int xq = (F.bid + xk) & 7;
        if (FTID() == 0) slot[0] = atomicAdd(ctr0 + xq * 64, 1u);
        __syncthreads();
        const int v = (int)slot[0];
        __syncthreads();
        if (v >= nper) { if (++xk == 8) break; continue; }
        int type, bl, h, qb, nkeys, qrow0, part = -1, sidx = 0; const bool lat_u = v < 70;
        { int p; if (v < 62) { type = v >> 5; p = 2 * xq + ((v >> 4) & 1); qb = v & 15; nkeys = RPB; }
          else if (lat_u) { const int w = v - 62; type = 1; p = 2 * xq + 1; qb = 14 + (w >> 2); part = w & 3; sidx = xq * 2 + (w >> 2); nkeys = RPB; }
          else { const int w = v - 70; type = w >> 1; p = 2 * xq + (w & 1); qb = 0; nkeys = CTX; }
          bl = p >> 3; h = p & 7; qrow0 = lat_u ? bl * RPB + CTX + qb * 256 : bl * RPB; }
        const int krow0 = bl * RPB;
        att::Args a;
        if (type == 0) {
            a.Q = QM + (size_t)qrow0 * 768 + h * 96; a.ldq = 768; a.K0 = KVM + (size_t)krow0 * KVP + h * 128; a.ldk0 = KVP; a.K1 = PP + (size_t)krow0 * PPW + C_KR; a.ldk1 = PPW;
            a.V = KVM + (size_t)krow0 * KVP + h * 128 + 64; a.ldv = KVP; a.O = (rep ? DUM : MO) + (size_t)qrow0 * 512 + h * 64; a.ldo = 512; a.nkeys = nkeys;
            a.rope_t0 = lat_u ? qb * 256 : -1; a.tc = (const float*)(F.ws + WS_T8C); a.ts = (const float*)(F.ws + WS_T8S);
            at96::Args b; b.Q = a.Q; b.ldq = a.ldq; b.K0 = a.K0; b.ldk0 = a.ldk0; b.K1 = a.K1; b.ldk1 = a.ldk1; b.V = a.V; b.ldv = a.ldv; b.O = a.O; b.ldo = a.ldo; b.nkeys = a.nkeys;
            b.rope_t0 = a.rope_t0; b.tc = a.tc; b.ts = a.ts;
            at96::unit(b, (char*)F.ldsg);
        } else {
            const int kvh = h >> 2;
            a.Q = PP + (size_t)qrow0 * PPW + C_GQ + h * 64; a.ldq = PPW; a.K0 = PP + (size_t)krow0 * PPW + C_GK + kvh * 64; a.ldk0 = PPW; a.K1 = a.K0; a.ldk1 = PPW;
            a.V = PP + (size_t)krow0 * PPW + C_GV + kvh * 64; a.ldv = PPW; a.O = rep ? DUM + (size_t)qrow0 * 512 + h * 64 : (bf16*)PP + (size_t)qrow0 * PPW + C_GQ + h * 64; a.ldo = rep ? 512 : PPW; a.nkeys = nkeys; a.rope_t0 = -1; a.tc = nullptr; a.ts = nullptr;
            at64::Args b; b.Q = a.Q; b.ldq = a.ldq; b.K = a.K0; b.ldk = a.ldk0; b.V = a.V; b.ldv = a.ldv; b.O = a.O; b.ldo = a.ldo; b.nkeys = a.nkeys; b.lse = nullptr;
            if (part >= 0) { const int k0 = (part < 2) ? part * 1152 : 2304 + (part - 2) * 1024; b.nkeys = (part < 2) ? 1152 : 1024;
                b.K = a.K0 + (size_t)k0 * a.ldk0; b.V = a.V + (size_t)k0 * a.ldv;
                unsigned char* sp = F.ws + WS_SPLIT + (size_t)(sidx * 4 + part) * SPLIT_BYTES; b.O = (bf16*)sp; b.ldo = 64; b.lse = (float*)(sp + 32768); }
            at64::unit(b, (char*)F.ldsg);
        }
    }
}

enum { OP_W0 = 0, OP_NORM1, OP_INPROJ, OP_PREP, OP_MIXER, OP_FINISH, OP_GATE, OP_MERGE, OP_WOUT, OP_NORM2, OP_FFUP, OP_FFDOWN, OP_FINAL };
constexpr int N_PHASES = 36;
__global__ void __launch_bounds__(NWAVES * 64, 2) trunk_fwd(Args args) {
    extern __shared__ __attribute__((aligned(16))) unsigned char lds[];
    Frame F;
    F.lds = (LAS unsigned char*)lds; F.ldsg = lds;
    F.G = gridDim.x; F.bid = blockIdx.x; F.ws = args.ws; F.ctl = (unsigned*)(args.ws + WS_CTL); F.out = args.out;
    volatile LAS unsigned* MISC = (volatile LAS unsigned*)(F.lds + MISC_OFF);
    for (int u = threadIdx.x; u < 32; u += NWAVES * 64) MISC[u] = 0u;
    __syncthreads();
    const int lo = args.ph_lo, hi = args.ph_hi;
    XcdBarrier bar = xcd_barrier_post(F.ctl + CW_BAR, MISC + 8);
#ifdef EXTRA_OP
    for (int pp = 2 * lo; pp < 2 * hi; ++pp) { const int p = pp >> 1, rep = pp & 1;
#else
    for (int p = lo; p < hi; ++p) { const int rep = 0;
#endif
        GAS unsigned char* wsg_ = (GAS unsigned char*)args.ws; GAS float* outg_ = (GAS float*)args.out; int bid_ = blockIdx.x, G_ = gridDim.x;
        asm volatile("" : "+s"(wsg_), "+s"(outg_), "+s"(bid_), "+s"(G_));
        unsigned char* ws = (unsigned char*)wsg_; float* outp = (float*)outg_;
        F.ws = ws; F.out = outp; F.bid = bid_; F.G = G_; F.ctl = (unsigned*)(ws + WS_CTL);
        unsigned char* wt = ws + WS_WT; const bf16* XN = (const bf16*)(ws + WS_XN); bf16* ctxx = (bf16*)(ws + WS_CTXX); bf16* XB = (bf16*)outp;
        int op, l = 0, half = 0;
        if (p == 0) op = OP_W0; else if (p == N_PHASES - 1) op = OP_FINAL;
        else { const int q = p - 1, r = q % 17; l = q / 17; if (r == 0) op = OP_NORM1; else if (r <= 7) { half = 0; op = OP_INPROJ + (r - 1); } else if (r <= 13) { half = 1; op = OP_PREP + (r - 8); } else op = OP_NORM2 + (r - 14); }
#ifdef ONLY_OP
        op = ONLY_OP;
#endif
#ifdef EXTRA_OP
        if (rep && op != EXTRA_OP) continue;
#endif
        const void* xl = (l == 0) ? (const void*)inp(I_X) : (const void*)XB; const void* xc = (l == 0) ? (const void*)inp(I_CTX) : (const void*)ctxx; const int sbf = (l != 0);
        const bool ctx_out = (l == 0);
        const int nMf = ctx_out ? 68 : 64, nMh = ctx_out ? 34 : 32, skipf = ctx_out ? 0 : 1;
        switch (op) {
        case OP_W0: ph_weights(F, 0); break;
        case OP_NORM1: if (l == 1) ph_weights(F, 1); ph_norm(F, l, xl, xc, sbf != 0, inp(I_G1) + l * DM, 0, false, (l == 1) ? (const float*)(ws + WS_END) : nullptr); break;
#define RUN_INPROJ(hh) do { pg8::Gemm g_{XN + (size_t)(hh) * HM * DM, (const bf16*)(wt + WT_IN), DM, DM, DM}; pg8::TileOrder S_; S_.init(HM / 256, PPW / 256, F.G, F.bid, 0); \
            pg8::Epi<pg8::EPI_BF16> E_{}; E_.O = (bf16*)(ws + WS_HALF + H_PP); E_.ldc = PPW; pg8::gemm_phase<pg8::Epi<pg8::EPI_BF16>, pg8::TileOrder, true>(F.lds, g_, S_, E_); } while (0)
        case OP_INPROJ: RUN_INPROJ(half); break;
        case OP_PREP: {
            if (rep == 0) ph_prep(F, l, half); ph_rwkv1(F, l); __syncthreads();
            if (rep == 0) {
            const bool isq = F.bid >= 136; const int cQ = F.bid - 136;
            if (!isq || cQ < 102) {
                pg8::TileOrder S; if (isq) S.init(HM / 256, 3, F.G, cQ, 0); else S.init(HM / 256, 4, F.G, F.bid, 0);
                pg8::Unit u0; S.next(0, u0);
                LAS float* rsl = (LAS float*)(F.lds + 143360);
                {   const int ncol = isq ? 384 : 256, trow = FTID() >> 1, th = FTID() & 1, nch = ncol / 16;
                    const bf16* src = (const bf16*)(ws + WS_HALF + H_PP) + (size_t)(u0.pm * 256 + trow) * PPW + (isq ? C_QD : C_KVD) + th * (ncol / 2);
                    float sq = 0.f;
                    for (int c0 = 0; c0 < nch; c0 += 8) { v4u w[8];
#pragma unroll
                        for (int j = 0; j < 8; ++j) w[j] = *(const v4u*)(src + (c0 + j) * 8);
#pragma unroll
                        for (int j = 0; j < 8; ++j) { const float a0 = pg8::bf_lo(w[j].x), a1 = pg8::bf_hi(w[j].x), a2 = pg8::bf_lo(w[j].y), a3 = pg8::bf_hi(w[j].y), a4 = pg8::bf_lo(w[j].z), a5 = pg8::bf_hi(w[j].z), a6 = pg8::bf_lo(w[j].w), a7 = pg8::bf_hi(w[j].w);
                            sq += (a0 * a0 + a1 * a1) + (a2 * a2 + a3 * a3) + (a4 * a4 + a5 * a5) + (a6 * a6 + a7 * a7); } }
                    sq += __shfl_xor(sq, 1);
                    if (th == 0) rsl[trow] = (isq ? 0.10206207261596575f * 1.4426950408889634f : 1.f) / sqrtf(sq * (1.f / (float)ncol) + NORM_EPS); }
                __syncthreads();
                if (isq) { pg8::Gemm g{(const bf16*)(ws + WS_HALF + H_PP) + C_QD, (const bf16*)(wt + WT_QU), PPW, 384, 384};
                    pg8::Epi<pg8::EPI_ROWSCALE> E{}; E.O = (bf16*)(ws + WS_HALF + H_QM); E.ldc = 768; E.rsl = rsl;
                    pg8::gemm_phase<pg8::Epi<pg8::EPI_ROWSCALE>, pg8::TileOrder, true>(F.lds, g, S, E); }
                else { pg8::Gemm g{(const bf16*)(ws + WS_HALF + H_PP) + C_KVD, (const bf16*)(wt + WT_KVU), PPW, 256, 256};
                    pg8::Epi<pg8::EPI_ROWSCALE> E{}; E.O = (bf16*)(ws + WS_HALF + H_KVM); E.ldc = KVP; E.rsl = rsl;
                    pg8::gemm_phase<pg8::Epi<pg8::EPI_ROWSCALE>, pg8::TileOrder, true>(F.lds, g, S, E); } } }
            } break;
        case OP_MIXER: ph_mixer(F, l, half, rep); break;
        case OP_FINISH: ph_rwkv3(F, l, ctx_out); __syncthreads(); break;
        case OP_GATE: {
            const int gs = ctx_out ? P3X_WGS : 0;
            if (F.bid >= gs) { pg8::Gemm g{XN + (size_t)half * HM * DM, (const bf16*)(wt + WT_G), DM, DM, DM}; pg8::TileOrder S; S.init(nMh, ctx_out ? 12 : 8, F.G - gs, F.bid - gs, skipf);
                pg8::Epi<pg8::EPI_SIGMOID> E{}; E.O = (bf16*)(ws + WS_G0); E.O1 = (bf16*)(ws + WS_G1); E.O2 = (bf16*)(ws + WS_G2); E.ldc = DM;
                pg8::gemm_phase<pg8::Epi<pg8::EPI_SIGMOID>, pg8::TileOrder, true>(F.lds, g, S, E);
                if (!ctx_out) {
                    pg8::Gemm g2{XN + (size_t)half * HM * DM, (const bf16*)(wt + WT_G) + (size_t)2 * DM * DM, DM, DM, DM}; pg8::TileOrder S2; S2.init(nMh, 8, F.G, F.bid, skipf);
                    pg8::Epi<pg8::EPI_SIGMOID, true> E2{}; E2.O = (bf16*)(ws + WS_G2); E2.ldc = DM;
                    pg8::gemm_phase<pg8::Epi<pg8::EPI_SIGMOID, true>, pg8::TileOrder, true, true>(F.lds, g2, S2, E2); } } } break;
        case OP_MERGE: {
            {
                pg8::Gemm g{(const bf16*)(ws + WS_HALF + H_PP) + C_GQ, (const bf16*)(wt + WT_BR), PPW, 512, 512};
                pg8::BranchOrder S; S.dA1 = C_QD - C_GQ; S.dA2 = (long)((H_MO - H_PP) / 2) - C_GQ; S.dB = (long)DM * 512; S.lda0 = PPW; S.dlda = PPW - 512;
                if (ctx_out) { S.T.init(nMh, 4, F.G, F.bid, skipf);
                    pg8::Epi<pg8::EPI_GATEMUL> E{}; E.O = (bf16*)(ws + WS_MIX); E.ldc = DM; E.G = (const bf16*)(ws + WS_G0); E.ldg = DM; E.dG1 = (long)((WS_G1 - WS_G0) / 2); E.dG2 = (long)((WS_G2 - WS_G0) / 2); E.multi = 1; E.first = 0;
                    pg8::gemm_phase<pg8::Epi<pg8::EPI_GATEMUL>, pg8::BranchOrder, true>(F.lds, g, S, E); }
                else { S.T.init(nMh, 8, F.G, F.bid, skipf);
                    pg8::Epi<pg8::EPI_GATEMUL, true> E{}; E.O = (bf16*)(ws + WS_MIX); E.ldc = DM; E.G = (const bf16*)(ws + WS_G0); E.ldg = DM; E.dG1 = (long)((WS_G1 - WS_G0) / 2); E.dG2 = (long)((WS_G2 - WS_G0) / 2); E.multi = 1; E.first = 0;
                    pg8::gemm_phase<pg8::Epi<pg8::EPI_GATEMUL, true>, pg8::BranchOrder, true, true>(F.lds, g, S, E); } }
            } break;
        case OP_WOUT: {
            pg8::Gemm g{(const bf16*)(ws + WS_MIX), (const bf16*)(wt + WT_OUT), DM, DM, DM}; pg8::TileOrder S;
            if (ctx_out && half == 1) { S.init(nMh, 4, F.G, F.bid, skipf);
                pg8::Epi<pg8::EPI_RESID> E{}; E.xsl = xl; E.xsc = xc; E.sbf = sbf; E.xdl = XB; E.xdc = ctxx; E.gate = (const float*)(ws + WS_MOD) + (size_t)l * 5 * 6144 + 2048; E.pm_off = half * 34; E.part = nullptr; E.kslice = 1;
                pg8::gemm_phase<pg8::Epi<pg8::EPI_RESID>, pg8::TileOrder, true>(F.lds, g, S, E); }
            else { S.init(nMh, 8, F.G, ctx_out ? (F.bid + 36) % F.G : F.bid, skipf);
                pg8::Epi<pg8::EPI_RESID, true> E{}; E.xsl = xl; E.xsc = xc; E.sbf = sbf; E.xdl = XB; E.xdc = ctxx; E.gate = (const float*)(ws + WS_MOD) + (size_t)l * 5 * 6144 + 2048; E.pm_off = half * 34; E.part = nullptr; E.kslice = 1;
                pg8::gemm_phase<pg8::Epi<pg8::EPI_RESID, true>, pg8::TileOrder, true, true>(F.lds, g, S, E); }
            if (half == 0) RUN_INPROJ(1);
            } break;
        case OP_NORM2: ph_norm(F, l, XB, ctxx, true, inp(I_G2) + l * DM, 1, !ctx_out); break;
        case OP_FFUP: {
            pg8::Gemm g{XN, (const bf16*)(wt + WT_F1), DM, DM, DM}; pg8::TileOrder S; S.init(64, 16, F.G, F.bid, 1);
            pg8::Epi<pg8::EPI_RELU2> E{}; E.O = (bf16*)(ws + WS_HID); E.ldc = DFF;
            pg8::gemm_phase<pg8::Epi<pg8::EPI_RELU2>, pg8::TileOrder, true>(F.lds, g, S, E);
            if (ctx_out) {
                pg8::CtxTilesOrder S2; S2.init(F.G, F.bid, 32); pg8::Epi<pg8::EPI_RELU2, true> E2{}; E2.O = (bf16*)(ws + WS_HID); E2.ldc = DFF;
                pg8::gemm_phase<pg8::Epi<pg8::EPI_RELU2, true>, pg8::CtxTilesOrder, true, true>(F.lds, g, S2, E2); } } break;
        case OP_FFDOWN: {
            pg8::Gemm g{(const bf16*)(ws + WS_HID), (const bf16*)(wt + WT_F2), DFF, DFF, DFF}; pg8::TileOrder S; S.init(64, 4, F.G, F.bid, 1);
            pg8::Epi<pg8::EPI_RESID> E{}; E.xsl = XB; E.xsc = ctxx; E.sbf = 1; E.xdl = ctx_out ? XB : (bf16*)(ws + WS_XN); E.xdc = ctxx; E.gate = (const float*)(ws + WS_MOD) + (size_t)l * 5 * 6144 + 5120;        E.pm_off = 0; E.part = nullptr; E.kslice = 1;
            pg8::gemm_phase<pg8::Epi<pg8::EPI_RESID>, pg8::TileOrder, true>(F.lds, g, S, E);
            if (ctx_out) { pg8::Gemm g2{(const bf16*)(ws + WS_HID), (const bf16*)(wt + WT_F2), DFF, DFF, DFF / 4}; pg8::CtxSplitOrder S2; S2.init(F.G, F.bid, DFF / 4);
                E.part = (float*)(ws + WS_END); E.kslice = DFF / 4; pg8::gemm_phase<pg8::Epi<pg8::EPI_RESID>, pg8::CtxSplitOrder, true>(F.lds, g2, S2, E); } } break;
        default: ph_final(F); break;
        }
        if (op == OP_FINISH) continue;
#ifdef EXTRA_OP
        if (pp + 1 < 2 * hi) xcd_barrier(bar);
#else
        if (p + 1 < hi) xcd_barrier(bar);
#endif
    }
}

extern "C" void kernel_launch(void* const* d_in, const int* in_sizes, int n_in, void* d_out, int out_size, void* d_ws, size_t ws_size, hipStream_t stream) {
    static int grid = 0;
    if (grid == 0) {
        if (n_in != 31 || out_size != NB * SEQ * DM || ws_size < WS_END + 12 * MiB) { fprintf(stderr, "kernel_launch: unexpected shapes (n_in %d out %d ws %zu, need ws >= %zu)\n", n_in, out_size, ws_size, (size_t)WS_END); grid = -1; return; }
        int dev = 0, cus = 0;
        if (hipGetDevice(&dev) != hipSuccess || hipDeviceGetAttribute(&cus, hipDeviceAttributeMultiprocessorCount, dev) != hipSuccess) { grid = -1; return; }
        if (hipFuncSetAttribute((const void*)trunk_fwd, hipFuncAttributeMaxDynamicSharedMemorySize, LDS_BYTES) != hipSuccess) { fprintf(stderr, "kernel_launch: hipFuncSetAttribute failed\n"); grid = -1; return; }
        grid = cus;
    }
    if (grid < 0) return;
    (void)hipMemsetAsync((char*)d_ws + WS_CTL, 0, CTL_BYTES, stream);
    Args a{};
    for (int i = 0; i < 31; ++i) a.in[i] = (const float*)d_in[i];
    a.out = (float*)d_out; a.ws = (unsigned char*)d_ws;
#if ONE_LAUNCH
    a.ph_lo = 0; a.ph_hi = N_PHASES;
    hipLaunchKernelGGL(trunk_fwd, dim3(grid), dim3(NWAVES * 64), LDS_BYTES, stream, a);
#else
    for (int p = 0; p < N_PHASES; ++p) { a.ph_lo = p; a.ph_hi = p + 1; hipLaunchKernelGGL(trunk_fwd, dim3(grid), dim3(NWAVES * 64), LDS_BYTES, stream, a); }
#endif
}
```
